# Optimizing an MI355X kernel written in HIP

```python
import jax, jax.numpy as jnp
from jax import lax
import numpy as np

D_MODEL = 1024
BATCH = 16
SEQ = 4096
DEPTH = 1

CHUNK = 64
EPS = 1e-6
N_HEADS = 8
HEAD_DIM = 64
ATTN_WIDTH = N_HEADS * HEAD_DIM
ROT_DIM = HEAD_DIM // 4
ROPE_THETA = 500000.0
IDX_HEADS = 8
IDX_DIM = 64
TOPK_MAX = 256
POOL_WINDOWS = (2, 4, 8, 16)
POOL_GROUPS = len(POOL_WINDOWS)
POOL_WIDTH = 512
POOL_GROUP_DIM = POOL_WIDTH // POOL_GROUPS
N_BRANCHES = 2
PEER_HEADS = 8
PEER_KEYS = 128
PEER_EXPERTS = PEER_KEYS * PEER_KEYS
PEER_KEY_DIM = 64
PEER_TOPK = 16
TOKEN_BLOCK = 128

SPLIT_SIZES = (ATTN_WIDTH, ATTN_WIDTH, ATTN_WIDTH, IDX_HEADS * IDX_DIM, IDX_DIM, IDX_HEADS, POOL_WIDTH, N_BRANCHES * D_MODEL)
SPLIT_POINTS = tuple(int(v) for v in np.cumsum(SPLIT_SIZES)[:-1])
IN_WIDTH = int(sum(SPLIT_SIZES))

kernel_name = "hybrid_dsa_pool_peer_block"


def rms_norm(x, g):
    xf = x.astype(jnp.float32)
    y = xf * lax.rsqrt(jnp.mean(xf * xf, axis=-1, keepdims=True) + EPS)
    return (y * g.astype(jnp.float32)).astype(x.dtype)


def partial_rope(x, pos):
    half = ROT_DIM // 2
    inv_freq = ROPE_THETA ** (-jnp.arange(half, dtype=jnp.float32) / half)
    ang = pos.astype(jnp.float32)[:, None] * inv_freq[None, :]
    cos = jnp.cos(ang)[None, :, None, :]
    sin = jnp.sin(ang)[None, :, None, :]
    xr = x[..., :ROT_DIM].astype(jnp.float32)
    x1, x2 = xr[..., :half], xr[..., half:]
    rot = jnp.concatenate([x1 * cos - x2 * sin, x2 * cos + x1 * sin], axis=-1)
    return jnp.concatenate([rot.astype(x.dtype), x[..., ROT_DIM:]], axis=-1)


def dsa_attention(q, k, v, q_i, k_i, w_i):
    B, S = q.shape[0], q.shape[1]
    n_blocks = S // CHUNK
    topk = min(TOPK_MAX, S // 4)
    key_pos = jnp.arange(S)

    def to_blocks(a):
        return jnp.moveaxis(a.reshape((B, n_blocks, CHUNK) + a.shape[2:]), 1, 0)

    def one_block(args):
        c, qb, qib, wib = args
        limit = (c + 1) * CHUNK
        admissible = key_pos < limit
        logits = jnp.einsum('bthd,bsd->bths', qib, k_i, preferred_element_type=jnp.float32) * (IDX_DIM ** -0.5)
        score = jnp.einsum('bth,bths->bts', wib.astype(jnp.float32), jax.nn.relu(logits))
        score = jnp.where(admissible[None, None, :], score, -jnp.inf)
        _, idx = lax.top_k(score, topk)
        valid = idx < limit
        k_sel = jax.vmap(lambda kb, ib: kb[ib])(k, idx)
        v_sel = jax.vmap(lambda vb, ib: vb[ib])(v, idx)
        s = jnp.einsum('bthd,btkhd->bthk', qb, k_sel, preferred_element_type=jnp.float32) * (HEAD_DIM ** -0.5)
        s = jnp.where(valid[:, :, None, :], s, -jnp.inf)
        p = jax.nn.softmax(s, axis=-1)
        return jnp.einsum('bthk,btkhd->bthd', p.astype(v.dtype), v_sel)

    out = lax.map(one_block, (jnp.arange(n_blocks), to_blocks(q), to_blocks(q_i), to_blocks(w_i)))
    return jnp.moveaxis(out, 0, 1).reshape(B, S, ATTN_WIDTH)


def multiscale_pool(p, pool_w, pool_scale):
    B, S, _ = p.shape
    pf = p.astype(jnp.float32).reshape(B, S, POOL_GROUPS, POOL_GROUP_DIM)
    csum = jnp.cumsum(pf, axis=1)
    t1 = jnp.arange(1, S + 1, dtype=jnp.float32)
    groups = []
    for g, w in enumerate(POOL_WINDOWS):
        c = csum[:, :, g]
        lower = jnp.concatenate([jnp.zeros((B, w, POOL_GROUP_DIM), jnp.float32), c[:, :S - w]], axis=1)
        count = jnp.minimum(t1, float(w))[None, :, None]
        groups.append((c - lower) / count - pf[:, :, g])
    pooled = jnp.stack(groups, axis=2).astype(p.dtype)
    mixed = jnp.einsum('bsgc,gcd->bsgd', pooled, pool_w)
    return mixed.reshape(B, S, POOL_WIDTH) * pool_scale


def peer_ffn(h, wq, subkeys, u, v):
    B, S, D = h.shape
    hb = h.reshape((B * S) // TOKEN_BLOCK, TOKEN_BLOCK, D)

    def one_block(xb):
        tb = xb.shape[0]
        q = (xb @ wq).reshape(tb, PEER_HEADS, 2, PEER_KEY_DIM)
        sub = jnp.einsum('thpd,hpnd->thpn', q, subkeys, preferred_element_type=jnp.float32)
        s_half, i_half = lax.top_k(sub, PEER_TOPK)
        cand = (s_half[:, :, 0, :, None] + s_half[:, :, 1, None, :]).reshape(tb, PEER_HEADS, PEER_TOPK * PEER_TOPK)
        cand_idx = (i_half[:, :, 0, :, None] * PEER_KEYS + i_half[:, :, 1, None, :]).reshape(tb, PEER_HEADS, PEER_TOPK * PEER_TOPK)
        top_s, pos = lax.top_k(cand, PEER_TOPK)
        expert = jnp.take_along_axis(cand_idx, pos, axis=-1)
        g = jax.nn.softmax(top_s, axis=-1)
        u_sel = u[expert]
        v_sel = v[expert]
        a = jax.nn.gelu(jnp.einsum('td,thkd->thk', xb, u_sel, preferred_element_type=jnp.float32), approximate=False)
        return jnp.einsum('thk,thkd->td', (g * a).astype(v.dtype), v_sel)

    return lax.map(one_block, hb).reshape(B, S, D)


def setup_inputs(seed: int = 0) -> dict:
    key = jax.random.key(seed)
    ks = jax.random.split(key, 16)
    f32 = jnp.float32
    L = DEPTH
    nrm = lambda k, shape, scale: jax.random.normal(k, shape, f32) * scale
    return {
        "x": jax.random.normal(ks[0], (BATCH, SEQ, D_MODEL), f32),
        "norm1_g": 1.0 + nrm(ks[1], (L, D_MODEL), 0.02),
        "w_in": nrm(ks[2], (L, D_MODEL, IN_WIDTH), D_MODEL ** -0.5),
        "q_norm_g": 1.0 + nrm(ks[3], (L, HEAD_DIM), 0.02),
        "k_norm_g": 1.0 + nrm(ks[4], (L, HEAD_DIM), 0.02),
        "pool_w": nrm(ks[5], (L, POOL_GROUPS, POOL_GROUP_DIM, POOL_GROUP_DIM), POOL_GROUP_DIM ** -0.5),
        "pool_scale": 1.0 + nrm(ks[6], (L, POOL_WIDTH), 0.02),
        "w_branch_attn": nrm(ks[7], (L, ATTN_WIDTH, D_MODEL), ATTN_WIDTH ** -0.5),
        "w_branch_pool": nrm(ks[8], (L, POOL_WIDTH, D_MODEL), POOL_WIDTH ** -0.5),
        "w_out": nrm(ks[9], (L, D_MODEL, D_MODEL), D_MODEL ** -0.5),
        "norm2_g": 1.0 + nrm(ks[10], (L, D_MODEL), 0.02),
        "peer_wq": nrm(ks[11], (L, D_MODEL, PEER_HEADS * 2 * PEER_KEY_DIM), D_MODEL ** -0.5),
        "peer_subkeys": nrm(ks[12], (L, PEER_HEADS, 2, PEER_KEYS, PEER_KEY_DIM), PEER_KEY_DIM ** -0.5),
        "peer_u": nrm(ks[13], (L, PEER_EXPERTS, D_MODEL), D_MODEL ** -0.5),
        "peer_v": nrm(ks[14], (L, PEER_EXPERTS, D_MODEL), PEER_HEADS ** -0.5),
    }


def reference(x, norm1_g, w_in, q_norm_g, k_norm_g, pool_w, pool_scale, w_branch_attn, w_branch_pool, w_out, norm2_g, peer_wq, peer_subkeys, peer_u, peer_v):
    B, S, _ = x.shape
    pos = jnp.arange(S)
    for l in range(DEPTH):
        xn = rms_norm(x, norm1_g[l])
        proj = xn @ w_in[l]
        q, k, v, qi, ki, wi, p, gl = jnp.split(proj, SPLIT_POINTS, axis=-1)
        q = partial_rope(rms_norm(q.reshape(B, S, N_HEADS, HEAD_DIM), q_norm_g[l]), pos)
        k = partial_rope(rms_norm(k.reshape(B, S, N_HEADS, HEAD_DIM), k_norm_g[l]), pos)
        v = v.reshape(B, S, N_HEADS, HEAD_DIM)
        qi = partial_rope(qi.reshape(B, S, IDX_HEADS, IDX_DIM), pos)
        ki = partial_rope(ki.reshape(B, S, 1, IDX_DIM), pos)[:, :, 0]
        wi = wi * (IDX_HEADS ** -0.5)
        y_attn = dsa_attention(q, k, v, qi, ki, wi) @ w_branch_attn[l]
        y_pool = multiscale_pool(p, pool_w[l], pool_scale[l]) @ w_branch_pool[l]
        g_attn, g_pool = jnp.split(jax.nn.sigmoid(gl), 2, axis=-1)
        x = x + (g_attn * y_attn + g_pool * y_pool) @ w_out[l]
        x = x + peer_ffn(rms_norm(x, norm2_g[l]), peer_wq[l], peer_subkeys[l], peer_u[l], peer_v[l])
    return x
```

```cpp
#include <hip/hip_runtime.h>
#include <cstdio>
#include <cstdint>
namespace pg8 {
#define PG8_LAS __attribute__((address_space(3)))
typedef unsigned short bf16_t;
typedef short bf16x8 __attribute__((ext_vector_type(8)));
typedef float f32x4 __attribute__((ext_vector_type(4)));
typedef unsigned u32x4 __attribute__((ext_vector_type(4)));
constexpr int BM = 256, BK = 64, HALF = 128, HTB = HALF * BK * 2  , STAGE_BYTES = 8 * HTB, NXCD = 8, WGM = 8;

__host__ __device__ __forceinline__ int lds_byte(int r, int c) { const int st = (r >> 4) * 2 + (c >> 5), rr = r & 15, cc = c & 31, ob = rr * 64 + cc * 2; return st * 1024 + (ob ^ (((ob >> 9) & 1) << 5)); }
__host__ __device__ __forceinline__ void stage_rc(int b, int& R, int& C) { const int st = b / 1024, sb = b % 1024, swz = sb ^ (((sb >> 9) & 1) << 5); R = (st >> 1) * 16 + swz / 64; C = (st & 1) * 32 + (swz % 64) / 2; }
__host__ __device__ __forceinline__ int perm32(int rho) { const int n = rho >> 4, i = rho & 15; return 8 * (i >> 2) + 4 * n + (i & 3); }

struct Unit { int pm, pn; };
struct Gemm { const bf16_t* A; const bf16_t* Bt; int M, N, K, lda, ldb; };

struct StaticOrder {
    int nM, nN, nwg, G, c;
    __host__ __device__ void init(int M, int N, int G_, int c_) { nM = M / BM; nN = N / BM; nwg = nM * nN; G = G_; c = c_; }
    __host__ __device__ bool next(int i, Unit& u) const {
        const long L = (long)i * G + c; if (L >= nwg) return false;
        int wgid = (int)L; { const int q = nwg / NXCD, r = nwg % NXCD, xcd = wgid % NXCD, off = wgid / NXCD; wgid = (xcd < r ? xcd * (q + 1) : r * (q + 1) + (xcd - r) * q) + off; }
        const int nig = WGM * nN, gid = wgid / nig, fm = gid * WGM, gsz = (nM - fm) < WGM ? (nM - fm) : WGM;
        u.pm = fm + ((wgid % nig) % gsz); u.pn = (wgid % nig) / gsz; return true;
    }
    __device__ __forceinline__ void a_ready(const Unit&) const {}
    __device__ __forceinline__ void done(const Unit&) const {}
};
typedef float f32x2c_t __attribute__((ext_vector_type(2))); typedef __bf16 bf16x2c_t __attribute__((ext_vector_type(2)));
__device__ __forceinline__ unsigned cvt_pk_bf16(float lo, float hi) { f32x2c_t v = {lo, hi}; bf16x2c_t b = __builtin_convertvector(v, bf16x2c_t); return __builtin_bit_cast(unsigned, b); }
typedef float f32x2 __attribute__((ext_vector_type(2)));
__device__ __forceinline__ f32x2 gelu_pk(f32x2 v) {
    const f32x2 av = __builtin_elementwise_abs(v), d = av * 0.2316418882f + 1.0f;
    f32x2 t; t.x = __builtin_amdgcn_rcpf(d.x); t.y = __builtin_amdgcn_rcpf(d.y);
    f32x2 q = t * 0.5307027145f + (-0.7265760135f); q = q * t + 0.7107068705f; q = q * t + (-0.142248368f); q = q * t + 0.127414796f; q = q * t;
    const f32x2 s = (v * v) * (-0.72134752044f);
    f32x2 e; e.x = __builtin_amdgcn_exp2f(s.x); e.y = __builtin_amdgcn_exp2f(s.y);
    const f32x2 m = v * (q * e), r = v - m;
    f32x2 o; o.x = v.x < 0.f ? m.x : r.x; o.y = v.y < 0.f ? m.y : r.y; return o;
}
__device__ __forceinline__ float bf_lo(unsigned w) { return __uint_as_float(w << 16); }
__device__ __forceinline__ float bf_hi(unsigned w) { return __uint_as_float(w & 0xffff0000u); }
__device__ __forceinline__ float sigmoidf_fast(float g) { return __builtin_amdgcn_rcpf(1.0f + __builtin_amdgcn_exp2f(-1.4426950408889634f * g)); }
__device__ __forceinline__ unsigned ord_key(float f) { const unsigned b = __float_as_uint(f); return b ^ ((unsigned)((int)b >> 31) | 0x80000000u); }
__device__ __forceinline__ float unord_key(unsigned k) { return __uint_as_float((k & 0x80000000u) ? (k ^ 0x80000000u) : ~k); }

struct EpiStoreBf16 {
    static constexpr bool PERM = true, AFTER_DRAIN = false;
    bf16_t* O; int ldc;
    __device__ __forceinline__ void operator()(const f32x4 (&acc)[2][2][4][2], const Unit& u, int wr, int wc, int fr, int fq) const {
        const int row0 = u.pm * BM + wr * 64 + fr, col0 = u.pn * BM + wc * 32 + 8 * fq;
#pragma unroll
        for (int ai = 0; ai < 2; ++ai)
#pragma unroll
            for (int m = 0; m < 4; ++m) { bf16_t* rowp = O + (size_t)(row0 + ai * HALF + m * 16) * ldc + col0;
#pragma unroll
                for (int bj = 0; bj < 2; ++bj) { const f32x4 v0 = acc[ai][bj][m][0], v1 = acc[ai][bj][m][1];
                    u32x4 w; w.x = cvt_pk_bf16(v0[0], v0[1]); w.y = cvt_pk_bf16(v0[2], v0[3]); w.z = cvt_pk_bf16(v1[0], v1[1]); w.w = cvt_pk_bf16(v1[2], v1[3]);
                    *(u32x4*)(rowp + bj * HALF) = w; } }
    }
};
template <bool ADD> struct EpiGate {
    static constexpr bool PERM = true, AFTER_DRAIN = false;
    bf16_t* O; int ldc; const bf16_t* G; int ldg;
    __device__ __forceinline__ void operator()(const f32x4 (&acc)[2][2][4][2], const Unit& u, int wr, int wc, int fr, int fq) const {
        const int row0 = u.pm * BM + wr * 64 + fr, col0 = u.pn * BM + wc * 32 + 8 * fq;
#pragma unroll
        for (int ai = 0; ai < 2; ++ai)
#pragma unroll
            for (int m = 0; m < 4; ++m) { const size_t row = (size_t)(row0 + ai * HALF + m * 16);
#pragma unroll
                for (int bj = 0; bj < 2; ++bj) { const int col = col0 + bj * HALF;
                    const u32x4 gr = *(const u32x4*)(G + row * ldg + col);
                    f32x4 v0 = acc[ai][bj][m][0], v1 = acc[ai][bj][m][1];
                    v0[0] *= sigmoidf_fast(bf_lo(gr.x)); v0[1] *= sigmoidf_fast(bf_hi(gr.x)); v0[2] *= sigmoidf_fast(bf_lo(gr.y)); v0[3] *= sigmoidf_fast(bf_hi(gr.y));
                    v1[0] *= sigmoidf_fast(bf_lo(gr.z)); v1[1] *= sigmoidf_fast(bf_hi(gr.z)); v1[2] *= sigmoidf_fast(bf_lo(gr.w)); v1[3] *= sigmoidf_fast(bf_hi(gr.w));
                    bf16_t* op = O + row * ldc + col;
                    if (ADD) { const u32x4 pr = *(const u32x4*)op;
                        v0[0] += bf_lo(pr.x); v0[1] += bf_hi(pr.x); v0[2] += bf_lo(pr.y); v0[3] += bf_hi(pr.y);
                        v1[0] += bf_lo(pr.z); v1[1] += bf_hi(pr.z); v1[2] += bf_lo(pr.w); v1[3] += bf_hi(pr.w); }
                    u32x4 w; w.x = cvt_pk_bf16(v0[0], v0[1]); w.y = cvt_pk_bf16(v0[2], v0[3]); w.z = cvt_pk_bf16(v1[0], v1[1]); w.w = cvt_pk_bf16(v1[2], v1[3]);
                    *(u32x4*)op = w; } }
    }
};
struct EpiResF32 {
    static constexpr bool PERM = false, AFTER_DRAIN = false;
    const float* base; float* out; int ldc;
    __device__ __forceinline__ void operator()(const f32x4 (&acc)[2][2][4][2], const Unit& u, int wr, int wc, int fr, int fq) const {
        const int col0 = u.pn * BM + wc * 32 + 4 * fq;
#pragma unroll
        for (int ai = 0; ai < 2; ++ai)
#pragma unroll
            for (int m = 0; m < 4; ++m) { const size_t off = (size_t)(u.pm * BM + ai * HALF + wr * 64 + m * 16 + fr) * ldc + col0;
#pragma unroll
                for (int bj = 0; bj < 2; ++bj)
#pragma unroll
                    for (int n = 0; n < 2; ++n) { const f32x4 bs = *(const f32x4*)(base + off + bj * HALF + n * 16); *(f32x4*)(out + off + bj * HALF + n * 16) = bs + acc[ai][bj][m][n]; } }
    }
};
struct EpiKeys {
    static constexpr bool PERM = false, AFTER_DRAIN = false;
    unsigned* O; int ldc;
    __device__ __forceinline__ void operator()(const f32x4 (&acc)[2][2][4][2], const Unit& u, int wr, int wc, int fr, int fq) const {
        const int col0 = u.pn * BM + wc * 32 + 4 * fq;
#pragma unroll
        for (int ai = 0; ai < 2; ++ai)
#pragma unroll
            for (int m = 0; m < 4; ++m) { const size_t off = (size_t)(u.pm * BM + ai * HALF + wr * 64 + m * 16 + fr) * ldc + col0;
#pragma unroll
                for (int bj = 0; bj < 2; ++bj)
#pragma unroll
                    for (int n = 0; n < 2; ++n) { const int nn = (col0 + bj * HALF + n * 16) & 127; const f32x4 a = acc[ai][bj][m][n]; u32x4 w;
                        w.x = (ord_key(a[0]) & ~127u) | (unsigned)(127 - nn); w.y = (ord_key(a[1]) & ~127u) | (unsigned)(126 - nn);
                        w.z = (ord_key(a[2]) & ~127u) | (unsigned)(125 - nn); w.w = (ord_key(a[3]) & ~127u) | (unsigned)(124 - nn);
                        *(u32x4*)(O + off + bj * HALF + n * 16) = w; } }
    }
};

template <class Epi, class Sched, bool ALIGN_EPI = false, bool SP2 = false>
__device__ __forceinline__ void gemm_phase(PG8_LAS unsigned char* lds, const Gemm g, const Sched& S, const Epi& E) {
    int tid_ = threadIdx.x; asm volatile("" : "+v"(tid_));
    const int tid = tid_, wid = __builtin_amdgcn_readfirstlane(tid >> 6), lane = tid & 63, wr = wid >> 2, wc = wid & 3, fr = lane & 15, fq = lane >> 4;
    const int K = g.K, nt = K / BK;
    unsigned voffA[2], voffB[2];
#pragma unroll
    for (int i = 0; i < 2; ++i) { int R, C; stage_rc(tid * 16 + i * 8192, R, C); const int Rb = Epi::PERM ? ((R & ~31) + perm32(R & 31)) : R;
        voffA[i] = (unsigned)(R * g.lda + C) * 2u; voffB[i] = (unsigned)(Rb * g.ldb + C) * 2u; }
    const size_t kstep = (size_t)(BK * 2);
    const size_t hstepA = (size_t)HALF * g.lda * 2, hstepB = (size_t)HALF * g.ldb * 2;
    const size_t tstepA = 2 * hstepA, tstepB = 2 * hstepB;
    const unsigned ldsw = (unsigned)wid * 1024u;
    const int aoff = lds_byte(wr * 64 + fr, fq * 8), boff = lds_byte(wc * 32 + fr, fq * 8);
#define PG8_SA(b, h) (((b) * 2 + (h)) * HTB)
#define PG8_SB(b, h) ((4 + (b) * 2 + (h)) * HTB)
#define PG8_STAGE(bufoff, gbase, voff) do { _Pragma("unroll") for (int _i = 0; _i < 2; ++_i) \
        __builtin_amdgcn_global_load_lds((const unsigned*)((const char*)(gbase) + (voff)[_i]), (PG8_LAS unsigned*)(lds + (bufoff) + ldsw + _i * 8192), 16, 0, 0); } while (0)
#define PG8_LDA(dst, b, h) do { _Pragma("unroll") for (int m = 0; m < 4; ++m) _Pragma("unroll") for (int k = 0; k < 2; ++k) dst[m][k] = *(const PG8_LAS bf16x8*)(lds + PG8_SA(b, h) + aoff + m * 2048 + k * 1024); } while (0)
#define PG8_LDB(dst, b, h) do { _Pragma("unroll") for (int n = 0; n < 2; ++n) _Pragma("unroll") for (int k = 0; k < 2; ++k) dst[n][k] = *(const PG8_LAS bf16x8*)(lds + PG8_SB(b, h) + boff + n * 2048 + k * 1024); } while (0)
#define PG8_MMA(ai, bj, At, Bt) do { __builtin_amdgcn_s_setprio(1); _Pragma("unroll") for (int m = 0; m < 4; ++m) _Pragma("unroll") for (int n = 0; n < 2; ++n) _Pragma("unroll") for (int k = 0; k < 2; ++k) \
        acc[ai][bj][m][n] = __builtin_amdgcn_mfma_f32_16x16x32_bf16(Bt[n][k], At[m][k], acc[ai][bj][m][n], 0, 0, 0); __builtin_amdgcn_s_setprio(0); } while (0)
#define PG8_WAIT_V(n) asm volatile("s_waitcnt vmcnt(" #n ")" ::: "memory")
#define PG8_WAIT_L(n) asm volatile("s_waitcnt lgkmcnt(" #n ")" ::: "memory")
#define PG8_BAR __builtin_amdgcn_s_barrier()
#define PG8_SCHED __builtin_amdgcn_sched_barrier(0)
    Unit cur, nxt; int ui = 0;
    if (!S.next(0, cur)) return;
    f32x4 acc[2][2][4][2];
#pragma unroll
    for (int a = 0; a < 2; ++a)
#pragma unroll
        for (int b = 0; b < 2; ++b)
#pragma unroll
            for (int m = 0; m < 4; ++m)
#pragma unroll
                for (int n = 0; n < 2; ++n) acc[a][b][m][n] = (f32x4){0.f, 0.f, 0.f, 0.f};
    bf16x8 At[4][2], B0[2][2], B1[2][2];
    const char* cA = (const char*)g.A + (size_t)cur.pm * tstepA; const char* cB = (const char*)g.Bt + (size_t)cur.pn * tstepB;
    S.a_ready(cur);
    if constexpr (SP2) {
        PG8_STAGE(PG8_SB(0, 0), cB, voffB); PG8_STAGE(PG8_SB(0, 1), cB + hstepB, voffB); PG8_STAGE(PG8_SA(0, 0), cA, voffA); PG8_STAGE(PG8_SA(0, 1), cA + hstepA, voffA);
        if (wr == 1) PG8_BAR;
        PG8_WAIT_V(2); PG8_BAR;
        PG8_STAGE(PG8_SB(1, 0), cB + kstep, voffB); PG8_STAGE(PG8_SA(1, 0), cA + kstep, voffA); PG8_STAGE(PG8_SB(1, 1), cB + hstepB + kstep, voffB);
        PG8_WAIT_V(6); PG8_BAR;
    } else {
        PG8_STAGE(PG8_SB(0, 0), cB, voffB); PG8_STAGE(PG8_SA(0, 0), cA, voffA); PG8_STAGE(PG8_SB(0, 1), cB + hstepB, voffB); PG8_STAGE(PG8_SA(0, 1), cA + hstepA, voffA);
        if (wr == 1) PG8_BAR;
        PG8_WAIT_V(4); PG8_BAR;
        PG8_STAGE(PG8_SB(1, 0), cB + kstep, voffB); PG8_STAGE(PG8_SA(1, 0), cA + kstep, voffA); PG8_STAGE(PG8_SB(1, 1), cB + hstepB + kstep, voffB);
        PG8_WAIT_V(6); PG8_BAR;
    }
    for (;;) {
        const bool has_next = S.next(ui + 1, nxt);
        const char* nA = has_next ? (const char*)g.A + (size_t)nxt.pm * tstepA : cA; const char* nB = has_next ? (const char*)g.Bt + (size_t)nxt.pn * tstepB : cB;
        for (int t = 0; t < nt; t += 2) {
            const bool last = (t == nt - 2);
            const char* a1 = cA + (size_t)(t + 1) * kstep;
            const char* a2 = last ? nA : cA + (size_t)(t + 2) * kstep; const char* b2 = last ? nB : cB + (size_t)(t + 2) * kstep;
            const char* a3 = a2 + kstep; const char* b3 = b2 + kstep;
            if (last && has_next) S.a_ready(nxt);
            if constexpr (SP2) {
            PG8_LDB(B0, 0, 0); PG8_LDB(B1, 0, 1); PG8_SCHED; PG8_LDA(At, 0, 0); PG8_STAGE(PG8_SA(1, 1), a1 + hstepA, voffA);
            PG8_WAIT_V(8); PG8_WAIT_L(0); PG8_BAR; PG8_MMA(0, 0, At, B0); PG8_MMA(0, 1, At, B1); PG8_BAR; PG8_SCHED;
            PG8_LDA(At, 0, 1); PG8_STAGE(PG8_SB(0, 0), b2, voffB); PG8_STAGE(PG8_SB(0, 1), b2 + hstepB, voffB); PG8_STAGE(PG8_SA(0, 0), a2, voffA);
            PG8_WAIT_V(8); PG8_WAIT_L(0); PG8_BAR; PG8_MMA(1, 0, At, B0); PG8_MMA(1, 1, At, B1); PG8_BAR; PG8_SCHED;
            PG8_LDB(B0, 1, 0); PG8_LDB(B1, 1, 1); PG8_SCHED; PG8_LDA(At, 1, 0); PG8_STAGE(PG8_SA(0, 1), a2 + hstepA, voffA);
            PG8_WAIT_V(8); PG8_WAIT_L(0); PG8_BAR; PG8_MMA(0, 0, At, B0); PG8_MMA(0, 1, At, B1); PG8_BAR; PG8_SCHED;
            PG8_LDA(At, 1, 1); PG8_STAGE(PG8_SB(1, 0), b3, voffB); PG8_STAGE(PG8_SB(1, 1), b3 + hstepB, voffB); PG8_STAGE(PG8_SA(1, 0), a3, voffA);
            PG8_WAIT_V(8); PG8_WAIT_L(0); PG8_BAR; PG8_MMA(1, 0, At, B0); PG8_MMA(1, 1, At, B1); PG8_BAR; PG8_SCHED;
            } else {
            PG8_LDB(B0, 0, 0); PG8_SCHED; PG8_LDA(At, 0, 0); PG8_STAGE(PG8_SA(1, 1), a1 + hstepA, voffA);
            PG8_WAIT_L(8); PG8_BAR; PG8_WAIT_L(0); PG8_MMA(0, 0, At, B0); PG8_BAR; PG8_SCHED;
            PG8_LDB(B1, 0, 1); PG8_STAGE(PG8_SB(0, 0), b2, voffB);
            PG8_BAR; PG8_WAIT_L(0); PG8_MMA(0, 1, At, B1); PG8_BAR;
            PG8_LDA(At, 0, 1); PG8_STAGE(PG8_SA(0, 0), a2, voffA);
            PG8_BAR; PG8_WAIT_L(0); PG8_MMA(1, 0, At, B0); PG8_BAR; PG8_SCHED;
            PG8_STAGE(PG8_SB(0, 1), b2 + hstepB, voffB);
            PG8_WAIT_V(6); PG8_BAR; PG8_MMA(1, 1, At, B1); PG8_BAR;
            PG8_LDB(B0, 1, 0); PG8_SCHED; PG8_LDA(At, 1, 0); PG8_STAGE(PG8_SA(0, 1), a2 + hstepA, voffA);
            PG8_WAIT_L(8); PG8_BAR; PG8_WAIT_L(0); PG8_MMA(0, 0, At, B0); PG8_BAR; PG8_SCHED;
            PG8_LDB(B1, 1, 1); PG8_STAGE(PG8_SB(1, 0), b3, voffB);
            PG8_BAR; PG8_WAIT_L(0); PG8_MMA(0, 1, At, B1); PG8_BAR;
            PG8_LDA(At, 1, 1); PG8_STAGE(PG8_SA(1, 0), a3, voffA);
            PG8_BAR; PG8_WAIT_L(0); PG8_MMA(1, 0, At, B0); PG8_BAR; PG8_SCHED;
            PG8_STAGE(PG8_SB(1, 1), b3 + hstepB, voffB);
            PG8_WAIT_V(6); PG8_BAR; PG8_MMA(1, 1, At, B1); PG8_BAR;
            }
        }
        if constexpr (ALIGN_EPI) { if (wr == 0) PG8_BAR; }
        if constexpr (!Epi::AFTER_DRAIN) { E(acc, cur, wr, wc, fr, fq); S.done(cur); }
        if (!has_next) break;
#pragma unroll
        for (int a = 0; a < 2; ++a)
#pragma unroll
            for (int b = 0; b < 2; ++b)
#pragma unroll
                for (int m = 0; m < 4; ++m)
#pragma unroll
                    for (int n = 0; n < 2; ++n) acc[a][b][m][n] = (f32x4){0.f, 0.f, 0.f, 0.f};
        cur = nxt; cA = nA; cB = nB; ++ui;
        if constexpr (ALIGN_EPI) { if (wr == 1) PG8_BAR; }
    }
    PG8_WAIT_V(0);
    if constexpr (!ALIGN_EPI) { if (wr == 0) PG8_BAR; }
    PG8_BAR;
    if constexpr (Epi::AFTER_DRAIN) { E.fused(acc, cur, wr, wc, fr, fq, lds, wid, lane); S.done(cur); }
#undef PG8_SA
#undef PG8_SB
#undef PG8_STAGE
#undef PG8_LDA
#undef PG8_LDB
#undef PG8_MMA
#undef PG8_WAIT_V
#undef PG8_WAIT_L
#undef PG8_BAR
#undef PG8_SCHED
}
}

constexpr int NWAVES = 8;
#ifndef MK_PER_PHASE
#define MK_PER_PHASE 0
#endif
constexpr int NPHASE = 12;

constexpr int BATCH = 16, SEQ = 4096, DM = 1024, MTOK = BATCH * SEQ;
constexpr int LDP = 4864;
constexpr int Q_OFF = 0, K_OFF = 512, V_OFF = 1024, QI_OFF = 1536, P_OFF = 2048, GA_OFF = 2560, GP_OFF = 3584, KI_OFF = 4608, WI_OFF = 4672;
constexpr int IN_WIDTH = 4680;
constexpr float EPS = 1e-6f;
constexpr float C2 = 0.125f * 1.4426950408889634f;
constexpr float WI_SCALE = 0.35355339059327373f * 0.125f;

constexpr size_t MiB = 1u << 20;
constexpr size_t WS_CTL = 0, CTL_ZERO_BYTES = 1 * MiB;
constexpr size_t WS_ROPE = 1 * MiB;
constexpr size_t WS_WIN = 2 * MiB;
constexpr size_t WS_WA = 12 * MiB;
constexpr size_t WS_WPP = 13 * MiB;
constexpr size_t WS_WO = 14 * MiB;
constexpr size_t WS_W2 = 16 * MiB;
constexpr size_t WS_U16 = 20 * MiB, WS_V16 = 52 * MiB;
constexpr size_t WS_MASK = 84 * MiB;
constexpr size_t WS_POOLED = 116 * MiB;
constexpr size_t WS_ACT = 180 * MiB;
constexpr size_t WS_PROJ = 308 * MiB;
constexpr size_t WS_REXP = 916 * MiB, WS_RG = 948 * MiB;
constexpr size_t WS_END = 980 * MiB;
constexpr int CW_TMO = 0, CW_BAR = 4096;

constexpr int RING_BYTES = 131072;
constexpr int LDSCTL_OFF = RING_BYTES, MISC_OFF = LDSCTL_OFF + 320;
constexpr int LDS_BYTES = 147456;

#define GAS __attribute__((address_space(1)))
#define LAS __attribute__((address_space(3)))
typedef unsigned short bf16;
typedef unsigned v4u __attribute__((ext_vector_type(4)));
typedef unsigned v2u __attribute__((ext_vector_type(2)));
typedef float f32x4 __attribute__((ext_vector_type(4)));
typedef float f32x16 __attribute__((ext_vector_type(16)));
typedef short bf16x8 __attribute__((ext_vector_type(8)));
typedef short s16x4 __attribute__((ext_vector_type(4)));
typedef GAS unsigned gu32;
#define RLX_AGENT __ATOMIC_RELAXED, __HIP_MEMORY_SCOPE_AGENT
#define LDS_WAIT() asm volatile("s_waitcnt lgkmcnt(0)" ::: "memory")
#define VM_WAIT() asm volatile("s_waitcnt vmcnt(0)" ::: "memory")
__device__ __forceinline__ unsigned f2bf(float f) { unsigned u = __builtin_bit_cast(unsigned, f); return (u + 0x7fffu + ((u >> 16) & 1u)) >> 16; }
__device__ __forceinline__ unsigned pk2(float lo, float hi) { return f2bf(lo) | (f2bf(hi) << 16); }
__device__ __forceinline__ float bflo(unsigned w) { return __uint_as_float(w << 16); }
__device__ __forceinline__ float bfhi(unsigned w) { return __uint_as_float(w & 0xffff0000u); }
__device__ __forceinline__ unsigned ordk(float f) { const unsigned b = __float_as_uint(f); return b ^ ((unsigned)((int)b >> 31) | 0x80000000u); }
__device__ __forceinline__ float unordk(unsigned k) { return __uint_as_float((k & 0x80000000u) ? (k ^ 0x80000000u) : ~k); }
__device__ __forceinline__ int crow(int r, int hi) { return (r & 3) + 8 * (r >> 2) + 4 * hi; }

#define XB_TMO      128
#define XB_XCNT(j)  (256  + 64 * (j))
#define XB_XSUB(j)  (1280 + 64 * (j))
#define XB_XGEN(j)  (2304 + 64 * (j))
#define XB_TOP      3328
#define XB_TOPGEN   3392
#define XCD_BAR_WORDS 3456
#define XB_SPIN_CAP (1u << 18)

__device__ __forceinline__ unsigned xb_ld(unsigned* p)              { return __hip_atomic_load(p, __ATOMIC_RELAXED, __HIP_MEMORY_SCOPE_AGENT); }
__device__ __forceinline__ unsigned xb_add(unsigned* p, unsigned v) { return __hip_atomic_fetch_add(p, v, __ATOMIC_RELAXED, __HIP_MEMORY_SCOPE_AGENT); }
__device__ __forceinline__ unsigned xb_xcc_id() { return (unsigned)__builtin_amdgcn_s_getreg((3 << 11) | 20) & 0xFu; }
#define XB_SPIN(cond, bar) do { unsigned _sp = 0; while (cond) { __builtin_amdgcn_s_sleep(1); \
    if ((++_sp & 255u) == 0u) { if (xb_ld(&(bar)[XB_TMO])) break; if (_sp > XB_SPIN_CAP) { atomicAdd(&(bar)[XB_TMO], 1u); break; } } } } while (0)

struct XcdBarrier {
    unsigned* bar; unsigned x;
    volatile LAS unsigned* st;
};

__device__ __forceinline__ XcdBarrier xcd_barrier_post(unsigned* bar, volatile LAS unsigned* st) {
    XcdBarrier b; b.bar = bar; b.x = xb_xcc_id(); b.st = st;
    if (threadIdx.x == 0) (void)xb_add(&bar[XB_XCNT(b.x)], 1u);
    return b;
}
__device__ __forceinline__ void xcd_barrier_complete(unsigned* bar, unsigned x, unsigned& nloc, unsigned& nx) {
    const unsigned G = gridDim.x * gridDim.y * gridDim.z;
    unsigned sum, cnt, mine, sp = 0u;
    for (;;) {
        sum = 0u; cnt = 0u; mine = 0u;
#pragma unroll
        for (unsigned j = 0; j < 16; ++j) { const unsigned c = xb_ld(&bar[XB_XCNT(j)]); sum += c; cnt += (c > 0u) ? 1u : 0u; mine = (j == x) ? c : mine; }
        if (sum == G) break;
        __builtin_amdgcn_s_sleep(1);
        if ((++sp & 255u) == 0u) { if (xb_ld(&bar[XB_TMO])) break; if (sp > XB_SPIN_CAP) { atomicAdd(&bar[XB_TMO], 1u); break; } }
    }
    nloc = mine > 0u ? mine : 1u; nx = cnt > 0u ? cnt : 1u;
}

__device__ __forceinline__ void xcd_barrier(const XcdBarrier& b) {
    asm volatile("s_waitcnt vmcnt(0)" ::: "memory");
    __syncthreads();
    if (threadIdx.x == 0) {
        unsigned* bar = b.bar;
        __builtin_amdgcn_s_waitcnt(0);
        unsigned nloc = b.st[0], nx = b.st[1];
        if (nloc == 0u) { xcd_barrier_complete(bar, b.x, nloc, nx); b.st[0] = nloc; b.st[1] = nx; }
        const unsigned old = xb_add(&bar[XB_XSUB(b.x)], 1u);
        const unsigned gen = old / nloc;
        if (old + 1u == (gen + 1u) * nloc) {
            __builtin_amdgcn_fence(__ATOMIC_RELEASE, "agent");
            asm volatile("s_waitcnt vmcnt(0)" ::: "memory");
            const unsigned og = xb_add(&bar[XB_TOP], 1u);
            const unsigned tg = og / nx;
            if (og + 1u == (tg + 1u) * nx) xb_add(&bar[XB_TOPGEN], 1u);
            else XB_SPIN(xb_ld(&bar[XB_TOPGEN]) == tg, bar);
            __builtin_amdgcn_fence(__ATOMIC_ACQUIRE, "agent");
            xb_add(&bar[XB_XGEN(b.x)], 1u);
            asm volatile("s_waitcnt vmcnt(0)" ::: "memory");
        } else {
            XB_SPIN(xb_ld(&bar[XB_XGEN(b.x)]) == gen, bar);
            __builtin_amdgcn_fence(__ATOMIC_ACQUIRE, "agent");
            asm volatile("s_waitcnt vmcnt(0)" ::: "memory");
        }
    }
    __syncthreads();
}


struct Frame {
    LAS unsigned char* lds;
    volatile LAS unsigned* MISC;
    gu32* ctl;
    unsigned char* ws;
    int tid, lane, wave, vcu, G;
};
struct Args { const float* in[15]; float* out; unsigned char* ws; int ph_lo, ph_hi; };

__device__ __forceinline__ float wave_sum(float v) {
#pragma unroll
    for (int o = 1; o < 64; o <<= 1) v += __shfl_xor(v, o);
    return v;
}

template <class ColMap>
__device__ __forceinline__ void p0_transpose_item(const float* W, int K, int N, bf16* WT, int nblk, LAS float* scr, int item, int lane, ColMap cm) {
    const int kb = item / nblk, nb = item % nblk, k0 = 64 * kb, n0 = 32 * nb;
    const int src = cm(n0 + (lane & 31));
#pragma unroll 8
    for (int i = 0; i < 32; ++i) { const int kk = 2 * i + (lane >> 5); scr[kk * 33 + (lane & 31)] = (src >= 0) ? W[(size_t)(k0 + kk) * N + src] : 0.f; }
    LDS_WAIT(); asm volatile("" ::: "memory");
    const int c = lane & 7;
#pragma unroll
    for (int j = 0; j < 4; ++j) { const int n = (lane >> 3) + 8 * j; const LAS float* s = scr + (8 * c) * 33 + n;
        v4u o; o.x = pk2(s[0 * 33], s[1 * 33]); o.y = pk2(s[2 * 33], s[3 * 33]); o.z = pk2(s[4 * 33], s[5 * 33]); o.w = pk2(s[6 * 33], s[7 * 33]);
        *(GAS v4u*)(WT + (size_t)(n0 + n) * K + k0 + 8 * c) = o; }
    LDS_WAIT(); asm volatile("" ::: "memory");
}
struct MapIdent { __device__ __forceinline__ int operator()(int n) const { return n; } };
struct MapWin { __device__ __forceinline__ int operator()(int n) const {
    if (n < 2048) return n;
    if (n < 2560) return 2120 + (n - 2048);
    if (n < 4608) return 2632 + (n - 2560);
    if (n < 4672) return 2048 + (n - 4608);
    if (n < 4680) return 2112 + (n - 4672);
    return -1; } };

__device__ __forceinline__ void rms_row_to_bf16(const float* xrow, const float* g, bf16* orow, int lane) {
    const GAS f32x4* xr = (const GAS f32x4*)xrow + lane; const GAS f32x4* gr = (const GAS f32x4*)g + lane;
    f32x4 v[4]; float s = 0.f;
#pragma unroll
    for (int j = 0; j < 4; ++j) { v[j] = xr[64 * j]; s += (v[j].x * v[j].x + v[j].y * v[j].y) + (v[j].z * v[j].z + v[j].w * v[j].w); }
    const float rs = 1.0f / sqrtf(wave_sum(s) * (1.f / 1024.f) + EPS);
    GAS unsigned long long* o8 = (GAS unsigned long long*)orow + lane;
#pragma unroll
    for (int j = 0; j < 4; ++j) { const f32x4 gg = gr[64 * j];
        o8[64 * j] = (unsigned long long)pk2(v[j].x * rs * gg.x, v[j].y * rs * gg.y) | ((unsigned long long)pk2(v[j].z * rs * gg.z, v[j].w * rs * gg.w) << 32); }
}

__device__ __forceinline__ void p0_prologue(Frame& F, const Args& AR) {
    LAS float* scr = (LAS float*)(F.lds + F.wave * 16384);
    const int gw = F.vcu * NWAVES + F.wave, NGW = F.G * NWAVES, lane = F.lane;
    constexpr int I_WIN = 16 * 152, I_WA = 8 * 32, I_WO = 16 * 32;
    for (int it = gw; it < I_WIN + I_WA + I_WO; it += NGW) {
        int r = it;
        if (r < I_WIN) { p0_transpose_item((AR.in[2]), 1024, IN_WIDTH, ((bf16*)(F.ws + WS_WIN)), 152, scr, r, lane, MapWin()); continue; } r -= I_WIN;
        if (r < I_WA) { p0_transpose_item((AR.in[7]), 512, 1024, ((bf16*)(F.ws + WS_WA)), 32, scr, r, lane, MapIdent()); continue; } r -= I_WA;
        p0_transpose_item((AR.in[9]), 1024, 1024, ((bf16*)(F.ws + WS_WO)), 32, scr, r, lane, MapIdent());
    }
    for (int it = gw; it < 16 * 64; it += NGW) {
        const int nb = it & 15, kb = it >> 4, n = nb * 64 + lane, k0 = kb * 8, g = k0 >> 7, c0 = k0 & 127;
        float acc[8];
#pragma unroll
        for (int j = 0; j < 8; ++j) acc[j] = 0.f;
        for (int d = 0; d < 128; ++d) {
            const float wv = (AR.in[8])[(size_t)(g * 128 + d) * 1024 + n] * (AR.in[6])[g * 128 + d];
#pragma unroll
            for (int j = 0; j < 8; ++j) acc[j] += (AR.in[5])[(size_t)(g * 128 + c0 + j) * 128 + d] * wv;
        }
        v4u o; o.x = pk2(acc[0], acc[1]); o.y = pk2(acc[2], acc[3]); o.z = pk2(acc[4], acc[5]); o.w = pk2(acc[6], acc[7]);
        *(GAS v4u*)(((bf16*)(F.ws + WS_WPP)) + (size_t)n * 512 + k0) = o;
    }
    for (int it = gw; it < 32 * 16; it += NGW) {
        const int nb = it & 31, kb = it >> 5, np = nb * 64 + lane, hp = nb >> 1, k0 = kb * 64;
#pragma unroll 4
        for (int d4 = 0; d4 < 16; ++d4) { const f32x4 t = *(const GAS f32x4*)((AR.in[12]) + (size_t)np * 64 + d4 * 4);
            scr[(4 * d4 + 0) * 64 + lane] = t.x; scr[(4 * d4 + 1) * 64 + lane] = t.y; scr[(4 * d4 + 2) * 64 + lane] = t.z; scr[(4 * d4 + 3) * 64 + lane] = t.w; }
        LDS_WAIT(); asm volatile("" ::: "memory");
#pragma unroll 1
        for (int k8 = 0; k8 < 8; ++k8) {
            float acc[8];
#pragma unroll
            for (int j = 0; j < 8; ++j) acc[j] = 0.f;
            const float* wr = (AR.in[11]) + (size_t)(k0 + k8 * 8) * 1024 + hp * 64;
#pragma unroll 4
            for (int d = 0; d < 64; ++d) { const float sv = scr[d * 64 + lane];
#pragma unroll
                for (int j = 0; j < 8; ++j) acc[j] += wr[(size_t)j * 1024 + d] * sv; }
            v4u o; o.x = pk2(acc[0], acc[1]); o.y = pk2(acc[2], acc[3]); o.z = pk2(acc[4], acc[5]); o.w = pk2(acc[6], acc[7]);
            *(GAS v4u*)(((bf16*)(F.ws + WS_W2)) + (size_t)np * 1024 + k0 + k8 * 8) = o;
        }
        LDS_WAIT(); asm volatile("" ::: "memory");
    }
    for (int it = gw; it < 2 * 32768; it += NGW) {
        const float* src = (it < 32768) ? (AR.in[13]) : (AR.in[14]); bf16* dst = (it < 32768) ? ((bf16*)(F.ws + WS_U16)) : ((bf16*)(F.ws + WS_V16)); const size_t e0 = (size_t)(it & 32767) * 512 + lane * 8;
        const f32x4 a = *(const GAS f32x4*)(src + e0), b = *(const GAS f32x4*)(src + e0 + 4);
        v4u o; o.x = pk2(a.x, a.y); o.y = pk2(a.z, a.w); o.z = pk2(b.x, b.y); o.w = pk2(b.z, b.w);
        *(GAS v4u*)(dst + e0) = o;
    }
    for (int it = gw * 64 + lane; it < 4096 * 8; it += NGW * 64) {
        const int pos = it >> 3, i = it & 7;
        const float invf = exp2f(-(float)i * 0.125f * 18.931568569324174f);
        const double ang = (double)((float)pos * invf);
        const double kq = __builtin_rint(ang * 0.6366197723675814);
        const float r = (float)(ang - kq * 1.5707963267948966);
        const int q = (int)((long long)kq & 3);
        const float r2 = r * r;
        const float sn = r + r * r2 * (-1.6666654611e-1f + r2 * (8.3321608736e-3f + r2 * (-1.9515295891e-4f)));
        const float cs = 1.0f - 0.5f * r2 + r2 * r2 * (4.166664568298827e-2f + r2 * (-1.388731625493765e-3f + r2 * 2.443315711809948e-5f));
        const float s = (q == 0) ? sn : (q == 1) ? cs : (q == 2) ? -sn : -cs;
        const float c = (q == 0) ? cs : (q == 1) ? -sn : (q == 2) ? -cs : sn;
        ((float*)(F.ws + WS_ROPE))[pos * 16 + i] = c; ((float*)(F.ws + WS_ROPE))[pos * 16 + 8 + i] = s;
    }
    for (int m = gw; m < MTOK; m += NGW) rms_row_to_bf16((AR.in[0]) + (size_t)m * DM, (AR.in[1]), ((bf16*)(F.ws + WS_ACT)) + (size_t)m * DM, lane);
}

__device__ __forceinline__ void unpack8(const v4u w, float (&v)[8]) { v[0] = bflo(w.x); v[1] = bfhi(w.x); v[2] = bflo(w.y); v[3] = bfhi(w.y); v[4] = bflo(w.z); v[5] = bfhi(w.z); v[6] = bflo(w.w); v[7] = bfhi(w.w); }
__device__ __forceinline__ v4u pack8(const float (&v)[8]) { v4u o; o.x = pk2(v[0], v[1]); o.y = pk2(v[2], v[3]); o.z = pk2(v[4], v[5]); o.w = pk2(v[6], v[7]); return o; }
__device__ __forceinline__ void rope8(float (&v)[8], int sub, const float (&cs)[8], const float (&sn)[8]) {
    float pv[8];
#pragma unroll
    for (int j = 0; j < 8; ++j) pv[j] = __shfl_xor(v[j], 1);
    if (sub == 0) {
#pragma unroll
        for (int j = 0; j < 8; ++j) v[j] = v[j] * cs[j] - pv[j] * sn[j];
    } else if (sub == 1) {
#pragma unroll
        for (int j = 0; j < 8; ++j) v[j] = v[j] * cs[j] + pv[j] * sn[j];
    }
}
__device__ __forceinline__ void fixup_token(Frame& F, const Args& AR, int tok) {
    const int lane = F.lane, sub = lane & 7, pos = tok & (SEQ - 1);
    bf16* row = ((bf16*)(F.ws + WS_PROJ)) + (size_t)tok * LDP;
    float cs[8], sn[8];
    { const GAS f32x4* rt = (const GAS f32x4*)(((float*)(F.ws + WS_ROPE)) + pos * 16); const f32x4 a = rt[0], b = rt[1], c = rt[2], d = rt[3];
      cs[0] = a.x; cs[1] = a.y; cs[2] = a.z; cs[3] = a.w; cs[4] = b.x; cs[5] = b.y; cs[6] = b.z; cs[7] = b.w;
      sn[0] = c.x; sn[1] = c.y; sn[2] = c.z; sn[3] = c.w; sn[4] = d.x; sn[5] = d.y; sn[6] = d.z; sn[7] = d.w; }
#pragma unroll
    for (int which = 0; which < 2; ++which) {
        GAS v4u* p = (GAS v4u*)(row + (which ? K_OFF : Q_OFF) + lane * 8);
        float v[8]; unpack8(*p, v);
        float ss = 0.f;
#pragma unroll
        for (int j = 0; j < 8; ++j) ss += v[j] * v[j];
        ss += __shfl_xor(ss, 1); ss += __shfl_xor(ss, 2); ss += __shfl_xor(ss, 4);
        const float rs = 1.0f / sqrtf(ss * (1.f / 64.f) + EPS);
        const float* g = (which ? (AR.in[4]) : (AR.in[3])) + sub * 8;
#pragma unroll
        for (int j = 0; j < 8; ++j) v[j] = v[j] * rs * g[j];
        rope8(v, sub, cs, sn);
        if (which == 0) {
#pragma unroll
            for (int j = 0; j < 8; ++j) v[j] *= C2;
        }
        *p = pack8(v);
    }
    { GAS v4u* p = (GAS v4u*)(row + QI_OFF + lane * 8); float v[8]; unpack8(*p, v); rope8(v, sub, cs, sn); *p = pack8(v); }
    { GAS v4u* p = (GAS v4u*)(row + KI_OFF + (lane & 7) * 8); float v[8]; unpack8(*p, v); rope8(v, sub, cs, sn); if (lane < 8) *p = pack8(v); }
    { const int g = lane >> 4, w = 2 << g;
      float acc[8], cur[8];
#pragma unroll
      for (int j = 0; j < 8; ++j) acc[j] = 0.f;
      unpack8(*(const GAS v4u*)(row + P_OFF + lane * 8), cur);
#pragma unroll
      for (int j = 0; j < 8; ++j) acc[j] = cur[j];
#pragma unroll
      for (int back = 1; back < 16; ++back) {
          if (back < w && back <= pos) { float t[8]; unpack8(*(const GAS v4u*)(row - (size_t)back * LDP + P_OFF + lane * 8), t);
#pragma unroll
              for (int j = 0; j < 8; ++j) acc[j] += t[j]; }
      }
      const float inv = 1.0f / (float)((pos + 1 < w) ? (pos + 1) : w);
      float o[8];
#pragma unroll
      for (int j = 0; j < 8; ++j) o[j] = acc[j] * inv - cur[j];
      *(GAS v4u*)(((bf16*)(F.ws + WS_POOLED)) + (size_t)tok * 512 + lane * 8) = pack8(o); }
}

#define wlane(dst, sval, j) asm volatile("s_nop 3\n\tv_writelane_b32 %0, %1, %2\n\ts_nop 1" : "+v"(dst) : "s"(sval), "i"(j))
__device__ __forceinline__ void select_row(const LAS float* srow, int nj, int lastw, GAS unsigned long long* mout, int lane) {
    unsigned key[64];
#pragma unroll
    for (int g = 0; g < 8; ++g) {
        if (nj > 8 * g) {
#pragma unroll
            for (int jj = 0; jj < 8; ++jj) key[8 * g + jj] = ordk(srow[64 * (8 * g + jj) + lane] + 0.0f);
        } else {
#pragma unroll
            for (int jj = 0; jj < 8; ++jj) key[8 * g + jj] = 0u;
        }
    }
    unsigned v = 0u;
#pragma unroll 1
    for (int bit = 31; bit >= 0; --bit) {
        const unsigned cand = v | (1u << bit);
        int cnt = 0;
#pragma unroll
        for (int g = 0; g < 8; ++g) {
            if (nj > 8 * g) {
#pragma unroll
                for (int jj = 0; jj < 8; ++jj) cnt += __popcll(__ballot(key[8 * g + jj] >= cand));
            }
        }
        if (cnt >= 256) v = cand;
    }
    int ngt = 0, neq = 0;
#pragma unroll
    for (int j = 0; j < 64; ++j) { ngt += __popcll(__ballot(key[j] > v)); neq += __popcll(__ballot(key[j] == v)); }
    unsigned mlo = 0u, mhi = 0u;
    if (ngt + neq == 256) {
#pragma unroll
        for (int j = 0; j < 64; ++j) { const unsigned long long m = __ballot(key[j] >= v);
            wlane(mlo, (unsigned)m, j); wlane(mhi, (unsigned)(m >> 32), j); }
    } else {
        int need = 256 - ngt;
#pragma unroll
        for (int j = 0; j < 64; ++j) {
            unsigned long long eq = __ballot(key[j] == v); const unsigned long long gt = __ballot(key[j] > v);
            unsigned long long keep = 0ull;
            while (need > 0 && eq != 0ull) { const unsigned long long lsb = eq & (0ull - eq); keep |= lsb; eq ^= lsb; --need; }
            const unsigned long long m = gt | keep;
            wlane(mlo, (unsigned)m, j); wlane(mhi, (unsigned)(m >> 32), j);
        }
    }
    if (lane <= lastw) mout[lane] = ((unsigned long long)mhi << 32) | (unsigned long long)mlo;
}

__device__ __forceinline__ void idx_unit(Frame& F, const Args& AR, int b, int c) {
    const int lane = F.lane, wid = F.wave, l31 = lane & 31, h2 = lane >> 5;
    LAS float* sc = (LAS float*)F.lds;
    const size_t rowb = (size_t)b * SEQ, tq0 = rowb + (size_t)c * 64;
    if (c < 4) {
        if (F.tid < 256) { const int q = F.tid >> 2, j = F.tid & 3; ((unsigned long long*)(F.ws + WS_MASK))[(tq0 + q) * 64 + j] = (j <= c) ? ~0ull : 0ull; }
        return;
    }
    const int ntile = 2 * (c + 1), nj = c + 1, lastw = c | 3, ntile_pad = 16 * ((nj + 7) >> 3);
    const int head = (l31 & 3) | (((l31 >> 3) & 1) << 2), qsub = ((l31 >> 2) & 1) | (((l31 >> 4) & 1) << 1);
    for (int pass = 0; pass < 8; ++pass) {
        const size_t tp0 = tq0 + pass * 8;
        bf16x8 a[2][4]; float w[2][16];
#pragma unroll
        for (int rb = 0; rb < 2; ++rb) {
            const bf16* ap = ((bf16*)(F.ws + WS_PROJ)) + (tp0 + 4 * rb + qsub) * LDP + QI_OFF + head * 64 + h2 * 8;
#pragma unroll
            for (int st = 0; st < 4; ++st) a[rb][st] = *(const GAS bf16x8*)(ap + st * 16);
            const v4u wa = *(const GAS v4u*)(((bf16*)(F.ws + WS_PROJ)) + (tp0 + 4 * rb + h2) * LDP + WI_OFF), wb = *(const GAS v4u*)(((bf16*)(F.ws + WS_PROJ)) + (tp0 + 4 * rb + h2 + 2) * LDP + WI_OFF);
            float t[8]; unpack8(wa, t);
#pragma unroll
            for (int j = 0; j < 8; ++j) w[rb][j] = t[j] * WI_SCALE;
            unpack8(wb, t);
#pragma unroll
            for (int j = 0; j < 8; ++j) w[rb][8 + j] = t[j] * WI_SCALE;
        }
        for (int kt = wid; kt < ntile_pad; kt += 8) {
            if (kt >= ntile) {
#pragma unroll
                for (int rb = 0; rb < 2; ++rb) { sc[(4 * rb + h2) * 4096 + kt * 32 + l31] = -INFINITY; sc[(4 * rb + h2 + 2) * 4096 + kt * 32 + l31] = -INFINITY; }
                continue;
            }
            const bf16* kp = ((bf16*)(F.ws + WS_PROJ)) + (rowb + kt * 32 + l31) * LDP + KI_OFF + h2 * 8;
            bf16x8 bfr[4];
#pragma unroll
            for (int st = 0; st < 4; ++st) bfr[st] = *(const GAS bf16x8*)(kp + st * 16);
#pragma unroll
            for (int rb = 0; rb < 2; ++rb) {
                f32x16 acc;
#pragma unroll
                for (int r = 0; r < 16; ++r) acc[r] = 0.f;
#pragma unroll
                for (int st = 0; st < 4; ++st) acc = __builtin_amdgcn_mfma_f32_32x32x16_bf16(a[rb][st], bfr[st], acc, 0, 0, 0);
                float s0 = 0.f, s1 = 0.f;
#pragma unroll
                for (int r = 0; r < 8; ++r) { s0 = fmaf(w[rb][r], fmaxf(acc[r], 0.f), s0); s1 = fmaf(w[rb][8 + r], fmaxf(acc[8 + r], 0.f), s1); }
                sc[(4 * rb + h2) * 4096 + kt * 32 + l31] = s0;
                sc[(4 * rb + h2 + 2) * 4096 + kt * 32 + l31] = s1;
            }
        }
        __syncthreads();
        select_row(sc + wid * 4096, nj, lastw, (GAS unsigned long long*)(((unsigned long long*)(F.ws + WS_MASK)) + (tp0 + wid) * 64), lane);
        __syncthreads();
    }
}

__device__ __forceinline__ void attn_unit(Frame& F, const Args& AR, int b, int h, int qb) {
    const int lane = F.lane, wid = F.wave, l31 = lane & 31, h2 = lane >> 5;
    LAS unsigned char* Ks = F.lds;
    LAS unsigned char* Vs = F.lds + 9216;
    LAS float* wsf = (LAS float*)(F.lds + 17408) + wid * 32;
    const size_t rowb = (size_t)b * SEQ, tok0 = rowb + (size_t)qb * 256 + wid * 32;
    bf16x8 qf[4];
    { const bf16* qp = ((bf16*)(F.ws + WS_PROJ)) + (tok0 + l31) * LDP + Q_OFF + h * 64 + h2 * 8;
#pragma unroll
      for (int st = 0; st < 4; ++st) qf[st] = *(const GAS bf16x8*)(qp + st * 16); }
    const int NT = 4 * (qb + 1), cw = qb * 4 + (wid >> 1);
    f32x16 o0, o1;
#pragma unroll
    for (int r = 0; r < 16; ++r) { o0[r] = 0.f; o1[r] = 0.f; }
    float lsum = 0.f;
    const int skey = F.tid >> 3, sch = F.tid & 7;
    const bf16* kg = ((bf16*)(F.ws + WS_PROJ)) + (rowb + skey) * LDP + K_OFF + h * 64 + sch * 8;
    const bf16* vg = ((bf16*)(F.ws + WS_PROJ)) + (rowb + skey) * LDP + V_OFF + h * 64 + sch * 8;
    v4u kreg = *(const GAS v4u*)kg, vreg = *(const GAS v4u*)vg;
    const unsigned kst = skey * 144 + sch * 16, vst = skey * 128 + ((sch * 16) ^ (((skey >> 1) & 1) << 6));
    const GAS unsigned long long* mrow = (const GAS unsigned long long*)(((unsigned long long*)(F.ws + WS_MASK)) + (tok0 + l31) * 64);
    const int i16 = lane & 15, qq = i16 >> 2, pp = i16 & 3, blk = (lane >> 4) & 1;
    const unsigned vrd = (unsigned)((4 * h2 + qq) * 128 + ((32 * blk + 8 * pp) ^ (((qq >> 1) & 1) << 6)));
    for (int t = 0; t < NT; ++t) {
        __syncthreads();
        *(LAS v4u*)(Ks + kst) = kreg; *(LAS v4u*)(Vs + vst) = vreg;
        __syncthreads();
        if (t + 1 < NT) { kreg = *(const GAS v4u*)(kg + (size_t)(t + 1) * 64 * LDP); vreg = *(const GAS v4u*)(vg + (size_t)(t + 1) * 64 * LDP); }
        if (t <= cw) {
            const unsigned long long mw = mrow[t];
            f32x16 p[2];
#pragma unroll
            for (int kb = 0; kb < 2; ++kb) {
                f32x16 acc;
#pragma unroll
                for (int r = 0; r < 16; ++r) acc[r] = 0.f;
#pragma unroll
                for (int st = 0; st < 4; ++st) { const bf16x8 ka = *(const LAS bf16x8*)(Ks + (32 * kb + l31) * 144 + st * 32 + h2 * 16); acc = __builtin_amdgcn_mfma_f32_32x32x16_bf16(ka, qf[st], acc, 0, 0, 0); }
                const unsigned wk = (kb ? (unsigned)(mw >> 32) : (unsigned)mw) >> (4 * h2);
#pragma unroll
                for (int r = 0; r < 16; ++r) {
                    const float e = __builtin_amdgcn_exp2f(acc[r]);
                    const int m = __builtin_amdgcn_sbfe((int)wk, (r & 3) + 8 * (r >> 2), 1);
                    const float pe = __uint_as_float(__float_as_uint(e) & (unsigned)m);
                    acc[r] = pe; lsum += pe;
                }
                p[kb] = acc;
            }
#pragma unroll
            for (int kb = 0; kb < 2; ++kb)
#pragma unroll
                for (int s = 0; s < 2; ++s) {
                    v4u pw; pw.x = pk2(p[kb][8 * s + 0], p[kb][8 * s + 1]); pw.y = pk2(p[kb][8 * s + 2], p[kb][8 * s + 3]); pw.z = pk2(p[kb][8 * s + 4], p[kb][8 * s + 5]); pw.w = pk2(p[kb][8 * s + 6], p[kb][8 * s + 7]);
                    const bf16x8 pa = __builtin_bit_cast(bf16x8, pw);
                    const unsigned rbase = vrd + (unsigned)((32 * kb + 16 * s) * 128);
#pragma unroll
                    for (int d0 = 0; d0 < 2; ++d0) {
                        const unsigned ad = rbase ^ (unsigned)(d0 << 6);
                        const s16x4 lo = __builtin_bit_cast(s16x4, __builtin_amdgcn_ds_read_tr16_b64_v4i16((LAS s16x4*)(Vs + ad)));
                        const s16x4 hi = __builtin_bit_cast(s16x4, __builtin_amdgcn_ds_read_tr16_b64_v4i16((LAS s16x4*)(Vs + ad + 8 * 128)));
                        const bf16x8 vb = (bf16x8){lo[0], lo[1], lo[2], lo[3], hi[0], hi[1], hi[2], hi[3]};
                        if (d0 == 0) o0 = __builtin_amdgcn_mfma_f32_32x32x16_bf16(pa, vb, o0, 0, 0, 0); else o1 = __builtin_amdgcn_mfma_f32_32x32x16_bf16(pa, vb, o1, 0, 0, 0);
                    }
                }
        }
    }
    lsum += __shfl_xor(lsum, 32);
    if (h2 == 0) wsf[l31] = lsum;
    LDS_WAIT(); asm volatile("" ::: "memory");
    bf16* op = ((bf16*)(F.ws + WS_PROJ)) + tok0 * LDP + Q_OFF + h * 64 + l31;
#pragma unroll
    for (int r = 0; r < 16; ++r) { const int q = crow(r, h2); const float rl = 1.0f / wsf[q];
        op[(size_t)q * LDP] = (bf16)f2bf(o0[r] * rl); op[(size_t)q * LDP + 32] = (bf16)f2bf(o1[r] * rl); }
    LDS_WAIT(); asm volatile("" ::: "memory");
}

__device__ __forceinline__ void route_wave(Frame& F, const Args& AR, size_t tokbase) {
    const int lane = F.lane; const size_t tok = tokbase + (lane >> 4); const int hp = lane & 15, half = hp & 1;
    const GAS v4u* rp = (const GAS v4u*)(((unsigned*)(F.ws + WS_PROJ)) + tok * 2048 + hp * 128);
    unsigned list[16];
#pragma unroll
    for (int i = 0; i < 16; ++i) list[i] = 0u;
#pragma unroll 4
    for (int c4 = 0; c4 < 32; ++c4) {
        const v4u kv = rp[c4];
#pragma unroll
        for (int e = 0; e < 4; ++e) { unsigned x = kv[e];
#pragma unroll
            for (int i = 0; i < 16; ++i) { const unsigned hi = list[i] > x ? list[i] : x; x = list[i] > x ? x : list[i]; list[i] = hi; } }
    }
    LAS unsigned* lk = (LAS unsigned*)F.lds;
#pragma unroll
    for (int i = 0; i < 16; ++i) lk[i * 512 + F.tid] = list[i];
    LDS_WAIT(); asm volatile("" ::: "memory");
    const int ta = F.tid & ~1, tb = F.tid | 1;
    unsigned ck[16], ce[16];
#pragma unroll
    for (int i = 0; i < 16; ++i) { ck[i] = 0u; ce[i] = 0u; }
#pragma unroll 1
    for (int i = 0; i < 16; ++i) {
        const unsigned ka = lk[i * 512 + ta];
        const float sai = unordk(ka & ~127u); const unsigned nai = (127u - (ka & 127u)) * 128u;
        const int njj = 16 / (i + 1);
#pragma unroll 1
        for (int j = 0; j < njj; ++j) {
            const unsigned kb = lk[j * 512 + tb];
            unsigned x = (ordk(sai + unordk(kb & ~127u)) & ~255u) | (unsigned)(255 - (i * 16 + j)); unsigned y = nai + (127u - (kb & 127u));
#pragma unroll
            for (int t = 0; t < 16; ++t) { const bool gt = x > ck[t]; const unsigned nk = gt ? x : ck[t], ne = gt ? y : ce[t]; x = gt ? ck[t] : x; y = gt ? ce[t] : y; ck[t] = nk; ce[t] = ne; }
        }
    }
    LDS_WAIT(); asm volatile("" ::: "memory");
    float ts[16]; float sum = 0.f; const float mx = unordk(ck[0] & ~255u);
#pragma unroll
    for (int t = 0; t < 16; ++t) { ts[t] = __builtin_amdgcn_exp2f((unordk(ck[t] & ~255u) - mx) * 1.4426950408889634f); sum += ts[t]; }
    const float inv = 1.0f / sum;
    if (half == 0) {
        GAS v4u* eo = (GAS v4u*)(((unsigned*)(F.ws + WS_REXP)) + tok * 128 + (hp >> 1) * 16); GAS f32x4* go = (GAS f32x4*)(((float*)(F.ws + WS_RG)) + tok * 128 + (hp >> 1) * 16);
#pragma unroll
        for (int t4 = 0; t4 < 4; ++t4) { eo[t4] = (v4u){ce[4 * t4], ce[4 * t4 + 1], ce[4 * t4 + 2], ce[4 * t4 + 3]};
            go[t4] = (f32x4){ts[4 * t4] * inv, ts[4 * t4 + 1] * inv, ts[4 * t4 + 2] * inv, ts[4 * t4 + 3] * inv}; }
    }
}

__device__ __forceinline__ float gelu_erf(float v) {
    const float av = fabsf(v), t = __builtin_amdgcn_rcpf(av * 0.2316418882f + 1.0f);
    float q = t * 0.5307027145f + (-0.7265760135f); q = q * t + 0.7107068705f; q = q * t + (-0.142248368f); q = q * t + 0.127414796f; q = q * t;
    const float e = __builtin_amdgcn_exp2f((v * v) * (-0.72134752044f));
    const float m = v * (q * e);
    return v < 0.f ? m : v - m;
}
__device__ __forceinline__ float dot8(const v4u a, const v4u b, float acc) {
    acc = fmaf(bflo(a.x), bflo(b.x), acc); acc = fmaf(bfhi(a.x), bfhi(b.x), acc); acc = fmaf(bflo(a.y), bflo(b.y), acc); acc = fmaf(bfhi(a.y), bfhi(b.y), acc);
    acc = fmaf(bflo(a.z), bflo(b.z), acc); acc = fmaf(bfhi(a.z), bfhi(b.z), acc); acc = fmaf(bflo(a.w), bflo(b.w), acc); acc = fmaf(bfhi(a.w), bfhi(b.w), acc);
    return acc;
}
__device__ __forceinline__ void peer_token(Frame& F, const Args& AR, size_t tok) {
    const int lane = F.lane;
    const GAS v4u* hp = (const GAS v4u*)(((bf16*)(F.ws + WS_ACT)) + tok * 1024) + lane * 2;
    const v4u hx0 = hp[0], hx1 = hp[1];
    const unsigned e0 = ((unsigned*)(F.ws + WS_REXP))[tok * 128 + lane], e1 = ((unsigned*)(F.ws + WS_REXP))[tok * 128 + 64 + lane];
    const float g0 = ((float*)(F.ws + WS_RG))[tok * 128 + lane], g1 = ((float*)(F.ws + WS_RG))[tok * 128 + 64 + lane];
    float out[16];
#pragma unroll
    for (int k = 0; k < 16; ++k) out[k] = 0.f;
    for (int grp = 0; grp < 16; ++grp) {
        const unsigned esel = (grp < 8) ? e0 : e1; const float gsel = (grp < 8) ? g0 : g1;
        unsigned eid[8]; float cf[8];
        v4u ra[8], rb[8];
#pragma unroll
        for (int i = 0; i < 8; ++i) { eid[i] = (unsigned)__builtin_amdgcn_readlane((int)esel, (grp * 8 + i) & 63);
            const GAS v4u* up = (const GAS v4u*)(((bf16*)(F.ws + WS_U16)) + (size_t)eid[i] * 1024) + lane * 2; ra[i] = up[0]; rb[i] = up[1]; }
#pragma unroll
        for (int i = 0; i < 8; ++i) { float d = dot8(ra[i], hx0, 0.f); d = dot8(rb[i], hx1, d); d = wave_sum(d);
            const float gi = __uint_as_float((unsigned)__builtin_amdgcn_readlane((int)__float_as_uint(gsel), (grp * 8 + i) & 63)); cf[i] = gi * gelu_erf(d); }
#pragma unroll
        for (int i = 0; i < 8; ++i) { const GAS v4u* vp = (const GAS v4u*)(((bf16*)(F.ws + WS_V16)) + (size_t)eid[i] * 1024) + lane * 2; ra[i] = vp[0]; rb[i] = vp[1]; }
#pragma unroll
        for (int i = 0; i < 8; ++i) { const float c = cf[i];
            out[0] = fmaf(c, bflo(ra[i].x), out[0]); out[1] = fmaf(c, bfhi(ra[i].x), out[1]); out[2] = fmaf(c, bflo(ra[i].y), out[2]); out[3] = fmaf(c, bfhi(ra[i].y), out[3]);
            out[4] = fmaf(c, bflo(ra[i].z), out[4]); out[5] = fmaf(c, bfhi(ra[i].z), out[5]); out[6] = fmaf(c, bflo(ra[i].w), out[6]); out[7] = fmaf(c, bfhi(ra[i].w), out[7]);
            out[8] = fmaf(c, bflo(rb[i].x), out[8]); out[9] = fmaf(c, bfhi(rb[i].x), out[9]); out[10] = fmaf(c, bflo(rb[i].y), out[10]); out[11] = fmaf(c, bfhi(rb[i].y), out[11]);
            out[12] = fmaf(c, bflo(rb[i].z), out[12]); out[13] = fmaf(c, bfhi(rb[i].z), out[13]); out[14] = fmaf(c, bflo(rb[i].w), out[14]); out[15] = fmaf(c, bfhi(rb[i].w), out[15]); }
    }
    GAS f32x4* op = (GAS f32x4*)((AR.out) + tok * 1024) + lane * 4;
#pragma unroll
    for (int k4 = 0; k4 < 4; ++k4) { f32x4 hv = op[k4]; hv.x += out[4 * k4]; hv.y += out[4 * k4 + 1]; hv.z += out[4 * k4 + 2]; hv.w += out[4 * k4 + 3]; op[k4] = hv; }
}

__global__ void __launch_bounds__(NWAVES * 64, 2) mk_fwd(Args args) {
    extern __shared__ __attribute__((aligned(16))) unsigned char lds[];
    Frame F;
    F.lds = (LAS unsigned char*)lds;
    F.MISC = (volatile LAS unsigned*)(F.lds + MISC_OFF);
    F.tid = threadIdx.x; F.lane = F.tid & 63; F.wave = __builtin_amdgcn_readfirstlane(F.tid >> 6);
    F.G = gridDim.x; { const int bx = blockIdx.x; F.vcu = (F.G % 8 == 0) ? (bx % 8) * (F.G / 8) + bx / 8 : bx; }
    F.ws = args.ws;
    F.ctl = (gu32*)(F.ws + WS_CTL);
    const Args& AR = args;
    for (int u = F.tid; u < (LDS_BYTES - LDSCTL_OFF) / 4; u += NWAVES * 64) ((LAS unsigned*)(F.lds + LDSCTL_OFF))[u] = 0u;
    __syncthreads();
    XcdBarrier bar; bar.bar = (unsigned*)(F.ctl + CW_BAR); bar.x = 0; bar.st = nullptr;
#if !MK_PER_PHASE
    bar = xcd_barrier_post((unsigned*)(F.ctl + CW_BAR), F.MISC + 8);
#endif
    const int lo = args.ph_lo, hi = args.ph_hi;
#ifdef EXP_E4
#define IN(k) ((k) != 3 && (k) != 4 && (k) != 5 && lo <= (k) && (k) < hi)
#elif defined(EXP_E3)
#define IN(k) (((k) == 0 || (k) >= 7) && lo <= (k) && (k) < hi)
#elif defined(ONLY_PHASE)
#define IN(k) ((k) == ONLY_PHASE && lo <= (k) && (k) < hi)
#elif defined(PHASE_MASK)
#define IN(k) (((PHASE_MASK >> (k)) & 1) && lo <= (k) && (k) < hi)
#else
#define IN(k) (lo <= (k) && (k) < hi)
#endif
#if MK_PER_PHASE
#define SEAM(k) do { } while (0)
#else
#define SEAM(k) do { if (IN(k) && IN((k) + 1)) xcd_barrier(bar); } while (0)
#endif
#define FRESH() Frame P = F; { int t_ = threadIdx.x; asm volatile("" : "+v"(t_)); P.tid = t_; P.lane = t_ & 63; P.wave = __builtin_amdgcn_readfirstlane(t_ >> 6); } const int gw = P.vcu * NWAVES + P.wave, NGW = P.G * NWAVES; (void)gw; (void)NGW

    if (IN(0)) { FRESH(); p0_prologue(P, args); } SEAM(0);
    if (IN(1)) { pg8::Gemm g{((bf16*)(F.ws + WS_ACT)), ((bf16*)(F.ws + WS_WIN)), MTOK, LDP, 1024, 1024, 1024}; pg8::StaticOrder S; S.init(MTOK, LDP, F.G, (int)blockIdx.x);
        pg8::EpiStoreBf16 E{((bf16*)(F.ws + WS_PROJ)), LDP};
        pg8::gemm_phase<pg8::EpiStoreBf16, pg8::StaticOrder, true, true>(F.lds, g, S, E); } SEAM(1);
    if (IN(2)) { FRESH(); for (int m = gw; m < MTOK; m += NGW) fixup_token(P, args, m); } SEAM(2);
    if (IN(3)) { FRESH(); for (int i = P.vcu; i < 256; i += P.G) { const int b = i >> 4, s = i & 15;
#pragma unroll 1
            for (int k = 0; k < 4; ++k) idx_unit(P, args, b, (k == 0) ? s : (k == 1) ? 31 - s : (k == 2) ? 32 + s : 63 - s); } } SEAM(3);
    if (IN(4)) { FRESH(); for (int i = P.vcu; i < 256; i += P.G) { const int bh = i >> 1, s = i & 1, b = bh >> 3, h = bh & 7;
#pragma unroll 1
            for (int k = 0; k < 8; ++k) attn_unit(P, args, b, h, (k & 1) ? 15 - (k >> 1) * 2 - s : (k >> 1) * 2 + s); } } SEAM(4);
    if (IN(5)) { pg8::Gemm g{((bf16*)(F.ws + WS_PROJ)) + Q_OFF, ((bf16*)(F.ws + WS_WA)), MTOK, 1024, 512, LDP, 512}; pg8::StaticOrder S; S.init(MTOK, 1024, F.G, (int)blockIdx.x);
        pg8::EpiGate<false> E{((bf16*)(F.ws + WS_ACT)), 1024, ((bf16*)(F.ws + WS_PROJ)) + GA_OFF, LDP};
        pg8::gemm_phase<pg8::EpiGate<false>, pg8::StaticOrder, true, true>(F.lds, g, S, E); } SEAM(5);
    if (IN(6)) { pg8::Gemm g{((bf16*)(F.ws + WS_POOLED)), ((bf16*)(F.ws + WS_WPP)), MTOK, 1024, 512, 512, 512}; pg8::StaticOrder S; S.init(MTOK, 1024, F.G, (int)blockIdx.x);
        #ifdef EXP_E4
#define ADDB false
#else
#define ADDB true
#endif
        pg8::EpiGate<ADDB> E{((bf16*)(F.ws + WS_ACT)), 1024, ((bf16*)(F.ws + WS_PROJ)) + GP_OFF, LDP};
        pg8::gemm_phase<pg8::EpiGate<ADDB>, pg8::StaticOrder, true, true>(F.lds, g, S, E); } SEAM(6);
#ifdef EXP_E3
    if (IN(7)) { FRESH(); for (size_t i = (size_t)gw * 64 + P.lane; i < (size_t)MTOK * DM / 4; i += (size_t)NGW * 64) ((f32x4*)args.out)[i] = ((const f32x4*)args.in[0])[i]; }
    if (0) { pg8::Gemm g{((bf16*)(F.ws + WS_ACT)), ((bf16*)(F.ws + WS_WO)), MTOK, 1024, 1024, 1024, 1024}; pg8::StaticOrder S; S.init(MTOK, 1024, F.G, (int)blockIdx.x);
        pg8::EpiResF32 E{(AR.in[0]), (AR.out), 1024};
        pg8::gemm_phase<pg8::EpiResF32, pg8::StaticOrder, true, true>(F.lds, g, S, E); } SEAM(7);
#else
    if (IN(7)) { pg8::Gemm g{((bf16*)(F.ws + WS_ACT)), ((bf16*)(F.ws + WS_WO)), MTOK, 1024, 1024, 1024, 1024}; pg8::StaticOrder S; S.init(MTOK, 1024, F.G, (int)blockIdx.x);
        pg8::EpiResF32 E{(AR.in[0]), (AR.out), 1024};
        pg8::gemm_phase<pg8::EpiResF32, pg8::StaticOrder, true, true>(F.lds, g, S, E); } SEAM(7);
#endif

    if (IN(8)) { FRESH(); for (int m = gw; m < MTOK; m += NGW) rms_row_to_bf16((args.out) + (size_t)m * DM, (args.in[10]), ((bf16*)(P.ws + WS_ACT)) + (size_t)m * DM, P.lane); } SEAM(8);
    if (IN(9)) { pg8::Gemm g{((bf16*)(F.ws + WS_ACT)), ((bf16*)(F.ws + WS_W2)), MTOK, 2048, 1024, 1024, 1024}; pg8::StaticOrder S; S.init(MTOK, 2048, F.G, (int)blockIdx.x);
        pg8::EpiKeys E{((unsigned*)(F.ws + WS_PROJ)), 2048};
        pg8::gemm_phase<pg8::EpiKeys, pg8::StaticOrder, true, true>(F.lds, g, S, E); } SEAM(9);
    if (IN(10)) { FRESH(); for (int m4 = gw; m4 < MTOK / 4; m4 += NGW) route_wave(P, args, (size_t)m4 * 4); } SEAM(10);
    #ifdef EXP_E2
    if (IN(11)) { FRESH(); for (int m = gw; m < MTOK; m += NGW) { const size_t tok = (size_t)m; const int lane = P.lane;
            const unsigned e0 = ((unsigned*)(P.ws + WS_REXP))[tok * 128 + lane], e1 = ((unsigned*)(P.ws + WS_REXP))[tok * 128 + 64 + lane];
            const float g0 = ((float*)(P.ws + WS_RG))[tok * 128 + lane], g1 = ((float*)(P.ws + WS_RG))[tok * 128 + 64 + lane];
            args.out[tok * 1024 + lane] += g0 * (float)(e0 & 1023u) * 1e-2f; args.out[tok * 1024 + 64 + lane] += g1 * (float)(e1 & 1023u) * 1e-2f; } }
#else
    if (IN(11)) { FRESH(); for (int m = gw; m < MTOK; m += NGW) peer_token(P, args, (size_t)m); }
#endif
#undef IN
#undef SEAM
}

extern "C" void kernel_launch(void* const* d_in, const int* in_sizes, int n_in, void* d_out, int out_size, void* d_ws, size_t ws_size, hipStream_t stream) {
    static int grid = 0;
    if (grid == 0) {
        if (n_in != 15 || in_sizes[0] != MTOK * DM || out_size != MTOK * DM || ws_size < WS_END) { fprintf(stderr, "kernel_launch: unexpected shapes (n_in %d, in0 %d, out %d, ws %zu < %zu)\n", n_in, n_in > 0 ? in_sizes[0] : -1, out_size, ws_size, (size_t)WS_END); grid = -1; return; }
        int dev = 0, cus = 0, per_cu = 0;
        if (hipGetDevice(&dev) != hipSuccess || hipDeviceGetAttribute(&cus, hipDeviceAttributeMultiprocessorCount, dev) != hipSuccess) { grid = -1; return; }
        if (hipFuncSetAttribute((const void*)mk_fwd, hipFuncAttributeMaxDynamicSharedMemorySize, LDS_BYTES) != hipSuccess) { fprintf(stderr, "kernel_launch: hipFuncSetAttribute failed\n"); grid = -1; return; }
        if (hipOccupancyMaxActiveBlocksPerMultiprocessor(&per_cu, (const void*)mk_fwd, NWAVES * 64, LDS_BYTES) != hipSuccess || per_cu < 1) { fprintf(stderr, "kernel_launch: occupancy query says %d blocks per CU\n", per_cu); (void)hipGetLastError(); grid = -1; return; }
        grid = cus;
    }
    if (grid < 0) return;
    if (hipMemsetAsync((char*)d_ws + WS_CTL, 0, CTL_ZERO_BYTES, stream) != hipSuccess) return;
    Args a{};
    for (int i = 0; i < 15; ++i) a.in[i] = (const float*)d_in[i];
    a.out = (float*)d_out; a.ws = (unsigned char*)d_ws;
#if MK_PER_PHASE
    for (int p = 0; p < NPHASE; ++p) { a.ph_lo = p; a.ph_hi = p + 1; hipLaunchKernelGGL(mk_fwd, dim3(grid), dim3(NWAVES * 64), LDS_BYTES, stream, a); }
#else
    a.ph_lo = 0; a.ph_hi = NPHASE;
    hipLaunchKernelGGL(mk_fwd, dim3(grid), dim3(NWAVES * 64), LDS_BYTES, stream, a);
#endif
}
```

```cpp
#include <hip/hip_runtime.h>
#include <cstdio>
#include <cstdint>
namespace pg8 {
#define PG8_LAS __attribute__((address_space(3)))
typedef unsigned short bf16_t;
typedef short bf16x8 __attribute__((ext_vector_type(8)));
typedef float f32x4 __attribute__((ext_vector_type(4)));
typedef unsigned u32x4 __attribute__((ext_vector_type(4)));
constexpr int BM = 256, BK = 64, HALF = 128, HTB = HALF * BK * 2  , STAGE_BYTES = 8 * HTB, NXCD = 8, WGM = 8;

__host__ __device__ __forceinline__ int lds_byte(int r, int c) { const int st = (r >> 4) * 2 + (c >> 5), rr = r & 15, cc = c & 31, ob = rr * 64 + cc * 2; return st * 1024 + (ob ^ (((ob >> 9) & 1) << 5)); }
__host__ __device__ __forceinline__ void stage_rc(int b, int& R, int& C) { const int st = b / 1024, sb = b % 1024, swz = sb ^ (((sb >> 9) & 1) << 5); R = (st >> 1) * 16 + swz / 64; C = (st & 1) * 32 + (swz % 64) / 2; }
__host__ __device__ __forceinline__ int perm32(int rho) { const int n = rho >> 4, i = rho & 15; return 8 * (i >> 2) + 4 * n + (i & 3); }

struct Unit { int pm, pn; };
struct Gemm { const bf16_t* A; const bf16_t* Bt; int M, N, K, lda, ldb; };

struct StaticOrder {
    int nM, nN, nwg, G, c;
    __host__ __device__ void init(int M, int N, int G_, int c_) { nM = M / BM; nN = N / BM; nwg = nM * nN; G = G_; c = c_; }
    __host__ __device__ bool next(int i, Unit& u) const {
        const long L = (long)i * G + c; if (L >= nwg) return false;
        int wgid = (int)L; { const int q = nwg / NXCD, r = nwg % NXCD, xcd = wgid % NXCD, off = wgid / NXCD; wgid = (xcd < r ? xcd * (q + 1) : r * (q + 1) + (xcd - r) * q) + off; }
        const int nig = WGM * nN, gid = wgid / nig, fm = gid * WGM, gsz = (nM - fm) < WGM ? (nM - fm) : WGM;
        u.pm = fm + ((wgid % nig) % gsz); u.pn = (wgid % nig) / gsz; return true;
    }
    __device__ __forceinline__ void a_ready(const Unit&) const {}
    __device__ __forceinline__ void done(const Unit&) const {}
};
typedef float f32x2c_t __attribute__((ext_vector_type(2))); typedef __bf16 bf16x2c_t __attribute__((ext_vector_type(2)));
__device__ __forceinline__ unsigned cvt_pk_bf16(float lo, float hi) { f32x2c_t v = {lo, hi}; bf16x2c_t b = __builtin_convertvector(v, bf16x2c_t); return __builtin_bit_cast(unsigned, b); }
typedef float f32x2 __attribute__((ext_vector_type(2)));
__device__ __forceinline__ f32x2 gelu_pk(f32x2 v) {
    const f32x2 av = __builtin_elementwise_abs(v), d = av * 0.2316418882f + 1.0f;
    f32x2 t; t.x = __builtin_amdgcn_rcpf(d.x); t.y = __builtin_amdgcn_rcpf(d.y);
    f32x2 q = t * 0.5307027145f + (-0.7265760135f); q = q * t + 0.7107068705f; q = q * t + (-0.142248368f); q = q * t + 0.127414796f; q = q * t;
    const f32x2 s = (v * v) * (-0.72134752044f);
    f32x2 e; e.x = __builtin_amdgcn_exp2f(s.x); e.y = __builtin_amdgcn_exp2f(s.y);
    const f32x2 m = v * (q * e), r = v - m;
    f32x2 o; o.x = v.x < 0.f ? m.x : r.x; o.y = v.y < 0.f ? m.y : r.y; return o;
}
__device__ __forceinline__ float bf_lo(unsigned w) { return __uint_as_float(w << 16); }
__device__ __forceinline__ float bf_hi(unsigned w) { return __uint_as_float(w & 0xffff0000u); }
__device__ __forceinline__ float sigmoidf_fast(float g) { return __builtin_amdgcn_rcpf(1.0f + __builtin_amdgcn_exp2f(-1.4426950408889634f * g)); }
__device__ __forceinline__ unsigned ord_key(float f) { const unsigned b = __float_as_uint(f); return b ^ ((unsigned)((int)b >> 31) | 0x80000000u); }
__device__ __forceinline__ float unord_key(unsigned k) { return __uint_as_float((k & 0x80000000u) ? (k ^ 0x80000000u) : ~k); }

struct EpiStoreBf16 {
    static constexpr bool PERM = true, AFTER_DRAIN = false;
    bf16_t* O; int ldc;
    __device__ __forceinline__ void operator()(const f32x4 (&acc)[2][2][4][2], const Unit& u, int wr, int wc, int fr, int fq) const {
        const int row0 = u.pm * BM + wr * 64 + fr, col0 = u.pn * BM + wc * 32 + 8 * fq;
#pragma unroll
        for (int ai = 0; ai < 2; ++ai)
#pragma unroll
            for (int m = 0; m < 4; ++m) { bf16_t* rowp = O + (size_t)(row0 + ai * HALF + m * 16) * ldc + col0;
#pragma unroll
                for (int bj = 0; bj < 2; ++bj) { const f32x4 v0 = acc[ai][bj][m][0], v1 = acc[ai][bj][m][1];
                    u32x4 w; w.x = cvt_pk_bf16(v0[0], v0[1]); w.y = cvt_pk_bf16(v0[2], v0[3]); w.z = cvt_pk_bf16(v1[0], v1[1]); w.w = cvt_pk_bf16(v1[2], v1[3]);
                    *(u32x4*)(rowp + bj * HALF) = w; } }
    }
};
template <bool ADD> struct EpiGate {
    static constexpr bool PERM = true, AFTER_DRAIN = false;
    bf16_t* O; int ldc; const bf16_t* G; int ldg;
    __device__ __forceinline__ void operator()(const f32x4 (&acc)[2][2][4][2], const Unit& u, int wr, int wc, int fr, int fq) const {
        const int row0 = u.pm * BM + wr * 64 + fr, col0 = u.pn * BM + wc * 32 + 8 * fq;
#pragma unroll
        for (int ai = 0; ai < 2; ++ai)
#pragma unroll
            for (int m = 0; m < 4; ++m) { const size_t row = (size_t)(row0 + ai * HALF + m * 16);
#pragma unroll
                for (int bj = 0; bj < 2; ++bj) { const int col = col0 + bj * HALF;
                    const u32x4 gr = *(const u32x4*)(G + row * ldg + col);
                    f32x4 v0 = acc[ai][bj][m][0], v1 = acc[ai][bj][m][1];
                    v0[0] *= sigmoidf_fast(bf_lo(gr.x)); v0[1] *= sigmoidf_fast(bf_hi(gr.x)); v0[2] *= sigmoidf_fast(bf_lo(gr.y)); v0[3] *= sigmoidf_fast(bf_hi(gr.y));
                    v1[0] *= sigmoidf_fast(bf_lo(gr.z)); v1[1] *= sigmoidf_fast(bf_hi(gr.z)); v1[2] *= sigmoidf_fast(bf_lo(gr.w)); v1[3] *= sigmoidf_fast(bf_hi(gr.w));
                    bf16_t* op = O + row * ldc + col;
                    if (ADD) { const u32x4 pr = *(const u32x4*)op;
                        v0[0] += bf_lo(pr.x); v0[1] += bf_hi(pr.x); v0[2] += bf_lo(pr.y); v0[3] += bf_hi(pr.y);
                        v1[0] += bf_lo(pr.z); v1[1] += bf_hi(pr.z); v1[2] += bf_lo(pr.w); v1[3] += bf_hi(pr.w); }
                    u32x4 w; w.x = cvt_pk_bf16(v0[0], v0[1]); w.y = cvt_pk_bf16(v0[2], v0[3]); w.z = cvt_pk_bf16(v1[0], v1[1]); w.w = cvt_pk_bf16(v1[2], v1[3]);
                    *(u32x4*)op = w; } }
    }
};
struct EpiResF32 {
    static constexpr bool PERM = false, AFTER_DRAIN = false;
    const float* base; float* out; int ldc;
    __device__ __forceinline__ void operator()(const f32x4 (&acc)[2][2][4][2], const Unit& u, int wr, int wc, int fr, int fq) const {
        const int col0 = u.pn * BM + wc * 32 + 4 * fq;
#pragma unroll
        for (int ai = 0; ai < 2; ++ai)
#pragma unroll
            for (int m = 0; m < 4; ++m) { const size_t off = (size_t)(u.pm * BM + ai * HALF + wr * 64 + m * 16 + fr) * ldc + col0;
#pragma unroll
                for (int bj = 0; bj < 2; ++bj)
#pragma unroll
                    for (int n = 0; n < 2; ++n) { const f32x4 bs = *(const f32x4*)(base + off + bj * HALF + n * 16); *(f32x4*)(out + off + bj * HALF + n * 16) = bs + acc[ai][bj][m][n]; } }
    }
};
struct EpiKeys {
    static constexpr bool PERM = false, AFTER_DRAIN = false;
    unsigned* O; int ldc;
    __device__ __forceinline__ void operator()(const f32x4 (&acc)[2][2][4][2], const Unit& u, int wr, int wc, int fr, int fq) const {
        const int col0 = u.pn * BM + wc * 32 + 4 * fq;
#pragma unroll
        for (int ai = 0; ai < 2; ++ai)
#pragma unroll
            for (int m = 0; m < 4; ++m) { const size_t off = (size_t)(u.pm * BM + ai * HALF + wr * 64 + m * 16 + fr) * ldc + col0;
#pragma unroll
                for (int bj = 0; bj < 2; ++bj)
#pragma unroll
                    for (int n = 0; n < 2; ++n) { const int nn = (col0 + bj * HALF + n * 16) & 127; const f32x4 a = acc[ai][bj][m][n]; u32x4 w;
                        w.x = (ord_key(a[0]) & ~127u) | (unsigned)(127 - nn); w.y = (ord_key(a[1]) & ~127u) | (unsigned)(126 - nn);
                        w.z = (ord_key(a[2]) & ~127u) | (unsigned)(125 - nn); w.w = (ord_key(a[3]) & ~127u) | (unsigned)(124 - nn);
                        *(u32x4*)(O + off + bj * HALF + n * 16) = w; } }
    }
};

template <class Epi, class Sched, bool ALIGN_EPI = false, bool SP2 = false>
__device__ __forceinline__ void gemm_phase(PG8_LAS unsigned char* lds, const Gemm g, const Sched& S, const Epi& E) {
    int tid_ = threadIdx.x; asm volatile("" : "+v"(tid_));
    const int tid = tid_, wid = __builtin_amdgcn_readfirstlane(tid >> 6), lane = tid & 63, wr = wid >> 2, wc = wid & 3, fr = lane & 15, fq = lane >> 4;
    const int K = g.K, nt = K / BK;
    unsigned voffA[2], voffB[2];
#pragma unroll
    for (int i = 0; i < 2; ++i) { int R, C; stage_rc(tid * 16 + i * 8192, R, C); const int Rb = Epi::PERM ? ((R & ~31) + perm32(R & 31)) : R;
        voffA[i] = (unsigned)(R * g.lda + C) * 2u; voffB[i] = (unsigned)(Rb * g.ldb + C) * 2u; }
    const size_t kstep = (size_t)(BK * 2);
    const size_t hstepA = (size_t)HALF * g.lda * 2, hstepB = (size_t)HALF * g.ldb * 2;
    const size_t tstepA = 2 * hstepA, tstepB = 2 * hstepB;
    const unsigned ldsw = (unsigned)wid * 1024u;
    const int aoff = lds_byte(wr * 64 + fr, fq * 8), boff = lds_byte(wc * 32 + fr, fq * 8);
#define PG8_SA(b, h) (((b) * 2 + (h)) * HTB)
#define PG8_SB(b, h) ((4 + (b) * 2 + (h)) * HTB)
#define PG8_STAGE(bufoff, gbase, voff) do { _Pragma("unroll") for (int _i = 0; _i < 2; ++_i) \
        __builtin_amdgcn_global_load_lds((const unsigned*)((const char*)(gbase) + (voff)[_i]), (PG8_LAS unsigned*)(lds + (bufoff) + ldsw + _i * 8192), 16, 0, 0); } while (0)
#define PG8_LDA(dst, b, h) do { _Pragma("unroll") for (int m = 0; m < 4; ++m) _Pragma("unroll") for (int k = 0; k < 2; ++k) dst[m][k] = *(const PG8_LAS bf16x8*)(lds + PG8_SA(b, h) + aoff + m * 2048 + k * 1024); } while (0)
#define PG8_LDB(dst, b, h) do { _Pragma("unroll") for (int n = 0; n < 2; ++n) _Pragma("unroll") for (int k = 0; k < 2; ++k) dst[n][k] = *(const PG8_LAS bf16x8*)(lds + PG8_SB(b, h) + boff + n * 2048 + k * 1024); } while (0)
#define PG8_MMA(ai, bj, At, Bt) do { __builtin_amdgcn_s_setprio(1); _Pragma("unroll") for (int m = 0; m < 4; ++m) _Pragma("unroll") for (int n = 0; n < 2; ++n) _Pragma("unroll") for (int k = 0; k < 2; ++k) \
        acc[ai][bj][m][n] = __builtin_amdgcn_mfma_f32_16x16x32_bf16(Bt[n][k], At[m][k], acc[ai][bj][m][n], 0, 0, 0); __builtin_amdgcn_s_setprio(0); } while (0)
#define PG8_WAIT_V(n) asm volatile("s_waitcnt vmcnt(" #n ")" ::: "memory")
#define PG8_WAIT_L(n) asm volatile("s_waitcnt lgkmcnt(" #n ")" ::: "memory")
#define PG8_BAR __builtin_amdgcn_s_barrier()
#define PG8_SCHED __builtin_amdgcn_sched_barrier(0)
    Unit cur, nxt; int ui = 0;
    if (!S.next(0, cur)) return;
    f32x4 acc[2][2][4][2];
#pragma unroll
    for (int a = 0; a < 2; ++a)
#pragma unroll
        for (int b = 0; b < 2; ++b)
#pragma unroll
            for (int m = 0; m < 4; ++m)
#pragma unroll
                for (int n = 0; n < 2; ++n) acc[a][b][m][n] = (f32x4){0.f, 0.f, 0.f, 0.f};
    bf16x8 At[4][2], B0[2][2], B1[2][2];
    const char* cA = (const char*)g.A + (size_t)cur.pm * tstepA; const char* cB = (const char*)g.Bt + (size_t)cur.pn * tstepB;
    S.a_ready(cur);
    if constexpr (SP2) {
        PG8_STAGE(PG8_SB(0, 0), cB, voffB); PG8_STAGE(PG8_SB(0, 1), cB + hstepB, voffB); PG8_STAGE(PG8_SA(0, 0), cA, voffA); PG8_STAGE(PG8_SA(0, 1), cA + hstepA, voffA);
        if (wr == 1) PG8_BAR;
        PG8_WAIT_V(2); PG8_BAR;
        PG8_STAGE(PG8_SB(1, 0), cB + kstep, voffB); PG8_STAGE(PG8_SA(1, 0), cA + kstep, voffA); PG8_STAGE(PG8_SB(1, 1), cB + hstepB + kstep, voffB);
        PG8_WAIT_V(6); PG8_BAR;
    } else {
        PG8_STAGE(PG8_SB(0, 0), cB, voffB); PG8_STAGE(PG8_SA(0, 0), cA, voffA); PG8_STAGE(PG8_SB(0, 1), cB + hstepB, voffB); PG8_STAGE(PG8_SA(0, 1), cA + hstepA, voffA);
        if (wr == 1) PG8_BAR;
        PG8_WAIT_V(4); PG8_BAR;
        PG8_STAGE(PG8_SB(1, 0), cB + kstep, voffB); PG8_STAGE(PG8_SA(1, 0), cA + kstep, voffA); PG8_STAGE(PG8_SB(1, 1), cB + hstepB + kstep, voffB);
        PG8_WAIT_V(6); PG8_BAR;
    }
    for (;;) {
        const bool has_next = S.next(ui + 1, nxt);
        const char* nA = has_next ? (const char*)g.A + (size_t)nxt.pm * tstepA : cA; const char* nB = has_next ? (const char*)g.Bt + (size_t)nxt.pn * tstepB : cB;
        for (int t = 0; t < nt; t += 2) {
            const bool last = (t == nt - 2);
            const char* a1 = cA + (size_t)(t + 1) * kstep;
            const char* a2 = last ? nA : cA + (size_t)(t + 2) * kstep; const char* b2 = last ? nB : cB + (size_t)(t + 2) * kstep;
            const char* a3 = a2 + kstep; const char* b3 = b2 + kstep;
            if (last && has_next) S.a_ready(nxt);
            if constexpr (SP2) {
            PG8_LDB(B0, 0, 0); PG8_LDB(B1, 0, 1); PG8_SCHED; PG8_LDA(At, 0, 0); PG8_STAGE(PG8_SA(1, 1), a1 + hstepA, voffA);
            PG8_WAIT_V(8); PG8_WAIT_L(0); PG8_BAR; PG8_MMA(0, 0, At, B0); PG8_MMA(0, 1, At, B1); PG8_BAR; PG8_SCHED;
            PG8_LDA(At, 0, 1); PG8_STAGE(PG8_SB(0, 0), b2, voffB); PG8_STAGE(PG8_SB(0, 1), b2 + hstepB, voffB); PG8_STAGE(PG8_SA(0, 0), a2, voffA);
            PG8_WAIT_V(8); PG8_WAIT_L(0); PG8_BAR; PG8_MMA(1, 0, At, B0); PG8_MMA(1, 1, At, B1); PG8_BAR; PG8_SCHED;
            PG8_LDB(B0, 1, 0); PG8_LDB(B1, 1, 1); PG8_SCHED; PG8_LDA(At, 1, 0); PG8_STAGE(PG8_SA(0, 1), a2 + hstepA, voffA);
            PG8_WAIT_V(8); PG8_WAIT_L(0); PG8_BAR; PG8_MMA(0, 0, At, B0); PG8_MMA(0, 1, At, B1); PG8_BAR; PG8_SCHED;
            PG8_LDA(At, 1, 1); PG8_STAGE(PG8_SB(1, 0), b3, voffB); PG8_STAGE(PG8_SB(1, 1), b3 + hstepB, voffB); PG8_STAGE(PG8_SA(1, 0), a3, voffA);
            PG8_WAIT_V(8); PG8_WAIT_L(0); PG8_BAR; PG8_MMA(1, 0, At, B0); PG8_MMA(1, 1, At, B1); PG8_BAR; PG8_SCHED;
            } else {
            PG8_LDB(B0, 0, 0); PG8_SCHED; PG8_LDA(At, 0, 0); PG8_STAGE(PG8_SA(1, 1), a1 + hstepA, voffA);
            PG8_WAIT_L(8); PG8_BAR; PG8_WAIT_L(0); PG8_MMA(0, 0, At, B0); PG8_BAR; PG8_SCHED;
            PG8_LDB(B1, 0, 1); PG8_STAGE(PG8_SB(0, 0), b2, voffB);
            PG8_BAR; PG8_WAIT_L(0); PG8_MMA(0, 1, At, B1); PG8_BAR;
            PG8_LDA(At, 0, 1); PG8_STAGE(PG8_SA(0, 0), a2, voffA);
            PG8_BAR; PG8_WAIT_L(0); PG8_MMA(1, 0, At, B0); PG8_BAR; PG8_SCHED;
            PG8_STAGE(PG8_SB(0, 1), b2 + hstepB, voffB);
            PG8_WAIT_V(6); PG8_BAR; PG8_MMA(1, 1, At, B1); PG8_BAR;
            PG8_LDB(B0, 1, 0); PG8_SCHED; PG8_LDA(At, 1, 0); PG8_STAGE(PG8_SA(0, 1), a2 + hstepA, voffA);
            PG8_WAIT_L(8); PG8_BAR; PG8_WAIT_L(0); PG8_MMA(0, 0, At, B0); PG8_BAR; PG8_SCHED;
            PG8_LDB(B1, 1, 1); PG8_STAGE(PG8_SB(1, 0), b3, voffB);
            PG8_BAR; PG8_WAIT_L(0); PG8_MMA(0, 1, At, B1); PG8_BAR;
            PG8_LDA(At, 1, 1); PG8_STAGE(PG8_SA(1, 0), a3, voffA);
            PG8_BAR; PG8_WAIT_L(0); PG8_MMA(1, 0, At, B0); PG8_BAR; PG8_SCHED;
            PG8_STAGE(PG8_SB(1, 1), b3 + hstepB, voffB);
            PG8_WAIT_V(6); PG8_BAR; PG8_MMA(1, 1, At, B1); PG8_BAR;
            }
        }
        if constexpr (ALIGN_EPI) { if (wr == 0) PG8_BAR; }
        if constexpr (!Epi::AFTER_DRAIN) { E(acc, cur, wr, wc, fr, fq); S.done(cur); }
        if (!has_next) break;
#pragma unroll
        for (int a = 0; a < 2; ++a)
#pragma unroll
            for (int b = 0; b < 2; ++b)
#pragma unroll
                for (int m = 0; m < 4; ++m)
#pragma unroll
                    for (int n = 0; n < 2; ++n) acc[a][b][m][n] = (f32x4){0.f, 0.f, 0.f, 0.f};
        cur = nxt; cA = nA; cB = nB; ++ui;
        if constexpr (ALIGN_EPI) { if (wr == 1) PG8_BAR; }
    }
    PG8_WAIT_V(0);
    if constexpr (!ALIGN_EPI) { if (wr == 0) PG8_BAR; }
    PG8_BAR;
    if constexpr (Epi::AFTER_DRAIN) { E.fused(acc, cur, wr, wc, fr, fq, lds, wid, lane); S.done(cur); }
#undef PG8_SA
#undef PG8_SB
#undef PG8_STAGE
#undef PG8_LDA
#undef PG8_LDB
#undef PG8_MMA
#undef PG8_WAIT_V
#undef PG8_WAIT_L
#undef PG8_BAR
#undef PG8_SCHED
}
}

constexpr int NWAVES = 8;
#ifndef REPEAT_MASK
#define REPEAT_MASK 0
#endif
#ifndef MK_PER_PHASE
#define MK_PER_PHASE 0
#endif
constexpr int NPHASE = 14;

constexpr int BATCH = 16, SEQ = 4096, DM = 1024, MTOK = BATCH * SEQ;
constexpr int LDP = 4864;
constexpr int Q_OFF = 0, K_OFF = 512, V_OFF = 1024, QI_OFF = 1536, P_OFF = 2048, GA_OFF = 2560, GP_OFF = 3584, KI_OFF = 4608, WI_OFF = 4672;
constexpr int IN_WIDTH = 4680;
constexpr float EPS = 1e-6f;
constexpr float C2 = 0.125f * 1.4426950408889634f;
constexpr float WI_SCALE = 0.35355339059327373f * 0.125f;

constexpr size_t MiB = 1u << 20;
constexpr size_t WS_CTL = 0, CTL_ZERO_BYTES = 1 * MiB;
constexpr size_t WS_ROPE = 1 * MiB;
constexpr size_t WS_WIN = 2 * MiB;
constexpr size_t WS_WA = 12 * MiB;
constexpr size_t WS_WPP = 13 * MiB;
constexpr size_t WS_WO = 14 * MiB;
constexpr size_t WS_W2 = 16 * MiB;
constexpr size_t WS_U16 = 20 * MiB, WS_V16 = 52 * MiB;
constexpr size_t WS_MASK = 84 * MiB;
constexpr size_t WS_POOLED = 116 * MiB;
constexpr size_t WS_ACT = 180 * MiB;
constexpr size_t WS_PROJ = 308 * MiB;
constexpr size_t WS_REXP = 916 * MiB, WS_RG = 948 * MiB;
constexpr size_t WS_END = 980 * MiB;
constexpr int CW_TMO = 0, CW_BAR = 4096;

constexpr int RING_BYTES = 131072;
constexpr int LDSCTL_OFF = RING_BYTES, MISC_OFF = LDSCTL_OFF + 320;
constexpr int LDS_BYTES = 147456;

#define GAS __attribute__((address_space(1)))
#define LAS __attribute__((address_space(3)))
typedef unsigned short bf16;
typedef unsigned v4u __attribute__((ext_vector_type(4)));
typedef unsigned v2u __attribute__((ext_vector_type(2)));
typedef float f32x4 __attribute__((ext_vector_type(4)));
typedef float f32x16 __attribute__((ext_vector_type(16)));
typedef short bf16x8 __attribute__((ext_vector_type(8)));
typedef short s16x4 __attribute__((ext_vector_type(4)));
typedef GAS unsigned gu32;
#define RLX_AGENT __ATOMIC_RELAXED, __HIP_MEMORY_SCOPE_AGENT
#define LDS_WAIT() asm volatile("s_waitcnt lgkmcnt(0)" ::: "memory")
#define VM_WAIT() asm volatile("s_waitcnt vmcnt(0)" ::: "memory")
__device__ __forceinline__ unsigned f2bf(float f) { unsigned u = __builtin_bit_cast(unsigned, f); return (u + 0x7fffu + ((u >> 16) & 1u)) >> 16; }
__device__ __forceinline__ unsigned pk2(float lo, float hi) { return f2bf(lo) | (f2bf(hi) << 16); }
__device__ __forceinline__ float bflo(unsigned w) { return __uint_as_float(w << 16); }
__device__ __forceinline__ float bfhi(unsigned w) { return __uint_as_float(w & 0xffff0000u); }
__device__ __forceinline__ unsigned ordk(float f) { const unsigned b = __float_as_uint(f); return b ^ ((unsigned)((int)b >> 31) | 0x80000000u); }
__device__ __forceinline__ float unordk(unsigned k) { return __uint_as_float((k & 0x80000000u) ? (k ^ 0x80000000u) : ~k); }
__device__ __forceinline__ int crow(int r, int hi) { return (r & 3) + 8 * (r >> 2) + 4 * hi; }

#define XB_TMO      128
#define XB_XCNT(j)  (256  + 64 * (j))
#define XB_XSUB(j)  (1280 + 64 * (j))
#define XB_XGEN(j)  (2304 + 64 * (j))
#define XB_TOP      3328
#define XB_TOPGEN   3392
#define XCD_BAR_WORDS 3456
#define XB_SPIN_CAP (1u << 18)

__device__ __forceinline__ unsigned xb_ld(unsigned* p)              { return __hip_atomic_load(p, __ATOMIC_RELAXED, __HIP_MEMORY_SCOPE_AGENT); }
__device__ __forceinline__ unsigned xb_add(unsigned* p, unsigned v) { return __hip_atomic_fetch_add(p, v, __ATOMIC_RELAXED, __HIP_MEMORY_SCOPE_AGENT); }
__device__ __forceinline__ unsigned xb_xcc_id() { return (unsigned)__builtin_amdgcn_s_getreg((3 << 11) | 20) & 0xFu; }
#define XB_SPIN(cond, bar) do { unsigned _sp = 0; while (cond) { __builtin_amdgcn_s_sleep(1); \
    if ((++_sp & 255u) == 0u) { if (xb_ld(&(bar)[XB_TMO])) break; if (_sp > XB_SPIN_CAP) { atomicAdd(&(bar)[XB_TMO], 1u); break; } } } } while (0)

struct XcdBarrier {
    unsigned* bar; unsigned x;
    volatile LAS unsigned* st;
};

__device__ __forceinline__ XcdBarrier xcd_barrier_post(unsigned* bar, volatile LAS unsigned* st) {
    XcdBarrier b; b.bar = bar; b.x = xb_xcc_id(); b.st = st;
    if (threadIdx.x == 0) (void)xb_add(&bar[XB_XCNT(b.x)], 1u);
    return b;
}
__device__ __forceinline__ void xcd_barrier_complete(unsigned* bar, unsigned x, unsigned& nloc, unsigned& nx) {
    const unsigned G = gridDim.x * gridDim.y * gridDim.z;
    unsigned sum, cnt, mine, sp = 0u;
    for (;;) {
        sum = 0u; cnt = 0u; mine = 0u;
#pragma unroll
        for (unsigned j = 0; j < 16; ++j) { const unsigned c = xb_ld(&bar[XB_XCNT(j)]); sum += c; cnt += (c > 0u) ? 1u : 0u; mine = (j == x) ? c : mine; }
        if (sum == G) break;
        __builtin_amdgcn_s_sleep(1);
        if ((++sp & 255u) == 0u) { if (xb_ld(&bar[XB_TMO])) break; if (sp > XB_SPIN_CAP) { atomicAdd(&bar[XB_TMO], 1u); break; } }
    }
    nloc = mine > 0u ? mine : 1u; nx = cnt > 0u ? cnt : 1u;
}

__device__ __forceinline__ void xcd_barrier(const XcdBarrier& b) {
    asm volatile("s_waitcnt vmcnt(0)" ::: "memory");
    __syncthreads();
    if (threadIdx.x == 0) {
        unsigned* bar = b.bar;
        __builtin_amdgcn_s_waitcnt(0);
        unsigned nloc = b.st[0], nx = b.st[1];
        if (nloc == 0u) { xcd_barrier_complete(bar, b.x, nloc, nx); b.st[0] = nloc; b.st[1] = nx; }
        const unsigned old = xb_add(&bar[XB_XSUB(b.x)], 1u);
        const unsigned gen = old / nloc;
        if (old + 1u == (gen + 1u) * nloc) {
            __builtin_amdgcn_fence(__ATOMIC_RELEASE, "agent");
            asm volatile("s_waitcnt vmcnt(0)" ::: "memory");
            const unsigned og = xb_add(&bar[XB_TOP], 1u);
            const unsigned tg = og / nx;
            if (og + 1u == (tg + 1u) * nx) xb_add(&bar[XB_TOPGEN], 1u);
            else XB_SPIN(xb_ld(&bar[XB_TOPGEN]) == tg, bar);
            __builtin_amdgcn_fence(__ATOMIC_ACQUIRE, "agent");
            xb_add(&bar[XB_XGEN(b.x)], 1u);
            asm volatile("s_waitcnt vmcnt(0)" ::: "memory");
        } else {
            XB_SPIN(xb_ld(&bar[XB_XGEN(b.x)]) == gen, bar);
            __builtin_amdgcn_fence(__ATOMIC_ACQUIRE, "agent");
            asm volatile("s_waitcnt vmcnt(0)" ::: "memory");
        }
    }
    __syncthreads();
}


struct Frame {
    LAS unsigned char* lds;
    volatile LAS unsigned* MISC;
    gu32* ctl;
    unsigned char* ws;
    int tid, lane, wave, vcu, G;
};
struct Args { const float* in[15]; float* out; unsigned char* ws; int ph_lo, ph_hi; };

__device__ __forceinline__ float wave_sum(float v) {
#pragma unroll
    for (int o = 1; o < 64; o <<= 1) v += __shfl_xor(v, o);
    return v;
}

template <class ColMap>
__device__ __forceinline__ void p0_transpose_item(const float* W, int K, int N, bf16* WT, int nblk, LAS float* scr, int item, int lane, ColMap cm) {
    const int kb = item / nblk, nb = item % nblk, k0 = 64 * kb, n0 = 32 * nb;
    const int src = cm(n0 + (lane & 31));
#pragma unroll 8
    for (int i = 0; i < 32; ++i) { const int kk = 2 * i + (lane >> 5); scr[kk * 33 + (lane & 31)] = (src >= 0) ? W[(size_t)(k0 + kk) * N + src] : 0.f; }
    LDS_WAIT(); asm volatile("" ::: "memory");
    const int c = lane & 7;
#pragma unroll
    for (int j = 0; j < 4; ++j) { const int n = (lane >> 3) + 8 * j; const LAS float* s = scr + (8 * c) * 33 + n;
        v4u o; o.x = pk2(s[0 * 33], s[1 * 33]); o.y = pk2(s[2 * 33], s[3 * 33]); o.z = pk2(s[4 * 33], s[5 * 33]); o.w = pk2(s[6 * 33], s[7 * 33]);
        *(GAS v4u*)(WT + (size_t)(n0 + n) * K + k0 + 8 * c) = o; }
    LDS_WAIT(); asm volatile("" ::: "memory");
}
struct MapIdent { __device__ __forceinline__ int operator()(int n) const { return n; } };
struct MapWin { __device__ __forceinline__ int operator()(int n) const {
    if (n < 2048) return n;
    if (n < 2560) return 2120 + (n - 2048);
    if (n < 4608) return 2632 + (n - 2560);
    if (n < 4672) return 2048 + (n - 4608);
    if (n < 4680) return 2112 + (n - 4672);
    return -1; } };

__device__ __forceinline__ void rms_row_to_bf16(const float* xrow, const float* g, bf16* orow, int lane) {
    const GAS f32x4* xr = (const GAS f32x4*)xrow + lane; const GAS f32x4* gr = (const GAS f32x4*)g + lane;
    f32x4 v[4]; float s = 0.f;
#pragma unroll
    for (int j = 0; j < 4; ++j) { v[j] = xr[64 * j]; s += (v[j].x * v[j].x + v[j].y * v[j].y) + (v[j].z * v[j].z + v[j].w * v[j].w); }
    const float rs = 1.0f / sqrtf(wave_sum(s) * (1.f / 1024.f) + EPS);
    GAS unsigned long long* o8 = (GAS unsigned long long*)orow + lane;
#pragma unroll
    for (int j = 0; j < 4; ++j) { const f32x4 gg = gr[64 * j];
        o8[64 * j] = (unsigned long long)pk2(v[j].x * rs * gg.x, v[j].y * rs * gg.y) | ((unsigned long long)pk2(v[j].z * rs * gg.z, v[j].w * rs * gg.w) << 32); }
}

__device__ __forceinline__ void p0_prologue(Frame& F, const Args& AR) {
    LAS float* scr = (LAS float*)(F.lds + F.wave * 16384);
    const int gw = F.vcu * NWAVES + F.wave, NGW = F.G * NWAVES, lane = F.lane;
    constexpr int I_WIN = 16 * 152, I_WA = 8 * 32, I_WO = 16 * 32;
    for (int it = gw; it < I_WIN + I_WA + I_WO; it += NGW) {
        int r = it;
        if (r < I_WIN) { p0_transpose_item((AR.in[2]), 1024, IN_WIDTH, ((bf16*)(F.ws + WS_WIN)), 152, scr, r, lane, MapWin()); continue; } r -= I_WIN;
        if (r < I_WA) { p0_transpose_item((AR.in[7]), 512, 1024, ((bf16*)(F.ws + WS_WA)), 32, scr, r, lane, MapIdent()); continue; } r -= I_WA;
        p0_transpose_item((AR.in[9]), 1024, 1024, ((bf16*)(F.ws + WS_WO)), 32, scr, r, lane, MapIdent());
    }
    for (int it = gw; it < 16 * 64; it += NGW) {
        const int nb = it & 15, kb = it >> 4, n = nb * 64 + lane, k0 = kb * 8, g = k0 >> 7, c0 = k0 & 127;
        float acc[8];
#pragma unroll
        for (int j = 0; j < 8; ++j) acc[j] = 0.f;
        for (int d = 0; d < 128; ++d) {
            const float wv = (AR.in[8])[(size_t)(g * 128 + d) * 1024 + n] * (AR.in[6])[g * 128 + d];
#pragma unroll
            for (int j = 0; j < 8; ++j) acc[j] += (AR.in[5])[(size_t)(g * 128 + c0 + j) * 128 + d] * wv;
        }
        v4u o; o.x = pk2(acc[0], acc[1]); o.y = pk2(acc[2], acc[3]); o.z = pk2(acc[4], acc[5]); o.w = pk2(acc[6], acc[7]);
        *(GAS v4u*)(((bf16*)(F.ws + WS_WPP)) + (size_t)n * 512 + k0) = o;
    }
    for (int it = gw; it < 32 * 16; it += NGW) {
        const int nb = it & 31, kb = it >> 5, np = nb * 64 + lane, hp = nb >> 1, k0 = kb * 64;
#pragma unroll 4
        for (int d4 = 0; d4 < 16; ++d4) { const f32x4 t = *(const GAS f32x4*)((AR.in[12]) + (size_t)np * 64 + d4 * 4);
            scr[(4 * d4 + 0) * 64 + lane] = t.x; scr[(4 * d4 + 1) * 64 + lane] = t.y; scr[(4 * d4 + 2) * 64 + lane] = t.z; scr[(4 * d4 + 3) * 64 + lane] = t.w; }
        LDS_WAIT(); asm volatile("" ::: "memory");
#pragma unroll 1
        for (int k8 = 0; k8 < 8; ++k8) {
            float acc[8];
#pragma unroll
            for (int j = 0; j < 8; ++j) acc[j] = 0.f;
            const float* wr = (AR.in[11]) + (size_t)(k0 + k8 * 8) * 1024 + hp * 64;
#pragma unroll 4
            for (int d = 0; d < 64; ++d) { const float sv = scr[d * 64 + lane];
#pragma unroll
                for (int j = 0; j < 8; ++j) acc[j] += wr[(size_t)j * 1024 + d] * sv; }
            v4u o; o.x = pk2(acc[0], acc[1]); o.y = pk2(acc[2], acc[3]); o.z = pk2(acc[4], acc[5]); o.w = pk2(acc[6], acc[7]);
            *(GAS v4u*)(((bf16*)(F.ws + WS_W2)) + (size_t)np * 1024 + k0 + k8 * 8) = o;
        }
        LDS_WAIT(); asm volatile("" ::: "memory");
    }
    for (int it = gw; it < 2 * 32768; it += NGW) {
        const float* src = (it < 32768) ? (AR.in[13]) : (AR.in[14]); bf16* dst = (it < 32768) ? ((bf16*)(F.ws + WS_U16)) : ((bf16*)(F.ws + WS_V16)); const size_t e0 = (size_t)(it & 32767) * 512 + lane * 8;
        const f32x4 a = *(const GAS f32x4*)(src + e0), b = *(const GAS f32x4*)(src + e0 + 4);
        v4u o; o.x = pk2(a.x, a.y); o.y = pk2(a.z, a.w); o.z = pk2(b.x, b.y); o.w = pk2(b.z, b.w);
        *(GAS v4u*)(dst + e0) = o;
    }
    for (int it = gw * 64 + lane; it < 4096 * 8; it += NGW * 64) {
        const int pos = it >> 3, i = it & 7;
        const float invf = exp2f(-(float)i * 0.125f * 18.931568569324174f);
        const double ang = (double)((float)pos * invf);
        const double kq = __builtin_rint(ang * 0.6366197723675814);
        const float r = (float)(ang - kq * 1.5707963267948966);
        const int q = (int)((long long)kq & 3);
        const float r2 = r * r;
        const float sn = r + r * r2 * (-1.6666654611e-1f + r2 * (8.3321608736e-3f + r2 * (-1.9515295891e-4f)));
        const float cs = 1.0f - 0.5f * r2 + r2 * r2 * (4.166664568298827e-2f + r2 * (-1.388731625493765e-3f + r2 * 2.443315711809948e-5f));
        const float s = (q == 0) ? sn : (q == 1) ? cs : (q == 2) ? -sn : -cs;
        const float c = (q == 0) ? cs : (q == 1) ? -sn : (q == 2) ? -cs : sn;
        ((float*)(F.ws + WS_ROPE))[pos * 16 + i] = c; ((float*)(F.ws + WS_ROPE))[pos * 16 + 8 + i] = s;
    }
    for (int m = gw; m < MTOK; m += NGW) rms_row_to_bf16((AR.in[0]) + (size_t)m * DM, (AR.in[1]), ((bf16*)(F.ws + WS_ACT)) + (size_t)m * DM, lane);
}

__device__ __forceinline__ void unpack8(const v4u w, float (&v)[8]) { v[0] = bflo(w.x); v[1] = bfhi(w.x); v[2] = bflo(w.y); v[3] = bfhi(w.y); v[4] = bflo(w.z); v[5] = bfhi(w.z); v[6] = bflo(w.w); v[7] = bfhi(w.w); }
__device__ __forceinline__ v4u pack8(const float (&v)[8]) { v4u o; o.x = pk2(v[0], v[1]); o.y = pk2(v[2], v[3]); o.z = pk2(v[4], v[5]); o.w = pk2(v[6], v[7]); return o; }
__device__ __forceinline__ void rope8(float (&v)[8], int sub, const float (&cs)[8], const float (&sn)[8]) {
    float pv[8];
#pragma unroll
    for (int j = 0; j < 8; ++j) pv[j] = __shfl_xor(v[j], 1);
    if (sub == 0) {
#pragma unroll
        for (int j = 0; j < 8; ++j) v[j] = v[j] * cs[j] - pv[j] * sn[j];
    } else if (sub == 1) {
#pragma unroll
        for (int j = 0; j < 8; ++j) v[j] = v[j] * cs[j] + pv[j] * sn[j];
    }
}
__device__ __forceinline__ void fixup_token(Frame& F, const Args& AR, int tok) {
    const int lane = F.lane, sub = lane & 7, pos = tok & (SEQ - 1);
    bf16* row = ((bf16*)(F.ws + WS_PROJ)) + (size_t)tok * LDP;
    float cs[8], sn[8];
    { const GAS f32x4* rt = (const GAS f32x4*)(((float*)(F.ws + WS_ROPE)) + pos * 16); const f32x4 a = rt[0], b = rt[1], c = rt[2], d = rt[3];
      cs[0] = a.x; cs[1] = a.y; cs[2] = a.z; cs[3] = a.w; cs[4] = b.x; cs[5] = b.y; cs[6] = b.z; cs[7] = b.w;
      sn[0] = c.x; sn[1] = c.y; sn[2] = c.z; sn[3] = c.w; sn[4] = d.x; sn[5] = d.y; sn[6] = d.z; sn[7] = d.w; }
#pragma unroll
    for (int which = 0; which < 2; ++which) {
        GAS v4u* p = (GAS v4u*)(row + (which ? K_OFF : Q_OFF) + lane * 8);
        float v[8]; unpack8(*p, v);
        float ss = 0.f;
#pragma unroll
        for (int j = 0; j < 8; ++j) ss += v[j] * v[j];
        ss += __shfl_xor(ss, 1); ss += __shfl_xor(ss, 2); ss += __shfl_xor(ss, 4);
        const float rs = 1.0f / sqrtf(ss * (1.f / 64.f) + EPS);
        const float* g = (which ? (AR.in[4]) : (AR.in[3])) + sub * 8;
#pragma unroll
        for (int j = 0; j < 8; ++j) v[j] = v[j] * rs * g[j];
        rope8(v, sub, cs, sn);
        if (which == 0) {
#pragma unroll
            for (int j = 0; j < 8; ++j) v[j] *= C2;
        }
        *p = pack8(v);
    }
    { GAS v4u* p = (GAS v4u*)(row + QI_OFF + lane * 8); float v[8]; unpack8(*p, v); rope8(v, sub, cs, sn); *p = pack8(v); }
    { GAS v4u* p = (GAS v4u*)(row + KI_OFF + (lane & 7) * 8); float v[8]; unpack8(*p, v); rope8(v, sub, cs, sn); if (lane < 8) *p = pack8(v); }
    { const int g = lane >> 4, w = 2 << g;
      float acc[8], cur[8];
#pragma unroll
      for (int j = 0; j < 8; ++j) acc[j] = 0.f;
      unpack8(*(const GAS v4u*)(row + P_OFF + lane * 8), cur);
#pragma unroll
      for (int j = 0; j < 8; ++j) acc[j] = cur[j];
#pragma unroll
      for (int back = 1; back < 16; ++back) {
          if (back < w && back <= pos) { float t[8]; unpack8(*(const GAS v4u*)(row - (size_t)back * LDP + P_OFF + lane * 8), t);
#pragma unroll
              for (int j = 0; j < 8; ++j) acc[j] += t[j]; }
      }
      const float inv = 1.0f / (float)((pos + 1 < w) ? (pos + 1) : w);
      float o[8];
#pragma unroll
      for (int j = 0; j < 8; ++j) o[j] = acc[j] * inv - cur[j];
      *(GAS v4u*)(((bf16*)(F.ws + WS_POOLED)) + (size_t)tok * 512 + lane * 8) = pack8(o); }
}

#define wlane(dst, sval, j) asm volatile("s_nop 3\n\tv_writelane_b32 %0, %1, %2\n\ts_nop 1" : "+v"(dst) : "s"(sval), "i"(j))
__device__ __forceinline__ void select_row(const LAS float* srow, int nj, int lastw, GAS unsigned long long* mout, int lane) {
    unsigned key[64];
#pragma unroll
    for (int g = 0; g < 8; ++g) {
        if (nj > 8 * g) {
#pragma unroll
            for (int jj = 0; jj < 8; ++jj) key[8 * g + jj] = ordk(srow[64 * (8 * g + jj) + lane] + 0.0f);
        } else {
#pragma unroll
            for (int jj = 0; jj < 8; ++jj) key[8 * g + jj] = 0u;
        }
    }
    unsigned v = 0u;
#pragma unroll 1
    for (int bit = 31; bit >= 0; --bit) {
        const unsigned cand = v | (1u << bit);
        int cnt = 0;
#pragma unroll
        for (int g = 0; g < 8; ++g) {
            if (nj > 8 * g) {
#pragma unroll
                for (int jj = 0; jj < 8; ++jj) cnt += __popcll(__ballot(key[8 * g + jj] >= cand));
            }
        }
        if (cnt >= 256) v = cand;
    }
    int ngt = 0, neq = 0;
#pragma unroll
    for (int j = 0; j < 64; ++j) { ngt += __popcll(__ballot(key[j] > v)); neq += __popcll(__ballot(key[j] == v)); }
    unsigned mlo = 0u, mhi = 0u;
    if (ngt + neq == 256) {
#pragma unroll
        for (int j = 0; j < 64; ++j) { const unsigned long long m = __ballot(key[j] >= v);
            wlane(mlo, (unsigned)m, j); wlane(mhi, (unsigned)(m >> 32), j); }
    } else {
        int need = 256 - ngt;
#pragma unroll
        for (int j = 0; j < 64; ++j) {
            unsigned long long eq = __ballot(key[j] == v); const unsigned long long gt = __ballot(key[j] > v);
            unsigned long long keep = 0ull;
            while (need > 0 && eq != 0ull) { const unsigned long long lsb = eq & (0ull - eq); keep |= lsb; eq ^= lsb; --need; }
            const unsigned long long m = gt | keep;
            wlane(mlo, (unsigned)m, j); wlane(mhi, (unsigned)(m >> 32), j);
        }
    }
    if (lane <= lastw) mout[lane] = ((unsigned long long)mhi << 32) | (unsigned long long)mlo;
}

__device__ __forceinline__ void idx_unit(Frame& F, const Args& AR, int b, int c) {
    const int lane = F.lane, wid = F.wave, l31 = lane & 31, h2 = lane >> 5;
    LAS float* sc = (LAS float*)F.lds;
    const size_t rowb = (size_t)b * SEQ, tq0 = rowb + (size_t)c * 64;
    if (c < 4) {
        if (F.tid < 256) { const int q = F.tid >> 2, j = F.tid & 3; ((unsigned long long*)(F.ws + WS_MASK))[(tq0 + q) * 64 + j] = (j <= c) ? ~0ull : 0ull; }
        return;
    }
    const int ntile = 2 * (c + 1), nj = c + 1, lastw = c | 3, ntile_pad = 16 * ((nj + 7) >> 3);
    const int head = (l31 & 3) | (((l31 >> 3) & 1) << 2), qsub = ((l31 >> 2) & 1) | (((l31 >> 4) & 1) << 1);
    for (int pass = 0; pass < 8; ++pass) {
        const size_t tp0 = tq0 + pass * 8;
        bf16x8 a[2][4]; float w[2][16];
#pragma unroll
        for (int rb = 0; rb < 2; ++rb) {
            const bf16* ap = ((bf16*)(F.ws + WS_PROJ)) + (tp0 + 4 * rb + qsub) * LDP + QI_OFF + head * 64 + h2 * 8;
#pragma unroll
            for (int st = 0; st < 4; ++st) a[rb][st] = *(const GAS bf16x8*)(ap + st * 16);
            const v4u wa = *(const GAS v4u*)(((bf16*)(F.ws + WS_PROJ)) + (tp0 + 4 * rb + h2) * LDP + WI_OFF), wb = *(const GAS v4u*)(((bf16*)(F.ws + WS_PROJ)) + (tp0 + 4 * rb + h2 + 2) * LDP + WI_OFF);
            float t[8]; unpack8(wa, t);
#pragma unroll
            for (int j = 0; j < 8; ++j) w[rb][j] = t[j] * WI_SCALE;
            unpack8(wb, t);
#pragma unroll
            for (int j = 0; j < 8; ++j) w[rb][8 + j] = t[j] * WI_SCALE;
        }
        for (int kt = wid; kt < ntile_pad; kt += 8) {
            if (kt >= ntile) {
#pragma unroll
                for (int rb = 0; rb < 2; ++rb) { sc[(4 * rb + h2) * 4096 + kt * 32 + l31] = -INFINITY; sc[(4 * rb + h2 + 2) * 4096 + kt * 32 + l31] = -INFINITY; }
                continue;
            }
            const bf16* kp = ((bf16*)(F.ws + WS_PROJ)) + (rowb + kt * 32 + l31) * LDP + KI_OFF + h2 * 8;
            bf16x8 bfr[4];
#pragma unroll
            for (int st = 0; st < 4; ++st) bfr[st] = *(const GAS bf16x8*)(kp + st * 16);
#pragma unroll
            for (int rb = 0; rb < 2; ++rb) {
                f32x16 acc;
#pragma unroll
                for (int r = 0; r < 16; ++r) acc[r] = 0.f;
#pragma unroll
                for (int st = 0; st < 4; ++st) acc = __builtin_amdgcn_mfma_f32_32x32x16_bf16(a[rb][st], bfr[st], acc, 0, 0, 0);
                float s0 = 0.f, s1 = 0.f;
#pragma unroll
                for (int r = 0; r < 8; ++r) { s0 = fmaf(w[rb][r], fmaxf(acc[r], 0.f), s0); s1 = fmaf(w[rb][8 + r], fmaxf(acc[8 + r], 0.f), s1); }
                sc[(4 * rb + h2) * 4096 + kt * 32 + l31] = s0;
                sc[(4 * rb + h2 + 2) * 4096 + kt * 32 + l31] = s1;
            }
        }
        __syncthreads();
        select_row(sc + wid * 4096, nj, lastw, (GAS unsigned long long*)(((unsigned long long*)(F.ws + WS_MASK)) + (tp0 + wid) * 64), lane);
        __syncthreads();
    }
}

__device__ __forceinline__ void attn_unit(Frame& F, const Args& AR, int b, int h, int qb) {
    const int lane = F.lane, wid = F.wave, l31 = lane & 31, h2 = lane >> 5;
    LAS unsigned char* Ks = F.lds;
    LAS unsigned char* Vs = F.lds + 9216;
    LAS float* wsf = (LAS float*)(F.lds + 17408) + wid * 32;
    const size_t rowb = (size_t)b * SEQ, tok0 = rowb + (size_t)qb * 256 + wid * 32;
    bf16x8 qf[4];
    { const bf16* qp = ((bf16*)(F.ws + WS_PROJ)) + (tok0 + l31) * LDP + Q_OFF + h * 64 + h2 * 8;
#pragma unroll
      for (int st = 0; st < 4; ++st) qf[st] = *(const GAS bf16x8*)(qp + st * 16); }
    const int NT = 4 * (qb + 1), cw = qb * 4 + (wid >> 1);
    f32x16 o0, o1;
#pragma unroll
    for (int r = 0; r < 16; ++r) { o0[r] = 0.f; o1[r] = 0.f; }
    float lsum = 0.f;
    const int skey = F.tid >> 3, sch = F.tid & 7;
    const bf16* kg = ((bf16*)(F.ws + WS_PROJ)) + (rowb + skey) * LDP + K_OFF + h * 64 + sch * 8;
    const bf16* vg = ((bf16*)(F.ws + WS_PROJ)) + (rowb + skey) * LDP + V_OFF + h * 64 + sch * 8;
    v4u kreg = *(const GAS v4u*)kg, vreg = *(const GAS v4u*)vg;
    const unsigned kst = skey * 144 + sch * 16, vst = skey * 128 + ((sch * 16) ^ (((skey >> 1) & 1) << 6));
    const GAS unsigned long long* mrow = (const GAS unsigned long long*)(((unsigned long long*)(F.ws + WS_MASK)) + (tok0 + l31) * 64);
    const int i16 = lane & 15, qq = i16 >> 2, pp = i16 & 3, blk = (lane >> 4) & 1;
    const unsigned vrd = (unsigned)((4 * h2 + qq) * 128 + ((32 * blk + 8 * pp) ^ (((qq >> 1) & 1) << 6)));
    for (int t = 0; t < NT; ++t) {
        __syncthreads();
        *(LAS v4u*)(Ks + kst) = kreg; *(LAS v4u*)(Vs + vst) = vreg;
        __syncthreads();
        if (t + 1 < NT) { kreg = *(const GAS v4u*)(kg + (size_t)(t + 1) * 64 * LDP); vreg = *(const GAS v4u*)(vg + (size_t)(t + 1) * 64 * LDP); }
        if (t <= cw) {
            const unsigned long long mw = mrow[t];
            f32x16 p[2];
#pragma unroll
            for (int kb = 0; kb < 2; ++kb) {
                f32x16 acc;
#pragma unroll
                for (int r = 0; r < 16; ++r) acc[r] = 0.f;
#pragma unroll
                for (int st = 0; st < 4; ++st) { const bf16x8 ka = *(const LAS bf16x8*)(Ks + (32 * kb + l31) * 144 + st * 32 + h2 * 16); acc = __builtin_amdgcn_mfma_f32_32x32x16_bf16(ka, qf[st], acc, 0, 0, 0); }
                const unsigned wk = (kb ? (unsigned)(mw >> 32) : (unsigned)mw) >> (4 * h2);
#pragma unroll
                for (int r = 0; r < 16; ++r) {
                    const float e = __builtin_amdgcn_exp2f(acc[r]);
                    const int m = __builtin_amdgcn_sbfe((int)wk, (r & 3) + 8 * (r >> 2), 1);
                    const float pe = __uint_as_float(__float_as_uint(e) & (unsigned)m);
                    acc[r] = pe; lsum += pe;
                }
                p[kb] = acc;
            }
#pragma unroll
            for (int kb = 0; kb < 2; ++kb)
#pragma unroll
                for (int s = 0; s < 2; ++s) {
                    v4u pw; pw.x = pk2(p[kb][8 * s + 0], p[kb][8 * s + 1]); pw.y = pk2(p[kb][8 * s + 2], p[kb][8 * s + 3]); pw.z = pk2(p[kb][8 * s + 4], p[kb][8 * s + 5]); pw.w = pk2(p[kb][8 * s + 6], p[kb][8 * s + 7]);
                    const bf16x8 pa = __builtin_bit_cast(bf16x8, pw);
                    const unsigned rbase = vrd + (unsigned)((32 * kb + 16 * s) * 128);
#pragma unroll
                    for (int d0 = 0; d0 < 2; ++d0) {
                        const unsigned ad = rbase ^ (unsigned)(d0 << 6);
                        const s16x4 lo = __builtin_bit_cast(s16x4, __builtin_amdgcn_ds_read_tr16_b64_v4i16((LAS s16x4*)(Vs + ad)));
                        const s16x4 hi = __builtin_bit_cast(s16x4, __builtin_amdgcn_ds_read_tr16_b64_v4i16((LAS s16x4*)(Vs + ad + 8 * 128)));
                        const bf16x8 vb = (bf16x8){lo[0], lo[1], lo[2], lo[3], hi[0], hi[1], hi[2], hi[3]};
                        if (d0 == 0) o0 = __builtin_amdgcn_mfma_f32_32x32x16_bf16(pa, vb, o0, 0, 0, 0); else o1 = __builtin_amdgcn_mfma_f32_32x32x16_bf16(pa, vb, o1, 0, 0, 0);
                    }
                }
        }
    }
    lsum += __shfl_xor(lsum, 32);
    if (h2 == 0) wsf[l31] = lsum;
    LDS_WAIT(); asm volatile("" ::: "memory");
    bf16* op = ((bf16*)(F.ws + WS_PROJ)) + tok0 * LDP + Q_OFF + h * 64 + l31;
#pragma unroll
    for (int r = 0; r < 16; ++r) { const int q = crow(r, h2); const float rl = 1.0f / wsf[q];
        op[(size_t)q * LDP] = (bf16)f2bf(o0[r] * rl); op[(size_t)q * LDP + 32] = (bf16)f2bf(o1[r] * rl); }
    LDS_WAIT(); asm volatile("" ::: "memory");
}

__device__ __forceinline__ void route_wave(Frame& F, const Args& AR, size_t tokbase) {
    const int lane = F.lane; const size_t tok = tokbase + (lane >> 4); const int hp = lane & 15, half = hp & 1;
    const GAS v4u* rp = (const GAS v4u*)(((unsigned*)(F.ws + WS_PROJ)) + tok * 2048 + hp * 128);
    unsigned list[16];
#pragma unroll
    for (int i = 0; i < 16; ++i) list[i] = 0u;
#pragma unroll 4
    for (int c4 = 0; c4 < 32; ++c4) {
        const v4u kv = rp[c4];
#pragma unroll
        for (int e = 0; e < 4; ++e) { unsigned x = kv[e];
#pragma unroll
            for (int i = 0; i < 16; ++i) { const unsigned hi = list[i] > x ? list[i] : x; x = list[i] > x ? x : list[i]; list[i] = hi; } }
    }
    LAS unsigned* lk = (LAS unsigned*)F.lds;
#pragma unroll
    for (int i = 0; i < 16; ++i) lk[i * 512 + F.tid] = list[i];
    LDS_WAIT(); asm volatile("" ::: "memory");
    const int ta = F.tid & ~1, tb = F.tid | 1;
    unsigned ck[16], ce[16];
#pragma unroll
    for (int i = 0; i < 16; ++i) { ck[i] = 0u; ce[i] = 0u; }
#pragma unroll 1
    for (int i = 0; i < 16; ++i) {
        const unsigned ka = lk[i * 512 + ta];
        const float sai = unordk(ka & ~127u); const unsigned nai = (127u - (ka & 127u)) * 128u;
        const int njj = 16 / (i + 1);
#pragma unroll 1
        for (int j = 0; j < njj; ++j) {
            const unsigned kb = lk[j * 512 + tb];
            unsigned x = (ordk(sai + unordk(kb & ~127u)) & ~255u) | (unsigned)(255 - (i * 16 + j)); unsigned y = nai + (127u - (kb & 127u));
#pragma unroll
            for (int t = 0; t < 16; ++t) { const bool gt = x > ck[t]; const unsigned nk = gt ? x : ck[t], ne = gt ? y : ce[t]; x = gt ? ck[t] : x; y = gt ? ce[t] : y; ck[t] = nk; ce[t] = ne; }
        }
    }
    LDS_WAIT(); asm volatile("" ::: "memory");
    float ts[16]; float sum = 0.f; const float mx = unordk(ck[0] & ~255u);
#pragma unroll
    for (int t = 0; t < 16; ++t) { ts[t] = __builtin_amdgcn_exp2f((unordk(ck[t] & ~255u) - mx) * 1.4426950408889634f); sum += ts[t]; }
    const float inv = 1.0f / sum;
    if (half == 0) {
        GAS v4u* eo = (GAS v4u*)(((unsigned short*)(F.ws + WS_REXP)) + tok * 128 + (hp >> 1) * 16); GAS f32x4* go = (GAS f32x4*)(((float*)(F.ws + WS_RG)) + tok * 128 + (hp >> 1) * 16);
        eo[0] = (v4u){ce[0] | (ce[1] << 16), ce[2] | (ce[3] << 16), ce[4] | (ce[5] << 16), ce[6] | (ce[7] << 16)};
        eo[1] = (v4u){ce[8] | (ce[9] << 16), ce[10] | (ce[11] << 16), ce[12] | (ce[13] << 16), ce[14] | (ce[15] << 16)};
#pragma unroll
        for (int t4 = 0; t4 < 4; ++t4) go[t4] = (f32x4){ts[4 * t4] * inv, ts[4 * t4 + 1] * inv, ts[4 * t4 + 2] * inv, ts[4 * t4 + 3] * inv};
    }
}

__device__ __forceinline__ float gelu_erf(float v) {
    const float av = fabsf(v), t = __builtin_amdgcn_rcpf(av * 0.2316418882f + 1.0f);
    float q = t * 0.5307027145f + (-0.7265760135f); q = q * t + 0.7107068705f; q = q * t + (-0.142248368f); q = q * t + 0.127414796f; q = q * t;
    const float e = __builtin_amdgcn_exp2f((v * v) * (-0.72134752044f));
    const float m = v * (q * e);
    return v < 0.f ? m : v - m;
}
typedef __bf16 bf16x2v_t __attribute__((ext_vector_type(2)));
__device__ __forceinline__ float dot2bf(unsigned a, unsigned b, float acc) { return __builtin_amdgcn_fdot2_f32_bf16(__builtin_bit_cast(bf16x2v_t, a), __builtin_bit_cast(bf16x2v_t, b), acc, false); }
__device__ __forceinline__ float dpp_add(float v, float w_unused) { return v; }
#define DPP_ADD(v, ctrl) ((v) + __builtin_bit_cast(float, __builtin_amdgcn_update_dpp(0, __builtin_bit_cast(int, (v)), (ctrl), 0xf, 0xf, true)))
constexpr int NSL = 16;
constexpr int CW_PEER = 8192;
__device__ __forceinline__ unsigned id_of(const v4u a, const v4u b, int m) { const unsigned w = (m < 8) ? a[(m & 7) >> 1] : b[(m & 7) >> 1]; return (m & 1) ? (w >> 16) : (w & 0xffffu); }
__device__ __forceinline__ void peer_u_token(Frame& F, size_t tok, int s, const v4u ia, const v4u ib, const v4u hx) {
    const int lane = F.lane, g = lane >> 3, c = lane & 7;
    const bf16* ub = ((bf16*)(F.ws + WS_U16)) + 64 * s + 8 * c;
    v4u r[16];
#pragma unroll
    for (int m = 0; m < 16; ++m) r[m] = *(const GAS v4u*)(ub + (size_t)id_of(ia, ib, m) * 1024);
    float d[16];
#pragma unroll
    for (int m = 0; m < 16; ++m) { float a = dot2bf(r[m].x, hx.x, 0.f); a = dot2bf(r[m].y, hx.y, a); a = dot2bf(r[m].z, hx.z, a); a = dot2bf(r[m].w, hx.w, a);
        a = DPP_ADD(a, 0xB1); a = DPP_ADD(a, 0x4E); a = DPP_ADD(a, 0x141); d[m] = a; }
    if (c == 0) { GAS f32x4* po = (GAS f32x4*)(((float*)(F.ws + WS_PROJ)) + (tok * NSL + s) * 128 + 16 * g);
        po[0] = (f32x4){d[0], d[1], d[2], d[3]}; po[1] = (f32x4){d[4], d[5], d[6], d[7]}; po[2] = (f32x4){d[8], d[9], d[10], d[11]}; po[3] = (f32x4){d[12], d[13], d[14], d[15]}; }
}
__device__ __forceinline__ void peer_v_token(Frame& F, const Args& AR, size_t tok, int s, const v4u ia, const v4u ib, const f32x4 (&cf)[4]) {
    const int lane = F.lane, g = lane >> 3, c = lane & 7;
    const bf16* vb = ((bf16*)(F.ws + WS_V16)) + 64 * s + 8 * c;
    v4u r[16];
#pragma unroll
    for (int m = 0; m < 16; ++m) r[m] = *(const GAS v4u*)(vb + (size_t)id_of(ia, ib, m) * 1024);
    float acc[8];
#pragma unroll
    for (int j = 0; j < 8; ++j) acc[j] = 0.f;
#pragma unroll
    for (int m = 0; m < 16; ++m) { const float cm = cf[m >> 2][m & 3];
        acc[0] = fmaf(cm, bflo(r[m].x), acc[0]); acc[1] = fmaf(cm, bfhi(r[m].x), acc[1]); acc[2] = fmaf(cm, bflo(r[m].y), acc[2]); acc[3] = fmaf(cm, bfhi(r[m].y), acc[3]);
        acc[4] = fmaf(cm, bflo(r[m].z), acc[4]); acc[5] = fmaf(cm, bfhi(r[m].z), acc[5]); acc[6] = fmaf(cm, bflo(r[m].w), acc[6]); acc[7] = fmaf(cm, bfhi(r[m].w), acc[7]); }
#pragma unroll
    for (int j = 0; j < 8; ++j) { float a = acc[j]; a = DPP_ADD(a, 0x128); a += __shfl_xor(a, 16); a += __shfl_xor(a, 32); acc[j] = a; }
    if (g == 0) { GAS f32x4* op = (GAS f32x4*)((AR.out) + tok * 1024 + 64 * s + 8 * c);
        f32x4 h0 = op[0], h1 = op[1];
        h0.x += acc[0]; h0.y += acc[1]; h0.z += acc[2]; h0.w += acc[3]; h1.x += acc[4]; h1.y += acc[5]; h1.z += acc[6]; h1.w += acc[7];
        op[0] = h0; op[1] = h1; }
}
template <int SIDE> __device__ __forceinline__ void peer_side(Frame& F, const Args& AR) {
    gu32* cnt = F.ctl + CW_PEER + SIDE * 16 * 64;
    LAS int* sh = (LAS int*)F.lds;
    const unsigned xcc = xb_xcc_id() & 7u;
    const int lane = F.lane, g = lane >> 3, c = lane & 7;
    const unsigned short* idp = ((const unsigned short*)(F.ws + WS_REXP)) + 16 * g;
#pragma unroll 1
    for (int k = 0; k < 16; ++k) {
        const int s = (int)((xcc + 8u * (unsigned)(k & 1) + (unsigned)(k >> 1)) & 15u);
#pragma unroll 1
        for (;;) {
            __syncthreads();
            if (F.tid == 0) sh[0] = (int)__hip_atomic_fetch_add(cnt + 64 * s, 1u, RLX_AGENT);
            __syncthreads();
            const int blk = sh[0];
            if (blk >= MTOK / 128) break;
            const size_t t0 = (size_t)blk * 128 + F.wave * 16;
            v4u ia = *(const GAS v4u*)(idp + t0 * 128), ib = *(const GAS v4u*)(idp + t0 * 128 + 8);
            if (SIDE == 0) {
                v4u hx = *(const GAS v4u*)(((bf16*)(F.ws + WS_ACT)) + t0 * 1024 + 64 * s + 8 * c);
#pragma unroll 1
                for (int i = 0; i < 16; ++i) { const size_t tok = t0 + i, tn = t0 + ((i + 1) & 15);
                    const v4u na = *(const GAS v4u*)(idp + tn * 128), nb = *(const GAS v4u*)(idp + tn * 128 + 8), nh = *(const GAS v4u*)(((bf16*)(F.ws + WS_ACT)) + tn * 1024 + 64 * s + 8 * c);
                    peer_u_token(F, tok, s, ia, ib, hx); ia = na; ib = nb; hx = nh; }
            } else {
                const float* cfp = ((const float*)(F.ws + WS_RG)) + 16 * g;
                f32x4 cf[4];
#pragma unroll
                for (int q = 0; q < 4; ++q) cf[q] = *(const GAS f32x4*)(cfp + t0 * 128 + 4 * q);
#pragma unroll 1
                for (int i = 0; i < 16; ++i) { const size_t tok = t0 + i, tn = t0 + ((i + 1) & 15);
                    const v4u na = *(const GAS v4u*)(idp + tn * 128), nb = *(const GAS v4u*)(idp + tn * 128 + 8); f32x4 nc[4];
#pragma unroll
                    for (int q = 0; q < 4; ++q) nc[q] = *(const GAS f32x4*)(cfp + tn * 128 + 4 * q);
                    peer_v_token(F, AR, tok, s, ia, ib, cf); ia = na; ib = nb;
#pragma unroll
                    for (int q = 0; q < 4; ++q) cf[q] = nc[q]; }
            }
        }
    }
}
__device__ __forceinline__ void peer_coef_token(Frame& F, size_t tok) {
    const int lane = F.lane;
    const float* pp = ((const float*)(F.ws + WS_PROJ)) + tok * NSL * 128;
    float a0 = 0.f, a1 = 0.f;
#pragma unroll
    for (int s = 0; s < NSL; ++s) { a0 += pp[s * 128 + lane]; a1 += pp[s * 128 + 64 + lane]; }
    float* gp = ((float*)(F.ws + WS_RG)) + tok * 128;
    gp[lane] = gp[lane] * gelu_erf(a0); gp[64 + lane] = gp[64 + lane] * gelu_erf(a1);
}

__global__ void __launch_bounds__(NWAVES * 64, 2) mk_fwd(Args args) {
    extern __shared__ __attribute__((aligned(16))) unsigned char lds[];
    Frame F;
    F.lds = (LAS unsigned char*)lds;
    F.MISC = (volatile LAS unsigned*)(F.lds + MISC_OFF);
    F.tid = threadIdx.x; F.lane = F.tid & 63; F.wave = __builtin_amdgcn_readfirstlane(F.tid >> 6);
    F.G = gridDim.x; { const int bx = blockIdx.x; F.vcu = (F.G % 8 == 0) ? (bx % 8) * (F.G / 8) + bx / 8 : bx; }
    F.ws = args.ws;
    F.ctl = (gu32*)(F.ws + WS_CTL);
    const Args& AR = args;
    for (int u = F.tid; u < (LDS_BYTES - LDSCTL_OFF) / 4; u += NWAVES * 64) ((LAS unsigned*)(F.lds + LDSCTL_OFF))[u] = 0u;
    __syncthreads();
    XcdBarrier bar; bar.bar = (unsigned*)(F.ctl + CW_BAR); bar.x = 0; bar.st = nullptr;
#if !MK_PER_PHASE
    bar = xcd_barrier_post((unsigned*)(F.ctl + CW_BAR), F.MISC + 8);
#endif
    const int lo = args.ph_lo, hi = args.ph_hi;
#if defined(ONLY_PHASE)
#define IN(k) ((k) == ONLY_PHASE && lo <= (k) && (k) < hi)
#elif defined(PHASE_MASK)
#define IN(k) (((PHASE_MASK >> (k)) & 1) && lo <= (k) && (k) < hi)
#else
#define IN(k) (lo <= (k) && (k) < hi)
#endif
#if MK_PER_PHASE
#define SEAM(k) do { } while (0)
#else
#define SEAM(k) do { if (IN(k) && IN((k) + 1)) xcd_barrier(bar); } while (0)
#endif
#define FRESH() Frame P = F; { int t_ = threadIdx.x; asm volatile("" : "+v"(t_)); P.tid = t_; P.lane = t_ & 63; P.wave = __builtin_amdgcn_readfirstlane(t_ >> 6); } const int gw = P.vcu * NWAVES + P.wave, NGW = P.G * NWAVES; (void)gw; (void)NGW

    for (int rep_ = 0; rep_ < (((REPEAT_MASK >> 0) & 1) ? 2 : 1); ++rep_) if (IN(0)) { FRESH(); p0_prologue(P, args); } SEAM(0);
    for (int rep_ = 0; rep_ < (((REPEAT_MASK >> 1) & 1) ? 2 : 1); ++rep_) if (IN(1)) { pg8::Gemm g{((bf16*)(F.ws + WS_ACT)), ((bf16*)(F.ws + WS_WIN)), MTOK, LDP, 1024, 1024, 1024}; pg8::StaticOrder S; S.init(MTOK, LDP, F.G, (int)blockIdx.x);
        pg8::EpiStoreBf16 E{((bf16*)(F.ws + WS_PROJ)), LDP};
        pg8::gemm_phase<pg8::EpiStoreBf16, pg8::StaticOrder, true, true>(F.lds, g, S, E); } SEAM(1);
    if (IN(2)) { FRESH(); for (int m = gw; m < MTOK; m += NGW) fixup_token(P, args, m); } SEAM(2);
    for (int rep_ = 0; rep_ < (((REPEAT_MASK >> 3) & 1) ? 2 : 1); ++rep_) if (IN(3)) { FRESH(); for (int i = P.vcu; i < 256; i += P.G) { const int b = i >> 4, s = i & 15;
#pragma unroll 1
            for (int k = 0; k < 4; ++k) idx_unit(P, args, b, (k == 0) ? s : (k == 1) ? 31 - s : (k == 2) ? 32 + s : 63 - s); } } SEAM(3);
    if (IN(4)) { FRESH(); for (int i = P.vcu; i < 256; i += P.G) { const int bh = i >> 1, s = i & 1, b = bh >> 3, h = bh & 7;
#pragma unroll 1
            for (int k = 0; k < 8; ++k) attn_unit(P, args, b, h, (k & 1) ? 15 - (k >> 1) * 2 - s : (k >> 1) * 2 + s); } } SEAM(4);
    for (int rep_ = 0; rep_ < (((REPEAT_MASK >> 5) & 1) ? 2 : 1); ++rep_) if (IN(5)) { pg8::Gemm g{((bf16*)(F.ws + WS_PROJ)) + Q_OFF, ((bf16*)(F.ws + WS_WA)), MTOK, 1024, 512, LDP, 512}; pg8::StaticOrder S; S.init(MTOK, 1024, F.G, (int)blockIdx.x);
        pg8::EpiGate<false> E{((bf16*)(F.ws + WS_ACT)), 1024, ((bf16*)(F.ws + WS_PROJ)) + GA_OFF, LDP};
        pg8::gemm_phase<pg8::EpiGate<false>, pg8::StaticOrder, true, true>(F.lds, g, S, E); } SEAM(5);
    if (IN(6)) { pg8::Gemm g{((bf16*)(F.ws + WS_POOLED)), ((bf16*)(F.ws + WS_WPP)), MTOK, 1024, 512, 512, 512}; pg8::StaticOrder S; S.init(MTOK, 1024, F.G, (int)blockIdx.x);
                pg8::EpiGate<true> E{((bf16*)(F.ws + WS_ACT)), 1024, ((bf16*)(F.ws + WS_PROJ)) + GP_OFF, LDP};
        pg8::gemm_phase<pg8::EpiGate<true>, pg8::StaticOrder, true, true>(F.lds, g, S, E); } SEAM(6);
    for (int rep_ = 0; rep_ < (((REPEAT_MASK >> 7) & 1) ? 2 : 1); ++rep_) if (IN(7)) { pg8::Gemm g{((bf16*)(F.ws + WS_ACT)), ((bf16*)(F.ws + WS_WO)), MTOK, 1024, 1024, 1024, 1024}; pg8::StaticOrder S; S.init(MTOK, 1024, F.G, (int)blockIdx.x);
        pg8::EpiResF32 E{(AR.in[0]), (AR.out), 1024};
        pg8::gemm_phase<pg8::EpiResF32, pg8::StaticOrder, true, true>(F.lds, g, S, E); } SEAM(7);

    for (int rep_ = 0; rep_ < (((REPEAT_MASK >> 8) & 1) ? 2 : 1); ++rep_) if (IN(8)) { FRESH(); for (int m = gw; m < MTOK; m += NGW) rms_row_to_bf16((args.out) + (size_t)m * DM, (args.in[10]), ((bf16*)(P.ws + WS_ACT)) + (size_t)m * DM, P.lane); } SEAM(8);
    for (int rep_ = 0; rep_ < (((REPEAT_MASK >> 9) & 1) ? 2 : 1); ++rep_) if (IN(9)) { pg8::Gemm g{((bf16*)(F.ws + WS_ACT)), ((bf16*)(F.ws + WS_W2)), MTOK, 2048, 1024, 1024, 1024}; pg8::StaticOrder S; S.init(MTOK, 2048, F.G, (int)blockIdx.x);
        pg8::EpiKeys E{((unsigned*)(F.ws + WS_PROJ)), 2048};
        pg8::gemm_phase<pg8::EpiKeys, pg8::StaticOrder, true, true>(F.lds, g, S, E); } SEAM(9);
    for (int rep_ = 0; rep_ < (((REPEAT_MASK >> 10) & 1) ? 2 : 1); ++rep_) if (IN(10)) { FRESH(); for (int m4 = gw; m4 < MTOK / 4; m4 += NGW) route_wave(P, args, (size_t)m4 * 4); } SEAM(10);
        if (IN(11)) { FRESH(); peer_side<0>(P, args); } SEAM(11);
    if (IN(12)) { FRESH(); for (int m = gw; m < MTOK; m += NGW) peer_coef_token(P, (size_t)m); } SEAM(12);
    if (IN(13)) { FRESH(); peer_side<1>(P, args); }

#undef IN
#undef SEAM
}

extern "C" void kernel_launch(void* const* d_in, const int* in_sizes, int n_in, void* d_out, int out_size, void* d_ws, size_t ws_size, hipStream_t stream) {
    static int grid = 0;
    if (grid == 0) {
        if (n_in != 15 || in_sizes[0] != MTOK * DM || out_size != MTOK * DM || ws_size < WS_END) { fprintf(stderr, "kernel_launch: unexpected shapes (n_in %d, in0 %d, out %d, ws %zu < %zu)\n", n_in, n_in > 0 ? in_sizes[0] : -1, out_size, ws_size, (size_t)WS_END); grid = -1; return; }
        int dev = 0, cus = 0, per_cu = 0;
        if (hipGetDevice(&dev) != hipSuccess || hipDeviceGetAttribute(&cus, hipDeviceAttributeMultiprocessorCount, dev) != hipSuccess) { grid = -1; return; }
        if (hipFuncSetAttribute((const void*)mk_fwd, hipFuncAttributeMaxDynamicSharedMemorySize, LDS_BYTES) != hipSuccess) { fprintf(stderr, "kernel_launch: hipFuncSetAttribute failed\n"); grid = -1; return; }
        if (hipOccupancyMaxActiveBlocksPerMultiprocessor(&per_cu, (const void*)mk_fwd, NWAVES * 64, LDS_BYTES) != hipSuccess || per_cu < 1) { fprintf(stderr, "kernel_launch: occupancy query says %d blocks per CU\n", per_cu); (void)hipGetLastError(); grid = -1; return; }
        grid = cus;
    }
    if (grid < 0) return;
    if (hipMemsetAsync((char*)d_ws + WS_CTL, 0, CTL_ZERO_BYTES, stream) != hipSuccess) return;
    Args a{};
    for (int i = 0; i < 15; ++i) a.in[i] = (const float*)d_in[i];
    a.out = (float*)d_out; a.ws = (unsigned char*)d_ws;
#if MK_PER_PHASE
    for (int p = 0; p < NPHASE; ++p) { a.ph_lo = p; a.ph_hi = p + 1; hipLaunchKernelGGL(mk_fwd, dim3(grid), dim3(NWAVES * 64), LDS_BYTES, stream, a); }
#else
    a.ph_lo = 0; a.ph_hi = NPHASE;
    hipLaunchKernelGGL(mk_fwd, dim3(grid), dim3(NWAVES * 64), LDS_BYTES, stream, a);
#endif
}
```

```cpp
#include <hip/hip_runtime.h>
#include <cstdio>
#include <cstdint>
namespace pg8 {
#define PG8_LAS __attribute__((address_space(3)))
typedef unsigned short bf16_t;
typedef short bf16x8 __attribute__((ext_vector_type(8)));
typedef float f32x4 __attribute__((ext_vector_type(4)));
typedef unsigned u32x4 __attribute__((ext_vector_type(4)));
constexpr int BM = 256, BK = 64, HALF = 128, HTB = HALF * BK * 2  , STAGE_BYTES = 8 * HTB, NXCD = 8, WGM = 8;

__host__ __device__ __forceinline__ int lds_byte(int r, int c) { const int st = (r >> 4) * 2 + (c >> 5), rr = r & 15, cc = c & 31, ob = rr * 64 + cc * 2; return st * 1024 + (ob ^ (((ob >> 9) & 1) << 5)); }
__host__ __device__ __forceinline__ void stage_rc(int b, int& R, int& C) { const int st = b / 1024, sb = b % 1024, swz = sb ^ (((sb >> 9) & 1) << 5); R = (st >> 1) * 16 + swz / 64; C = (st & 1) * 32 + (swz % 64) / 2; }
__host__ __device__ __forceinline__ int perm32(int rho) { const int n = rho >> 4, i = rho & 15; return 8 * (i >> 2) + 4 * n + (i & 3); }

struct Unit { int pm, pn; };
struct Gemm { const bf16_t* A; const bf16_t* Bt; int M, N, K, lda, ldb; };

struct StaticOrder {
    int nM, nN, nwg, G, c;
    __host__ __device__ void init(int M, int N, int G_, int c_) { nM = M / BM; nN = N / BM; nwg = nM * nN; G = G_; c = c_; }
    __host__ __device__ bool next(int i, Unit& u) const {
        const long L = (long)i * G + c; if (L >= nwg) return false;
        int wgid = (int)L; { const int q = nwg / NXCD, r = nwg % NXCD, xcd = wgid % NXCD, off = wgid / NXCD; wgid = (xcd < r ? xcd * (q + 1) : r * (q + 1) + (xcd - r) * q) + off; }
        const int nig = WGM * nN, gid = wgid / nig, fm = gid * WGM, gsz = (nM - fm) < WGM ? (nM - fm) : WGM;
        u.pm = fm + ((wgid % nig) % gsz); u.pn = (wgid % nig) / gsz; return true;
    }
    __device__ __forceinline__ void a_ready(const Unit&) const {}
    __device__ __forceinline__ void done(const Unit&) const {}
};
typedef float f32x2c_t __attribute__((ext_vector_type(2))); typedef __bf16 bf16x2c_t __attribute__((ext_vector_type(2)));
__device__ __forceinline__ unsigned cvt_pk_bf16(float lo, float hi) { f32x2c_t v = {lo, hi}; bf16x2c_t b = __builtin_convertvector(v, bf16x2c_t); return __builtin_bit_cast(unsigned, b); }
typedef float f32x2 __attribute__((ext_vector_type(2)));
__device__ __forceinline__ f32x2 gelu_pk(f32x2 v) {
    const f32x2 av = __builtin_elementwise_abs(v), d = av * 0.2316418882f + 1.0f;
    f32x2 t; t.x = __builtin_amdgcn_rcpf(d.x); t.y = __builtin_amdgcn_rcpf(d.y);
    f32x2 q = t * 0.5307027145f + (-0.7265760135f); q = q * t + 0.7107068705f; q = q * t + (-0.142248368f); q = q * t + 0.127414796f; q = q * t;
    const f32x2 s = (v * v) * (-0.72134752044f);
    f32x2 e; e.x = __builtin_amdgcn_exp2f(s.x); e.y = __builtin_amdgcn_exp2f(s.y);
    const f32x2 m = v * (q * e), r = v - m;
    f32x2 o; o.x = v.x < 0.f ? m.x : r.x; o.y = v.y < 0.f ? m.y : r.y; return o;
}
__device__ __forceinline__ float bf_lo(unsigned w) { return __uint_as_float(w << 16); }
__device__ __forceinline__ float bf_hi(unsigned w) { return __uint_as_float(w & 0xffff0000u); }
__device__ __forceinline__ float sigmoidf_fast(float g) { return __builtin_amdgcn_rcpf(1.0f + __builtin_amdgcn_exp2f(-1.4426950408889634f * g)); }
__device__ __forceinline__ unsigned ord_key(float f) { const unsigned b = __float_as_uint(f); return b ^ ((unsigned)((int)b >> 31) | 0x80000000u); }
__device__ __forceinline__ float unord_key(unsigned k) { return __uint_as_float((k & 0x80000000u) ? (k ^ 0x80000000u) : ~k); }

struct EpiStoreBf16 {
    static constexpr bool PERM = true, AFTER_DRAIN = false;
    bf16_t* O; int ldc;
    __device__ __forceinline__ void operator()(const f32x4 (&acc)[2][2][4][2], const Unit& u, int wr, int wc, int fr, int fq) const {
        const int row0 = u.pm * BM + wr * 64 + fr, col0 = u.pn * BM + wc * 32 + 8 * fq;
#pragma unroll
        for (int ai = 0; ai < 2; ++ai)
#pragma unroll
            for (int m = 0; m < 4; ++m) { bf16_t* rowp = O + (size_t)(row0 + ai * HALF + m * 16) * ldc + col0;
#pragma unroll
                for (int bj = 0; bj < 2; ++bj) { const f32x4 v0 = acc[ai][bj][m][0], v1 = acc[ai][bj][m][1];
                    u32x4 w; w.x = cvt_pk_bf16(v0[0], v0[1]); w.y = cvt_pk_bf16(v0[2], v0[3]); w.z = cvt_pk_bf16(v1[0], v1[1]); w.w = cvt_pk_bf16(v1[2], v1[3]);
                    *(u32x4*)(rowp + bj * HALF) = w; } }
    }
};
template <bool ADD> struct EpiGate {
    static constexpr bool PERM = true, AFTER_DRAIN = false;
    bf16_t* O; int ldc; const bf16_t* G; int ldg;
    __device__ __forceinline__ void operator()(const f32x4 (&acc)[2][2][4][2], const Unit& u, int wr, int wc, int fr, int fq) const {
        const int row0 = u.pm * BM + wr * 64 + fr, col0 = u.pn * BM + wc * 32 + 8 * fq;
#pragma unroll
        for (int ai = 0; ai < 2; ++ai)
#pragma unroll
            for (int m = 0; m < 4; ++m) { const size_t row = (size_t)(row0 + ai * HALF + m * 16);
#pragma unroll
                for (int bj = 0; bj < 2; ++bj) { const int col = col0 + bj * HALF;
                    const u32x4 gr = *(const u32x4*)(G + row * ldg + col);
                    f32x4 v0 = acc[ai][bj][m][0], v1 = acc[ai][bj][m][1];
                    v0[0] *= sigmoidf_fast(bf_lo(gr.x)); v0[1] *= sigmoidf_fast(bf_hi(gr.x)); v0[2] *= sigmoidf_fast(bf_lo(gr.y)); v0[3] *= sigmoidf_fast(bf_hi(gr.y));
                    v1[0] *= sigmoidf_fast(bf_lo(gr.z)); v1[1] *= sigmoidf_fast(bf_hi(gr.z)); v1[2] *= sigmoidf_fast(bf_lo(gr.w)); v1[3] *= sigmoidf_fast(bf_hi(gr.w));
                    bf16_t* op = O + row * ldc + col;
                    if (ADD) { const u32x4 pr = *(const u32x4*)op;
                        v0[0] += bf_lo(pr.x); v0[1] += bf_hi(pr.x); v0[2] += bf_lo(pr.y); v0[3] += bf_hi(pr.y);
                        v1[0] += bf_lo(pr.z); v1[1] += bf_hi(pr.z); v1[2] += bf_lo(pr.w); v1[3] += bf_hi(pr.w); }
                    u32x4 w; w.x = cvt_pk_bf16(v0[0], v0[1]); w.y = cvt_pk_bf16(v0[2], v0[3]); w.z = cvt_pk_bf16(v1[0], v1[1]); w.w = cvt_pk_bf16(v1[2], v1[3]);
                    *(u32x4*)op = w; } }
    }
};
struct EpiResF32 {
    static constexpr bool PERM = false, AFTER_DRAIN = false;
    const float* base; float* out; int ldc;
    __device__ __forceinline__ void operator()(const f32x4 (&acc)[2][2][4][2], const Unit& u, int wr, int wc, int fr, int fq) const {
        const int col0 = u.pn * BM + wc * 32 + 4 * fq;
#pragma unroll
        for (int ai = 0; ai < 2; ++ai)
#pragma unroll
            for (int m = 0; m < 4; ++m) { const size_t off = (size_t)(u.pm * BM + ai * HALF + wr * 64 + m * 16 + fr) * ldc + col0;
#pragma unroll
                for (int bj = 0; bj < 2; ++bj)
#pragma unroll
                    for (int n = 0; n < 2; ++n) { const f32x4 bs = *(const f32x4*)(base + off + bj * HALF + n * 16); *(f32x4*)(out + off + bj * HALF + n * 16) = bs + acc[ai][bj][m][n]; } }
    }
};
struct EpiKeys {
    static constexpr bool PERM = false, AFTER_DRAIN = false;
    unsigned* O; int ldc;
    __device__ __forceinline__ void operator()(const f32x4 (&acc)[2][2][4][2], const Unit& u, int wr, int wc, int fr, int fq) const {
        const int col0 = u.pn * BM + wc * 32 + 4 * fq;
#pragma unroll
        for (int ai = 0; ai < 2; ++ai)
#pragma unroll
            for (int m = 0; m < 4; ++m) { const size_t off = (size_t)(u.pm * BM + ai * HALF + wr * 64 + m * 16 + fr) * ldc + col0;
#pragma unroll
                for (int bj = 0; bj < 2; ++bj)
#pragma unroll
                    for (int n = 0; n < 2; ++n) { const int nn = (col0 + bj * HALF + n * 16) & 127; const f32x4 a = acc[ai][bj][m][n]; u32x4 w;
                        w.x = (ord_key(a[0]) & ~127u) | (unsigned)(127 - nn); w.y = (ord_key(a[1]) & ~127u) | (unsigned)(126 - nn);
                        w.z = (ord_key(a[2]) & ~127u) | (unsigned)(125 - nn); w.w = (ord_key(a[3]) & ~127u) | (unsigned)(124 - nn);
                        *(u32x4*)(O + off + bj * HALF + n * 16) = w; } }
    }
};

template <class Epi, class Sched, bool ALIGN_EPI = false, bool SP2 = false>
__device__ __forceinline__ void gemm_phase(PG8_LAS unsigned char* lds, const Gemm g, const Sched& S, const Epi& E) {
    int tid_ = threadIdx.x; asm volatile("" : "+v"(tid_));
    const int tid = tid_, wid = __builtin_amdgcn_readfirstlane(tid >> 6), lane = tid & 63, wr = wid >> 2, wc = wid & 3, fr = lane & 15, fq = lane >> 4;
    const int K = g.K, nt = K / BK;
    unsigned voffA[2], voffB[2];
#pragma unroll
    for (int i = 0; i < 2; ++i) { int R, C; stage_rc(tid * 16 + i * 8192, R, C); const int Rb = Epi::PERM ? ((R & ~31) + perm32(R & 31)) : R;
        voffA[i] = (unsigned)(R * g.lda + C) * 2u; voffB[i] = (unsigned)(Rb * g.ldb + C) * 2u; }
    const size_t kstep = (size_t)(BK * 2);
    const size_t hstepA = (size_t)HALF * g.lda * 2, hstepB = (size_t)HALF * g.ldb * 2;
    const size_t tstepA = 2 * hstepA, tstepB = 2 * hstepB;
    const unsigned ldsw = (unsigned)wid * 1024u;
    const int aoff = lds_byte(wr * 64 + fr, fq * 8), boff = lds_byte(wc * 32 + fr, fq * 8);
#define PG8_SA(b, h) (((b) * 2 + (h)) * HTB)
#define PG8_SB(b, h) ((4 + (b) * 2 + (h)) * HTB)
#define PG8_STAGE(bufoff, gbase, voff) do { _Pragma("unroll") for (int _i = 0; _i < 2; ++_i) \
        __builtin_amdgcn_global_load_lds((const unsigned*)((const char*)(gbase) + (voff)[_i]), (PG8_LAS unsigned*)(lds + (bufoff) + ldsw + _i * 8192), 16, 0, 0); } while (0)
#define PG8_LDA(dst, b, h) do { _Pragma("unroll") for (int m = 0; m < 4; ++m) _Pragma("unroll") for (int k = 0; k < 2; ++k) dst[m][k] = *(const PG8_LAS bf16x8*)(lds + PG8_SA(b, h) + aoff + m * 2048 + k * 1024); } while (0)
#define PG8_LDB(dst, b, h) do { _Pragma("unroll") for (int n = 0; n < 2; ++n) _Pragma("unroll") for (int k = 0; k < 2; ++k) dst[n][k] = *(const PG8_LAS bf16x8*)(lds + PG8_SB(b, h) + boff + n * 2048 + k * 1024); } while (0)
#define PG8_MMA(ai, bj, At, Bt) do { __builtin_amdgcn_s_setprio(1); _Pragma("unroll") for (int m = 0; m < 4; ++m) _Pragma("unroll") for (int n = 0; n < 2; ++n) _Pragma("unroll") for (int k = 0; k < 2; ++k) \
        acc[ai][bj][m][n] = __builtin_amdgcn_mfma_f32_16x16x32_bf16(Bt[n][k], At[m][k], acc[ai][bj][m][n], 0, 0, 0); __builtin_amdgcn_s_setprio(0); } while (0)
#define PG8_WAIT_V(n) asm volatile("s_waitcnt vmcnt(" #n ")" ::: "memory")
#define PG8_WAIT_L(n) asm volatile("s_waitcnt lgkmcnt(" #n ")" ::: "memory")
#define PG8_BAR __builtin_amdgcn_s_barrier()
#define PG8_SCHED __builtin_amdgcn_sched_barrier(0)
    Unit cur, nxt; int ui = 0;
    if (!S.next(0, cur)) return;
    f32x4 acc[2][2][4][2];
#pragma unroll
    for (int a = 0; a < 2; ++a)
#pragma unroll
        for (int b = 0; b < 2; ++b)
#pragma unroll
            for (int m = 0; m < 4; ++m)
#pragma unroll
                for (int n = 0; n < 2; ++n) acc[a][b][m][n] = (f32x4){0.f, 0.f, 0.f, 0.f};
    bf16x8 At[4][2], B0[2][2], B1[2][2];
    const char* cA = (const char*)g.A + (size_t)cur.pm * tstepA; const char* cB = (const char*)g.Bt + (size_t)cur.pn * tstepB;
    S.a_ready(cur);
    if constexpr (SP2) {
        PG8_STAGE(PG8_SB(0, 0), cB, voffB); PG8_STAGE(PG8_SB(0, 1), cB + hstepB, voffB); PG8_STAGE(PG8_SA(0, 0), cA, voffA); PG8_STAGE(PG8_SA(0, 1), cA + hstepA, voffA);
        if (wr == 1) PG8_BAR;
        PG8_WAIT_V(2); PG8_BAR;
        PG8_STAGE(PG8_SB(1, 0), cB + kstep, voffB); PG8_STAGE(PG8_SA(1, 0), cA + kstep, voffA); PG8_STAGE(PG8_SB(1, 1), cB + hstepB + kstep, voffB);
        PG8_WAIT_V(6); PG8_BAR;
    } else {
        PG8_STAGE(PG8_SB(0, 0), cB, voffB); PG8_STAGE(PG8_SA(0, 0), cA, voffA); PG8_STAGE(PG8_SB(0, 1), cB + hstepB, voffB); PG8_STAGE(PG8_SA(0, 1), cA + hstepA, voffA);
        if (wr == 1) PG8_BAR;
        PG8_WAIT_V(4); PG8_BAR;
        PG8_STAGE(PG8_SB(1, 0), cB + kstep, voffB); PG8_STAGE(PG8_SA(1, 0), cA + kstep, voffA); PG8_STAGE(PG8_SB(1, 1), cB + hstepB + kstep, voffB);
        PG8_WAIT_V(6); PG8_BAR;
    }
    for (;;) {
        const bool has_next = S.next(ui + 1, nxt);
        const char* nA = has_next ? (const char*)g.A + (size_t)nxt.pm * tstepA : cA; const char* nB = has_next ? (const char*)g.Bt + (size_t)nxt.pn * tstepB : cB;
        for (int t = 0; t < nt; t += 2) {
            const bool last = (t == nt - 2);
            const char* a1 = cA + (size_t)(t + 1) * kstep;
            const char* a2 = last ? nA : cA + (size_t)(t + 2) * kstep; const char* b2 = last ? nB : cB + (size_t)(t + 2) * kstep;
            const char* a3 = a2 + kstep; const char* b3 = b2 + kstep;
            if (last && has_next) S.a_ready(nxt);
            if constexpr (SP2) {
            PG8_LDB(B0, 0, 0); PG8_LDB(B1, 0, 1); PG8_SCHED; PG8_LDA(At, 0, 0); PG8_STAGE(PG8_SA(1, 1), a1 + hstepA, voffA);
            PG8_WAIT_V(8); PG8_WAIT_L(0); PG8_BAR; PG8_MMA(0, 0, At, B0); PG8_MMA(0, 1, At, B1); PG8_BAR; PG8_SCHED;
            PG8_LDA(At, 0, 1); PG8_STAGE(PG8_SB(0, 0), b2, voffB); PG8_STAGE(PG8_SB(0, 1), b2 + hstepB, voffB); PG8_STAGE(PG8_SA(0, 0), a2, voffA);
            PG8_WAIT_V(8); PG8_WAIT_L(0); PG8_BAR; PG8_MMA(1, 0, At, B0); PG8_MMA(1, 1, At, B1); PG8_BAR; PG8_SCHED;
            PG8_LDB(B0, 1, 0); PG8_LDB(B1, 1, 1); PG8_SCHED; PG8_LDA(At, 1, 0); PG8_STAGE(PG8_SA(0, 1), a2 + hstepA, voffA);
            PG8_WAIT_V(8); PG8_WAIT_L(0); PG8_BAR; PG8_MMA(0, 0, At, B0); PG8_MMA(0, 1, At, B1); PG8_BAR; PG8_SCHED;
            PG8_LDA(At, 1, 1); PG8_STAGE(PG8_SB(1, 0), b3, voffB); PG8_STAGE(PG8_SB(1, 1), b3 + hstepB, voffB); PG8_STAGE(PG8_SA(1, 0), a3, voffA);
            PG8_WAIT_V(8); PG8_WAIT_L(0); PG8_BAR; PG8_MMA(1, 0, At, B0); PG8_MMA(1, 1, At, B1); PG8_BAR; PG8_SCHED;
            } else {
            PG8_LDB(B0, 0, 0); PG8_SCHED; PG8_LDA(At, 0, 0); PG8_STAGE(PG8_SA(1, 1), a1 + hstepA, voffA);
            PG8_WAIT_L(8); PG8_BAR; PG8_WAIT_L(0); PG8_MMA(0, 0, At, B0); PG8_BAR; PG8_SCHED;
            PG8_LDB(B1, 0, 1); PG8_STAGE(PG8_SB(0, 0), b2, voffB);
            PG8_BAR; PG8_WAIT_L(0); PG8_MMA(0, 1, At, B1); PG8_BAR;
            PG8_LDA(At, 0, 1); PG8_STAGE(PG8_SA(0, 0), a2, voffA);
            PG8_BAR; PG8_WAIT_L(0); PG8_MMA(1, 0, At, B0); PG8_BAR; PG8_SCHED;
            PG8_STAGE(PG8_SB(0, 1), b2 + hstepB, voffB);
            PG8_WAIT_V(6); PG8_BAR; PG8_MMA(1, 1, At, B1); PG8_BAR;
            PG8_LDB(B0, 1, 0); PG8_SCHED; PG8_LDA(At, 1, 0); PG8_STAGE(PG8_SA(0, 1), a2 + hstepA, voffA);
            PG8_WAIT_L(8); PG8_BAR; PG8_WAIT_L(0); PG8_MMA(0, 0, At, B0); PG8_BAR; PG8_SCHED;
            PG8_LDB(B1, 1, 1); PG8_STAGE(PG8_SB(1, 0), b3, voffB);
            PG8_BAR; PG8_WAIT_L(0); PG8_MMA(0, 1, At, B1); PG8_BAR;
            PG8_LDA(At, 1, 1); PG8_STAGE(PG8_SA(1, 0), a3, voffA);
            PG8_BAR; PG8_WAIT_L(0); PG8_MMA(1, 0, At, B0); PG8_BAR; PG8_SCHED;
            PG8_STAGE(PG8_SB(1, 1), b3 + hstepB, voffB);
            PG8_WAIT_V(6); PG8_BAR; PG8_MMA(1, 1, At, B1); PG8_BAR;
            }
        }
        if constexpr (ALIGN_EPI) { if (wr == 0) PG8_BAR; }
        if constexpr (!Epi::AFTER_DRAIN) { E(acc, cur, wr, wc, fr, fq); S.done(cur); }
        if (!has_next) break;
#pragma unroll
        for (int a = 0; a < 2; ++a)
#pragma unroll
            for (int b = 0; b < 2; ++b)
#pragma unroll
                for (int m = 0; m < 4; ++m)
#pragma unroll
                    for (int n = 0; n < 2; ++n) acc[a][b][m][n] = (f32x4){0.f, 0.f, 0.f, 0.f};
        cur = nxt; cA = nA; cB = nB; ++ui;
        if constexpr (ALIGN_EPI) { if (wr == 1) PG8_BAR; }
    }
    PG8_WAIT_V(0);
    if constexpr (!ALIGN_EPI) { if (wr == 0) PG8_BAR; }
    PG8_BAR;
    if constexpr (Epi::AFTER_DRAIN) { E.fused(acc, cur, wr, wc, fr, fq, lds, wid, lane); S.done(cur); }
#undef PG8_SA
#undef PG8_SB
#undef PG8_STAGE
#undef PG8_LDA
#undef PG8_LDB
#undef PG8_MMA
#undef PG8_WAIT_V
#undef PG8_WAIT_L
#undef PG8_BAR
#undef PG8_SCHED
}
}

constexpr int NWAVES = 8;
#ifndef REPEAT_MASK
#define REPEAT_MASK 0
#endif
#ifndef MK_PER_PHASE
#define MK_PER_PHASE 0
#endif
constexpr int NPHASE = 14;

constexpr int BATCH = 16, SEQ = 4096, DM = 1024, MTOK = BATCH * SEQ;
constexpr int LDP = 4864;
constexpr int Q_OFF = 0, K_OFF = 512, V_OFF = 1024, QI_OFF = 1536, P_OFF = 2048, GA_OFF = 2560, GP_OFF = 3584, KI_OFF = 4608, WI_OFF = 4672;
constexpr int IN_WIDTH = 4680;
constexpr float EPS = 1e-6f;
constexpr float C2 = 0.125f * 1.4426950408889634f;
constexpr float WI_SCALE = 0.35355339059327373f * 0.125f;

constexpr size_t MiB = 1u << 20;
constexpr size_t WS_CTL = 0, CTL_ZERO_BYTES = 1 * MiB;
constexpr size_t WS_ROPE = 1 * MiB;
constexpr size_t WS_WIN = 2 * MiB;
constexpr size_t WS_WA = 12 * MiB;
constexpr size_t WS_WPP = 13 * MiB;
constexpr size_t WS_WO = 14 * MiB;
constexpr size_t WS_W2 = 16 * MiB;
constexpr size_t WS_U16 = 20 * MiB, WS_V16 = 52 * MiB;
constexpr size_t WS_MASK = 84 * MiB;
constexpr size_t WS_POOLED = 116 * MiB;
constexpr size_t WS_ACT = 180 * MiB;
constexpr size_t WS_PROJ = 308 * MiB;
constexpr size_t WS_REXP = 916 * MiB, WS_RG = 948 * MiB;
constexpr size_t WS_END = 980 * MiB;
constexpr int CW_TMO = 0, CW_BAR = 4096, CW_AMAX = 12288;

constexpr int RING_BYTES = 131072;
constexpr int LDSCTL_OFF = RING_BYTES, MISC_OFF = LDSCTL_OFF + 320;
constexpr int LDS_BYTES = 147456;

#define GAS __attribute__((address_space(1)))
#define LAS __attribute__((address_space(3)))
typedef unsigned short bf16;
typedef unsigned v4u __attribute__((ext_vector_type(4)));
typedef unsigned v2u __attribute__((ext_vector_type(2)));
typedef float f32x4 __attribute__((ext_vector_type(4)));
typedef float f32x16 __attribute__((ext_vector_type(16)));
typedef short bf16x8 __attribute__((ext_vector_type(8)));
typedef short s16x4 __attribute__((ext_vector_type(4)));
typedef GAS unsigned gu32;
#define RLX_AGENT __ATOMIC_RELAXED, __HIP_MEMORY_SCOPE_AGENT
#define LDS_WAIT() asm volatile("s_waitcnt lgkmcnt(0)" ::: "memory")
#define VM_WAIT() asm volatile("s_waitcnt vmcnt(0)" ::: "memory")
__device__ __forceinline__ unsigned f2bf(float f) { unsigned u = __builtin_bit_cast(unsigned, f); return (u + 0x7fffu + ((u >> 16) & 1u)) >> 16; }
__device__ __forceinline__ unsigned pk2(float lo, float hi) { return f2bf(lo) | (f2bf(hi) << 16); }
__device__ __forceinline__ float bflo(unsigned w) { return __uint_as_float(w << 16); }
__device__ __forceinline__ float bfhi(unsigned w) { return __uint_as_float(w & 0xffff0000u); }
__device__ __forceinline__ unsigned ordk(float f) { const unsigned b = __float_as_uint(f); return b ^ ((unsigned)((int)b >> 31) | 0x80000000u); }
__device__ __forceinline__ float unordk(unsigned k) { return __uint_as_float((k & 0x80000000u) ? (k ^ 0x80000000u) : ~k); }
__device__ __forceinline__ int crow(int r, int hi) { return (r & 3) + 8 * (r >> 2) + 4 * hi; }

#define XB_TMO      128
#define XB_XCNT(j)  (256  + 64 * (j))
#define XB_XSUB(j)  (1280 + 64 * (j))
#define XB_XGEN(j)  (2304 + 64 * (j))
#define XB_TOP      3328
#define XB_TOPGEN   3392
#define XCD_BAR_WORDS 3456
#define XB_SPIN_CAP (1u << 18)

__device__ __forceinline__ unsigned xb_ld(unsigned* p)              { return __hip_atomic_load(p, __ATOMIC_RELAXED, __HIP_MEMORY_SCOPE_AGENT); }
__device__ __forceinline__ unsigned xb_add(unsigned* p, unsigned v) { return __hip_atomic_fetch_add(p, v, __ATOMIC_RELAXED, __HIP_MEMORY_SCOPE_AGENT); }
__device__ __forceinline__ unsigned xb_xcc_id() { return (unsigned)__builtin_amdgcn_s_getreg((3 << 11) | 20) & 0xFu; }
#define XB_SPIN(cond, bar) do { unsigned _sp = 0; while (cond) { __builtin_amdgcn_s_sleep(1); \
    if ((++_sp & 255u) == 0u) { if (xb_ld(&(bar)[XB_TMO])) break; if (_sp > XB_SPIN_CAP) { atomicAdd(&(bar)[XB_TMO], 1u); break; } } } } while (0)

struct XcdBarrier {
    unsigned* bar; unsigned x;
    volatile LAS unsigned* st;
};

__device__ __forceinline__ XcdBarrier xcd_barrier_post(unsigned* bar, volatile LAS unsigned* st) {
    XcdBarrier b; b.bar = bar; b.x = xb_xcc_id(); b.st = st;
    if (threadIdx.x == 0) (void)xb_add(&bar[XB_XCNT(b.x)], 1u);
    return b;
}
__device__ __forceinline__ void xcd_barrier_complete(unsigned* bar, unsigned x, unsigned& nloc, unsigned& nx) {
    const unsigned G = gridDim.x * gridDim.y * gridDim.z;
    unsigned sum, cnt, mine, sp = 0u;
    for (;;) {
        sum = 0u; cnt = 0u; mine = 0u;
#pragma unroll
        for (unsigned j = 0; j < 16; ++j) { const unsigned c = xb_ld(&bar[XB_XCNT(j)]); sum += c; cnt += (c > 0u) ? 1u : 0u; mine = (j == x) ? c : mine; }
        if (sum == G) break;
        __builtin_amdgcn_s_sleep(1);
        if ((++sp & 255u) == 0u) { if (xb_ld(&bar[XB_TMO])) break; if (sp > XB_SPIN_CAP) { atomicAdd(&bar[XB_TMO], 1u); break; } }
    }
    nloc = mine > 0u ? mine : 1u; nx = cnt > 0u ? cnt : 1u;
}

__device__ __forceinline__ void xcd_barrier(const XcdBarrier& b) {
    asm volatile("s_waitcnt vmcnt(0)" ::: "memory");
    __syncthreads();
    if (threadIdx.x == 0) {
        unsigned* bar = b.bar;
        __builtin_amdgcn_s_waitcnt(0);
        unsigned nloc = b.st[0], nx = b.st[1];
        if (nloc == 0u) { xcd_barrier_complete(bar, b.x, nloc, nx); b.st[0] = nloc; b.st[1] = nx; }
        const unsigned old = xb_add(&bar[XB_XSUB(b.x)], 1u);
        const unsigned gen = old / nloc;
        if (old + 1u == (gen + 1u) * nloc) {
            __builtin_amdgcn_fence(__ATOMIC_RELEASE, "agent");
            asm volatile("s_waitcnt vmcnt(0)" ::: "memory");
            const unsigned og = xb_add(&bar[XB_TOP], 1u);
            const unsigned tg = og / nx;
            if (og + 1u == (tg + 1u) * nx) xb_add(&bar[XB_TOPGEN], 1u);
            else XB_SPIN(xb_ld(&bar[XB_TOPGEN]) == tg, bar);
            __builtin_amdgcn_fence(__ATOMIC_ACQUIRE, "agent");
            xb_add(&bar[XB_XGEN(b.x)], 1u);
            asm volatile("s_waitcnt vmcnt(0)" ::: "memory");
        } else {
            XB_SPIN(xb_ld(&bar[XB_XGEN(b.x)]) == gen, bar);
            __builtin_amdgcn_fence(__ATOMIC_ACQUIRE, "agent");
            asm volatile("s_waitcnt vmcnt(0)" ::: "memory");
        }
    }
    __syncthreads();
}


struct Frame {
    LAS unsigned char* lds;
    volatile LAS unsigned* MISC;
    gu32* ctl;
    unsigned char* ws;
    int tid, lane, wave, vcu, G;
};
struct Args { const float* in[15]; float* out; unsigned char* ws; int ph_lo, ph_hi; };

__device__ __forceinline__ float wave_sum(float v) {
#pragma unroll
    for (int o = 1; o < 64; o <<= 1) v += __shfl_xor(v, o);
    return v;
}

template <class ColMap>
__device__ __forceinline__ void p0_transpose_item(const float* W, int K, int N, bf16* WT, int nblk, LAS float* scr, int item, int lane, ColMap cm) {
    const int kb = item / nblk, nb = item % nblk, k0 = 64 * kb, n0 = 32 * nb;
    const int src = cm(n0 + (lane & 31));
#pragma unroll 8
    for (int i = 0; i < 32; ++i) { const int kk = 2 * i + (lane >> 5); scr[kk * 33 + (lane & 31)] = (src >= 0) ? W[(size_t)(k0 + kk) * N + src] : 0.f; }
    LDS_WAIT(); asm volatile("" ::: "memory");
    const int c = lane & 7;
#pragma unroll
    for (int j = 0; j < 4; ++j) { const int n = (lane >> 3) + 8 * j; const LAS float* s = scr + (8 * c) * 33 + n;
        v4u o; o.x = pk2(s[0 * 33], s[1 * 33]); o.y = pk2(s[2 * 33], s[3 * 33]); o.z = pk2(s[4 * 33], s[5 * 33]); o.w = pk2(s[6 * 33], s[7 * 33]);
        *(GAS v4u*)(WT + (size_t)(n0 + n) * K + k0 + 8 * c) = o; }
    LDS_WAIT(); asm volatile("" ::: "memory");
}
struct MapIdent { __device__ __forceinline__ int operator()(int n) const { return n; } };
struct MapWin { __device__ __forceinline__ int operator()(int n) const {
    if (n < 2048) return n;
    if (n < 2560) return 2120 + (n - 2048);
    if (n < 4608) return 2632 + (n - 2560);
    if (n < 4672) return 2048 + (n - 4608);
    if (n < 4680) return 2112 + (n - 4672);
    return -1; } };

__device__ __forceinline__ void rms_row_to_bf16(const float* xrow, const float* g, bf16* orow, int lane) {
    const GAS f32x4* xr = (const GAS f32x4*)xrow + lane; const GAS f32x4* gr = (const GAS f32x4*)g + lane;
    f32x4 v[4]; float s = 0.f;
#pragma unroll
    for (int j = 0; j < 4; ++j) { v[j] = xr[64 * j]; s += (v[j].x * v[j].x + v[j].y * v[j].y) + (v[j].z * v[j].z + v[j].w * v[j].w); }
    const float rs = 1.0f / sqrtf(wave_sum(s) * (1.f / 1024.f) + EPS);
    GAS unsigned long long* o8 = (GAS unsigned long long*)orow + lane;
#pragma unroll
    for (int j = 0; j < 4; ++j) { const f32x4 gg = gr[64 * j];
        o8[64 * j] = (unsigned long long)pk2(v[j].x * rs * gg.x, v[j].y * rs * gg.y) | ((unsigned long long)pk2(v[j].z * rs * gg.z, v[j].w * rs * gg.w) << 32); }
}

__device__ __forceinline__ void p0_prologue(Frame& F, const Args& AR) {
    LAS float* scr = (LAS float*)(F.lds + F.wave * 16384);
    const int gw = F.vcu * NWAVES + F.wave, NGW = F.G * NWAVES, lane = F.lane;
    constexpr int I_WIN = 16 * 152, I_WA = 8 * 32, I_WO = 16 * 32;
    for (int it = gw; it < I_WIN + I_WA + I_WO; it += NGW) {
        int r = it;
        if (r < I_WIN) { p0_transpose_item((AR.in[2]), 1024, IN_WIDTH, ((bf16*)(F.ws + WS_WIN)), 152, scr, r, lane, MapWin()); continue; } r -= I_WIN;
        if (r < I_WA) { p0_transpose_item((AR.in[7]), 512, 1024, ((bf16*)(F.ws + WS_WA)), 32, scr, r, lane, MapIdent()); continue; } r -= I_WA;
        p0_transpose_item((AR.in[9]), 1024, 1024, ((bf16*)(F.ws + WS_WO)), 32, scr, r, lane, MapIdent());
    }
    for (int it = gw; it < 16 * 64; it += NGW) {
        const int nb = it & 15, kb = it >> 4, n = nb * 64 + lane, k0 = kb * 8, g = k0 >> 7, c0 = k0 & 127;
        float acc[8];
#pragma unroll
        for (int j = 0; j < 8; ++j) acc[j] = 0.f;
        for (int d = 0; d < 128; ++d) {
            const float wv = (AR.in[8])[(size_t)(g * 128 + d) * 1024 + n] * (AR.in[6])[g * 128 + d];
#pragma unroll
            for (int j = 0; j < 8; ++j) acc[j] += (AR.in[5])[(size_t)(g * 128 + c0 + j) * 128 + d] * wv;
        }
        v4u o; o.x = pk2(acc[0], acc[1]); o.y = pk2(acc[2], acc[3]); o.z = pk2(acc[4], acc[5]); o.w = pk2(acc[6], acc[7]);
        *(GAS v4u*)(((bf16*)(F.ws + WS_WPP)) + (size_t)n * 512 + k0) = o;
    }
    for (int it = gw; it < 32 * 16; it += NGW) {
        const int nb = it & 31, kb = it >> 5, np = nb * 64 + lane, hp = nb >> 1, k0 = kb * 64;
#pragma unroll 4
        for (int d4 = 0; d4 < 16; ++d4) { const f32x4 t = *(const GAS f32x4*)((AR.in[12]) + (size_t)np * 64 + d4 * 4);
            scr[(4 * d4 + 0) * 64 + lane] = t.x; scr[(4 * d4 + 1) * 64 + lane] = t.y; scr[(4 * d4 + 2) * 64 + lane] = t.z; scr[(4 * d4 + 3) * 64 + lane] = t.w; }
        LDS_WAIT(); asm volatile("" ::: "memory");
#pragma unroll 1
        for (int k8 = 0; k8 < 8; ++k8) {
            float acc[8];
#pragma unroll
            for (int j = 0; j < 8; ++j) acc[j] = 0.f;
            const float* wr = (AR.in[11]) + (size_t)(k0 + k8 * 8) * 1024 + hp * 64;
#pragma unroll 4
            for (int d = 0; d < 64; ++d) { const float sv = scr[d * 64 + lane];
#pragma unroll
                for (int j = 0; j < 8; ++j) acc[j] += wr[(size_t)j * 1024 + d] * sv; }
            v4u o; o.x = pk2(acc[0], acc[1]); o.y = pk2(acc[2], acc[3]); o.z = pk2(acc[4], acc[5]); o.w = pk2(acc[6], acc[7]);
            *(GAS v4u*)(((bf16*)(F.ws + WS_W2)) + (size_t)np * 1024 + k0 + k8 * 8) = o;
        }
        LDS_WAIT(); asm volatile("" ::: "memory");
    }
    {   float mu = 0.f, mv = 0.f;
        for (int it = gw; it < 2 * 32768; it += NGW) {
            const float* src = (it < 32768) ? (AR.in[13]) : (AR.in[14]); const size_t e0 = (size_t)(it & 32767) * 512 + lane * 8;
            const f32x4 a = *(const GAS f32x4*)(src + e0), b = *(const GAS f32x4*)(src + e0 + 4);
            const float m = fmaxf(fmaxf(fmaxf(fabsf(a.x), fabsf(a.y)), fmaxf(fabsf(a.z), fabsf(a.w))), fmaxf(fmaxf(fabsf(b.x), fabsf(b.y)), fmaxf(fabsf(b.z), fabsf(b.w))));
            if (it < 32768) mu = fmaxf(mu, m); else mv = fmaxf(mv, m);
        }
#pragma unroll
        for (int o = 1; o < 64; o <<= 1) { mu = fmaxf(mu, __shfl_xor(mu, o)); mv = fmaxf(mv, __shfl_xor(mv, o)); }
        if (lane == 0) { __hip_atomic_fetch_max(F.ctl + CW_AMAX, __float_as_uint(mu), RLX_AGENT); __hip_atomic_fetch_max(F.ctl + CW_AMAX + 1, __float_as_uint(mv), RLX_AGENT); }
    }
    for (int it = gw * 64 + lane; it < 4096 * 8; it += NGW * 64) {
        const int pos = it >> 3, i = it & 7;
        const float invf = exp2f(-(float)i * 0.125f * 18.931568569324174f);
        const double ang = (double)((float)pos * invf);
        const double kq = __builtin_rint(ang * 0.6366197723675814);
        const float r = (float)(ang - kq * 1.5707963267948966);
        const int q = (int)((long long)kq & 3);
        const float r2 = r * r;
        const float sn = r + r * r2 * (-1.6666654611e-1f + r2 * (8.3321608736e-3f + r2 * (-1.9515295891e-4f)));
        const float cs = 1.0f - 0.5f * r2 + r2 * r2 * (4.166664568298827e-2f + r2 * (-1.388731625493765e-3f + r2 * 2.443315711809948e-5f));
        const float s = (q == 0) ? sn : (q == 1) ? cs : (q == 2) ? -sn : -cs;
        const float c = (q == 0) ? cs : (q == 1) ? -sn : (q == 2) ? -cs : sn;
        ((float*)(F.ws + WS_ROPE))[pos * 16 + i] = c; ((float*)(F.ws + WS_ROPE))[pos * 16 + 8 + i] = s;
    }
    for (int m = gw; m < MTOK; m += NGW) rms_row_to_bf16((AR.in[0]) + (size_t)m * DM, (AR.in[1]), ((bf16*)(F.ws + WS_ACT)) + (size_t)m * DM, lane);
}

__device__ __forceinline__ void unpack8(const v4u w, float (&v)[8]) { v[0] = bflo(w.x); v[1] = bfhi(w.x); v[2] = bflo(w.y); v[3] = bfhi(w.y); v[4] = bflo(w.z); v[5] = bfhi(w.z); v[6] = bflo(w.w); v[7] = bfhi(w.w); }
__device__ __forceinline__ v4u pack8(const float (&v)[8]) { v4u o; o.x = pk2(v[0], v[1]); o.y = pk2(v[2], v[3]); o.z = pk2(v[4], v[5]); o.w = pk2(v[6], v[7]); return o; }
__device__ __forceinline__ void rope8(float (&v)[8], int sub, const float (&cs)[8], const float (&sn)[8]) {
    float pv[8];
#pragma unroll
    for (int j = 0; j < 8; ++j) pv[j] = __shfl_xor(v[j], 1);
    if (sub == 0) {
#pragma unroll
        for (int j = 0; j < 8; ++j) v[j] = v[j] * cs[j] - pv[j] * sn[j];
    } else if (sub == 1) {
#pragma unroll
        for (int j = 0; j < 8; ++j) v[j] = v[j] * cs[j] + pv[j] * sn[j];
    }
}
__device__ __forceinline__ float fp8_scale(unsigned amax_bits) { const unsigned be = (amax_bits >> 23) & 0xffu; return (be == 0u || be > 250u) ? 1.0f : __uint_as_float((261u - be) << 23); }
__device__ __forceinline__ float fp8_inv_scale(unsigned amax_bits) { const unsigned be = (amax_bits >> 23) & 0xffu; return (be == 0u || be > 250u) ? 1.0f : __uint_as_float((be - 7u) << 23); }
__device__ __forceinline__ void row_to_fp8(const float* src, unsigned char* dst, float sc, int lane) {
    const GAS f32x4* p = (const GAS f32x4*)src + lane * 4; v4u o;
#pragma unroll
    for (int q = 0; q < 4; ++q) { const f32x4 a = p[q]; int w = 0; w = __builtin_amdgcn_cvt_pk_fp8_f32(a.x * sc, a.y * sc, w, false); w = __builtin_amdgcn_cvt_pk_fp8_f32(a.z * sc, a.w * sc, w, true); o[q] = (unsigned)w; }
    *(GAS v4u*)(dst + lane * 16) = o;
}
__device__ __forceinline__ void fixup_token(Frame& F, const Args& AR, int tok) {
    const int lane = F.lane, sub = lane & 7, pos = tok & (SEQ - 1);
    bf16* row = ((bf16*)(F.ws + WS_PROJ)) + (size_t)tok * LDP;
    float cs[8], sn[8];
    { const GAS f32x4* rt = (const GAS f32x4*)(((float*)(F.ws + WS_ROPE)) + pos * 16); const f32x4 a = rt[0], b = rt[1], c = rt[2], d = rt[3];
      cs[0] = a.x; cs[1] = a.y; cs[2] = a.z; cs[3] = a.w; cs[4] = b.x; cs[5] = b.y; cs[6] = b.z; cs[7] = b.w;
      sn[0] = c.x; sn[1] = c.y; sn[2] = c.z; sn[3] = c.w; sn[4] = d.x; sn[5] = d.y; sn[6] = d.z; sn[7] = d.w; }
#pragma unroll
    for (int which = 0; which < 2; ++which) {
        GAS v4u* p = (GAS v4u*)(row + (which ? K_OFF : Q_OFF) + lane * 8);
        float v[8]; unpack8(*p, v);
        float ss = 0.f;
#pragma unroll
        for (int j = 0; j < 8; ++j) ss += v[j] * v[j];
        ss += __shfl_xor(ss, 1); ss += __shfl_xor(ss, 2); ss += __shfl_xor(ss, 4);
        const float rs = 1.0f / sqrtf(ss * (1.f / 64.f) + EPS);
        const float* g = (which ? (AR.in[4]) : (AR.in[3])) + sub * 8;
#pragma unroll
        for (int j = 0; j < 8; ++j) v[j] = v[j] * rs * g[j];
        rope8(v, sub, cs, sn);
        if (which == 0) {
#pragma unroll
            for (int j = 0; j < 8; ++j) v[j] *= C2;
        }
        *p = pack8(v);
    }
    { GAS v4u* p = (GAS v4u*)(row + QI_OFF + lane * 8); float v[8]; unpack8(*p, v); rope8(v, sub, cs, sn); *p = pack8(v); }
    { GAS v4u* p = (GAS v4u*)(row + KI_OFF + (lane & 7) * 8); float v[8]; unpack8(*p, v); rope8(v, sub, cs, sn); if (lane < 8) *p = pack8(v); }
    { const int g = lane >> 4, w = 2 << g;
      float acc[8], cur[8];
#pragma unroll
      for (int j = 0; j < 8; ++j) acc[j] = 0.f;
      unpack8(*(const GAS v4u*)(row + P_OFF + lane * 8), cur);
#pragma unroll
      for (int j = 0; j < 8; ++j) acc[j] = cur[j];
#pragma unroll
      for (int back = 1; back < 16; ++back) {
          if (back < w && back <= pos) { float t[8]; unpack8(*(const GAS v4u*)(row - (size_t)back * LDP + P_OFF + lane * 8), t);
#pragma unroll
              for (int j = 0; j < 8; ++j) acc[j] += t[j]; }
      }
      const float inv = 1.0f / (float)((pos + 1 < w) ? (pos + 1) : w);
      float o[8];
#pragma unroll
      for (int j = 0; j < 8; ++j) o[j] = acc[j] * inv - cur[j];
      *(GAS v4u*)(((bf16*)(F.ws + WS_POOLED)) + (size_t)tok * 512 + lane * 8) = pack8(o); }
}

#define wlane(dst, sval, j) asm volatile("s_nop 3\n\tv_writelane_b32 %0, %1, %2\n\ts_nop 1" : "+v"(dst) : "s"(sval), "i"(j))
__device__ __forceinline__ void select_row(const LAS float* srow, int nj, int lastw, GAS unsigned long long* mout, int lane) {
    unsigned key[64];
#pragma unroll
    for (int g = 0; g < 8; ++g) {
        if (nj > 8 * g) {
#pragma unroll
            for (int jj = 0; jj < 8; ++jj) key[8 * g + jj] = ordk(srow[64 * (8 * g + jj) + lane] + 0.0f);
        } else {
#pragma unroll
            for (int jj = 0; jj < 8; ++jj) key[8 * g + jj] = 0u;
        }
    }
    unsigned v = 0u;
#pragma unroll 1
    for (int bit = 31; bit >= 0; --bit) {
        const unsigned cand = v | (1u << bit);
        int cnt = 0;
#pragma unroll
        for (int g = 0; g < 8; ++g) {
            if (nj > 8 * g) {
#pragma unroll
                for (int jj = 0; jj < 8; ++jj) cnt += __popcll(__ballot(key[8 * g + jj] >= cand));
            }
        }
        if (cnt >= 256) v = cand;
    }
    int ngt = 0, neq = 0;
#pragma unroll
    for (int j = 0; j < 64; ++j) { ngt += __popcll(__ballot(key[j] > v)); neq += __popcll(__ballot(key[j] == v)); }
    unsigned mlo = 0u, mhi = 0u;
    if (ngt + neq == 256) {
#pragma unroll
        for (int j = 0; j < 64; ++j) { const unsigned long long m = __ballot(key[j] >= v);
            wlane(mlo, (unsigned)m, j); wlane(mhi, (unsigned)(m >> 32), j); }
    } else {
        int need = 256 - ngt;
#pragma unroll
        for (int j = 0; j < 64; ++j) {
            unsigned long long eq = __ballot(key[j] == v); const unsigned long long gt = __ballot(key[j] > v);
            unsigned long long keep = 0ull;
            while (need > 0 && eq != 0ull) { const unsigned long long lsb = eq & (0ull - eq); keep |= lsb; eq ^= lsb; --need; }
            const unsigned long long m = gt | keep;
            wlane(mlo, (unsigned)m, j); wlane(mhi, (unsigned)(m >> 32), j);
        }
    }
    if (lane <= lastw) mout[lane] = ((unsigned long long)mhi << 32) | (unsigned long long)mlo;
}

__device__ __forceinline__ void idx_unit(Frame& F, const Args& AR, int b, int c) {
    const int lane = F.lane, wid = F.wave, l31 = lane & 31, h2 = lane >> 5;
    LAS float* sc = (LAS float*)F.lds;
    const size_t rowb = (size_t)b * SEQ, tq0 = rowb + (size_t)c * 64;
    if (c < 4) {
        if (F.tid < 256) { const int q = F.tid >> 2, j = F.tid & 3; ((unsigned long long*)(F.ws + WS_MASK))[(tq0 + q) * 64 + j] = (j <= c) ? ~0ull : 0ull; }
        return;
    }
    const int ntile = 2 * (c + 1), nj = c + 1, lastw = c | 3, ntile_pad = 16 * ((nj + 7) >> 3);
    const int head = (l31 & 3) | (((l31 >> 3) & 1) << 2), qsub = ((l31 >> 2) & 1) | (((l31 >> 4) & 1) << 1);
    for (int pass = 0; pass < 8; ++pass) {
        const size_t tp0 = tq0 + pass * 8;
        bf16x8 a[2][4]; float w[2][16];
#pragma unroll
        for (int rb = 0; rb < 2; ++rb) {
            const bf16* ap = ((bf16*)(F.ws + WS_PROJ)) + (tp0 + 4 * rb + qsub) * LDP + QI_OFF + head * 64 + h2 * 8;
#pragma unroll
            for (int st = 0; st < 4; ++st) a[rb][st] = *(const GAS bf16x8*)(ap + st * 16);
            const v4u wa = *(const GAS v4u*)(((bf16*)(F.ws + WS_PROJ)) + (tp0 + 4 * rb + h2) * LDP + WI_OFF), wb = *(const GAS v4u*)(((bf16*)(F.ws + WS_PROJ)) + (tp0 + 4 * rb + h2 + 2) * LDP + WI_OFF);
            float t[8]; unpack8(wa, t);
#pragma unroll
            for (int j = 0; j < 8; ++j) w[rb][j] = t[j] * WI_SCALE;
            unpack8(wb, t);
#pragma unroll
            for (int j = 0; j < 8; ++j) w[rb][8 + j] = t[j] * WI_SCALE;
        }
        for (int kt = wid; kt < ntile_pad; kt += 8) {
            if (kt >= ntile) {
#pragma unroll
                for (int rb = 0; rb < 2; ++rb) { sc[(4 * rb + h2) * 4096 + kt * 32 + l31] = -INFINITY; sc[(4 * rb + h2 + 2) * 4096 + kt * 32 + l31] = -INFINITY; }
                continue;
            }
            const bf16* kp = ((bf16*)(F.ws + WS_PROJ)) + (rowb + kt * 32 + l31) * LDP + KI_OFF + h2 * 8;
            bf16x8 bfr[4];
#pragma unroll
            for (int st = 0; st < 4; ++st) bfr[st] = *(const GAS bf16x8*)(kp + st * 16);
#pragma unroll
            for (int rb = 0; rb < 2; ++rb) {
                f32x16 acc;
#pragma unroll
                for (int r = 0; r < 16; ++r) acc[r] = 0.f;
#pragma unroll
                for (int st = 0; st < 4; ++st) acc = __builtin_amdgcn_mfma_f32_32x32x16_bf16(a[rb][st], bfr[st], acc, 0, 0, 0);
                float s0 = 0.f, s1 = 0.f;
#pragma unroll
                for (int r = 0; r < 8; ++r) { s0 = fmaf(w[rb][r], fmaxf(acc[r], 0.f), s0); s1 = fmaf(w[rb][8 + r], fmaxf(acc[8 + r], 0.f), s1); }
                sc[(4 * rb + h2) * 4096 + kt * 32 + l31] = s0;
                sc[(4 * rb + h2 + 2) * 4096 + kt * 32 + l31] = s1;
            }
        }
        __syncthreads();
        select_row(sc + wid * 4096, nj, lastw, (GAS unsigned long long*)(((unsigned long long*)(F.ws + WS_MASK)) + (tp0 + wid) * 64), lane);
        __syncthreads();
    }
}

__device__ __forceinline__ void attn_unit(Frame& F, const Args& AR, int b, int h, int qb) {
    const int lane = F.lane, wid = F.wave, l31 = lane & 31, h2 = lane >> 5;
    LAS unsigned char* Ks = F.lds;
    LAS unsigned char* Vs = F.lds + 9216;
    LAS float* wsf = (LAS float*)(F.lds + 17408) + wid * 32;
    const size_t rowb = (size_t)b * SEQ, tok0 = rowb + (size_t)qb * 256 + wid * 32;
    bf16x8 qf[4];
    { const bf16* qp = ((bf16*)(F.ws + WS_PROJ)) + (tok0 + l31) * LDP + Q_OFF + h * 64 + h2 * 8;
#pragma unroll
      for (int st = 0; st < 4; ++st) qf[st] = *(const GAS bf16x8*)(qp + st * 16); }
    const int NT = 4 * (qb + 1), cw = qb * 4 + (wid >> 1);
    f32x16 o0, o1;
#pragma unroll
    for (int r = 0; r < 16; ++r) { o0[r] = 0.f; o1[r] = 0.f; }
    float lsum = 0.f;
    const int skey = F.tid >> 3, sch = F.tid & 7;
    const bf16* kg = ((bf16*)(F.ws + WS_PROJ)) + (rowb + skey) * LDP + K_OFF + h * 64 + sch * 8;
    const bf16* vg = ((bf16*)(F.ws + WS_PROJ)) + (rowb + skey) * LDP + V_OFF + h * 64 + sch * 8;
    v4u kreg = *(const GAS v4u*)kg, vreg = *(const GAS v4u*)vg;
    const unsigned kst = skey * 144 + sch * 16, vst = skey * 128 + ((sch * 16) ^ (((skey >> 1) & 1) << 6));
    const GAS unsigned long long* mrow = (const GAS unsigned long long*)(((unsigned long long*)(F.ws + WS_MASK)) + (tok0 + l31) * 64);
    const int i16 = lane & 15, qq = i16 >> 2, pp = i16 & 3, blk = (lane >> 4) & 1;
    const unsigned vrd = (unsigned)((4 * h2 + qq) * 128 + ((32 * blk + 8 * pp) ^ (((qq >> 1) & 1) << 6)));
    for (int t = 0; t < NT; ++t) {
        __syncthreads();
        *(LAS v4u*)(Ks + kst) = kreg; *(LAS v4u*)(Vs + vst) = vreg;
        __syncthreads();
        if (t + 1 < NT) { kreg = *(const GAS v4u*)(kg + (size_t)(t + 1) * 64 * LDP); vreg = *(const GAS v4u*)(vg + (size_t)(t + 1) * 64 * LDP); }
        if (t <= cw) {
            const unsigned long long mw = mrow[t];
            f32x16 p[2];
#pragma unroll
            for (int kb = 0; kb < 2; ++kb) {
                f32x16 acc;
#pragma unroll
                for (int r = 0; r < 16; ++r) acc[r] = 0.f;
#pragma unroll
                for (int st = 0; st < 4; ++st) { const bf16x8 ka = *(const LAS bf16x8*)(Ks + (32 * kb + l31) * 144 + st * 32 + h2 * 16); acc = __builtin_amdgcn_mfma_f32_32x32x16_bf16(ka, qf[st], acc, 0, 0, 0); }
                const unsigned wk = (kb ? (unsigned)(mw >> 32) : (unsigned)mw) >> (4 * h2);
#pragma unroll
                for (int r = 0; r < 16; ++r) {
                    const float e = __builtin_amdgcn_exp2f(acc[r]);
                    const int m = __builtin_amdgcn_sbfe((int)wk, (r & 3) + 8 * (r >> 2), 1);
                    const float pe = __uint_as_float(__float_as_uint(e) & (unsigned)m);
                    acc[r] = pe; lsum += pe;
                }
                p[kb] = acc;
            }
#pragma unroll
            for (int kb = 0; kb < 2; ++kb)
#pragma unroll
                for (int s = 0; s < 2; ++s) {
                    v4u pw; pw.x = pk2(p[kb][8 * s + 0], p[kb][8 * s + 1]); pw.y = pk2(p[kb][8 * s + 2], p[kb][8 * s + 3]); pw.z = pk2(p[kb][8 * s + 4], p[kb][8 * s + 5]); pw.w = pk2(p[kb][8 * s + 6], p[kb][8 * s + 7]);
                    const bf16x8 pa = __builtin_bit_cast(bf16x8, pw);
                    const unsigned rbase = vrd + (unsigned)((32 * kb + 16 * s) * 128);
#pragma unroll
                    for (int d0 = 0; d0 < 2; ++d0) {
                        const unsigned ad = rbase ^ (unsigned)(d0 << 6);
                        const s16x4 lo = __builtin_bit_cast(s16x4, __builtin_amdgcn_ds_read_tr16_b64_v4i16((LAS s16x4*)(Vs + ad)));
                        const s16x4 hi = __builtin_bit_cast(s16x4, __builtin_amdgcn_ds_read_tr16_b64_v4i16((LAS s16x4*)(Vs + ad + 8 * 128)));
                        const bf16x8 vb = (bf16x8){lo[0], lo[1], lo[2], lo[3], hi[0], hi[1], hi[2], hi[3]};
                        if (d0 == 0) o0 = __builtin_amdgcn_mfma_f32_32x32x16_bf16(pa, vb, o0, 0, 0, 0); else o1 = __builtin_amdgcn_mfma_f32_32x32x16_bf16(pa, vb, o1, 0, 0, 0);
                    }
                }
        }
    }
    lsum += __shfl_xor(lsum, 32);
    if (h2 == 0) wsf[l31] = lsum;
    LDS_WAIT(); asm volatile("" ::: "memory");
    bf16* op = ((bf16*)(F.ws + WS_PROJ)) + tok0 * LDP + Q_OFF + h * 64 + l31;
#pragma unroll
    for (int r = 0; r < 16; ++r) { const int q = crow(r, h2); const float rl = 1.0f / wsf[q];
        op[(size_t)q * LDP] = (bf16)f2bf(o0[r] * rl); op[(size_t)q * LDP + 32] = (bf16)f2bf(o1[r] * rl); }
    LDS_WAIT(); asm volatile("" ::: "memory");
}

__device__ __forceinline__ void route_wave(Frame& F, const Args& AR, size_t tokbase) {
    const int lane = F.lane; const size_t tok = tokbase + (lane >> 4); const int hp = lane & 15, half = hp & 1;
    const GAS v4u* rp = (const GAS v4u*)(((unsigned*)(F.ws + WS_PROJ)) + tok * 2048 + hp * 128);
    unsigned list[16];
#pragma unroll
    for (int i = 0; i < 16; ++i) list[i] = 0u;
#pragma unroll 4
    for (int c4 = 0; c4 < 32; ++c4) {
        const v4u kv = rp[c4];
#pragma unroll
        for (int e = 0; e < 4; ++e) { unsigned x = kv[e];
#pragma unroll
            for (int i = 0; i < 16; ++i) { const unsigned hi = list[i] > x ? list[i] : x; x = list[i] > x ? x : list[i]; list[i] = hi; } }
    }
    LAS unsigned* lk = (LAS unsigned*)F.lds;
#pragma unroll
    for (int i = 0; i < 16; ++i) lk[i * 512 + F.tid] = list[i];
    LDS_WAIT(); asm volatile("" ::: "memory");
    const int ta = F.tid & ~1, tb = F.tid | 1;
    unsigned ck[16], ce[16];
#pragma unroll
    for (int i = 0; i < 16; ++i) { ck[i] = 0u; ce[i] = 0u; }
#pragma unroll 1
    for (int i = 0; i < 16; ++i) {
        const unsigned ka = lk[i * 512 + ta];
        const float sai = unordk(ka & ~127u); const unsigned nai = (127u - (ka & 127u)) * 128u;
        const int njj = 16 / (i + 1);
#pragma unroll 1
        for (int j = 0; j < njj; ++j) {
            const unsigned kb = lk[j * 512 + tb];
            unsigned x = (ordk(sai + unordk(kb & ~127u)) & ~255u) | (unsigned)(255 - (i * 16 + j)); unsigned y = nai + (127u - (kb & 127u));
#pragma unroll
            for (int t = 0; t < 16; ++t) { const bool gt = x > ck[t]; const unsigned nk = gt ? x : ck[t], ne = gt ? y : ce[t]; x = gt ? ck[t] : x; y = gt ? ce[t] : y; ck[t] = nk; ce[t] = ne; }
        }
    }
    LDS_WAIT(); asm volatile("" ::: "memory");
    float ts[16]; float sum = 0.f; const float mx = unordk(ck[0] & ~255u);
#pragma unroll
    for (int t = 0; t < 16; ++t) { ts[t] = __builtin_amdgcn_exp2f((unordk(ck[t] & ~255u) - mx) * 1.4426950408889634f); sum += ts[t]; }
    const float inv = 1.0f / sum;
    if (half == 0) {
        GAS v4u* eo = (GAS v4u*)(((unsigned short*)(F.ws + WS_REXP)) + tok * 128 + (hp >> 1) * 16); GAS f32x4* go = (GAS f32x4*)(((float*)(F.ws + WS_RG)) + tok * 128 + (hp >> 1) * 16);
        eo[0] = (v4u){ce[0] | (ce[1] << 16), ce[2] | (ce[3] << 16), ce[4] | (ce[5] << 16), ce[6] | (ce[7] << 16)};
        eo[1] = (v4u){ce[8] | (ce[9] << 16), ce[10] | (ce[11] << 16), ce[12] | (ce[13] << 16), ce[14] | (ce[15] << 16)};
#pragma unroll
        for (int t4 = 0; t4 < 4; ++t4) go[t4] = (f32x4){ts[4 * t4] * inv, ts[4 * t4 + 1] * inv, ts[4 * t4 + 2] * inv, ts[4 * t4 + 3] * inv};
    }
}

__device__ __forceinline__ float gelu_erf(float v) {
    const float av = fabsf(v), t = __builtin_amdgcn_rcpf(av * 0.2316418882f + 1.0f);
    float q = t * 0.5307027145f + (-0.7265760135f); q = q * t + 0.7107068705f; q = q * t + (-0.142248368f); q = q * t + 0.127414796f; q = q * t;
    const float e = __builtin_amdgcn_exp2f((v * v) * (-0.72134752044f));
    const float m = v * (q * e);
    return v < 0.f ? m : v - m;
}
typedef __bf16 bf16x2v_t __attribute__((ext_vector_type(2)));
__device__ __forceinline__ float dot2bf(unsigned a, unsigned b, float acc) { return __builtin_amdgcn_fdot2_f32_bf16(__builtin_bit_cast(bf16x2v_t, a), __builtin_bit_cast(bf16x2v_t, b), acc, false); }
__device__ __forceinline__ float dpp_add(float v, float w_unused) { return v; }
#define DPP_ADD(v, ctrl) ((v) + __builtin_bit_cast(float, __builtin_amdgcn_update_dpp(0, __builtin_bit_cast(int, (v)), (ctrl), 0xf, 0xf, true)))
constexpr int NSL = 8;
constexpr int CW_PEER = 8192;
typedef float f32x2v __attribute__((ext_vector_type(2)));
__device__ __forceinline__ unsigned id_of(const v4u a, const v4u b, int m) { const unsigned w = (m < 8) ? a[(m & 7) >> 1] : b[(m & 7) >> 1]; return (m & 1) ? (w >> 16) : (w & 0xffffu); }
__device__ __forceinline__ void peer_u_token(Frame& F, size_t tok, int s, const v4u ia, const v4u ib, const f32x2v (&hn2)[8]) {
    const int lane = F.lane, g = lane >> 3, c = lane & 7;
    const unsigned char* ub = ((const unsigned char*)(F.ws + WS_U16)) + 128 * s + 16 * c;
    v4u r[16];
#pragma unroll
    for (int m = 0; m < 16; ++m) r[m] = *(const GAS v4u*)(ub + (size_t)id_of(ia, ib, m) * 1024);
    float d[16];
#pragma unroll
    for (int m = 0; m < 16; ++m) { f32x2v acc = {0.f, 0.f};
#pragma unroll
        for (int q = 0; q < 4; ++q) { const int w = (int)r[m][q]; acc = __builtin_amdgcn_cvt_pk_f32_fp8(w, false) * hn2[2 * q] + acc; acc = __builtin_amdgcn_cvt_pk_f32_fp8(w, true) * hn2[2 * q + 1] + acc; }
        float a = acc.x + acc.y; a = DPP_ADD(a, 0xB1); a = DPP_ADD(a, 0x4E); a = DPP_ADD(a, 0x141); d[m] = a; }
    if (c == 0) { GAS f32x4* po = (GAS f32x4*)(((float*)(F.ws + WS_PROJ)) + (tok * NSL + s) * 128 + 16 * g);
        po[0] = (f32x4){d[0], d[1], d[2], d[3]}; po[1] = (f32x4){d[4], d[5], d[6], d[7]}; po[2] = (f32x4){d[8], d[9], d[10], d[11]}; po[3] = (f32x4){d[12], d[13], d[14], d[15]}; }
}
__device__ __forceinline__ void peer_v_token(Frame& F, const Args& AR, size_t tok, int s, const v4u ia, const v4u ib, const f32x4 (&cf)[4]) {
    const int lane = F.lane, g = lane >> 3, c = lane & 7;
    const unsigned char* vb = ((const unsigned char*)(F.ws + WS_V16)) + 128 * s + 16 * c;
    v4u r[16];
#pragma unroll
    for (int m = 0; m < 16; ++m) r[m] = *(const GAS v4u*)(vb + (size_t)id_of(ia, ib, m) * 1024);
    f32x2v acc[8];
#pragma unroll
    for (int j = 0; j < 8; ++j) acc[j] = (f32x2v){0.f, 0.f};
#pragma unroll
    for (int m = 0; m < 16; ++m) { const float cm = cf[m >> 2][m & 3]; const f32x2v c2 = {cm, cm};
#pragma unroll
        for (int q = 0; q < 4; ++q) { const int w = (int)r[m][q]; acc[2 * q] = __builtin_amdgcn_cvt_pk_f32_fp8(w, false) * c2 + acc[2 * q]; acc[2 * q + 1] = __builtin_amdgcn_cvt_pk_f32_fp8(w, true) * c2 + acc[2 * q + 1]; } }
    float o[16];
#pragma unroll
    for (int j = 0; j < 16; ++j) { float a = (j & 1) ? acc[j >> 1].y : acc[j >> 1].x; a = DPP_ADD(a, 0x128); a += __shfl_xor(a, 16); a += __shfl_xor(a, 32); o[j] = a; }
    if (g == 0) { GAS f32x4* op = (GAS f32x4*)((AR.out) + tok * 1024 + 128 * s + 16 * c);
#pragma unroll
        for (int q = 0; q < 4; ++q) { f32x4 h = op[q]; h.x += o[4 * q]; h.y += o[4 * q + 1]; h.z += o[4 * q + 2]; h.w += o[4 * q + 3]; op[q] = h; } }
}
__device__ __forceinline__ void load_hn2(const bf16* p, f32x2v (&hn2)[8]) { const v4u a = *(const GAS v4u*)p, b = *(const GAS v4u*)(p + 8);
    hn2[0] = (f32x2v){bflo(a.x), bfhi(a.x)}; hn2[1] = (f32x2v){bflo(a.y), bfhi(a.y)}; hn2[2] = (f32x2v){bflo(a.z), bfhi(a.z)}; hn2[3] = (f32x2v){bflo(a.w), bfhi(a.w)};
    hn2[4] = (f32x2v){bflo(b.x), bfhi(b.x)}; hn2[5] = (f32x2v){bflo(b.y), bfhi(b.y)}; hn2[6] = (f32x2v){bflo(b.z), bfhi(b.z)}; hn2[7] = (f32x2v){bflo(b.w), bfhi(b.w)}; }
template <int SIDE> __device__ __forceinline__ void peer_side(Frame& F, const Args& AR) {
    gu32* cnt = F.ctl + CW_PEER + SIDE * 16 * 64;
    LAS int* sh = (LAS int*)F.lds;
    const unsigned xcc = xb_xcc_id() & 7u;
    const int lane = F.lane, g = lane >> 3, c = lane & 7;
    const unsigned short* idp = ((const unsigned short*)(F.ws + WS_REXP)) + 16 * g;
#pragma unroll 1
    for (int k = 0; k < NSL; ++k) {
        const int s = (int)((xcc + (unsigned)k) & (unsigned)(NSL - 1));
#pragma unroll 1
        for (;;) {
            __syncthreads();
            if (F.tid == 0) sh[0] = (int)__hip_atomic_fetch_add(cnt + 64 * s, 1u, RLX_AGENT);
            __syncthreads();
            const int blk = sh[0];
            if (blk >= MTOK / 128) break;
            const size_t t0 = (size_t)blk * 128 + F.wave * 16;
            v4u ia = *(const GAS v4u*)(idp + t0 * 128), ib = *(const GAS v4u*)(idp + t0 * 128 + 8);
            if (SIDE == 0) {
                const bf16* hp = ((const bf16*)(F.ws + WS_ACT)) + 128 * s + 16 * c;
                f32x2v hn2[8]; load_hn2(hp + t0 * 1024, hn2);
#pragma unroll 1
                for (int i = 0; i < 16; ++i) { const size_t tok = t0 + i, tn = t0 + ((i + 1) & 15);
                    const v4u na = *(const GAS v4u*)(idp + tn * 128), nb = *(const GAS v4u*)(idp + tn * 128 + 8); f32x2v nh[8]; load_hn2(hp + tn * 1024, nh);
                    peer_u_token(F, tok, s, ia, ib, hn2); ia = na; ib = nb;
#pragma unroll
                    for (int q = 0; q < 8; ++q) hn2[q] = nh[q]; }
            } else {
                const float* cfp = ((const float*)(F.ws + WS_RG)) + 16 * g;
                f32x4 cf[4];
#pragma unroll
                for (int q = 0; q < 4; ++q) cf[q] = *(const GAS f32x4*)(cfp + t0 * 128 + 4 * q);
#pragma unroll 1
                for (int i = 0; i < 16; ++i) { const size_t tok = t0 + i, tn = t0 + ((i + 1) & 15);
                    const v4u na = *(const GAS v4u*)(idp + tn * 128), nb = *(const GAS v4u*)(idp + tn * 128 + 8); f32x4 nc[4];
#pragma unroll
                    for (int q = 0; q < 4; ++q) nc[q] = *(const GAS f32x4*)(cfp + tn * 128 + 4 * q);
                    peer_v_token(F, AR, tok, s, ia, ib, cf); ia = na; ib = nb;
#pragma unroll
                    for (int q = 0; q < 4; ++q) cf[q] = nc[q]; }
            }
        }
    }
}
__device__ __forceinline__ void peer_coef_token(Frame& F, size_t tok, float inv_su, float inv_sv) {
    const int lane = F.lane;
    const float* pp = ((const float*)(F.ws + WS_PROJ)) + tok * NSL * 128;
    float a0 = 0.f, a1 = 0.f;
#pragma unroll
    for (int s = 0; s < NSL; ++s) { a0 += pp[s * 128 + lane]; a1 += pp[s * 128 + 64 + lane]; }
    float* gp = ((float*)(F.ws + WS_RG)) + tok * 128;
    gp[lane] = gp[lane] * gelu_erf(a0 * inv_su) * inv_sv; gp[64 + lane] = gp[64 + lane] * gelu_erf(a1 * inv_su) * inv_sv;
}

__global__ void __launch_bounds__(NWAVES * 64, 2) mk_fwd(Args args) {
    extern __shared__ __attribute__((aligned(16))) unsigned char lds[];
    Frame F;
    F.lds = (LAS unsigned char*)lds;
    F.MISC = (volatile LAS unsigned*)(F.lds + MISC_OFF);
    F.tid = threadIdx.x; F.lane = F.tid & 63; F.wave = __builtin_amdgcn_readfirstlane(F.tid >> 6);
    F.G = gridDim.x; { const int bx = blockIdx.x; F.vcu = (F.G % 8 == 0) ? (bx % 8) * (F.G / 8) + bx / 8 : bx; }
    F.ws = args.ws;
    F.ctl = (gu32*)(F.ws + WS_CTL);
    const Args& AR = args;
    for (int u = F.tid; u < (LDS_BYTES - LDSCTL_OFF) / 4; u += NWAVES * 64) ((LAS unsigned*)(F.lds + LDSCTL_OFF))[u] = 0u;
    __syncthreads();
    XcdBarrier bar; bar.bar = (unsigned*)(F.ctl + CW_BAR); bar.x = 0; bar.st = nullptr;
#if !MK_PER_PHASE
    bar = xcd_barrier_post((unsigned*)(F.ctl + CW_BAR), F.MISC + 8);
#endif
    const int lo = args.ph_lo, hi = args.ph_hi;
#if defined(ONLY_PHASE)
#define IN(k) ((k) == ONLY_PHASE && lo <= (k) && (k) < hi)
#elif defined(PHASE_MASK)
#define IN(k) (((PHASE_MASK >> (k)) & 1) && lo <= (k) && (k) < hi)
#else
#define IN(k) (lo <= (k) && (k) < hi)
#endif
#if MK_PER_PHASE
#define SEAM(k) do { } while (0)
#else
#define SEAM(k) do { if (IN(k) && IN((k) + 1)) xcd_barrier(bar); } while (0)
#endif
#define FRESH() Frame P = F; { int t_ = threadIdx.x; asm volatile("" : "+v"(t_)); P.tid = t_; P.lane = t_ & 63; P.wave = __builtin_amdgcn_readfirstlane(t_ >> 6); } const int gw = P.vcu * NWAVES + P.wave, NGW = P.G * NWAVES; (void)gw; (void)NGW

    for (int rep_ = 0; rep_ < (((REPEAT_MASK >> 0) & 1) ? 2 : 1); ++rep_) if (IN(0)) { FRESH(); p0_prologue(P, args); } SEAM(0);
    for (int rep_ = 0; rep_ < (((REPEAT_MASK >> 1) & 1) ? 2 : 1); ++rep_) if (IN(1)) { pg8::Gemm g{((bf16*)(F.ws + WS_ACT)), ((bf16*)(F.ws + WS_WIN)), MTOK, LDP, 1024, 1024, 1024}; pg8::StaticOrder S; S.init(MTOK, LDP, F.G, (int)blockIdx.x);
        pg8::EpiStoreBf16 E{((bf16*)(F.ws + WS_PROJ)), LDP};
        pg8::gemm_phase<pg8::EpiStoreBf16, pg8::StaticOrder, true, true>(F.lds, g, S, E); } SEAM(1);
    if (IN(2)) { FRESH(); for (int m = gw; m < MTOK; m += NGW) fixup_token(P, args, m);
        const float su = fp8_scale(__hip_atomic_load(P.ctl + CW_AMAX, RLX_AGENT)), sv = fp8_scale(__hip_atomic_load(P.ctl + CW_AMAX + 1, RLX_AGENT));
        for (int r = gw; r < 2 * 16384; r += NGW) { const int rr = r & 16383;
            if (r < 16384) row_to_fp8(args.in[13] + (size_t)rr * 1024, (unsigned char*)(P.ws + WS_U16) + (size_t)rr * 1024, su, P.lane);
            else row_to_fp8(args.in[14] + (size_t)rr * 1024, (unsigned char*)(P.ws + WS_V16) + (size_t)rr * 1024, sv, P.lane); } } SEAM(2);
    for (int rep_ = 0; rep_ < (((REPEAT_MASK >> 3) & 1) ? 2 : 1); ++rep_) if (IN(3)) { FRESH(); for (int i = P.vcu; i < 256; i += P.G) { const int b = i >> 4, s = i & 15;
#pragma unroll 1
            for (int k = 0; k < 4; ++k) idx_unit(P, args, b, (k == 0) ? s : (k == 1) ? 31 - s : (k == 2) ? 32 + s : 63 - s); } } SEAM(3);
    if (IN(4)) { FRESH(); for (int i = P.vcu; i < 256; i += P.G) { const int bh = i >> 1, s = i & 1, b = bh >> 3, h = bh & 7;
#pragma unroll 1
            for (int k = 0; k < 8; ++k) attn_unit(P, args, b, h, (k & 1) ? 15 - (k >> 1) * 2 - s : (k >> 1) * 2 + s); } } SEAM(4);
    for (int rep_ = 0; rep_ < (((REPEAT_MASK >> 5) & 1) ? 2 : 1); ++rep_) if (IN(5)) { pg8::Gemm g{((bf16*)(F.ws + WS_PROJ)) + Q_OFF, ((bf16*)(F.ws + WS_WA)), MTOK, 1024, 512, LDP, 512}; pg8::StaticOrder S; S.init(MTOK, 1024, F.G, (int)blockIdx.x);
        pg8::EpiGate<false> E{((bf16*)(F.ws + WS_ACT)), 1024, ((bf16*)(F.ws + WS_PROJ)) + GA_OFF, LDP};
        pg8::gemm_phase<pg8::EpiGate<false>, pg8::StaticOrder, true, true>(F.lds, g, S, E); } SEAM(5);
    if (IN(6)) { pg8::Gemm g{((bf16*)(F.ws + WS_POOLED)), ((bf16*)(F.ws + WS_WPP)), MTOK, 1024, 512, 512, 512}; pg8::StaticOrder S; S.init(MTOK, 1024, F.G, (int)blockIdx.x);
                pg8::EpiGate<true> E{((bf16*)(F.ws + WS_ACT)), 1024, ((bf16*)(F.ws + WS_PROJ)) + GP_OFF, LDP};
        pg8::gemm_phase<pg8::EpiGate<true>, pg8::StaticOrder, true, true>(F.lds, g, S, E); } SEAM(6);
    for (int rep_ = 0; rep_ < (((REPEAT_MASK >> 7) & 1) ? 2 : 1); ++rep_) if (IN(7)) { pg8::Gemm g{((bf16*)(F.ws + WS_ACT)), ((bf16*)(F.ws + WS_WO)), MTOK, 1024, 1024, 1024, 1024}; pg8::StaticOrder S; S.init(MTOK, 1024, F.G, (int)blockIdx.x);
        pg8::EpiResF32 E{(AR.in[0]), (AR.out), 1024};
        pg8::gemm_phase<pg8::EpiResF32, pg8::StaticOrder, true, true>(F.lds, g, S, E); } SEAM(7);

    for (int rep_ = 0; rep_ < (((REPEAT_MASK >> 8) & 1) ? 2 : 1); ++rep_) if (IN(8)) { FRESH(); for (int m = gw; m < MTOK; m += NGW) rms_row_to_bf16((args.out) + (size_t)m * DM, (args.in[10]), ((bf16*)(P.ws + WS_ACT)) + (size_t)m * DM, P.lane); } SEAM(8);
    for (int rep_ = 0; rep_ < (((REPEAT_MASK >> 9) & 1) ? 2 : 1); ++rep_) if (IN(9)) { pg8::Gemm g{((bf16*)(F.ws + WS_ACT)), ((bf16*)(F.ws + WS_W2)), MTOK, 2048, 1024, 1024, 1024}; pg8::StaticOrder S; S.init(MTOK, 2048, F.G, (int)blockIdx.x);
        pg8::EpiKeys E{((unsigned*)(F.ws + WS_PROJ)), 2048};
        pg8::gemm_phase<pg8::EpiKeys, pg8::StaticOrder, true, true>(F.lds, g, S, E); } SEAM(9);
    for (int rep_ = 0; rep_ < (((REPEAT_MASK >> 10) & 1) ? 2 : 1); ++rep_) if (IN(10)) { FRESH(); for (int m4 = gw; m4 < MTOK / 4; m4 += NGW) route_wave(P, args, (size_t)m4 * 4); } SEAM(10);
        if (IN(11)) { FRESH(); peer_side<0>(P, args); } SEAM(11);
    if (IN(12)) { FRESH(); const float iu = fp8_inv_scale(__hip_atomic_load(P.ctl + CW_AMAX, RLX_AGENT)), iv = fp8_inv_scale(__hip_atomic_load(P.ctl + CW_AMAX + 1, RLX_AGENT));
        for (int m = gw; m < MTOK; m += NGW) peer_coef_token(P, (size_t)m, iu, iv); } SEAM(12);
    if (IN(13)) { FRESH(); peer_side<1>(P, args); }

#undef IN
#undef SEAM
}

extern "C" void kernel_launch(void* const* d_in, const int* in_sizes, int n_in, void* d_out, int out_size, void* d_ws, size_t ws_size, hipStream_t stream) {
    static int grid = 0;
    if (grid == 0) {
        if (n_in != 15 || in_sizes[0] != MTOK * DM || out_size != MTOK * DM || ws_size < WS_END) { fprintf(stderr, "kernel_launch: unexpected shapes (n_in %d, in0 %d, out %d, ws %zu < %zu)\n", n_in, n_in > 0 ? in_sizes[0] : -1, out_size, ws_size, (size_t)WS_END); grid = -1; return; }
        int dev = 0, cus = 0, per_cu = 0;
        if (hipGetDevice(&dev) != hipSuccess || hipDeviceGetAttribute(&cus, hipDeviceAttributeMultiprocessorCount, dev) != hipSuccess) { grid = -1; return; }
        if (hipFuncSetAttribute((const void*)mk_fwd, hipFuncAttributeMaxDynamicSharedMemorySize, LDS_BYTES) != hipSuccess) { fprintf(stderr, "kernel_launch: hipFuncSetAttribute failed\n"); grid = -1; return; }
        if (hipOccupancyMaxActiveBlocksPerMultiprocessor(&per_cu, (const void*)mk_fwd, NWAVES * 64, LDS_BYTES) != hipSuccess || per_cu < 1) { fprintf(stderr, "kernel_launch: occupancy query says %d blocks per CU\n", per_cu); (void)hipGetLastError(); grid = -1; return; }
        grid = cus;
    }
    if (grid < 0) return;
    if (hipMemsetAsync((char*)d_ws + WS_CTL, 0, CTL_ZERO_BYTES, stream) != hipSuccess) return;
    Args a{};
    for (int i = 0; i < 15; ++i) a.in[i] = (const float*)d_in[i];
    a.out = (float*)d_out; a.ws = (unsigned char*)d_ws;
#if MK_PER_PHASE
    for (int p = 0; p < NPHASE; ++p) { a.ph_lo = p; a.ph_hi = p + 1; hipLaunchKernelGGL(mk_fwd, dim3(grid), dim3(NWAVES * 64), LDS_BYTES, stream, a); }
#else
    a.ph_lo = 0; a.ph_hi = NPHASE;
    hipLaunchKernelGGL(mk_fwd, dim3(grid), dim3(NWAVES * 64), LDS_BYTES, stream, a);
#endif
}
```

```cpp
#include <hip/hip_runtime.h>
#include <cstdio>
#include <cstdint>
namespace pg8 {
#define PG8_LAS __attribute__((address_space(3)))
typedef unsigned short bf16_t;
typedef short bf16x8 __attribute__((ext_vector_type(8)));
typedef float f32x4 __attribute__((ext_vector_type(4)));
typedef unsigned u32x4 __attribute__((ext_vector_type(4)));
constexpr int BM = 256, BK = 64, HALF = 128, HTB = HALF * BK * 2  , STAGE_BYTES = 8 * HTB, NXCD = 8, WGM = 8;

__host__ __device__ __forceinline__ int lds_byte(int r, int c) { const int st = (r >> 4) * 2 + (c >> 5), rr = r & 15, cc = c & 31, ob = rr * 64 + cc * 2; return st * 1024 + (ob ^ (((ob >> 9) & 1) << 5)); }
__host__ __device__ __forceinline__ void stage_rc(int b, int& R, int& C) { const int st = b / 1024, sb = b % 1024, swz = sb ^ (((sb >> 9) & 1) << 5); R = (st >> 1) * 16 + swz / 64; C = (st & 1) * 32 + (swz % 64) / 2; }
__host__ __device__ __forceinline__ int perm32(int rho) { const int n = rho >> 4, i = rho & 15; return 8 * (i >> 2) + 4 * n + (i & 3); }

struct Unit { int pm, pn; };
struct Gemm { const bf16_t* A; const bf16_t* Bt; int M, N, K, lda, ldb; };

struct StaticOrder {
    int nM, nN, nwg, G, c;
    __host__ __device__ void init(int M, int N, int G_, int c_) { nM = M / BM; nN = N / BM; nwg = nM * nN; G = G_; c = c_; }
    __host__ __device__ bool next(int i, Unit& u) const {
        const long L = (long)i * G + c; if (L >= nwg) return false;
        int wgid = (int)L; { const int q = nwg / NXCD, r = nwg % NXCD, xcd = wgid % NXCD, off = wgid / NXCD; wgid = (xcd < r ? xcd * (q + 1) : r * (q + 1) + (xcd - r) * q) + off; }
        const int nig = WGM * nN, gid = wgid / nig, fm = gid * WGM, gsz = (nM - fm) < WGM ? (nM - fm) : WGM;
        u.pm = fm + ((wgid % nig) % gsz); u.pn = (wgid % nig) / gsz; return true;
    }
    __device__ __forceinline__ void a_ready(const Unit&) const {}
    __device__ __forceinline__ void done(const Unit&) const {}
};
typedef float f32x2c_t __attribute__((ext_vector_type(2))); typedef __bf16 bf16x2c_t __attribute__((ext_vector_type(2)));
__device__ __forceinline__ unsigned cvt_pk_bf16(float lo, float hi) { f32x2c_t v = {lo, hi}; bf16x2c_t b = __builtin_convertvector(v, bf16x2c_t); return __builtin_bit_cast(unsigned, b); }
typedef float f32x2 __attribute__((ext_vector_type(2)));
__device__ __forceinline__ f32x2 gelu_pk(f32x2 v) {
    const f32x2 av = __builtin_elementwise_abs(v), d = av * 0.2316418882f + 1.0f;
    f32x2 t; t.x = __builtin_amdgcn_rcpf(d.x); t.y = __builtin_amdgcn_rcpf(d.y);
    f32x2 q = t * 0.5307027145f + (-0.7265760135f); q = q * t + 0.7107068705f; q = q * t + (-0.142248368f); q = q * t + 0.127414796f; q = q * t;
    const f32x2 s = (v * v) * (-0.72134752044f);
    f32x2 e; e.x = __builtin_amdgcn_exp2f(s.x); e.y = __builtin_amdgcn_exp2f(s.y);
    const f32x2 m = v * (q * e), r = v - m;
    f32x2 o; o.x = v.x < 0.f ? m.x : r.x; o.y = v.y < 0.f ? m.y : r.y; return o;
}
__device__ __forceinline__ float bf_lo(unsigned w) { return __uint_as_float(w << 16); }
__device__ __forceinline__ float bf_hi(unsigned w) { return __uint_as_float(w & 0xffff0000u); }
__device__ __forceinline__ float sigmoidf_fast(float g) { return __builtin_amdgcn_rcpf(1.0f + __builtin_amdgcn_exp2f(-1.4426950408889634f * g)); }
__device__ __forceinline__ unsigned ord_key(float f) { const unsigned b = __float_as_uint(f); return b ^ ((unsigned)((int)b >> 31) | 0x80000000u); }
__device__ __forceinline__ float unord_key(unsigned k) { return __uint_as_float((k & 0x80000000u) ? (k ^ 0x80000000u) : ~k); }

struct EpiStoreBf16 {
    static constexpr bool PERM = true, AFTER_DRAIN = false;
    bf16_t* O; int ldc;
    __device__ __forceinline__ void operator()(const f32x4 (&acc)[2][2][4][2], const Unit& u, int wr, int wc, int fr, int fq) const {
        const int row0 = u.pm * BM + wr * 64 + fr, col0 = u.pn * BM + wc * 32 + 8 * fq;
#pragma unroll
        for (int ai = 0; ai < 2; ++ai)
#pragma unroll
            for (int m = 0; m < 4; ++m) { bf16_t* rowp = O + (size_t)(row0 + ai * HALF + m * 16) * ldc + col0;
#pragma unroll
                for (int bj = 0; bj < 2; ++bj) { const f32x4 v0 = acc[ai][bj][m][0], v1 = acc[ai][bj][m][1];
                    u32x4 w; w.x = cvt_pk_bf16(v0[0], v0[1]); w.y = cvt_pk_bf16(v0[2], v0[3]); w.z = cvt_pk_bf16(v1[0], v1[1]); w.w = cvt_pk_bf16(v1[2], v1[3]);
                    *(u32x4*)(rowp + bj * HALF) = w; } }
    }
};
template <bool ADD> struct EpiGate {
    static constexpr bool PERM = true, AFTER_DRAIN = false;
    bf16_t* O; int ldc; const bf16_t* G; int ldg;
    __device__ __forceinline__ void operator()(const f32x4 (&acc)[2][2][4][2], const Unit& u, int wr, int wc, int fr, int fq) const {
        const int row0 = u.pm * BM + wr * 64 + fr, col0 = u.pn * BM + wc * 32 + 8 * fq;
#pragma unroll
        for (int ai = 0; ai < 2; ++ai)
#pragma unroll
            for (int m = 0; m < 4; ++m) { const size_t row = (size_t)(row0 + ai * HALF + m * 16);
#pragma unroll
                for (int bj = 0; bj < 2; ++bj) { const int col = col0 + bj * HALF;
                    const u32x4 gr = *(const u32x4*)(G + row * ldg + col);
                    f32x4 v0 = acc[ai][bj][m][0], v1 = acc[ai][bj][m][1];
                    v0[0] *= sigmoidf_fast(bf_lo(gr.x)); v0[1] *= sigmoidf_fast(bf_hi(gr.x)); v0[2] *= sigmoidf_fast(bf_lo(gr.y)); v0[3] *= sigmoidf_fast(bf_hi(gr.y));
                    v1[0] *= sigmoidf_fast(bf_lo(gr.z)); v1[1] *= sigmoidf_fast(bf_hi(gr.z)); v1[2] *= sigmoidf_fast(bf_lo(gr.w)); v1[3] *= sigmoidf_fast(bf_hi(gr.w));
                    bf16_t* op = O + row * ldc + col;
                    if (ADD) { const u32x4 pr = *(const u32x4*)op;
                        v0[0] += bf_lo(pr.x); v0[1] += bf_hi(pr.x); v0[2] += bf_lo(pr.y); v0[3] += bf_hi(pr.y);
                        v1[0] += bf_lo(pr.z); v1[1] += bf_hi(pr.z); v1[2] += bf_lo(pr.w); v1[3] += bf_hi(pr.w); }
                    u32x4 w; w.x = cvt_pk_bf16(v0[0], v0[1]); w.y = cvt_pk_bf16(v0[2], v0[3]); w.z = cvt_pk_bf16(v1[0], v1[1]); w.w = cvt_pk_bf16(v1[2], v1[3]);
                    *(u32x4*)op = w; } }
    }
};
struct EpiResF32 {
    static constexpr bool PERM = false, AFTER_DRAIN = false;
    const float* base; float* out; int ldc;
    __device__ __forceinline__ void operator()(const f32x4 (&acc)[2][2][4][2], const Unit& u, int wr, int wc, int fr, int fq) const {
        const int col0 = u.pn * BM + wc * 32 + 4 * fq;
#pragma unroll
        for (int ai = 0; ai < 2; ++ai)
#pragma unroll
            for (int m = 0; m < 4; ++m) { const size_t off = (size_t)(u.pm * BM + ai * HALF + wr * 64 + m * 16 + fr) * ldc + col0;
#pragma unroll
                for (int bj = 0; bj < 2; ++bj)
#pragma unroll
                    for (int n = 0; n < 2; ++n) { const f32x4 bs = *(const f32x4*)(base + off + bj * HALF + n * 16); *(f32x4*)(out + off + bj * HALF + n * 16) = bs + acc[ai][bj][m][n]; } }
    }
};
struct EpiKeys {
    static constexpr bool PERM = false, AFTER_DRAIN = false;
    unsigned* O; int ldc;
    __device__ __forceinline__ void operator()(const f32x4 (&acc)[2][2][4][2], const Unit& u, int wr, int wc, int fr, int fq) const {
        const int col0 = u.pn * BM + wc * 32 + 4 * fq;
#pragma unroll
        for (int ai = 0; ai < 2; ++ai)
#pragma unroll
            for (int m = 0; m < 4; ++m) { const size_t off = (size_t)(u.pm * BM + ai * HALF + wr * 64 + m * 16 + fr) * ldc + col0;
#pragma unroll
                for (int bj = 0; bj < 2; ++bj)
#pragma unroll
                    for (int n = 0; n < 2; ++n) { const int nn = (col0 + bj * HALF + n * 16) & 127; const f32x4 a = acc[ai][bj][m][n]; u32x4 w;
                        w.x = (ord_key(a[0]) & ~127u) | (unsigned)(127 - nn); w.y = (ord_key(a[1]) & ~127u) | (unsigned)(126 - nn);
                        w.z = (ord_key(a[2]) & ~127u) | (unsigned)(125 - nn); w.w = (ord_key(a[3]) & ~127u) | (unsigned)(124 - nn);
                        *(u32x4*)(O + off + bj * HALF + n * 16) = w; } }
    }
};

template <class Epi, class Sched, bool ALIGN_EPI = false, bool SP2 = false>
__device__ __forceinline__ void gemm_phase(PG8_LAS unsigned char* lds, const Gemm g, const Sched& S, const Epi& E) {
    int tid_ = threadIdx.x; asm volatile("" : "+v"(tid_));
    const int tid = tid_, wid = __builtin_amdgcn_readfirstlane(tid >> 6), lane = tid & 63, wr = wid >> 2, wc = wid & 3, fr = lane & 15, fq = lane >> 4;
    const int K = g.K, nt = K / BK;
    unsigned voffA[2], voffB[2];
#pragma unroll
    for (int i = 0; i < 2; ++i) { int R, C; stage_rc(tid * 16 + i * 8192, R, C); const int Rb = Epi::PERM ? ((R & ~31) + perm32(R & 31)) : R;
        voffA[i] = (unsigned)(R * g.lda + C) * 2u; voffB[i] = (unsigned)(Rb * g.ldb + C) * 2u; }
    const size_t kstep = (size_t)(BK * 2);
    const size_t hstepA = (size_t)HALF * g.lda * 2, hstepB = (size_t)HALF * g.ldb * 2;
    const size_t tstepA = 2 * hstepA, tstepB = 2 * hstepB;
    const unsigned ldsw = (unsigned)wid * 1024u;
    const int aoff = lds_byte(wr * 64 + fr, fq * 8), boff = lds_byte(wc * 32 + fr, fq * 8);
#define PG8_SA(b, h) (((b) * 2 + (h)) * HTB)
#define PG8_SB(b, h) ((4 + (b) * 2 + (h)) * HTB)
#define PG8_STAGE(bufoff, gbase, voff) do { _Pragma("unroll") for (int _i = 0; _i < 2; ++_i) \
        __builtin_amdgcn_global_load_lds((const unsigned*)((const char*)(gbase) + (voff)[_i]), (PG8_LAS unsigned*)(lds + (bufoff) + ldsw + _i * 8192), 16, 0, 0); } while (0)
#define PG8_LDA(dst, b, h) do { _Pragma("unroll") for (int m = 0; m < 4; ++m) _Pragma("unroll") for (int k = 0; k < 2; ++k) dst[m][k] = *(const PG8_LAS bf16x8*)(lds + PG8_SA(b, h) + aoff + m * 2048 + k * 1024); } while (0)
#define PG8_LDB(dst, b, h) do { _Pragma("unroll") for (int n = 0; n < 2; ++n) _Pragma("unroll") for (int k = 0; k < 2; ++k) dst[n][k] = *(const PG8_LAS bf16x8*)(lds + PG8_SB(b, h) + boff + n * 2048 + k * 1024); } while (0)
#define PG8_MMA(ai, bj, At, Bt) do { __builtin_amdgcn_s_setprio(1); _Pragma("unroll") for (int m = 0; m < 4; ++m) _Pragma("unroll") for (int n = 0; n < 2; ++n) _Pragma("unroll") for (int k = 0; k < 2; ++k) \
        acc[ai][bj][m][n] = __builtin_amdgcn_mfma_f32_16x16x32_bf16(Bt[n][k], At[m][k], acc[ai][bj][m][n], 0, 0, 0); __builtin_amdgcn_s_setprio(0); } while (0)
#define PG8_WAIT_V(n) asm volatile("s_waitcnt vmcnt(" #n ")" ::: "memory")
#define PG8_WAIT_L(n) asm volatile("s_waitcnt lgkmcnt(" #n ")" ::: "memory")
#define PG8_BAR __builtin_amdgcn_s_barrier()
#define PG8_SCHED __builtin_amdgcn_sched_barrier(0)
    Unit cur, nxt; int ui = 0;
    if (!S.next(0, cur)) return;
    f32x4 acc[2][2][4][2];
#pragma unroll
    for (int a = 0; a < 2; ++a)
#pragma unroll
        for (int b = 0; b < 2; ++b)
#pragma unroll
            for (int m = 0; m < 4; ++m)
#pragma unroll
                for (int n = 0; n < 2; ++n) acc[a][b][m][n] = (f32x4){0.f, 0.f, 0.f, 0.f};
    bf16x8 At[4][2], B0[2][2], B1[2][2];
    const char* cA = (const char*)g.A + (size_t)cur.pm * tstepA; const char* cB = (const char*)g.Bt + (size_t)cur.pn * tstepB;
    S.a_ready(cur);
    if constexpr (SP2) {
        PG8_STAGE(PG8_SB(0, 0), cB, voffB); PG8_STAGE(PG8_SB(0, 1), cB + hstepB, voffB); PG8_STAGE(PG8_SA(0, 0), cA, voffA); PG8_STAGE(PG8_SA(0, 1), cA + hstepA, voffA);
        if (wr == 1) PG8_BAR;
        PG8_WAIT_V(2); PG8_BAR;
        PG8_STAGE(PG8_SB(1, 0), cB + kstep, voffB); PG8_STAGE(PG8_SA(1, 0), cA + kstep, voffA); PG8_STAGE(PG8_SB(1, 1), cB + hstepB + kstep, voffB);
        PG8_WAIT_V(6); PG8_BAR;
    } else {
        PG8_STAGE(PG8_SB(0, 0), cB, voffB); PG8_STAGE(PG8_SA(0, 0), cA, voffA); PG8_STAGE(PG8_SB(0, 1), cB + hstepB, voffB); PG8_STAGE(PG8_SA(0, 1), cA + hstepA, voffA);
        if (wr == 1) PG8_BAR;
        PG8_WAIT_V(4); PG8_BAR;
        PG8_STAGE(PG8_SB(1, 0), cB + kstep, voffB); PG8_STAGE(PG8_SA(1, 0), cA + kstep, voffA); PG8_STAGE(PG8_SB(1, 1), cB + hstepB + kstep, voffB);
        PG8_WAIT_V(6); PG8_BAR;
    }
    for (;;) {
        const bool has_next = S.next(ui + 1, nxt);
        const char* nA = has_next ? (const char*)g.A + (size_t)nxt.pm * tstepA : cA; const char* nB = has_next ? (const char*)g.Bt + (size_t)nxt.pn * tstepB : cB;
        for (int t = 0; t < nt; t += 2) {
            const bool last = (t == nt - 2);
            const char* a1 = cA + (size_t)(t + 1) * kstep;
            const char* a2 = last ? nA : cA + (size_t)(t + 2) * kstep; const char* b2 = last ? nB : cB + (size_t)(t + 2) * kstep;
            const char* a3 = a2 + kstep; const char* b3 = b2 + kstep;
            if (last && has_next) S.a_ready(nxt);
            if constexpr (SP2) {
            PG8_LDB(B0, 0, 0); PG8_LDB(B1, 0, 1); PG8_SCHED; PG8_LDA(At, 0, 0); PG8_STAGE(PG8_SA(1, 1), a1 + hstepA, voffA);
            PG8_WAIT_V(8); PG8_WAIT_L(0); PG8_BAR; PG8_MMA(0, 0, At, B0); PG8_MMA(0, 1, At, B1); PG8_BAR; PG8_SCHED;
            PG8_LDA(At, 0, 1); PG8_STAGE(PG8_SB(0, 0), b2, voffB); PG8_STAGE(PG8_SB(0, 1), b2 + hstepB, voffB); PG8_STAGE(PG8_SA(0, 0), a2, voffA);
            PG8_WAIT_V(8); PG8_WAIT_L(0); PG8_BAR; PG8_MMA(1, 0, At, B0); PG8_MMA(1, 1, At, B1); PG8_BAR; PG8_SCHED;
            PG8_LDB(B0, 1, 0); PG8_LDB(B1, 1, 1); PG8_SCHED; PG8_LDA(At, 1, 0); PG8_STAGE(PG8_SA(0, 1), a2 + hstepA, voffA);
            PG8_WAIT_V(8); PG8_WAIT_L(0); PG8_BAR; PG8_MMA(0, 0, At, B0); PG8_MMA(0, 1, At, B1); PG8_BAR; PG8_SCHED;
            PG8_LDA(At, 1, 1); PG8_STAGE(PG8_SB(1, 0), b3, voffB); PG8_STAGE(PG8_SB(1, 1), b3 + hstepB, voffB); PG8_STAGE(PG8_SA(1, 0), a3, voffA);
            PG8_WAIT_V(8); PG8_WAIT_L(0); PG8_BAR; PG8_MMA(1, 0, At, B0); PG8_MMA(1, 1, At, B1); PG8_BAR; PG8_SCHED;
            } else {
            PG8_LDB(B0, 0, 0); PG8_SCHED; PG8_LDA(At, 0, 0); PG8_STAGE(PG8_SA(1, 1), a1 + hstepA, voffA);
            PG8_WAIT_L(8); PG8_BAR; PG8_WAIT_L(0); PG8_MMA(0, 0, At, B0); PG8_BAR; PG8_SCHED;
            PG8_LDB(B1, 0, 1); PG8_STAGE(PG8_SB(0, 0), b2, voffB);
            PG8_BAR; PG8_WAIT_L(0); PG8_MMA(0, 1, At, B1); PG8_BAR;
            PG8_LDA(At, 0, 1); PG8_STAGE(PG8_SA(0, 0), a2, voffA);
            PG8_BAR; PG8_WAIT_L(0); PG8_MMA(1, 0, At, B0); PG8_BAR; PG8_SCHED;
            PG8_STAGE(PG8_SB(0, 1), b2 + hstepB, voffB);
            PG8_WAIT_V(6); PG8_BAR; PG8_MMA(1, 1, At, B1); PG8_BAR;
            PG8_LDB(B0, 1, 0); PG8_SCHED; PG8_LDA(At, 1, 0); PG8_STAGE(PG8_SA(0, 1), a2 + hstepA, voffA);
            PG8_WAIT_L(8); PG8_BAR; PG8_WAIT_L(0); PG8_MMA(0, 0, At, B0); PG8_BAR; PG8_SCHED;
            PG8_LDB(B1, 1, 1); PG8_STAGE(PG8_SB(1, 0), b3, voffB);
            PG8_BAR; PG8_WAIT_L(0); PG8_MMA(0, 1, At, B1); PG8_BAR;
            PG8_LDA(At, 1, 1); PG8_STAGE(PG8_SA(1, 0), a3, voffA);
            PG8_BAR; PG8_WAIT_L(0); PG8_MMA(1, 0, At, B0); PG8_BAR; PG8_SCHED;
            PG8_STAGE(PG8_SB(1, 1), b3 + hstepB, voffB);
            PG8_WAIT_V(6); PG8_BAR; PG8_MMA(1, 1, At, B1); PG8_BAR;
            }
        }
        if constexpr (ALIGN_EPI) { if (wr == 0) PG8_BAR; }
        if constexpr (!Epi::AFTER_DRAIN) { E(acc, cur, wr, wc, fr, fq); S.done(cur); }
        if (!has_next) break;
#pragma unroll
        for (int a = 0; a < 2; ++a)
#pragma unroll
            for (int b = 0; b < 2; ++b)
#pragma unroll
                for (int m = 0; m < 4; ++m)
#pragma unroll
                    for (int n = 0; n < 2; ++n) acc[a][b][m][n] = (f32x4){0.f, 0.f, 0.f, 0.f};
        cur = nxt; cA = nA; cB = nB; ++ui;
        if constexpr (ALIGN_EPI) { if (wr == 1) PG8_BAR; }
    }
    PG8_WAIT_V(0);
    if constexpr (!ALIGN_EPI) { if (wr == 0) PG8_BAR; }
    PG8_BAR;
    if constexpr (Epi::AFTER_DRAIN) { E.fused(acc, cur, wr, wc, fr, fq, lds, wid, lane); S.done(cur); }
#undef PG8_SA
#undef PG8_SB
#undef PG8_STAGE
#undef PG8_LDA
#undef PG8_LDB
#undef PG8_MMA
#undef PG8_WAIT_V
#undef PG8_WAIT_L
#undef PG8_BAR
#undef PG8_SCHED
}
}

constexpr int NWAVES = 8;
#ifndef REPEAT_MASK
#define REPEAT_MASK 0
#endif
#ifndef PROBE_SEL2
#define PROBE_SEL2 1
#endif
#ifndef PROBE_NOSEL
#define PROBE_NOSEL 0
#endif
#ifndef MK_PER_PHASE
#define MK_PER_PHASE 0
#endif
constexpr int NPHASE = 14;

constexpr int BATCH = 16, SEQ = 4096, DM = 1024, MTOK = BATCH * SEQ;
constexpr int LDP = 4864;
constexpr int Q_OFF = 0, K_OFF = 512, V_OFF = 1024, QI_OFF = 1536, P_OFF = 2048, GA_OFF = 2560, GP_OFF = 3584, KI_OFF = 4608, WI_OFF = 4672;
constexpr int IN_WIDTH = 4680;
constexpr float EPS = 1e-6f;
constexpr float C2 = 0.125f * 1.4426950408889634f;
constexpr float WI_SCALE = 0.35355339059327373f * 0.125f;

constexpr size_t MiB = 1u << 20;
constexpr size_t WS_CTL = 0, CTL_ZERO_BYTES = 1 * MiB;
constexpr size_t WS_ROPE = 1 * MiB;
constexpr size_t WS_WIN = 2 * MiB;
constexpr size_t WS_WA = 12 * MiB;
constexpr size_t WS_WPP = 13 * MiB;
constexpr size_t WS_WO = 14 * MiB;
constexpr size_t WS_W2 = 16 * MiB;
constexpr size_t WS_U16 = 20 * MiB, WS_V16 = 52 * MiB;
constexpr size_t WS_MASK = 84 * MiB;
constexpr size_t WS_POOLED = 116 * MiB;
constexpr size_t WS_ACT = 180 * MiB;
constexpr size_t WS_PROJ = 308 * MiB;
constexpr size_t WS_AO = 916 * MiB;
constexpr size_t WS_REXP = 916 * MiB, WS_RG = 948 * MiB;
constexpr size_t WS_END = 1024 * MiB;
constexpr int CW_TMO = 0, CW_BAR = 4096, CW_AMAX = 12288;

constexpr int RING_BYTES = 131072;
constexpr int LDSCTL_OFF = RING_BYTES, MISC_OFF = LDSCTL_OFF + 320;
constexpr int LDS_BYTES = 147456;

#define GAS __attribute__((address_space(1)))
#define LAS __attribute__((address_space(3)))
typedef unsigned short bf16;
typedef unsigned v4u __attribute__((ext_vector_type(4)));
typedef unsigned v2u __attribute__((ext_vector_type(2)));
typedef float f32x4 __attribute__((ext_vector_type(4)));
typedef float f32x16 __attribute__((ext_vector_type(16)));
typedef short bf16x8 __attribute__((ext_vector_type(8)));
typedef short s16x4 __attribute__((ext_vector_type(4)));
typedef GAS unsigned gu32;
#define RLX_AGENT __ATOMIC_RELAXED, __HIP_MEMORY_SCOPE_AGENT
#define LDS_WAIT() asm volatile("s_waitcnt lgkmcnt(0)" ::: "memory")
#define VM_WAIT() asm volatile("s_waitcnt vmcnt(0)" ::: "memory")
__device__ __forceinline__ unsigned f2bf(float f) { unsigned u = __builtin_bit_cast(unsigned, f); return (u + 0x7fffu + ((u >> 16) & 1u)) >> 16; }
__device__ __forceinline__ unsigned pk2(float lo, float hi) { return f2bf(lo) | (f2bf(hi) << 16); }
__device__ __forceinline__ float bflo(unsigned w) { return __uint_as_float(w << 16); }
__device__ __forceinline__ float bfhi(unsigned w) { return __uint_as_float(w & 0xffff0000u); }
__device__ __forceinline__ unsigned ordk(float f) { const unsigned b = __float_as_uint(f); return b ^ ((unsigned)((int)b >> 31) | 0x80000000u); }
__device__ __forceinline__ float unordk(unsigned k) { return __uint_as_float((k & 0x80000000u) ? (k ^ 0x80000000u) : ~k); }
__device__ __forceinline__ int crow(int r, int hi) { return (r & 3) + 8 * (r >> 2) + 4 * hi; }

#define XB_TMO      128
#define XB_XCNT(j)  (256  + 64 * (j))
#define XB_XSUB(j)  (1280 + 64 * (j))
#define XB_XGEN(j)  (2304 + 64 * (j))
#define XB_TOP      3328
#define XB_TOPGEN   3392
#define XCD_BAR_WORDS 3456
#define XB_SPIN_CAP (1u << 18)

__device__ __forceinline__ unsigned xb_ld(unsigned* p)              { return __hip_atomic_load(p, __ATOMIC_RELAXED, __HIP_MEMORY_SCOPE_AGENT); }
__device__ __forceinline__ unsigned xb_add(unsigned* p, unsigned v) { return __hip_atomic_fetch_add(p, v, __ATOMIC_RELAXED, __HIP_MEMORY_SCOPE_AGENT); }
__device__ __forceinline__ unsigned xb_xcc_id() { return (unsigned)__builtin_amdgcn_s_getreg((3 << 11) | 20) & 0xFu; }
#define XB_SPIN(cond, bar) do { unsigned _sp = 0; while (cond) { __builtin_amdgcn_s_sleep(1); \
    if ((++_sp & 255u) == 0u) { if (xb_ld(&(bar)[XB_TMO])) break; if (_sp > XB_SPIN_CAP) { atomicAdd(&(bar)[XB_TMO], 1u); break; } } } } while (0)

struct XcdBarrier {
    unsigned* bar; unsigned x;
    volatile LAS unsigned* st;
};

__device__ __forceinline__ XcdBarrier xcd_barrier_post(unsigned* bar, volatile LAS unsigned* st) {
    XcdBarrier b; b.bar = bar; b.x = xb_xcc_id(); b.st = st;
    if (threadIdx.x == 0) (void)xb_add(&bar[XB_XCNT(b.x)], 1u);
    return b;
}
__device__ __forceinline__ void xcd_barrier_complete(unsigned* bar, unsigned x, unsigned& nloc, unsigned& nx) {
    const unsigned G = gridDim.x * gridDim.y * gridDim.z;
    unsigned sum, cnt, mine, sp = 0u;
    for (;;) {
        sum = 0u; cnt = 0u; mine = 0u;
#pragma unroll
        for (unsigned j = 0; j < 16; ++j) { const unsigned c = xb_ld(&bar[XB_XCNT(j)]); sum += c; cnt += (c > 0u) ? 1u : 0u; mine = (j == x) ? c : mine; }
        if (sum == G) break;
        __builtin_amdgcn_s_sleep(1);
        if ((++sp & 255u) == 0u) { if (xb_ld(&bar[XB_TMO])) break; if (sp > XB_SPIN_CAP) { atomicAdd(&bar[XB_TMO], 1u); break; } }
    }
    nloc = mine > 0u ? mine : 1u; nx = cnt > 0u ? cnt : 1u;
}

__device__ __forceinline__ void xcd_barrier(const XcdBarrier& b) {
    asm volatile("s_waitcnt vmcnt(0)" ::: "memory");
    __syncthreads();
    if (threadIdx.x == 0) {
        unsigned* bar = b.bar;
        __builtin_amdgcn_s_waitcnt(0);
        unsigned nloc = b.st[0], nx = b.st[1];
        if (nloc == 0u) { xcd_barrier_complete(bar, b.x, nloc, nx); b.st[0] = nloc; b.st[1] = nx; }
        const unsigned old = xb_add(&bar[XB_XSUB(b.x)], 1u);
        const unsigned gen = old / nloc;
        if (old + 1u == (gen + 1u) * nloc) {
            __builtin_amdgcn_fence(__ATOMIC_RELEASE, "agent");
            asm volatile("s_waitcnt vmcnt(0)" ::: "memory");
            const unsigned og = xb_add(&bar[XB_TOP], 1u);
            const unsigned tg = og / nx;
            if (og + 1u == (tg + 1u) * nx) xb_add(&bar[XB_TOPGEN], 1u);
            else XB_SPIN(xb_ld(&bar[XB_TOPGEN]) == tg, bar);
            __builtin_amdgcn_fence(__ATOMIC_ACQUIRE, "agent");
            xb_add(&bar[XB_XGEN(b.x)], 1u);
            asm volatile("s_waitcnt vmcnt(0)" ::: "memory");
        } else {
            XB_SPIN(xb_ld(&bar[XB_XGEN(b.x)]) == gen, bar);
            __builtin_amdgcn_fence(__ATOMIC_ACQUIRE, "agent");
            asm volatile("s_waitcnt vmcnt(0)" ::: "memory");
        }
    }
    __syncthreads();
}


struct Frame {
    LAS unsigned char* lds;
    volatile LAS unsigned* MISC;
    gu32* ctl;
    unsigned char* ws;
    int tid, lane, wave, vcu, G;
};
struct Args { const float* in[15]; float* out; unsigned char* ws; int ph_lo, ph_hi; };

__device__ __forceinline__ float wave_sum(float v) {
#pragma unroll
    for (int o = 1; o < 64; o <<= 1) v += __shfl_xor(v, o);
    return v;
}

template <class ColMap>
__device__ __forceinline__ void p0_transpose_item(const float* W, int K, int N, bf16* WT, int nblk, LAS float* scr, int item, int lane, ColMap cm) {
    const int kb = item / nblk, nb = item % nblk, k0 = 64 * kb, n0 = 32 * nb;
    const int src = cm(n0 + (lane & 31));
#pragma unroll 8
    for (int i = 0; i < 32; ++i) { const int kk = 2 * i + (lane >> 5); scr[kk * 33 + (lane & 31)] = (src >= 0) ? W[(size_t)(k0 + kk) * N + src] : 0.f; }
    LDS_WAIT(); asm volatile("" ::: "memory");
    const int c = lane & 7;
#pragma unroll
    for (int j = 0; j < 4; ++j) { const int n = (lane >> 3) + 8 * j; const LAS float* s = scr + (8 * c) * 33 + n;
        v4u o; o.x = pk2(s[0 * 33], s[1 * 33]); o.y = pk2(s[2 * 33], s[3 * 33]); o.z = pk2(s[4 * 33], s[5 * 33]); o.w = pk2(s[6 * 33], s[7 * 33]);
        *(GAS v4u*)(WT + (size_t)(n0 + n) * K + k0 + 8 * c) = o; }
    LDS_WAIT(); asm volatile("" ::: "memory");
}
struct MapIdent { __device__ __forceinline__ int operator()(int n) const { return n; } };
struct MapWin { __device__ __forceinline__ int operator()(int n) const {
    if (n < 2048) return n;
    if (n < 2560) return 2120 + (n - 2048);
    if (n < 4608) return 2632 + (n - 2560);
    if (n < 4672) return 2048 + (n - 4608);
    if (n < 4680) return 2112 + (n - 4672);
    return -1; } };

__device__ __forceinline__ void rms_row_to_bf16(const float* xrow, const float* g, bf16* orow, int lane) {
    const GAS f32x4* xr = (const GAS f32x4*)xrow + lane; const GAS f32x4* gr = (const GAS f32x4*)g + lane;
    f32x4 v[4]; float s = 0.f;
#pragma unroll
    for (int j = 0; j < 4; ++j) { v[j] = xr[64 * j]; s += (v[j].x * v[j].x + v[j].y * v[j].y) + (v[j].z * v[j].z + v[j].w * v[j].w); }
    const float rs = 1.0f / sqrtf(wave_sum(s) * (1.f / 1024.f) + EPS);
    GAS unsigned long long* o8 = (GAS unsigned long long*)orow + lane;
#pragma unroll
    for (int j = 0; j < 4; ++j) { const f32x4 gg = gr[64 * j];
        o8[64 * j] = (unsigned long long)pk2(v[j].x * rs * gg.x, v[j].y * rs * gg.y) | ((unsigned long long)pk2(v[j].z * rs * gg.z, v[j].w * rs * gg.w) << 32); }
}

__device__ __forceinline__ void p0_prologue(Frame& F, const Args& AR) {
    LAS float* scr = (LAS float*)(F.lds + F.wave * 16384);
    const int gw = F.vcu * NWAVES + F.wave, NGW = F.G * NWAVES, lane = F.lane;
    constexpr int I_WIN = 16 * 152, I_WA = 8 * 32, I_WO = 16 * 32;
    for (int it = gw; it < I_WIN + I_WA + I_WO; it += NGW) {
        int r = it;
        if (r < I_WIN) { p0_transpose_item((AR.in[2]), 1024, IN_WIDTH, ((bf16*)(F.ws + WS_WIN)), 152, scr, r, lane, MapWin()); continue; } r -= I_WIN;
        if (r < I_WA) { p0_transpose_item((AR.in[7]), 512, 1024, ((bf16*)(F.ws + WS_WA)), 32, scr, r, lane, MapIdent()); continue; } r -= I_WA;
        p0_transpose_item((AR.in[9]), 1024, 1024, ((bf16*)(F.ws + WS_WO)), 32, scr, r, lane, MapIdent());
    }
    for (int it = gw; it < 16 * 64; it += NGW) {
        const int nb = it & 15, kb = it >> 4, n = nb * 64 + lane, k0 = kb * 8, g = k0 >> 7, c0 = k0 & 127;
        float acc[8];
#pragma unroll
        for (int j = 0; j < 8; ++j) acc[j] = 0.f;
        for (int d = 0; d < 128; ++d) {
            const float wv = (AR.in[8])[(size_t)(g * 128 + d) * 1024 + n] * (AR.in[6])[g * 128 + d];
#pragma unroll
            for (int j = 0; j < 8; ++j) acc[j] += (AR.in[5])[(size_t)(g * 128 + c0 + j) * 128 + d] * wv;
        }
        v4u o; o.x = pk2(acc[0], acc[1]); o.y = pk2(acc[2], acc[3]); o.z = pk2(acc[4], acc[5]); o.w = pk2(acc[6], acc[7]);
        *(GAS v4u*)(((bf16*)(F.ws + WS_WPP)) + (size_t)n * 512 + k0) = o;
    }
    for (int it = gw; it < 32 * 16; it += NGW) {
        const int nb = it & 31, kb = it >> 5, np = nb * 64 + lane, hp = nb >> 1, k0 = kb * 64;
#pragma unroll 4
        for (int d4 = 0; d4 < 16; ++d4) { const f32x4 t = *(const GAS f32x4*)((AR.in[12]) + (size_t)np * 64 + d4 * 4);
            scr[(4 * d4 + 0) * 64 + lane] = t.x; scr[(4 * d4 + 1) * 64 + lane] = t.y; scr[(4 * d4 + 2) * 64 + lane] = t.z; scr[(4 * d4 + 3) * 64 + lane] = t.w; }
        LDS_WAIT(); asm volatile("" ::: "memory");
#pragma unroll 1
        for (int k8 = 0; k8 < 8; ++k8) {
            float acc[8];
#pragma unroll
            for (int j = 0; j < 8; ++j) acc[j] = 0.f;
            const float* wr = (AR.in[11]) + (size_t)(k0 + k8 * 8) * 1024 + hp * 64;
#pragma unroll 4
            for (int d = 0; d < 64; ++d) { const float sv = scr[d * 64 + lane];
#pragma unroll
                for (int j = 0; j < 8; ++j) acc[j] += wr[(size_t)j * 1024 + d] * sv; }
            v4u o; o.x = pk2(acc[0], acc[1]); o.y = pk2(acc[2], acc[3]); o.z = pk2(acc[4], acc[5]); o.w = pk2(acc[6], acc[7]);
            *(GAS v4u*)(((bf16*)(F.ws + WS_W2)) + (size_t)np * 1024 + k0 + k8 * 8) = o;
        }
        LDS_WAIT(); asm volatile("" ::: "memory");
    }
    {   float mu = 0.f, mv = 0.f;
        for (int it = gw; it < 2 * 32768; it += NGW) {
            const float* src = (it < 32768) ? (AR.in[13]) : (AR.in[14]); const size_t e0 = (size_t)(it & 32767) * 512 + lane * 8;
            const f32x4 a = *(const GAS f32x4*)(src + e0), b = *(const GAS f32x4*)(src + e0 + 4);
            const float m = fmaxf(fmaxf(fmaxf(fabsf(a.x), fabsf(a.y)), fmaxf(fabsf(a.z), fabsf(a.w))), fmaxf(fmaxf(fabsf(b.x), fabsf(b.y)), fmaxf(fabsf(b.z), fabsf(b.w))));
            if (it < 32768) mu = fmaxf(mu, m); else mv = fmaxf(mv, m);
        }
#pragma unroll
        for (int o = 1; o < 64; o <<= 1) { mu = fmaxf(mu, __shfl_xor(mu, o)); mv = fmaxf(mv, __shfl_xor(mv, o)); }
        if (lane == 0) { __hip_atomic_fetch_max(F.ctl + CW_AMAX, __float_as_uint(mu), RLX_AGENT); __hip_atomic_fetch_max(F.ctl + CW_AMAX + 1, __float_as_uint(mv), RLX_AGENT); }
    }
    for (int it = gw * 64 + lane; it < 4096 * 8; it += NGW * 64) {
        const int pos = it >> 3, i = it & 7;
        const float invf = exp2f(-(float)i * 0.125f * 18.931568569324174f);
        const double ang = (double)((float)pos * invf);
        const double kq = __builtin_rint(ang * 0.6366197723675814);
        const float r = (float)(ang - kq * 1.5707963267948966);
        const int q = (int)((long long)kq & 3);
        const float r2 = r * r;
        const float sn = r + r * r2 * (-1.6666654611e-1f + r2 * (8.3321608736e-3f + r2 * (-1.9515295891e-4f)));
        const float cs = 1.0f - 0.5f * r2 + r2 * r2 * (4.166664568298827e-2f + r2 * (-1.388731625493765e-3f + r2 * 2.443315711809948e-5f));
        const float s = (q == 0) ? sn : (q == 1) ? cs : (q == 2) ? -sn : -cs;
        const float c = (q == 0) ? cs : (q == 1) ? -sn : (q == 2) ? -cs : sn;
        ((float*)(F.ws + WS_ROPE))[pos * 16 + i] = c; ((float*)(F.ws + WS_ROPE))[pos * 16 + 8 + i] = s;
    }
    for (int m = gw; m < MTOK; m += NGW) rms_row_to_bf16((AR.in[0]) + (size_t)m * DM, (AR.in[1]), ((bf16*)(F.ws + WS_ACT)) + (size_t)m * DM, lane);
}

__device__ __forceinline__ void unpack8(const v4u w, float (&v)[8]) { v[0] = bflo(w.x); v[1] = bfhi(w.x); v[2] = bflo(w.y); v[3] = bfhi(w.y); v[4] = bflo(w.z); v[5] = bfhi(w.z); v[6] = bflo(w.w); v[7] = bfhi(w.w); }
__device__ __forceinline__ v4u pack8(const float (&v)[8]) { v4u o; o.x = pk2(v[0], v[1]); o.y = pk2(v[2], v[3]); o.z = pk2(v[4], v[5]); o.w = pk2(v[6], v[7]); return o; }
__device__ __forceinline__ void rope8(float (&v)[8], int sub, const float (&cs)[8], const float (&sn)[8]) {
    float pv[8];
#pragma unroll
    for (int j = 0; j < 8; ++j) pv[j] = __shfl_xor(v[j], 1);
    if (sub == 0) {
#pragma unroll
        for (int j = 0; j < 8; ++j) v[j] = v[j] * cs[j] - pv[j] * sn[j];
    } else if (sub == 1) {
#pragma unroll
        for (int j = 0; j < 8; ++j) v[j] = v[j] * cs[j] + pv[j] * sn[j];
    }
}
__device__ __forceinline__ float fp8_scale(unsigned amax_bits) { const unsigned be = (amax_bits >> 23) & 0xffu; return (be == 0u || be > 250u) ? 1.0f : __uint_as_float((261u - be) << 23); }
__device__ __forceinline__ float fp8_inv_scale(unsigned amax_bits) { const unsigned be = (amax_bits >> 23) & 0xffu; return (be == 0u || be > 250u) ? 1.0f : __uint_as_float((be - 7u) << 23); }
__device__ __forceinline__ void row_to_fp8(const float* src, unsigned char* dst, float sc, int lane) {
    const GAS f32x4* p = (const GAS f32x4*)src + lane * 4; v4u o;
#pragma unroll
    for (int q = 0; q < 4; ++q) { const f32x4 a = p[q]; int w = 0; w = __builtin_amdgcn_cvt_pk_fp8_f32(a.x * sc, a.y * sc, w, false); w = __builtin_amdgcn_cvt_pk_fp8_f32(a.z * sc, a.w * sc, w, true); o[q] = (unsigned)w; }
    *(GAS v4u*)(dst + lane * 16) = o;
}
__device__ __forceinline__ void fixup_token(Frame& F, const Args& AR, int tok) {
    const int lane = F.lane, sub = lane & 7, pos = tok & (SEQ - 1);
    bf16* row = ((bf16*)(F.ws + WS_PROJ)) + (size_t)tok * LDP;
    float cs[8], sn[8];
    { const GAS f32x4* rt = (const GAS f32x4*)(((float*)(F.ws + WS_ROPE)) + pos * 16); const f32x4 a = rt[0], b = rt[1], c = rt[2], d = rt[3];
      cs[0] = a.x; cs[1] = a.y; cs[2] = a.z; cs[3] = a.w; cs[4] = b.x; cs[5] = b.y; cs[6] = b.z; cs[7] = b.w;
      sn[0] = c.x; sn[1] = c.y; sn[2] = c.z; sn[3] = c.w; sn[4] = d.x; sn[5] = d.y; sn[6] = d.z; sn[7] = d.w; }
#pragma unroll
    for (int which = 0; which < 2; ++which) {
        GAS v4u* p = (GAS v4u*)(row + (which ? K_OFF : Q_OFF) + lane * 8);
        float v[8]; unpack8(*p, v);
        float ss = 0.f;
#pragma unroll
        for (int j = 0; j < 8; ++j) ss += v[j] * v[j];
        ss += __shfl_xor(ss, 1); ss += __shfl_xor(ss, 2); ss += __shfl_xor(ss, 4);
        const float rs = 1.0f / sqrtf(ss * (1.f / 64.f) + EPS);
        const float* g = (which ? (AR.in[4]) : (AR.in[3])) + sub * 8;
#pragma unroll
        for (int j = 0; j < 8; ++j) v[j] = v[j] * rs * g[j];
        rope8(v, sub, cs, sn);
        if (which == 0) {
#pragma unroll
            for (int j = 0; j < 8; ++j) v[j] *= C2;
        }
        *p = pack8(v);
    }
    { GAS v4u* p = (GAS v4u*)(row + QI_OFF + lane * 8); float v[8]; unpack8(*p, v); rope8(v, sub, cs, sn); *p = pack8(v); }
    { GAS v4u* p = (GAS v4u*)(row + KI_OFF + (lane & 7) * 8); float v[8]; unpack8(*p, v); rope8(v, sub, cs, sn); if (lane < 8) *p = pack8(v); }
    { const int g = lane >> 4, w = 2 << g;
      float acc[8], cur[8];
#pragma unroll
      for (int j = 0; j < 8; ++j) acc[j] = 0.f;
      unpack8(*(const GAS v4u*)(row + P_OFF + lane * 8), cur);
#pragma unroll
      for (int j = 0; j < 8; ++j) acc[j] = cur[j];
#pragma unroll
      for (int back = 1; back < 16; ++back) {
          if (back < w && back <= pos) { float t[8]; unpack8(*(const GAS v4u*)(row - (size_t)back * LDP + P_OFF + lane * 8), t);
#pragma unroll
              for (int j = 0; j < 8; ++j) acc[j] += t[j]; }
      }
      const float inv = 1.0f / (float)((pos + 1 < w) ? (pos + 1) : w);
      float o[8];
#pragma unroll
      for (int j = 0; j < 8; ++j) o[j] = acc[j] * inv - cur[j];
      *(GAS v4u*)(((bf16*)(F.ws + WS_POOLED)) + (size_t)tok * 512 + lane * 8) = pack8(o); }
}

__device__ __forceinline__ int wave_incl_scan(int v) {
    v += __builtin_amdgcn_update_dpp(0, v, 0x111, 0xf, 0xf, false);
    v += __builtin_amdgcn_update_dpp(0, v, 0x112, 0xf, 0xf, false);
    v += __builtin_amdgcn_update_dpp(0, v, 0x114, 0xf, 0xf, false);
    v += __builtin_amdgcn_update_dpp(0, v, 0x118, 0xf, 0xf, false);
    v += __builtin_amdgcn_update_dpp(0, v, 0x142, 0xa, 0xf, false);
    v += __builtin_amdgcn_update_dpp(0, v, 0x143, 0xc, 0xf, false);
    return v;
}
template <int NB> __device__ __forceinline__ void hist_search(const LAS unsigned* hist, int need, int lane, int& B, int& G, int& E) {
    constexpr int PER = NB / 64;
    int t = 0;
#pragma unroll
    for (int q = 0; q < PER / 4; ++q) { const v4u h = *(const LAS v4u*)(hist + lane * PER + 4 * q); t += (int)(h.x + h.y + h.z + h.w); }
    const int pfx = wave_incl_scan(t);
    const int L = __ffsll((long long)__ballot(pfx >= need)) - 1;
    const int base = __builtin_amdgcn_readlane(pfx, L) - __builtin_amdgcn_readlane(t, L);
    const int hv = (lane < PER) ? (int)hist[L * PER + lane] : 0;
    const int p2 = wave_incl_scan(hv) + base;
    const int i = __ffsll((long long)__ballot(p2 >= need)) - 1;
    B = L * PER + i; E = __builtin_amdgcn_readlane(hv, i); G = __builtin_amdgcn_readlane(p2, i) - E;
}
template <int NB> __device__ __forceinline__ void hist_zero(LAS unsigned* hist, int lane) {
#pragma unroll
    for (int q = 0; q < NB / 256; ++q) *(LAS v4u*)(hist + q * 256 + lane * 4) = (v4u){0u, 0u, 0u, 0u};
}
#define HIST_ADD(p) (void)__hip_atomic_fetch_add((p), 1u, __ATOMIC_RELAXED, __HIP_MEMORY_SCOPE_WORKGROUP)
#define wlane(dst, sval, j) asm volatile("s_nop 3\n\tv_writelane_b32 %0, %1, %2\n\ts_nop 1" : "+v"(dst) : "s"(sval), "i"(j))
__device__ __forceinline__ void select_row(const float* srow, LAS unsigned* hist, int nj, int lastw, GAS unsigned long long* mout, int lane) {
    unsigned key[64];
#pragma unroll
    for (int g = 0; g < 8; ++g) {
        if (nj > 8 * g) {
#pragma unroll
            for (int jj = 0; jj < 8; ++jj) key[8 * g + jj] = ordk(((const GAS float*)srow)[64 * (8 * g + jj) + lane] + 0.0f);
        } else {
#pragma unroll
            for (int jj = 0; jj < 8; ++jj) key[8 * g + jj] = 0u;
        }
    }
    LDS_WAIT(); asm volatile("" ::: "memory");
    int need = 256, B, G, E;
    hist_zero<2048>(hist, lane); LDS_WAIT(); asm volatile("" ::: "memory");
#pragma unroll
    for (int g = 0; g < 8; ++g) if (nj > 8 * g) {
#pragma unroll
        for (int jj = 0; jj < 8; ++jj) HIST_ADD(hist + (2047u - (key[8 * g + jj] >> 21)));
    }
    LDS_WAIT(); asm volatile("" ::: "memory");
    hist_search<2048>(hist, need, lane, B, G, E); need -= G;
    const unsigned d1 = 2047u - (unsigned)B;
    asm volatile("" ::: "memory"); hist_zero<2048>(hist, lane); LDS_WAIT(); asm volatile("" ::: "memory");
#pragma unroll
    for (int g = 0; g < 8; ++g) if (nj > 8 * g) {
#pragma unroll
        for (int jj = 0; jj < 8; ++jj) { const unsigned k = key[8 * g + jj]; if ((k >> 21) == d1) HIST_ADD(hist + (2047u - ((k >> 10) & 0x7ffu))); }
    }
    LDS_WAIT(); asm volatile("" ::: "memory");
    hist_search<2048>(hist, need, lane, B, G, E); need -= G;
    const unsigned pre2 = (d1 << 11) | (2047u - (unsigned)B);
    asm volatile("" ::: "memory"); hist_zero<1024>(hist, lane); LDS_WAIT(); asm volatile("" ::: "memory");
#pragma unroll
    for (int g = 0; g < 8; ++g) if (nj > 8 * g) {
#pragma unroll
        for (int jj = 0; jj < 8; ++jj) { const unsigned k = key[8 * g + jj]; if ((k >> 10) == pre2) HIST_ADD(hist + (1023u - (k & 0x3ffu))); }
    }
    LDS_WAIT(); asm volatile("" ::: "memory");
    hist_search<1024>(hist, need, lane, B, G, E); need -= G;
    const unsigned v = (pre2 << 10) | (1023u - (unsigned)B);
    unsigned mlo = 0u, mhi = 0u;
    if (need == E) {
#pragma unroll
        for (int j = 0; j < 64; ++j) { const unsigned long long m = __ballot(key[j] >= v); wlane(mlo, (unsigned)m, j); wlane(mhi, (unsigned)(m >> 32), j); }
    } else {
#pragma unroll
        for (int j = 0; j < 64; ++j) {
            unsigned long long eq = __ballot(key[j] == v); const unsigned long long gt = __ballot(key[j] > v);
            unsigned long long keep = 0ull;
            while (need > 0 && eq != 0ull) { const unsigned long long lsb = eq & (0ull - eq); keep |= lsb; eq ^= lsb; --need; }
            const unsigned long long m = gt | keep;
            wlane(mlo, (unsigned)m, j); wlane(mhi, (unsigned)(m >> 32), j);
        }
    }
    if (lane <= lastw) mout[lane] = ((unsigned long long)mhi << 32) | (unsigned long long)mlo;
    LDS_WAIT(); asm volatile("" ::: "memory");
}

__device__ __forceinline__ float* wave_scratch(unsigned char* ws, int gwv) {
    if (gwv < 1024) return (float*)(ws + WS_ACT) + (size_t)gwv * 32768;
    gwv -= 1024; if (gwv < 512) return (float*)(ws + WS_AO) + (size_t)gwv * 32768;
    gwv -= 512; if (gwv < 352) return (float*)(ws + 980 * MiB) + (size_t)gwv * 32768;
    gwv -= 352; if (gwv < 128) return (float*)(ws + 36 * MiB) + (size_t)gwv * 32768;
    gwv -= 128; return (float*)(ws + 68 * MiB) + (size_t)(gwv & 127) * 32768;
}
__device__ __forceinline__ void idx_unit(Frame& F, const Args& AR, int b, int c, bool do_select = true) {
    const int lane = F.lane, wid = F.wave, l31 = lane & 31, h2 = lane >> 5;
    const size_t rowb = (size_t)b * SEQ, tp0 = rowb + (size_t)c * 64 + wid * 8;
    GAS unsigned long long* mbase = (GAS unsigned long long*)(((unsigned long long*)(F.ws + WS_MASK)) + tp0 * 64);
    if (c < 4) {
        if (lane < 32) { const int q = lane >> 2, j = lane & 3; mbase[q * 64 + j] = (j <= c) ? ~0ull : 0ull; }
        return;
    }
    float* sc = wave_scratch(F.ws, F.vcu * NWAVES + wid);
    LAS unsigned* hist = (LAS unsigned*)(F.lds + wid * 8192);
    const int ntile = 2 * (c + 1), nj = c + 1, lastw = c | 3, ntile_pad = 16 * ((nj + 7) >> 3);
    const int head = (l31 & 3) | (((l31 >> 3) & 1) << 2), qsub = ((l31 >> 2) & 1) | (((l31 >> 4) & 1) << 1);
    bf16x8 a[2][4]; float w[2][16];
#pragma unroll
    for (int rb = 0; rb < 2; ++rb) {
        const bf16* ap = ((bf16*)(F.ws + WS_PROJ)) + (tp0 + 4 * rb + qsub) * LDP + QI_OFF + head * 64 + h2 * 8;
#pragma unroll
        for (int st = 0; st < 4; ++st) a[rb][st] = *(const GAS bf16x8*)(ap + st * 16);
        const v4u wa = *(const GAS v4u*)(((bf16*)(F.ws + WS_PROJ)) + (tp0 + 4 * rb + h2) * LDP + WI_OFF), wb = *(const GAS v4u*)(((bf16*)(F.ws + WS_PROJ)) + (tp0 + 4 * rb + h2 + 2) * LDP + WI_OFF);
        float t[8]; unpack8(wa, t);
#pragma unroll
        for (int j = 0; j < 8; ++j) w[rb][j] = t[j] * WI_SCALE;
        unpack8(wb, t);
#pragma unroll
        for (int j = 0; j < 8; ++j) w[rb][8 + j] = t[j] * WI_SCALE;
    }
    {
        LAS unsigned char* kb = F.lds + 65536;
        const int nstage = (ntile + 3) >> 2;
        const int sk0 = F.tid >> 3, sch = F.tid & 7;
        const bf16* kg = ((bf16*)(F.ws + WS_PROJ)) + (rowb + sk0) * LDP + KI_OFF + sch * 8;
        v4u r0 = *(const GAS v4u*)kg, r1 = *(const GAS v4u*)(kg + (size_t)64 * LDP);
#pragma unroll 1
        for (int sg = 0; sg < nstage; ++sg) {
            LAS unsigned char* cur = kb + (sg & 1) * 18432;
            *(LAS v4u*)(cur + sk0 * 144 + sch * 16) = r0; *(LAS v4u*)(cur + (sk0 + 64) * 144 + sch * 16) = r1;
            __syncthreads();
            if (sg + 1 < nstage) { r0 = *(const GAS v4u*)(kg + (size_t)(sg + 1) * 128 * LDP); r1 = *(const GAS v4u*)(kg + (size_t)((sg + 1) * 128 + 64) * LDP); }
#pragma unroll
            for (int t4 = 0; t4 < 4; ++t4) {
                const int kt = 4 * sg + t4;
                if (kt < ntile) {
                    bf16x8 bfr[4];
#pragma unroll
                    for (int st = 0; st < 4; ++st) bfr[st] = *(const LAS bf16x8*)(cur + (t4 * 32 + l31) * 144 + st * 32 + h2 * 16);
#pragma unroll
                    for (int rb = 0; rb < 2; ++rb) {
                        f32x16 acc;
#pragma unroll
                        for (int r = 0; r < 16; ++r) acc[r] = 0.f;
#pragma unroll
                        for (int st = 0; st < 4; ++st) acc = __builtin_amdgcn_mfma_f32_32x32x16_bf16(a[rb][st], bfr[st], acc, 0, 0, 0);
                        float s0 = 0.f, s1 = 0.f;
#pragma unroll
                        for (int r = 0; r < 8; ++r) { s0 = fmaf(w[rb][r], fmaxf(acc[r], 0.f), s0); s1 = fmaf(w[rb][8 + r], fmaxf(acc[8 + r], 0.f), s1); }
                        ((GAS float*)sc)[(4 * rb + h2) * 4096 + kt * 32 + l31] = s0;
                        ((GAS float*)sc)[(4 * rb + h2 + 2) * 4096 + kt * 32 + l31] = s1;
                    }
                }
            }
        }
        for (int kt = ntile; kt < ntile_pad; ++kt) {
#pragma unroll
            for (int rb = 0; rb < 2; ++rb) { ((GAS float*)sc)[(4 * rb + h2) * 4096 + kt * 32 + l31] = -INFINITY; ((GAS float*)sc)[(4 * rb + h2 + 2) * 4096 + kt * 32 + l31] = -INFINITY; }
        }
    }
    VM_WAIT();
    if (do_select) {
#pragma unroll 1
        for (int q = 0; q < 8 * PROBE_SEL2; ++q) select_row(sc + (q & 7) * 4096, hist, nj, lastw, mbase + (q & 7) * 64, lane);
    }
}

__device__ __forceinline__ void attn_unit(Frame& F, const Args& AR, int b, int h, int qb) {
    const int lane = F.lane, wid = F.wave, l31 = lane & 31, h2 = lane >> 5;
    LAS unsigned char* Ks = F.lds;
    LAS unsigned char* Vs = F.lds + 9216;
    LAS float* wsf = (LAS float*)(F.lds + 17408) + wid * 32;
    const size_t rowb = (size_t)b * SEQ, tok0 = rowb + (size_t)qb * 256 + wid * 32;
    bf16x8 qf[4];
    { const bf16* qp = ((bf16*)(F.ws + WS_PROJ)) + (tok0 + l31) * LDP + Q_OFF + h * 64 + h2 * 8;
#pragma unroll
      for (int st = 0; st < 4; ++st) qf[st] = *(const GAS bf16x8*)(qp + st * 16); }
    const int NT = 4 * (qb + 1), cw = qb * 4 + (wid >> 1);
    f32x16 o0, o1;
#pragma unroll
    for (int r = 0; r < 16; ++r) { o0[r] = 0.f; o1[r] = 0.f; }
    float lsum = 0.f;
    const int skey = F.tid >> 3, sch = F.tid & 7;
    const bf16* kg = ((bf16*)(F.ws + WS_PROJ)) + (rowb + skey) * LDP + K_OFF + h * 64 + sch * 8;
    const bf16* vg = ((bf16*)(F.ws + WS_PROJ)) + (rowb + skey) * LDP + V_OFF + h * 64 + sch * 8;
    v4u kreg = *(const GAS v4u*)kg, vreg = *(const GAS v4u*)vg;
    const unsigned kst = skey * 144 + sch * 16, vst = skey * 128 + ((sch * 16) ^ (((skey >> 1) & 1) << 6));
    const GAS unsigned long long* mrow = (const GAS unsigned long long*)(((unsigned long long*)(F.ws + WS_MASK)) + (tok0 + l31) * 64);
    const int i16 = lane & 15, qq = i16 >> 2, pp = i16 & 3, blk = (lane >> 4) & 1;
    const unsigned vrd = (unsigned)((4 * h2 + qq) * 128 + ((32 * blk + 8 * pp) ^ (((qq >> 1) & 1) << 6)));
    for (int t = 0; t < NT; ++t) {
        __syncthreads();
        *(LAS v4u*)(Ks + kst) = kreg; *(LAS v4u*)(Vs + vst) = vreg;
        __syncthreads();
        if (t + 1 < NT) { kreg = *(const GAS v4u*)(kg + (size_t)(t + 1) * 64 * LDP); vreg = *(const GAS v4u*)(vg + (size_t)(t + 1) * 64 * LDP); }
        if (t <= cw) {
            const unsigned long long mw = mrow[t];
            f32x16 p[2];
#pragma unroll
            for (int kb = 0; kb < 2; ++kb) {
                f32x16 acc;
#pragma unroll
                for (int r = 0; r < 16; ++r) acc[r] = 0.f;
#pragma unroll
                for (int st = 0; st < 4; ++st) { const bf16x8 ka = *(const LAS bf16x8*)(Ks + (32 * kb + l31) * 144 + st * 32 + h2 * 16); acc = __builtin_amdgcn_mfma_f32_32x32x16_bf16(ka, qf[st], acc, 0, 0, 0); }
                const unsigned wk = (kb ? (unsigned)(mw >> 32) : (unsigned)mw) >> (4 * h2);
#pragma unroll
                for (int r = 0; r < 16; ++r) {
                    const float e = __builtin_amdgcn_exp2f(acc[r]);
                    const int m = __builtin_amdgcn_sbfe((int)wk, (r & 3) + 8 * (r >> 2), 1);
                    const float pe = __uint_as_float(__float_as_uint(e) & (unsigned)m);
                    acc[r] = pe; lsum += pe;
                }
                p[kb] = acc;
            }
#pragma unroll
            for (int kb = 0; kb < 2; ++kb)
#pragma unroll
                for (int s = 0; s < 2; ++s) {
                    v4u pw; pw.x = pk2(p[kb][8 * s + 0], p[kb][8 * s + 1]); pw.y = pk2(p[kb][8 * s + 2], p[kb][8 * s + 3]); pw.z = pk2(p[kb][8 * s + 4], p[kb][8 * s + 5]); pw.w = pk2(p[kb][8 * s + 6], p[kb][8 * s + 7]);
                    const bf16x8 pa = __builtin_bit_cast(bf16x8, pw);
                    const unsigned rbase = vrd + (unsigned)((32 * kb + 16 * s) * 128);
#pragma unroll
                    for (int d0 = 0; d0 < 2; ++d0) {
                        const unsigned ad = rbase ^ (unsigned)(d0 << 6);
                        const s16x4 lo = __builtin_bit_cast(s16x4, __builtin_amdgcn_ds_read_tr16_b64_v4i16((LAS s16x4*)(Vs + ad)));
                        const s16x4 hi = __builtin_bit_cast(s16x4, __builtin_amdgcn_ds_read_tr16_b64_v4i16((LAS s16x4*)(Vs + ad + 8 * 128)));
                        const bf16x8 vb = (bf16x8){lo[0], lo[1], lo[2], lo[3], hi[0], hi[1], hi[2], hi[3]};
                        if (d0 == 0) o0 = __builtin_amdgcn_mfma_f32_32x32x16_bf16(pa, vb, o0, 0, 0, 0); else o1 = __builtin_amdgcn_mfma_f32_32x32x16_bf16(pa, vb, o1, 0, 0, 0);
                    }
                }
        }
    }
    lsum += __shfl_xor(lsum, 32);
    if (h2 == 0) wsf[l31] = lsum;
    LDS_WAIT(); asm volatile("" ::: "memory");
    bf16* op = ((bf16*)(F.ws + WS_AO)) + tok0 * 512 + h * 64 + l31;
#pragma unroll
    for (int r = 0; r < 16; ++r) { const int q = crow(r, h2); const float rl = 1.0f / wsf[q];
        op[(size_t)q * 512] = (bf16)f2bf(o0[r] * rl); op[(size_t)q * 512 + 32] = (bf16)f2bf(o1[r] * rl); }
    LDS_WAIT(); asm volatile("" ::: "memory");
}

__device__ __forceinline__ void route_wave(Frame& F, const Args& AR, size_t tokbase) {
    const int lane = F.lane; const size_t tok = tokbase + (lane >> 4); const int hp = lane & 15, half = hp & 1;
    const GAS v4u* rp = (const GAS v4u*)(((unsigned*)(F.ws + WS_PROJ)) + tok * 2048 + hp * 128);
    unsigned list[16];
#pragma unroll
    for (int i = 0; i < 16; ++i) list[i] = 0u;
#pragma unroll 4
    for (int c4 = 0; c4 < 32; ++c4) {
        const v4u kv = rp[c4];
#pragma unroll
        for (int e = 0; e < 4; ++e) { unsigned x = kv[e];
#pragma unroll
            for (int i = 0; i < 16; ++i) { const unsigned hi = list[i] > x ? list[i] : x; x = list[i] > x ? x : list[i]; list[i] = hi; } }
    }
    LAS unsigned* lk = (LAS unsigned*)F.lds;
#pragma unroll
    for (int i = 0; i < 16; ++i) lk[i * 512 + F.tid] = list[i];
    LDS_WAIT(); asm volatile("" ::: "memory");
    const int ta = F.tid & ~1, tb = F.tid | 1;
    unsigned ck[16], ce[16];
#pragma unroll
    for (int i = 0; i < 16; ++i) { ck[i] = 0u; ce[i] = 0u; }
#pragma unroll 1
    for (int i = 0; i < 16; ++i) {
        const unsigned ka = lk[i * 512 + ta];
        const float sai = unordk(ka & ~127u); const unsigned nai = (127u - (ka & 127u)) * 128u;
        const int njj = 16 / (i + 1);
#pragma unroll 1
        for (int j = 0; j < njj; ++j) {
            const unsigned kb = lk[j * 512 + tb];
            unsigned x = (ordk(sai + unordk(kb & ~127u)) & ~255u) | (unsigned)(255 - (i * 16 + j)); unsigned y = nai + (127u - (kb & 127u));
#pragma unroll
            for (int t = 0; t < 16; ++t) { const bool gt = x > ck[t]; const unsigned nk = gt ? x : ck[t], ne = gt ? y : ce[t]; x = gt ? ck[t] : x; y = gt ? ce[t] : y; ck[t] = nk; ce[t] = ne; }
        }
    }
    LDS_WAIT(); asm volatile("" ::: "memory");
    float ts[16]; float sum = 0.f; const float mx = unordk(ck[0] & ~255u);
#pragma unroll
    for (int t = 0; t < 16; ++t) { ts[t] = __builtin_amdgcn_exp2f((unordk(ck[t] & ~255u) - mx) * 1.4426950408889634f); sum += ts[t]; }
    const float inv = 1.0f / sum;
    if (half == 0) {
        GAS v4u* eo = (GAS v4u*)(((unsigned short*)(F.ws + WS_REXP)) + tok * 128 + (hp >> 1) * 16); GAS f32x4* go = (GAS f32x4*)(((float*)(F.ws + WS_RG)) + tok * 128 + (hp >> 1) * 16);
        eo[0] = (v4u){ce[0] | (ce[1] << 16), ce[2] | (ce[3] << 16), ce[4] | (ce[5] << 16), ce[6] | (ce[7] << 16)};
        eo[1] = (v4u){ce[8] | (ce[9] << 16), ce[10] | (ce[11] << 16), ce[12] | (ce[13] << 16), ce[14] | (ce[15] << 16)};
#pragma unroll
        for (int t4 = 0; t4 < 4; ++t4) go[t4] = (f32x4){ts[4 * t4] * inv, ts[4 * t4 + 1] * inv, ts[4 * t4 + 2] * inv, ts[4 * t4 + 3] * inv};
    }
}

__device__ __forceinline__ float gelu_erf(float v) {
    const float av = fabsf(v), t = __builtin_amdgcn_rcpf(av * 0.2316418882f + 1.0f);
    float q = t * 0.5307027145f + (-0.7265760135f); q = q * t + 0.7107068705f; q = q * t + (-0.142248368f); q = q * t + 0.127414796f; q = q * t;
    const float e = __builtin_amdgcn_exp2f((v * v) * (-0.72134752044f));
    const float m = v * (q * e);
    return v < 0.f ? m : v - m;
}
typedef __bf16 bf16x2v_t __attribute__((ext_vector_type(2)));
__device__ __forceinline__ float dot2bf(unsigned a, unsigned b, float acc) { return __builtin_amdgcn_fdot2_f32_bf16(__builtin_bit_cast(bf16x2v_t, a), __builtin_bit_cast(bf16x2v_t, b), acc, false); }
__device__ __forceinline__ float dpp_add(float v, float w_unused) { return v; }
#define DPP_ADD(v, ctrl) ((v) + __builtin_bit_cast(float, __builtin_amdgcn_update_dpp(0, __builtin_bit_cast(int, (v)), (ctrl), 0xf, 0xf, true)))
constexpr int NSL = 8;
constexpr int CW_PEER = 8192;
typedef float f32x2v __attribute__((ext_vector_type(2)));
__device__ __forceinline__ unsigned id_of(const v4u a, const v4u b, int m) { const unsigned w = (m < 8) ? a[(m & 7) >> 1] : b[(m & 7) >> 1]; return (m & 1) ? (w >> 16) : (w & 0xffffu); }
__device__ __forceinline__ void load_hn2(const bf16* p, f32x2v (&hn2)[8]) { const v4u a = *(const GAS v4u*)p, b = *(const GAS v4u*)(p + 8);
    hn2[0] = (f32x2v){bflo(a.x), bfhi(a.x)}; hn2[1] = (f32x2v){bflo(a.y), bfhi(a.y)}; hn2[2] = (f32x2v){bflo(a.z), bfhi(a.z)}; hn2[3] = (f32x2v){bflo(a.w), bfhi(a.w)};
    hn2[4] = (f32x2v){bflo(b.x), bfhi(b.x)}; hn2[5] = (f32x2v){bflo(b.y), bfhi(b.y)}; hn2[6] = (f32x2v){bflo(b.z), bfhi(b.z)}; hn2[7] = (f32x2v){bflo(b.w), bfhi(b.w)}; }
template <int SIDE> __device__ __forceinline__ void peer_item8(Frame& F, const Args& AR, int s, size_t t0) {
    const int lane = F.lane, ts = lane >> 3, c = lane & 7;
    const size_t tok = t0 + ts;
    const unsigned char* tbase = ((const unsigned char*)(F.ws + (SIDE == 0 ? WS_U16 : WS_V16))) + 128 * s;
    const unsigned lo = 16u * (unsigned)c;
    const GAS v4u* idq = (const GAS v4u*)(((const unsigned short*)(F.ws + WS_REXP)) + tok * 128);
    v4u ia = idq[0], ib = idq[1];
    if (SIDE == 0) {
        f32x2v hn2[8]; load_hn2(((const bf16*)(F.ws + WS_ACT)) + tok * 1024 + 128 * s + 16 * c, hn2);
        float* po = ((float*)(F.ws + WS_PROJ)) + (tok * NSL + s) * 128;
#pragma unroll 1
        for (int b = 0; b < 8; ++b) {
            v4u r[16];
#pragma unroll
            for (int m = 0; m < 16; ++m) r[m] = *(const GAS v4u*)(tbase + (size_t)((id_of(ia, ib, m) << 10) + lo));
            const int bn = (b + 1) & 7; ia = idq[2 * bn]; ib = idq[2 * bn + 1];
            float d[16];
#pragma unroll
            for (int m = 0; m < 16; ++m) { f32x2v acc = {0.f, 0.f};
#pragma unroll
                for (int q = 0; q < 4; ++q) { const int w = (int)r[m][q]; acc = __builtin_amdgcn_cvt_pk_f32_fp8(w, false) * hn2[2 * q] + acc; acc = __builtin_amdgcn_cvt_pk_f32_fp8(w, true) * hn2[2 * q + 1] + acc; }
                float a = acc.x + acc.y; a = DPP_ADD(a, 0xB1); a = DPP_ADD(a, 0x4E); a = DPP_ADD(a, 0x141); d[m] = a; }
            if (c == 0) { GAS f32x4* pq = (GAS f32x4*)(po + 16 * b);
                pq[0] = (f32x4){d[0], d[1], d[2], d[3]}; pq[1] = (f32x4){d[4], d[5], d[6], d[7]}; pq[2] = (f32x4){d[8], d[9], d[10], d[11]}; pq[3] = (f32x4){d[12], d[13], d[14], d[15]}; }
        }
    } else {
        const GAS f32x4* cfq = (const GAS f32x4*)(((const float*)(F.ws + WS_RG)) + tok * 128);
        f32x4 cf[4];
#pragma unroll
        for (int q = 0; q < 4; ++q) cf[q] = cfq[q];
        f32x2v acc[8];
#pragma unroll
        for (int j = 0; j < 8; ++j) acc[j] = (f32x2v){0.f, 0.f};
#pragma unroll 1
        for (int b = 0; b < 8; ++b) {
            v4u r[16];
#pragma unroll
            for (int m = 0; m < 16; ++m) r[m] = *(const GAS v4u*)(tbase + (size_t)((id_of(ia, ib, m) << 10) + lo));
            const int bn = (b + 1) & 7; ia = idq[2 * bn]; ib = idq[2 * bn + 1];
            f32x4 cn[4];
#pragma unroll
            for (int q = 0; q < 4; ++q) cn[q] = cfq[4 * bn + q];
#pragma unroll
            for (int m = 0; m < 16; ++m) { const float cm = cf[m >> 2][m & 3]; const f32x2v c2 = {cm, cm};
#pragma unroll
                for (int q = 0; q < 4; ++q) { const int w = (int)r[m][q]; acc[2 * q] = __builtin_amdgcn_cvt_pk_f32_fp8(w, false) * c2 + acc[2 * q]; acc[2 * q + 1] = __builtin_amdgcn_cvt_pk_f32_fp8(w, true) * c2 + acc[2 * q + 1]; } }
#pragma unroll
            for (int q = 0; q < 4; ++q) cf[q] = cn[q];
        }
        GAS f32x4* op = (GAS f32x4*)((AR.out) + tok * 1024 + 128 * s + 16 * c);
#pragma unroll
        for (int q = 0; q < 4; ++q) { f32x4 h = op[q]; h.x += acc[2 * q].x; h.y += acc[2 * q].y; h.z += acc[2 * q + 1].x; h.w += acc[2 * q + 1].y; op[q] = h; }
    }
}
template <int SIDE> __device__ __forceinline__ void peer_side(Frame& F, const Args& AR, int rep = 0) {
    gu32* cnt = F.ctl + CW_PEER + (SIDE + 2 * rep) * 16 * 64;
    LAS int* sh = (LAS int*)F.lds;
    const unsigned xcc = xb_xcc_id() & 7u;
#pragma unroll 1
    for (int k = 0; k < NSL; ++k) {
        const int s = (int)((xcc + (unsigned)k) & (unsigned)(NSL - 1));
#pragma unroll 1
        for (;;) {
            __syncthreads();
            if (F.tid == 0) sh[0] = (int)__hip_atomic_fetch_add(cnt + 64 * s, 1u, RLX_AGENT);
            __syncthreads();
            const int blk = sh[0];
            if (blk >= MTOK / 128) break;
            const size_t t0 = (size_t)blk * 128 + F.wave * 16;
            peer_item8<SIDE>(F, AR, s, t0); peer_item8<SIDE>(F, AR, s, t0 + 8);
        }
    }
}
__device__ __forceinline__ void peer_coef_token(Frame& F, size_t tok, float inv_su, float inv_sv) {
    const int lane = F.lane;
    const float* pp = ((const float*)(F.ws + WS_PROJ)) + tok * NSL * 128;
    float a0 = 0.f, a1 = 0.f;
#pragma unroll
    for (int s = 0; s < NSL; ++s) { a0 += pp[s * 128 + lane]; a1 += pp[s * 128 + 64 + lane]; }
    float* gp = ((float*)(F.ws + WS_RG)) + tok * 128;
    gp[lane] = gp[lane] * gelu_erf(a0 * inv_su) * inv_sv; gp[64 + lane] = gp[64 + lane] * gelu_erf(a1 * inv_su) * inv_sv;
}

__global__ void __launch_bounds__(NWAVES * 64, 2) mk_fwd(Args args) {
    extern __shared__ __attribute__((aligned(16))) unsigned char lds[];
    Frame F;
    F.lds = (LAS unsigned char*)lds;
    F.MISC = (volatile LAS unsigned*)(F.lds + MISC_OFF);
    F.tid = threadIdx.x; F.lane = F.tid & 63; F.wave = __builtin_amdgcn_readfirstlane(F.tid >> 6);
    F.G = gridDim.x; { const int bx = blockIdx.x; F.vcu = (F.G % 8 == 0) ? (bx % 8) * (F.G / 8) + bx / 8 : bx; }
    F.ws = args.ws;
    F.ctl = (gu32*)(F.ws + WS_CTL);
    const Args& AR = args;
    for (int u = F.tid; u < (LDS_BYTES - LDSCTL_OFF) / 4; u += NWAVES * 64) ((LAS unsigned*)(F.lds + LDSCTL_OFF))[u] = 0u;
    __syncthreads();
    XcdBarrier bar; bar.bar = (unsigned*)(F.ctl + CW_BAR); bar.x = 0; bar.st = nullptr;
#if !MK_PER_PHASE
    bar = xcd_barrier_post((unsigned*)(F.ctl + CW_BAR), F.MISC + 8);
#endif
    const int lo = args.ph_lo, hi = args.ph_hi;
#if defined(ONLY_PHASE)
#define IN(k) ((k) == ONLY_PHASE && lo <= (k) && (k) < hi)
#elif defined(PHASE_MASK)
#define IN(k) (((PHASE_MASK >> (k)) & 1) && lo <= (k) && (k) < hi)
#else
#define IN(k) (lo <= (k) && (k) < hi)
#endif
#if MK_PER_PHASE
#define SEAM(k) do { } while (0)
#else
#define SEAM(k) do { if (IN(k) && IN((k) + 1)) xcd_barrier(bar); } while (0)
#endif
#define FRESH() Frame P = F; { int t_ = threadIdx.x; asm volatile("" : "+v"(t_)); P.tid = t_; P.lane = t_ & 63; P.wave = __builtin_amdgcn_readfirstlane(t_ >> 6); } const int gw = P.vcu * NWAVES + P.wave, NGW = P.G * NWAVES; (void)gw; (void)NGW

    for (int rep_ = 0; rep_ < (((REPEAT_MASK >> 0) & 1) ? 2 : 1); ++rep_) if (IN(0)) { FRESH(); p0_prologue(P, args); } SEAM(0);
    for (int rep_ = 0; rep_ < (((REPEAT_MASK >> 1) & 1) ? 2 : 1); ++rep_) if (IN(1)) { pg8::Gemm g{((bf16*)(F.ws + WS_ACT)), ((bf16*)(F.ws + WS_WIN)), MTOK, LDP, 1024, 1024, 1024}; pg8::StaticOrder S; S.init(MTOK, LDP, F.G, (int)blockIdx.x);
        pg8::EpiStoreBf16 E{((bf16*)(F.ws + WS_PROJ)), LDP};
        pg8::gemm_phase<pg8::EpiStoreBf16, pg8::StaticOrder, true, true>(F.lds, g, S, E); } SEAM(1);
    if (IN(2)) { FRESH(); for (int m = gw; m < MTOK; m += NGW) fixup_token(P, args, m);
        const float su = fp8_scale(__hip_atomic_load(P.ctl + CW_AMAX, RLX_AGENT)), sv = fp8_scale(__hip_atomic_load(P.ctl + CW_AMAX + 1, RLX_AGENT));
        for (int r = gw; r < 2 * 16384; r += NGW) { const int rr = r & 16383;
            if (r < 16384) row_to_fp8(args.in[13] + (size_t)rr * 1024, (unsigned char*)(P.ws + WS_U16) + (size_t)rr * 1024, su, P.lane);
            else row_to_fp8(args.in[14] + (size_t)rr * 1024, (unsigned char*)(P.ws + WS_V16) + (size_t)rr * 1024, sv, P.lane); } } SEAM(2);
    for (int rep_ = 0; rep_ < (((REPEAT_MASK >> 3) & 1) ? 2 : 1); ++rep_) if (IN(3)) { FRESH(); for (int i = P.vcu; i < 256; i += P.G) { const int b = i >> 4, s = i & 15;
#pragma unroll 1
            for (int k = 0; k < 4; ++k) idx_unit(P, args, b, (k == 0) ? s : (k == 1) ? 31 - s : (k == 2) ? 32 + s : 63 - s, PROBE_NOSEL ? (rep_ == 1) : true); } } SEAM(3);
    for (int rep_ = 0; rep_ < (((REPEAT_MASK >> 4) & 1) ? 2 : 1); ++rep_) if (IN(4)) { FRESH(); for (int i = P.vcu; i < 256; i += P.G) { const int bh = i >> 1, s = i & 1, b = bh >> 3, h = bh & 7;
#pragma unroll 1
            for (int k = 0; k < 8; ++k) attn_unit(P, args, b, h, (k & 1) ? 15 - (k >> 1) * 2 - s : (k >> 1) * 2 + s); } } SEAM(4);
    for (int rep_ = 0; rep_ < (((REPEAT_MASK >> 5) & 1) ? 2 : 1); ++rep_) if (IN(5)) { pg8::Gemm g{((bf16*)(F.ws + WS_AO)), ((bf16*)(F.ws + WS_WA)), MTOK, 1024, 512, 512, 512}; pg8::StaticOrder S; S.init(MTOK, 1024, F.G, (int)blockIdx.x);
        pg8::EpiGate<false> E{((bf16*)(F.ws + WS_ACT)), 1024, ((bf16*)(F.ws + WS_PROJ)) + GA_OFF, LDP};
        pg8::gemm_phase<pg8::EpiGate<false>, pg8::StaticOrder, true, true>(F.lds, g, S, E); } SEAM(5);
    if (IN(6)) { pg8::Gemm g{((bf16*)(F.ws + WS_POOLED)), ((bf16*)(F.ws + WS_WPP)), MTOK, 1024, 512, 512, 512}; pg8::StaticOrder S; S.init(MTOK, 1024, F.G, (int)blockIdx.x);
                pg8::EpiGate<true> E{((bf16*)(F.ws + WS_ACT)), 1024, ((bf16*)(F.ws + WS_PROJ)) + GP_OFF, LDP};
        pg8::gemm_phase<pg8::EpiGate<true>, pg8::StaticOrder, true, true>(F.lds, g, S, E); } SEAM(6);
    for (int rep_ = 0; rep_ < (((REPEAT_MASK >> 7) & 1) ? 2 : 1); ++rep_) if (IN(7)) { pg8::Gemm g{((bf16*)(F.ws + WS_ACT)), ((bf16*)(F.ws + WS_WO)), MTOK, 1024, 1024, 1024, 1024}; pg8::StaticOrder S; S.init(MTOK, 1024, F.G, (int)blockIdx.x);
        pg8::EpiResF32 E{(AR.in[0]), (AR.out), 1024};
        pg8::gemm_phase<pg8::EpiResF32, pg8::StaticOrder, true, true>(F.lds, g, S, E); } SEAM(7);

    for (int rep_ = 0; rep_ < (((REPEAT_MASK >> 8) & 1) ? 2 : 1); ++rep_) if (IN(8)) { FRESH(); for (int m = gw; m < MTOK; m += NGW) rms_row_to_bf16((args.out) + (size_t)m * DM, (args.in[10]), ((bf16*)(P.ws + WS_ACT)) + (size_t)m * DM, P.lane); } SEAM(8);
    for (int rep_ = 0; rep_ < (((REPEAT_MASK >> 9) & 1) ? 2 : 1); ++rep_) if (IN(9)) { pg8::Gemm g{((bf16*)(F.ws + WS_ACT)), ((bf16*)(F.ws + WS_W2)), MTOK, 2048, 1024, 1024, 1024}; pg8::StaticOrder S; S.init(MTOK, 2048, F.G, (int)blockIdx.x);
        pg8::EpiKeys E{((unsigned*)(F.ws + WS_PROJ)), 2048};
        pg8::gemm_phase<pg8::EpiKeys, pg8::StaticOrder, true, true>(F.lds, g, S, E); } SEAM(9);
    for (int rep_ = 0; rep_ < (((REPEAT_MASK >> 10) & 1) ? 2 : 1); ++rep_) if (IN(10)) { FRESH(); for (int m4 = gw; m4 < MTOK / 4; m4 += NGW) route_wave(P, args, (size_t)m4 * 4); } SEAM(10);
        for (int rep_ = 0; rep_ < (((REPEAT_MASK >> 11) & 1) ? 2 : 1); ++rep_) if (IN(11)) { FRESH(); peer_side<0>(P, args, rep_); } SEAM(11);
    if (IN(12)) { FRESH(); const float iu = fp8_inv_scale(__hip_atomic_load(P.ctl + CW_AMAX, RLX_AGENT)), iv = fp8_inv_scale(__hip_atomic_load(P.ctl + CW_AMAX + 1, RLX_AGENT));
        for (int m = gw; m < MTOK; m += NGW) peer_coef_token(P, (size_t)m, iu, iv); } SEAM(12);
    if (IN(13)) { FRESH(); peer_side<1>(P, args); }

#undef IN
#undef SEAM
}

extern "C" void kernel_launch(void* const* d_in, const int* in_sizes, int n_in, void* d_out, int out_size, void* d_ws, size_t ws_size, hipStream_t stream) {
    static int grid = 0;
    if (grid == 0) {
        if (n_in != 15 || in_sizes[0] != MTOK * DM || out_size != MTOK * DM || ws_size < WS_END) { fprintf(stderr, "kernel_launch: unexpected shapes (n_in %d, in0 %d, out %d, ws %zu < %zu)\n", n_in, n_in > 0 ? in_sizes[0] : -1, out_size, ws_size, (size_t)WS_END); grid = -1; return; }
        int dev = 0, cus = 0, per_cu = 0;
        if (hipGetDevice(&dev) != hipSuccess || hipDeviceGetAttribute(&cus, hipDeviceAttributeMultiprocessorCount, dev) != hipSuccess) { grid = -1; return; }
        if (hipFuncSetAttribute((const void*)mk_fwd, hipFuncAttributeMaxDynamicSharedMemorySize, LDS_BYTES) != hipSuccess) { fprintf(stderr, "kernel_launch: hipFuncSetAttribute failed\n"); grid = -1; return; }
        if (hipOccupancyMaxActiveBlocksPerMultiprocessor(&per_cu, (const void*)mk_fwd, NWAVES * 64, LDS_BYTES) != hipSuccess || per_cu < 1) { fprintf(stderr, "kernel_launch: occupancy query says %d blocks per CU\n", per_cu); (void)hipGetLastError(); grid = -1; return; }
        grid = cus;
    }
    if (grid < 0) return;
    if (hipMemsetAsync((char*)d_ws + WS_CTL, 0, CTL_ZERO_BYTES, stream) != hipSuccess) return;
    Args a{};
    for (int i = 0; i < 15; ++i) a.in[i] = (const float*)d_in[i];
    a.out = (float*)d_out; a.ws = (unsigned char*)d_ws;
#if MK_PER_PHASE
    for (int p = 0; p < NPHASE; ++p) { a.ph_lo = p; a.ph_hi = p + 1; hipLaunchKernelGGL(mk_fwd, dim3(grid), dim3(NWAVES * 64), LDS_BYTES, stream, a); }
#else
    a.ph_lo = 0; a.ph_hi = NPHASE;
    hipLaunchKernelGGL(mk_fwd, dim3(grid), dim3(NWAVES * 64), LDS_BYTES, stream, a);
#endif
}
```

```cpp
#include <hip/hip_runtime.h>
#include <cstdio>
#include <cstdint>
namespace pg8 {
#define PG8_LAS __attribute__((address_space(3)))
typedef unsigned short bf16_t;
typedef short bf16x8 __attribute__((ext_vector_type(8)));
typedef float f32x4 __attribute__((ext_vector_type(4)));
typedef unsigned u32x4 __attribute__((ext_vector_type(4)));
constexpr int BM = 256, BK = 64, HALF = 128, HTB = HALF * BK * 2  , STAGE_BYTES = 8 * HTB, NXCD = 8, WGM = 8;

__host__ __device__ __forceinline__ int lds_byte(int r, int c) { const int st = (r >> 4) * 2 + (c >> 5), rr = r & 15, cc = c & 31, ob = rr * 64 + cc * 2; return st * 1024 + (ob ^ (((ob >> 9) & 1) << 5)); }
__host__ __device__ __forceinline__ void stage_rc(int b, int& R, int& C) { const int st = b / 1024, sb = b % 1024, swz = sb ^ (((sb >> 9) & 1) << 5); R = (st >> 1) * 16 + swz / 64; C = (st & 1) * 32 + (swz % 64) / 2; }
__host__ __device__ __forceinline__ int perm32(int rho) { const int n = rho >> 4, i = rho & 15; return 8 * (i >> 2) + 4 * n + (i & 3); }

struct Unit { int pm, pn; };
struct Gemm { const bf16_t* A; const bf16_t* Bt; int M, N, K, lda, ldb; };

struct StaticOrder {
    int nM, nN, nwg, G, c;
    __host__ __device__ void init(int M, int N, int G_, int c_) { nM = M / BM; nN = N / BM; nwg = nM * nN; G = G_; c = c_; }
    __host__ __device__ bool next(int i, Unit& u) const {
        const long L = (long)i * G + c; if (L >= nwg) return false;
        int wgid = (int)L; { const int q = nwg / NXCD, r = nwg % NXCD, xcd = wgid % NXCD, off = wgid / NXCD; wgid = (xcd < r ? xcd * (q + 1) : r * (q + 1) + (xcd - r) * q) + off; }
        const int nig = WGM * nN, gid = wgid / nig, fm = gid * WGM, gsz = (nM - fm) < WGM ? (nM - fm) : WGM;
        u.pm = fm + ((wgid % nig) % gsz); u.pn = (wgid % nig) / gsz; return true;
    }
    __device__ __forceinline__ void a_ready(const Unit&) const {}
    __device__ __forceinline__ void done(const Unit&) const {}
};
typedef float f32x2c_t __attribute__((ext_vector_type(2))); typedef __bf16 bf16x2c_t __attribute__((ext_vector_type(2)));
__device__ __forceinline__ unsigned cvt_pk_bf16(float lo, float hi) { f32x2c_t v = {lo, hi}; bf16x2c_t b = __builtin_convertvector(v, bf16x2c_t); return __builtin_bit_cast(unsigned, b); }
typedef float f32x2 __attribute__((ext_vector_type(2)));
__device__ __forceinline__ f32x2 gelu_pk(f32x2 v) {
    const f32x2 av = __builtin_elementwise_abs(v), d = av * 0.2316418882f + 1.0f;
    f32x2 t; t.x = __builtin_amdgcn_rcpf(d.x); t.y = __builtin_amdgcn_rcpf(d.y);
    f32x2 q = t * 0.5307027145f + (-0.7265760135f); q = q * t + 0.7107068705f; q = q * t + (-0.142248368f); q = q * t + 0.127414796f; q = q * t;
    const f32x2 s = (v * v) * (-0.72134752044f);
    f32x2 e; e.x = __builtin_amdgcn_exp2f(s.x); e.y = __builtin_amdgcn_exp2f(s.y);
    const f32x2 m = v * (q * e), r = v - m;
    f32x2 o; o.x = v.x < 0.f ? m.x : r.x; o.y = v.y < 0.f ? m.y : r.y; return o;
}
__device__ __forceinline__ float bf_lo(unsigned w) { return __uint_as_float(w << 16); }
__device__ __forceinline__ float bf_hi(unsigned w) { return __uint_as_float(w & 0xffff0000u); }
__device__ __forceinline__ float sigmoidf_fast(float g) { return __builtin_amdgcn_rcpf(1.0f + __builtin_amdgcn_exp2f(-1.4426950408889634f * g)); }
__device__ __forceinline__ unsigned ord_key(float f) { const unsigned b = __float_as_uint(f); return b ^ ((unsigned)((int)b >> 31) | 0x80000000u); }
__device__ __forceinline__ float unord_key(unsigned k) { return __uint_as_float((k & 0x80000000u) ? (k ^ 0x80000000u) : ~k); }

struct EpiStoreBf16 {
    static constexpr bool PERM = true, AFTER_DRAIN = false;
    bf16_t* O; int ldc;
    __device__ __forceinline__ void operator()(const f32x4 (&acc)[2][2][4][2], const Unit& u, int wr, int wc, int fr, int fq) const {
        const int row0 = u.pm * BM + wr * 64 + fr, col0 = u.pn * BM + wc * 32 + 8 * fq;
#pragma unroll
        for (int ai = 0; ai < 2; ++ai)
#pragma unroll
            for (int m = 0; m < 4; ++m) { bf16_t* rowp = O + (size_t)(row0 + ai * HALF + m * 16) * ldc + col0;
#pragma unroll
                for (int bj = 0; bj < 2; ++bj) { const f32x4 v0 = acc[ai][bj][m][0], v1 = acc[ai][bj][m][1];
                    u32x4 w; w.x = cvt_pk_bf16(v0[0], v0[1]); w.y = cvt_pk_bf16(v0[2], v0[3]); w.z = cvt_pk_bf16(v1[0], v1[1]); w.w = cvt_pk_bf16(v1[2], v1[3]);
                    *(u32x4*)(rowp + bj * HALF) = w; } }
    }
};
template <bool ADD> struct EpiGate {
    static constexpr bool PERM = true, AFTER_DRAIN = false;
    bf16_t* O; int ldc; const bf16_t* G; int ldg;
    __device__ __forceinline__ void operator()(const f32x4 (&acc)[2][2][4][2], const Unit& u, int wr, int wc, int fr, int fq) const {
        const int row0 = u.pm * BM + wr * 64 + fr, col0 = u.pn * BM + wc * 32 + 8 * fq;
#pragma unroll
        for (int ai = 0; ai < 2; ++ai)
#pragma unroll
            for (int m = 0; m < 4; ++m) { const size_t row = (size_t)(row0 + ai * HALF + m * 16);
#pragma unroll
                for (int bj = 0; bj < 2; ++bj) { const int col = col0 + bj * HALF;
                    const u32x4 gr = *(const u32x4*)(G + row * ldg + col);
                    f32x4 v0 = acc[ai][bj][m][0], v1 = acc[ai][bj][m][1];
                    v0[0] *= sigmoidf_fast(bf_lo(gr.x)); v0[1] *= sigmoidf_fast(bf_hi(gr.x)); v0[2] *= sigmoidf_fast(bf_lo(gr.y)); v0[3] *= sigmoidf_fast(bf_hi(gr.y));
                    v1[0] *= sigmoidf_fast(bf_lo(gr.z)); v1[1] *= sigmoidf_fast(bf_hi(gr.z)); v1[2] *= sigmoidf_fast(bf_lo(gr.w)); v1[3] *= sigmoidf_fast(bf_hi(gr.w));
                    bf16_t* op = O + row * ldc + col;
                    if (ADD) { const u32x4 pr = *(const u32x4*)op;
                        v0[0] += bf_lo(pr.x); v0[1] += bf_hi(pr.x); v0[2] += bf_lo(pr.y); v0[3] += bf_hi(pr.y);
                        v1[0] += bf_lo(pr.z); v1[1] += bf_hi(pr.z); v1[2] += bf_lo(pr.w); v1[3] += bf_hi(pr.w); }
                    u32x4 w; w.x = cvt_pk_bf16(v0[0], v0[1]); w.y = cvt_pk_bf16(v0[2], v0[3]); w.z = cvt_pk_bf16(v1[0], v1[1]); w.w = cvt_pk_bf16(v1[2], v1[3]);
                    *(u32x4*)op = w; } }
    }
};
struct EpiResF32 {
    static constexpr bool PERM = false, AFTER_DRAIN = false;
    const float* base; float* out; int ldc;
    __device__ __forceinline__ void operator()(const f32x4 (&acc)[2][2][4][2], const Unit& u, int wr, int wc, int fr, int fq) const {
        const int col0 = u.pn * BM + wc * 32 + 4 * fq;
#pragma unroll
        for (int ai = 0; ai < 2; ++ai)
#pragma unroll
            for (int m = 0; m < 4; ++m) { const size_t off = (size_t)(u.pm * BM + ai * HALF + wr * 64 + m * 16 + fr) * ldc + col0;
#pragma unroll
                for (int bj = 0; bj < 2; ++bj)
#pragma unroll
                    for (int n = 0; n < 2; ++n) { const f32x4 bs = *(const f32x4*)(base + off + bj * HALF + n * 16); *(f32x4*)(out + off + bj * HALF + n * 16) = bs + acc[ai][bj][m][n]; } }
    }
};
struct EpiKeys {
    static constexpr bool PERM = false, AFTER_DRAIN = false;
    unsigned* O; int ldc;
    __device__ __forceinline__ void operator()(const f32x4 (&acc)[2][2][4][2], const Unit& u, int wr, int wc, int fr, int fq) const {
        const int col0 = u.pn * BM + wc * 32 + 4 * fq;
#pragma unroll
        for (int ai = 0; ai < 2; ++ai)
#pragma unroll
            for (int m = 0; m < 4; ++m) { const size_t off = (size_t)(u.pm * BM + ai * HALF + wr * 64 + m * 16 + fr) * ldc + col0;
#pragma unroll
                for (int bj = 0; bj < 2; ++bj)
#pragma unroll
                    for (int n = 0; n < 2; ++n) { const int nn = (col0 + bj * HALF + n * 16) & 127; const f32x4 a = acc[ai][bj][m][n]; u32x4 w;
                        w.x = (ord_key(a[0]) & ~127u) | (unsigned)(127 - nn); w.y = (ord_key(a[1]) & ~127u) | (unsigned)(126 - nn);
                        w.z = (ord_key(a[2]) & ~127u) | (unsigned)(125 - nn); w.w = (ord_key(a[3]) & ~127u) | (unsigned)(124 - nn);
                        *(u32x4*)(O + off + bj * HALF + n * 16) = w; } }
    }
};

template <class Epi, class Sched, bool ALIGN_EPI = false, bool SP2 = false>
__device__ __forceinline__ void gemm_phase(PG8_LAS unsigned char* lds, const Gemm g, const Sched& S, const Epi& E) {
    int tid_ = threadIdx.x; asm volatile("" : "+v"(tid_));
    const int tid = tid_, wid = __builtin_amdgcn_readfirstlane(tid >> 6), lane = tid & 63, wr = wid >> 2, wc = wid & 3, fr = lane & 15, fq = lane >> 4;
    const int K = g.K, nt = K / BK;
    unsigned voffA[2], voffB[2];
#pragma unroll
    for (int i = 0; i < 2; ++i) { int R, C; stage_rc(tid * 16 + i * 8192, R, C); const int Rb = Epi::PERM ? ((R & ~31) + perm32(R & 31)) : R;
        voffA[i] = (unsigned)(R * g.lda + C) * 2u; voffB[i] = (unsigned)(Rb * g.ldb + C) * 2u; }
    const size_t kstep = (size_t)(BK * 2);
    const size_t hstepA = (size_t)HALF * g.lda * 2, hstepB = (size_t)HALF * g.ldb * 2;
    const size_t tstepA = 2 * hstepA, tstepB = 2 * hstepB;
    const unsigned ldsw = (unsigned)wid * 1024u;
    const int aoff = lds_byte(wr * 64 + fr, fq * 8), boff = lds_byte(wc * 32 + fr, fq * 8);
#define PG8_SA(b, h) (((b) * 2 + (h)) * HTB)
#define PG8_SB(b, h) ((4 + (b) * 2 + (h)) * HTB)
#define PG8_STAGE(bufoff, gbase, voff) do { _Pragma("unroll") for (int _i = 0; _i < 2; ++_i) \
        __builtin_amdgcn_global_load_lds((const unsigned*)((const char*)(gbase) + (voff)[_i]), (PG8_LAS unsigned*)(lds + (bufoff) + ldsw + _i * 8192), 16, 0, 0); } while (0)
#define PG8_LDA(dst, b, h) do { _Pragma("unroll") for (int m = 0; m < 4; ++m) _Pragma("unroll") for (int k = 0; k < 2; ++k) dst[m][k] = *(const PG8_LAS bf16x8*)(lds + PG8_SA(b, h) + aoff + m * 2048 + k * 1024); } while (0)
#define PG8_LDB(dst, b, h) do { _Pragma("unroll") for (int n = 0; n < 2; ++n) _Pragma("unroll") for (int k = 0; k < 2; ++k) dst[n][k] = *(const PG8_LAS bf16x8*)(lds + PG8_SB(b, h) + boff + n * 2048 + k * 1024); } while (0)
#define PG8_MMA(ai, bj, At, Bt) do { __builtin_amdgcn_s_setprio(1); _Pragma("unroll") for (int m = 0; m < 4; ++m) _Pragma("unroll") for (int n = 0; n < 2; ++n) _Pragma("unroll") for (int k = 0; k < 2; ++k) \
        acc[ai][bj][m][n] = __builtin_amdgcn_mfma_f32_16x16x32_bf16(Bt[n][k], At[m][k], acc[ai][bj][m][n], 0, 0, 0); __builtin_amdgcn_s_setprio(0); } while (0)
#define PG8_WAIT_V(n) asm volatile("s_waitcnt vmcnt(" #n ")" ::: "memory")
#define PG8_WAIT_L(n) asm volatile("s_waitcnt lgkmcnt(" #n ")" ::: "memory")
#define PG8_BAR __builtin_amdgcn_s_barrier()
#define PG8_SCHED __builtin_amdgcn_sched_barrier(0)
    Unit cur, nxt; int ui = 0;
    if (!S.next(0, cur)) return;
    f32x4 acc[2][2][4][2];
#pragma unroll
    for (int a = 0; a < 2; ++a)
#pragma unroll
        for (int b = 0; b < 2; ++b)
#pragma unroll
            for (int m = 0; m < 4; ++m)
#pragma unroll
                for (int n = 0; n < 2; ++n) acc[a][b][m][n] = (f32x4){0.f, 0.f, 0.f, 0.f};
    bf16x8 At[4][2], B0[2][2], B1[2][2];
    const char* cA = (const char*)g.A + (size_t)cur.pm * tstepA; const char* cB = (const char*)g.Bt + (size_t)cur.pn * tstepB;
    S.a_ready(cur);
    if constexpr (SP2) {
        PG8_STAGE(PG8_SB(0, 0), cB, voffB); PG8_STAGE(PG8_SB(0, 1), cB + hstepB, voffB); PG8_STAGE(PG8_SA(0, 0), cA, voffA); PG8_STAGE(PG8_SA(0, 1), cA + hstepA, voffA);
        if (wr == 1) PG8_BAR;
        PG8_WAIT_V(2); PG8_BAR;
        PG8_STAGE(PG8_SB(1, 0), cB + kstep, voffB); PG8_STAGE(PG8_SA(1, 0), cA + kstep, voffA); PG8_STAGE(PG8_SB(1, 1), cB + hstepB + kstep, voffB);
        PG8_WAIT_V(6); PG8_BAR;
    } else {
        PG8_STAGE(PG8_SB(0, 0), cB, voffB); PG8_STAGE(PG8_SA(0, 0), cA, voffA); PG8_STAGE(PG8_SB(0, 1), cB + hstepB, voffB); PG8_STAGE(PG8_SA(0, 1), cA + hstepA, voffA);
        if (wr == 1) PG8_BAR;
        PG8_WAIT_V(4); PG8_BAR;
        PG8_STAGE(PG8_SB(1, 0), cB + kstep, voffB); PG8_STAGE(PG8_SA(1, 0), cA + kstep, voffA); PG8_STAGE(PG8_SB(1, 1), cB + hstepB + kstep, voffB);
        PG8_WAIT_V(6); PG8_BAR;
    }
    for (;;) {
        const bool has_next = S.next(ui + 1, nxt);
        const char* nA = has_next ? (const char*)g.A + (size_t)nxt.pm * tstepA : cA; const char* nB = has_next ? (const char*)g.Bt + (size_t)nxt.pn * tstepB : cB;
        for (int t = 0; t < nt; t += 2) {
            const bool last = (t == nt - 2);
            const char* a1 = cA + (size_t)(t + 1) * kstep;
            const char* a2 = last ? nA : cA + (size_t)(t + 2) * kstep; const char* b2 = last ? nB : cB + (size_t)(t + 2) * kstep;
            const char* a3 = a2 + kstep; const char* b3 = b2 + kstep;
            if (last && has_next) S.a_ready(nxt);
            if constexpr (SP2) {
            PG8_LDB(B0, 0, 0); PG8_LDB(B1, 0, 1); PG8_SCHED; PG8_LDA(At, 0, 0); PG8_STAGE(PG8_SA(1, 1), a1 + hstepA, voffA);
            PG8_WAIT_V(8); PG8_WAIT_L(0); PG8_BAR; PG8_MMA(0, 0, At, B0); PG8_MMA(0, 1, At, B1); PG8_BAR; PG8_SCHED;
            PG8_LDA(At, 0, 1); PG8_STAGE(PG8_SB(0, 0), b2, voffB); PG8_STAGE(PG8_SB(0, 1), b2 + hstepB, voffB); PG8_STAGE(PG8_SA(0, 0), a2, voffA);
            PG8_WAIT_V(8); PG8_WAIT_L(0); PG8_BAR; PG8_MMA(1, 0, At, B0); PG8_MMA(1, 1, At, B1); PG8_BAR; PG8_SCHED;
            PG8_LDB(B0, 1, 0); PG8_LDB(B1, 1, 1); PG8_SCHED; PG8_LDA(At, 1, 0); PG8_STAGE(PG8_SA(0, 1), a2 + hstepA, voffA);
            PG8_WAIT_V(8); PG8_WAIT_L(0); PG8_BAR; PG8_MMA(0, 0, At, B0); PG8_MMA(0, 1, At, B1); PG8_BAR; PG8_SCHED;
            PG8_LDA(At, 1, 1); PG8_STAGE(PG8_SB(1, 0), b3, voffB); PG8_STAGE(PG8_SB(1, 1), b3 + hstepB, voffB); PG8_STAGE(PG8_SA(1, 0), a3, voffA);
            PG8_WAIT_V(8); PG8_WAIT_L(0); PG8_BAR; PG8_MMA(1, 0, At, B0); PG8_MMA(1, 1, At, B1); PG8_BAR; PG8_SCHED;
            } else {
            PG8_LDB(B0, 0, 0); PG8_SCHED; PG8_LDA(At, 0, 0); PG8_STAGE(PG8_SA(1, 1), a1 + hstepA, voffA);
            PG8_WAIT_L(8); PG8_BAR; PG8_WAIT_L(0); PG8_MMA(0, 0, At, B0); PG8_BAR; PG8_SCHED;
            PG8_LDB(B1, 0, 1); PG8_STAGE(PG8_SB(0, 0), b2, voffB);
            PG8_BAR; PG8_WAIT_L(0); PG8_MMA(0, 1, At, B1); PG8_BAR;
            PG8_LDA(At, 0, 1); PG8_STAGE(PG8_SA(0, 0), a2, voffA);
            PG8_BAR; PG8_WAIT_L(0); PG8_MMA(1, 0, At, B0); PG8_BAR; PG8_SCHED;
            PG8_STAGE(PG8_SB(0, 1), b2 + hstepB, voffB);
            PG8_WAIT_V(6); PG8_BAR; PG8_MMA(1, 1, At, B1); PG8_BAR;
            PG8_LDB(B0, 1, 0); PG8_SCHED; PG8_LDA(At, 1, 0); PG8_STAGE(PG8_SA(0, 1), a2 + hstepA, voffA);
            PG8_WAIT_L(8); PG8_BAR; PG8_WAIT_L(0); PG8_MMA(0, 0, At, B0); PG8_BAR; PG8_SCHED;
            PG8_LDB(B1, 1, 1); PG8_STAGE(PG8_SB(1, 0), b3, voffB);
            PG8_BAR; PG8_WAIT_L(0); PG8_MMA(0, 1, At, B1); PG8_BAR;
            PG8_LDA(At, 1, 1); PG8_STAGE(PG8_SA(1, 0), a3, voffA);
            PG8_BAR; PG8_WAIT_L(0); PG8_MMA(1, 0, At, B0); PG8_BAR; PG8_SCHED;
            PG8_STAGE(PG8_SB(1, 1), b3 + hstepB, voffB);
            PG8_WAIT_V(6); PG8_BAR; PG8_MMA(1, 1, At, B1); PG8_BAR;
            }
        }
        if constexpr (ALIGN_EPI) { if (wr == 0) PG8_BAR; }
        if constexpr (!Epi::AFTER_DRAIN) { E(acc, cur, wr, wc, fr, fq); S.done(cur); }
        if (!has_next) break;
#pragma unroll
        for (int a = 0; a < 2; ++a)
#pragma unroll
            for (int b = 0; b < 2; ++b)
#pragma unroll
                for (int m = 0; m < 4; ++m)
#pragma unroll
                    for (int n = 0; n < 2; ++n) acc[a][b][m][n] = (f32x4){0.f, 0.f, 0.f, 0.f};
        cur = nxt; cA = nA; cB = nB; ++ui;
        if constexpr (ALIGN_EPI) { if (wr == 1) PG8_BAR; }
    }
    PG8_WAIT_V(0);
    if constexpr (!ALIGN_EPI) { if (wr == 0) PG8_BAR; }
    PG8_BAR;
    if constexpr (Epi::AFTER_DRAIN) { E.fused(acc, cur, wr, wc, fr, fq, lds, wid, lane); S.done(cur); }
#undef PG8_SA
#undef PG8_SB
#undef PG8_STAGE
#undef PG8_LDA
#undef PG8_LDB
#undef PG8_MMA
#undef PG8_WAIT_V
#undef PG8_WAIT_L
#undef PG8_BAR
#undef PG8_SCHED
}
}

constexpr int NWAVES = 8;
#ifndef REPEAT_MASK
#define REPEAT_MASK 0
#endif
#ifndef PROBE_SEL2
#define PROBE_SEL2 1
#endif
#ifndef PROBE_NOSEL
#define PROBE_NOSEL 0
#endif
#ifndef MK_PER_PHASE
#define MK_PER_PHASE 0
#endif
constexpr int NPHASE = 14;

constexpr int BATCH = 16, SEQ = 4096, DM = 1024, MTOK = BATCH * SEQ;
constexpr int LDP = 4864;
constexpr int Q_OFF = 0, K_OFF = 512, V_OFF = 1024, QI_OFF = 1536, P_OFF = 2048, GA_OFF = 2560, GP_OFF = 3584, KI_OFF = 4608, WI_OFF = 4672;
constexpr int IN_WIDTH = 4680;
constexpr float EPS = 1e-6f;
constexpr float C2 = 0.125f * 1.4426950408889634f;
constexpr float WI_SCALE = 0.35355339059327373f * 0.125f;

constexpr size_t MiB = 1u << 20;
constexpr size_t WS_CTL = 0, CTL_ZERO_BYTES = 1 * MiB;
constexpr size_t WS_ROPE = 1 * MiB;
constexpr size_t WS_WIN = 2 * MiB;
constexpr size_t WS_WA = 12 * MiB;
constexpr size_t WS_WPP = 13 * MiB;
constexpr size_t WS_WO = 14 * MiB;
constexpr size_t WS_W2 = 16 * MiB;
constexpr size_t WS_U16 = 20 * MiB, WS_V16 = 52 * MiB;
constexpr size_t WS_MASK = 84 * MiB;
constexpr size_t WS_POOLED = 116 * MiB;
constexpr size_t WS_ACT = 180 * MiB;
constexpr size_t WS_PROJ = 308 * MiB;
constexpr size_t WS_AO = 916 * MiB;
constexpr size_t WS_REXP = 916 * MiB, WS_RG = 948 * MiB;
constexpr size_t WS_END = 1024 * MiB;
constexpr int CW_TMO = 0, CW_BAR = 4096, CW_AMAX = 12288;

constexpr int RING_BYTES = 131072;
constexpr int LDSCTL_OFF = RING_BYTES, MISC_OFF = LDSCTL_OFF + 320;
constexpr int LDS_BYTES = 147456;

#define GAS __attribute__((address_space(1)))
#define LAS __attribute__((address_space(3)))
typedef unsigned short bf16;
typedef unsigned v4u __attribute__((ext_vector_type(4)));
typedef unsigned v2u __attribute__((ext_vector_type(2)));
typedef float f32x4 __attribute__((ext_vector_type(4)));
typedef float f32x16 __attribute__((ext_vector_type(16)));
typedef short bf16x8 __attribute__((ext_vector_type(8)));
typedef short s16x4 __attribute__((ext_vector_type(4)));
typedef GAS unsigned gu32;
#define RLX_AGENT __ATOMIC_RELAXED, __HIP_MEMORY_SCOPE_AGENT
#define LDS_WAIT() asm volatile("s_waitcnt lgkmcnt(0)" ::: "memory")
#define VM_WAIT() asm volatile("s_waitcnt vmcnt(0)" ::: "memory")
__device__ __forceinline__ unsigned f2bf(float f) { unsigned u = __builtin_bit_cast(unsigned, f); return (u + 0x7fffu + ((u >> 16) & 1u)) >> 16; }
typedef float f32x2k_t __attribute__((ext_vector_type(2))); typedef __bf16 bf16x2k_t __attribute__((ext_vector_type(2)));
__device__ __forceinline__ unsigned pk2(float lo, float hi) { f32x2k_t v = {lo, hi}; bf16x2k_t b = __builtin_convertvector(v, bf16x2k_t); return __builtin_bit_cast(unsigned, b); }
__device__ __forceinline__ float bflo(unsigned w) { return __uint_as_float(w << 16); }
__device__ __forceinline__ float bfhi(unsigned w) { return __uint_as_float(w & 0xffff0000u); }
__device__ __forceinline__ unsigned ordk(float f) { const unsigned b = __float_as_uint(f); return b ^ ((unsigned)((int)b >> 31) | 0x80000000u); }
__device__ __forceinline__ float unordk(unsigned k) { return __uint_as_float((k & 0x80000000u) ? (k ^ 0x80000000u) : ~k); }
__device__ __forceinline__ int crow(int r, int hi) { return (r & 3) + 8 * (r >> 2) + 4 * hi; }
typedef __bf16 bf16x2v_t __attribute__((ext_vector_type(2)));
__device__ __forceinline__ float dot2bf(unsigned a, unsigned b, float acc) { return __builtin_amdgcn_fdot2_f32_bf16(__builtin_bit_cast(bf16x2v_t, a), __builtin_bit_cast(bf16x2v_t, b), acc, false); }

#define XB_TMO      128
#define XB_XCNT(j)  (256  + 64 * (j))
#define XB_XSUB(j)  (1280 + 64 * (j))
#define XB_XGEN(j)  (2304 + 64 * (j))
#define XB_TOP      3328
#define XB_TOPGEN   3392
#define XCD_BAR_WORDS 3456
#define XB_SPIN_CAP (1u << 18)

__device__ __forceinline__ unsigned xb_ld(unsigned* p)              { return __hip_atomic_load(p, __ATOMIC_RELAXED, __HIP_MEMORY_SCOPE_AGENT); }
__device__ __forceinline__ unsigned xb_add(unsigned* p, unsigned v) { return __hip_atomic_fetch_add(p, v, __ATOMIC_RELAXED, __HIP_MEMORY_SCOPE_AGENT); }
__device__ __forceinline__ unsigned xb_xcc_id() { return (unsigned)__builtin_amdgcn_s_getreg((3 << 11) | 20) & 0xFu; }
#define XB_SPIN(cond, bar) do { unsigned _sp = 0; while (cond) { __builtin_amdgcn_s_sleep(1); \
    if ((++_sp & 255u) == 0u) { if (xb_ld(&(bar)[XB_TMO])) break; if (_sp > XB_SPIN_CAP) { atomicAdd(&(bar)[XB_TMO], 1u); break; } } } } while (0)

struct XcdBarrier {
    unsigned* bar; unsigned x;
    volatile LAS unsigned* st;
};

__device__ __forceinline__ XcdBarrier xcd_barrier_post(unsigned* bar, volatile LAS unsigned* st) {
    XcdBarrier b; b.bar = bar; b.x = xb_xcc_id(); b.st = st;
    if (threadIdx.x == 0) (void)xb_add(&bar[XB_XCNT(b.x)], 1u);
    return b;
}
__device__ __forceinline__ void xcd_barrier_complete(unsigned* bar, unsigned x, unsigned& nloc, unsigned& nx) {
    const unsigned G = gridDim.x * gridDim.y * gridDim.z;
    unsigned sum, cnt, mine, sp = 0u;
    for (;;) {
        sum = 0u; cnt = 0u; mine = 0u;
#pragma unroll
        for (unsigned j = 0; j < 16; ++j) { const unsigned c = xb_ld(&bar[XB_XCNT(j)]); sum += c; cnt += (c > 0u) ? 1u : 0u; mine = (j == x) ? c : mine; }
        if (sum == G) break;
        __builtin_amdgcn_s_sleep(1);
        if ((++sp & 255u) == 0u) { if (xb_ld(&bar[XB_TMO])) break; if (sp > XB_SPIN_CAP) { atomicAdd(&bar[XB_TMO], 1u); break; } }
    }
    nloc = mine > 0u ? mine : 1u; nx = cnt > 0u ? cnt : 1u;
}

__device__ __forceinline__ void xcd_barrier(const XcdBarrier& b) {
    asm volatile("s_waitcnt vmcnt(0)" ::: "memory");
    __syncthreads();
    if (threadIdx.x == 0) {
        unsigned* bar = b.bar;
        __builtin_amdgcn_s_waitcnt(0);
        unsigned nloc = b.st[0], nx = b.st[1];
        if (nloc == 0u) { xcd_barrier_complete(bar, b.x, nloc, nx); b.st[0] = nloc; b.st[1] = nx; }
        const unsigned old = xb_add(&bar[XB_XSUB(b.x)], 1u);
        const unsigned gen = old / nloc;
        if (old + 1u == (gen + 1u) * nloc) {
            __builtin_amdgcn_fence(__ATOMIC_RELEASE, "agent");
            asm volatile("s_waitcnt vmcnt(0)" ::: "memory");
            const unsigned og = xb_add(&bar[XB_TOP], 1u);
            const unsigned tg = og / nx;
            if (og + 1u == (tg + 1u) * nx) xb_add(&bar[XB_TOPGEN], 1u);
            else XB_SPIN(xb_ld(&bar[XB_TOPGEN]) == tg, bar);
            __builtin_amdgcn_fence(__ATOMIC_ACQUIRE, "agent");
            xb_add(&bar[XB_XGEN(b.x)], 1u);
            asm volatile("s_waitcnt vmcnt(0)" ::: "memory");
        } else {
            XB_SPIN(xb_ld(&bar[XB_XGEN(b.x)]) == gen, bar);
            __builtin_amdgcn_fence(__ATOMIC_ACQUIRE, "agent");
            asm volatile("s_waitcnt vmcnt(0)" ::: "memory");
        }
    }
    __syncthreads();
}


struct Frame {
    LAS unsigned char* lds;
    volatile LAS unsigned* MISC;
    gu32* ctl;
    unsigned char* ws;
    int tid, lane, wave, vcu, G;
};
struct Args { const float* in[15]; float* out; unsigned char* ws; int ph_lo, ph_hi; };

__device__ __forceinline__ float wave_sum(float v) {
#pragma unroll
    for (int o = 1; o < 64; o <<= 1) v += __shfl_xor(v, o);
    return v;
}

template <class ColMap>
__device__ __forceinline__ void p0_transpose_item(const float* W, int K, int N, bf16* WT, int nblk, LAS float* scr, int item, int lane, ColMap cm) {
    const int kb = item / nblk, nb = item % nblk, k0 = 64 * kb, n0 = 32 * nb;
    const int src = cm(n0 + (lane & 31));
#pragma unroll 8
    for (int i = 0; i < 32; ++i) { const int kk = 2 * i + (lane >> 5); scr[kk * 33 + (lane & 31)] = (src >= 0) ? W[(size_t)(k0 + kk) * N + src] : 0.f; }
    LDS_WAIT(); asm volatile("" ::: "memory");
    const int c = lane & 7;
#pragma unroll
    for (int j = 0; j < 4; ++j) { const int n = (lane >> 3) + 8 * j; const LAS float* s = scr + (8 * c) * 33 + n;
        v4u o; o.x = pk2(s[0 * 33], s[1 * 33]); o.y = pk2(s[2 * 33], s[3 * 33]); o.z = pk2(s[4 * 33], s[5 * 33]); o.w = pk2(s[6 * 33], s[7 * 33]);
        *(GAS v4u*)(WT + (size_t)(n0 + n) * K + k0 + 8 * c) = o; }
    LDS_WAIT(); asm volatile("" ::: "memory");
}
struct MapIdent { __device__ __forceinline__ int operator()(int n) const { return n; } };
struct MapWin { __device__ __forceinline__ int operator()(int n) const {
    if (n < 2048) return n;
    if (n < 2560) return 2120 + (n - 2048);
    if (n < 4608) return 2632 + (n - 2560);
    if (n < 4672) return 2048 + (n - 4608);
    if (n < 4680) return 2112 + (n - 4672);
    return -1; } };

__device__ __forceinline__ void rms_row_to_bf16(const float* xrow, const float* g, bf16* orow, int lane) {
    const GAS f32x4* xr = (const GAS f32x4*)xrow + lane; const GAS f32x4* gr = (const GAS f32x4*)g + lane;
    f32x4 v[4]; float s = 0.f;
#pragma unroll
    for (int j = 0; j < 4; ++j) { v[j] = xr[64 * j]; s += (v[j].x * v[j].x + v[j].y * v[j].y) + (v[j].z * v[j].z + v[j].w * v[j].w); }
    const float rs = 1.0f / sqrtf(wave_sum(s) * (1.f / 1024.f) + EPS);
    GAS unsigned long long* o8 = (GAS unsigned long long*)orow + lane;
#pragma unroll
    for (int j = 0; j < 4; ++j) { const f32x4 gg = gr[64 * j];
        o8[64 * j] = (unsigned long long)pk2(v[j].x * rs * gg.x, v[j].y * rs * gg.y) | ((unsigned long long)pk2(v[j].z * rs * gg.z, v[j].w * rs * gg.w) << 32); }
}

__device__ __forceinline__ void p0_prologue(Frame& F, const Args& AR) {
    LAS float* scr = (LAS float*)(F.lds + F.wave * 16384);
    const int gw = F.vcu * NWAVES + F.wave, NGW = F.G * NWAVES, lane = F.lane;
    constexpr int I_WIN = 16 * 152, I_WA = 8 * 32, I_WO = 16 * 32;
    for (int it = gw; it < I_WIN + I_WA + I_WO; it += NGW) {
        int r = it;
        if (r < I_WIN) { p0_transpose_item((AR.in[2]), 1024, IN_WIDTH, ((bf16*)(F.ws + WS_WIN)), 152, scr, r, lane, MapWin()); continue; } r -= I_WIN;
        if (r < I_WA) { p0_transpose_item((AR.in[7]), 512, 1024, ((bf16*)(F.ws + WS_WA)), 32, scr, r, lane, MapIdent()); continue; } r -= I_WA;
        p0_transpose_item((AR.in[9]), 1024, 1024, ((bf16*)(F.ws + WS_WO)), 32, scr, r, lane, MapIdent());
    }
    for (int it = gw; it < 16 * 64; it += NGW) {
        const int nb = it & 15, kb = it >> 4, n = nb * 64 + lane, k0 = kb * 8, g = k0 >> 7, c0 = k0 & 127;
        float acc[8];
#pragma unroll
        for (int j = 0; j < 8; ++j) acc[j] = 0.f;
        for (int d = 0; d < 128; ++d) {
            const float wv = (AR.in[8])[(size_t)(g * 128 + d) * 1024 + n] * (AR.in[6])[g * 128 + d];
#pragma unroll
            for (int j = 0; j < 8; ++j) acc[j] += (AR.in[5])[(size_t)(g * 128 + c0 + j) * 128 + d] * wv;
        }
        v4u o; o.x = pk2(acc[0], acc[1]); o.y = pk2(acc[2], acc[3]); o.z = pk2(acc[4], acc[5]); o.w = pk2(acc[6], acc[7]);
        *(GAS v4u*)(((bf16*)(F.ws + WS_WPP)) + (size_t)n * 512 + k0) = o;
    }
    for (int it = gw; it < 32 * 16; it += NGW) {
        const int nb = it & 31, kb = it >> 5, np = nb * 64 + lane, hp = nb >> 1, k0 = kb * 64;
#pragma unroll 4
        for (int d4 = 0; d4 < 16; ++d4) { const f32x4 t = *(const GAS f32x4*)((AR.in[12]) + (size_t)np * 64 + d4 * 4);
            scr[(4 * d4 + 0) * 64 + lane] = t.x; scr[(4 * d4 + 1) * 64 + lane] = t.y; scr[(4 * d4 + 2) * 64 + lane] = t.z; scr[(4 * d4 + 3) * 64 + lane] = t.w; }
        LDS_WAIT(); asm volatile("" ::: "memory");
#pragma unroll 1
        for (int k8 = 0; k8 < 8; ++k8) {
            float acc[8];
#pragma unroll
            for (int j = 0; j < 8; ++j) acc[j] = 0.f;
            const float* wr = (AR.in[11]) + (size_t)(k0 + k8 * 8) * 1024 + hp * 64;
#pragma unroll 4
            for (int d = 0; d < 64; ++d) { const float sv = scr[d * 64 + lane];
#pragma unroll
                for (int j = 0; j < 8; ++j) acc[j] += wr[(size_t)j * 1024 + d] * sv; }
            v4u o; o.x = pk2(acc[0], acc[1]); o.y = pk2(acc[2], acc[3]); o.z = pk2(acc[4], acc[5]); o.w = pk2(acc[6], acc[7]);
            *(GAS v4u*)(((bf16*)(F.ws + WS_W2)) + (size_t)np * 1024 + k0 + k8 * 8) = o;
        }
        LDS_WAIT(); asm volatile("" ::: "memory");
    }
    {   float mu = 0.f, mv = 0.f;
        for (int it = gw; it < 2 * 32768; it += NGW) {
            const float* src = (it < 32768) ? (AR.in[13]) : (AR.in[14]); const size_t e0 = (size_t)(it & 32767) * 512 + lane * 8;
            const f32x4 a = *(const GAS f32x4*)(src + e0), b = *(const GAS f32x4*)(src + e0 + 4);
            const float m = fmaxf(fmaxf(fmaxf(fabsf(a.x), fabsf(a.y)), fmaxf(fabsf(a.z), fabsf(a.w))), fmaxf(fmaxf(fabsf(b.x), fabsf(b.y)), fmaxf(fabsf(b.z), fabsf(b.w))));
            if (it < 32768) mu = fmaxf(mu, m); else mv = fmaxf(mv, m);
        }
#pragma unroll
        for (int o = 1; o < 64; o <<= 1) { mu = fmaxf(mu, __shfl_xor(mu, o)); mv = fmaxf(mv, __shfl_xor(mv, o)); }
        if (lane == 0) { __hip_atomic_fetch_max(F.ctl + CW_AMAX, __float_as_uint(mu), RLX_AGENT); __hip_atomic_fetch_max(F.ctl + CW_AMAX + 1, __float_as_uint(mv), RLX_AGENT); }
    }
    for (int it = gw * 64 + lane; it < 4096 * 8; it += NGW * 64) {
        const int pos = it >> 3, i = it & 7;
        const float invf = exp2f(-(float)i * 0.125f * 18.931568569324174f);
        const double ang = (double)((float)pos * invf);
        const double kq = __builtin_rint(ang * 0.6366197723675814);
        const float r = (float)(ang - kq * 1.5707963267948966);
        const int q = (int)((long long)kq & 3);
        const float r2 = r * r;
        const float sn = r + r * r2 * (-1.6666654611e-1f + r2 * (8.3321608736e-3f + r2 * (-1.9515295891e-4f)));
        const float cs = 1.0f - 0.5f * r2 + r2 * r2 * (4.166664568298827e-2f + r2 * (-1.388731625493765e-3f + r2 * 2.443315711809948e-5f));
        const float s = (q == 0) ? sn : (q == 1) ? cs : (q == 2) ? -sn : -cs;
        const float c = (q == 0) ? cs : (q == 1) ? -sn : (q == 2) ? -cs : sn;
        ((float*)(F.ws + WS_ROPE))[pos * 16 + i] = c; ((float*)(F.ws + WS_ROPE))[pos * 16 + 8 + i] = s;
    }
    for (int m = gw; m < MTOK; m += NGW) rms_row_to_bf16((AR.in[0]) + (size_t)m * DM, (AR.in[1]), ((bf16*)(F.ws + WS_ACT)) + (size_t)m * DM, lane);
}

__device__ __forceinline__ void unpack8(const v4u w, float (&v)[8]) { v[0] = bflo(w.x); v[1] = bfhi(w.x); v[2] = bflo(w.y); v[3] = bfhi(w.y); v[4] = bflo(w.z); v[5] = bfhi(w.z); v[6] = bflo(w.w); v[7] = bfhi(w.w); }
__device__ __forceinline__ v4u pack8(const float (&v)[8]) { v4u o; o.x = pk2(v[0], v[1]); o.y = pk2(v[2], v[3]); o.z = pk2(v[4], v[5]); o.w = pk2(v[6], v[7]); return o; }
__device__ __forceinline__ void rope8(float (&v)[8], int sub, const float (&cs)[8], const float (&sn)[8]) {
    float pv[8];
#pragma unroll
    for (int j = 0; j < 8; ++j) pv[j] = __shfl_xor(v[j], 1);
    if (sub == 0) {
#pragma unroll
        for (int j = 0; j < 8; ++j) v[j] = v[j] * cs[j] - pv[j] * sn[j];
    } else if (sub == 1) {
#pragma unroll
        for (int j = 0; j < 8; ++j) v[j] = v[j] * cs[j] + pv[j] * sn[j];
    }
}
__device__ __forceinline__ float fp8_scale(unsigned amax_bits) { const unsigned be = (amax_bits >> 23) & 0xffu; return (be == 0u || be > 250u) ? 1.0f : __uint_as_float((261u - be) << 23); }
__device__ __forceinline__ float fp8_inv_scale(unsigned amax_bits) { const unsigned be = (amax_bits >> 23) & 0xffu; return (be == 0u || be > 250u) ? 1.0f : __uint_as_float((be - 7u) << 23); }
__device__ __forceinline__ void row_to_fp8(const float* src, unsigned char* dst, float sc, int lane) {
    const GAS f32x4* p = (const GAS f32x4*)src + lane * 4; v4u o;
#pragma unroll
    for (int q = 0; q < 4; ++q) { const f32x4 a = p[q]; int w = 0; w = __builtin_amdgcn_cvt_pk_fp8_f32(a.x * sc, a.y * sc, w, false); w = __builtin_amdgcn_cvt_pk_fp8_f32(a.z * sc, a.w * sc, w, true); o[q] = (unsigned)w; }
    *(GAS v4u*)(dst + lane * 16) = o;
}
__device__ __forceinline__ void fixup_token(Frame& F, const Args& AR, int tok) {
    const int lane = F.lane, sub = lane & 7, pos = tok & (SEQ - 1);
    bf16* row = ((bf16*)(F.ws + WS_PROJ)) + (size_t)tok * LDP;
    float cs[8], sn[8];
    { const GAS f32x4* rt = (const GAS f32x4*)(((float*)(F.ws + WS_ROPE)) + pos * 16); const f32x4 a = rt[0], b = rt[1], c = rt[2], d = rt[3];
      cs[0] = a.x; cs[1] = a.y; cs[2] = a.z; cs[3] = a.w; cs[4] = b.x; cs[5] = b.y; cs[6] = b.z; cs[7] = b.w;
      sn[0] = c.x; sn[1] = c.y; sn[2] = c.z; sn[3] = c.w; sn[4] = d.x; sn[5] = d.y; sn[6] = d.z; sn[7] = d.w; }
#pragma unroll
    for (int which = 0; which < 2; ++which) {
        GAS v4u* p = (GAS v4u*)(row + (which ? K_OFF : Q_OFF) + lane * 8);
        float v[8]; unpack8(*p, v);
        float ss = 0.f;
#pragma unroll
        for (int j = 0; j < 8; ++j) ss += v[j] * v[j];
        ss += __shfl_xor(ss, 1); ss += __shfl_xor(ss, 2); ss += __shfl_xor(ss, 4);
        const float rs = 1.0f / sqrtf(ss * (1.f / 64.f) + EPS);
        const float* g = (which ? (AR.in[4]) : (AR.in[3])) + sub * 8;
#pragma unroll
        for (int j = 0; j < 8; ++j) v[j] = v[j] * rs * g[j];
        rope8(v, sub, cs, sn);
        if (which == 0) {
#pragma unroll
            for (int j = 0; j < 8; ++j) v[j] *= C2;
        }
        *p = pack8(v);
    }
    { GAS v4u* p = (GAS v4u*)(row + QI_OFF + lane * 8); float v[8]; unpack8(*p, v); rope8(v, sub, cs, sn); *p = pack8(v); }
    { GAS v4u* p = (GAS v4u*)(row + KI_OFF + (lane & 7) * 8); float v[8]; unpack8(*p, v); rope8(v, sub, cs, sn); if (lane < 8) *p = pack8(v); }
    { const int g = lane >> 4, w = 2 << g;
      float acc[8], cur[8];
#pragma unroll
      for (int j = 0; j < 8; ++j) acc[j] = 0.f;
      unpack8(*(const GAS v4u*)(row + P_OFF + lane * 8), cur);
#pragma unroll
      for (int j = 0; j < 8; ++j) acc[j] = cur[j];
#pragma unroll
      for (int back = 1; back < 16; ++back) {
          if (back < w && back <= pos) { float t[8]; unpack8(*(const GAS v4u*)(row - (size_t)back * LDP + P_OFF + lane * 8), t);
#pragma unroll
              for (int j = 0; j < 8; ++j) acc[j] += t[j]; }
      }
      const float inv = 1.0f / (float)((pos + 1 < w) ? (pos + 1) : w);
      float o[8];
#pragma unroll
      for (int j = 0; j < 8; ++j) o[j] = acc[j] * inv - cur[j];
      *(GAS v4u*)(((bf16*)(F.ws + WS_POOLED)) + (size_t)tok * 512 + lane * 8) = pack8(o); }
}

__device__ __forceinline__ int wave_incl_scan(int v) {
    v += __builtin_amdgcn_update_dpp(0, v, 0x111, 0xf, 0xf, false);
    v += __builtin_amdgcn_update_dpp(0, v, 0x112, 0xf, 0xf, false);
    v += __builtin_amdgcn_update_dpp(0, v, 0x114, 0xf, 0xf, false);
    v += __builtin_amdgcn_update_dpp(0, v, 0x118, 0xf, 0xf, false);
    v += __builtin_amdgcn_update_dpp(0, v, 0x142, 0xa, 0xf, false);
    v += __builtin_amdgcn_update_dpp(0, v, 0x143, 0xc, 0xf, false);
    return v;
}
template <int NB> __device__ __forceinline__ void hist_search(const LAS unsigned* hist, int need, int lane, int& B, int& G, int& E) {
    constexpr int PER = NB / 64;
    int t = 0;
#pragma unroll
    for (int q = 0; q < PER / 4; ++q) { const v4u h = *(const LAS v4u*)(hist + lane * PER + 4 * q); t += (int)(h.x + h.y + h.z + h.w); }
    const int pfx = wave_incl_scan(t);
    const int L = __ffsll((long long)__ballot(pfx >= need)) - 1;
    const int base = __builtin_amdgcn_readlane(pfx, L) - __builtin_amdgcn_readlane(t, L);
    const int hv = (lane < PER) ? (int)hist[L * PER + lane] : 0;
    const int p2 = wave_incl_scan(hv) + base;
    const int i = __ffsll((long long)__ballot(p2 >= need)) - 1;
    B = L * PER + i; E = __builtin_amdgcn_readlane(hv, i); G = __builtin_amdgcn_readlane(p2, i) - E;
}
template <int NB> __device__ __forceinline__ void hist_zero(LAS unsigned* hist, int lane) {
#pragma unroll
    for (int q = 0; q < NB / 256; ++q) *(LAS v4u*)(hist + q * 256 + lane * 4) = (v4u){0u, 0u, 0u, 0u};
}
#define HIST_ADD(p) (void)__hip_atomic_fetch_add((p), 1u, __ATOMIC_RELAXED, __HIP_MEMORY_SCOPE_WORKGROUP)
#define wlane(dst, sval, j) asm volatile("s_nop 3\n\tv_writelane_b32 %0, %1, %2\n\ts_nop 1" : "+v"(dst) : "s"(sval), "i"(j))
__device__ __forceinline__ void select_row(const float* srow, LAS unsigned* hist, int nj, int lastw, GAS unsigned long long* mout, int lane) {
    unsigned key[64];
#pragma unroll
    for (int g = 0; g < 8; ++g) {
        if (nj > 8 * g) {
#pragma unroll
            for (int jj = 0; jj < 8; ++jj) key[8 * g + jj] = ordk(((const GAS float*)srow)[64 * (8 * g + jj) + lane] + 0.0f);
        } else {
#pragma unroll
            for (int jj = 0; jj < 8; ++jj) key[8 * g + jj] = 0u;
        }
    }
    LDS_WAIT(); asm volatile("" ::: "memory");
    int need = 256, B, G, E;
    hist_zero<2048>(hist, lane); LDS_WAIT(); asm volatile("" ::: "memory");
#pragma unroll
    for (int g = 0; g < 8; ++g) if (nj > 8 * g) {
#pragma unroll
        for (int jj = 0; jj < 8; ++jj) HIST_ADD(hist + (2047u - (key[8 * g + jj] >> 21)));
    }
    LDS_WAIT(); asm volatile("" ::: "memory");
    hist_search<2048>(hist, need, lane, B, G, E); need -= G;
    const unsigned d1 = 2047u - (unsigned)B;
    asm volatile("" ::: "memory"); hist_zero<2048>(hist, lane); LDS_WAIT(); asm volatile("" ::: "memory");
#pragma unroll
    for (int g = 0; g < 8; ++g) if (nj > 8 * g) {
#pragma unroll
        for (int jj = 0; jj < 8; ++jj) { const unsigned k = key[8 * g + jj]; if ((k >> 21) == d1) HIST_ADD(hist + (2047u - ((k >> 10) & 0x7ffu))); }
    }
    LDS_WAIT(); asm volatile("" ::: "memory");
    hist_search<2048>(hist, need, lane, B, G, E); need -= G;
    const unsigned pre2 = (d1 << 11) | (2047u - (unsigned)B);
    asm volatile("" ::: "memory"); hist_zero<1024>(hist, lane); LDS_WAIT(); asm volatile("" ::: "memory");
#pragma unroll
    for (int g = 0; g < 8; ++g) if (nj > 8 * g) {
#pragma unroll
        for (int jj = 0; jj < 8; ++jj) { const unsigned k = key[8 * g + jj]; if ((k >> 10) == pre2) HIST_ADD(hist + (1023u - (k & 0x3ffu))); }
    }
    LDS_WAIT(); asm volatile("" ::: "memory");
    hist_search<1024>(hist, need, lane, B, G, E); need -= G;
    const unsigned v = (pre2 << 10) | (1023u - (unsigned)B);
    unsigned mlo = 0u, mhi = 0u;
    if (need == E) {
#pragma unroll
        for (int j = 0; j < 64; ++j) { const unsigned long long m = __ballot(key[j] >= v); wlane(mlo, (unsigned)m, j); wlane(mhi, (unsigned)(m >> 32), j); }
    } else {
#pragma unroll
        for (int j = 0; j < 64; ++j) {
            unsigned long long eq = __ballot(key[j] == v); const unsigned long long gt = __ballot(key[j] > v);
            unsigned long long keep = 0ull;
            while (need > 0 && eq != 0ull) { const unsigned long long lsb = eq & (0ull - eq); keep |= lsb; eq ^= lsb; --need; }
            const unsigned long long m = gt | keep;
            wlane(mlo, (unsigned)m, j); wlane(mhi, (unsigned)(m >> 32), j);
        }
    }
    if (lane <= lastw) mout[lane] = ((unsigned long long)mhi << 32) | (unsigned long long)mlo;
    LDS_WAIT(); asm volatile("" ::: "memory");
}

__device__ __forceinline__ float* wave_scratch(unsigned char* ws, int gwv) {
    if (gwv < 1024) return (float*)(ws + WS_ACT) + (size_t)gwv * 32768;
    gwv -= 1024; if (gwv < 512) return (float*)(ws + WS_AO) + (size_t)gwv * 32768;
    gwv -= 512; if (gwv < 352) return (float*)(ws + 980 * MiB) + (size_t)gwv * 32768;
    gwv -= 352; if (gwv < 128) return (float*)(ws + 36 * MiB) + (size_t)gwv * 32768;
    gwv -= 128; return (float*)(ws + 68 * MiB) + (size_t)(gwv & 127) * 32768;
}
__device__ __forceinline__ void idx_unit(Frame& F, const Args& AR, int b, int c, bool do_select = true) {
    const int lane = F.lane, wid = F.wave, l31 = lane & 31, h2 = lane >> 5;
    const size_t rowb = (size_t)b * SEQ, tp0 = rowb + (size_t)c * 64 + wid * 8;
    GAS unsigned long long* mbase = (GAS unsigned long long*)(((unsigned long long*)(F.ws + WS_MASK)) + tp0 * 64);
    if (c < 4) {
        if (lane < 32) { const int q = lane >> 2, j = lane & 3; mbase[q * 64 + j] = (j <= c) ? ~0ull : 0ull; }
        return;
    }
    float* sc = wave_scratch(F.ws, F.vcu * NWAVES + wid);
    LAS unsigned* hist = (LAS unsigned*)(F.lds + wid * 8192);
    const int ntile = 2 * (c + 1), nj = c + 1, lastw = c | 3, ntile_pad = 16 * ((nj + 7) >> 3);
    const int head = (l31 & 3) | (((l31 >> 3) & 1) << 2), qsub = ((l31 >> 2) & 1) | (((l31 >> 4) & 1) << 1);
    bf16x8 a[2][4]; float w[2][16];
#pragma unroll
    for (int rb = 0; rb < 2; ++rb) {
        const bf16* ap = ((bf16*)(F.ws + WS_PROJ)) + (tp0 + 4 * rb + qsub) * LDP + QI_OFF + head * 64 + h2 * 8;
#pragma unroll
        for (int st = 0; st < 4; ++st) a[rb][st] = *(const GAS bf16x8*)(ap + st * 16);
        const v4u wa = *(const GAS v4u*)(((bf16*)(F.ws + WS_PROJ)) + (tp0 + 4 * rb + h2) * LDP + WI_OFF), wb = *(const GAS v4u*)(((bf16*)(F.ws + WS_PROJ)) + (tp0 + 4 * rb + h2 + 2) * LDP + WI_OFF);
        float t[8]; unpack8(wa, t);
#pragma unroll
        for (int j = 0; j < 8; ++j) w[rb][j] = t[j] * WI_SCALE;
        unpack8(wb, t);
#pragma unroll
        for (int j = 0; j < 8; ++j) w[rb][8 + j] = t[j] * WI_SCALE;
    }
    {
        LAS unsigned char* kb = F.lds + 65536;
        const int nstage = (ntile + 3) >> 2;
        const int sk0 = F.tid >> 3, sch = F.tid & 7;
        const bf16* kg = ((bf16*)(F.ws + WS_PROJ)) + (rowb + sk0) * LDP + KI_OFF + sch * 8;
        v4u r0 = *(const GAS v4u*)kg, r1 = *(const GAS v4u*)(kg + (size_t)64 * LDP);
#pragma unroll 1
        for (int sg = 0; sg < nstage; ++sg) {
            LAS unsigned char* cur = kb + (sg & 1) * 18432;
            *(LAS v4u*)(cur + sk0 * 144 + sch * 16) = r0; *(LAS v4u*)(cur + (sk0 + 64) * 144 + sch * 16) = r1;
            __syncthreads();
            if (sg + 1 < nstage) { r0 = *(const GAS v4u*)(kg + (size_t)(sg + 1) * 128 * LDP); r1 = *(const GAS v4u*)(kg + (size_t)((sg + 1) * 128 + 64) * LDP); }
#pragma unroll
            for (int t4 = 0; t4 < 4; ++t4) {
                const int kt = 4 * sg + t4;
                if (kt < ntile) {
                    bf16x8 bfr[4];
#pragma unroll
                    for (int st = 0; st < 4; ++st) bfr[st] = *(const LAS bf16x8*)(cur + (t4 * 32 + l31) * 144 + st * 32 + h2 * 16);
#pragma unroll
                    for (int rb = 0; rb < 2; ++rb) {
                        f32x16 acc;
#pragma unroll
                        for (int r = 0; r < 16; ++r) acc[r] = 0.f;
#pragma unroll
                        for (int st = 0; st < 4; ++st) acc = __builtin_amdgcn_mfma_f32_32x32x16_bf16(a[rb][st], bfr[st], acc, 0, 0, 0);
                        float s0 = 0.f, s1 = 0.f;
#pragma unroll
                        for (int r = 0; r < 8; ++r) { s0 = fmaf(w[rb][r], fmaxf(acc[r], 0.f), s0); s1 = fmaf(w[rb][8 + r], fmaxf(acc[8 + r], 0.f), s1); }
                        ((GAS float*)sc)[(4 * rb + h2) * 4096 + kt * 32 + l31] = s0;
                        ((GAS float*)sc)[(4 * rb + h2 + 2) * 4096 + kt * 32 + l31] = s1;
                    }
                }
            }
        }
        for (int kt = ntile; kt < ntile_pad; ++kt) {
#pragma unroll
            for (int rb = 0; rb < 2; ++rb) { ((GAS float*)sc)[(4 * rb + h2) * 4096 + kt * 32 + l31] = -INFINITY; ((GAS float*)sc)[(4 * rb + h2 + 2) * 4096 + kt * 32 + l31] = -INFINITY; }
        }
    }
    VM_WAIT();
    if (do_select) {
#pragma unroll 1
        for (int q = 0; q < 8 * PROBE_SEL2; ++q) select_row(sc + (q & 7) * 4096, hist, nj, lastw, mbase + (q & 7) * 64, lane);
    }
}

__device__ __forceinline__ void attn_unit(Frame& F, const Args& AR, int b, int h, int qb) {
    const int lane = F.lane, wid = F.wave, l31 = lane & 31, h2 = lane >> 5;
    LAS unsigned char* Ks = F.lds;
    LAS float* wsf = (LAS float*)(F.lds + 2 * 17408) + wid * 32;
    const size_t rowb = (size_t)b * SEQ, tok0 = rowb + (size_t)qb * 256 + wid * 32;
    bf16x8 qf[4];
    { const bf16* qp = ((bf16*)(F.ws + WS_PROJ)) + (tok0 + l31) * LDP + Q_OFF + h * 64 + h2 * 8;
#pragma unroll
      for (int st = 0; st < 4; ++st) qf[st] = *(const GAS bf16x8*)(qp + st * 16); }
    const int NT = 4 * (qb + 1), cw = qb * 4 + (wid >> 1);
    f32x16 o0, o1;
#pragma unroll
    for (int r = 0; r < 16; ++r) { o0[r] = 0.f; o1[r] = 0.f; }
    float lsum = 0.f;
    const int skey = F.tid >> 3, sch = F.tid & 7;
    const bf16* kg = ((bf16*)(F.ws + WS_PROJ)) + (rowb + skey) * LDP + K_OFF + h * 64 + sch * 8;
    const bf16* vg = ((bf16*)(F.ws + WS_PROJ)) + (rowb + skey) * LDP + V_OFF + h * 64 + sch * 8;
    const unsigned kst = skey * 144 + sch * 16, vst = skey * 128 + ((sch * 16) ^ (((skey >> 1) & 1) << 6));
    const GAS unsigned long long* mrow = (const GAS unsigned long long*)(((unsigned long long*)(F.ws + WS_MASK)) + (tok0 + l31) * 64);
    const int i16 = lane & 15, qq = i16 >> 2, pp = i16 & 3, blk = (lane >> 4) & 1;
    const unsigned vrd = (unsigned)((4 * h2 + qq) * 128 + ((32 * blk + 8 * pp) ^ (((qq >> 1) & 1) << 6)));
    v4u kr[3], vr[3];
#pragma unroll
    for (int u = 0; u < 3; ++u) { kr[u] = *(const GAS v4u*)(kg + (size_t)u * 64 * LDP); vr[u] = *(const GAS v4u*)(vg + (size_t)u * 64 * LDP); }
    unsigned long long mwn = mrow[0];
#pragma unroll 1
    for (int t = 0; t < NT; t += 3) {
#pragma unroll
        for (int u = 0; u < 3; ++u) {
            const int tt = t + u;
            if (tt < NT) {
                LAS unsigned char* Kc = Ks + (tt & 1) * 17408; LAS unsigned char* Vc = Kc + 9216;
                *(LAS v4u*)(Kc + kst) = kr[u]; *(LAS v4u*)(Vc + vst) = vr[u];
                __syncthreads();
                if (tt + 3 < NT) { kr[u] = *(const GAS v4u*)(kg + (size_t)(tt + 3) * 64 * LDP); vr[u] = *(const GAS v4u*)(vg + (size_t)(tt + 3) * 64 * LDP); }
                const unsigned long long mw = mwn;
                mwn = mrow[(tt + 1 < NT) ? tt + 1 : tt];
                if (tt <= cw) {
                    f32x16 p[2];
        #pragma unroll
                    for (int kb = 0; kb < 2; ++kb) {
                        f32x16 acc;
        #pragma unroll
                        for (int r = 0; r < 16; ++r) acc[r] = 0.f;
        #pragma unroll
                        for (int st = 0; st < 4; ++st) { const bf16x8 ka = *(const LAS bf16x8*)(Kc + (32 * kb + l31) * 144 + st * 32 + h2 * 16); acc = __builtin_amdgcn_mfma_f32_32x32x16_bf16(ka, qf[st], acc, 0, 0, 0); }
                        const unsigned wk = (kb ? (unsigned)(mw >> 32) : (unsigned)mw) >> (4 * h2);
        #pragma unroll
                        for (int r = 0; r < 16; ++r) {
                            const float e = __builtin_amdgcn_exp2f(acc[r]);
                            const int m = __builtin_amdgcn_sbfe((int)wk, (r & 3) + 8 * (r >> 2), 1);
                            const float pe = __uint_as_float(__float_as_uint(e) & (unsigned)m);
                            acc[r] = pe;
                        }
                        p[kb] = acc;
                    }
        #pragma unroll
                    for (int kb = 0; kb < 2; ++kb)
        #pragma unroll
                        for (int s = 0; s < 2; ++s) {
                            v4u pw; pw.x = pg8::cvt_pk_bf16(p[kb][8 * s + 0], p[kb][8 * s + 1]); pw.y = pg8::cvt_pk_bf16(p[kb][8 * s + 2], p[kb][8 * s + 3]); pw.z = pg8::cvt_pk_bf16(p[kb][8 * s + 4], p[kb][8 * s + 5]); pw.w = pg8::cvt_pk_bf16(p[kb][8 * s + 6], p[kb][8 * s + 7]);
                            lsum = dot2bf(pw.x, 0x3f803f80u, lsum); lsum = dot2bf(pw.y, 0x3f803f80u, lsum); lsum = dot2bf(pw.z, 0x3f803f80u, lsum); lsum = dot2bf(pw.w, 0x3f803f80u, lsum);
                            const bf16x8 pa = __builtin_bit_cast(bf16x8, pw);
                            const unsigned rbase = vrd + (unsigned)((32 * kb + 16 * s) * 128);
        #pragma unroll
                            for (int d0 = 0; d0 < 2; ++d0) {
                                const unsigned ad = rbase ^ (unsigned)(d0 << 6);
                                const s16x4 lo = __builtin_bit_cast(s16x4, __builtin_amdgcn_ds_read_tr16_b64_v4i16((LAS s16x4*)(Vc + ad)));
                                const s16x4 hi = __builtin_bit_cast(s16x4, __builtin_amdgcn_ds_read_tr16_b64_v4i16((LAS s16x4*)(Vc + ad + 8 * 128)));
                                const bf16x8 vb = (bf16x8){lo[0], lo[1], lo[2], lo[3], hi[0], hi[1], hi[2], hi[3]};
                                if (d0 == 0) o0 = __builtin_amdgcn_mfma_f32_32x32x16_bf16(pa, vb, o0, 0, 0, 0); else o1 = __builtin_amdgcn_mfma_f32_32x32x16_bf16(pa, vb, o1, 0, 0, 0);
                            }
                        }
                }
            }
        }
    }
    lsum += __shfl_xor(lsum, 32);
    if (h2 == 0) wsf[l31] = lsum;
    LDS_WAIT(); asm volatile("" ::: "memory");
    bf16* op = ((bf16*)(F.ws + WS_AO)) + tok0 * 512 + h * 64 + l31;
#pragma unroll
    for (int r = 0; r < 16; ++r) { const int q = crow(r, h2); const float rl = 1.0f / wsf[q];
        op[(size_t)q * 512] = (bf16)f2bf(o0[r] * rl); op[(size_t)q * 512 + 32] = (bf16)f2bf(o1[r] * rl); }
    LDS_WAIT(); asm volatile("" ::: "memory");
}

__device__ __forceinline__ void sort16_desc(unsigned (&a)[16]) {
#pragma unroll
    for (int k = 2; k <= 16; k <<= 1)
#pragma unroll
        for (int j = k >> 1; j > 0; j >>= 1)
#pragma unroll
            for (int i = 0; i < 16; ++i) { const int l = i ^ j; if (l > i) { const unsigned hi = a[i] > a[l] ? a[i] : a[l], lo = a[i] > a[l] ? a[l] : a[i];
                if ((i & k) == 0) { a[i] = hi; a[l] = lo; } else { a[i] = lo; a[l] = hi; } } }
}
__device__ __forceinline__ void merge16_desc(unsigned (&top)[16], const unsigned (&a)[16]) {
#pragma unroll
    for (int i = 0; i < 16; ++i) top[i] = top[i] > a[15 - i] ? top[i] : a[15 - i];
#pragma unroll
    for (int j = 8; j > 0; j >>= 1)
#pragma unroll
        for (int i = 0; i < 16; ++i) { const int l = i ^ j; if (l > i) { const unsigned hi = top[i] > top[l] ? top[i] : top[l], lo = top[i] > top[l] ? top[l] : top[i]; top[i] = hi; top[l] = lo; } }
}
struct PairTab { int i[64], j[64]; };
constexpr PairTab make_pairs() { PairTab t{}; int n = 0; for (int i = 0; i < 16; ++i) for (int j = 0; j < 16; ++j) if ((i + 1) * (j + 1) <= 16) { t.i[n] = i; t.j[n] = j; ++n; } for (; n < 64; ++n) { t.i[n] = -1; t.j[n] = -1; } return t; }
__device__ __forceinline__ void route_wave(Frame& F, const Args& AR, size_t tokbase) {
    const int lane = F.lane; const size_t tok = tokbase + (lane >> 4); const int hp = lane & 15, half = hp & 1;
    const GAS v4u* rp = (const GAS v4u*)(((unsigned*)(F.ws + WS_PROJ)) + tok * 2048 + hp * 128);
    unsigned list[16];
#pragma unroll 1
    for (int grp = 0; grp < 8; ++grp) {
        unsigned a[16];
#pragma unroll
        for (int q = 0; q < 4; ++q) { const v4u kv = rp[4 * grp + q]; a[4 * q] = kv.x; a[4 * q + 1] = kv.y; a[4 * q + 2] = kv.z; a[4 * q + 3] = kv.w; }
        sort16_desc(a);
        if (grp == 0) {
#pragma unroll
            for (int i = 0; i < 16; ++i) list[i] = a[i];
        } else merge16_desc(list, a);
    }
    LAS unsigned* lk = (LAS unsigned*)F.lds;
#pragma unroll
    for (int i = 0; i < 16; ++i) lk[i * 512 + F.tid] = list[i];
    LDS_WAIT(); asm volatile("" ::: "memory");
    const int ta = F.tid & ~1, tb = F.tid | 1;
    unsigned KA[16], KB[16]; float sa[16], sb[16];
#pragma unroll
    for (int i = 0; i < 16; ++i) { KA[i] = lk[i * 512 + ta]; KB[i] = lk[i * 512 + tb]; sa[i] = unordk(KA[i] & ~127u); sb[i] = unordk(KB[i] & ~127u); }
    unsigned ck[16];
#pragma unroll
    for (int grp = 0; grp < 4; ++grp) {
        unsigned a[16];
#pragma unroll
        for (int q = 0; q < 16; ++q) { constexpr PairTab T = make_pairs(); const int pi = T.i[grp * 16 + q], pj = T.j[grp * 16 + q];
            a[q] = (pi < 0) ? 0u : ((ordk(sa[pi < 0 ? 0 : pi] + sb[pj < 0 ? 0 : pj]) & ~255u) | (unsigned)(255 - (pi * 16 + pj))); }
        sort16_desc(a);
        if (grp == 0) {
#pragma unroll
            for (int i = 0; i < 16; ++i) ck[i] = a[i];
        } else merge16_desc(ck, a);
    }
    unsigned ce[16];
#pragma unroll
    for (int t = 0; t < 16; ++t) { const unsigned flat = 255u - (ck[t] & 255u); const unsigned ka = lk[(flat >> 4) * 512 + ta], kb = lk[(flat & 15u) * 512 + tb];
        ce[t] = (127u - (ka & 127u)) * 128u + (127u - (kb & 127u)); }
    LDS_WAIT(); asm volatile("" ::: "memory");
    float ts[16]; float sum = 0.f; const float mx = unordk(ck[0] & ~255u);
#pragma unroll
    for (int t = 0; t < 16; ++t) { ts[t] = __builtin_amdgcn_exp2f((unordk(ck[t] & ~255u) - mx) * 1.4426950408889634f); sum += ts[t]; }
    const float inv = 1.0f / sum;
    if (half == 0) {
        GAS v4u* eo = (GAS v4u*)(((unsigned short*)(F.ws + WS_REXP)) + tok * 128 + (hp >> 1) * 16); GAS f32x4* go = (GAS f32x4*)(((float*)(F.ws + WS_RG)) + tok * 128 + (hp >> 1) * 16);
        eo[0] = (v4u){ce[0] | (ce[1] << 16), ce[2] | (ce[3] << 16), ce[4] | (ce[5] << 16), ce[6] | (ce[7] << 16)};
        eo[1] = (v4u){ce[8] | (ce[9] << 16), ce[10] | (ce[11] << 16), ce[12] | (ce[13] << 16), ce[14] | (ce[15] << 16)};
#pragma unroll
        for (int t4 = 0; t4 < 4; ++t4) go[t4] = (f32x4){ts[4 * t4] * inv, ts[4 * t4 + 1] * inv, ts[4 * t4 + 2] * inv, ts[4 * t4 + 3] * inv};
    }
}

__device__ __forceinline__ float gelu_erf(float v) {
    const float av = fabsf(v), t = __builtin_amdgcn_rcpf(av * 0.2316418882f + 1.0f);
    float q = t * 0.5307027145f + (-0.7265760135f); q = q * t + 0.7107068705f; q = q * t + (-0.142248368f); q = q * t + 0.127414796f; q = q * t;
    const float e = __builtin_amdgcn_exp2f((v * v) * (-0.72134752044f));
    const float m = v * (q * e);
    return v < 0.f ? m : v - m;
}
__device__ __forceinline__ float dpp_add(float v, float w_unused) { return v; }
#define DPP_ADD(v, ctrl) ((v) + __builtin_bit_cast(float, __builtin_amdgcn_update_dpp(0, __builtin_bit_cast(int, (v)), (ctrl), 0xf, 0xf, true)))
constexpr int NSL = 8;
constexpr int CW_PEER = 8192;
typedef float f32x2v __attribute__((ext_vector_type(2)));
__device__ __forceinline__ unsigned id_of(const v4u a, const v4u b, int m) { const unsigned w = (m < 8) ? a[(m & 7) >> 1] : b[(m & 7) >> 1]; return (m & 1) ? (w >> 16) : (w & 0xffffu); }
__device__ __forceinline__ void load_hn2(const bf16* p, f32x2v (&hn2)[8]) { const v4u a = *(const GAS v4u*)p, b = *(const GAS v4u*)(p + 8);
    hn2[0] = (f32x2v){bflo(a.x), bfhi(a.x)}; hn2[1] = (f32x2v){bflo(a.y), bfhi(a.y)}; hn2[2] = (f32x2v){bflo(a.z), bfhi(a.z)}; hn2[3] = (f32x2v){bflo(a.w), bfhi(a.w)};
    hn2[4] = (f32x2v){bflo(b.x), bfhi(b.x)}; hn2[5] = (f32x2v){bflo(b.y), bfhi(b.y)}; hn2[6] = (f32x2v){bflo(b.z), bfhi(b.z)}; hn2[7] = (f32x2v){bflo(b.w), bfhi(b.w)}; }
template <int SIDE> __device__ __forceinline__ void peer_item8(Frame& F, const Args& AR, int s, size_t t0) {
    const int lane = F.lane, ts = lane >> 3, c = lane & 7;
    const size_t tok = t0 + ts;
    const unsigned char* tbase = ((const unsigned char*)(F.ws + (SIDE == 0 ? WS_U16 : WS_V16))) + 128 * s;
    const unsigned lo = 16u * (unsigned)c;
    const GAS v4u* idq = (const GAS v4u*)(((const unsigned short*)(F.ws + WS_REXP)) + tok * 128);
    v4u ia = idq[0], ib = idq[1];
    if (SIDE == 0) {
        f32x2v hn2[8]; load_hn2(((const bf16*)(F.ws + WS_ACT)) + tok * 1024 + 128 * s + 16 * c, hn2);
        float* po = ((float*)(F.ws + WS_PROJ)) + (tok * NSL + s) * 128;
#pragma unroll 1
        for (int b = 0; b < 8; ++b) {
            v4u r[16];
#pragma unroll
            for (int m = 0; m < 16; ++m) r[m] = *(const GAS v4u*)(tbase + (size_t)((id_of(ia, ib, m) << 10) + lo));
            const int bn = (b + 1) & 7; ia = idq[2 * bn]; ib = idq[2 * bn + 1];
            float d[16];
#pragma unroll
            for (int m = 0; m < 16; ++m) { f32x2v acc = {0.f, 0.f};
#pragma unroll
                for (int q = 0; q < 4; ++q) { const int w = (int)r[m][q]; acc = __builtin_amdgcn_cvt_pk_f32_fp8(w, false) * hn2[2 * q] + acc; acc = __builtin_amdgcn_cvt_pk_f32_fp8(w, true) * hn2[2 * q + 1] + acc; }
                float a = acc.x + acc.y; a = DPP_ADD(a, 0xB1); a = DPP_ADD(a, 0x4E); a = DPP_ADD(a, 0x141); d[m] = a; }
            if (c == 0) { GAS f32x4* pq = (GAS f32x4*)(po + 16 * b);
                pq[0] = (f32x4){d[0], d[1], d[2], d[3]}; pq[1] = (f32x4){d[4], d[5], d[6], d[7]}; pq[2] = (f32x4){d[8], d[9], d[10], d[11]}; pq[3] = (f32x4){d[12], d[13], d[14], d[15]}; }
        }
    } else {
        const GAS f32x4* cfq = (const GAS f32x4*)(((const float*)(F.ws + WS_RG)) + tok * 128);
        f32x4 cf[4];
#pragma unroll
        for (int q = 0; q < 4; ++q) cf[q] = cfq[q];
        f32x2v acc[8];
#pragma unroll
        for (int j = 0; j < 8; ++j) acc[j] = (f32x2v){0.f, 0.f};
#pragma unroll 1
        for (int b = 0; b < 8; ++b) {
            v4u r[16];
#pragma unroll
            for (int m = 0; m < 16; ++m) r[m] = *(const GAS v4u*)(tbase + (size_t)((id_of(ia, ib, m) << 10) + lo));
            const int bn = (b + 1) & 7; ia = idq[2 * bn]; ib = idq[2 * bn + 1];
            f32x4 cn[4];
#pragma unroll
            for (int q = 0; q < 4; ++q) cn[q] = cfq[4 * bn + q];
#pragma unroll
            for (int m = 0; m < 16; ++m) { const float cm = cf[m >> 2][m & 3]; const f32x2v c2 = {cm, cm};
#pragma unroll
                for (int q = 0; q < 4; ++q) { const int w = (int)r[m][q]; acc[2 * q] = __builtin_amdgcn_cvt_pk_f32_fp8(w, false) * c2 + acc[2 * q]; acc[2 * q + 1] = __builtin_amdgcn_cvt_pk_f32_fp8(w, true) * c2 + acc[2 * q + 1]; } }
#pragma unroll
            for (int q = 0; q < 4; ++q) cf[q] = cn[q];
        }
        GAS f32x4* op = (GAS f32x4*)((AR.out) + tok * 1024 + 128 * s + 16 * c);
#pragma unroll
        for (int q = 0; q < 4; ++q) { f32x4 h = op[q]; h.x += acc[2 * q].x; h.y += acc[2 * q].y; h.z += acc[2 * q + 1].x; h.w += acc[2 * q + 1].y; op[q] = h; }
    }
}
template <int SIDE> __device__ __forceinline__ void peer_side(Frame& F, const Args& AR, int rep = 0) {
    gu32* cnt = F.ctl + CW_PEER + (SIDE + 2 * rep) * 16 * 64;
    LAS int* sh = (LAS int*)F.lds;
    const unsigned xcc = xb_xcc_id() & 7u;
#pragma unroll 1
    for (int k = 0; k < NSL; ++k) {
        const int s = (int)((xcc + (unsigned)k) & (unsigned)(NSL - 1));
#pragma unroll 1
        for (;;) {
            __syncthreads();
            if (F.tid == 0) sh[0] = (int)__hip_atomic_fetch_add(cnt + 64 * s, 1u, RLX_AGENT);
            __syncthreads();
            const int blk = sh[0];
            if (blk >= MTOK / 128) break;
            const size_t t0 = (size_t)blk * 128 + F.wave * 16;
            peer_item8<SIDE>(F, AR, s, t0); peer_item8<SIDE>(F, AR, s, t0 + 8);
        }
    }
}
__device__ __forceinline__ void peer_coef_token(Frame& F, size_t tok, float inv_su, float inv_sv) {
    const int lane = F.lane;
    const float* pp = ((const float*)(F.ws + WS_PROJ)) + tok * NSL * 128;
    float a0 = 0.f, a1 = 0.f;
#pragma unroll
    for (int s = 0; s < NSL; ++s) { a0 += pp[s * 128 + lane]; a1 += pp[s * 128 + 64 + lane]; }
    float* gp = ((float*)(F.ws + WS_RG)) + tok * 128;
    gp[lane] = gp[lane] * gelu_erf(a0 * inv_su) * inv_sv; gp[64 + lane] = gp[64 + lane] * gelu_erf(a1 * inv_su) * inv_sv;
}

__global__ void __launch_bounds__(NWAVES * 64, 2) mk_fwd(Args args) {
    extern __shared__ __attribute__((aligned(16))) unsigned char lds[];
    Frame F;
    F.lds = (LAS unsigned char*)lds;
    F.MISC = (volatile LAS unsigned*)(F.lds + MISC_OFF);
    F.tid = threadIdx.x; F.lane = F.tid & 63; F.wave = __builtin_amdgcn_readfirstlane(F.tid >> 6);
    F.G = gridDim.x; { const int bx = blockIdx.x; F.vcu = (F.G % 8 == 0) ? (bx % 8) * (F.G / 8) + bx / 8 : bx; }
    F.ws = args.ws;
    F.ctl = (gu32*)(F.ws + WS_CTL);
    const Args& AR = args;
    for (int u = F.tid; u < (LDS_BYTES - LDSCTL_OFF) / 4; u += NWAVES * 64) ((LAS unsigned*)(F.lds + LDSCTL_OFF))[u] = 0u;
    __syncthreads();
    XcdBarrier bar; bar.bar = (unsigned*)(F.ctl + CW_BAR); bar.x = 0; bar.st = nullptr;
#if !MK_PER_PHASE
    bar = xcd_barrier_post((unsigned*)(F.ctl + CW_BAR), F.MISC + 8);
#endif
    const int lo = args.ph_lo, hi = args.ph_hi;
#if defined(ONLY_PHASE)
#define IN(k) ((k) == ONLY_PHASE && lo <= (k) && (k) < hi)
#elif defined(PHASE_MASK)
#define IN(k) (((PHASE_MASK >> (k)) & 1) && lo <= (k) && (k) < hi)
#else
#define IN(k) (lo <= (k) && (k) < hi)
#endif
#if MK_PER_PHASE
#define SEAM(k) do { } while (0)
#else
#define SEAM(k) do { if (IN(k) && IN((k) + 1)) xcd_barrier(bar); } while (0)
#endif
#define FRESH() Frame P = F; { int t_ = threadIdx.x; asm volatile("" : "+v"(t_)); P.tid = t_; P.lane = t_ & 63; P.wave = __builtin_amdgcn_readfirstlane(t_ >> 6); } const int gw = P.vcu * NWAVES + P.wave, NGW = P.G * NWAVES; (void)gw; (void)NGW

    for (int rep_ = 0; rep_ < (((REPEAT_MASK >> 0) & 1) ? 2 : 1); ++rep_) if (IN(0)) { FRESH(); p0_prologue(P, args); } SEAM(0);
    for (int rep_ = 0; rep_ < (((REPEAT_MASK >> 1) & 1) ? 2 : 1); ++rep_) if (IN(1)) { pg8::Gemm g{((bf16*)(F.ws + WS_ACT)), ((bf16*)(F.ws + WS_WIN)), MTOK, LDP, 1024, 1024, 1024}; pg8::StaticOrder S; S.init(MTOK, LDP, F.G, (int)blockIdx.x);
        pg8::EpiStoreBf16 E{((bf16*)(F.ws + WS_PROJ)), LDP};
        pg8::gemm_phase<pg8::EpiStoreBf16, pg8::StaticOrder, true, true>(F.lds, g, S, E); } SEAM(1);
    if (IN(2)) { FRESH(); for (int m = gw; m < MTOK; m += NGW) fixup_token(P, args, m);
        const float su = fp8_scale(__hip_atomic_load(P.ctl + CW_AMAX, RLX_AGENT)), sv = fp8_scale(__hip_atomic_load(P.ctl + CW_AMAX + 1, RLX_AGENT));
        for (int r = gw; r < 2 * 16384; r += NGW) { const int rr = r & 16383;
            if (r < 16384) row_to_fp8(args.in[13] + (size_t)rr * 1024, (unsigned char*)(P.ws + WS_U16) + (size_t)rr * 1024, su, P.lane);
            else row_to_fp8(args.in[14] + (size_t)rr * 1024, (unsigned char*)(P.ws + WS_V16) + (size_t)rr * 1024, sv, P.lane); } } SEAM(2);
    for (int rep_ = 0; rep_ < (((REPEAT_MASK >> 3) & 1) ? 2 : 1); ++rep_) if (IN(3)) { FRESH(); for (int i = P.vcu; i < 256; i += P.G) { const int b = i >> 4, s = i & 15;
#pragma unroll 1
            for (int k = 0; k < 4; ++k) idx_unit(P, args, b, (k == 0) ? s : (k == 1) ? 31 - s : (k == 2) ? 32 + s : 63 - s, PROBE_NOSEL ? (rep_ == 1) : true); } } SEAM(3);
    for (int rep_ = 0; rep_ < (((REPEAT_MASK >> 4) & 1) ? 2 : 1); ++rep_) if (IN(4)) { FRESH(); for (int i = P.vcu; i < 256; i += P.G) { const int bh = i >> 1, s = i & 1, b = bh >> 3, h = bh & 7;
#pragma unroll 1
            for (int k = 0; k < 8; ++k) attn_unit(P, args, b, h, (k & 1) ? 15 - (k >> 1) * 2 - s : (k >> 1) * 2 + s); } } SEAM(4);
    for (int rep_ = 0; rep_ < (((REPEAT_MASK >> 5) & 1) ? 2 : 1); ++rep_) if (IN(5)) { pg8::Gemm g{((bf16*)(F.ws + WS_AO)), ((bf16*)(F.ws + WS_WA)), MTOK, 1024, 512, 512, 512}; pg8::StaticOrder S; S.init(MTOK, 1024, F.G, (int)blockIdx.x);
        pg8::EpiGate<false> E{((bf16*)(F.ws + WS_ACT)), 1024, ((bf16*)(F.ws + WS_PROJ)) + GA_OFF, LDP};
        pg8::gemm_phase<pg8::EpiGate<false>, pg8::StaticOrder, true, true>(F.lds, g, S, E); } SEAM(5);
    if (IN(6)) { pg8::Gemm g{((bf16*)(F.ws + WS_POOLED)), ((bf16*)(F.ws + WS_WPP)), MTOK, 1024, 512, 512, 512}; pg8::StaticOrder S; S.init(MTOK, 1024, F.G, (int)blockIdx.x);
                pg8::EpiGate<true> E{((bf16*)(F.ws + WS_ACT)), 1024, ((bf16*)(F.ws + WS_PROJ)) + GP_OFF, LDP};
        pg8::gemm_phase<pg8::EpiGate<true>, pg8::StaticOrder, true, true>(F.lds, g, S, E); } SEAM(6);
    for (int rep_ = 0; rep_ < (((REPEAT_MASK >> 7) & 1) ? 2 : 1); ++rep_) if (IN(7)) { pg8::Gemm g{((bf16*)(F.ws + WS_ACT)), ((bf16*)(F.ws + WS_WO)), MTOK, 1024, 1024, 1024, 1024}; pg8::StaticOrder S; S.init(MTOK, 1024, F.G, (int)blockIdx.x);
        pg8::EpiResF32 E{(AR.in[0]), (AR.out), 1024};
        pg8::gemm_phase<pg8::EpiResF32, pg8::StaticOrder, true, true>(F.lds, g, S, E); } SEAM(7);

    for (int rep_ = 0; rep_ < (((REPEAT_MASK >> 8) & 1) ? 2 : 1); ++rep_) if (IN(8)) { FRESH(); for (int m = gw; m < MTOK; m += NGW) rms_row_to_bf16((args.out) + (size_t)m * DM, (args.in[10]), ((bf16*)(P.ws + WS_ACT)) + (size_t)m * DM, P.lane); } SEAM(8);
    for (int rep_ = 0; rep_ < (((REPEAT_MASK >> 9) & 1) ? 2 : 1); ++rep_) if (IN(9)) { pg8::Gemm g{((bf16*)(F.ws + WS_ACT)), ((bf16*)(F.ws + WS_W2)), MTOK, 2048, 1024, 1024, 1024}; pg8::StaticOrder S; S.init(MTOK, 2048, F.G, (int)blockIdx.x);
        pg8::EpiKeys E{((unsigned*)(F.ws + WS_PROJ)), 2048};
        pg8::gemm_phase<pg8::EpiKeys, pg8::StaticOrder, true, true>(F.lds, g, S, E); } SEAM(9);
    for (int rep_ = 0; rep_ < (((REPEAT_MASK >> 10) & 1) ? 2 : 1); ++rep_) if (IN(10)) { FRESH(); for (int m4 = gw; m4 < MTOK / 4; m4 += NGW) route_wave(P, args, (size_t)m4 * 4); } SEAM(10);
        for (int rep_ = 0; rep_ < (((REPEAT_MASK >> 11) & 1) ? 2 : 1); ++rep_) if (IN(11)) { FRESH(); peer_side<0>(P, args, rep_); } SEAM(11);
    if (IN(12)) { FRESH(); const float iu = fp8_inv_scale(__hip_atomic_load(P.ctl + CW_AMAX, RLX_AGENT)), iv = fp8_inv_scale(__hip_atomic_load(P.ctl + CW_AMAX + 1, RLX_AGENT));
        for (int m = gw; m < MTOK; m += NGW) peer_coef_token(P, (size_t)m, iu, iv); } SEAM(12);
    if (IN(13)) { FRESH(); peer_side<1>(P, args); }

#undef IN
#undef SEAM
}

extern "C" void kernel_launch(void* const* d_in, const int* in_sizes, int n_in, void* d_out, int out_size, void* d_ws, size_t ws_size, hipStream_t stream) {
    static int grid = 0;
    if (grid == 0) {
        if (n_in != 15 || in_sizes[0] != MTOK * DM || out_size != MTOK * DM || ws_size < WS_END) { fprintf(stderr, "kernel_launch: unexpected shapes (n_in %d, in0 %d, out %d, ws %zu < %zu)\n", n_in, n_in > 0 ? in_sizes[0] : -1, out_size, ws_size, (size_t)WS_END); grid = -1; return; }
        int dev = 0, cus = 0, per_cu = 0;
        if (hipGetDevice(&dev) != hipSuccess || hipDeviceGetAttribute(&cus, hipDeviceAttributeMultiprocessorCount, dev) != hipSuccess) { grid = -1; return; }
        if (hipFuncSetAttribute((const void*)mk_fwd, hipFuncAttributeMaxDynamicSharedMemorySize, LDS_BYTES) != hipSuccess) { fprintf(stderr, "kernel_launch: hipFuncSetAttribute failed\n"); grid = -1; return; }
        if (hipOccupancyMaxActiveBlocksPerMultiprocessor(&per_cu, (const void*)mk_fwd, NWAVES * 64, LDS_BYTES) != hipSuccess || per_cu < 1) { fprintf(stderr, "kernel_launch: occupancy query says %d blocks per CU\n", per_cu); (void)hipGetLastError(); grid = -1; return; }
        grid = cus;
    }
    if (grid < 0) return;
    if (hipMemsetAsync((char*)d_ws + WS_CTL, 0, CTL_ZERO_BYTES, stream) != hipSuccess) return;
    Args a{};
    for (int i = 0; i < 15; ++i) a.in[i] = (const float*)d_in[i];
    a.out = (float*)d_out; a.ws = (unsigned char*)d_ws;
#if MK_PER_PHASE
    for (int p = 0; p < NPHASE; ++p) { a.ph_lo = p; a.ph_hi = p + 1; hipLaunchKernelGGL(mk_fwd, dim3(grid), dim3(NWAVES * 64), LDS_BYTES, stream, a); }
#else
    a.ph_lo = 0; a.ph_hi = NPHASE;
    hipLaunchKernelGGL(mk_fwd, dim3(grid), dim3(NWAVES * 64), LDS_BYTES, stream, a);
#endif
}
```

```cpp
#include <hip/hip_runtime.h>
#include <cstdio>
#include <cstdint>
namespace pg8 {
#define PG8_LAS __attribute__((address_space(3)))
typedef unsigned short bf16_t;
typedef short bf16x8 __attribute__((ext_vector_type(8)));
typedef float f32x4 __attribute__((ext_vector_type(4)));
typedef unsigned u32x4 __attribute__((ext_vector_type(4)));
constexpr int BM = 256, BK = 64, HALF = 128, HTB = HALF * BK * 2  , STAGE_BYTES = 8 * HTB, NXCD = 8, WGM = 8;

__host__ __device__ __forceinline__ int lds_byte(int r, int c) { const int st = (r >> 4) * 2 + (c >> 5), rr = r & 15, cc = c & 31, ob = rr * 64 + cc * 2; return st * 1024 + (ob ^ (((ob >> 9) & 1) << 5)); }
__host__ __device__ __forceinline__ void stage_rc(int b, int& R, int& C) { const int st = b / 1024, sb = b % 1024, swz = sb ^ (((sb >> 9) & 1) << 5); R = (st >> 1) * 16 + swz / 64; C = (st & 1) * 32 + (swz % 64) / 2; }
__host__ __device__ __forceinline__ int perm32(int rho) { const int n = rho >> 4, i = rho & 15; return 8 * (i >> 2) + 4 * n + (i & 3); }

struct Unit { int pm, pn; };
struct Gemm { const bf16_t* A; const bf16_t* Bt; int M, N, K, lda, ldb; };

struct StaticOrder {
    int nM, nN, nwg, G, c;
    __host__ __device__ void init(int M, int N, int G_, int c_) { nM = M / BM; nN = N / BM; nwg = nM * nN; G = G_; c = c_; }
    __host__ __device__ bool next(int i, Unit& u) const {
        const long L = (long)i * G + c; if (L >= nwg) return false;
        int wgid = (int)L; { const int q = nwg / NXCD, r = nwg % NXCD, xcd = wgid % NXCD, off = wgid / NXCD; wgid = (xcd < r ? xcd * (q + 1) : r * (q + 1) + (xcd - r) * q) + off; }
        const int nig = WGM * nN, gid = wgid / nig, fm = gid * WGM, gsz = (nM - fm) < WGM ? (nM - fm) : WGM;
        u.pm = fm + ((wgid % nig) % gsz); u.pn = (wgid % nig) / gsz; return true;
    }
    __device__ __forceinline__ void a_ready(const Unit&) const {}
    __device__ __forceinline__ void done(const Unit&) const {}
};
typedef float f32x2c_t __attribute__((ext_vector_type(2))); typedef __bf16 bf16x2c_t __attribute__((ext_vector_type(2)));
__device__ __forceinline__ unsigned cvt_pk_bf16(float lo, float hi) { f32x2c_t v = {lo, hi}; bf16x2c_t b = __builtin_convertvector(v, bf16x2c_t); return __builtin_bit_cast(unsigned, b); }
typedef float f32x2 __attribute__((ext_vector_type(2)));
__device__ __forceinline__ f32x2 gelu_pk(f32x2 v) {
    const f32x2 av = __builtin_elementwise_abs(v), d = av * 0.2316418882f + 1.0f;
    f32x2 t; t.x = __builtin_amdgcn_rcpf(d.x); t.y = __builtin_amdgcn_rcpf(d.y);
    f32x2 q = t * 0.5307027145f + (-0.7265760135f); q = q * t + 0.7107068705f; q = q * t + (-0.142248368f); q = q * t + 0.127414796f; q = q * t;
    const f32x2 s = (v * v) * (-0.72134752044f);
    f32x2 e; e.x = __builtin_amdgcn_exp2f(s.x); e.y = __builtin_amdgcn_exp2f(s.y);
    const f32x2 m = v * (q * e), r = v - m;
    f32x2 o; o.x = v.x < 0.f ? m.x : r.x; o.y = v.y < 0.f ? m.y : r.y; return o;
}
typedef unsigned u32x2e __attribute__((ext_vector_type(2)));
__device__ __forceinline__ float bf_lo(unsigned w) { return __uint_as_float(w << 16); }
__device__ __forceinline__ float bf_hi(unsigned w) { return __uint_as_float(w & 0xffff0000u); }
__device__ __forceinline__ float sigmoidf_fast(float g) { return __builtin_amdgcn_rcpf(1.0f + __builtin_amdgcn_exp2f(-1.4426950408889634f * g)); }
__device__ __forceinline__ unsigned ord_key(float f) { const unsigned b = __float_as_uint(f); return b ^ ((unsigned)((int)b >> 31) | 0x80000000u); }
__device__ __forceinline__ float unord_key(unsigned k) { return __uint_as_float((k & 0x80000000u) ? (k ^ 0x80000000u) : ~k); }

struct EpiStoreBf16 {
    static constexpr bool PERM = true, AFTER_DRAIN = false;
    bf16_t* O; int ldc;
    __device__ __forceinline__ void operator()(const f32x4 (&acc)[2][2][4][2], const Unit& u, int wr, int wc, int fr, int fq) const {
        const int row0 = u.pm * BM + wr * 64 + fr, col0 = u.pn * BM + wc * 32 + 8 * fq;
#pragma unroll
        for (int ai = 0; ai < 2; ++ai)
#pragma unroll
            for (int m = 0; m < 4; ++m) { bf16_t* rowp = O + (size_t)(row0 + ai * HALF + m * 16) * ldc + col0;
#pragma unroll
                for (int bj = 0; bj < 2; ++bj) { const f32x4 v0 = acc[ai][bj][m][0], v1 = acc[ai][bj][m][1];
                    u32x4 w; w.x = cvt_pk_bf16(v0[0], v0[1]); w.y = cvt_pk_bf16(v0[2], v0[3]); w.z = cvt_pk_bf16(v1[0], v1[1]); w.w = cvt_pk_bf16(v1[2], v1[3]);
                    *(u32x4*)(rowp + bj * HALF) = w; } }
    }
};
template <bool ADD> struct EpiGate {
    static constexpr bool PERM = true, AFTER_DRAIN = false;
    bf16_t* O; int ldc; const bf16_t* G; int ldg;
    __device__ __forceinline__ void operator()(const f32x4 (&acc)[2][2][4][2], const Unit& u, int wr, int wc, int fr, int fq) const {
        const int row0 = u.pm * BM + wr * 64 + fr, col0 = u.pn * BM + wc * 32 + 8 * fq;
#pragma unroll
        for (int ai = 0; ai < 2; ++ai)
#pragma unroll
            for (int m = 0; m < 4; ++m) { const size_t row = (size_t)(row0 + ai * HALF + m * 16);
#pragma unroll
                for (int bj = 0; bj < 2; ++bj) { const int col = col0 + bj * HALF;
                    const u32x4 gr = *(const u32x4*)(G + row * ldg + col);
                    f32x4 v0 = acc[ai][bj][m][0], v1 = acc[ai][bj][m][1];
                    v0[0] *= sigmoidf_fast(bf_lo(gr.x)); v0[1] *= sigmoidf_fast(bf_hi(gr.x)); v0[2] *= sigmoidf_fast(bf_lo(gr.y)); v0[3] *= sigmoidf_fast(bf_hi(gr.y));
                    v1[0] *= sigmoidf_fast(bf_lo(gr.z)); v1[1] *= sigmoidf_fast(bf_hi(gr.z)); v1[2] *= sigmoidf_fast(bf_lo(gr.w)); v1[3] *= sigmoidf_fast(bf_hi(gr.w));
                    bf16_t* op = O + row * ldc + col;
                    if (ADD) { const u32x4 pr = *(const u32x4*)op;
                        v0[0] += bf_lo(pr.x); v0[1] += bf_hi(pr.x); v0[2] += bf_lo(pr.y); v0[3] += bf_hi(pr.y);
                        v1[0] += bf_lo(pr.z); v1[1] += bf_hi(pr.z); v1[2] += bf_lo(pr.w); v1[3] += bf_hi(pr.w); }
                    u32x4 w; w.x = cvt_pk_bf16(v0[0], v0[1]); w.y = cvt_pk_bf16(v0[2], v0[3]); w.z = cvt_pk_bf16(v1[0], v1[1]); w.w = cvt_pk_bf16(v1[2], v1[3]);
                    *(u32x4*)op = w; } }
    }
};
struct EpiResF32 {
    static constexpr bool PERM = false, AFTER_DRAIN = false;
    const float* base; float* out; int ldc;
    __device__ __forceinline__ void operator()(const f32x4 (&acc)[2][2][4][2], const Unit& u, int wr, int wc, int fr, int fq) const {
        const int col0 = u.pn * BM + wc * 32 + 4 * fq;
#pragma unroll
        for (int ai = 0; ai < 2; ++ai)
#pragma unroll
            for (int m = 0; m < 4; ++m) { const size_t off = (size_t)(u.pm * BM + ai * HALF + wr * 64 + m * 16 + fr) * ldc + col0;
#pragma unroll
                for (int bj = 0; bj < 2; ++bj)
#pragma unroll
                    for (int n = 0; n < 2; ++n) { const f32x4 bs = *(const f32x4*)(base + off + bj * HALF + n * 16); *(f32x4*)(out + off + bj * HALF + n * 16) = bs + acc[ai][bj][m][n]; } }
    }
};
struct EpiResHG {
    static constexpr bool PERM = false, AFTER_DRAIN = false;
    const float* base; float* out; bf16_t* hg; const float* gain; float* ssp; int ldc;
    __device__ __forceinline__ void operator()(const f32x4 (&acc)[2][2][4][2], const Unit& u, int wr, int wc, int fr, int fq) const {
        const int col0 = u.pn * BM + wc * 32 + 4 * fq;
        f32x4 gv[2][2];
#pragma unroll
        for (int bj = 0; bj < 2; ++bj)
#pragma unroll
            for (int n = 0; n < 2; ++n) gv[bj][n] = *(const f32x4*)(gain + col0 + bj * HALF + n * 16);
#pragma unroll
        for (int ai = 0; ai < 2; ++ai)
#pragma unroll
            for (int m = 0; m < 4; ++m) { const int row = u.pm * BM + ai * HALF + wr * 64 + m * 16 + fr; const size_t off = (size_t)row * ldc + col0; float ss = 0.f;
#pragma unroll
                for (int bj = 0; bj < 2; ++bj)
#pragma unroll
                    for (int n = 0; n < 2; ++n) { const f32x4 h = *(const f32x4*)(base + off + bj * HALF + n * 16) + acc[ai][bj][m][n]; *(f32x4*)(out + off + bj * HALF + n * 16) = h;
                        ss += (h[0] * h[0] + h[1] * h[1]) + (h[2] * h[2] + h[3] * h[3]);
                        const f32x4 hgv = h * gv[bj][n]; u32x2e w; w.x = cvt_pk_bf16(hgv[0], hgv[1]); w.y = cvt_pk_bf16(hgv[2], hgv[3]); *(u32x2e*)(hg + off + bj * HALF + n * 16) = w; }
                ss += __shfl_xor(ss, 16); ss += __shfl_xor(ss, 32);
                if (fq == 0) ssp[(size_t)row * 16 + u.pn * 4 + wc] = ss; }
    }
};
struct EpiKeys {
    static constexpr bool PERM = false, AFTER_DRAIN = false;
    unsigned* O; int ldc;
    __device__ __forceinline__ void operator()(const f32x4 (&acc)[2][2][4][2], const Unit& u, int wr, int wc, int fr, int fq) const {
        const int col0 = u.pn * BM + wc * 32 + 4 * fq;
#pragma unroll
        for (int ai = 0; ai < 2; ++ai)
#pragma unroll
            for (int m = 0; m < 4; ++m) { const size_t off = (size_t)(u.pm * BM + ai * HALF + wr * 64 + m * 16 + fr) * ldc + col0;
#pragma unroll
                for (int bj = 0; bj < 2; ++bj)
#pragma unroll
                    for (int n = 0; n < 2; ++n) { const int nn = (col0 + bj * HALF + n * 16) & 127; const f32x4 a = acc[ai][bj][m][n]; u32x4 w;
                        w.x = (ord_key(a[0]) & ~127u) | (unsigned)(127 - nn); w.y = (ord_key(a[1]) & ~127u) | (unsigned)(126 - nn);
                        w.z = (ord_key(a[2]) & ~127u) | (unsigned)(125 - nn); w.w = (ord_key(a[3]) & ~127u) | (unsigned)(124 - nn);
                        *(u32x4*)(O + off + bj * HALF + n * 16) = w; } }
    }
};

template <class Epi, class Sched, bool ALIGN_EPI = false, bool SP2 = false>
__device__ __forceinline__ void gemm_phase(PG8_LAS unsigned char* lds, const Gemm g, const Sched& S, const Epi& E) {
    int tid_ = threadIdx.x; asm volatile("" : "+v"(tid_));
    const int tid = tid_, wid = __builtin_amdgcn_readfirstlane(tid >> 6), lane = tid & 63, wr = wid >> 2, wc = wid & 3, fr = lane & 15, fq = lane >> 4;
    const int K = g.K, nt = K / BK;
    unsigned voffA[2], voffB[2];
#pragma unroll
    for (int i = 0; i < 2; ++i) { int R, C; stage_rc(tid * 16 + i * 8192, R, C); const int Rb = Epi::PERM ? ((R & ~31) + perm32(R & 31)) : R;
        voffA[i] = (unsigned)(R * g.lda + C) * 2u; voffB[i] = (unsigned)(Rb * g.ldb + C) * 2u; }
    const size_t kstep = (size_t)(BK * 2);
    const size_t hstepA = (size_t)HALF * g.lda * 2, hstepB = (size_t)HALF * g.ldb * 2;
    const size_t tstepA = 2 * hstepA, tstepB = 2 * hstepB;
    const unsigned ldsw = (unsigned)wid * 1024u;
    const int aoff = lds_byte(wr * 64 + fr, fq * 8), boff = lds_byte(wc * 32 + fr, fq * 8);
#define PG8_SA(b, h) (((b) * 2 + (h)) * HTB)
#define PG8_SB(b, h) ((4 + (b) * 2 + (h)) * HTB)
#define PG8_STAGE(bufoff, gbase, voff) do { _Pragma("unroll") for (int _i = 0; _i < 2; ++_i) \
        __builtin_amdgcn_global_load_lds((const unsigned*)((const char*)(gbase) + (voff)[_i]), (PG8_LAS unsigned*)(lds + (bufoff) + ldsw + _i * 8192), 16, 0, 0); } while (0)
#define PG8_LDA(dst, b, h) do { _Pragma("unroll") for (int m = 0; m < 4; ++m) _Pragma("unroll") for (int k = 0; k < 2; ++k) dst[m][k] = *(const PG8_LAS bf16x8*)(lds + PG8_SA(b, h) + aoff + m * 2048 + k * 1024); } while (0)
#define PG8_LDB(dst, b, h) do { _Pragma("unroll") for (int n = 0; n < 2; ++n) _Pragma("unroll") for (int k = 0; k < 2; ++k) dst[n][k] = *(const PG8_LAS bf16x8*)(lds + PG8_SB(b, h) + boff + n * 2048 + k * 1024); } while (0)
#define PG8_MMA(ai, bj, At, Bt) do { __builtin_amdgcn_s_setprio(1); _Pragma("unroll") for (int m = 0; m < 4; ++m) _Pragma("unroll") for (int n = 0; n < 2; ++n) _Pragma("unroll") for (int k = 0; k < 2; ++k) \
        acc[ai][bj][m][n] = __builtin_amdgcn_mfma_f32_16x16x32_bf16(Bt[n][k], At[m][k], acc[ai][bj][m][n], 0, 0, 0); __builtin_amdgcn_s_setprio(0); } while (0)
#define PG8_WAIT_V(n) asm volatile("s_waitcnt vmcnt(" #n ")" ::: "memory")
#define PG8_WAIT_L(n) asm volatile("s_waitcnt lgkmcnt(" #n ")" ::: "memory")
#define PG8_BAR __builtin_amdgcn_s_barrier()
#define PG8_SCHED __builtin_amdgcn_sched_barrier(0)
    Unit cur, nxt; int ui = 0;
    if (!S.next(0, cur)) return;
    f32x4 acc[2][2][4][2];
#pragma unroll
    for (int a = 0; a < 2; ++a)
#pragma unroll
        for (int b = 0; b < 2; ++b)
#pragma unroll
            for (int m = 0; m < 4; ++m)
#pragma unroll
                for (int n = 0; n < 2; ++n) acc[a][b][m][n] = (f32x4){0.f, 0.f, 0.f, 0.f};
    bf16x8 At[4][2], B0[2][2], B1[2][2];
    const char* cA = (const char*)g.A + (size_t)cur.pm * tstepA; const char* cB = (const char*)g.Bt + (size_t)cur.pn * tstepB;
    S.a_ready(cur);
    if constexpr (SP2) {
        PG8_STAGE(PG8_SB(0, 0), cB, voffB); PG8_STAGE(PG8_SB(0, 1), cB + hstepB, voffB); PG8_STAGE(PG8_SA(0, 0), cA, voffA); PG8_STAGE(PG8_SA(0, 1), cA + hstepA, voffA);
        if (wr == 1) PG8_BAR;
        PG8_WAIT_V(2); PG8_BAR;
        PG8_STAGE(PG8_SB(1, 0), cB + kstep, voffB); PG8_STAGE(PG8_SA(1, 0), cA + kstep, voffA); PG8_STAGE(PG8_SB(1, 1), cB + hstepB + kstep, voffB);
        PG8_WAIT_V(6); PG8_BAR;
    } else {
        PG8_STAGE(PG8_SB(0, 0), cB, voffB); PG8_STAGE(PG8_SA(0, 0), cA, voffA); PG8_STAGE(PG8_SB(0, 1), cB + hstepB, voffB); PG8_STAGE(PG8_SA(0, 1), cA + hstepA, voffA);
        if (wr == 1) PG8_BAR;
        PG8_WAIT_V(4); PG8_BAR;
        PG8_STAGE(PG8_SB(1, 0), cB + kstep, voffB); PG8_STAGE(PG8_SA(1, 0), cA + kstep, voffA); PG8_STAGE(PG8_SB(1, 1), cB + hstepB + kstep, voffB);
        PG8_WAIT_V(6); PG8_BAR;
    }
    for (;;) {
        const bool has_next = S.next(ui + 1, nxt);
        const char* nA = has_next ? (const char*)g.A + (size_t)nxt.pm * tstepA : cA; const char* nB = has_next ? (const char*)g.Bt + (size_t)nxt.pn * tstepB : cB;
        for (int t = 0; t < nt; t += 2) {
            const bool last = (t == nt - 2);
            const char* a1 = cA + (size_t)(t + 1) * kstep;
            const char* a2 = last ? nA : cA + (size_t)(t + 2) * kstep; const char* b2 = last ? nB : cB + (size_t)(t + 2) * kstep;
            const char* a3 = a2 + kstep; const char* b3 = b2 + kstep;
            if (last && has_next) S.a_ready(nxt);
            if constexpr (SP2) {
            PG8_LDB(B0, 0, 0); PG8_LDB(B1, 0, 1); PG8_SCHED; PG8_LDA(At, 0, 0); PG8_STAGE(PG8_SA(1, 1), a1 + hstepA, voffA);
            PG8_WAIT_V(8); PG8_WAIT_L(0); PG8_BAR; PG8_MMA(0, 0, At, B0); PG8_MMA(0, 1, At, B1); PG8_BAR; PG8_SCHED;
            PG8_LDA(At, 0, 1); PG8_STAGE(PG8_SB(0, 0), b2, voffB); PG8_STAGE(PG8_SB(0, 1), b2 + hstepB, voffB); PG8_STAGE(PG8_SA(0, 0), a2, voffA);
            PG8_WAIT_V(8); PG8_WAIT_L(0); PG8_BAR; PG8_MMA(1, 0, At, B0); PG8_MMA(1, 1, At, B1); PG8_BAR; PG8_SCHED;
            PG8_LDB(B0, 1, 0); PG8_LDB(B1, 1, 1); PG8_SCHED; PG8_LDA(At, 1, 0); PG8_STAGE(PG8_SA(0, 1), a2 + hstepA, voffA);
            PG8_WAIT_V(8); PG8_WAIT_L(0); PG8_BAR; PG8_MMA(0, 0, At, B0); PG8_MMA(0, 1, At, B1); PG8_BAR; PG8_SCHED;
            PG8_LDA(At, 1, 1); PG8_STAGE(PG8_SB(1, 0), b3, voffB); PG8_STAGE(PG8_SB(1, 1), b3 + hstepB, voffB); PG8_STAGE(PG8_SA(1, 0), a3, voffA);
            PG8_WAIT_V(8); PG8_WAIT_L(0); PG8_BAR; PG8_MMA(1, 0, At, B0); PG8_MMA(1, 1, At, B1); PG8_BAR; PG8_SCHED;
            } else {
            PG8_LDB(B0, 0, 0); PG8_SCHED; PG8_LDA(At, 0, 0); PG8_STAGE(PG8_SA(1, 1), a1 + hstepA, voffA);
            PG8_WAIT_L(8); PG8_BAR; PG8_WAIT_L(0); PG8_MMA(0, 0, At, B0); PG8_BAR; PG8_SCHED;
            PG8_LDB(B1, 0, 1); PG8_STAGE(PG8_SB(0, 0), b2, voffB);
            PG8_BAR; PG8_WAIT_L(0); PG8_MMA(0, 1, At, B1); PG8_BAR;
            PG8_LDA(At, 0, 1); PG8_STAGE(PG8_SA(0, 0), a2, voffA);
            PG8_BAR; PG8_WAIT_L(0); PG8_MMA(1, 0, At, B0); PG8_BAR; PG8_SCHED;
            PG8_STAGE(PG8_SB(0, 1), b2 + hstepB, voffB);
            PG8_WAIT_V(6); PG8_BAR; PG8_MMA(1, 1, At, B1); PG8_BAR;
            PG8_LDB(B0, 1, 0); PG8_SCHED; PG8_LDA(At, 1, 0); PG8_STAGE(PG8_SA(0, 1), a2 + hstepA, voffA);
            PG8_WAIT_L(8); PG8_BAR; PG8_WAIT_L(0); PG8_MMA(0, 0, At, B0); PG8_BAR; PG8_SCHED;
            PG8_LDB(B1, 1, 1); PG8_STAGE(PG8_SB(1, 0), b3, voffB);
            PG8_BAR; PG8_WAIT_L(0); PG8_MMA(0, 1, At, B1); PG8_BAR;
            PG8_LDA(At, 1, 1); PG8_STAGE(PG8_SA(1, 0), a3, voffA);
            PG8_BAR; PG8_WAIT_L(0); PG8_MMA(1, 0, At, B0); PG8_BAR; PG8_SCHED;
            PG8_STAGE(PG8_SB(1, 1), b3 + hstepB, voffB);
            PG8_WAIT_V(6); PG8_BAR; PG8_MMA(1, 1, At, B1); PG8_BAR;
            }
        }
        if constexpr (ALIGN_EPI) { if (wr == 0) PG8_BAR; }
        if constexpr (!Epi::AFTER_DRAIN) { E(acc, cur, wr, wc, fr, fq); S.done(cur); }
        if (!has_next) break;
#pragma unroll
        for (int a = 0; a < 2; ++a)
#pragma unroll
            for (int b = 0; b < 2; ++b)
#pragma unroll
                for (int m = 0; m < 4; ++m)
#pragma unroll
                    for (int n = 0; n < 2; ++n) acc[a][b][m][n] = (f32x4){0.f, 0.f, 0.f, 0.f};
        cur = nxt; cA = nA; cB = nB; ++ui;
        if constexpr (ALIGN_EPI) { if (wr == 1) PG8_BAR; }
    }
    PG8_WAIT_V(0);
    if constexpr (!ALIGN_EPI) { if (wr == 0) PG8_BAR; }
    PG8_BAR;
    if constexpr (Epi::AFTER_DRAIN) { E.fused(acc, cur, wr, wc, fr, fq, lds, wid, lane); S.done(cur); }
#undef PG8_SA
#undef PG8_SB
#undef PG8_STAGE
#undef PG8_LDA
#undef PG8_LDB
#undef PG8_MMA
#undef PG8_WAIT_V
#undef PG8_WAIT_L
#undef PG8_BAR
#undef PG8_SCHED
}
}

constexpr int NWAVES = 8;
#ifndef REPEAT_MASK
#define REPEAT_MASK 0
#endif
#ifndef PROBE_SEL2
#define PROBE_SEL2 1
#endif
#ifndef PROBE_NOSEL
#define PROBE_NOSEL 0
#endif
#ifndef MK_PER_PHASE
#define MK_PER_PHASE 0
#endif
constexpr int NPHASE = 14;

constexpr int BATCH = 16, SEQ = 4096, DM = 1024, MTOK = BATCH * SEQ;
constexpr int LDP = 4864;
constexpr int Q_OFF = 0, K_OFF = 512, V_OFF = 1024, QI_OFF = 1536, P_OFF = 2048, GA_OFF = 2560, GP_OFF = 3584, KI_OFF = 4608, WI_OFF = 4672;
constexpr int IN_WIDTH = 4680;
constexpr float EPS = 1e-6f;
constexpr float C2 = 0.125f * 1.4426950408889634f;
constexpr float WI_SCALE = 0.35355339059327373f * 0.125f;

constexpr size_t MiB = 1u << 20;
constexpr size_t WS_CTL = 0, CTL_ZERO_BYTES = 1 * MiB;
constexpr size_t WS_ROPE = 1 * MiB;
constexpr size_t WS_WIN = 2 * MiB;
constexpr size_t WS_WA = 12 * MiB;
constexpr size_t WS_WPP = 13 * MiB;
constexpr size_t WS_WO = 14 * MiB;
constexpr size_t WS_W2 = 16 * MiB;
constexpr size_t WS_SKB = 19 * MiB;
constexpr size_t WS_U16 = 20 * MiB, WS_V16 = 52 * MiB;
constexpr size_t WS_MASK = 84 * MiB;
constexpr size_t WS_POOLED = 116 * MiB;
constexpr size_t WS_ACT = 180 * MiB;
constexpr size_t WS_PROJ = 308 * MiB;
constexpr size_t WS_AO = 916 * MiB;
constexpr size_t WS_REXP = 980 * MiB, WS_RG = 116 * MiB;
constexpr size_t WS_HG = 308 * MiB;
constexpr size_t WS_SUBK = 436 * MiB;
constexpr size_t WS_SSP = 948 * MiB;
constexpr size_t WS_END = 1024 * MiB;
constexpr int CW_TMO = 0, CW_BAR = 4096, CW_AMAX = 12288;

constexpr int RING_BYTES = 131072;
constexpr int LDSCTL_OFF = RING_BYTES, MISC_OFF = LDSCTL_OFF + 320;
constexpr int LDS_BYTES = 147456;

#define GAS __attribute__((address_space(1)))
#define LAS __attribute__((address_space(3)))
typedef unsigned short bf16;
typedef unsigned v4u __attribute__((ext_vector_type(4)));
typedef unsigned v2u __attribute__((ext_vector_type(2)));
typedef float f32x4 __attribute__((ext_vector_type(4)));
typedef float f32x16 __attribute__((ext_vector_type(16)));
typedef short bf16x8 __attribute__((ext_vector_type(8)));
typedef short s16x4 __attribute__((ext_vector_type(4)));
typedef GAS unsigned gu32;
#define RLX_AGENT __ATOMIC_RELAXED, __HIP_MEMORY_SCOPE_AGENT
#define LDS_WAIT() asm volatile("s_waitcnt lgkmcnt(0)" ::: "memory")
#define VM_WAIT() asm volatile("s_waitcnt vmcnt(0)" ::: "memory")
__device__ __forceinline__ unsigned f2bf(float f) { unsigned u = __builtin_bit_cast(unsigned, f); return (u + 0x7fffu + ((u >> 16) & 1u)) >> 16; }
typedef float f32x2k_t __attribute__((ext_vector_type(2))); typedef __bf16 bf16x2k_t __attribute__((ext_vector_type(2)));
__device__ __forceinline__ unsigned pk2(float lo, float hi) { f32x2k_t v = {lo, hi}; bf16x2k_t b = __builtin_convertvector(v, bf16x2k_t); return __builtin_bit_cast(unsigned, b); }
__device__ __forceinline__ float bflo(unsigned w) { return __uint_as_float(w << 16); }
__device__ __forceinline__ float bfhi(unsigned w) { return __uint_as_float(w & 0xffff0000u); }
__device__ __forceinline__ unsigned ordk(float f) { const unsigned b = __float_as_uint(f); return b ^ ((unsigned)((int)b >> 31) | 0x80000000u); }
__device__ __forceinline__ float unordk(unsigned k) { return __uint_as_float((k & 0x80000000u) ? (k ^ 0x80000000u) : ~k); }
__device__ __forceinline__ int crow(int r, int hi) { return (r & 3) + 8 * (r >> 2) + 4 * hi; }
typedef __bf16 bf16x2v_t __attribute__((ext_vector_type(2)));
__device__ __forceinline__ float dot2bf(unsigned a, unsigned b, float acc) { return __builtin_amdgcn_fdot2_f32_bf16(__builtin_bit_cast(bf16x2v_t, a), __builtin_bit_cast(bf16x2v_t, b), acc, false); }

#define XB_TMO      128
#define XB_XCNT(j)  (256  + 64 * (j))
#define XB_XSUB(j)  (1280 + 64 * (j))
#define XB_XGEN(j)  (2304 + 64 * (j))
#define XB_TOP      3328
#define XB_TOPGEN   3392
#define XCD_BAR_WORDS 3456
#define XB_SPIN_CAP (1u << 18)

__device__ __forceinline__ unsigned xb_ld(unsigned* p)              { return __hip_atomic_load(p, __ATOMIC_RELAXED, __HIP_MEMORY_SCOPE_AGENT); }
__device__ __forceinline__ unsigned xb_add(unsigned* p, unsigned v) { return __hip_atomic_fetch_add(p, v, __ATOMIC_RELAXED, __HIP_MEMORY_SCOPE_AGENT); }
__device__ __forceinline__ unsigned xb_xcc_id() { return (unsigned)__builtin_amdgcn_s_getreg((3 << 11) | 20) & 0xFu; }
#define XB_SPIN(cond, bar) do { unsigned _sp = 0; while (cond) { __builtin_amdgcn_s_sleep(1); \
    if ((++_sp & 255u) == 0u) { if (xb_ld(&(bar)[XB_TMO])) break; if (_sp > XB_SPIN_CAP) { atomicAdd(&(bar)[XB_TMO], 1u); break; } } } } while (0)

struct XcdBarrier {
    unsigned* bar; unsigned x;
    volatile LAS unsigned* st;
};

__device__ __forceinline__ XcdBarrier xcd_barrier_post(unsigned* bar, volatile LAS unsigned* st) {
    XcdBarrier b; b.bar = bar; b.x = xb_xcc_id(); b.st = st;
    if (threadIdx.x == 0) (void)xb_add(&bar[XB_XCNT(b.x)], 1u);
    return b;
}
__device__ __forceinline__ void xcd_barrier_complete(unsigned* bar, unsigned x, unsigned& nloc, unsigned& nx) {
    const unsigned G = gridDim.x * gridDim.y * gridDim.z;
    unsigned sum, cnt, mine, sp = 0u;
    for (;;) {
        sum = 0u; cnt = 0u; mine = 0u;
#pragma unroll
        for (unsigned j = 0; j < 16; ++j) { const unsigned c = xb_ld(&bar[XB_XCNT(j)]); sum += c; cnt += (c > 0u) ? 1u : 0u; mine = (j == x) ? c : mine; }
        if (sum == G) break;
        __builtin_amdgcn_s_sleep(1);
        if ((++sp & 255u) == 0u) { if (xb_ld(&bar[XB_TMO])) break; if (sp > XB_SPIN_CAP) { atomicAdd(&bar[XB_TMO], 1u); break; } }
    }
    nloc = mine > 0u ? mine : 1u; nx = cnt > 0u ? cnt : 1u;
}

__device__ __forceinline__ void xcd_barrier(const XcdBarrier& b) {
    asm volatile("s_waitcnt vmcnt(0)" ::: "memory");
    __syncthreads();
    if (threadIdx.x == 0) {
        unsigned* bar = b.bar;
        __builtin_amdgcn_s_waitcnt(0);
        unsigned nloc = b.st[0], nx = b.st[1];
        if (nloc == 0u) { xcd_barrier_complete(bar, b.x, nloc, nx); b.st[0] = nloc; b.st[1] = nx; }
        const unsigned old = xb_add(&bar[XB_XSUB(b.x)], 1u);
        const unsigned gen = old / nloc;
        if (old + 1u == (gen + 1u) * nloc) {
            __builtin_amdgcn_fence(__ATOMIC_RELEASE, "agent");
            asm volatile("s_waitcnt vmcnt(0)" ::: "memory");
            const unsigned og = xb_add(&bar[XB_TOP], 1u);
            const unsigned tg = og / nx;
            if (og + 1u == (tg + 1u) * nx) xb_add(&bar[XB_TOPGEN], 1u);
            else XB_SPIN(xb_ld(&bar[XB_TOPGEN]) == tg, bar);
            __builtin_amdgcn_fence(__ATOMIC_ACQUIRE, "agent");
            xb_add(&bar[XB_XGEN(b.x)], 1u);
            asm volatile("s_waitcnt vmcnt(0)" ::: "memory");
        } else {
            XB_SPIN(xb_ld(&bar[XB_XGEN(b.x)]) == gen, bar);
            __builtin_amdgcn_fence(__ATOMIC_ACQUIRE, "agent");
            asm volatile("s_waitcnt vmcnt(0)" ::: "memory");
        }
    }
    __syncthreads();
}


struct Frame {
    LAS unsigned char* lds;
    volatile LAS unsigned* MISC;
    gu32* ctl;
    unsigned char* ws;
    int tid, lane, wave, vcu, G;
};
struct Args { const float* in[15]; float* out; unsigned char* ws; int ph_lo, ph_hi; };

__device__ __forceinline__ float wave_sum(float v) {
#pragma unroll
    for (int o = 1; o < 64; o <<= 1) v += __shfl_xor(v, o);
    return v;
}

template <class ColMap>
__device__ __forceinline__ void p0_transpose_item(const float* W, int K, int N, bf16* WT, int nblk, LAS float* scr, int item, int lane, ColMap cm) {
    const int kb = item / nblk, nb = item % nblk, k0 = 64 * kb, n0 = 32 * nb;
    const int src = cm(n0 + (lane & 31));
#pragma unroll 8
    for (int i = 0; i < 32; ++i) { const int kk = 2 * i + (lane >> 5); scr[kk * 33 + (lane & 31)] = (src >= 0) ? W[(size_t)(k0 + kk) * N + src] : 0.f; }
    LDS_WAIT(); asm volatile("" ::: "memory");
    const int c = lane & 7;
#pragma unroll
    for (int j = 0; j < 4; ++j) { const int n = (lane >> 3) + 8 * j; const LAS float* s = scr + (8 * c) * 33 + n;
        v4u o; o.x = pk2(s[0 * 33], s[1 * 33]); o.y = pk2(s[2 * 33], s[3 * 33]); o.z = pk2(s[4 * 33], s[5 * 33]); o.w = pk2(s[6 * 33], s[7 * 33]);
        *(GAS v4u*)(WT + (size_t)(n0 + n) * K + k0 + 8 * c) = o; }
    LDS_WAIT(); asm volatile("" ::: "memory");
}
struct MapIdent { __device__ __forceinline__ int operator()(int n) const { return n; } };
struct MapWin { __device__ __forceinline__ int operator()(int n) const {
    if (n < 2048) return n;
    if (n < 2560) return 2120 + (n - 2048);
    if (n < 4608) return 2632 + (n - 2560);
    if (n < 4672) return 2048 + (n - 4608);
    if (n < 4680) return 2112 + (n - 4672);
    return -1; } };

__device__ __forceinline__ void rms_row_to_bf16(const float* xrow, const float* g, bf16* orow, int lane) {
    const GAS f32x4* xr = (const GAS f32x4*)xrow + lane; const GAS f32x4* gr = (const GAS f32x4*)g + lane;
    f32x4 v[4]; float s = 0.f;
#pragma unroll
    for (int j = 0; j < 4; ++j) { v[j] = xr[64 * j]; s += (v[j].x * v[j].x + v[j].y * v[j].y) + (v[j].z * v[j].z + v[j].w * v[j].w); }
    const float rs = 1.0f / sqrtf(wave_sum(s) * (1.f / 1024.f) + EPS);
    GAS unsigned long long* o8 = (GAS unsigned long long*)orow + lane;
#pragma unroll
    for (int j = 0; j < 4; ++j) { const f32x4 gg = gr[64 * j];
        o8[64 * j] = (unsigned long long)pk2(v[j].x * rs * gg.x, v[j].y * rs * gg.y) | ((unsigned long long)pk2(v[j].z * rs * gg.z, v[j].w * rs * gg.w) << 32); }
}

__device__ __forceinline__ void p0_prologue(Frame& F, const Args& AR) {
    LAS float* scr = (LAS float*)(F.lds + F.wave * 16384);
    const int gw = F.vcu * NWAVES + F.wave, NGW = F.G * NWAVES, lane = F.lane;
    constexpr int I_WIN = 16 * 152, I_WA = 8 * 32, I_WO = 16 * 32;
    for (int it = gw; it < I_WIN + I_WA + I_WO; it += NGW) {
        int r = it;
        if (r < I_WIN) { p0_transpose_item((AR.in[2]), 1024, IN_WIDTH, ((bf16*)(F.ws + WS_WIN)), 152, scr, r, lane, MapWin()); continue; } r -= I_WIN;
        if (r < I_WA) { p0_transpose_item((AR.in[7]), 512, 1024, ((bf16*)(F.ws + WS_WA)), 32, scr, r, lane, MapIdent()); continue; } r -= I_WA;
        p0_transpose_item((AR.in[9]), 1024, 1024, ((bf16*)(F.ws + WS_WO)), 32, scr, r, lane, MapIdent());
    }
    for (int it = gw; it < 16 * 64; it += NGW) {
        const int nb = it & 15, kb = it >> 4, n = nb * 64 + lane, k0 = kb * 8, g = k0 >> 7, c0 = k0 & 127;
        float acc[8];
#pragma unroll
        for (int j = 0; j < 8; ++j) acc[j] = 0.f;
        for (int d = 0; d < 128; ++d) {
            const float wv = (AR.in[8])[(size_t)(g * 128 + d) * 1024 + n] * (AR.in[6])[g * 128 + d];
#pragma unroll
            for (int j = 0; j < 8; ++j) acc[j] += (AR.in[5])[(size_t)(g * 128 + c0 + j) * 128 + d] * wv;
        }
        v4u o; o.x = pk2(acc[0], acc[1]); o.y = pk2(acc[2], acc[3]); o.z = pk2(acc[4], acc[5]); o.w = pk2(acc[6], acc[7]);
        *(GAS v4u*)(((bf16*)(F.ws + WS_WPP)) + (size_t)n * 512 + k0) = o;
    }
    for (int it = gw; it < 16 * 32; it += NGW) p0_transpose_item((AR.in[11]), 1024, 1024, ((bf16*)(F.ws + WS_W2)), 32, scr, it, lane, MapIdent());
    for (int it = gw; it < 256; it += NGW) { const size_t e0 = (size_t)it * 512 + lane * 8;
        const f32x4 a = *(const GAS f32x4*)((AR.in[12]) + e0), b = *(const GAS f32x4*)((AR.in[12]) + e0 + 4);
        v4u o; o.x = pk2(a.x, a.y); o.y = pk2(a.z, a.w); o.z = pk2(b.x, b.y); o.w = pk2(b.z, b.w);
        *(GAS v4u*)(((bf16*)(F.ws + WS_SKB)) + e0) = o; }
    {   float mu = 0.f, mv = 0.f;
        for (int it = gw; it < 2 * 32768; it += NGW) {
            const float* src = (it < 32768) ? (AR.in[13]) : (AR.in[14]); const size_t e0 = (size_t)(it & 32767) * 512 + lane * 8;
            const f32x4 a = *(const GAS f32x4*)(src + e0), b = *(const GAS f32x4*)(src + e0 + 4);
            const float m = fmaxf(fmaxf(fmaxf(fabsf(a.x), fabsf(a.y)), fmaxf(fabsf(a.z), fabsf(a.w))), fmaxf(fmaxf(fabsf(b.x), fabsf(b.y)), fmaxf(fabsf(b.z), fabsf(b.w))));
            if (it < 32768) mu = fmaxf(mu, m); else mv = fmaxf(mv, m);
        }
#pragma unroll
        for (int o = 1; o < 64; o <<= 1) { mu = fmaxf(mu, __shfl_xor(mu, o)); mv = fmaxf(mv, __shfl_xor(mv, o)); }
        if (lane == 0) { __hip_atomic_fetch_max(F.ctl + CW_AMAX, __float_as_uint(mu), RLX_AGENT); __hip_atomic_fetch_max(F.ctl + CW_AMAX + 1, __float_as_uint(mv), RLX_AGENT); }
    }
    for (int it = gw * 64 + lane; it < 4096 * 8; it += NGW * 64) {
        const int pos = it >> 3, i = it & 7;
        const float invf = exp2f(-(float)i * 0.125f * 18.931568569324174f);
        const double ang = (double)((float)pos * invf);
        const double kq = __builtin_rint(ang * 0.6366197723675814);
        const float r = (float)(ang - kq * 1.5707963267948966);
        const int q = (int)((long long)kq & 3);
        const float r2 = r * r;
        const float sn = r + r * r2 * (-1.6666654611e-1f + r2 * (8.3321608736e-3f + r2 * (-1.9515295891e-4f)));
        const float cs = 1.0f - 0.5f * r2 + r2 * r2 * (4.166664568298827e-2f + r2 * (-1.388731625493765e-3f + r2 * 2.443315711809948e-5f));
        const float s = (q == 0) ? sn : (q == 1) ? cs : (q == 2) ? -sn : -cs;
        const float c = (q == 0) ? cs : (q == 1) ? -sn : (q == 2) ? -cs : sn;
        ((float*)(F.ws + WS_ROPE))[pos * 16 + i] = c; ((float*)(F.ws + WS_ROPE))[pos * 16 + 8 + i] = s;
    }
    for (int m = gw; m < MTOK; m += NGW) rms_row_to_bf16((AR.in[0]) + (size_t)m * DM, (AR.in[1]), ((bf16*)(F.ws + WS_ACT)) + (size_t)m * DM, lane);
}

__device__ __forceinline__ void unpack8(const v4u w, float (&v)[8]) { v[0] = bflo(w.x); v[1] = bfhi(w.x); v[2] = bflo(w.y); v[3] = bfhi(w.y); v[4] = bflo(w.z); v[5] = bfhi(w.z); v[6] = bflo(w.w); v[7] = bfhi(w.w); }
__device__ __forceinline__ v4u pack8(const float (&v)[8]) { v4u o; o.x = pk2(v[0], v[1]); o.y = pk2(v[2], v[3]); o.z = pk2(v[4], v[5]); o.w = pk2(v[6], v[7]); return o; }
__device__ __forceinline__ void rope8(float (&v)[8], int sub, const float (&cs)[8], const float (&sn)[8]) {
    float pv[8];
#pragma unroll
    for (int j = 0; j < 8; ++j) pv[j] = __shfl_xor(v[j], 1);
    if (sub == 0) {
#pragma unroll
        for (int j = 0; j < 8; ++j) v[j] = v[j] * cs[j] - pv[j] * sn[j];
    } else if (sub == 1) {
#pragma unroll
        for (int j = 0; j < 8; ++j) v[j] = v[j] * cs[j] + pv[j] * sn[j];
    }
}
__device__ __forceinline__ float fp8_scale(unsigned amax_bits) { const unsigned be = (amax_bits >> 23) & 0xffu; return (be == 0u || be > 250u) ? 1.0f : __uint_as_float((261u - be) << 23); }
__device__ __forceinline__ float fp8_inv_scale(unsigned amax_bits) { const unsigned be = (amax_bits >> 23) & 0xffu; return (be == 0u || be > 250u) ? 1.0f : __uint_as_float((be - 7u) << 23); }
__device__ __forceinline__ void row_to_fp8(const float* src, unsigned char* dst, float sc, int lane) {
    const GAS f32x4* p = (const GAS f32x4*)src + lane * 4; v4u o;
#pragma unroll
    for (int q = 0; q < 4; ++q) { const f32x4 a = p[q]; int w = 0; w = __builtin_amdgcn_cvt_pk_fp8_f32(a.x * sc, a.y * sc, w, false); w = __builtin_amdgcn_cvt_pk_fp8_f32(a.z * sc, a.w * sc, w, true); o[q] = (unsigned)w; }
    *(GAS v4u*)(dst + lane * 16) = o;
}
__device__ __forceinline__ void fixup_token(Frame& F, const Args& AR, int tok) {
    const int lane = F.lane, sub = lane & 7, pos = tok & (SEQ - 1);
    bf16* row = ((bf16*)(F.ws + WS_PROJ)) + (size_t)tok * LDP;
    float cs[8], sn[8];
    { const GAS f32x4* rt = (const GAS f32x4*)(((float*)(F.ws + WS_ROPE)) + pos * 16); const f32x4 a = rt[0], b = rt[1], c = rt[2], d = rt[3];
      cs[0] = a.x; cs[1] = a.y; cs[2] = a.z; cs[3] = a.w; cs[4] = b.x; cs[5] = b.y; cs[6] = b.z; cs[7] = b.w;
      sn[0] = c.x; sn[1] = c.y; sn[2] = c.z; sn[3] = c.w; sn[4] = d.x; sn[5] = d.y; sn[6] = d.z; sn[7] = d.w; }
#pragma unroll
    for (int which = 0; which < 2; ++which) {
        GAS v4u* p = (GAS v4u*)(row + (which ? K_OFF : Q_OFF) + lane * 8);
        float v[8]; unpack8(*p, v);
        float ss = 0.f;
#pragma unroll
        for (int j = 0; j < 8; ++j) ss += v[j] * v[j];
        ss += __shfl_xor(ss, 1); ss += __shfl_xor(ss, 2); ss += __shfl_xor(ss, 4);
        const float rs = 1.0f / sqrtf(ss * (1.f / 64.f) + EPS);
        const float* g = (which ? (AR.in[4]) : (AR.in[3])) + sub * 8;
#pragma unroll
        for (int j = 0; j < 8; ++j) v[j] = v[j] * rs * g[j];
        rope8(v, sub, cs, sn);
        if (which == 0) {
#pragma unroll
            for (int j = 0; j < 8; ++j) v[j] *= C2;
        }
        *p = pack8(v);
    }
    { GAS v4u* p = (GAS v4u*)(row + QI_OFF + lane * 8); float v[8]; unpack8(*p, v); rope8(v, sub, cs, sn); *p = pack8(v); }
    { GAS v4u* p = (GAS v4u*)(row + KI_OFF + (lane & 7) * 8); float v[8]; unpack8(*p, v); rope8(v, sub, cs, sn); if (lane < 8) *p = pack8(v); }
    { const int g = lane >> 4, w = 2 << g;
      float acc[8], cur[8];
#pragma unroll
      for (int j = 0; j < 8; ++j) acc[j] = 0.f;
      unpack8(*(const GAS v4u*)(row + P_OFF + lane * 8), cur);
#pragma unroll
      for (int j = 0; j < 8; ++j) acc[j] = cur[j];
#pragma unroll
      for (int back = 1; back < 16; ++back) {
          if (back < w && back <= pos) { float t[8]; unpack8(*(const GAS v4u*)(row - (size_t)back * LDP + P_OFF + lane * 8), t);
#pragma unroll
              for (int j = 0; j < 8; ++j) acc[j] += t[j]; }
      }
      const float inv = 1.0f / (float)((pos + 1 < w) ? (pos + 1) : w);
      float o[8];
#pragma unroll
      for (int j = 0; j < 8; ++j) o[j] = acc[j] * inv - cur[j];
      *(GAS v4u*)(((bf16*)(F.ws + WS_POOLED)) + (size_t)tok * 512 + lane * 8) = pack8(o); }
}

__device__ __forceinline__ int wave_incl_scan(int v) {
    v += __builtin_amdgcn_update_dpp(0, v, 0x111, 0xf, 0xf, false);
    v += __builtin_amdgcn_update_dpp(0, v, 0x112, 0xf, 0xf, false);
    v += __builtin_amdgcn_update_dpp(0, v, 0x114, 0xf, 0xf, false);
    v += __builtin_amdgcn_update_dpp(0, v, 0x118, 0xf, 0xf, false);
    v += __builtin_amdgcn_update_dpp(0, v, 0x142, 0xa, 0xf, false);
    v += __builtin_amdgcn_update_dpp(0, v, 0x143, 0xc, 0xf, false);
    return v;
}
template <int NB> __device__ __forceinline__ void hist_search(const LAS unsigned* hist, int need, int lane, int& B, int& G, int& E) {
    constexpr int PER = NB / 64;
    int t = 0;
#pragma unroll
    for (int q = 0; q < PER / 4; ++q) { const v4u h = *(const LAS v4u*)(hist + lane * PER + 4 * q); t += (int)(h.x + h.y + h.z + h.w); }
    const int pfx = wave_incl_scan(t);
    const int L = __ffsll((long long)__ballot(pfx >= need)) - 1;
    const int base = __builtin_amdgcn_readlane(pfx, L) - __builtin_amdgcn_readlane(t, L);
    const int hv = (lane < PER) ? (int)hist[L * PER + lane] : 0;
    const int p2 = wave_incl_scan(hv) + base;
    const int i = __ffsll((long long)__ballot(p2 >= need)) - 1;
    B = L * PER + i; E = __builtin_amdgcn_readlane(hv, i); G = __builtin_amdgcn_readlane(p2, i) - E;
}
template <int NB> __device__ __forceinline__ void hist_zero(LAS unsigned* hist, int lane) {
#pragma unroll
    for (int q = 0; q < NB / 256; ++q) *(LAS v4u*)(hist + q * 256 + lane * 4) = (v4u){0u, 0u, 0u, 0u};
}
#define HIST_ADD(p) (void)__hip_atomic_fetch_add((p), 1u, __ATOMIC_RELAXED, __HIP_MEMORY_SCOPE_WORKGROUP)
#define wlane(dst, sval, j) asm volatile("s_nop 3\n\tv_writelane_b32 %0, %1, %2\n\ts_nop 1" : "+v"(dst) : "s"(sval), "i"(j))
__device__ __forceinline__ void select_row(const float* srow, LAS unsigned* hist, int nj, int lastw, GAS unsigned long long* mout, int lane) {
    unsigned key[64];
#pragma unroll
    for (int g = 0; g < 8; ++g) {
        if (nj > 8 * g) {
#pragma unroll
            for (int jj = 0; jj < 8; ++jj) key[8 * g + jj] = ordk(((const GAS float*)srow)[64 * (8 * g + jj) + lane] + 0.0f);
        } else {
#pragma unroll
            for (int jj = 0; jj < 8; ++jj) key[8 * g + jj] = 0u;
        }
    }
    LDS_WAIT(); asm volatile("" ::: "memory");
    int need = 256, B, G, E;
    hist_zero<2048>(hist, lane); LDS_WAIT(); asm volatile("" ::: "memory");
#pragma unroll
    for (int g = 0; g < 8; ++g) if (nj > 8 * g) {
#pragma unroll
        for (int jj = 0; jj < 8; ++jj) HIST_ADD(hist + (2047u - (key[8 * g + jj] >> 21)));
    }
    LDS_WAIT(); asm volatile("" ::: "memory");
    hist_search<2048>(hist, need, lane, B, G, E); need -= G;
    const unsigned d1 = 2047u - (unsigned)B;
    asm volatile("" ::: "memory"); hist_zero<2048>(hist, lane); LDS_WAIT(); asm volatile("" ::: "memory");
#pragma unroll
    for (int g = 0; g < 8; ++g) if (nj > 8 * g) {
#pragma unroll
        for (int jj = 0; jj < 8; ++jj) { const unsigned k = key[8 * g + jj]; if ((k >> 21) == d1) HIST_ADD(hist + (2047u - ((k >> 10) & 0x7ffu))); }
    }
    LDS_WAIT(); asm volatile("" ::: "memory");
    hist_search<2048>(hist, need, lane, B, G, E); need -= G;
    const unsigned pre2 = (d1 << 11) | (2047u - (unsigned)B);
    unsigned v = pre2 << 10;
    if (need != E) {
        asm volatile("" ::: "memory"); hist_zero<1024>(hist, lane); LDS_WAIT(); asm volatile("" ::: "memory");
#pragma unroll
        for (int g = 0; g < 8; ++g) if (nj > 8 * g) {
#pragma unroll
            for (int jj = 0; jj < 8; ++jj) { const unsigned k = key[8 * g + jj]; if ((k >> 10) == pre2) HIST_ADD(hist + (1023u - (k & 0x3ffu))); }
        }
        LDS_WAIT(); asm volatile("" ::: "memory");
        hist_search<1024>(hist, need, lane, B, G, E); need -= G;
        v = (pre2 << 10) | (1023u - (unsigned)B);
    }
    unsigned mlo = 0u, mhi = 0u;
    if (need == E) {
#pragma unroll
        for (int g = 0; g < 8; ++g) {
            asm volatile("v_cmp_ge_u32_e64 s[40:41], %2, %10\n\tv_cmp_ge_u32_e64 s[42:43], %3, %10\n\tv_cmp_ge_u32_e64 s[44:45], %4, %10\n\tv_cmp_ge_u32_e64 s[46:47], %5, %10\n\t"
                         "v_cmp_ge_u32_e64 s[48:49], %6, %10\n\tv_cmp_ge_u32_e64 s[50:51], %7, %10\n\tv_cmp_ge_u32_e64 s[52:53], %8, %10\n\tv_cmp_ge_u32_e64 s[54:55], %9, %10\n\ts_nop 1\n\t"
                         "v_writelane_b32 %0, s40, %11\n\tv_writelane_b32 %1, s41, %11\n\tv_writelane_b32 %0, s42, %12\n\tv_writelane_b32 %1, s43, %12\n\t"
                         "v_writelane_b32 %0, s44, %13\n\tv_writelane_b32 %1, s45, %13\n\tv_writelane_b32 %0, s46, %14\n\tv_writelane_b32 %1, s47, %14\n\t"
                         "v_writelane_b32 %0, s48, %15\n\tv_writelane_b32 %1, s49, %15\n\tv_writelane_b32 %0, s50, %16\n\tv_writelane_b32 %1, s51, %16\n\t"
                         "v_writelane_b32 %0, s52, %17\n\tv_writelane_b32 %1, s53, %17\n\tv_writelane_b32 %0, s54, %18\n\tv_writelane_b32 %1, s55, %18\n\ts_nop 1"
                         : "+v"(mlo), "+v"(mhi)
                         : "v"(key[8 * g]), "v"(key[8 * g + 1]), "v"(key[8 * g + 2]), "v"(key[8 * g + 3]), "v"(key[8 * g + 4]), "v"(key[8 * g + 5]), "v"(key[8 * g + 6]), "v"(key[8 * g + 7]), "v"(v),
                           "i"(8 * g), "i"(8 * g + 1), "i"(8 * g + 2), "i"(8 * g + 3), "i"(8 * g + 4), "i"(8 * g + 5), "i"(8 * g + 6), "i"(8 * g + 7)
                         : "s40", "s41", "s42", "s43", "s44", "s45", "s46", "s47", "s48", "s49", "s50", "s51", "s52", "s53", "s54", "s55");
        }
    } else {
#pragma unroll
        for (int j = 0; j < 64; ++j) {
            unsigned long long eq = __ballot(key[j] == v); const unsigned long long gt = __ballot(key[j] > v);
            unsigned long long keep = 0ull;
            while (need > 0 && eq != 0ull) { const unsigned long long lsb = eq & (0ull - eq); keep |= lsb; eq ^= lsb; --need; }
            const unsigned long long m = gt | keep;
            wlane(mlo, (unsigned)m, j); wlane(mhi, (unsigned)(m >> 32), j);
        }
    }
    if (lane <= lastw) mout[lane] = ((unsigned long long)mhi << 32) | (unsigned long long)mlo;
    LDS_WAIT(); asm volatile("" ::: "memory");
}

__device__ __forceinline__ float* wave_scratch(unsigned char* ws, int gwv) {
    if (gwv < 1024) return (float*)(ws + WS_ACT) + (size_t)gwv * 32768;
    gwv -= 1024; if (gwv < 512) return (float*)(ws + WS_AO) + (size_t)gwv * 32768;
    gwv -= 512; if (gwv < 352) return (float*)(ws + 980 * MiB) + (size_t)gwv * 32768;
    gwv -= 352; if (gwv < 128) return (float*)(ws + 36 * MiB) + (size_t)gwv * 32768;
    gwv -= 128; return (float*)(ws + 68 * MiB) + (size_t)(gwv & 127) * 32768;
}
__device__ __forceinline__ void idx_unit(Frame& F, const Args& AR, int b, int c, bool do_select = true) {
    const int lane = F.lane, wid = F.wave, l31 = lane & 31, h2 = lane >> 5;
    const size_t rowb = (size_t)b * SEQ, tp0 = rowb + (size_t)c * 64 + wid * 8;
    GAS unsigned long long* mbase = (GAS unsigned long long*)(((unsigned long long*)(F.ws + WS_MASK)) + tp0 * 64);
    if (c < 4) {
        if (lane < 32) { const int q = lane >> 2, j = lane & 3; mbase[q * 64 + j] = (j <= c) ? ~0ull : 0ull; }
        return;
    }
    float* sc = wave_scratch(F.ws, F.vcu * NWAVES + wid);
    LAS unsigned* hist = (LAS unsigned*)(F.lds + wid * 8192);
    const int ntile = 2 * (c + 1), nj = c + 1, lastw = c | 3, ntile_pad = 16 * ((nj + 7) >> 3);
    const int head = (l31 & 3) | (((l31 >> 3) & 1) << 2), qsub = ((l31 >> 2) & 1) | (((l31 >> 4) & 1) << 1);
    bf16x8 a[2][4]; float w[2][16];
#pragma unroll
    for (int rb = 0; rb < 2; ++rb) {
        const bf16* ap = ((bf16*)(F.ws + WS_PROJ)) + (tp0 + 4 * rb + qsub) * LDP + QI_OFF + head * 64 + h2 * 8;
#pragma unroll
        for (int st = 0; st < 4; ++st) a[rb][st] = *(const GAS bf16x8*)(ap + st * 16);
        const v4u wa = *(const GAS v4u*)(((bf16*)(F.ws + WS_PROJ)) + (tp0 + 4 * rb + h2) * LDP + WI_OFF), wb = *(const GAS v4u*)(((bf16*)(F.ws + WS_PROJ)) + (tp0 + 4 * rb + h2 + 2) * LDP + WI_OFF);
        float t[8]; unpack8(wa, t);
#pragma unroll
        for (int j = 0; j < 8; ++j) w[rb][j] = t[j] * WI_SCALE;
        unpack8(wb, t);
#pragma unroll
        for (int j = 0; j < 8; ++j) w[rb][8 + j] = t[j] * WI_SCALE;
    }
    {
        LAS unsigned char* kb = F.lds + 65536;
        const int nstage = (ntile + 3) >> 2;
        const int sk0 = F.tid >> 3, sch = F.tid & 7;
        const bf16* kg = ((bf16*)(F.ws + WS_PROJ)) + (rowb + sk0) * LDP + KI_OFF + sch * 8;
        v4u r0 = *(const GAS v4u*)kg, r1 = *(const GAS v4u*)(kg + (size_t)64 * LDP);
#pragma unroll 1
        for (int sg = 0; sg < nstage; ++sg) {
            LAS unsigned char* cur = kb + (sg & 1) * 18432;
            *(LAS v4u*)(cur + sk0 * 144 + sch * 16) = r0; *(LAS v4u*)(cur + (sk0 + 64) * 144 + sch * 16) = r1;
            __syncthreads();
            if (sg + 1 < nstage) { r0 = *(const GAS v4u*)(kg + (size_t)(sg + 1) * 128 * LDP); r1 = *(const GAS v4u*)(kg + (size_t)((sg + 1) * 128 + 64) * LDP); }
#pragma unroll
            for (int t4 = 0; t4 < 4; ++t4) {
                const int kt = 4 * sg + t4;
                if (kt < ntile) {
                    bf16x8 bfr[4];
#pragma unroll
                    for (int st = 0; st < 4; ++st) bfr[st] = *(const LAS bf16x8*)(cur + (t4 * 32 + l31) * 144 + st * 32 + h2 * 16);
#pragma unroll
                    for (int rb = 0; rb < 2; ++rb) {
                        f32x16 acc;
#pragma unroll
                        for (int r = 0; r < 16; ++r) acc[r] = 0.f;
#pragma unroll
                        for (int st = 0; st < 4; ++st) acc = __builtin_amdgcn_mfma_f32_32x32x16_bf16(a[rb][st], bfr[st], acc, 0, 0, 0);
                        float s0 = 0.f, s1 = 0.f;
#pragma unroll
                        for (int r = 0; r < 8; ++r) { s0 = fmaf(w[rb][r], fmaxf(acc[r], 0.f), s0); s1 = fmaf(w[rb][8 + r], fmaxf(acc[8 + r], 0.f), s1); }
                        ((GAS float*)sc)[(4 * rb + h2) * 4096 + kt * 32 + l31] = s0;
                        ((GAS float*)sc)[(4 * rb + h2 + 2) * 4096 + kt * 32 + l31] = s1;
                    }
                }
            }
        }
        for (int kt = ntile; kt < ntile_pad; ++kt) {
#pragma unroll
            for (int rb = 0; rb < 2; ++rb) { ((GAS float*)sc)[(4 * rb + h2) * 4096 + kt * 32 + l31] = -INFINITY; ((GAS float*)sc)[(4 * rb + h2 + 2) * 4096 + kt * 32 + l31] = -INFINITY; }
        }
    }
    VM_WAIT();
    if (do_select) {
#pragma unroll 1
        for (int q = 0; q < 8 * PROBE_SEL2; ++q) select_row(sc + (q & 7) * 4096, hist, nj, lastw, mbase + (q & 7) * 64, lane);
    }
}

__device__ __forceinline__ void attn_unit(Frame& F, const Args& AR, int b, int h, int qb) {
    const int lane = F.lane, wid = F.wave, l31 = lane & 31, h2 = lane >> 5;
    LAS unsigned char* Ks = F.lds;
    LAS float* wsf = (LAS float*)(F.lds + 2 * 17408) + wid * 32;
    const size_t rowb = (size_t)b * SEQ, tok0 = rowb + (size_t)qb * 256 + wid * 32;
    bf16x8 qf[4];
    { const bf16* qp = ((bf16*)(F.ws + WS_PROJ)) + (tok0 + l31) * LDP + Q_OFF + h * 64 + h2 * 8;
#pragma unroll
      for (int st = 0; st < 4; ++st) qf[st] = *(const GAS bf16x8*)(qp + st * 16); }
    const int NT = 4 * (qb + 1), cw = qb * 4 + (wid >> 1);
    f32x16 o0, o1;
#pragma unroll
    for (int r = 0; r < 16; ++r) { o0[r] = 0.f; o1[r] = 0.f; }
    float lsum = 0.f;
    const int skey = F.tid >> 3, sch = F.tid & 7;
    const bf16* kg = ((bf16*)(F.ws + WS_PROJ)) + (rowb + skey) * LDP + K_OFF + h * 64 + sch * 8;
    const bf16* vg = ((bf16*)(F.ws + WS_PROJ)) + (rowb + skey) * LDP + V_OFF + h * 64 + sch * 8;
    const unsigned kst = skey * 144 + sch * 16, vst = skey * 128 + ((sch * 16) ^ (((skey >> 1) & 1) << 6));
    const GAS unsigned long long* mrow = (const GAS unsigned long long*)(((unsigned long long*)(F.ws + WS_MASK)) + (tok0 + l31) * 64);
    const int i16 = lane & 15, qq = i16 >> 2, pp = i16 & 3, blk = (lane >> 4) & 1;
    const unsigned vrd = (unsigned)((4 * h2 + qq) * 128 + ((32 * blk + 8 * pp) ^ (((qq >> 1) & 1) << 6)));
    v4u kr[3], vr[3];
#pragma unroll
    for (int u = 0; u < 3; ++u) { kr[u] = *(const GAS v4u*)(kg + (size_t)u * 64 * LDP); vr[u] = *(const GAS v4u*)(vg + (size_t)u * 64 * LDP); }
    unsigned long long mwn = mrow[0];
#pragma unroll 1
    for (int t = 0; t < NT; t += 3) {
#pragma unroll
        for (int u = 0; u < 3; ++u) {
            const int tt = t + u;
            if (tt < NT) {
                LAS unsigned char* Kc = Ks + (tt & 1) * 17408; LAS unsigned char* Vc = Kc + 9216;
                *(LAS v4u*)(Kc + kst) = kr[u]; *(LAS v4u*)(Vc + vst) = vr[u];
                __syncthreads();
                if (tt + 3 < NT) { kr[u] = *(const GAS v4u*)(kg + (size_t)(tt + 3) * 64 * LDP); vr[u] = *(const GAS v4u*)(vg + (size_t)(tt + 3) * 64 * LDP); }
                const unsigned long long mw = mwn;
                mwn = mrow[(tt + 1 < NT) ? tt + 1 : tt];
                if (tt <= cw) {
                    f32x16 p[2];
        #pragma unroll
                    for (int kb = 0; kb < 2; ++kb) {
                        f32x16 acc;
        #pragma unroll
                        for (int r = 0; r < 16; ++r) acc[r] = 0.f;
        #pragma unroll
                        for (int st = 0; st < 4; ++st) { const bf16x8 ka = *(const LAS bf16x8*)(Kc + (32 * kb + l31) * 144 + st * 32 + h2 * 16); acc = __builtin_amdgcn_mfma_f32_32x32x16_bf16(ka, qf[st], acc, 0, 0, 0); }
                        const unsigned wk = (kb ? (unsigned)(mw >> 32) : (unsigned)mw) >> (4 * h2);
        #pragma unroll
                        for (int r = 0; r < 16; ++r) {
                            const float e = __builtin_amdgcn_exp2f(acc[r]);
                            const int m = __builtin_amdgcn_sbfe((int)wk, (r & 3) + 8 * (r >> 2), 1);
                            const float pe = __uint_as_float(__float_as_uint(e) & (unsigned)m);
                            acc[r] = pe;
                        }
                        p[kb] = acc;
                    }
        #pragma unroll
                    for (int kb = 0; kb < 2; ++kb)
        #pragma unroll
                        for (int s = 0; s < 2; ++s) {
                            v4u pw; pw.x = pg8::cvt_pk_bf16(p[kb][8 * s + 0], p[kb][8 * s + 1]); pw.y = pg8::cvt_pk_bf16(p[kb][8 * s + 2], p[kb][8 * s + 3]); pw.z = pg8::cvt_pk_bf16(p[kb][8 * s + 4], p[kb][8 * s + 5]); pw.w = pg8::cvt_pk_bf16(p[kb][8 * s + 6], p[kb][8 * s + 7]);
                            lsum = dot2bf(pw.x, 0x3f803f80u, lsum); lsum = dot2bf(pw.y, 0x3f803f80u, lsum); lsum = dot2bf(pw.z, 0x3f803f80u, lsum); lsum = dot2bf(pw.w, 0x3f803f80u, lsum);
                            const bf16x8 pa = __builtin_bit_cast(bf16x8, pw);
                            const unsigned rbase = vrd + (unsigned)((32 * kb + 16 * s) * 128);
        #pragma unroll
                            for (int d0 = 0; d0 < 2; ++d0) {
                                const unsigned ad = rbase ^ (unsigned)(d0 << 6);
                                const s16x4 lo = __builtin_bit_cast(s16x4, __builtin_amdgcn_ds_read_tr16_b64_v4i16((LAS s16x4*)(Vc + ad)));
                                const s16x4 hi = __builtin_bit_cast(s16x4, __builtin_amdgcn_ds_read_tr16_b64_v4i16((LAS s16x4*)(Vc + ad + 8 * 128)));
                                const bf16x8 vb = (bf16x8){lo[0], lo[1], lo[2], lo[3], hi[0], hi[1], hi[2], hi[3]};
                                if (d0 == 0) o0 = __builtin_amdgcn_mfma_f32_32x32x16_bf16(pa, vb, o0, 0, 0, 0); else o1 = __builtin_amdgcn_mfma_f32_32x32x16_bf16(pa, vb, o1, 0, 0, 0);
                            }
                        }
                }
            }
        }
    }
    lsum += __shfl_xor(lsum, 32);
    if (h2 == 0) wsf[l31] = lsum;
    LDS_WAIT(); asm volatile("" ::: "memory");
    bf16* op = ((bf16*)(F.ws + WS_AO)) + tok0 * 512 + h * 64 + l31;
#pragma unroll
    for (int r = 0; r < 16; ++r) { const int q = crow(r, h2); const float rl = 1.0f / wsf[q];
        op[(size_t)q * 512] = (bf16)f2bf(o0[r] * rl); op[(size_t)q * 512 + 32] = (bf16)f2bf(o1[r] * rl); }
    LDS_WAIT(); asm volatile("" ::: "memory");
}

__device__ __forceinline__ float row_rs(const float* ssp, size_t tok) {
    const GAS f32x4* p = (const GAS f32x4*)(ssp + tok * 16); const f32x4 a = p[0], b = p[1], c = p[2], d = p[3];
    const float ss = ((a.x + a.y) + (a.z + a.w)) + ((b.x + b.y) + (b.z + b.w)) + ((c.x + c.y) + (c.z + c.w)) + ((d.x + d.y) + (d.z + d.w));
    return 1.0f / sqrtf(ss * (1.f / 1024.f) + EPS);
}
__device__ __forceinline__ void sort16_desc(unsigned (&a)[16]) {
#pragma unroll
    for (int k = 2; k <= 16; k <<= 1)
#pragma unroll
        for (int j = k >> 1; j > 0; j >>= 1)
#pragma unroll
            for (int i = 0; i < 16; ++i) { const int l = i ^ j; if (l > i) { const unsigned hi = a[i] > a[l] ? a[i] : a[l], lo = a[i] > a[l] ? a[l] : a[i];
                if ((i & k) == 0) { a[i] = hi; a[l] = lo; } else { a[i] = lo; a[l] = hi; } } }
}
__device__ __forceinline__ void merge16_desc(unsigned (&top)[16], const unsigned (&a)[16]) {
#pragma unroll
    for (int i = 0; i < 16; ++i) top[i] = top[i] > a[15 - i] ? top[i] : a[15 - i];
#pragma unroll
    for (int j = 8; j > 0; j >>= 1)
#pragma unroll
        for (int i = 0; i < 16; ++i) { const int l = i ^ j; if (l > i) { const unsigned hi = top[i] > top[l] ? top[i] : top[l], lo = top[i] > top[l] ? top[l] : top[i]; top[i] = hi; top[l] = lo; } }
}
struct PairTab { int i[64], j[64]; };
constexpr PairTab make_pairs() { PairTab t{}; int n = 0; for (int i = 0; i < 16; ++i) for (int j = 0; j < 16; ++j) if ((i + 1) * (j + 1) <= 16) { t.i[n] = i; t.j[n] = j; ++n; } for (; n < 64; ++n) { t.i[n] = -1; t.j[n] = -1; } return t; }
__device__ __forceinline__ void route_task(Frame& F, const Args& AR, int tt, int h) {
    const int lane = F.lane, l31 = lane & 31, h2 = lane >> 5;
    const size_t tok = (size_t)tt * 32 + l31;
    LAS unsigned* lk = (LAS unsigned*)F.lds;
    unsigned KA[16], KB[16];
#pragma unroll
    for (int i = 0; i < 16; ++i) { KA[i] = 0u; KB[i] = 0u; }
#pragma unroll 1
    for (int p = 0; p < 2; ++p) {
        const int hp = 2 * h + p;
        bf16x8 bq[4];
        { const bf16* qp = ((const bf16*)(F.ws + WS_SUBK)) + tok * 1024 + hp * 64 + h2 * 8;
#pragma unroll
          for (int st = 0; st < 4; ++st) bq[st] = *(const GAS bf16x8*)(qp + st * 16); }
        unsigned top[16];
#pragma unroll
        for (int i = 0; i < 16; ++i) top[i] = 0u;
#pragma unroll 1
        for (int blk = 0; blk < 4; ++blk) {
            const bf16* ap = ((const bf16*)(F.ws + WS_SKB)) + (size_t)(hp * 128 + 32 * blk + l31) * 64 + h2 * 8;
            f32x16 acc;
#pragma unroll
            for (int r = 0; r < 16; ++r) acc[r] = 0.f;
#pragma unroll
            for (int st = 0; st < 4; ++st) { const bf16x8 af = *(const GAS bf16x8*)(ap + st * 16); acc = __builtin_amdgcn_mfma_f32_32x32x16_bf16(af, bq[st], acc, 0, 0, 0); }
            unsigned a16[16];
#pragma unroll
            for (int r = 0; r < 16; ++r) a16[r] = (ordk(acc[r]) & ~127u) | (unsigned)(127 - (32 * blk + (r & 3) + 8 * (r >> 2)) - 4 * h2);
            sort16_desc(a16);
            merge16_desc(top, a16);
        }
        unsigned oth[16];
#pragma unroll
        for (int i = 0; i < 16; ++i) oth[i] = __shfl_xor(top[i], 32);
        merge16_desc(top, oth);
#pragma unroll
        for (int i = 0; i < 16; ++i) { if (p == 0) KA[i] = top[i]; else KB[i] = top[i]; }
    }
    float sa[16], sb[16];
#pragma unroll
    for (int i = 0; i < 16; ++i) { sa[i] = unordk(KA[i] & ~127u); sb[i] = unordk(KB[i] & ~127u); lk[i * 512 + F.tid] = KA[i]; lk[(16 + i) * 512 + F.tid] = KB[i]; }
    unsigned ck[16];
#pragma unroll
    for (int grp = 0; grp < 4; ++grp) {
        unsigned a[16];
#pragma unroll
        for (int q = 0; q < 16; ++q) { constexpr PairTab T = make_pairs(); const int pi = T.i[grp * 16 + q], pj = T.j[grp * 16 + q];
            a[q] = (pi < 0) ? 0u : ((ordk(sa[pi < 0 ? 0 : pi] + sb[pj < 0 ? 0 : pj]) & ~255u) | (unsigned)(255 - (pi * 16 + pj))); }
        sort16_desc(a);
        if (grp == 0) {
#pragma unroll
            for (int i = 0; i < 16; ++i) ck[i] = a[i];
        } else merge16_desc(ck, a);
    }
    LDS_WAIT(); asm volatile("" ::: "memory");
    unsigned ce[16];
#pragma unroll
    for (int t = 0; t < 16; ++t) { const unsigned flat = 255u - (ck[t] & 255u); const unsigned ka = lk[(flat >> 4) * 512 + F.tid], kb = lk[(16u + (flat & 15u)) * 512 + F.tid];
        ce[t] = (127u - (ka & 127u)) * 128u + (127u - (kb & 127u)); }
    LDS_WAIT(); asm volatile("" ::: "memory");
    float ts[16]; float sum = 0.f; const float mx = unordk(ck[0] & ~255u);
    const float rsl = row_rs((const float*)(F.ws + WS_SSP), tok) * 1.4426950408889634f;
#pragma unroll
    for (int t = 0; t < 16; ++t) { ts[t] = __builtin_amdgcn_exp2f((unordk(ck[t] & ~255u) - mx) * rsl); sum += ts[t]; }
    const float inv = 1.0f / sum;
    if (h2 == 0) {
        GAS v4u* eo = (GAS v4u*)(((unsigned short*)(F.ws + WS_REXP)) + tok * 128 + h * 16); GAS f32x4* go = (GAS f32x4*)(((float*)(F.ws + WS_RG)) + tok * 128 + h * 16);
        eo[0] = (v4u){ce[0] | (ce[1] << 16), ce[2] | (ce[3] << 16), ce[4] | (ce[5] << 16), ce[6] | (ce[7] << 16)};
        eo[1] = (v4u){ce[8] | (ce[9] << 16), ce[10] | (ce[11] << 16), ce[12] | (ce[13] << 16), ce[14] | (ce[15] << 16)};
#pragma unroll
        for (int t4 = 0; t4 < 4; ++t4) go[t4] = (f32x4){ts[4 * t4] * inv, ts[4 * t4 + 1] * inv, ts[4 * t4 + 2] * inv, ts[4 * t4 + 3] * inv};
    }
}

__device__ __forceinline__ float gelu_erf(float v) {
    const float av = fabsf(v), t = __builtin_amdgcn_rcpf(av * 0.2316418882f + 1.0f);
    float q = t * 0.5307027145f + (-0.7265760135f); q = q * t + 0.7107068705f; q = q * t + (-0.142248368f); q = q * t + 0.127414796f; q = q * t;
    const float e = __builtin_amdgcn_exp2f((v * v) * (-0.72134752044f));
    const float m = v * (q * e);
    return v < 0.f ? m : v - m;
}
__device__ __forceinline__ float dpp_add(float v, float w_unused) { return v; }
#define DPP_ADD(v, ctrl) ((v) + __builtin_bit_cast(float, __builtin_amdgcn_update_dpp(0, __builtin_bit_cast(int, (v)), (ctrl), 0xf, 0xf, true)))
constexpr int NSL = 8;
constexpr int CW_PEER = 8192;
typedef float f32x2v __attribute__((ext_vector_type(2)));
__device__ __forceinline__ unsigned id_of(const v4u a, const v4u b, int m) { const unsigned w = (m < 8) ? a[(m & 7) >> 1] : b[(m & 7) >> 1]; return (m & 1) ? (w >> 16) : (w & 0xffffu); }
__device__ __forceinline__ void load_hn2(const bf16* p, f32x2v (&hn2)[8]) { const v4u a = *(const GAS v4u*)p, b = *(const GAS v4u*)(p + 8);
    hn2[0] = (f32x2v){bflo(a.x), bfhi(a.x)}; hn2[1] = (f32x2v){bflo(a.y), bfhi(a.y)}; hn2[2] = (f32x2v){bflo(a.z), bfhi(a.z)}; hn2[3] = (f32x2v){bflo(a.w), bfhi(a.w)};
    hn2[4] = (f32x2v){bflo(b.x), bfhi(b.x)}; hn2[5] = (f32x2v){bflo(b.y), bfhi(b.y)}; hn2[6] = (f32x2v){bflo(b.z), bfhi(b.z)}; hn2[7] = (f32x2v){bflo(b.w), bfhi(b.w)}; }
template <int SIDE> __device__ __forceinline__ void peer_item8(Frame& F, const Args& AR, int s, size_t t0) {
    const int lane = F.lane, ts = lane >> 3, c = lane & 7;
    const size_t tok = t0 + ts;
    const unsigned char* tbase = ((const unsigned char*)(F.ws + (SIDE == 0 ? WS_U16 : WS_V16))) + 128 * s;
    const unsigned lo = 16u * (unsigned)c;
    const GAS v4u* idq = (const GAS v4u*)(((const unsigned short*)(F.ws + WS_REXP)) + tok * 128);
    v4u ia = idq[0], ib = idq[1];
    if (SIDE == 0) {
        f32x2v hn2[8]; load_hn2(((const bf16*)(F.ws + WS_HG)) + tok * 1024 + 128 * s + 16 * c, hn2);
        float* po = ((float*)(F.ws + WS_SUBK)) + (tok * NSL + s) * 128;
#pragma unroll 1
        for (int b = 0; b < 8; ++b) {
            v4u r[16];
#pragma unroll
            for (int m = 0; m < 16; ++m) r[m] = *(const GAS v4u*)(tbase + (size_t)((id_of(ia, ib, m) << 10) + lo));
            const int bn = (b + 1) & 7; ia = idq[2 * bn]; ib = idq[2 * bn + 1];
            float d[16];
#pragma unroll
            for (int m = 0; m < 16; ++m) { f32x2v acc = {0.f, 0.f};
#pragma unroll
                for (int q = 0; q < 4; ++q) { const int w = (int)r[m][q]; acc = __builtin_amdgcn_cvt_pk_f32_fp8(w, false) * hn2[2 * q] + acc; acc = __builtin_amdgcn_cvt_pk_f32_fp8(w, true) * hn2[2 * q + 1] + acc; }
                float a = acc.x + acc.y; a = DPP_ADD(a, 0xB1); a = DPP_ADD(a, 0x4E); a = DPP_ADD(a, 0x141); d[m] = a; }
            if (c == 0) { GAS f32x4* pq = (GAS f32x4*)(po + 16 * b);
                pq[0] = (f32x4){d[0], d[1], d[2], d[3]}; pq[1] = (f32x4){d[4], d[5], d[6], d[7]}; pq[2] = (f32x4){d[8], d[9], d[10], d[11]}; pq[3] = (f32x4){d[12], d[13], d[14], d[15]}; }
        }
    } else {
        const GAS f32x4* cfq = (const GAS f32x4*)(((const float*)(F.ws + WS_RG)) + tok * 128);
        f32x4 cf[4];
#pragma unroll
        for (int q = 0; q < 4; ++q) cf[q] = cfq[q];
        f32x2v acc[8];
#pragma unroll
        for (int j = 0; j < 8; ++j) acc[j] = (f32x2v){0.f, 0.f};
#pragma unroll 1
        for (int b = 0; b < 8; ++b) {
            v4u r[16];
#pragma unroll
            for (int m = 0; m < 16; ++m) r[m] = *(const GAS v4u*)(tbase + (size_t)((id_of(ia, ib, m) << 10) + lo));
            const int bn = (b + 1) & 7; ia = idq[2 * bn]; ib = idq[2 * bn + 1];
            f32x4 cn[4];
#pragma unroll
            for (int q = 0; q < 4; ++q) cn[q] = cfq[4 * bn + q];
#pragma unroll
            for (int m = 0; m < 16; ++m) { const float cm = cf[m >> 2][m & 3]; const f32x2v c2 = {cm, cm};
#pragma unroll
                for (int q = 0; q < 4; ++q) { const int w = (int)r[m][q]; acc[2 * q] = __builtin_amdgcn_cvt_pk_f32_fp8(w, false) * c2 + acc[2 * q]; acc[2 * q + 1] = __builtin_amdgcn_cvt_pk_f32_fp8(w, true) * c2 + acc[2 * q + 1]; } }
#pragma unroll
            for (int q = 0; q < 4; ++q) cf[q] = cn[q];
        }
        GAS f32x4* op = (GAS f32x4*)((AR.out) + tok * 1024 + 128 * s + 16 * c);
#pragma unroll
        for (int q = 0; q < 4; ++q) { f32x4 h = op[q]; h.x += acc[2 * q].x; h.y += acc[2 * q].y; h.z += acc[2 * q + 1].x; h.w += acc[2 * q + 1].y; op[q] = h; }
    }
}
template <int SIDE> __device__ __forceinline__ void peer_side(Frame& F, const Args& AR, int rep = 0) {
    gu32* cnt = F.ctl + CW_PEER + (SIDE + 2 * rep) * 16 * 64;
    LAS int* sh = (LAS int*)F.lds;
    const unsigned xcc = xb_xcc_id() & 7u;
#pragma unroll 1
    for (int k = 0; k < NSL; ++k) {
        const int s = (int)((xcc + (unsigned)k) & (unsigned)(NSL - 1));
#pragma unroll 1
        for (;;) {
            __syncthreads();
            if (F.tid == 0) sh[0] = (int)__hip_atomic_fetch_add(cnt + 64 * s, 1u, RLX_AGENT);
            __syncthreads();
            const int blk = sh[0];
            if (blk >= MTOK / 128) break;
            const size_t t0 = (size_t)blk * 128 + F.wave * 16;
            peer_item8<SIDE>(F, AR, s, t0); peer_item8<SIDE>(F, AR, s, t0 + 8);
        }
    }
}
__device__ __forceinline__ void peer_coef_token(Frame& F, size_t tok, float inv_su, float inv_sv) {
    const int lane = F.lane;
    const float* pp = ((const float*)(F.ws + WS_SUBK)) + tok * NSL * 128;
    float a0 = 0.f, a1 = 0.f;
#pragma unroll
    for (int s = 0; s < NSL; ++s) { a0 += pp[s * 128 + lane]; a1 += pp[s * 128 + 64 + lane]; }
    float* gp = ((float*)(F.ws + WS_RG)) + tok * 128;
    const float sc = inv_su * row_rs((const float*)(F.ws + WS_SSP), tok);
    gp[lane] = gp[lane] * gelu_erf(a0 * sc) * inv_sv; gp[64 + lane] = gp[64 + lane] * gelu_erf(a1 * sc) * inv_sv;
}

__global__ void __launch_bounds__(NWAVES * 64, 2) mk_fwd(Args args) {
    extern __shared__ __attribute__((aligned(16))) unsigned char lds[];
    Frame F;
    F.lds = (LAS unsigned char*)lds;
    F.MISC = (volatile LAS unsigned*)(F.lds + MISC_OFF);
    F.tid = threadIdx.x; F.lane = F.tid & 63; F.wave = __builtin_amdgcn_readfirstlane(F.tid >> 6);
    F.G = gridDim.x; { const int bx = blockIdx.x; F.vcu = (F.G % 8 == 0) ? (bx % 8) * (F.G / 8) + bx / 8 : bx; }
    F.ws = args.ws;
    F.ctl = (gu32*)(F.ws + WS_CTL);
    const Args& AR = args;
    for (int u = F.tid; u < (LDS_BYTES - LDSCTL_OFF) / 4; u += NWAVES * 64) ((LAS unsigned*)(F.lds + LDSCTL_OFF))[u] = 0u;
    __syncthreads();
    XcdBarrier bar; bar.bar = (unsigned*)(F.ctl + CW_BAR); bar.x = 0; bar.st = nullptr;
#if !MK_PER_PHASE
    bar = xcd_barrier_post((unsigned*)(F.ctl + CW_BAR), F.MISC + 8);
#endif
    const int lo = args.ph_lo, hi = args.ph_hi;
#if defined(ONLY_PHASE)
#define IN(k) ((k) == ONLY_PHASE && lo <= (k) && (k) < hi)
#elif defined(PHASE_MASK)
#define IN(k) (((PHASE_MASK >> (k)) & 1) && lo <= (k) && (k) < hi)
#else
#define IN(k) (lo <= (k) && (k) < hi)
#endif
#if MK_PER_PHASE
#define SEAM(k) do { } while (0)
#else
#define SEAM(k) do { if (IN(k) && IN((k) + 1)) xcd_barrier(bar); } while (0)
#endif
#define FRESH() Frame P = F; { int t_ = threadIdx.x; asm volatile("" : "+v"(t_)); P.tid = t_; P.lane = t_ & 63; P.wave = __builtin_amdgcn_readfirstlane(t_ >> 6); } const int gw = P.vcu * NWAVES + P.wave, NGW = P.G * NWAVES; (void)gw; (void)NGW

    for (int rep_ = 0; rep_ < (((REPEAT_MASK >> 0) & 1) ? 2 : 1); ++rep_) if (IN(0)) { FRESH(); p0_prologue(P, args); } SEAM(0);
    for (int rep_ = 0; rep_ < (((REPEAT_MASK >> 1) & 1) ? 2 : 1); ++rep_) if (IN(1)) { pg8::Gemm g{((bf16*)(F.ws + WS_ACT)), ((bf16*)(F.ws + WS_WIN)), MTOK, LDP, 1024, 1024, 1024}; pg8::StaticOrder S; S.init(MTOK, LDP, F.G, (int)blockIdx.x);
        pg8::EpiStoreBf16 E{((bf16*)(F.ws + WS_PROJ)), LDP};
        pg8::gemm_phase<pg8::EpiStoreBf16, pg8::StaticOrder, true, true>(F.lds, g, S, E); } SEAM(1);
    if (IN(2)) { FRESH(); for (int m = gw; m < MTOK; m += NGW) fixup_token(P, args, m);
        const float su = fp8_scale(__hip_atomic_load(P.ctl + CW_AMAX, RLX_AGENT)), sv = fp8_scale(__hip_atomic_load(P.ctl + CW_AMAX + 1, RLX_AGENT));
        for (int r = gw; r < 2 * 16384; r += NGW) { const int rr = r & 16383;
            if (r < 16384) row_to_fp8(args.in[13] + (size_t)rr * 1024, (unsigned char*)(P.ws + WS_U16) + (size_t)rr * 1024, su, P.lane);
            else row_to_fp8(args.in[14] + (size_t)rr * 1024, (unsigned char*)(P.ws + WS_V16) + (size_t)rr * 1024, sv, P.lane); } } SEAM(2);
    for (int rep_ = 0; rep_ < (((REPEAT_MASK >> 3) & 1) ? 2 : 1); ++rep_) if (IN(3)) { FRESH(); for (int i = P.vcu; i < 256; i += P.G) { const int b = i >> 4, s = i & 15;
#pragma unroll 1
            for (int k = 0; k < 4; ++k) idx_unit(P, args, b, (k == 0) ? s : (k == 1) ? 31 - s : (k == 2) ? 32 + s : 63 - s, PROBE_NOSEL ? (rep_ == 1) : true); } } SEAM(3);
    for (int rep_ = 0; rep_ < (((REPEAT_MASK >> 4) & 1) ? 2 : 1); ++rep_) if (IN(4)) { FRESH(); for (int i = P.vcu; i < 256; i += P.G) { const int bh = i >> 1, s = i & 1, b = bh >> 3, h = bh & 7;
#pragma unroll 1
            for (int k = 0; k < 8; ++k) attn_unit(P, args, b, h, (k & 1) ? 15 - (k >> 1) * 2 - s : (k >> 1) * 2 + s); } } SEAM(4);
    for (int rep_ = 0; rep_ < (((REPEAT_MASK >> 5) & 1) ? 2 : 1); ++rep_) if (IN(5)) { pg8::Gemm g{((bf16*)(F.ws + WS_AO)), ((bf16*)(F.ws + WS_WA)), MTOK, 1024, 512, 512, 512}; pg8::StaticOrder S; S.init(MTOK, 1024, F.G, (int)blockIdx.x);
        pg8::EpiGate<false> E{((bf16*)(F.ws + WS_ACT)), 1024, ((bf16*)(F.ws + WS_PROJ)) + GA_OFF, LDP};
        pg8::gemm_phase<pg8::EpiGate<false>, pg8::StaticOrder, true, true>(F.lds, g, S, E); }
    if (IN(6)) { pg8::Gemm g{((bf16*)(F.ws + WS_POOLED)), ((bf16*)(F.ws + WS_WPP)), MTOK, 1024, 512, 512, 512}; pg8::StaticOrder S; S.init(MTOK, 1024, F.G, (int)blockIdx.x);
                pg8::EpiGate<true> E{((bf16*)(F.ws + WS_ACT)), 1024, ((bf16*)(F.ws + WS_PROJ)) + GP_OFF, LDP};
        pg8::gemm_phase<pg8::EpiGate<true>, pg8::StaticOrder, true, true>(F.lds, g, S, E); } SEAM(6);
    for (int rep_ = 0; rep_ < (((REPEAT_MASK >> 7) & 1) ? 2 : 1); ++rep_) if (IN(7)) { pg8::Gemm g{((bf16*)(F.ws + WS_ACT)), ((bf16*)(F.ws + WS_WO)), MTOK, 1024, 1024, 1024, 1024}; pg8::StaticOrder S; S.init(MTOK, 1024, F.G, (int)blockIdx.x);
        pg8::EpiResHG E{(AR.in[0]), (AR.out), ((bf16*)(F.ws + WS_HG)), (AR.in[10]), ((float*)(F.ws + WS_SSP)), 1024};
        pg8::gemm_phase<pg8::EpiResHG, pg8::StaticOrder, true, true>(F.lds, g, S, E); } SEAM(7);

    for (int rep_ = 0; rep_ < (((REPEAT_MASK >> 9) & 1) ? 2 : 1); ++rep_) if (IN(9)) { pg8::Gemm g{((bf16*)(F.ws + WS_HG)), ((bf16*)(F.ws + WS_W2)), MTOK, 1024, 1024, 1024, 1024}; pg8::StaticOrder S; S.init(MTOK, 1024, F.G, (int)blockIdx.x);
        pg8::EpiStoreBf16 E{((bf16*)(F.ws + WS_SUBK)), 1024};
        pg8::gemm_phase<pg8::EpiStoreBf16, pg8::StaticOrder, true, true>(F.lds, g, S, E); } SEAM(9);
    for (int rep_ = 0; rep_ < (((REPEAT_MASK >> 10) & 1) ? 2 : 1); ++rep_) if (IN(10)) { FRESH(); for (int tt = P.vcu; tt < MTOK / 32; tt += P.G) route_task(P, args, tt, P.wave); } SEAM(10);
        for (int rep_ = 0; rep_ < (((REPEAT_MASK >> 11) & 1) ? 2 : 1); ++rep_) if (IN(11)) { FRESH(); peer_side<0>(P, args, rep_); } SEAM(11);
    if (IN(12)) { FRESH(); const float iu = fp8_inv_scale(__hip_atomic_load(P.ctl + CW_AMAX, RLX_AGENT)), iv = fp8_inv_scale(__hip_atomic_load(P.ctl + CW_AMAX + 1, RLX_AGENT));
        for (int m = gw; m < MTOK; m += NGW) peer_coef_token(P, (size_t)m, iu, iv); } SEAM(12);
    if (IN(13)) { FRESH(); peer_side<1>(P, args); }

#undef IN
#undef SEAM
}

extern "C" void kernel_launch(void* const* d_in, const int* in_sizes, int n_in, void* d_out, int out_size, void* d_ws, size_t ws_size, hipStream_t stream) {
    static int grid = 0;
    if (grid == 0) {
        if (n_in != 15 || in_sizes[0] != MTOK * DM || out_size != MTOK * DM || ws_size < WS_END) { fprintf(stderr, "kernel_launch: unexpected shapes (n_in %d, in0 %d, out %d, ws %zu < %zu)\n", n_in, n_in > 0 ? in_sizes[0] : -1, out_size, ws_size, (size_t)WS_END); grid = -1; return; }
        int dev = 0, cus = 0, per_cu = 0;
        if (hipGetDevice(&dev) != hipSuccess || hipDeviceGetAttribute(&cus, hipDeviceAttributeMultiprocessorCount, dev) != hipSuccess) { grid = -1; return; }
        if (hipFuncSetAttribute((const void*)mk_fwd, hipFuncAttributeMaxDynamicSharedMemorySize, LDS_BYTES) != hipSuccess) { fprintf(stderr, "kernel_launch: hipFuncSetAttribute failed\n"); grid = -1; return; }
        if (hipOccupancyMaxActiveBlocksPerMultiprocessor(&per_cu, (const void*)mk_fwd, NWAVES * 64, LDS_BYTES) != hipSuccess || per_cu < 1) { fprintf(stderr, "kernel_launch: occupancy query says %d blocks per CU\n", per_cu); (void)hipGetLastError(); grid = -1; return; }
        grid = cus;
    }
    if (grid < 0) return;
    if (hipMemsetAsync((char*)d_ws + WS_CTL, 0, CTL_ZERO_BYTES, stream) != hipSuccess) return;
    Args a{};
    for (int i = 0; i < 15; ++i) a.in[i] = (const float*)d_in[i];
    a.out = (float*)d_out; a.ws = (unsigned char*)d_ws;
#if MK_PER_PHASE
    for (int p = 0; p < NPHASE; ++p) { a.ph_lo = p; a.ph_hi = p + 1; hipLaunchKernelGGL(mk_fwd, dim3(grid), dim3(NWAVES * 64), LDS_BYTES, stream, a); }
#else
    a.ph_lo = 0; a.ph_hi = NPHASE;
    hipLaunchKernelGGL(mk_fwd, dim3(grid), dim3(NWAVES * 64), LDS_BYTES, stream, a);
#endif
}
```

```cpp
#include <hip/hip_runtime.h>
#include <cstdio>
#include <cstdint>
namespace pg8 {
#define PG8_LAS __attribute__((address_space(3)))
typedef unsigned short bf16_t;
typedef short bf16x8 __attribute__((ext_vector_type(8)));
typedef float f32x4 __attribute__((ext_vector_type(4)));
typedef unsigned u32x4 __attribute__((ext_vector_type(4)));
constexpr int BM = 256, BK = 64, HALF = 128, HTB = HALF * BK * 2  , STAGE_BYTES = 8 * HTB, NXCD = 8, WGM = 8;

__host__ __device__ __forceinline__ int lds_byte(int r, int c) { const int st = (r >> 4) * 2 + (c >> 5), rr = r & 15, cc = c & 31, ob = rr * 64 + cc * 2; return st * 1024 + (ob ^ (((ob >> 9) & 1) << 5)); }
__host__ __device__ __forceinline__ void stage_rc(int b, int& R, int& C) { const int st = b / 1024, sb = b % 1024, swz = sb ^ (((sb >> 9) & 1) << 5); R = (st >> 1) * 16 + swz / 64; C = (st & 1) * 32 + (swz % 64) / 2; }
__host__ __device__ __forceinline__ int perm32(int rho) { const int n = rho >> 4, i = rho & 15; return 8 * (i >> 2) + 4 * n + (i & 3); }

struct Unit { int pm, pn; };
struct Gemm { const bf16_t* A; const bf16_t* Bt; int M, N, K, lda, ldb; };

struct StaticOrder {
    int nM, nN, nwg, G, c;
    __host__ __device__ void init(int M, int N, int G_, int c_) { nM = M / BM; nN = N / BM; nwg = nM * nN; G = G_; c = c_; }
    __host__ __device__ bool next(int i, Unit& u) const {
        const long L = (long)i * G + c; if (L >= nwg) return false;
        int wgid = (int)L; { const int q = nwg / NXCD, r = nwg % NXCD, xcd = wgid % NXCD, off = wgid / NXCD; wgid = (xcd < r ? xcd * (q + 1) : r * (q + 1) + (xcd - r) * q) + off; }
        const int nig = WGM * nN, gid = wgid / nig, fm = gid * WGM, gsz = (nM - fm) < WGM ? (nM - fm) : WGM;
        u.pm = fm + ((wgid % nig) % gsz); u.pn = (wgid % nig) / gsz; return true;
    }
    __device__ __forceinline__ void a_ready(const Unit&) const {}
    __device__ __forceinline__ void done(const Unit&) const {}
};
struct PanelOrder {
    int nN, pm;
    __host__ __device__ bool next(int i, Unit& u) const { if (i >= nN) return false; u.pm = pm; u.pn = i; return true; }
    __device__ __forceinline__ void a_ready(const Unit&) const {}
    __device__ __forceinline__ void done(const Unit&) const {}
};
typedef float f32x2c_t __attribute__((ext_vector_type(2))); typedef __bf16 bf16x2c_t __attribute__((ext_vector_type(2)));
__device__ __forceinline__ unsigned cvt_pk_bf16(float lo, float hi) { f32x2c_t v = {lo, hi}; bf16x2c_t b = __builtin_convertvector(v, bf16x2c_t); return __builtin_bit_cast(unsigned, b); }
typedef float f32x2 __attribute__((ext_vector_type(2)));
__device__ __forceinline__ f32x2 gelu_pk(f32x2 v) {
    const f32x2 av = __builtin_elementwise_abs(v), d = av * 0.2316418882f + 1.0f;
    f32x2 t; t.x = __builtin_amdgcn_rcpf(d.x); t.y = __builtin_amdgcn_rcpf(d.y);
    f32x2 q = t * 0.5307027145f + (-0.7265760135f); q = q * t + 0.7107068705f; q = q * t + (-0.142248368f); q = q * t + 0.127414796f; q = q * t;
    const f32x2 s = (v * v) * (-0.72134752044f);
    f32x2 e; e.x = __builtin_amdgcn_exp2f(s.x); e.y = __builtin_amdgcn_exp2f(s.y);
    const f32x2 m = v * (q * e), r = v - m;
    f32x2 o; o.x = v.x < 0.f ? m.x : r.x; o.y = v.y < 0.f ? m.y : r.y; return o;
}
typedef unsigned u32x2e __attribute__((ext_vector_type(2)));
__device__ __forceinline__ float bf_lo(unsigned w) { return __uint_as_float(w << 16); }
__device__ __forceinline__ float bf_hi(unsigned w) { return __uint_as_float(w & 0xffff0000u); }
__device__ __forceinline__ float sigmoidf_fast(float g) { return __builtin_amdgcn_rcpf(1.0f + __builtin_amdgcn_exp2f(-1.4426950408889634f * g)); }
__device__ __forceinline__ unsigned ord_key(float f) { const unsigned b = __float_as_uint(f); return b ^ ((unsigned)((int)b >> 31) | 0x80000000u); }
__device__ __forceinline__ float unord_key(unsigned k) { return __uint_as_float((k & 0x80000000u) ? (k ^ 0x80000000u) : ~k); }

struct EpiStoreBf16 {
    static constexpr bool PERM = true, AFTER_DRAIN = false;
    bf16_t* O; int ldc;
    __device__ __forceinline__ void operator()(const f32x4 (&acc)[2][2][4][2], const Unit& u, int wr, int wc, int fr, int fq) const {
        const int row0 = u.pm * BM + wr * 64 + fr, col0 = u.pn * BM + wc * 32 + 8 * fq;
#pragma unroll
        for (int ai = 0; ai < 2; ++ai)
#pragma unroll
            for (int m = 0; m < 4; ++m) { bf16_t* rowp = O + (size_t)(row0 + ai * HALF + m * 16) * ldc + col0;
#pragma unroll
                for (int bj = 0; bj < 2; ++bj) { const f32x4 v0 = acc[ai][bj][m][0], v1 = acc[ai][bj][m][1];
                    u32x4 w; w.x = cvt_pk_bf16(v0[0], v0[1]); w.y = cvt_pk_bf16(v0[2], v0[3]); w.z = cvt_pk_bf16(v1[0], v1[1]); w.w = cvt_pk_bf16(v1[2], v1[3]);
                    *(u32x4*)(rowp + bj * HALF) = w; } }
    }
};
template <bool ADD> struct EpiGate {
    static constexpr bool PERM = true, AFTER_DRAIN = false;
    bf16_t* O; int ldc; const bf16_t* G; int ldg;
    __device__ __forceinline__ void operator()(const f32x4 (&acc)[2][2][4][2], const Unit& u, int wr, int wc, int fr, int fq) const {
        const int row0 = u.pm * BM + wr * 64 + fr, col0 = u.pn * BM + wc * 32 + 8 * fq;
#pragma unroll
        for (int ai = 0; ai < 2; ++ai)
#pragma unroll
            for (int m = 0; m < 4; ++m) { const size_t row = (size_t)(row0 + ai * HALF + m * 16);
#pragma unroll
                for (int bj = 0; bj < 2; ++bj) { const int col = col0 + bj * HALF;
                    const u32x4 gr = *(const u32x4*)(G + row * ldg + col);
                    f32x4 v0 = acc[ai][bj][m][0], v1 = acc[ai][bj][m][1];
                    v0[0] *= sigmoidf_fast(bf_lo(gr.x)); v0[1] *= sigmoidf_fast(bf_hi(gr.x)); v0[2] *= sigmoidf_fast(bf_lo(gr.y)); v0[3] *= sigmoidf_fast(bf_hi(gr.y));
                    v1[0] *= sigmoidf_fast(bf_lo(gr.z)); v1[1] *= sigmoidf_fast(bf_hi(gr.z)); v1[2] *= sigmoidf_fast(bf_lo(gr.w)); v1[3] *= sigmoidf_fast(bf_hi(gr.w));
                    bf16_t* op = O + row * ldc + col;
                    if (ADD) { const u32x4 pr = *(const u32x4*)op;
                        v0[0] += bf_lo(pr.x); v0[1] += bf_hi(pr.x); v0[2] += bf_lo(pr.y); v0[3] += bf_hi(pr.y);
                        v1[0] += bf_lo(pr.z); v1[1] += bf_hi(pr.z); v1[2] += bf_lo(pr.w); v1[3] += bf_hi(pr.w); }
                    u32x4 w; w.x = cvt_pk_bf16(v0[0], v0[1]); w.y = cvt_pk_bf16(v0[2], v0[3]); w.z = cvt_pk_bf16(v1[0], v1[1]); w.w = cvt_pk_bf16(v1[2], v1[3]);
                    *(u32x4*)op = w; } }
    }
};
struct EpiResF32 {
    static constexpr bool PERM = false, AFTER_DRAIN = false;
    const float* base; float* out; int ldc;
    __device__ __forceinline__ void operator()(const f32x4 (&acc)[2][2][4][2], const Unit& u, int wr, int wc, int fr, int fq) const {
        const int col0 = u.pn * BM + wc * 32 + 4 * fq;
#pragma unroll
        for (int ai = 0; ai < 2; ++ai)
#pragma unroll
            for (int m = 0; m < 4; ++m) { const size_t off = (size_t)(u.pm * BM + ai * HALF + wr * 64 + m * 16 + fr) * ldc + col0;
#pragma unroll
                for (int bj = 0; bj < 2; ++bj)
#pragma unroll
                    for (int n = 0; n < 2; ++n) { const f32x4 bs = *(const f32x4*)(base + off + bj * HALF + n * 16); *(f32x4*)(out + off + bj * HALF + n * 16) = bs + acc[ai][bj][m][n]; } }
    }
};
struct EpiResHG {
    static constexpr bool PERM = false, AFTER_DRAIN = false;
    const float* base; float* out; bf16_t* hg; const float* gain; float* ssp; int ldc;
    __device__ __forceinline__ void operator()(const f32x4 (&acc)[2][2][4][2], const Unit& u, int wr, int wc, int fr, int fq) const {
        const int col0 = u.pn * BM + wc * 32 + 4 * fq;
        f32x4 gv[2][2];
#pragma unroll
        for (int bj = 0; bj < 2; ++bj)
#pragma unroll
            for (int n = 0; n < 2; ++n) gv[bj][n] = *(const f32x4*)(gain + col0 + bj * HALF + n * 16);
#pragma unroll
        for (int ai = 0; ai < 2; ++ai)
#pragma unroll
            for (int m = 0; m < 4; ++m) { const int row = u.pm * BM + ai * HALF + wr * 64 + m * 16 + fr; const size_t off = (size_t)row * ldc + col0; float ss = 0.f;
#pragma unroll
                for (int bj = 0; bj < 2; ++bj)
#pragma unroll
                    for (int n = 0; n < 2; ++n) { const f32x4 h = *(const f32x4*)(base + off + bj * HALF + n * 16) + acc[ai][bj][m][n]; *(f32x4*)(out + off + bj * HALF + n * 16) = h;
                        ss += (h[0] * h[0] + h[1] * h[1]) + (h[2] * h[2] + h[3] * h[3]);
                        const f32x4 hgv = h * gv[bj][n]; u32x2e w; w.x = cvt_pk_bf16(hgv[0], hgv[1]); w.y = cvt_pk_bf16(hgv[2], hgv[3]); *(u32x2e*)(hg + off + bj * HALF + n * 16) = w; }
                ss += __shfl_xor(ss, 16); ss += __shfl_xor(ss, 32);
                if (fq == 0) ssp[(size_t)row * 16 + u.pn * 4 + wc] = ss; }
    }
};
struct EpiKeys {
    static constexpr bool PERM = false, AFTER_DRAIN = false;
    unsigned* O; int ldc;
    __device__ __forceinline__ void operator()(const f32x4 (&acc)[2][2][4][2], const Unit& u, int wr, int wc, int fr, int fq) const {
        const int col0 = u.pn * BM + wc * 32 + 4 * fq;
#pragma unroll
        for (int ai = 0; ai < 2; ++ai)
#pragma unroll
            for (int m = 0; m < 4; ++m) { const size_t off = (size_t)(u.pm * BM + ai * HALF + wr * 64 + m * 16 + fr) * ldc + col0;
#pragma unroll
                for (int bj = 0; bj < 2; ++bj)
#pragma unroll
                    for (int n = 0; n < 2; ++n) { const int nn = (col0 + bj * HALF + n * 16) & 127; const f32x4 a = acc[ai][bj][m][n]; u32x4 w;
                        w.x = (ord_key(a[0]) & ~127u) | (unsigned)(127 - nn); w.y = (ord_key(a[1]) & ~127u) | (unsigned)(126 - nn);
                        w.z = (ord_key(a[2]) & ~127u) | (unsigned)(125 - nn); w.w = (ord_key(a[3]) & ~127u) | (unsigned)(124 - nn);
                        *(u32x4*)(O + off + bj * HALF + n * 16) = w; } }
    }
};

template <class Epi, class Sched, bool ALIGN_EPI = false, bool SP2 = false>
__device__ __forceinline__ void gemm_phase(PG8_LAS unsigned char* lds, const Gemm g, const Sched& S, const Epi& E) {
    int tid_ = threadIdx.x; asm volatile("" : "+v"(tid_));
    const int tid = tid_, wid = __builtin_amdgcn_readfirstlane(tid >> 6), lane = tid & 63, wr = wid >> 2, wc = wid & 3, fr = lane & 15, fq = lane >> 4;
    const int K = g.K, nt = K / BK;
    unsigned voffA[2], voffB[2];
#pragma unroll
    for (int i = 0; i < 2; ++i) { int R, C; stage_rc(tid * 16 + i * 8192, R, C); const int Rb = Epi::PERM ? ((R & ~31) + perm32(R & 31)) : R;
        voffA[i] = (unsigned)(R * g.lda + C) * 2u; voffB[i] = (unsigned)(Rb * g.ldb + C) * 2u; }
    const size_t kstep = (size_t)(BK * 2);
    const size_t hstepA = (size_t)HALF * g.lda * 2, hstepB = (size_t)HALF * g.ldb * 2;
    const size_t tstepA = 2 * hstepA, tstepB = 2 * hstepB;
    const unsigned ldsw = (unsigned)wid * 1024u;
    const int aoff = lds_byte(wr * 64 + fr, fq * 8), boff = lds_byte(wc * 32 + fr, fq * 8);
#define PG8_SA(b, h) (((b) * 2 + (h)) * HTB)
#define PG8_SB(b, h) ((4 + (b) * 2 + (h)) * HTB)
#define PG8_STAGE(bufoff, gbase, voff) do { _Pragma("unroll") for (int _i = 0; _i < 2; ++_i) \
        __builtin_amdgcn_global_load_lds((const unsigned*)((const char*)(gbase) + (voff)[_i]), (PG8_LAS unsigned*)(lds + (bufoff) + ldsw + _i * 8192), 16, 0, 0); } while (0)
#define PG8_LDA(dst, b, h) do { _Pragma("unroll") for (int m = 0; m < 4; ++m) _Pragma("unroll") for (int k = 0; k < 2; ++k) dst[m][k] = *(const PG8_LAS bf16x8*)(lds + PG8_SA(b, h) + aoff + m * 2048 + k * 1024); } while (0)
#define PG8_LDB(dst, b, h) do { _Pragma("unroll") for (int n = 0; n < 2; ++n) _Pragma("unroll") for (int k = 0; k < 2; ++k) dst[n][k] = *(const PG8_LAS bf16x8*)(lds + PG8_SB(b, h) + boff + n * 2048 + k * 1024); } while (0)
#define PG8_MMA(ai, bj, At, Bt) do { __builtin_amdgcn_s_setprio(1); _Pragma("unroll") for (int m = 0; m < 4; ++m) _Pragma("unroll") for (int n = 0; n < 2; ++n) _Pragma("unroll") for (int k = 0; k < 2; ++k) \
        acc[ai][bj][m][n] = __builtin_amdgcn_mfma_f32_16x16x32_bf16(Bt[n][k], At[m][k], acc[ai][bj][m][n], 0, 0, 0); __builtin_amdgcn_s_setprio(0); } while (0)
#define PG8_WAIT_V(n) asm volatile("s_waitcnt vmcnt(" #n ")" ::: "memory")
#define PG8_WAIT_L(n) asm volatile("s_waitcnt lgkmcnt(" #n ")" ::: "memory")
#define PG8_BAR __builtin_amdgcn_s_barrier()
#define PG8_SCHED __builtin_amdgcn_sched_barrier(0)
    Unit cur, nxt; int ui = 0;
    if (!S.next(0, cur)) return;
    f32x4 acc[2][2][4][2];
#pragma unroll
    for (int a = 0; a < 2; ++a)
#pragma unroll
        for (int b = 0; b < 2; ++b)
#pragma unroll
            for (int m = 0; m < 4; ++m)
#pragma unroll
                for (int n = 0; n < 2; ++n) acc[a][b][m][n] = (f32x4){0.f, 0.f, 0.f, 0.f};
    bf16x8 At[4][2], B0[2][2], B1[2][2];
    const char* cA = (const char*)g.A + (size_t)cur.pm * tstepA; const char* cB = (const char*)g.Bt + (size_t)cur.pn * tstepB;
    S.a_ready(cur);
    if constexpr (SP2) {
        PG8_STAGE(PG8_SB(0, 0), cB, voffB); PG8_STAGE(PG8_SB(0, 1), cB + hstepB, voffB); PG8_STAGE(PG8_SA(0, 0), cA, voffA); PG8_STAGE(PG8_SA(0, 1), cA + hstepA, voffA);
        if (wr == 1) PG8_BAR;
        PG8_WAIT_V(2); PG8_BAR;
        PG8_STAGE(PG8_SB(1, 0), cB + kstep, voffB); PG8_STAGE(PG8_SA(1, 0), cA + kstep, voffA); PG8_STAGE(PG8_SB(1, 1), cB + hstepB + kstep, voffB);
        PG8_WAIT_V(6); PG8_BAR;
    } else {
        PG8_STAGE(PG8_SB(0, 0), cB, voffB); PG8_STAGE(PG8_SA(0, 0), cA, voffA); PG8_STAGE(PG8_SB(0, 1), cB + hstepB, voffB); PG8_STAGE(PG8_SA(0, 1), cA + hstepA, voffA);
        if (wr == 1) PG8_BAR;
        PG8_WAIT_V(4); PG8_BAR;
        PG8_STAGE(PG8_SB(1, 0), cB + kstep, voffB); PG8_STAGE(PG8_SA(1, 0), cA + kstep, voffA); PG8_STAGE(PG8_SB(1, 1), cB + hstepB + kstep, voffB);
        PG8_WAIT_V(6); PG8_BAR;
    }
    for (;;) {
        const bool has_next = S.next(ui + 1, nxt);
        const char* nA = has_next ? (const char*)g.A + (size_t)nxt.pm * tstepA : cA; const char* nB = has_next ? (const char*)g.Bt + (size_t)nxt.pn * tstepB : cB;
        for (int t = 0; t < nt; t += 2) {
            const bool last = (t == nt - 2);
            const char* a1 = cA + (size_t)(t + 1) * kstep;
            const char* a2 = last ? nA : cA + (size_t)(t + 2) * kstep; const char* b2 = last ? nB : cB + (size_t)(t + 2) * kstep;
            const char* a3 = a2 + kstep; const char* b3 = b2 + kstep;
            if (last && has_next) S.a_ready(nxt);
            if constexpr (SP2) {
            PG8_LDB(B0, 0, 0); PG8_LDB(B1, 0, 1); PG8_SCHED; PG8_LDA(At, 0, 0); PG8_STAGE(PG8_SA(1, 1), a1 + hstepA, voffA);
            PG8_WAIT_V(8); PG8_WAIT_L(0); PG8_BAR; PG8_MMA(0, 0, At, B0); PG8_MMA(0, 1, At, B1); PG8_BAR; PG8_SCHED;
            PG8_LDA(At, 0, 1); PG8_STAGE(PG8_SB(0, 0), b2, voffB); PG8_STAGE(PG8_SB(0, 1), b2 + hstepB, voffB); PG8_STAGE(PG8_SA(0, 0), a2, voffA);
            PG8_WAIT_V(8); PG8_WAIT_L(0); PG8_BAR; PG8_MMA(1, 0, At, B0); PG8_MMA(1, 1, At, B1); PG8_BAR; PG8_SCHED;
            PG8_LDB(B0, 1, 0); PG8_LDB(B1, 1, 1); PG8_SCHED; PG8_LDA(At, 1, 0); PG8_STAGE(PG8_SA(0, 1), a2 + hstepA, voffA);
            PG8_WAIT_V(8); PG8_WAIT_L(0); PG8_BAR; PG8_MMA(0, 0, At, B0); PG8_MMA(0, 1, At, B1); PG8_BAR; PG8_SCHED;
            PG8_LDA(At, 1, 1); PG8_STAGE(PG8_SB(1, 0), b3, voffB); PG8_STAGE(PG8_SB(1, 1), b3 + hstepB, voffB); PG8_STAGE(PG8_SA(1, 0), a3, voffA);
            PG8_WAIT_V(8); PG8_WAIT_L(0); PG8_BAR; PG8_MMA(1, 0, At, B0); PG8_MMA(1, 1, At, B1); PG8_BAR; PG8_SCHED;
            } else {
            PG8_LDB(B0, 0, 0); PG8_SCHED; PG8_LDA(At, 0, 0); PG8_STAGE(PG8_SA(1, 1), a1 + hstepA, voffA);
            PG8_WAIT_L(8); PG8_BAR; PG8_WAIT_L(0); PG8_MMA(0, 0, At, B0); PG8_BAR; PG8_SCHED;
            PG8_LDB(B1, 0, 1); PG8_STAGE(PG8_SB(0, 0), b2, voffB);
            PG8_BAR; PG8_WAIT_L(0); PG8_MMA(0, 1, At, B1); PG8_BAR;
            PG8_LDA(At, 0, 1); PG8_STAGE(PG8_SA(0, 0), a2, voffA);
            PG8_BAR; PG8_WAIT_L(0); PG8_MMA(1, 0, At, B0); PG8_BAR; PG8_SCHED;
            PG8_STAGE(PG8_SB(0, 1), b2 + hstepB, voffB);
            PG8_WAIT_V(6); PG8_BAR; PG8_MMA(1, 1, At, B1); PG8_BAR;
            PG8_LDB(B0, 1, 0); PG8_SCHED; PG8_LDA(At, 1, 0); PG8_STAGE(PG8_SA(0, 1), a2 + hstepA, voffA);
            PG8_WAIT_L(8); PG8_BAR; PG8_WAIT_L(0); PG8_MMA(0, 0, At, B0); PG8_BAR; PG8_SCHED;
            PG8_LDB(B1, 1, 1); PG8_STAGE(PG8_SB(1, 0), b3, voffB);
            PG8_BAR; PG8_WAIT_L(0); PG8_MMA(0, 1, At, B1); PG8_BAR;
            PG8_LDA(At, 1, 1); PG8_STAGE(PG8_SA(1, 0), a3, voffA);
            PG8_BAR; PG8_WAIT_L(0); PG8_MMA(1, 0, At, B0); PG8_BAR; PG8_SCHED;
            PG8_STAGE(PG8_SB(1, 1), b3 + hstepB, voffB);
            PG8_WAIT_V(6); PG8_BAR; PG8_MMA(1, 1, At, B1); PG8_BAR;
            }
        }
        if constexpr (ALIGN_EPI) { if (wr == 0) PG8_BAR; }
        if constexpr (!Epi::AFTER_DRAIN) { Unit ue = cur; asm volatile("" : "+s"(ue.pm), "+s"(ue.pn));
            E(acc, ue, wr, wc, fr, fq); S.done(cur); }
        if (!has_next) break;
#pragma unroll
        for (int a = 0; a < 2; ++a)
#pragma unroll
            for (int b = 0; b < 2; ++b)
#pragma unroll
                for (int m = 0; m < 4; ++m)
#pragma unroll
                    for (int n = 0; n < 2; ++n) acc[a][b][m][n] = (f32x4){0.f, 0.f, 0.f, 0.f};
        cur = nxt; cA = nA; cB = nB; ++ui;
        if constexpr (ALIGN_EPI) { if (wr == 1) PG8_BAR; }
    }
    PG8_WAIT_V(0);
    if constexpr (!ALIGN_EPI) { if (wr == 0) PG8_BAR; }
    PG8_BAR;
    if constexpr (Epi::AFTER_DRAIN) { E.fused(acc, cur, wr, wc, fr, fq, lds, wid, lane); S.done(cur); }
#undef PG8_SA
#undef PG8_SB
#undef PG8_STAGE
#undef PG8_LDA
#undef PG8_LDB
#undef PG8_MMA
#undef PG8_WAIT_V
#undef PG8_WAIT_L
#undef PG8_BAR
#undef PG8_SCHED
}
}

constexpr int NWAVES = 8;
#ifndef REPEAT_MASK
#define REPEAT_MASK 0
#endif
#ifndef PROBE_SEL2
#define PROBE_SEL2 1
#endif
#ifndef PROBE_NOSEL
#define PROBE_NOSEL 0
#endif
#ifndef MK_PER_PHASE
#define MK_PER_PHASE 0
#endif
constexpr int NPHASE = 14;

constexpr int BATCH = 16, SEQ = 4096, DM = 1024, MTOK = BATCH * SEQ;
constexpr int LDP = 4864;
constexpr int Q_OFF = 0, K_OFF = 512, V_OFF = 1024, QI_OFF = 1536, P_OFF = 2048, GA_OFF = 2560, GP_OFF = 3584, KI_OFF = 4608, WI_OFF = 4672;
constexpr int IN_WIDTH = 4680;
constexpr float EPS = 1e-6f;
constexpr float C2 = 0.125f * 1.4426950408889634f;
constexpr float WI_SCALE = 0.35355339059327373f * 0.125f;

constexpr size_t MiB = 1u << 20;
constexpr size_t WS_CTL = 0, CTL_ZERO_BYTES = 1 * MiB;
constexpr size_t WS_ROPE = 1 * MiB;
constexpr size_t WS_WIN = 2 * MiB;
constexpr size_t WS_WA = 12 * MiB;
constexpr size_t WS_WPP = 13 * MiB;
constexpr size_t WS_WO = 14 * MiB;
constexpr size_t WS_W2 = 16 * MiB;
constexpr size_t WS_SKB = 19 * MiB;
constexpr size_t WS_U16 = 20 * MiB, WS_V16 = 52 * MiB;
constexpr size_t WS_MASK = 84 * MiB;
constexpr size_t WS_POOLED = 116 * MiB;
constexpr size_t WS_ACT = 180 * MiB;
constexpr size_t WS_PROJ = 308 * MiB;
constexpr size_t WS_AO = 916 * MiB;
constexpr size_t WS_REXP = 980 * MiB, WS_RG = 116 * MiB;
constexpr size_t WS_HG = 308 * MiB;
constexpr size_t WS_SUBK = 436 * MiB;
constexpr size_t WS_SSP = 948 * MiB;
constexpr size_t WS_END = 1024 * MiB;
constexpr int CW_TMO = 0, CW_BAR = 4096, CW_AMAX = 12288;

constexpr int RING_BYTES = 131072;
constexpr int LDSCTL_OFF = RING_BYTES, MISC_OFF = LDSCTL_OFF + 320;
constexpr int LDS_BYTES = 147456;

#define GAS __attribute__((address_space(1)))
#define LAS __attribute__((address_space(3)))
typedef unsigned short bf16;
typedef unsigned v4u __attribute__((ext_vector_type(4)));
typedef unsigned v2u __attribute__((ext_vector_type(2)));
typedef float f32x4 __attribute__((ext_vector_type(4)));
typedef float f32x16 __attribute__((ext_vector_type(16)));
typedef short bf16x8 __attribute__((ext_vector_type(8)));
typedef short s16x4 __attribute__((ext_vector_type(4)));
typedef GAS unsigned gu32;
#define RLX_AGENT __ATOMIC_RELAXED, __HIP_MEMORY_SCOPE_AGENT
#define LDS_WAIT() asm volatile("s_waitcnt lgkmcnt(0)" ::: "memory")
#define BAR_LDS() asm volatile("s_waitcnt lgkmcnt(0)\n\ts_barrier" ::: "memory")
#define VM_WAIT() asm volatile("s_waitcnt vmcnt(0)" ::: "memory")
__device__ __forceinline__ unsigned f2bf(float f) { unsigned u = __builtin_bit_cast(unsigned, f); return (u + 0x7fffu + ((u >> 16) & 1u)) >> 16; }
typedef float f32x2k_t __attribute__((ext_vector_type(2))); typedef __bf16 bf16x2k_t __attribute__((ext_vector_type(2)));
__device__ __forceinline__ unsigned pk2(float lo, float hi) { f32x2k_t v = {lo, hi}; bf16x2k_t b = __builtin_convertvector(v, bf16x2k_t); return __builtin_bit_cast(unsigned, b); }
__device__ __forceinline__ float bflo(unsigned w) { return __uint_as_float(w << 16); }
__device__ __forceinline__ float bfhi(unsigned w) { return __uint_as_float(w & 0xffff0000u); }
__device__ __forceinline__ unsigned ordk(float f) { const unsigned b = __float_as_uint(f); return b ^ ((unsigned)((int)b >> 31) | 0x80000000u); }
__device__ __forceinline__ float unordk(unsigned k) { return __uint_as_float((k & 0x80000000u) ? (k ^ 0x80000000u) : ~k); }
__device__ __forceinline__ int crow(int r, int hi) { return (r & 3) + 8 * (r >> 2) + 4 * hi; }
typedef __bf16 bf16x2v_t __attribute__((ext_vector_type(2)));
__device__ __forceinline__ float dot2bf(unsigned a, unsigned b, float acc) { return __builtin_amdgcn_fdot2_f32_bf16(__builtin_bit_cast(bf16x2v_t, a), __builtin_bit_cast(bf16x2v_t, b), acc, false); }

#define XB_TMO      128
#define XB_XCNT(j)  (256  + 64 * (j))
#define XB_XSUB(j)  (1280 + 64 * (j))
#define XB_XGEN(j)  (2304 + 64 * (j))
#define XB_TOP      3328
#define XB_TOPGEN   3392
#define XCD_BAR_WORDS 3456
#define XB_SPIN_CAP (1u << 18)

__device__ __forceinline__ unsigned xb_ld(unsigned* p)              { return __hip_atomic_load(p, __ATOMIC_RELAXED, __HIP_MEMORY_SCOPE_AGENT); }
__device__ __forceinline__ unsigned xb_add(unsigned* p, unsigned v) { return __hip_atomic_fetch_add(p, v, __ATOMIC_RELAXED, __HIP_MEMORY_SCOPE_AGENT); }
__device__ __forceinline__ unsigned xb_xcc_id() { return (unsigned)__builtin_amdgcn_s_getreg((3 << 11) | 20) & 0xFu; }
#define XB_SPIN(cond, bar) do { unsigned _sp = 0; while (cond) { __builtin_amdgcn_s_sleep(1); \
    if ((++_sp & 255u) == 0u) { if (xb_ld(&(bar)[XB_TMO])) break; if (_sp > XB_SPIN_CAP) { atomicAdd(&(bar)[XB_TMO], 1u); break; } } } } while (0)

struct XcdBarrier {
    unsigned* bar; unsigned x;
    volatile LAS unsigned* st;
};

__device__ __forceinline__ XcdBarrier xcd_barrier_post(unsigned* bar, volatile LAS unsigned* st) {
    XcdBarrier b; b.bar = bar; b.x = xb_xcc_id(); b.st = st;
    if (threadIdx.x == 0) (void)xb_add(&bar[XB_XCNT(b.x)], 1u);
    return b;
}
__device__ __forceinline__ void xcd_barrier_complete(unsigned* bar, unsigned x, unsigned& nloc, unsigned& nx) {
    const unsigned G = gridDim.x * gridDim.y * gridDim.z;
    unsigned sum, cnt, mine, sp = 0u;
    for (;;) {
        sum = 0u; cnt = 0u; mine = 0u;
#pragma unroll
        for (unsigned j = 0; j < 16; ++j) { const unsigned c = xb_ld(&bar[XB_XCNT(j)]); sum += c; cnt += (c > 0u) ? 1u : 0u; mine = (j == x) ? c : mine; }
        if (sum == G) break;
        __builtin_amdgcn_s_sleep(1);
        if ((++sp & 255u) == 0u) { if (xb_ld(&bar[XB_TMO])) break; if (sp > XB_SPIN_CAP) { atomicAdd(&bar[XB_TMO], 1u); break; } }
    }
    nloc = mine > 0u ? mine : 1u; nx = cnt > 0u ? cnt : 1u;
}

__device__ __forceinline__ void xcd_barrier(const XcdBarrier& b) {
    asm volatile("s_waitcnt vmcnt(0)" ::: "memory");
    __syncthreads();
    if (threadIdx.x == 0) {
        unsigned* bar = b.bar;
        __builtin_amdgcn_s_waitcnt(0);
        unsigned nloc = b.st[0], nx = b.st[1];
        if (nloc == 0u) { xcd_barrier_complete(bar, b.x, nloc, nx); b.st[0] = nloc; b.st[1] = nx; }
        const unsigned old = xb_add(&bar[XB_XSUB(b.x)], 1u);
        const unsigned gen = old / nloc;
        if (old + 1u == (gen + 1u) * nloc) {
            __builtin_amdgcn_fence(__ATOMIC_RELEASE, "agent");
            asm volatile("s_waitcnt vmcnt(0)" ::: "memory");
            const unsigned og = xb_add(&bar[XB_TOP], 1u);
            const unsigned tg = og / nx;
            if (og + 1u == (tg + 1u) * nx) xb_add(&bar[XB_TOPGEN], 1u);
            else XB_SPIN(xb_ld(&bar[XB_TOPGEN]) == tg, bar);
            __builtin_amdgcn_fence(__ATOMIC_ACQUIRE, "agent");
            xb_add(&bar[XB_XGEN(b.x)], 1u);
            asm volatile("s_waitcnt vmcnt(0)" ::: "memory");
        } else {
            XB_SPIN(xb_ld(&bar[XB_XGEN(b.x)]) == gen, bar);
            __builtin_amdgcn_fence(__ATOMIC_ACQUIRE, "agent");
            asm volatile("s_waitcnt vmcnt(0)" ::: "memory");
        }
    }
    __syncthreads();
}


struct Frame {
    LAS unsigned char* lds;
    volatile LAS unsigned* MISC;
    gu32* ctl;
    unsigned char* ws;
    int tid, lane, wave, vcu, G;
};
struct Args { const float* in[15]; float* out; unsigned char* ws; int ph_lo, ph_hi; };

__device__ __forceinline__ float wave_sum(float v) {
#pragma unroll
    for (int o = 1; o < 64; o <<= 1) v += __shfl_xor(v, o);
    return v;
}

template <class ColMap>
__device__ __forceinline__ void p0_transpose_item(const float* W, int K, int N, bf16* WT, int nblk, LAS float* scr, int item, int lane, ColMap cm) {
    const int kb = item / nblk, nb = item % nblk, k0 = 64 * kb, n0 = 32 * nb;
    const int src = cm(n0 + (lane & 31));
#pragma unroll 8
    for (int i = 0; i < 32; ++i) { const int kk = 2 * i + (lane >> 5); scr[kk * 33 + (lane & 31)] = (src >= 0) ? W[(size_t)(k0 + kk) * N + src] : 0.f; }
    LDS_WAIT(); asm volatile("" ::: "memory");
    const int c = lane & 7;
#pragma unroll
    for (int j = 0; j < 4; ++j) { const int n = (lane >> 3) + 8 * j; const LAS float* s = scr + (8 * c) * 33 + n;
        v4u o; o.x = pk2(s[0 * 33], s[1 * 33]); o.y = pk2(s[2 * 33], s[3 * 33]); o.z = pk2(s[4 * 33], s[5 * 33]); o.w = pk2(s[6 * 33], s[7 * 33]);
        *(GAS v4u*)(WT + (size_t)(n0 + n) * K + k0 + 8 * c) = o; }
    LDS_WAIT(); asm volatile("" ::: "memory");
}
struct MapIdent { __device__ __forceinline__ int operator()(int n) const { return n; } };
struct MapWin { __device__ __forceinline__ int operator()(int n) const {
    if (n < 2048) return n;
    if (n < 2560) return 2120 + (n - 2048);
    if (n < 4608) return 2632 + (n - 2560);
    if (n < 4672) return 2048 + (n - 4608);
    if (n < 4680) return 2112 + (n - 4672);
    return -1; } };

__device__ __forceinline__ void rms_row_to_bf16(const float* xrow, const float* g, bf16* orow, int lane) {
    const GAS f32x4* xr = (const GAS f32x4*)xrow + lane; const GAS f32x4* gr = (const GAS f32x4*)g + lane;
    f32x4 v[4]; float s = 0.f;
#pragma unroll
    for (int j = 0; j < 4; ++j) { v[j] = xr[64 * j]; s += (v[j].x * v[j].x + v[j].y * v[j].y) + (v[j].z * v[j].z + v[j].w * v[j].w); }
    const float rs = 1.0f / sqrtf(wave_sum(s) * (1.f / 1024.f) + EPS);
    GAS unsigned long long* o8 = (GAS unsigned long long*)orow + lane;
#pragma unroll
    for (int j = 0; j < 4; ++j) { const f32x4 gg = gr[64 * j];
        o8[64 * j] = (unsigned long long)pk2(v[j].x * rs * gg.x, v[j].y * rs * gg.y) | ((unsigned long long)pk2(v[j].z * rs * gg.z, v[j].w * rs * gg.w) << 32); }
}

__device__ __forceinline__ void p0_prologue(Frame& F, const Args& AR) {
    LAS float* scr = (LAS float*)(F.lds + F.wave * 16384);
    const int gw = F.vcu * NWAVES + F.wave, NGW = F.G * NWAVES, lane = F.lane;
    constexpr int I_WIN = 16 * 152, I_WA = 8 * 32, I_WO = 16 * 32;
    for (int it = gw; it < I_WIN + I_WA + I_WO; it += NGW) {
        int r = it;
        if (r < I_WIN) { p0_transpose_item((AR.in[2]), 1024, IN_WIDTH, ((bf16*)(F.ws + WS_WIN)), 152, scr, r, lane, MapWin()); continue; } r -= I_WIN;
        if (r < I_WA) { p0_transpose_item((AR.in[7]), 512, 1024, ((bf16*)(F.ws + WS_WA)), 32, scr, r, lane, MapIdent()); continue; } r -= I_WA;
        p0_transpose_item((AR.in[9]), 1024, 1024, ((bf16*)(F.ws + WS_WO)), 32, scr, r, lane, MapIdent());
    }
    for (int it = gw; it < 16 * 64; it += NGW) {
        const int nb = it & 15, kb = it >> 4, n = nb * 64 + lane, k0 = kb * 8, g = k0 >> 7, c0 = k0 & 127;
        float acc[8];
#pragma unroll
        for (int j = 0; j < 8; ++j) acc[j] = 0.f;
        for (int d = 0; d < 128; ++d) {
            const float wv = (AR.in[8])[(size_t)(g * 128 + d) * 1024 + n] * (AR.in[6])[g * 128 + d];
#pragma unroll
            for (int j = 0; j < 8; ++j) acc[j] += (AR.in[5])[(size_t)(g * 128 + c0 + j) * 128 + d] * wv;
        }
        v4u o; o.x = pk2(acc[0], acc[1]); o.y = pk2(acc[2], acc[3]); o.z = pk2(acc[4], acc[5]); o.w = pk2(acc[6], acc[7]);
        *(GAS v4u*)(((bf16*)(F.ws + WS_WPP)) + (size_t)n * 512 + k0) = o;
    }
    for (int it = gw; it < 16 * 32; it += NGW) p0_transpose_item((AR.in[11]), 1024, 1024, ((bf16*)(F.ws + WS_W2)), 32, scr, it, lane, MapIdent());
    for (int it = gw; it < 256; it += NGW) { const size_t e0 = (size_t)it * 512 + lane * 8;
        const f32x4 a = *(const GAS f32x4*)((AR.in[12]) + e0), b = *(const GAS f32x4*)((AR.in[12]) + e0 + 4);
        v4u o; o.x = pk2(a.x, a.y); o.y = pk2(a.z, a.w); o.z = pk2(b.x, b.y); o.w = pk2(b.z, b.w);
        *(GAS v4u*)(((bf16*)(F.ws + WS_SKB)) + e0) = o; }
    {   float mu = 0.f, mv = 0.f;
        for (int it = gw; it < 2 * 32768; it += NGW) {
            const float* src = (it < 32768) ? (AR.in[13]) : (AR.in[14]); const size_t e0 = (size_t)(it & 32767) * 512 + lane * 8;
            const f32x4 a = *(const GAS f32x4*)(src + e0), b = *(const GAS f32x4*)(src + e0 + 4);
            const float m = fmaxf(fmaxf(fmaxf(fabsf(a.x), fabsf(a.y)), fmaxf(fabsf(a.z), fabsf(a.w))), fmaxf(fmaxf(fabsf(b.x), fabsf(b.y)), fmaxf(fabsf(b.z), fabsf(b.w))));
            if (it < 32768) mu = fmaxf(mu, m); else mv = fmaxf(mv, m);
        }
#pragma unroll
        for (int o = 1; o < 64; o <<= 1) { mu = fmaxf(mu, __shfl_xor(mu, o)); mv = fmaxf(mv, __shfl_xor(mv, o)); }
        if (lane == 0) { __hip_atomic_fetch_max(F.ctl + CW_AMAX, __float_as_uint(mu), RLX_AGENT); __hip_atomic_fetch_max(F.ctl + CW_AMAX + 1, __float_as_uint(mv), RLX_AGENT); }
    }
    for (int it = gw * 64 + lane; it < 4096 * 8; it += NGW * 64) {
        const int pos = it >> 3, i = it & 7;
        const float invf = exp2f(-(float)i * 0.125f * 18.931568569324174f);
        const double ang = (double)((float)pos * invf);
        const double kq = __builtin_rint(ang * 0.6366197723675814);
        const float r = (float)(ang - kq * 1.5707963267948966);
        const int q = (int)((long long)kq & 3);
        const float r2 = r * r;
        const float sn = r + r * r2 * (-1.6666654611e-1f + r2 * (8.3321608736e-3f + r2 * (-1.9515295891e-4f)));
        const float cs = 1.0f - 0.5f * r2 + r2 * r2 * (4.166664568298827e-2f + r2 * (-1.388731625493765e-3f + r2 * 2.443315711809948e-5f));
        const float s = (q == 0) ? sn : (q == 1) ? cs : (q == 2) ? -sn : -cs;
        const float c = (q == 0) ? cs : (q == 1) ? -sn : (q == 2) ? -cs : sn;
        ((float*)(F.ws + WS_ROPE))[pos * 16 + i] = c; ((float*)(F.ws + WS_ROPE))[pos * 16 + 8 + i] = s;
    }
    for (int m = gw; m < MTOK; m += NGW) rms_row_to_bf16((AR.in[0]) + (size_t)m * DM, (AR.in[1]), ((bf16*)(F.ws + WS_ACT)) + (size_t)m * DM, lane);
}

__device__ __forceinline__ void unpack8(const v4u w, float (&v)[8]) { v[0] = bflo(w.x); v[1] = bfhi(w.x); v[2] = bflo(w.y); v[3] = bfhi(w.y); v[4] = bflo(w.z); v[5] = bfhi(w.z); v[6] = bflo(w.w); v[7] = bfhi(w.w); }
__device__ __forceinline__ v4u pack8(const float (&v)[8]) { v4u o; o.x = pk2(v[0], v[1]); o.y = pk2(v[2], v[3]); o.z = pk2(v[4], v[5]); o.w = pk2(v[6], v[7]); return o; }
__device__ __forceinline__ void rope8(float (&v)[8], int sub, const float (&cs)[8], const float (&sn)[8]) {
    float pv[8];
#pragma unroll
    for (int j = 0; j < 8; ++j) pv[j] = __shfl_xor(v[j], 1);
    if (sub == 0) {
#pragma unroll
        for (int j = 0; j < 8; ++j) v[j] = v[j] * cs[j] - pv[j] * sn[j];
    } else if (sub == 1) {
#pragma unroll
        for (int j = 0; j < 8; ++j) v[j] = v[j] * cs[j] + pv[j] * sn[j];
    }
}
__device__ __forceinline__ float fp8_scale(unsigned amax_bits) { const unsigned be = (amax_bits >> 23) & 0xffu; return (be == 0u || be > 250u) ? 1.0f : __uint_as_float((261u - be) << 23); }
__device__ __forceinline__ float fp8_inv_scale(unsigned amax_bits) { const unsigned be = (amax_bits >> 23) & 0xffu; return (be == 0u || be > 250u) ? 1.0f : __uint_as_float((be - 7u) << 23); }
__device__ __forceinline__ void row_to_fp8(const float* src, unsigned char* dst, float sc, int lane) {
    const GAS f32x4* p = (const GAS f32x4*)src + lane * 4; v4u o;
#pragma unroll
    for (int q = 0; q < 4; ++q) { const f32x4 a = p[q]; int w = 0; w = __builtin_amdgcn_cvt_pk_fp8_f32(a.x * sc, a.y * sc, w, false); w = __builtin_amdgcn_cvt_pk_fp8_f32(a.z * sc, a.w * sc, w, true); o[q] = (unsigned)w; }
    *(GAS v4u*)(dst + lane * 16) = o;
}
__device__ __forceinline__ void fixup_token(Frame& F, const Args& AR, int tok) {
    const int lane = F.lane, sub = lane & 7, pos = tok & (SEQ - 1);
    bf16* row = ((bf16*)(F.ws + WS_PROJ)) + (size_t)tok * LDP;
    float cs[8], sn[8];
    { const GAS f32x4* rt = (const GAS f32x4*)(((float*)(F.ws + WS_ROPE)) + pos * 16); const f32x4 a = rt[0], b = rt[1], c = rt[2], d = rt[3];
      cs[0] = a.x; cs[1] = a.y; cs[2] = a.z; cs[3] = a.w; cs[4] = b.x; cs[5] = b.y; cs[6] = b.z; cs[7] = b.w;
      sn[0] = c.x; sn[1] = c.y; sn[2] = c.z; sn[3] = c.w; sn[4] = d.x; sn[5] = d.y; sn[6] = d.z; sn[7] = d.w; }
#pragma unroll
    for (int which = 0; which < 2; ++which) {
        GAS v4u* p = (GAS v4u*)(row + (which ? K_OFF : Q_OFF) + lane * 8);
        float v[8]; unpack8(*p, v);
        float ss = 0.f;
#pragma unroll
        for (int j = 0; j < 8; ++j) ss += v[j] * v[j];
        ss += __shfl_xor(ss, 1); ss += __shfl_xor(ss, 2); ss += __shfl_xor(ss, 4);
        const float rs = 1.0f / sqrtf(ss * (1.f / 64.f) + EPS);
        const float* g = (which ? (AR.in[4]) : (AR.in[3])) + sub * 8;
#pragma unroll
        for (int j = 0; j < 8; ++j) v[j] = v[j] * rs * g[j];
        rope8(v, sub, cs, sn);
        if (which == 0) {
#pragma unroll
            for (int j = 0; j < 8; ++j) v[j] *= C2;
        }
        *p = pack8(v);
    }
    { GAS v4u* p = (GAS v4u*)(row + QI_OFF + lane * 8); float v[8]; unpack8(*p, v); rope8(v, sub, cs, sn); *p = pack8(v); }
    { GAS v4u* p = (GAS v4u*)(row + KI_OFF + (lane & 7) * 8); float v[8]; unpack8(*p, v); rope8(v, sub, cs, sn); if (lane < 8) *p = pack8(v); }
    { const int g = lane >> 4, w = 2 << g;
      float acc[8], cur[8];
#pragma unroll
      for (int j = 0; j < 8; ++j) acc[j] = 0.f;
      unpack8(*(const GAS v4u*)(row + P_OFF + lane * 8), cur);
#pragma unroll
      for (int j = 0; j < 8; ++j) acc[j] = cur[j];
#pragma unroll
      for (int back = 1; back < 16; ++back) {
          if (back < w && back <= pos) { float t[8]; unpack8(*(const GAS v4u*)(row - (size_t)back * LDP + P_OFF + lane * 8), t);
#pragma unroll
              for (int j = 0; j < 8; ++j) acc[j] += t[j]; }
      }
      const float inv = 1.0f / (float)((pos + 1 < w) ? (pos + 1) : w);
      float o[8];
#pragma unroll
      for (int j = 0; j < 8; ++j) o[j] = acc[j] * inv - cur[j];
      *(GAS v4u*)(((bf16*)(F.ws + WS_POOLED)) + (size_t)tok * 512 + lane * 8) = pack8(o); }
}

__device__ __forceinline__ int wave_incl_scan(int v) {
    v += __builtin_amdgcn_update_dpp(0, v, 0x111, 0xf, 0xf, false);
    v += __builtin_amdgcn_update_dpp(0, v, 0x112, 0xf, 0xf, false);
    v += __builtin_amdgcn_update_dpp(0, v, 0x114, 0xf, 0xf, false);
    v += __builtin_amdgcn_update_dpp(0, v, 0x118, 0xf, 0xf, false);
    v += __builtin_amdgcn_update_dpp(0, v, 0x142, 0xa, 0xf, false);
    v += __builtin_amdgcn_update_dpp(0, v, 0x143, 0xc, 0xf, false);
    return v;
}
template <int NB> __device__ __forceinline__ void hist_search(const LAS unsigned* hist, int need, int lane, int& B, int& G, int& E) {
    constexpr int PER = NB / 64;
    int t = 0;
#pragma unroll
    for (int q = 0; q < PER / 4; ++q) { const v4u h = *(const LAS v4u*)(hist + lane * PER + 4 * q); t += (int)(h.x + h.y + h.z + h.w); }
    const int pfx = wave_incl_scan(t);
    const int L = __ffsll((long long)__ballot(pfx >= need)) - 1;
    const int base = __builtin_amdgcn_readlane(pfx, L) - __builtin_amdgcn_readlane(t, L);
    const int hv = (lane < PER) ? (int)hist[L * PER + lane] : 0;
    const int p2 = wave_incl_scan(hv) + base;
    const int i = __ffsll((long long)__ballot(p2 >= need)) - 1;
    B = L * PER + i; E = __builtin_amdgcn_readlane(hv, i); G = __builtin_amdgcn_readlane(p2, i) - E;
}
template <int NB> __device__ __forceinline__ void hist_zero(LAS unsigned* hist, int lane) {
#pragma unroll
    for (int q = 0; q < NB / 256; ++q) *(LAS v4u*)(hist + q * 256 + lane * 4) = (v4u){0u, 0u, 0u, 0u};
}
#define HIST_ADD(p) (void)__hip_atomic_fetch_add((p), 1u, __ATOMIC_RELAXED, __HIP_MEMORY_SCOPE_WORKGROUP)
#define wlane(dst, sval, j) asm volatile("s_nop 3\n\tv_writelane_b32 %0, %1, %2\n\ts_nop 1" : "+v"(dst) : "s"(sval), "i"(j))
__device__ __forceinline__ void select_row(const unsigned short* srow  , LAS unsigned* hist, int nj, int lastw, GAS unsigned long long* mout, int lane) {
    unsigned key[64];
#pragma unroll
    for (int g = 0; g < 8; ++g) {
        if (nj > 8 * g) {
#pragma unroll
            for (int jj = 0; jj < 8; ++jj) key[8 * g + jj] = ordk(__uint_as_float((unsigned)((const GAS unsigned short*)srow)[(64 * (8 * g + jj) + lane) * 8] << 16) + 0.0f);
        } else {
#pragma unroll
            for (int jj = 0; jj < 8; ++jj) key[8 * g + jj] = 0u;
        }
    }
    LDS_WAIT(); asm volatile("" ::: "memory");
    int need = 256, B, G, E;
    hist_zero<2048>(hist, lane); LDS_WAIT(); asm volatile("" ::: "memory");
#pragma unroll
    for (int g = 0; g < 8; ++g) if (nj > 8 * g) {
#pragma unroll
        for (int jj = 0; jj < 8; ++jj) HIST_ADD(hist + (2047u - (key[8 * g + jj] >> 21)));
    }
    LDS_WAIT(); asm volatile("" ::: "memory");
    hist_search<2048>(hist, need, lane, B, G, E); need -= G;
    const unsigned d1 = 2047u - (unsigned)B;
    asm volatile("" ::: "memory"); hist_zero<2048>(hist, lane); LDS_WAIT(); asm volatile("" ::: "memory");
#pragma unroll
    for (int g = 0; g < 8; ++g) if (nj > 8 * g) {
#pragma unroll
        for (int jj = 0; jj < 8; ++jj) { const unsigned k = key[8 * g + jj]; if ((k >> 21) == d1) HIST_ADD(hist + (2047u - ((k >> 10) & 0x7ffu))); }
    }
    LDS_WAIT(); asm volatile("" ::: "memory");
    hist_search<2048>(hist, need, lane, B, G, E); need -= G;
    const unsigned pre2 = (d1 << 11) | (2047u - (unsigned)B);
    const unsigned v = pre2 << 10;
    unsigned mlo = 0u, mhi = 0u;
#pragma unroll
    for (int g = 0; g < 8; ++g) {
        asm volatile("v_cmp_ge_u32_e64 s[40:41], %2, %10\n\tv_cmp_ge_u32_e64 s[42:43], %3, %10\n\tv_cmp_ge_u32_e64 s[44:45], %4, %10\n\tv_cmp_ge_u32_e64 s[46:47], %5, %10\n\t"
                     "v_cmp_ge_u32_e64 s[48:49], %6, %10\n\tv_cmp_ge_u32_e64 s[50:51], %7, %10\n\tv_cmp_ge_u32_e64 s[52:53], %8, %10\n\tv_cmp_ge_u32_e64 s[54:55], %9, %10\n\ts_nop 1\n\t"
                     "v_writelane_b32 %0, s40, %11\n\tv_writelane_b32 %1, s41, %11\n\tv_writelane_b32 %0, s42, %12\n\tv_writelane_b32 %1, s43, %12\n\t"
                     "v_writelane_b32 %0, s44, %13\n\tv_writelane_b32 %1, s45, %13\n\tv_writelane_b32 %0, s46, %14\n\tv_writelane_b32 %1, s47, %14\n\t"
                     "v_writelane_b32 %0, s48, %15\n\tv_writelane_b32 %1, s49, %15\n\tv_writelane_b32 %0, s50, %16\n\tv_writelane_b32 %1, s51, %16\n\t"
                     "v_writelane_b32 %0, s52, %17\n\tv_writelane_b32 %1, s53, %17\n\tv_writelane_b32 %0, s54, %18\n\tv_writelane_b32 %1, s55, %18\n\ts_nop 1"
                     : "+v"(mlo), "+v"(mhi)
                     : "v"(key[8 * g]), "v"(key[8 * g + 1]), "v"(key[8 * g + 2]), "v"(key[8 * g + 3]), "v"(key[8 * g + 4]), "v"(key[8 * g + 5]), "v"(key[8 * g + 6]), "v"(key[8 * g + 7]), "v"(v),
                       "i"(8 * g), "i"(8 * g + 1), "i"(8 * g + 2), "i"(8 * g + 3), "i"(8 * g + 4), "i"(8 * g + 5), "i"(8 * g + 6), "i"(8 * g + 7)
                     : "s40", "s41", "s42", "s43", "s44", "s45", "s46", "s47", "s48", "s49", "s50", "s51", "s52", "s53", "s54", "s55");
    }
    int drop = E - need;
#pragma unroll
    for (int j = 63; j >= 0; --j) {
        if (drop > 0) {
            unsigned long long eq = __ballot(key[j] == v);
            if (eq != 0ull) {
                unsigned long long rem = 0ull;
                while (drop > 0 && eq != 0ull) { const unsigned long long hb = 1ull << (63 - __clzll((long long)eq)); rem |= hb; eq ^= hb; --drop; }
                const unsigned long long m = __ballot(key[j] >= v) & ~rem;
                wlane(mlo, (unsigned)m, j); wlane(mhi, (unsigned)(m >> 32), j);
            }
        }
    }
    if (lane <= lastw) mout[lane] = ((unsigned long long)mhi << 32) | (unsigned long long)mlo;
    LDS_WAIT(); asm volatile("" ::: "memory");
}

__device__ __forceinline__ float* wave_scratch(unsigned char* ws, int gwv) {
    if (gwv < 1024) return (float*)(ws + WS_ACT) + (size_t)gwv * 32768;
    gwv -= 1024; if (gwv < 512) return (float*)(ws + WS_AO) + (size_t)gwv * 32768;
    gwv -= 512; if (gwv < 352) return (float*)(ws + 980 * MiB) + (size_t)gwv * 32768;
    gwv -= 352; if (gwv < 128) return (float*)(ws + 36 * MiB) + (size_t)gwv * 32768;
    gwv -= 128; return (float*)(ws + 68 * MiB) + (size_t)(gwv & 127) * 32768;
}
__device__ __forceinline__ void idx_unit(Frame& F, const Args& AR, int b, int c, bool do_select = true) {
    const int lane = F.lane, wid = F.wave, l31 = lane & 31, h2 = lane >> 5;
    const size_t rowb = (size_t)b * SEQ, tp0 = rowb + (size_t)c * 64 + wid * 8;
    GAS unsigned long long* mbase = (GAS unsigned long long*)(((unsigned long long*)(F.ws + WS_MASK)) + tp0 * 64);
    if (c < 4) {
        if (lane < 32) { const int q = lane >> 2, j = lane & 3; mbase[q * 64 + j] = (j <= c) ? ~0ull : 0ull; }
        return;
    }
    unsigned short* sc = (unsigned short*)wave_scratch(F.ws, F.vcu * NWAVES + wid);
    LAS unsigned* hist = (LAS unsigned*)(F.lds + wid * 8192);
    const int ntile = 2 * (c + 1), nj = c + 1, lastw = c | 3, ntile_pad = 16 * ((nj + 7) >> 3);
    const int head = (l31 & 3) | (((l31 >> 3) & 1) << 2), qsub = ((l31 >> 2) & 1) | (((l31 >> 4) & 1) << 1);
    bf16x8 a[2][4]; float w[2][16];
#pragma unroll
    for (int rb = 0; rb < 2; ++rb) {
        const bf16* ap = ((bf16*)(F.ws + WS_PROJ)) + (tp0 + 4 * rb + qsub) * LDP + QI_OFF + head * 64 + h2 * 8;
#pragma unroll
        for (int st = 0; st < 4; ++st) a[rb][st] = *(const GAS bf16x8*)(ap + st * 16);
        const v4u wa = *(const GAS v4u*)(((bf16*)(F.ws + WS_PROJ)) + (tp0 + 4 * rb + h2) * LDP + WI_OFF), wb = *(const GAS v4u*)(((bf16*)(F.ws + WS_PROJ)) + (tp0 + 4 * rb + h2 + 2) * LDP + WI_OFF);
        float t[8]; unpack8(wa, t);
#pragma unroll
        for (int j = 0; j < 8; ++j) w[rb][j] = t[j] * WI_SCALE;
        unpack8(wb, t);
#pragma unroll
        for (int j = 0; j < 8; ++j) w[rb][8 + j] = t[j] * WI_SCALE;
    }
    {
        LAS unsigned char* kb = F.lds + 65536;
        const int nstage = (ntile + 3) >> 2;
        const int sk0 = F.tid >> 3, sch = F.tid & 7;
        const bf16* kg = ((bf16*)(F.ws + WS_PROJ)) + (rowb + sk0) * LDP + KI_OFF + sch * 8;
        v4u r0 = *(const GAS v4u*)kg, r1 = *(const GAS v4u*)(kg + (size_t)64 * LDP);
#pragma unroll 1
        for (int sg = 0; sg < nstage; ++sg) {
            LAS unsigned char* cur = kb + (sg & 1) * 18432;
            *(LAS v4u*)(cur + sk0 * 144 + sch * 16) = r0; *(LAS v4u*)(cur + (sk0 + 64) * 144 + sch * 16) = r1;
            BAR_LDS();
            { const int sn = (sg + 1 < nstage) ? sg + 1 : sg; r0 = *(const GAS v4u*)(kg + (size_t)sn * 128 * LDP); r1 = *(const GAS v4u*)(kg + (size_t)(sn * 128 + 64) * LDP); }
#pragma unroll
            for (int t4 = 0; t4 < 4; ++t4) {
                const int kt = 4 * sg + t4;
                if (kt < ntile) {
                    bf16x8 bfr[4];
#pragma unroll
                    for (int st = 0; st < 4; ++st) bfr[st] = *(const LAS bf16x8*)(cur + (t4 * 32 + l31) * 144 + st * 32 + h2 * 16);
                    float sq[4];
#pragma unroll
                    for (int rb = 0; rb < 2; ++rb) {
                        f32x16 acc;
#pragma unroll
                        for (int r = 0; r < 16; ++r) acc[r] = 0.f;
#pragma unroll
                        for (int st = 0; st < 4; ++st) acc = __builtin_amdgcn_mfma_f32_32x32x16_bf16(a[rb][st], bfr[st], acc, 0, 0, 0);
                        float s0 = 0.f, s1 = 0.f;
#pragma unroll
                        for (int r = 0; r < 8; ++r) { s0 = fmaf(w[rb][r], fmaxf(acc[r], 0.f), s0); s1 = fmaf(w[rb][8 + r], fmaxf(acc[8 + r], 0.f), s1); }
                        sq[2 * rb] = s0; sq[2 * rb + 1] = s1;
                    }
                    *(GAS v2u*)(sc + (size_t)(kt * 32 + l31) * 8 + 4 * h2) = (v2u){pk2(sq[0], sq[1]), pk2(sq[2], sq[3])};
                }
            }
        }
        for (int kt = ntile; kt < ntile_pad; ++kt)
            *(GAS v2u*)(sc + (size_t)(kt * 32 + l31) * 8 + 4 * h2) = (v2u){0xff80ff80u, 0xff80ff80u};
    }
    VM_WAIT();
    if (do_select) {
#pragma unroll 1
        for (int q = 0; q < 8 * PROBE_SEL2; ++q) select_row(sc + 4 * (q & 1) + ((q & 7) >> 1), hist, nj, lastw, mbase + (q & 7) * 64, lane);
    }
}

__device__ __forceinline__ void attn_unit(Frame& F, const Args& AR, int b, int h, int qb) {
    const int lane = F.lane, wid = F.wave, l31 = lane & 31, h2 = lane >> 5;
    LAS unsigned char* Ks = F.lds;
    LAS float* wsf = (LAS float*)(F.lds + 2 * 17408) + wid * 32;
    const size_t rowb = (size_t)b * SEQ, tok0 = rowb + (size_t)qb * 256 + wid * 32;
    bf16x8 qf[4];
    { const bf16* qp = ((bf16*)(F.ws + WS_PROJ)) + (tok0 + l31) * LDP + Q_OFF + h * 64 + h2 * 8;
#pragma unroll
      for (int st = 0; st < 4; ++st) qf[st] = *(const GAS bf16x8*)(qp + st * 16); }
    const int NT = 4 * (qb + 1), cw = qb * 4 + (wid >> 1);
    f32x16 o0, o1;
#pragma unroll
    for (int r = 0; r < 16; ++r) { o0[r] = 0.f; o1[r] = 0.f; }
    float lsum = 0.f;
    const int skey = F.tid >> 3, sch = F.tid & 7;
    const bf16* kg = ((bf16*)(F.ws + WS_PROJ)) + (rowb + skey) * LDP + K_OFF + h * 64 + sch * 8;
    const bf16* vg = ((bf16*)(F.ws + WS_PROJ)) + (rowb + skey) * LDP + V_OFF + h * 64 + sch * 8;
    const unsigned kst = skey * 144 + sch * 16, vst = skey * 128 + ((sch * 16) ^ (((skey >> 1) & 1) << 6));
    const GAS unsigned long long* mrow = (const GAS unsigned long long*)(((unsigned long long*)(F.ws + WS_MASK)) + (tok0 + l31) * 64);
    const int i16 = lane & 15, qq = i16 >> 2, pp = i16 & 3, blk = (lane >> 4) & 1;
    const unsigned vrd = (unsigned)((4 * h2 + qq) * 128 + ((32 * blk + 8 * pp) ^ (((qq >> 1) & 1) << 6)));
    v4u kr[3], vr[3];
#pragma unroll
    for (int u = 0; u < 3; ++u) { kr[u] = *(const GAS v4u*)(kg + (size_t)u * 64 * LDP); vr[u] = *(const GAS v4u*)(vg + (size_t)u * 64 * LDP); }
    unsigned long long mwn = mrow[0];
#pragma unroll 1
    for (int t = 0; t < NT; t += 3) {
#pragma unroll
        for (int u = 0; u < 3; ++u) {
            const int tt = t + u;
            if (tt < NT) {
                LAS unsigned char* Kc = Ks + (tt & 1) * 17408; LAS unsigned char* Vc = Kc + 9216;
                *(LAS v4u*)(Kc + kst) = kr[u]; *(LAS v4u*)(Vc + vst) = vr[u];
                BAR_LDS();
                { const int tn = (tt + 3 < NT) ? tt + 3 : NT - 1;
                  kr[u] = *(const GAS v4u*)(kg + (size_t)tn * 64 * LDP); vr[u] = *(const GAS v4u*)(vg + (size_t)tn * 64 * LDP); }
                const unsigned long long mw = mwn;
                mwn = mrow[(tt + 1 < NT) ? tt + 1 : tt];
                if (tt <= cw) {
                    bf16x8 vfr[2][2][2];
        #pragma unroll
                    for (int kb = 0; kb < 2; ++kb)
        #pragma unroll
                        for (int s = 0; s < 2; ++s)
        #pragma unroll
                            for (int d0 = 0; d0 < 2; ++d0) {
                                const unsigned ad = (vrd + (unsigned)((32 * kb + 16 * s) * 128)) ^ (unsigned)(d0 << 6);
                                const s16x4 lo = __builtin_bit_cast(s16x4, __builtin_amdgcn_ds_read_tr16_b64_v4i16((LAS s16x4*)(Vc + ad)));
                                const s16x4 hi = __builtin_bit_cast(s16x4, __builtin_amdgcn_ds_read_tr16_b64_v4i16((LAS s16x4*)(Vc + ad + 8 * 128)));
                                vfr[kb][s][d0] = (bf16x8){lo[0], lo[1], lo[2], lo[3], hi[0], hi[1], hi[2], hi[3]};
                            }
                    f32x16 p[2];
        #pragma unroll
                    for (int kb = 0; kb < 2; ++kb) {
                        f32x16 acc;
        #pragma unroll
                        for (int r = 0; r < 16; ++r) acc[r] = 0.f;
        #pragma unroll
                        for (int st = 0; st < 4; ++st) { const bf16x8 ka = *(const LAS bf16x8*)(Kc + (32 * kb + l31) * 144 + st * 32 + h2 * 16); acc = __builtin_amdgcn_mfma_f32_32x32x16_bf16(ka, qf[st], acc, 0, 0, 0); }
                        const unsigned wk = (kb ? (unsigned)(mw >> 32) : (unsigned)mw) >> (4 * h2);
        #pragma unroll
                        for (int r = 0; r < 16; ++r) {
                            const float e = __builtin_amdgcn_exp2f(acc[r]);
                            const int m = __builtin_amdgcn_sbfe((int)wk, (r & 3) + 8 * (r >> 2), 1);
                            const float pe = __uint_as_float(__float_as_uint(e) & (unsigned)m);
                            acc[r] = pe;
                        }
                        p[kb] = acc;
                    }
        #pragma unroll
                    for (int kb = 0; kb < 2; ++kb)
        #pragma unroll
                        for (int s = 0; s < 2; ++s) {
                            v4u pw; pw.x = pg8::cvt_pk_bf16(p[kb][8 * s + 0], p[kb][8 * s + 1]); pw.y = pg8::cvt_pk_bf16(p[kb][8 * s + 2], p[kb][8 * s + 3]); pw.z = pg8::cvt_pk_bf16(p[kb][8 * s + 4], p[kb][8 * s + 5]); pw.w = pg8::cvt_pk_bf16(p[kb][8 * s + 6], p[kb][8 * s + 7]);
                            lsum = dot2bf(pw.x, 0x3f803f80u, lsum); lsum = dot2bf(pw.y, 0x3f803f80u, lsum); lsum = dot2bf(pw.z, 0x3f803f80u, lsum); lsum = dot2bf(pw.w, 0x3f803f80u, lsum);
                            const bf16x8 pa = __builtin_bit_cast(bf16x8, pw);
        #pragma unroll
                            for (int d0 = 0; d0 < 2; ++d0) {
                                const bf16x8 vb = vfr[kb][s][d0];
                                if (d0 == 0) o0 = __builtin_amdgcn_mfma_f32_32x32x16_bf16(pa, vb, o0, 0, 0, 0); else o1 = __builtin_amdgcn_mfma_f32_32x32x16_bf16(pa, vb, o1, 0, 0, 0);
                            }
                        }
                }
            }
        }
    }
    lsum += __shfl_xor(lsum, 32);
    if (h2 == 0) wsf[l31] = lsum;
    LDS_WAIT(); asm volatile("" ::: "memory");
    bf16* op = ((bf16*)(F.ws + WS_AO)) + tok0 * 512 + h * 64 + l31;
#pragma unroll
    for (int r = 0; r < 16; ++r) { const int q = crow(r, h2); const float rl = 1.0f / wsf[q];
        op[(size_t)q * 512] = (bf16)f2bf(o0[r] * rl); op[(size_t)q * 512 + 32] = (bf16)f2bf(o1[r] * rl); }
    LDS_WAIT(); asm volatile("" ::: "memory");
}

__device__ __forceinline__ float row_rs(const float* ssp, size_t tok) {
    const GAS f32x4* p = (const GAS f32x4*)(ssp + tok * 16); const f32x4 a = p[0], b = p[1], c = p[2], d = p[3];
    const float ss = ((a.x + a.y) + (a.z + a.w)) + ((b.x + b.y) + (b.z + b.w)) + ((c.x + c.y) + (c.z + c.w)) + ((d.x + d.y) + (d.z + d.w));
    return 1.0f / sqrtf(ss * (1.f / 1024.f) + EPS);
}
__device__ __forceinline__ void sort16_desc(unsigned (&a)[16]) {
#pragma unroll
    for (int k = 2; k <= 16; k <<= 1)
#pragma unroll
        for (int j = k >> 1; j > 0; j >>= 1)
#pragma unroll
            for (int i = 0; i < 16; ++i) { const int l = i ^ j; if (l > i) { const unsigned hi = a[i] > a[l] ? a[i] : a[l], lo = a[i] > a[l] ? a[l] : a[i];
                if ((i & k) == 0) { a[i] = hi; a[l] = lo; } else { a[i] = lo; a[l] = hi; } } }
}
__device__ __forceinline__ void merge16_desc(unsigned (&top)[16], const unsigned (&a)[16]) {
#pragma unroll
    for (int i = 0; i < 16; ++i) top[i] = top[i] > a[15 - i] ? top[i] : a[15 - i];
#pragma unroll
    for (int j = 8; j > 0; j >>= 1)
#pragma unroll
        for (int i = 0; i < 16; ++i) { const int l = i ^ j; if (l > i) { const unsigned hi = top[i] > top[l] ? top[i] : top[l], lo = top[i] > top[l] ? top[l] : top[i]; top[i] = hi; top[l] = lo; } }
}
struct PairTab { int i[64], j[64]; };
constexpr PairTab make_pairs() { PairTab t{}; int n = 0; for (int i = 0; i < 16; ++i) for (int j = 0; j < 16; ++j) if ((i + 1) * (j + 1) <= 16) { t.i[n] = i; t.j[n] = j; ++n; } for (; n < 64; ++n) { t.i[n] = -1; t.j[n] = -1; } return t; }
__device__ __forceinline__ void route_task(Frame& F, const Args& AR, int tt, int h) {
    const int lane = F.lane, l31 = lane & 31, h2 = lane >> 5;
    const size_t tok = (size_t)tt * 32 + l31;
    LAS unsigned* lk = (LAS unsigned*)F.lds;
    unsigned KA[16], KB[16];
#pragma unroll
    for (int i = 0; i < 16; ++i) { KA[i] = 0u; KB[i] = 0u; }
#pragma unroll 1
    for (int p = 0; p < 2; ++p) {
        const int hp = 2 * h + p;
        bf16x8 bq[4];
        { const bf16* qp = ((const bf16*)(F.ws + WS_SUBK)) + tok * 1024 + hp * 64 + h2 * 8;
#pragma unroll
          for (int st = 0; st < 4; ++st) bq[st] = *(const GAS bf16x8*)(qp + st * 16); }
        unsigned top[16];
#pragma unroll
        for (int i = 0; i < 16; ++i) top[i] = 0u;
#pragma unroll 1
        for (int blk = 0; blk < 4; ++blk) {
            const bf16* ap = ((const bf16*)(F.ws + WS_SKB)) + (size_t)(hp * 128 + 32 * blk + l31) * 64 + h2 * 8;
            f32x16 acc;
#pragma unroll
            for (int r = 0; r < 16; ++r) acc[r] = 0.f;
#pragma unroll
            for (int st = 0; st < 4; ++st) { const bf16x8 af = *(const GAS bf16x8*)(ap + st * 16); acc = __builtin_amdgcn_mfma_f32_32x32x16_bf16(af, bq[st], acc, 0, 0, 0); }
            unsigned a16[16];
#pragma unroll
            for (int r = 0; r < 16; ++r) a16[r] = (ordk(acc[r]) & ~127u) | (unsigned)(127 - (32 * blk + (r & 3) + 8 * (r >> 2)) - 4 * h2);
            sort16_desc(a16);
            merge16_desc(top, a16);
        }
        unsigned oth[16];
#pragma unroll
        for (int i = 0; i < 16; ++i) oth[i] = __shfl_xor(top[i], 32);
        merge16_desc(top, oth);
#pragma unroll
        for (int i = 0; i < 16; ++i) { if (p == 0) KA[i] = top[i]; else KB[i] = top[i]; }
    }
    float sa[16], sb[16];
#pragma unroll
    for (int i = 0; i < 16; ++i) { sa[i] = unordk(KA[i] & ~127u); sb[i] = unordk(KB[i] & ~127u); lk[i * 512 + F.tid] = KA[i]; lk[(16 + i) * 512 + F.tid] = KB[i]; }
    unsigned ck[16];
#pragma unroll
    for (int grp = 0; grp < 4; ++grp) {
        unsigned a[16];
#pragma unroll
        for (int q = 0; q < 16; ++q) { constexpr PairTab T = make_pairs(); const int pi = T.i[grp * 16 + q], pj = T.j[grp * 16 + q];
            a[q] = (pi < 0) ? 0u : ((ordk(sa[pi < 0 ? 0 : pi] + sb[pj < 0 ? 0 : pj]) & ~255u) | (unsigned)(255 - (pi * 16 + pj))); }
        sort16_desc(a);
        if (grp == 0) {
#pragma unroll
            for (int i = 0; i < 16; ++i) ck[i] = a[i];
        } else merge16_desc(ck, a);
    }
    LDS_WAIT(); asm volatile("" ::: "memory");
    unsigned ce[16];
#pragma unroll
    for (int t = 0; t < 16; ++t) { const unsigned flat = 255u - (ck[t] & 255u); const unsigned ka = lk[(flat >> 4) * 512 + F.tid], kb = lk[(16u + (flat & 15u)) * 512 + F.tid];
        ce[t] = (127u - (ka & 127u)) * 128u + (127u - (kb & 127u)); }
    LDS_WAIT(); asm volatile("" ::: "memory");
    float ts[16]; float sum = 0.f; const float mx = unordk(ck[0] & ~255u);
    const float rsl = row_rs((const float*)(F.ws + WS_SSP), tok) * 1.4426950408889634f;
#pragma unroll
    for (int t = 0; t < 16; ++t) { ts[t] = __builtin_amdgcn_exp2f((unordk(ck[t] & ~255u) - mx) * rsl); sum += ts[t]; }
    const float inv = 1.0f / sum;
    if (h2 == 0) {
        GAS v4u* eo = (GAS v4u*)(((unsigned short*)(F.ws + WS_REXP)) + tok * 128 + h * 16); GAS f32x4* go = (GAS f32x4*)(((float*)(F.ws + WS_RG)) + tok * 128 + h * 16);
        eo[0] = (v4u){ce[0] | (ce[1] << 16), ce[2] | (ce[3] << 16), ce[4] | (ce[5] << 16), ce[6] | (ce[7] << 16)};
        eo[1] = (v4u){ce[8] | (ce[9] << 16), ce[10] | (ce[11] << 16), ce[12] | (ce[13] << 16), ce[14] | (ce[15] << 16)};
#pragma unroll
        for (int t4 = 0; t4 < 4; ++t4) go[t4] = (f32x4){ts[4 * t4] * inv, ts[4 * t4 + 1] * inv, ts[4 * t4 + 2] * inv, ts[4 * t4 + 3] * inv};
    }
}

__device__ __forceinline__ float gelu_erf(float v) {
    const float av = fabsf(v), t = __builtin_amdgcn_rcpf(av * 0.2316418882f + 1.0f);
    float q = t * 0.5307027145f + (-0.7265760135f); q = q * t + 0.7107068705f; q = q * t + (-0.142248368f); q = q * t + 0.127414796f; q = q * t;
    const float e = __builtin_amdgcn_exp2f((v * v) * (-0.72134752044f));
    const float m = v * (q * e);
    return v < 0.f ? m : v - m;
}
__device__ __forceinline__ float dpp_add(float v, float w_unused) { return v; }
#define DPP_ADD(v, ctrl) ((v) + __builtin_bit_cast(float, __builtin_amdgcn_update_dpp(0, __builtin_bit_cast(int, (v)), (ctrl), 0xf, 0xf, true)))
constexpr int NSL = 8;
constexpr int CW_PEER = 8192;
typedef float f32x2v __attribute__((ext_vector_type(2)));
__device__ __forceinline__ unsigned id_of(const v4u a, const v4u b, int m) { const unsigned w = (m < 8) ? a[(m & 7) >> 1] : b[(m & 7) >> 1]; return (m & 1) ? (w >> 16) : (w & 0xffffu); }
__device__ __forceinline__ void load_hn2(const bf16* p, f32x2v (&hn2)[8]) { const v4u a = *(const GAS v4u*)p, b = *(const GAS v4u*)(p + 8);
    hn2[0] = (f32x2v){bflo(a.x), bfhi(a.x)}; hn2[1] = (f32x2v){bflo(a.y), bfhi(a.y)}; hn2[2] = (f32x2v){bflo(a.z), bfhi(a.z)}; hn2[3] = (f32x2v){bflo(a.w), bfhi(a.w)};
    hn2[4] = (f32x2v){bflo(b.x), bfhi(b.x)}; hn2[5] = (f32x2v){bflo(b.y), bfhi(b.y)}; hn2[6] = (f32x2v){bflo(b.z), bfhi(b.z)}; hn2[7] = (f32x2v){bflo(b.w), bfhi(b.w)}; }
template <int SIDE> __device__ __forceinline__ void peer_item8(Frame& F, const Args& AR, int s, size_t t0) {
    const int lane = F.lane, ts = lane >> 3, c = lane & 7;
    const size_t tok = t0 + ts;
    const unsigned char* tbase = ((const unsigned char*)(F.ws + (SIDE == 0 ? WS_U16 : WS_V16))) + 128 * s;
    const unsigned lo = 16u * (unsigned)c;
    const GAS v4u* idq = (const GAS v4u*)(((const unsigned short*)(F.ws + WS_REXP)) + tok * 128);
    v4u ia = idq[0], ib = idq[1];
    if (SIDE == 0) {
        f32x2v hn2[8]; load_hn2(((const bf16*)(F.ws + WS_HG)) + tok * 1024 + 128 * s + 16 * c, hn2);
        float* po = ((float*)(F.ws + WS_SUBK)) + (tok * NSL + s) * 128;
#pragma unroll 1
        for (int b = 0; b < 8; ++b) {
            v4u r[16];
#pragma unroll
            for (int m = 0; m < 16; ++m) r[m] = *(const GAS v4u*)(tbase + (size_t)((id_of(ia, ib, m) << 10) + lo));
            const int bn = (b + 1) & 7; ia = idq[2 * bn]; ib = idq[2 * bn + 1];
            float d[16];
#pragma unroll
            for (int m = 0; m < 16; ++m) { f32x2v acc = {0.f, 0.f};
#pragma unroll
                for (int q = 0; q < 4; ++q) { const int w = (int)r[m][q]; acc = __builtin_amdgcn_cvt_pk_f32_fp8(w, false) * hn2[2 * q] + acc; acc = __builtin_amdgcn_cvt_pk_f32_fp8(w, true) * hn2[2 * q + 1] + acc; }
                float a = acc.x + acc.y; a = DPP_ADD(a, 0xB1); a = DPP_ADD(a, 0x4E); a = DPP_ADD(a, 0x141); d[m] = a; }
            if (c == 0) { GAS f32x4* pq = (GAS f32x4*)(po + 16 * b);
                pq[0] = (f32x4){d[0], d[1], d[2], d[3]}; pq[1] = (f32x4){d[4], d[5], d[6], d[7]}; pq[2] = (f32x4){d[8], d[9], d[10], d[11]}; pq[3] = (f32x4){d[12], d[13], d[14], d[15]}; }
        }
    } else {
        const GAS f32x4* cfq = (const GAS f32x4*)(((const float*)(F.ws + WS_RG)) + tok * 128);
        f32x4 cf[4];
#pragma unroll
        for (int q = 0; q < 4; ++q) cf[q] = cfq[q];
        f32x2v acc[8];
#pragma unroll
        for (int j = 0; j < 8; ++j) acc[j] = (f32x2v){0.f, 0.f};
#pragma unroll 1
        for (int b = 0; b < 8; ++b) {
            v4u r[16];
#pragma unroll
            for (int m = 0; m < 16; ++m) r[m] = *(const GAS v4u*)(tbase + (size_t)((id_of(ia, ib, m) << 10) + lo));
            const int bn = (b + 1) & 7; ia = idq[2 * bn]; ib = idq[2 * bn + 1];
            f32x4 cn[4];
#pragma unroll
            for (int q = 0; q < 4; ++q) cn[q] = cfq[4 * bn + q];
#pragma unroll
            for (int m = 0; m < 16; ++m) { const float cm = cf[m >> 2][m & 3]; const f32x2v c2 = {cm, cm};
#pragma unroll
                for (int q = 0; q < 4; ++q) { const int w = (int)r[m][q]; acc[2 * q] = __builtin_amdgcn_cvt_pk_f32_fp8(w, false) * c2 + acc[2 * q]; acc[2 * q + 1] = __builtin_amdgcn_cvt_pk_f32_fp8(w, true) * c2 + acc[2 * q + 1]; } }
#pragma unroll
            for (int q = 0; q < 4; ++q) cf[q] = cn[q];
        }
        GAS f32x4* op = (GAS f32x4*)((AR.out) + tok * 1024 + 128 * s + 16 * c);
#pragma unroll
        for (int q = 0; q < 4; ++q) { f32x4 h = op[q]; h.x += acc[2 * q].x; h.y += acc[2 * q].y; h.z += acc[2 * q + 1].x; h.w += acc[2 * q + 1].y; op[q] = h; }
    }
}
template <int SIDE> __device__ __forceinline__ void peer_side(Frame& F, const Args& AR, int rep = 0) {
    gu32* cnt = F.ctl + CW_PEER + (SIDE + 2 * rep) * 16 * 64;
    LAS int* sh = (LAS int*)F.lds;
    const unsigned xcc = xb_xcc_id() & 7u;
#pragma unroll 1
    for (int k = 0; k < NSL; ++k) {
        const int s = (int)((xcc + (unsigned)k) & (unsigned)(NSL - 1));
#pragma unroll 1
        for (;;) {
            __syncthreads();
            if (F.tid == 0) sh[0] = (int)__hip_atomic_fetch_add(cnt + 64 * s, 1u, RLX_AGENT);
            __syncthreads();
            const int blk = sh[0];
            if (blk >= MTOK / 128) break;
            const size_t t0 = (size_t)blk * 128 + F.wave * 16;
            peer_item8<SIDE>(F, AR, s, t0); peer_item8<SIDE>(F, AR, s, t0 + 8);
        }
    }
}
__device__ __forceinline__ void peer_coef_token(Frame& F, size_t tok, float inv_su, float inv_sv) {
    const int lane = F.lane;
    const float* pp = ((const float*)(F.ws + WS_SUBK)) + tok * NSL * 128;
    float a0 = 0.f, a1 = 0.f;
#pragma unroll
    for (int s = 0; s < NSL; ++s) { a0 += pp[s * 128 + lane]; a1 += pp[s * 128 + 64 + lane]; }
    float* gp = ((float*)(F.ws + WS_RG)) + tok * 128;
    const float sc = inv_su * row_rs((const float*)(F.ws + WS_SSP), tok);
    gp[lane] = gp[lane] * gelu_erf(a0 * sc) * inv_sv; gp[64 + lane] = gp[64 + lane] * gelu_erf(a1 * sc) * inv_sv;
}

__global__ void __launch_bounds__(NWAVES * 64, 2) mk_fwd(Args args) {
    extern __shared__ __attribute__((aligned(16))) unsigned char lds[];
    Frame F;
    F.lds = (LAS unsigned char*)lds;
    F.MISC = (volatile LAS unsigned*)(F.lds + MISC_OFF);
    F.tid = threadIdx.x; F.lane = F.tid & 63; F.wave = __builtin_amdgcn_readfirstlane(F.tid >> 6);
    F.G = gridDim.x; { const int bx = blockIdx.x; F.vcu = (F.G % 8 == 0) ? (bx % 8) * (F.G / 8) + bx / 8 : bx; }
    F.ws = args.ws;
    F.ctl = (gu32*)(F.ws + WS_CTL);
    const Args& AR = args;
    for (int u = F.tid; u < (LDS_BYTES - LDSCTL_OFF) / 4; u += NWAVES * 64) ((LAS unsigned*)(F.lds + LDSCTL_OFF))[u] = 0u;
    __syncthreads();
    XcdBarrier bar; bar.bar = (unsigned*)(F.ctl + CW_BAR); bar.x = 0; bar.st = nullptr;
#if !MK_PER_PHASE
    bar = xcd_barrier_post((unsigned*)(F.ctl + CW_BAR), F.MISC + 8);
#endif
    const int lo = args.ph_lo, hi = args.ph_hi;
#if defined(ONLY_PHASE)
#define IN(k) ((k) == ONLY_PHASE && lo <= (k) && (k) < hi)
#elif defined(PHASE_MASK)
#define IN(k) (((PHASE_MASK >> (k)) & 1) && lo <= (k) && (k) < hi)
#else
#define IN(k) (lo <= (k) && (k) < hi)
#endif
#if MK_PER_PHASE
#define SEAM(k) do { } while (0)
#else
#define SEAM(k) do { if (IN(k) && IN((k) + 1)) xcd_barrier(bar); } while (0)
#endif
#define FRESH() Frame P = F; { int t_ = threadIdx.x; asm volatile("" : "+v"(t_)); P.tid = t_; P.lane = t_ & 63; P.wave = __builtin_amdgcn_readfirstlane(t_ >> 6); } const int gw = P.vcu * NWAVES + P.wave, NGW = P.G * NWAVES; (void)gw; (void)NGW

    for (int rep_ = 0; rep_ < (((REPEAT_MASK >> 0) & 1) ? 2 : 1); ++rep_) if (IN(0)) { FRESH(); p0_prologue(P, args); } SEAM(0);
    for (int rep_ = 0; rep_ < (((REPEAT_MASK >> 1) & 1) ? 2 : 1); ++rep_) if (IN(1)) { pg8::Gemm g{((bf16*)(F.ws + WS_ACT)), ((bf16*)(F.ws + WS_WIN)), MTOK, LDP, 1024, 1024, 1024}; pg8::StaticOrder S; S.init(MTOK, LDP, F.G, (int)blockIdx.x);
        pg8::EpiStoreBf16 E{((bf16*)(F.ws + WS_PROJ)), LDP};
        pg8::gemm_phase<pg8::EpiStoreBf16, pg8::StaticOrder, true, true>(F.lds, g, S, E); } SEAM(1);
    if (IN(2)) { FRESH(); for (int m = gw; m < MTOK; m += NGW) fixup_token(P, args, m);
        const float su = fp8_scale(__hip_atomic_load(P.ctl + CW_AMAX, RLX_AGENT)), sv = fp8_scale(__hip_atomic_load(P.ctl + CW_AMAX + 1, RLX_AGENT));
        for (int r = gw; r < 2 * 16384; r += NGW) { const int rr = r & 16383;
            if (r < 16384) row_to_fp8(args.in[13] + (size_t)rr * 1024, (unsigned char*)(P.ws + WS_U16) + (size_t)rr * 1024, su, P.lane);
            else row_to_fp8(args.in[14] + (size_t)rr * 1024, (unsigned char*)(P.ws + WS_V16) + (size_t)rr * 1024, sv, P.lane); } } SEAM(2);
    for (int rep_ = 0; rep_ < (((REPEAT_MASK >> 3) & 1) ? 2 : 1); ++rep_) if (IN(3)) { FRESH(); for (int i = P.vcu; i < 256; i += P.G) { const int b = i >> 4, s = i & 15;
#pragma unroll 1
            for (int k = 0; k < 4; ++k) idx_unit(P, args, b, (k == 0) ? s : (k == 1) ? 31 - s : (k == 2) ? 32 + s : 63 - s, PROBE_NOSEL ? (rep_ == 1) : true); } } SEAM(3);
    for (int rep_ = 0; rep_ < (((REPEAT_MASK >> 4) & 1) ? 2 : 1); ++rep_) if (IN(4)) { FRESH(); for (int i = P.vcu; i < 256; i += P.G) { const int bh = i >> 1, s = i & 1, b = bh >> 3, h = bh & 7;
#pragma unroll 1
            for (int k = 0; k < 8; ++k) attn_unit(P, args, b, h, (k & 1) ? 15 - (k >> 1) * 2 - s : (k >> 1) * 2 + s); } } SEAM(4);
    for (int rep_ = 0; rep_ < (((REPEAT_MASK >> 5) & 1) ? 2 : 1); ++rep_) if (IN(5)) { pg8::Gemm g{((bf16*)(F.ws + WS_AO)), ((bf16*)(F.ws + WS_WA)), MTOK, 1024, 512, 512, 512}; pg8::StaticOrder S; S.init(MTOK, 1024, F.G, (int)blockIdx.x);
        pg8::EpiGate<false> E{((bf16*)(F.ws + WS_ACT)), 1024, ((bf16*)(F.ws + WS_PROJ)) + GA_OFF, LDP};
        pg8::gemm_phase<pg8::EpiGate<false>, pg8::StaticOrder, true, true>(F.lds, g, S, E); }
    if (IN(6)) { pg8::Gemm g{((bf16*)(F.ws + WS_POOLED)), ((bf16*)(F.ws + WS_WPP)), MTOK, 1024, 512, 512, 512}; pg8::StaticOrder S; S.init(MTOK, 1024, F.G, (int)blockIdx.x);
                pg8::EpiGate<true> E{((bf16*)(F.ws + WS_ACT)), 1024, ((bf16*)(F.ws + WS_PROJ)) + GP_OFF, LDP};
        pg8::gemm_phase<pg8::EpiGate<true>, pg8::StaticOrder, true, true>(F.lds, g, S, E); } SEAM(6);
    for (int rep_ = 0; rep_ < (((REPEAT_MASK >> 7) & 1) ? 2 : 1); ++rep_) if (IN(7)) { pg8::Gemm g{((bf16*)(F.ws + WS_ACT)), ((bf16*)(F.ws + WS_WO)), MTOK, 1024, 1024, 1024, 1024}; pg8::StaticOrder S; S.init(MTOK, 1024, F.G, (int)blockIdx.x);
        pg8::EpiResHG E{(AR.in[0]), (AR.out), ((bf16*)(F.ws + WS_HG)), (AR.in[10]), ((float*)(F.ws + WS_SSP)), 1024};
        pg8::gemm_phase<pg8::EpiResHG, pg8::StaticOrder, true, true>(F.lds, g, S, E); } SEAM(7);

    for (int rep_ = 0; rep_ < (((REPEAT_MASK >> 9) & 1) ? 2 : 1); ++rep_) if (IN(9)) { pg8::Gemm g{((bf16*)(F.ws + WS_HG)), ((bf16*)(F.ws + WS_W2)), MTOK, 1024, 1024, 1024, 1024}; pg8::StaticOrder S; S.init(MTOK, 1024, F.G, (int)blockIdx.x);
        pg8::EpiStoreBf16 E{((bf16*)(F.ws + WS_SUBK)), 1024};
        pg8::gemm_phase<pg8::EpiStoreBf16, pg8::StaticOrder, true, true>(F.lds, g, S, E); } SEAM(9);
    for (int rep_ = 0; rep_ < (((REPEAT_MASK >> 10) & 1) ? 2 : 1); ++rep_) if (IN(10)) { FRESH(); for (int tt = P.vcu; tt < MTOK / 32; tt += P.G) route_task(P, args, tt, P.wave); } SEAM(10);
        for (int rep_ = 0; rep_ < (((REPEAT_MASK >> 11) & 1) ? 2 : 1); ++rep_) if (IN(11)) { FRESH(); peer_side<0>(P, args, rep_); } SEAM(11);
    if (IN(12)) { FRESH(); const float iu = fp8_inv_scale(__hip_atomic_load(P.ctl + CW_AMAX, RLX_AGENT)), iv = fp8_inv_scale(__hip_atomic_load(P.ctl + CW_AMAX + 1, RLX_AGENT));
        for (int m = gw; m < MTOK; m += NGW) peer_coef_token(P, (size_t)m, iu, iv); } SEAM(12);
    if (IN(13)) { FRESH(); peer_side<1>(P, args); }

#undef IN
#undef SEAM
}

extern "C" void kernel_launch(void* const* d_in, const int* in_sizes, int n_in, void* d_out, int out_size, void* d_ws, size_t ws_size, hipStream_t stream) {
    static int grid = 0;
    if (grid == 0) {
        if (n_in != 15 || in_sizes[0] != MTOK * DM || out_size != MTOK * DM || ws_size < WS_END) { fprintf(stderr, "kernel_launch: unexpected shapes (n_in %d, in0 %d, out %d, ws %zu < %zu)\n", n_in, n_in > 0 ? in_sizes[0] : -1, out_size, ws_size, (size_t)WS_END); grid = -1; return; }
        int dev = 0, cus = 0, per_cu = 0;
        if (hipGetDevice(&dev) != hipSuccess || hipDeviceGetAttribute(&cus, hipDeviceAttributeMultiprocessorCount, dev) != hipSuccess) { grid = -1; return; }
        if (hipFuncSetAttribute((const void*)mk_fwd, hipFuncAttributeMaxDynamicSharedMemorySize, LDS_BYTES) != hipSuccess) { fprintf(stderr, "kernel_launch: hipFuncSetAttribute failed\n"); grid = -1; return; }
        if (hipOccupancyMaxActiveBlocksPerMultiprocessor(&per_cu, (const void*)mk_fwd, NWAVES * 64, LDS_BYTES) != hipSuccess || per_cu < 1) { fprintf(stderr, "kernel_launch: occupancy query says %d blocks per CU\n", per_cu); (void)hipGetLastError(); grid = -1; return; }
        grid = cus;
    }
    if (grid < 0) return;
    if (hipMemsetAsync((char*)d_ws + WS_CTL, 0, CTL_ZERO_BYTES, stream) != hipSuccess) return;
    Args a{};
    for (int i = 0; i < 15; ++i) a.in[i] = (const float*)d_in[i];
    a.out = (float*)d_out; a.ws = (unsigned char*)d_ws;
#if MK_PER_PHASE
    for (int p = 0; p < NPHASE; ++p) { a.ph_lo = p; a.ph_hi = p + 1; hipLaunchKernelGGL(mk_fwd, dim3(grid), dim3(NWAVES * 64), LDS_BYTES, stream, a); }
#else
    a.ph_lo = 0; a.ph_hi = NPHASE;
    hipLaunchKernelGGL(mk_fwd, dim3(grid), dim3(NWAVES * 64), LDS_BYTES, stream, a);
#endif
}
```

```cpp
#include <hip/hip_runtime.h>
#include <cstdio>
#include <cstdint>
namespace pg8 {
#define PG8_LAS __attribute__((address_space(3)))
typedef unsigned short bf16_t;
typedef short bf16x8 __attribute__((ext_vector_type(8)));
typedef float f32x4 __attribute__((ext_vector_type(4)));
typedef unsigned u32x4 __attribute__((ext_vector_type(4)));
constexpr int BM = 256, BK = 64, HALF = 128, HTB = HALF * BK * 2  , STAGE_BYTES = 8 * HTB, NXCD = 8, WGM = 8;

__host__ __device__ __forceinline__ int lds_byte(int r, int c) { const int st = (r >> 4) * 2 + (c >> 5), rr = r & 15, cc = c & 31, ob = rr * 64 + cc * 2; return st * 1024 + (ob ^ (((ob >> 9) & 1) << 5)); }
__host__ __device__ __forceinline__ void stage_rc(int b, int& R, int& C) { const int st = b / 1024, sb = b % 1024, swz = sb ^ (((sb >> 9) & 1) << 5); R = (st >> 1) * 16 + swz / 64; C = (st & 1) * 32 + (swz % 64) / 2; }
__host__ __device__ __forceinline__ int perm32(int rho) { const int n = rho >> 4, i = rho & 15; return 8 * (i >> 2) + 4 * n + (i & 3); }

struct Unit { int pm, pn; };
struct Gemm { const bf16_t* A; const bf16_t* Bt; int M, N, K, lda, ldb; };

struct StaticOrder {
    int nM, nN, nwg, G, c;
    __host__ __device__ void init(int M, int N, int G_, int c_) { nM = M / BM; nN = N / BM; nwg = nM * nN; G = G_; c = c_; }
    __host__ __device__ bool next(int i, Unit& u) const {
        const long L = (long)i * G + c; if (L >= nwg) return false;
        int wgid = (int)L; { const int q = nwg / NXCD, r = nwg % NXCD, xcd = wgid % NXCD, off = wgid / NXCD; wgid = (xcd < r ? xcd * (q + 1) : r * (q + 1) + (xcd - r) * q) + off; }
        const int nig = WGM * nN, gid = wgid / nig, fm = gid * WGM, gsz = (nM - fm) < WGM ? (nM - fm) : WGM;
        u.pm = fm + ((wgid % nig) % gsz); u.pn = (wgid % nig) / gsz; return true;
    }
    __device__ __forceinline__ void a_ready(const Unit&) const {}
    __device__ __forceinline__ void done(const Unit&) const {}
};
struct PanelOrder {
    int nN, pm;
    __host__ __device__ bool next(int i, Unit& u) const { if (i >= nN) return false; u.pm = pm; u.pn = i; return true; }
    __device__ __forceinline__ void a_ready(const Unit&) const {}
    __device__ __forceinline__ void done(const Unit&) const {}
};
typedef float f32x2c_t __attribute__((ext_vector_type(2))); typedef __bf16 bf16x2c_t __attribute__((ext_vector_type(2)));
__device__ __forceinline__ unsigned cvt_pk_bf16(float lo, float hi) { f32x2c_t v = {lo, hi}; bf16x2c_t b = __builtin_convertvector(v, bf16x2c_t); return __builtin_bit_cast(unsigned, b); }
typedef float f32x2 __attribute__((ext_vector_type(2)));
__device__ __forceinline__ f32x2 gelu_pk(f32x2 v) {
    const f32x2 av = __builtin_elementwise_abs(v), d = av * 0.2316418882f + 1.0f;
    f32x2 t; t.x = __builtin_amdgcn_rcpf(d.x); t.y = __builtin_amdgcn_rcpf(d.y);
    f32x2 q = t * 0.5307027145f + (-0.7265760135f); q = q * t + 0.7107068705f; q = q * t + (-0.142248368f); q = q * t + 0.127414796f; q = q * t;
    const f32x2 s = (v * v) * (-0.72134752044f);
    f32x2 e; e.x = __builtin_amdgcn_exp2f(s.x); e.y = __builtin_amdgcn_exp2f(s.y);
    const f32x2 m = v * (q * e), r = v - m;
    f32x2 o; o.x = v.x < 0.f ? m.x : r.x; o.y = v.y < 0.f ? m.y : r.y; return o;
}
typedef unsigned u32x2e __attribute__((ext_vector_type(2)));
__device__ __forceinline__ float bf_lo(unsigned w) { return __uint_as_float(w << 16); }
__device__ __forceinline__ float bf_hi(unsigned w) { return __uint_as_float(w & 0xffff0000u); }
__device__ __forceinline__ float sigmoidf_fast(float g) { return __builtin_amdgcn_rcpf(1.0f + __builtin_amdgcn_exp2f(-1.4426950408889634f * g)); }
__device__ __forceinline__ unsigned ord_key(float f) { const unsigned b = __float_as_uint(f); return b ^ ((unsigned)((int)b >> 31) | 0x80000000u); }
__device__ __forceinline__ float unord_key(unsigned k) { return __uint_as_float((k & 0x80000000u) ? (k ^ 0x80000000u) : ~k); }

struct EpiStoreBf16 {
    static constexpr bool PERM = true, AFTER_DRAIN = false;
    bf16_t* O; int ldc;
    __device__ __forceinline__ void operator()(const f32x4 (&acc)[2][2][4][2], const Unit& u, int wr, int wc, int fr, int fq) const {
        const int row0 = u.pm * BM + wr * 64 + fr, col0 = u.pn * BM + wc * 32 + 8 * fq;
#pragma unroll
        for (int ai = 0; ai < 2; ++ai)
#pragma unroll
            for (int m = 0; m < 4; ++m) { bf16_t* rowp = O + (size_t)(row0 + ai * HALF + m * 16) * ldc + col0;
#pragma unroll
                for (int bj = 0; bj < 2; ++bj) { const f32x4 v0 = acc[ai][bj][m][0], v1 = acc[ai][bj][m][1];
                    u32x4 w; w.x = cvt_pk_bf16(v0[0], v0[1]); w.y = cvt_pk_bf16(v0[2], v0[3]); w.z = cvt_pk_bf16(v1[0], v1[1]); w.w = cvt_pk_bf16(v1[2], v1[3]);
                    *(u32x4*)(rowp + bj * HALF) = w; } }
    }
};
template <bool ADD> struct EpiGate {
    static constexpr bool PERM = true, AFTER_DRAIN = false;
    bf16_t* O; int ldc; const bf16_t* G; int ldg;
    __device__ __forceinline__ void operator()(const f32x4 (&acc)[2][2][4][2], const Unit& u, int wr, int wc, int fr, int fq) const {
        const int row0 = u.pm * BM + wr * 64 + fr, col0 = u.pn * BM + wc * 32 + 8 * fq;
#pragma unroll
        for (int ai = 0; ai < 2; ++ai)
#pragma unroll
            for (int m = 0; m < 4; ++m) { const size_t row = (size_t)(row0 + ai * HALF + m * 16);
#pragma unroll
                for (int bj = 0; bj < 2; ++bj) { const int col = col0 + bj * HALF;
                    const u32x4 gr = *(const u32x4*)(G + row * ldg + col);
                    f32x4 v0 = acc[ai][bj][m][0], v1 = acc[ai][bj][m][1];
                    v0[0] *= sigmoidf_fast(bf_lo(gr.x)); v0[1] *= sigmoidf_fast(bf_hi(gr.x)); v0[2] *= sigmoidf_fast(bf_lo(gr.y)); v0[3] *= sigmoidf_fast(bf_hi(gr.y));
                    v1[0] *= sigmoidf_fast(bf_lo(gr.z)); v1[1] *= sigmoidf_fast(bf_hi(gr.z)); v1[2] *= sigmoidf_fast(bf_lo(gr.w)); v1[3] *= sigmoidf_fast(bf_hi(gr.w));
                    bf16_t* op = O + row * ldc + col;
                    if (ADD) { const u32x4 pr = *(const u32x4*)op;
                        v0[0] += bf_lo(pr.x); v0[1] += bf_hi(pr.x); v0[2] += bf_lo(pr.y); v0[3] += bf_hi(pr.y);
                        v1[0] += bf_lo(pr.z); v1[1] += bf_hi(pr.z); v1[2] += bf_lo(pr.w); v1[3] += bf_hi(pr.w); }
                    u32x4 w; w.x = cvt_pk_bf16(v0[0], v0[1]); w.y = cvt_pk_bf16(v0[2], v0[3]); w.z = cvt_pk_bf16(v1[0], v1[1]); w.w = cvt_pk_bf16(v1[2], v1[3]);
                    *(u32x4*)op = w; } }
    }
};
struct EpiResF32 {
    static constexpr bool PERM = false, AFTER_DRAIN = false;
    const float* base; float* out; int ldc;
    __device__ __forceinline__ void operator()(const f32x4 (&acc)[2][2][4][2], const Unit& u, int wr, int wc, int fr, int fq) const {
        const int col0 = u.pn * BM + wc * 32 + 4 * fq;
#pragma unroll
        for (int ai = 0; ai < 2; ++ai)
#pragma unroll
            for (int m = 0; m < 4; ++m) { const size_t off = (size_t)(u.pm * BM + ai * HALF + wr * 64 + m * 16 + fr) * ldc + col0;
#pragma unroll
                for (int bj = 0; bj < 2; ++bj)
#pragma unroll
                    for (int n = 0; n < 2; ++n) { const f32x4 bs = *(const f32x4*)(base + off + bj * HALF + n * 16); *(f32x4*)(out + off + bj * HALF + n * 16) = bs + acc[ai][bj][m][n]; } }
    }
};
struct EpiResHG {
    static constexpr bool PERM = false, AFTER_DRAIN = false;
    const float* base; float* out; bf16_t* hg; const float* gain; float* ssp; int ldc;
    __device__ __forceinline__ void operator()(const f32x4 (&acc)[2][2][4][2], const Unit& u, int wr, int wc, int fr, int fq) const {
        const int col0 = u.pn * BM + wc * 32 + 4 * fq;
        f32x4 gv[2][2];
#pragma unroll
        for (int bj = 0; bj < 2; ++bj)
#pragma unroll
            for (int n = 0; n < 2; ++n) gv[bj][n] = *(const f32x4*)(gain + col0 + bj * HALF + n * 16);
#pragma unroll
        for (int ai = 0; ai < 2; ++ai)
#pragma unroll
            for (int m = 0; m < 4; ++m) { const int row = u.pm * BM + ai * HALF + wr * 64 + m * 16 + fr; const size_t off = (size_t)row * ldc + col0; float ss = 0.f;
#pragma unroll
                for (int bj = 0; bj < 2; ++bj)
#pragma unroll
                    for (int n = 0; n < 2; ++n) { const f32x4 h = *(const f32x4*)(base + off + bj * HALF + n * 16) + acc[ai][bj][m][n]; *(f32x4*)(out + off + bj * HALF + n * 16) = h;
                        ss += (h[0] * h[0] + h[1] * h[1]) + (h[2] * h[2] + h[3] * h[3]);
                        const f32x4 hgv = h * gv[bj][n]; u32x2e w; w.x = cvt_pk_bf16(hgv[0], hgv[1]); w.y = cvt_pk_bf16(hgv[2], hgv[3]); *(u32x2e*)(hg + off + bj * HALF + n * 16) = w; }
                ss += __shfl_xor(ss, 16); ss += __shfl_xor(ss, 32);
                if (fq == 0) ssp[(size_t)row * 16 + u.pn * 4 + wc] = ss; }
    }
};
struct EpiKeys {
    static constexpr bool PERM = false, AFTER_DRAIN = false;
    unsigned* O; int ldc;
    __device__ __forceinline__ void operator()(const f32x4 (&acc)[2][2][4][2], const Unit& u, int wr, int wc, int fr, int fq) const {
        const int col0 = u.pn * BM + wc * 32 + 4 * fq;
#pragma unroll
        for (int ai = 0; ai < 2; ++ai)
#pragma unroll
            for (int m = 0; m < 4; ++m) { const size_t off = (size_t)(u.pm * BM + ai * HALF + wr * 64 + m * 16 + fr) * ldc + col0;
#pragma unroll
                for (int bj = 0; bj < 2; ++bj)
#pragma unroll
                    for (int n = 0; n < 2; ++n) { const int nn = (col0 + bj * HALF + n * 16) & 127; const f32x4 a = acc[ai][bj][m][n]; u32x4 w;
                        w.x = (ord_key(a[0]) & ~127u) | (unsigned)(127 - nn); w.y = (ord_key(a[1]) & ~127u) | (unsigned)(126 - nn);
                        w.z = (ord_key(a[2]) & ~127u) | (unsigned)(125 - nn); w.w = (ord_key(a[3]) & ~127u) | (unsigned)(124 - nn);
                        *(u32x4*)(O + off + bj * HALF + n * 16) = w; } }
    }
};

template <class Epi, class Sched, bool ALIGN_EPI = false, bool SP2 = false>
__device__ __forceinline__ void gemm_phase(PG8_LAS unsigned char* lds, const Gemm g, const Sched& S, const Epi& E) {
    int tid_ = threadIdx.x; asm volatile("" : "+v"(tid_));
    const int tid = tid_, wid = __builtin_amdgcn_readfirstlane(tid >> 6), lane = tid & 63, wr = wid >> 2, wc = wid & 3, fr = lane & 15, fq = lane >> 4;
    const int K = g.K, nt = K / BK;
    unsigned voffA[2], voffB[2];
#pragma unroll
    for (int i = 0; i < 2; ++i) { int R, C; stage_rc(tid * 16 + i * 8192, R, C); const int Rb = Epi::PERM ? ((R & ~31) + perm32(R & 31)) : R;
        voffA[i] = (unsigned)(R * g.lda + C) * 2u; voffB[i] = (unsigned)(Rb * g.ldb + C) * 2u; }
    const size_t kstep = (size_t)(BK * 2);
    const size_t hstepA = (size_t)HALF * g.lda * 2, hstepB = (size_t)HALF * g.ldb * 2;
    const size_t tstepA = 2 * hstepA, tstepB = 2 * hstepB;
    const unsigned ldsw = (unsigned)wid * 1024u;
    const int aoff = lds_byte(wr * 64 + fr, fq * 8), boff = lds_byte(wc * 32 + fr, fq * 8);
#define PG8_SA(b, h) (((b) * 2 + (h)) * HTB)
#define PG8_SB(b, h) ((4 + (b) * 2 + (h)) * HTB)
#define PG8_STAGE(bufoff, gbase, voff) do { _Pragma("unroll") for (int _i = 0; _i < 2; ++_i) \
        __builtin_amdgcn_global_load_lds((const unsigned*)((const char*)(gbase) + (voff)[_i]), (PG8_LAS unsigned*)(lds + (bufoff) + ldsw + _i * 8192), 16, 0, 0); } while (0)
#define PG8_LDA(dst, b, h) do { _Pragma("unroll") for (int m = 0; m < 4; ++m) _Pragma("unroll") for (int k = 0; k < 2; ++k) dst[m][k] = *(const PG8_LAS bf16x8*)(lds + PG8_SA(b, h) + aoff + m * 2048 + k * 1024); } while (0)
#define PG8_LDB(dst, b, h) do { _Pragma("unroll") for (int n = 0; n < 2; ++n) _Pragma("unroll") for (int k = 0; k < 2; ++k) dst[n][k] = *(const PG8_LAS bf16x8*)(lds + PG8_SB(b, h) + boff + n * 2048 + k * 1024); } while (0)
#define PG8_MMA(ai, bj, At, Bt) do { __builtin_amdgcn_s_setprio(1); _Pragma("unroll") for (int m = 0; m < 4; ++m) _Pragma("unroll") for (int n = 0; n < 2; ++n) _Pragma("unroll") for (int k = 0; k < 2; ++k) \
        acc[ai][bj][m][n] = __builtin_amdgcn_mfma_f32_16x16x32_bf16(Bt[n][k], At[m][k], acc[ai][bj][m][n], 0, 0, 0); __builtin_amdgcn_s_setprio(0); } while (0)
#define PG8_WAIT_V(n) asm volatile("s_waitcnt vmcnt(" #n ")" ::: "memory")
#define PG8_WAIT_L(n) asm volatile("s_waitcnt lgkmcnt(" #n ")" ::: "memory")
#define PG8_BAR __builtin_amdgcn_s_barrier()
#define PG8_SCHED __builtin_amdgcn_sched_barrier(0)
    Unit cur, nxt; int ui = 0;
    if (!S.next(0, cur)) return;
    f32x4 acc[2][2][4][2];
#pragma unroll
    for (int a = 0; a < 2; ++a)
#pragma unroll
        for (int b = 0; b < 2; ++b)
#pragma unroll
            for (int m = 0; m < 4; ++m)
#pragma unroll
                for (int n = 0; n < 2; ++n) acc[a][b][m][n] = (f32x4){0.f, 0.f, 0.f, 0.f};
    bf16x8 At[4][2], B0[2][2], B1[2][2];
    const char* cA = (const char*)g.A + (size_t)cur.pm * tstepA; const char* cB = (const char*)g.Bt + (size_t)cur.pn * tstepB;
    S.a_ready(cur);
    if constexpr (SP2) {
        PG8_STAGE(PG8_SB(0, 0), cB, voffB); PG8_STAGE(PG8_SB(0, 1), cB + hstepB, voffB); PG8_STAGE(PG8_SA(0, 0), cA, voffA); PG8_STAGE(PG8_SA(0, 1), cA + hstepA, voffA);
        if (wr == 1) PG8_BAR;
        PG8_WAIT_V(2); PG8_BAR;
        PG8_STAGE(PG8_SB(1, 0), cB + kstep, voffB); PG8_STAGE(PG8_SA(1, 0), cA + kstep, voffA); PG8_STAGE(PG8_SB(1, 1), cB + hstepB + kstep, voffB);
        PG8_WAIT_V(6); PG8_BAR;
    } else {
        PG8_STAGE(PG8_SB(0, 0), cB, voffB); PG8_STAGE(PG8_SA(0, 0), cA, voffA); PG8_STAGE(PG8_SB(0, 1), cB + hstepB, voffB); PG8_STAGE(PG8_SA(0, 1), cA + hstepA, voffA);
        if (wr == 1) PG8_BAR;
        PG8_WAIT_V(4); PG8_BAR;
        PG8_STAGE(PG8_SB(1, 0), cB + kstep, voffB); PG8_STAGE(PG8_SA(1, 0), cA + kstep, voffA); PG8_STAGE(PG8_SB(1, 1), cB + hstepB + kstep, voffB);
        PG8_WAIT_V(6); PG8_BAR;
    }
    for (;;) {
        const bool has_next = S.next(ui + 1, nxt);
        const char* nA = has_next ? (const char*)g.A + (size_t)nxt.pm * tstepA : cA; const char* nB = has_next ? (const char*)g.Bt + (size_t)nxt.pn * tstepB : cB;
        for (int t = 0; t < nt; t += 2) {
            const bool last = (t == nt - 2);
            const char* a1 = cA + (size_t)(t + 1) * kstep;
            const char* a2 = last ? nA : cA + (size_t)(t + 2) * kstep; const char* b2 = last ? nB : cB + (size_t)(t + 2) * kstep;
            const char* a3 = a2 + kstep; const char* b3 = b2 + kstep;
            if (last && has_next) S.a_ready(nxt);
            if constexpr (SP2) {
            PG8_LDB(B0, 0, 0); PG8_LDB(B1, 0, 1); PG8_SCHED; PG8_LDA(At, 0, 0); PG8_STAGE(PG8_SA(1, 1), a1 + hstepA, voffA);
            PG8_WAIT_V(8); PG8_WAIT_L(0); PG8_BAR; PG8_MMA(0, 0, At, B0); PG8_MMA(0, 1, At, B1); PG8_BAR; PG8_SCHED;
            PG8_LDA(At, 0, 1); PG8_STAGE(PG8_SB(0, 0), b2, voffB); PG8_STAGE(PG8_SB(0, 1), b2 + hstepB, voffB); PG8_STAGE(PG8_SA(0, 0), a2, voffA);
            PG8_WAIT_V(8); PG8_WAIT_L(0); PG8_BAR; PG8_MMA(1, 0, At, B0); PG8_MMA(1, 1, At, B1); PG8_BAR; PG8_SCHED;
            PG8_LDB(B0, 1, 0); PG8_LDB(B1, 1, 1); PG8_SCHED; PG8_LDA(At, 1, 0); PG8_STAGE(PG8_SA(0, 1), a2 + hstepA, voffA);
            PG8_WAIT_V(8); PG8_WAIT_L(0); PG8_BAR; PG8_MMA(0, 0, At, B0); PG8_MMA(0, 1, At, B1); PG8_BAR; PG8_SCHED;
            PG8_LDA(At, 1, 1); PG8_STAGE(PG8_SB(1, 0), b3, voffB); PG8_STAGE(PG8_SB(1, 1), b3 + hstepB, voffB); PG8_STAGE(PG8_SA(1, 0), a3, voffA);
            PG8_WAIT_V(8); PG8_WAIT_L(0); PG8_BAR; PG8_MMA(1, 0, At, B0); PG8_MMA(1, 1, At, B1); PG8_BAR; PG8_SCHED;
            } else {
            PG8_LDB(B0, 0, 0); PG8_SCHED; PG8_LDA(At, 0, 0); PG8_STAGE(PG8_SA(1, 1), a1 + hstepA, voffA);
            PG8_WAIT_L(8); PG8_BAR; PG8_WAIT_L(0); PG8_MMA(0, 0, At, B0); PG8_BAR; PG8_SCHED;
            PG8_LDB(B1, 0, 1); PG8_STAGE(PG8_SB(0, 0), b2, voffB);
            PG8_BAR; PG8_WAIT_L(0); PG8_MMA(0, 1, At, B1); PG8_BAR;
            PG8_LDA(At, 0, 1); PG8_STAGE(PG8_SA(0, 0), a2, voffA);
            PG8_BAR; PG8_WAIT_L(0); PG8_MMA(1, 0, At, B0); PG8_BAR; PG8_SCHED;
            PG8_STAGE(PG8_SB(0, 1), b2 + hstepB, voffB);
            PG8_WAIT_V(6); PG8_BAR; PG8_MMA(1, 1, At, B1); PG8_BAR;
            PG8_LDB(B0, 1, 0); PG8_SCHED; PG8_LDA(At, 1, 0); PG8_STAGE(PG8_SA(0, 1), a2 + hstepA, voffA);
            PG8_WAIT_L(8); PG8_BAR; PG8_WAIT_L(0); PG8_MMA(0, 0, At, B0); PG8_BAR; PG8_SCHED;
            PG8_LDB(B1, 1, 1); PG8_STAGE(PG8_SB(1, 0), b3, voffB);
            PG8_BAR; PG8_WAIT_L(0); PG8_MMA(0, 1, At, B1); PG8_BAR;
            PG8_LDA(At, 1, 1); PG8_STAGE(PG8_SA(1, 0), a3, voffA);
            PG8_BAR; PG8_WAIT_L(0); PG8_MMA(1, 0, At, B0); PG8_BAR; PG8_SCHED;
            PG8_STAGE(PG8_SB(1, 1), b3 + hstepB, voffB);
            PG8_WAIT_V(6); PG8_BAR; PG8_MMA(1, 1, At, B1); PG8_BAR;
            }
        }
        if constexpr (ALIGN_EPI) { if (wr == 0) PG8_BAR; }
        if constexpr (!Epi::AFTER_DRAIN) { Unit ue = cur; asm volatile("" : "+s"(ue.pm), "+s"(ue.pn));
            E(acc, ue, wr, wc, fr, fq); S.done(cur); }
        if (!has_next) break;
#pragma unroll
        for (int a = 0; a < 2; ++a)
#pragma unroll
            for (int b = 0; b < 2; ++b)
#pragma unroll
                for (int m = 0; m < 4; ++m)
#pragma unroll
                    for (int n = 0; n < 2; ++n) acc[a][b][m][n] = (f32x4){0.f, 0.f, 0.f, 0.f};
        cur = nxt; cA = nA; cB = nB; ++ui;
        if constexpr (ALIGN_EPI) { if (wr == 1) PG8_BAR; }
    }
    PG8_WAIT_V(0);
    if constexpr (!ALIGN_EPI) { if (wr == 0) PG8_BAR; }
    PG8_BAR;
    if constexpr (Epi::AFTER_DRAIN) { E.fused(acc, cur, wr, wc, fr, fq, lds, wid, lane); S.done(cur); }
#undef PG8_SA
#undef PG8_SB
#undef PG8_STAGE
#undef PG8_LDA
#undef PG8_LDB
#undef PG8_MMA
#undef PG8_WAIT_V
#undef PG8_WAIT_L
#undef PG8_BAR
#undef PG8_SCHED
}
}

constexpr int NWAVES = 8;
#ifndef REPEAT_MASK
#define REPEAT_MASK 0
#endif
#ifndef PROBE_SEL2
#define PROBE_SEL2 1
#endif
#ifndef PROBE_SEC
#define PROBE_SEC 0
#endif
#ifndef PROBE_NOSEL
#define PROBE_NOSEL 0
#endif
#ifndef MK_PER_PHASE
#define MK_PER_PHASE 0
#endif
constexpr int NPHASE = 14;

constexpr int BATCH = 16, SEQ = 4096, DM = 1024, MTOK = BATCH * SEQ;
constexpr int LDP = 4864;
constexpr int Q_OFF = 0, K_OFF = 512, V_OFF = 1024, QI_OFF = 1536, P_OFF = 2048, GA_OFF = 2560, GP_OFF = 3584, KI_OFF = 4608, WI_OFF = 4672;
constexpr int IN_WIDTH = 4680;
constexpr float EPS = 1e-6f;
constexpr float C2 = 0.125f * 1.4426950408889634f;
constexpr float WI_SCALE = 0.35355339059327373f * 0.125f;

constexpr size_t MiB = 1u << 20;
constexpr size_t WS_CTL = 0, CTL_ZERO_BYTES = 1 * MiB;
constexpr size_t WS_ROPE = 1 * MiB;
constexpr size_t WS_WIN = 2 * MiB;
constexpr size_t WS_WA = 12 * MiB;
constexpr size_t WS_WPP = 13 * MiB;
constexpr size_t WS_WO = 14 * MiB;
constexpr size_t WS_W2 = 16 * MiB;
constexpr size_t WS_SKB = 19 * MiB;
constexpr size_t WS_U16 = 20 * MiB, WS_V16 = 52 * MiB;
constexpr size_t WS_MASK = 84 * MiB;
constexpr size_t WS_POOLED = 116 * MiB;
constexpr size_t WS_ACT = 180 * MiB;
constexpr size_t WS_PROJ = 308 * MiB;
constexpr size_t WS_AO = 916 * MiB;
constexpr size_t WS_REXP = 980 * MiB, WS_RG = 116 * MiB;
constexpr size_t WS_HG = 308 * MiB;
constexpr size_t WS_SUBK = 436 * MiB;
constexpr size_t WS_SSP = 948 * MiB;
constexpr size_t WS_END = 1024 * MiB;
constexpr int CW_TMO = 0, CW_BAR = 4096, CW_AMAX = 12288;

constexpr int RING_BYTES = 131072;
constexpr int LDSCTL_OFF = RING_BYTES, MISC_OFF = LDSCTL_OFF + 320;
constexpr int LDS_BYTES = 147456;

#define GAS __attribute__((address_space(1)))
#define LAS __attribute__((address_space(3)))
typedef unsigned short bf16;
typedef unsigned v4u __attribute__((ext_vector_type(4)));
typedef unsigned v2u __attribute__((ext_vector_type(2)));
typedef float f32x4 __attribute__((ext_vector_type(4)));
typedef float f32x16 __attribute__((ext_vector_type(16)));
typedef short bf16x8 __attribute__((ext_vector_type(8)));
typedef short s16x4 __attribute__((ext_vector_type(4)));
typedef GAS unsigned gu32;
#define RLX_AGENT __ATOMIC_RELAXED, __HIP_MEMORY_SCOPE_AGENT
#define LDS_WAIT() asm volatile("s_waitcnt lgkmcnt(0)" ::: "memory")
#define BAR_LDS() asm volatile("s_waitcnt lgkmcnt(0)\n\ts_barrier" ::: "memory")
#define VM_WAIT() asm volatile("s_waitcnt vmcnt(0)" ::: "memory")
__device__ __forceinline__ unsigned f2bf(float f) { unsigned u = __builtin_bit_cast(unsigned, f); return (u + 0x7fffu + ((u >> 16) & 1u)) >> 16; }
typedef float f32x2k_t __attribute__((ext_vector_type(2))); typedef __bf16 bf16x2k_t __attribute__((ext_vector_type(2)));
__device__ __forceinline__ unsigned pk2(float lo, float hi) { f32x2k_t v = {lo, hi}; bf16x2k_t b = __builtin_convertvector(v, bf16x2k_t); return __builtin_bit_cast(unsigned, b); }
__device__ __forceinline__ float bflo(unsigned w) { return __uint_as_float(w << 16); }
__device__ __forceinline__ float bfhi(unsigned w) { return __uint_as_float(w & 0xffff0000u); }
__device__ __forceinline__ unsigned ordk(float f) { const unsigned b = __float_as_uint(f); return b ^ ((unsigned)((int)b >> 31) | 0x80000000u); }
__device__ __forceinline__ float unordk(unsigned k) { return __uint_as_float((k & 0x80000000u) ? (k ^ 0x80000000u) : ~k); }
__device__ __forceinline__ int crow(int r, int hi) { return (r & 3) + 8 * (r >> 2) + 4 * hi; }
typedef __bf16 bf16x2v_t __attribute__((ext_vector_type(2)));
__device__ __forceinline__ float dot2bf(unsigned a, unsigned b, float acc) { return __builtin_amdgcn_fdot2_f32_bf16(__builtin_bit_cast(bf16x2v_t, a), __builtin_bit_cast(bf16x2v_t, b), acc, false); }

#define XB_TMO      128
#define XB_XCNT(j)  (256  + 64 * (j))
#define XB_XSUB(j)  (1280 + 64 * (j))
#define XB_XGEN(j)  (2304 + 64 * (j))
#define XB_TOP      3328
#define XB_TOPGEN   3392
#define XCD_BAR_WORDS 3456
#define XB_SPIN_CAP (1u << 18)

__device__ __forceinline__ unsigned xb_ld(unsigned* p)              { return __hip_atomic_load(p, __ATOMIC_RELAXED, __HIP_MEMORY_SCOPE_AGENT); }
__device__ __forceinline__ unsigned xb_add(unsigned* p, unsigned v) { return __hip_atomic_fetch_add(p, v, __ATOMIC_RELAXED, __HIP_MEMORY_SCOPE_AGENT); }
__device__ __forceinline__ unsigned xb_xcc_id() { return (unsigned)__builtin_amdgcn_s_getreg((3 << 11) | 20) & 0xFu; }
#define XB_SPIN(cond, bar) do { unsigned _sp = 0; while (cond) { __builtin_amdgcn_s_sleep(1); \
    if ((++_sp & 255u) == 0u) { if (xb_ld(&(bar)[XB_TMO])) break; if (_sp > XB_SPIN_CAP) { atomicAdd(&(bar)[XB_TMO], 1u); break; } } } } while (0)

struct XcdBarrier {
    unsigned* bar; unsigned x;
    volatile LAS unsigned* st;
};

__device__ __forceinline__ XcdBarrier xcd_barrier_post(unsigned* bar, volatile LAS unsigned* st) {
    XcdBarrier b; b.bar = bar; b.x = xb_xcc_id(); b.st = st;
    if (threadIdx.x == 0) (void)xb_add(&bar[XB_XCNT(b.x)], 1u);
    return b;
}
__device__ __forceinline__ void xcd_barrier_complete(unsigned* bar, unsigned x, unsigned& nloc, unsigned& nx) {
    const unsigned G = gridDim.x * gridDim.y * gridDim.z;
    unsigned sum, cnt, mine, sp = 0u;
    for (;;) {
        sum = 0u; cnt = 0u; mine = 0u;
#pragma unroll
        for (unsigned j = 0; j < 16; ++j) { const unsigned c = xb_ld(&bar[XB_XCNT(j)]); sum += c; cnt += (c > 0u) ? 1u : 0u; mine = (j == x) ? c : mine; }
        if (sum == G) break;
        __builtin_amdgcn_s_sleep(1);
        if ((++sp & 255u) == 0u) { if (xb_ld(&bar[XB_TMO])) break; if (sp > XB_SPIN_CAP) { atomicAdd(&bar[XB_TMO], 1u); break; } }
    }
    nloc = mine > 0u ? mine : 1u; nx = cnt > 0u ? cnt : 1u;
}

__device__ __forceinline__ void xcd_barrier(const XcdBarrier& b) {
    asm volatile("s_waitcnt vmcnt(0)" ::: "memory");
    __syncthreads();
    if (threadIdx.x == 0) {
        unsigned* bar = b.bar;
        __builtin_amdgcn_s_waitcnt(0);
        unsigned nloc = b.st[0], nx = b.st[1];
        if (nloc == 0u) { xcd_barrier_complete(bar, b.x, nloc, nx); b.st[0] = nloc; b.st[1] = nx; }
        const unsigned old = xb_add(&bar[XB_XSUB(b.x)], 1u);
        const unsigned gen = old / nloc;
        if (old + 1u == (gen + 1u) * nloc) {
            __builtin_amdgcn_fence(__ATOMIC_RELEASE, "agent");
            asm volatile("s_waitcnt vmcnt(0)" ::: "memory");
            const unsigned og = xb_add(&bar[XB_TOP], 1u);
            const unsigned tg = og / nx;
            if (og + 1u == (tg + 1u) * nx) xb_add(&bar[XB_TOPGEN], 1u);
            else XB_SPIN(xb_ld(&bar[XB_TOPGEN]) == tg, bar);
            __builtin_amdgcn_fence(__ATOMIC_ACQUIRE, "agent");
            xb_add(&bar[XB_XGEN(b.x)], 1u);
            asm volatile("s_waitcnt vmcnt(0)" ::: "memory");
        } else {
            XB_SPIN(xb_ld(&bar[XB_XGEN(b.x)]) == gen, bar);
            __builtin_amdgcn_fence(__ATOMIC_ACQUIRE, "agent");
            asm volatile("s_waitcnt vmcnt(0)" ::: "memory");
        }
    }
    __syncthreads();
}


struct Frame {
    LAS unsigned char* lds;
    volatile LAS unsigned* MISC;
    gu32* ctl;
    unsigned char* ws;
    int tid, lane, wave, vcu, G;
};
struct Args { const float* in[15]; float* out; unsigned char* ws; int ph_lo, ph_hi; };

__device__ __forceinline__ float wave_sum(float v) {
#pragma unroll
    for (int o = 1; o < 64; o <<= 1) v += __shfl_xor(v, o);
    return v;
}

template <class ColMap>
__device__ __forceinline__ void p0_transpose_item(const float* W, int K, int N, bf16* WT, int nblk, LAS float* scr, int item, int lane, ColMap cm) {
    const int kb = item / nblk, nb = item % nblk, k0 = 64 * kb, n0 = 32 * nb;
    const int src = cm(n0 + (lane & 31));
#pragma unroll 8
    for (int i = 0; i < 32; ++i) { const int kk = 2 * i + (lane >> 5); scr[kk * 33 + (lane & 31)] = (src >= 0) ? W[(size_t)(k0 + kk) * N + src] : 0.f; }
    LDS_WAIT(); asm volatile("" ::: "memory");
    const int c = lane & 7;
#pragma unroll
    for (int j = 0; j < 4; ++j) { const int n = (lane >> 3) + 8 * j; const LAS float* s = scr + (8 * c) * 33 + n;
        v4u o; o.x = pk2(s[0 * 33], s[1 * 33]); o.y = pk2(s[2 * 33], s[3 * 33]); o.z = pk2(s[4 * 33], s[5 * 33]); o.w = pk2(s[6 * 33], s[7 * 33]);
        *(GAS v4u*)(WT + (size_t)(n0 + n) * K + k0 + 8 * c) = o; }
    LDS_WAIT(); asm volatile("" ::: "memory");
}
struct MapIdent { __device__ __forceinline__ int operator()(int n) const { return n; } };
struct MapWin { __device__ __forceinline__ int operator()(int n) const {
    if (n < 2048) return n;
    if (n < 2560) return 2120 + (n - 2048);
    if (n < 4608) return 2632 + (n - 2560);
    if (n < 4672) return 2048 + (n - 4608);
    if (n < 4680) return 2112 + (n - 4672);
    return -1; } };

template <int NR> __device__ __forceinline__ void rms_rows_to_bf16(const float* x, const float* g, bf16* o, int m0, int stride, int lane) {
    f32x4 v[NR][4]; float s[NR];
#pragma unroll
    for (int r = 0; r < NR; ++r) { const GAS f32x4* xr = (const GAS f32x4*)(x + (size_t)(m0 + r * stride) * DM) + lane;
#pragma unroll
        for (int j = 0; j < 4; ++j) v[r][j] = xr[64 * j]; }
#pragma unroll
    for (int r = 0; r < NR; ++r) { float a = 0.f;
#pragma unroll
        for (int j = 0; j < 4; ++j) a += (v[r][j].x * v[r][j].x + v[r][j].y * v[r][j].y) + (v[r][j].z * v[r][j].z + v[r][j].w * v[r][j].w);
        s[r] = a; }
#pragma unroll
    for (int o2 = 1; o2 < 64; o2 <<= 1) {
#pragma unroll
        for (int r = 0; r < NR; ++r) s[r] += __shfl_xor(s[r], o2);
    }
    const GAS f32x4* gr = (const GAS f32x4*)g + lane;
    f32x4 gg[4];
#pragma unroll
    for (int j = 0; j < 4; ++j) gg[j] = gr[64 * j];
#pragma unroll
    for (int r = 0; r < NR; ++r) { const float rs = 1.0f / sqrtf(s[r] * (1.f / 1024.f) + EPS);
        GAS unsigned long long* o8 = (GAS unsigned long long*)(o + (size_t)(m0 + r * stride) * DM) + lane;
#pragma unroll
        for (int j = 0; j < 4; ++j) o8[64 * j] = (unsigned long long)pk2(v[r][j].x * rs * gg[j].x, v[r][j].y * rs * gg[j].y) | ((unsigned long long)pk2(v[r][j].z * rs * gg[j].z, v[r][j].w * rs * gg[j].w) << 32); }
}

__device__ __forceinline__ void p0_prologue(Frame& F, const Args& AR) {
    LAS float* scr = (LAS float*)(F.lds + F.wave * 16384);
    const int gw = F.vcu * NWAVES + F.wave, NGW = F.G * NWAVES, lane = F.lane;
    constexpr int I_WIN = 16 * 152, I_WA = 8 * 32, I_WO = 16 * 32;
    for (int it = gw; it < I_WIN + I_WA + I_WO; it += NGW) {
        int r = it;
        if (r < I_WIN) { p0_transpose_item((AR.in[2]), 1024, IN_WIDTH, ((bf16*)(F.ws + WS_WIN)), 152, scr, r, lane, MapWin()); continue; } r -= I_WIN;
        if (r < I_WA) { p0_transpose_item((AR.in[7]), 512, 1024, ((bf16*)(F.ws + WS_WA)), 32, scr, r, lane, MapIdent()); continue; } r -= I_WA;
        p0_transpose_item((AR.in[9]), 1024, 1024, ((bf16*)(F.ws + WS_WO)), 32, scr, r, lane, MapIdent());
    }
    for (int it = gw; it < 16 * 64; it += NGW) {
        const int nb = it & 15, kb = it >> 4, n = nb * 64 + lane, k0 = kb * 8, g = k0 >> 7, c0 = k0 & 127;
        float acc[8];
#pragma unroll
        for (int j = 0; j < 8; ++j) acc[j] = 0.f;
        for (int d = 0; d < 128; ++d) {
            const float wv = (AR.in[8])[(size_t)(g * 128 + d) * 1024 + n] * (AR.in[6])[g * 128 + d];
#pragma unroll
            for (int j = 0; j < 8; ++j) acc[j] += (AR.in[5])[(size_t)(g * 128 + c0 + j) * 128 + d] * wv;
        }
        v4u o; o.x = pk2(acc[0], acc[1]); o.y = pk2(acc[2], acc[3]); o.z = pk2(acc[4], acc[5]); o.w = pk2(acc[6], acc[7]);
        *(GAS v4u*)(((bf16*)(F.ws + WS_WPP)) + (size_t)n * 512 + k0) = o;
    }
    for (int it = gw; it < 16 * 32; it += NGW) p0_transpose_item((AR.in[11]), 1024, 1024, ((bf16*)(F.ws + WS_W2)), 32, scr, it, lane, MapIdent());
    for (int it = gw; it < 256; it += NGW) { const size_t e0 = (size_t)it * 512 + lane * 8;
        const f32x4 a = *(const GAS f32x4*)((AR.in[12]) + e0), b = *(const GAS f32x4*)((AR.in[12]) + e0 + 4);
        v4u o; o.x = pk2(a.x, a.y); o.y = pk2(a.z, a.w); o.z = pk2(b.x, b.y); o.w = pk2(b.z, b.w);
        *(GAS v4u*)(((bf16*)(F.ws + WS_SKB)) + e0) = o; }
    {   float mu = 0.f, mv = 0.f;
#pragma unroll 4
        for (int it = gw; it < 2 * 32768; it += NGW) {
            const float* src = (it < 32768) ? (AR.in[13]) : (AR.in[14]); const size_t e0 = (size_t)(it & 32767) * 512 + lane * 8;
            const f32x4 a = *(const GAS f32x4*)(src + e0), b = *(const GAS f32x4*)(src + e0 + 4);
            const float m = fmaxf(fmaxf(fmaxf(fabsf(a.x), fabsf(a.y)), fmaxf(fabsf(a.z), fabsf(a.w))), fmaxf(fmaxf(fabsf(b.x), fabsf(b.y)), fmaxf(fabsf(b.z), fabsf(b.w))));
            if (it < 32768) mu = fmaxf(mu, m); else mv = fmaxf(mv, m);
        }
#pragma unroll
        for (int o = 1; o < 64; o <<= 1) { mu = fmaxf(mu, __shfl_xor(mu, o)); mv = fmaxf(mv, __shfl_xor(mv, o)); }
        if (lane == 0) { __hip_atomic_fetch_max(F.ctl + CW_AMAX, __float_as_uint(mu), RLX_AGENT); __hip_atomic_fetch_max(F.ctl + CW_AMAX + 1, __float_as_uint(mv), RLX_AGENT); }
    }
    for (int it = gw * 64 + lane; it < 4096 * 8; it += NGW * 64) {
        const int pos = it >> 3, i = it & 7;
        const float invf = exp2f(-(float)i * 0.125f * 18.931568569324174f);
        const double ang = (double)((float)pos * invf);
        const double kq = __builtin_rint(ang * 0.6366197723675814);
        const float r = (float)(ang - kq * 1.5707963267948966);
        const int q = (int)((long long)kq & 3);
        const float r2 = r * r;
        const float sn = r + r * r2 * (-1.6666654611e-1f + r2 * (8.3321608736e-3f + r2 * (-1.9515295891e-4f)));
        const float cs = 1.0f - 0.5f * r2 + r2 * r2 * (4.166664568298827e-2f + r2 * (-1.388731625493765e-3f + r2 * 2.443315711809948e-5f));
        const float s = (q == 0) ? sn : (q == 1) ? cs : (q == 2) ? -sn : -cs;
        const float c = (q == 0) ? cs : (q == 1) ? -sn : (q == 2) ? -cs : sn;
        ((float*)(F.ws + WS_ROPE))[pos * 16 + i] = c; ((float*)(F.ws + WS_ROPE))[pos * 16 + 8 + i] = s;
    }
    { int m = gw;
      for (; m + 3 * NGW < MTOK; m += 4 * NGW) rms_rows_to_bf16<4>((AR.in[0]), (AR.in[1]), ((bf16*)(F.ws + WS_ACT)), m, NGW, lane);
      for (; m < MTOK; m += NGW) rms_rows_to_bf16<1>((AR.in[0]), (AR.in[1]), ((bf16*)(F.ws + WS_ACT)), m, NGW, lane); }
}

__device__ __forceinline__ void unpack8(const v4u w, float (&v)[8]) { v[0] = bflo(w.x); v[1] = bfhi(w.x); v[2] = bflo(w.y); v[3] = bfhi(w.y); v[4] = bflo(w.z); v[5] = bfhi(w.z); v[6] = bflo(w.w); v[7] = bfhi(w.w); }
__device__ __forceinline__ v4u pack8(const float (&v)[8]) { v4u o; o.x = pk2(v[0], v[1]); o.y = pk2(v[2], v[3]); o.z = pk2(v[4], v[5]); o.w = pk2(v[6], v[7]); return o; }
__device__ __forceinline__ void rope8(float (&v)[8], int sub, const float (&cs)[8], const float (&sn)[8]) {
    float pv[8];
#pragma unroll
    for (int j = 0; j < 8; ++j) pv[j] = __shfl_xor(v[j], 1);
    if (sub == 0) {
#pragma unroll
        for (int j = 0; j < 8; ++j) v[j] = v[j] * cs[j] - pv[j] * sn[j];
    } else if (sub == 1) {
#pragma unroll
        for (int j = 0; j < 8; ++j) v[j] = v[j] * cs[j] + pv[j] * sn[j];
    }
}
__device__ __forceinline__ float fp8_scale(unsigned amax_bits) { const unsigned be = (amax_bits >> 23) & 0xffu; return (be == 0u || be > 250u) ? 1.0f : __uint_as_float((261u - be) << 23); }
__device__ __forceinline__ float fp8_inv_scale(unsigned amax_bits) { const unsigned be = (amax_bits >> 23) & 0xffu; return (be == 0u || be > 250u) ? 1.0f : __uint_as_float((be - 7u) << 23); }
__device__ __forceinline__ void row_to_fp8(const float* src, unsigned char* dst, float sc, int lane) {
    const GAS f32x4* p = (const GAS f32x4*)src + lane * 4; v4u o;
#pragma unroll
    for (int q = 0; q < 4; ++q) { const f32x4 a = p[q]; int w = 0; w = __builtin_amdgcn_cvt_pk_fp8_f32(a.x * sc, a.y * sc, w, false); w = __builtin_amdgcn_cvt_pk_fp8_f32(a.z * sc, a.w * sc, w, true); o[q] = (unsigned)w; }
    *(GAS v4u*)(dst + lane * 16) = o;
}
__device__ __forceinline__ void fixup_token(Frame& F, const Args& AR, int tok) {
    const int lane = F.lane, sub = lane & 7, pos = tok & (SEQ - 1);
    bf16* row = ((bf16*)(F.ws + WS_PROJ)) + (size_t)tok * LDP;
    float cs[8], sn[8];
    { const GAS f32x4* rt = (const GAS f32x4*)(((float*)(F.ws + WS_ROPE)) + pos * 16); const f32x4 a = rt[0], b = rt[1], c = rt[2], d = rt[3];
      cs[0] = a.x; cs[1] = a.y; cs[2] = a.z; cs[3] = a.w; cs[4] = b.x; cs[5] = b.y; cs[6] = b.z; cs[7] = b.w;
      sn[0] = c.x; sn[1] = c.y; sn[2] = c.z; sn[3] = c.w; sn[4] = d.x; sn[5] = d.y; sn[6] = d.z; sn[7] = d.w; }
#pragma unroll
    for (int which = 0; which < 2; ++which) {
        GAS v4u* p = (GAS v4u*)(row + (which ? K_OFF : Q_OFF) + lane * 8);
        float v[8]; unpack8(*p, v);
        float ss = 0.f;
#pragma unroll
        for (int j = 0; j < 8; ++j) ss += v[j] * v[j];
        ss += __shfl_xor(ss, 1); ss += __shfl_xor(ss, 2); ss += __shfl_xor(ss, 4);
        const float rs = 1.0f / sqrtf(ss * (1.f / 64.f) + EPS);
        const float* g = (which ? (AR.in[4]) : (AR.in[3])) + sub * 8;
#pragma unroll
        for (int j = 0; j < 8; ++j) v[j] = v[j] * rs * g[j];
        rope8(v, sub, cs, sn);
        if (which == 0) {
#pragma unroll
            for (int j = 0; j < 8; ++j) v[j] *= C2;
        }
        *p = pack8(v);
    }
    { GAS v4u* p = (GAS v4u*)(row + QI_OFF + lane * 8); float v[8]; unpack8(*p, v); rope8(v, sub, cs, sn); *p = pack8(v); }
    { GAS v4u* p = (GAS v4u*)(row + KI_OFF + (lane & 7) * 8); float v[8]; unpack8(*p, v); rope8(v, sub, cs, sn); if (lane < 8) *p = pack8(v); }
}
__device__ __forceinline__ void pool_run(Frame& F, int tok0, int ntok) {
    const int lane = F.lane, g = lane >> 4, w = 2 << g;
    const bf16* pcol = ((const bf16*)(F.ws + WS_PROJ)) + P_OFF + lane * 8;
    float S[8];
#pragma unroll
    for (int j = 0; j < 8; ++j) S[j] = 0.f;
    { const int pos0 = tok0 & (SEQ - 1);
#pragma unroll
      for (int back = 1; back < 16; ++back) {
          if (back < w && back <= pos0) { float t[8]; unpack8(*(const GAS v4u*)(pcol + (size_t)(tok0 - back) * LDP), t);
#pragma unroll
              for (int j = 0; j < 8; ++j) S[j] += t[j]; }
      } }
#pragma unroll 1
    for (int i = 0; i < ntok; ++i) {
        const int tok = tok0 + i, pos = tok & (SEQ - 1);
        float cur[8]; unpack8(*(const GAS v4u*)(pcol + (size_t)tok * LDP), cur);
#pragma unroll
        for (int j = 0; j < 8; ++j) S[j] += cur[j];
        const float inv = 1.0f / (float)((pos + 1 < w) ? (pos + 1) : w);
        float o[8];
#pragma unroll
        for (int j = 0; j < 8; ++j) o[j] = S[j] * inv - cur[j];
        *(GAS v4u*)(((bf16*)(F.ws + WS_POOLED)) + (size_t)tok * 512 + lane * 8) = pack8(o);
        if (pos + 1 >= w) { float t[8]; unpack8(*(const GAS v4u*)(pcol + (size_t)(tok + 1 - w) * LDP), t);
#pragma unroll
            for (int j = 0; j < 8; ++j) S[j] -= t[j]; }
    }
}

__device__ __forceinline__ int wave_incl_scan(int v) {
    v += __builtin_amdgcn_update_dpp(0, v, 0x111, 0xf, 0xf, false);
    v += __builtin_amdgcn_update_dpp(0, v, 0x112, 0xf, 0xf, false);
    v += __builtin_amdgcn_update_dpp(0, v, 0x114, 0xf, 0xf, false);
    v += __builtin_amdgcn_update_dpp(0, v, 0x118, 0xf, 0xf, false);
    v += __builtin_amdgcn_update_dpp(0, v, 0x142, 0xa, 0xf, false);
    v += __builtin_amdgcn_update_dpp(0, v, 0x143, 0xc, 0xf, false);
    return v;
}
template <int NB> __device__ __forceinline__ void hist_search(const LAS unsigned* hist, int need, int lane, int& B, int& G, int& E) {
    constexpr int PER = NB / 64;
    int t = 0;
#pragma unroll
    for (int q = 0; q < PER / 4; ++q) { const v4u h = *(const LAS v4u*)(hist + lane * PER + 4 * q); t += (int)(h.x + h.y + h.z + h.w); }
    const int pfx = wave_incl_scan(t);
    const int L = __ffsll((long long)__ballot(pfx >= need)) - 1;
    const int base = __builtin_amdgcn_readlane(pfx, L) - __builtin_amdgcn_readlane(t, L);
    const int hv = (lane < PER) ? (int)hist[L * PER + lane] : 0;
    const int p2 = wave_incl_scan(hv) + base;
    const int i = __ffsll((long long)__ballot(p2 >= need)) - 1;
    B = L * PER + i; E = __builtin_amdgcn_readlane(hv, i); G = __builtin_amdgcn_readlane(p2, i) - E;
}
template <int NB> __device__ __forceinline__ void hist_zero(LAS unsigned* hist, int lane) {
#pragma unroll
    for (int q = 0; q < NB / 256; ++q) *(LAS v4u*)(hist + q * 256 + lane * 4) = (v4u){0u, 0u, 0u, 0u};
}
#define HIST_ADD(p) (void)__hip_atomic_fetch_add((p), 1u, __ATOMIC_RELAXED, __HIP_MEMORY_SCOPE_WORKGROUP)
#define wlane(dst, sval, j) asm volatile("s_nop 3\n\tv_writelane_b32 %0, %1, %2\n\ts_nop 1" : "+v"(dst) : "s"(sval), "i"(j))
__device__ __forceinline__ void select_row(const unsigned short* srow  , LAS unsigned* hist, int nj, int lastw, GAS unsigned long long* mout, int lane) {
    unsigned key[64];
#pragma unroll
    for (int g = 0; g < 8; ++g) {
        if (nj > 8 * g) {
#pragma unroll
            for (int jj = 0; jj < 8; ++jj) key[8 * g + jj] = ordk(__uint_as_float((unsigned)((const GAS unsigned short*)srow)[(64 * (8 * g + jj) + lane) * 8] << 16) + 0.0f);
        } else {
#pragma unroll
            for (int jj = 0; jj < 8; ++jj) key[8 * g + jj] = 0u;
        }
    }
    LDS_WAIT(); asm volatile("" ::: "memory");
    int need = 256, B, G, E;
    hist_zero<2048>(hist, lane); LDS_WAIT(); asm volatile("" ::: "memory");
#pragma unroll
    for (int g = 0; g < 8; ++g) if (nj > 8 * g) {
#pragma unroll
        for (int jj = 0; jj < 8; ++jj) HIST_ADD(hist + (2047u - (key[8 * g + jj] >> 21)));
    }
    LDS_WAIT(); asm volatile("" ::: "memory");
    hist_search<2048>(hist, need, lane, B, G, E); need -= G;
    const unsigned d1 = 2047u - (unsigned)B;
    asm volatile("" ::: "memory"); hist_zero<2048>(hist, lane); LDS_WAIT(); asm volatile("" ::: "memory");
#pragma unroll
    for (int g = 0; g < 8; ++g) if (nj > 8 * g) {
#pragma unroll
        for (int jj = 0; jj < 8; ++jj) { const unsigned k = key[8 * g + jj]; if ((k >> 21) == d1) HIST_ADD(hist + (2047u - ((k >> 10) & 0x7ffu))); }
    }
    LDS_WAIT(); asm volatile("" ::: "memory");
    hist_search<2048>(hist, need, lane, B, G, E); need -= G;
    const unsigned pre2 = (d1 << 11) | (2047u - (unsigned)B);
    const unsigned v = pre2 << 10;
    unsigned mlo = 0u, mhi = 0u;
#pragma unroll
    for (int g = 0; g < 8; ++g) {
        asm volatile("v_cmp_ge_u32_e64 s[40:41], %2, %10\n\tv_cmp_ge_u32_e64 s[42:43], %3, %10\n\tv_cmp_ge_u32_e64 s[44:45], %4, %10\n\tv_cmp_ge_u32_e64 s[46:47], %5, %10\n\t"
                     "v_cmp_ge_u32_e64 s[48:49], %6, %10\n\tv_cmp_ge_u32_e64 s[50:51], %7, %10\n\tv_cmp_ge_u32_e64 s[52:53], %8, %10\n\tv_cmp_ge_u32_e64 s[54:55], %9, %10\n\ts_nop 1\n\t"
                     "v_writelane_b32 %0, s40, %11\n\tv_writelane_b32 %1, s41, %11\n\tv_writelane_b32 %0, s42, %12\n\tv_writelane_b32 %1, s43, %12\n\t"
                     "v_writelane_b32 %0, s44, %13\n\tv_writelane_b32 %1, s45, %13\n\tv_writelane_b32 %0, s46, %14\n\tv_writelane_b32 %1, s47, %14\n\t"
                     "v_writelane_b32 %0, s48, %15\n\tv_writelane_b32 %1, s49, %15\n\tv_writelane_b32 %0, s50, %16\n\tv_writelane_b32 %1, s51, %16\n\t"
                     "v_writelane_b32 %0, s52, %17\n\tv_writelane_b32 %1, s53, %17\n\tv_writelane_b32 %0, s54, %18\n\tv_writelane_b32 %1, s55, %18\n\ts_nop 1"
                     : "+v"(mlo), "+v"(mhi)
                     : "v"(key[8 * g]), "v"(key[8 * g + 1]), "v"(key[8 * g + 2]), "v"(key[8 * g + 3]), "v"(key[8 * g + 4]), "v"(key[8 * g + 5]), "v"(key[8 * g + 6]), "v"(key[8 * g + 7]), "v"(v),
                       "i"(8 * g), "i"(8 * g + 1), "i"(8 * g + 2), "i"(8 * g + 3), "i"(8 * g + 4), "i"(8 * g + 5), "i"(8 * g + 6), "i"(8 * g + 7)
                     : "s40", "s41", "s42", "s43", "s44", "s45", "s46", "s47", "s48", "s49", "s50", "s51", "s52", "s53", "s54", "s55");
    }
    int drop = E - need;
#pragma unroll
    for (int j = 63; j >= 0; --j) {
        if (drop > 0) {
            unsigned long long eq = __ballot(key[j] == v);
            if (eq != 0ull) {
                unsigned long long rem = 0ull;
                while (drop > 0 && eq != 0ull) { const unsigned long long hb = 1ull << (63 - __clzll((long long)eq)); rem |= hb; eq ^= hb; --drop; }
                const unsigned long long m = __ballot(key[j] >= v) & ~rem;
                wlane(mlo, (unsigned)m, j); wlane(mhi, (unsigned)(m >> 32), j);
            }
        }
    }
    if (lane <= lastw) mout[lane] = ((unsigned long long)mhi << 32) | (unsigned long long)mlo;
    LDS_WAIT(); asm volatile("" ::: "memory");
}

__device__ __forceinline__ float* wave_scratch(unsigned char* ws, int gwv) {
    if (gwv < 1024) return (float*)(ws + WS_ACT) + (size_t)gwv * 32768;
    gwv -= 1024; if (gwv < 512) return (float*)(ws + WS_AO) + (size_t)gwv * 32768;
    gwv -= 512; if (gwv < 352) return (float*)(ws + 980 * MiB) + (size_t)gwv * 32768;
    gwv -= 352; if (gwv < 128) return (float*)(ws + 36 * MiB) + (size_t)gwv * 32768;
    gwv -= 128; return (float*)(ws + 68 * MiB) + (size_t)(gwv & 127) * 32768;
}
__device__ __forceinline__ void idx_unit(Frame& F, const Args& AR, int b, int c, bool do_select = true) {
    const int lane = F.lane, wid = F.wave, l31 = lane & 31, h2 = lane >> 5;
    const size_t rowb = (size_t)b * SEQ, tp0 = rowb + (size_t)c * 64 + wid * 8;
    GAS unsigned long long* mbase = (GAS unsigned long long*)(((unsigned long long*)(F.ws + WS_MASK)) + tp0 * 64);
    if (c < 4) {
        if (lane < 32) { const int q = lane >> 2, j = lane & 3; mbase[q * 64 + j] = (j <= c) ? ~0ull : 0ull; }
        return;
    }
    unsigned short* sc = (unsigned short*)wave_scratch(F.ws, F.vcu * NWAVES + wid);
    LAS unsigned* hist = (LAS unsigned*)(F.lds + wid * 8192);
    const int ntile = 2 * (c + 1), nj = c + 1, lastw = c | 3, ntile_pad = 16 * ((nj + 7) >> 3);
    const int head = (l31 & 3) | (((l31 >> 3) & 1) << 2), qsub = ((l31 >> 2) & 1) | (((l31 >> 4) & 1) << 1);
    bf16x8 a[2][4]; float w[2][16];
#pragma unroll
    for (int rb = 0; rb < 2; ++rb) {
        const bf16* ap = ((bf16*)(F.ws + WS_PROJ)) + (tp0 + 4 * rb + qsub) * LDP + QI_OFF + head * 64 + h2 * 8;
#pragma unroll
        for (int st = 0; st < 4; ++st) a[rb][st] = *(const GAS bf16x8*)(ap + st * 16);
        const v4u wa = *(const GAS v4u*)(((bf16*)(F.ws + WS_PROJ)) + (tp0 + 4 * rb + h2) * LDP + WI_OFF), wb = *(const GAS v4u*)(((bf16*)(F.ws + WS_PROJ)) + (tp0 + 4 * rb + h2 + 2) * LDP + WI_OFF);
        float t[8]; unpack8(wa, t);
#pragma unroll
        for (int j = 0; j < 8; ++j) w[rb][j] = t[j] * WI_SCALE;
        unpack8(wb, t);
#pragma unroll
        for (int j = 0; j < 8; ++j) w[rb][8 + j] = t[j] * WI_SCALE;
    }
    {
        LAS unsigned char* kb = F.lds + 65536;
        const int nstage = (ntile + 3) >> 2;
        const int sk0 = F.tid >> 3, sch = F.tid & 7;
        const bf16* kg = ((bf16*)(F.ws + WS_PROJ)) + (rowb + sk0) * LDP + KI_OFF + sch * 8;
        v4u r0 = *(const GAS v4u*)kg, r1 = *(const GAS v4u*)(kg + (size_t)64 * LDP);
#pragma unroll 1
        for (int sg = 0; sg < nstage; ++sg) {
            LAS unsigned char* cur = kb + (sg & 1) * 18432;
            *(LAS v4u*)(cur + sk0 * 144 + sch * 16) = r0; *(LAS v4u*)(cur + (sk0 + 64) * 144 + sch * 16) = r1;
            BAR_LDS();
            { const int sn = (sg + 1 < nstage) ? sg + 1 : sg; r0 = *(const GAS v4u*)(kg + (size_t)sn * 128 * LDP); r1 = *(const GAS v4u*)(kg + (size_t)(sn * 128 + 64) * LDP); }
#pragma unroll
            for (int t4 = 0; t4 < 4; ++t4) {
                const int kt = 4 * sg + t4;
                if (kt < ntile) {
                    bf16x8 bfr[4];
#pragma unroll
                    for (int st = 0; st < 4; ++st) bfr[st] = *(const LAS bf16x8*)(cur + (t4 * 32 + l31) * 144 + st * 32 + h2 * 16);
                    float sq[4];
#pragma unroll
                    for (int rb = 0; rb < 2; ++rb) {
                        f32x16 acc;
#pragma unroll
                        for (int r = 0; r < 16; ++r) acc[r] = 0.f;
#pragma unroll
                        for (int st = 0; st < 4; ++st) acc = __builtin_amdgcn_mfma_f32_32x32x16_bf16(a[rb][st], bfr[st], acc, 0, 0, 0);
                        float s0 = 0.f, s1 = 0.f;
#pragma unroll
                        for (int r = 0; r < 8; ++r) { s0 = fmaf(w[rb][r], fmaxf(acc[r], 0.f), s0); s1 = fmaf(w[rb][8 + r], fmaxf(acc[8 + r], 0.f), s1); }
                        sq[2 * rb] = s0; sq[2 * rb + 1] = s1;
                    }
                    *(GAS v2u*)(sc + (size_t)(kt * 32 + l31) * 8 + 4 * h2) = (v2u){pk2(sq[0], sq[1]), pk2(sq[2], sq[3])};
                }
            }
        }
        for (int kt = ntile; kt < ntile_pad; ++kt)
            *(GAS v2u*)(sc + (size_t)(kt * 32 + l31) * 8 + 4 * h2) = (v2u){0xff80ff80u, 0xff80ff80u};
    }
    VM_WAIT();
    if (do_select) {
#pragma unroll 1
        for (int q = 0; q < 8 * PROBE_SEL2; ++q) select_row(sc + 4 * (q & 1) + ((q & 7) >> 1), hist, nj, lastw, mbase + (q & 7) * 64, lane);
    }
}

__device__ __forceinline__ void attn_unit(Frame& F, const Args& AR, int b, int h, int qb, unsigned long long& tacc, unsigned& tcnt) {
    const int lane = F.lane, wid = F.wave, l31 = lane & 31, h2 = lane >> 5;
    LAS unsigned char* Ks = F.lds;
    LAS float* wsf = (LAS float*)(F.lds + 2 * 17408) + wid * 32;
    const size_t rowb = (size_t)b * SEQ, tok0 = rowb + (size_t)qb * 256 + wid * 32;
    bf16x8 qf[4];
    { const bf16* qp = ((bf16*)(F.ws + WS_PROJ)) + (tok0 + l31) * LDP + Q_OFF + h * 64 + h2 * 8;
#pragma unroll
      for (int st = 0; st < 4; ++st) qf[st] = *(const GAS bf16x8*)(qp + st * 16); }
    const int NT = 4 * (qb + 1), cw = qb * 4 + (wid >> 1);
    f32x16 o0, o1;
#pragma unroll
    for (int r = 0; r < 16; ++r) { o0[r] = 0.f; o1[r] = 0.f; }
    float lsum = 0.f;
    const int skey = F.tid >> 3, sch = F.tid & 7;
    const bf16* kg = ((bf16*)(F.ws + WS_PROJ)) + (rowb + skey) * LDP + K_OFF + h * 64 + sch * 8;
    const bf16* vg = ((bf16*)(F.ws + WS_PROJ)) + (rowb + skey) * LDP + V_OFF + h * 64 + sch * 8;
    const unsigned kst = skey * 144 + sch * 16, vst = skey * 128 + ((sch * 16) ^ (((skey >> 1) & 1) << 6));
    const GAS unsigned long long* mrow = (const GAS unsigned long long*)(((unsigned long long*)(F.ws + WS_MASK)) + (tok0 + l31) * 64);
    const int i16 = lane & 15, qq = i16 >> 2, pp = i16 & 3, blk = (lane >> 4) & 1;
    const unsigned vrd = (unsigned)((4 * h2 + qq) * 128 + ((32 * blk + 8 * pp) ^ (((qq >> 1) & 1) << 6)));
    v4u kr[3], vr[3];
#pragma unroll
    for (int u = 0; u < 3; ++u) { kr[u] = *(const GAS v4u*)(kg + (size_t)u * 64 * LDP); vr[u] = *(const GAS v4u*)(vg + (size_t)u * 64 * LDP); }
    unsigned long long mwn = mrow[0];
#pragma unroll 1
    for (int t = 0; t < NT; t += 3) {
#pragma unroll
        for (int u = 0; u < 3; ++u) {
            const int tt = t + u;
            if (tt < NT) {
                LAS unsigned char* Kc = Ks + (tt & 1) * 17408; LAS unsigned char* Vc = Kc + 9216;
                const unsigned long long t_a = PROBE_SEC ? __builtin_amdgcn_s_memtime() : 0ull;
                *(LAS v4u*)(Kc + kst) = kr[u]; *(LAS v4u*)(Vc + vst) = vr[u];
                BAR_LDS();
                const unsigned long long t_b = PROBE_SEC ? __builtin_amdgcn_s_memtime() : 0ull;
                { const int tn = (tt + 3 < NT) ? tt + 3 : NT - 1;
                  kr[u] = *(const GAS v4u*)(kg + (size_t)tn * 64 * LDP); vr[u] = *(const GAS v4u*)(vg + (size_t)tn * 64 * LDP); }
                const unsigned long long mw = mwn;
                mwn = mrow[(tt + 1 < NT) ? tt + 1 : tt];
                if (tt <= cw) {
                    bf16x8 vfr[2][2][2];
        #pragma unroll
                    for (int kb = 0; kb < 2; ++kb)
        #pragma unroll
                        for (int s = 0; s < 2; ++s)
        #pragma unroll
                            for (int d0 = 0; d0 < 2; ++d0) {
                                const unsigned ad = (vrd + (unsigned)((32 * kb + 16 * s) * 128)) ^ (unsigned)(d0 << 6);
                                const s16x4 lo = __builtin_bit_cast(s16x4, __builtin_amdgcn_ds_read_tr16_b64_v4i16((LAS s16x4*)(Vc + ad)));
                                const s16x4 hi = __builtin_bit_cast(s16x4, __builtin_amdgcn_ds_read_tr16_b64_v4i16((LAS s16x4*)(Vc + ad + 8 * 128)));
                                vfr[kb][s][d0] = (bf16x8){lo[0], lo[1], lo[2], lo[3], hi[0], hi[1], hi[2], hi[3]};
                            }
                    f32x16 p[2];
        #pragma unroll
                    for (int kb = 0; kb < 2; ++kb) {
                        f32x16 acc;
        #pragma unroll
                        for (int r = 0; r < 16; ++r) acc[r] = 0.f;
        #pragma unroll
                        for (int st = 0; st < 4; ++st) { const bf16x8 ka = *(const LAS bf16x8*)(Kc + (32 * kb + l31) * 144 + st * 32 + h2 * 16); acc = __builtin_amdgcn_mfma_f32_32x32x16_bf16(ka, qf[st], acc, 0, 0, 0); }
                        const unsigned wk = (kb ? (unsigned)(mw >> 32) : (unsigned)mw) >> (4 * h2);
        #pragma unroll
                        for (int r = 0; r < 16; ++r) {
                            const float e = __builtin_amdgcn_exp2f(acc[r]);
                            float pe;
                            asm("v_bfe_i32 %0, %2, %3, 1\n\tv_and_b32 %0, %0, %1" : "=&v"(pe) : "v"(e), "v"(wk), "i"((r & 3) + 8 * (r >> 2)));
                            acc[r] = pe;
                        }
                        p[kb] = acc;
                    }
                    const unsigned long long t_c = PROBE_SEC ? __builtin_amdgcn_s_memtime() : 0ull;
        #pragma unroll
                    for (int kb = 0; kb < 2; ++kb)
        #pragma unroll
                        for (int s = 0; s < 2; ++s) {
                            v4u pw; pw.x = pg8::cvt_pk_bf16(p[kb][8 * s + 0], p[kb][8 * s + 1]); pw.y = pg8::cvt_pk_bf16(p[kb][8 * s + 2], p[kb][8 * s + 3]); pw.z = pg8::cvt_pk_bf16(p[kb][8 * s + 4], p[kb][8 * s + 5]); pw.w = pg8::cvt_pk_bf16(p[kb][8 * s + 6], p[kb][8 * s + 7]);
                            lsum = dot2bf(pw.x, 0x3f803f80u, lsum); lsum = dot2bf(pw.y, 0x3f803f80u, lsum); lsum = dot2bf(pw.z, 0x3f803f80u, lsum); lsum = dot2bf(pw.w, 0x3f803f80u, lsum);
                            const bf16x8 pa = __builtin_bit_cast(bf16x8, pw);
        #pragma unroll
                            for (int d0 = 0; d0 < 2; ++d0) {
                                const bf16x8 vb = vfr[kb][s][d0];
                                if (d0 == 0) o0 = __builtin_amdgcn_mfma_f32_32x32x16_bf16(pa, vb, o0, 0, 0, 0); else o1 = __builtin_amdgcn_mfma_f32_32x32x16_bf16(pa, vb, o1, 0, 0, 0);
                            }
                        }
                    if (PROBE_SEC) { const unsigned long long t_d = __builtin_amdgcn_s_memtime(); tacc += (PROBE_SEC == 1) ? (t_b - t_a) : (PROBE_SEC == 2) ? (t_c - t_b) : (PROBE_SEC == 3) ? (t_d - t_c) : (t_d - t_a); ++tcnt; }
                }
            }
        }
    }
    lsum += __shfl_xor(lsum, 32);
    if (h2 == 0) wsf[l31] = lsum;
    LDS_WAIT(); asm volatile("" ::: "memory");
    LAS bf16* stg = (LAS bf16*)(F.lds + 2 * 17408 + 1024) + wid * 2048;
#pragma unroll
    for (int r = 0; r < 16; ++r) { const int q = crow(r, h2); const float rl = 1.0f / wsf[q];
        stg[q * 64 + l31] = (bf16)f2bf(o0[r] * rl); stg[q * 64 + 32 + l31] = (bf16)f2bf(o1[r] * rl); }
    LDS_WAIT(); asm volatile("" ::: "memory");
    bf16* ow = ((bf16*)(F.ws + WS_AO)) + tok0 * 512 + h * 64;
#pragma unroll
    for (int i = 0; i < 4; ++i) { const int row = i * 8 + (lane >> 3), ch = lane & 7; const v4u v = *(const LAS v4u*)(stg + row * 64 + ch * 8); *(GAS v4u*)(ow + (size_t)row * 512 + ch * 8) = v; }
    LDS_WAIT(); asm volatile("" ::: "memory");
}

__device__ __forceinline__ float row_rs(const float* ssp, size_t tok) {
    const GAS f32x4* p = (const GAS f32x4*)(ssp + tok * 16); const f32x4 a = p[0], b = p[1], c = p[2], d = p[3];
    const float ss = ((a.x + a.y) + (a.z + a.w)) + ((b.x + b.y) + (b.z + b.w)) + ((c.x + c.y) + (c.z + c.w)) + ((d.x + d.y) + (d.z + d.w));
    return 1.0f / sqrtf(ss * (1.f / 1024.f) + EPS);
}
__device__ __forceinline__ void sort16_desc(unsigned (&a)[16]) {
#pragma unroll
    for (int k = 2; k <= 16; k <<= 1)
#pragma unroll
        for (int j = k >> 1; j > 0; j >>= 1)
#pragma unroll
            for (int i = 0; i < 16; ++i) { const int l = i ^ j; if (l > i) { const unsigned hi = a[i] > a[l] ? a[i] : a[l], lo = a[i] > a[l] ? a[l] : a[i];
                if ((i & k) == 0) { a[i] = hi; a[l] = lo; } else { a[i] = lo; a[l] = hi; } } }
}
__device__ __forceinline__ void merge16_desc(unsigned (&top)[16], const unsigned (&a)[16]) {
#pragma unroll
    for (int i = 0; i < 16; ++i) top[i] = top[i] > a[15 - i] ? top[i] : a[15 - i];
#pragma unroll
    for (int j = 8; j > 0; j >>= 1)
#pragma unroll
        for (int i = 0; i < 16; ++i) { const int l = i ^ j; if (l > i) { const unsigned hi = top[i] > top[l] ? top[i] : top[l], lo = top[i] > top[l] ? top[l] : top[i]; top[i] = hi; top[l] = lo; } }
}
struct PairTab { int i[64], j[64]; };
constexpr PairTab make_pairs() { PairTab t{}; int n = 0; for (int i = 0; i < 16; ++i) for (int j = 0; j < 16; ++j) if ((i + 1) * (j + 1) <= 16) { t.i[n] = i; t.j[n] = j; ++n; } for (; n < 64; ++n) { t.i[n] = -1; t.j[n] = -1; } return t; }
__device__ __forceinline__ void route_task(Frame& F, const Args& AR, int tt, int h) {
    const int lane = F.lane, l31 = lane & 31, h2 = lane >> 5;
    const size_t tok = (size_t)tt * 32 + l31;
    LAS unsigned* lk = (LAS unsigned*)F.lds;
    unsigned KA[16], KB[16];
#pragma unroll
    for (int i = 0; i < 16; ++i) { KA[i] = 0u; KB[i] = 0u; }
#pragma unroll 1
    for (int p = 0; p < 2; ++p) {
        const int hp = 2 * h + p;
        bf16x8 bq[4];
        { const bf16* qp = ((const bf16*)(F.ws + WS_SUBK)) + tok * 1024 + hp * 64 + h2 * 8;
#pragma unroll
          for (int st = 0; st < 4; ++st) bq[st] = *(const GAS bf16x8*)(qp + st * 16); }
        unsigned top[16];
#pragma unroll
        for (int i = 0; i < 16; ++i) top[i] = 0u;
#pragma unroll 1
        for (int blk = 0; blk < 4; ++blk) {
            const bf16* ap = ((const bf16*)(F.ws + WS_SKB)) + (size_t)(hp * 128 + 32 * blk + l31) * 64 + h2 * 8;
            f32x16 acc;
#pragma unroll
            for (int r = 0; r < 16; ++r) acc[r] = 0.f;
#pragma unroll
            for (int st = 0; st < 4; ++st) { const bf16x8 af = *(const GAS bf16x8*)(ap + st * 16); acc = __builtin_amdgcn_mfma_f32_32x32x16_bf16(af, bq[st], acc, 0, 0, 0); }
            unsigned a16[16];
#pragma unroll
            for (int r = 0; r < 16; ++r) a16[r] = (ordk(acc[r]) & ~127u) | (unsigned)(127 - (32 * blk + (r & 3) + 8 * (r >> 2)) - 4 * h2);
            sort16_desc(a16);
            merge16_desc(top, a16);
        }
        unsigned oth[16];
#pragma unroll
        for (int i = 0; i < 16; ++i) oth[i] = __shfl_xor(top[i], 32);
        merge16_desc(top, oth);
#pragma unroll
        for (int i = 0; i < 16; ++i) { if (p == 0) KA[i] = top[i]; else KB[i] = top[i]; }
    }
    float sa[16], sb[16];
#pragma unroll
    for (int i = 0; i < 16; ++i) { sa[i] = unordk(KA[i] & ~127u); sb[i] = unordk(KB[i] & ~127u); lk[i * 512 + F.tid] = KA[i]; lk[(16 + i) * 512 + F.tid] = KB[i]; }
    unsigned ck[16];
#pragma unroll
    for (int grp = 0; grp < 4; ++grp) {
        unsigned a[16];
#pragma unroll
        for (int q = 0; q < 16; ++q) { constexpr PairTab T = make_pairs(); const int pi = T.i[grp * 16 + q], pj = T.j[grp * 16 + q];
            a[q] = (pi < 0) ? 0u : ((ordk(sa[pi < 0 ? 0 : pi] + sb[pj < 0 ? 0 : pj]) & ~255u) | (unsigned)(255 - (pi * 16 + pj))); }
        sort16_desc(a);
        if (grp == 0) {
#pragma unroll
            for (int i = 0; i < 16; ++i) ck[i] = a[i];
        } else merge16_desc(ck, a);
    }
    LDS_WAIT(); asm volatile("" ::: "memory");
    unsigned ce[16];
#pragma unroll
    for (int t = 0; t < 16; ++t) { const unsigned flat = 255u - (ck[t] & 255u); const unsigned ka = lk[(flat >> 4) * 512 + F.tid], kb = lk[(16u + (flat & 15u)) * 512 + F.tid];
        ce[t] = (127u - (ka & 127u)) * 128u + (127u - (kb & 127u)); }
    LDS_WAIT(); asm volatile("" ::: "memory");
    float ts[16]; float sum = 0.f; const float mx = unordk(ck[0] & ~255u);
    const float rsl = row_rs((const float*)(F.ws + WS_SSP), tok) * 1.4426950408889634f;
#pragma unroll
    for (int t = 0; t < 16; ++t) { ts[t] = __builtin_amdgcn_exp2f((unordk(ck[t] & ~255u) - mx) * rsl); sum += ts[t]; }
    const float inv = 1.0f / sum;
    if (h2 == 0) {
        GAS v4u* eo = (GAS v4u*)(((unsigned short*)(F.ws + WS_REXP)) + tok * 128 + h * 16); GAS f32x4* go = (GAS f32x4*)(((float*)(F.ws + WS_RG)) + tok * 128 + h * 16);
        eo[0] = (v4u){ce[0] | (ce[1] << 16), ce[2] | (ce[3] << 16), ce[4] | (ce[5] << 16), ce[6] | (ce[7] << 16)};
        eo[1] = (v4u){ce[8] | (ce[9] << 16), ce[10] | (ce[11] << 16), ce[12] | (ce[13] << 16), ce[14] | (ce[15] << 16)};
#pragma unroll
        for (int t4 = 0; t4 < 4; ++t4) go[t4] = (f32x4){ts[4 * t4] * inv, ts[4 * t4 + 1] * inv, ts[4 * t4 + 2] * inv, ts[4 * t4 + 3] * inv};
    }
}

__device__ __forceinline__ float gelu_erf(float v) {
    const float av = fabsf(v), t = __builtin_amdgcn_rcpf(av * 0.2316418882f + 1.0f);
    float q = t * 0.5307027145f + (-0.7265760135f); q = q * t + 0.7107068705f; q = q * t + (-0.142248368f); q = q * t + 0.127414796f; q = q * t;
    const float e = __builtin_amdgcn_exp2f((v * v) * (-0.72134752044f));
    const float m = v * (q * e);
    return v < 0.f ? m : v - m;
}
__device__ __forceinline__ float dpp_add(float v, float w_unused) { return v; }
#define DPP_ADD(v, ctrl) ((v) + __builtin_bit_cast(float, __builtin_amdgcn_update_dpp(0, __builtin_bit_cast(int, (v)), (ctrl), 0xf, 0xf, true)))
constexpr int NSL = 8;
constexpr int CW_PEER = 8192;
typedef float f32x2v __attribute__((ext_vector_type(2)));
__device__ __forceinline__ unsigned id_of(const v4u a, const v4u b, int m) { const unsigned w = (m < 8) ? a[(m & 7) >> 1] : b[(m & 7) >> 1]; return (m & 1) ? (w >> 16) : (w & 0xffffu); }
__device__ __forceinline__ void load_hn2(const bf16* p, f32x2v (&hn2)[8]) { const v4u a = *(const GAS v4u*)p, b = *(const GAS v4u*)(p + 8);
    hn2[0] = (f32x2v){bflo(a.x), bfhi(a.x)}; hn2[1] = (f32x2v){bflo(a.y), bfhi(a.y)}; hn2[2] = (f32x2v){bflo(a.z), bfhi(a.z)}; hn2[3] = (f32x2v){bflo(a.w), bfhi(a.w)};
    hn2[4] = (f32x2v){bflo(b.x), bfhi(b.x)}; hn2[5] = (f32x2v){bflo(b.y), bfhi(b.y)}; hn2[6] = (f32x2v){bflo(b.z), bfhi(b.z)}; hn2[7] = (f32x2v){bflo(b.w), bfhi(b.w)}; }
template <int SIDE> __device__ __forceinline__ void peer_item8(Frame& F, const Args& AR, int s, size_t t0) {
    const int lane = F.lane, ts = lane >> 3, c = lane & 7;
    const size_t tok = t0 + ts;
    const unsigned char* tbase = ((const unsigned char*)(F.ws + (SIDE == 0 ? WS_U16 : WS_V16))) + 128 * s;
    const unsigned lo = 16u * (unsigned)c;
    const GAS v4u* idq = (const GAS v4u*)(((const unsigned short*)(F.ws + WS_REXP)) + tok * 128);
    v4u ia = idq[0], ib = idq[1];
    if (SIDE == 0) {
        f32x2v hn2[8]; load_hn2(((const bf16*)(F.ws + WS_HG)) + tok * 1024 + 128 * s + 16 * c, hn2);
        bf16* po = ((bf16*)(F.ws + WS_SUBK)) + (tok * NSL + s) * 128;
#pragma unroll 1
        for (int b = 0; b < 8; ++b) {
            v4u r[16];
#pragma unroll
            for (int m = 0; m < 16; ++m) r[m] = *(const GAS v4u*)(tbase + (size_t)((id_of(ia, ib, m) << 10) + lo));
            const int bn = (b + 1) & 7; ia = idq[2 * bn]; ib = idq[2 * bn + 1];
            float d[16];
#pragma unroll
            for (int m = 0; m < 16; ++m) { f32x2v acc = {0.f, 0.f};
#pragma unroll
                for (int q = 0; q < 4; ++q) { const int w = (int)r[m][q]; acc = __builtin_amdgcn_cvt_pk_f32_fp8(w, false) * hn2[2 * q] + acc; acc = __builtin_amdgcn_cvt_pk_f32_fp8(w, true) * hn2[2 * q + 1] + acc; }
                float a = acc.x + acc.y; a = DPP_ADD(a, 0xB1); a = DPP_ADD(a, 0x4E); a = DPP_ADD(a, 0x141); d[m] = a; }
            if (c == 0) { GAS v4u* pq = (GAS v4u*)(po + 16 * b);
                pq[0] = (v4u){pk2(d[0], d[1]), pk2(d[2], d[3]), pk2(d[4], d[5]), pk2(d[6], d[7])}; pq[1] = (v4u){pk2(d[8], d[9]), pk2(d[10], d[11]), pk2(d[12], d[13]), pk2(d[14], d[15])}; }
        }
    } else {
        const GAS f32x4* cfq = (const GAS f32x4*)(((const float*)(F.ws + WS_RG)) + tok * 128);
        f32x4 cf[4];
#pragma unroll
        for (int q = 0; q < 4; ++q) cf[q] = cfq[q];
        f32x2v acc[8];
#pragma unroll
        for (int j = 0; j < 8; ++j) acc[j] = (f32x2v){0.f, 0.f};
#pragma unroll 1
        for (int b = 0; b < 8; ++b) {
            v4u r[16];
#pragma unroll
            for (int m = 0; m < 16; ++m) r[m] = *(const GAS v4u*)(tbase + (size_t)((id_of(ia, ib, m) << 10) + lo));
            const int bn = (b + 1) & 7; ia = idq[2 * bn]; ib = idq[2 * bn + 1];
            f32x4 cn[4];
#pragma unroll
            for (int q = 0; q < 4; ++q) cn[q] = cfq[4 * bn + q];
#pragma unroll
            for (int m = 0; m < 16; ++m) { const float cm = cf[m >> 2][m & 3]; const f32x2v c2 = {cm, cm};
#pragma unroll
                for (int q = 0; q < 4; ++q) { const int w = (int)r[m][q]; acc[2 * q] = __builtin_amdgcn_cvt_pk_f32_fp8(w, false) * c2 + acc[2 * q]; acc[2 * q + 1] = __builtin_amdgcn_cvt_pk_f32_fp8(w, true) * c2 + acc[2 * q + 1]; } }
#pragma unroll
            for (int q = 0; q < 4; ++q) cf[q] = cn[q];
        }
        GAS f32x4* op = (GAS f32x4*)((AR.out) + tok * 1024 + 128 * s + 16 * c);
#pragma unroll
        for (int q = 0; q < 4; ++q) { f32x4 h = op[q]; h.x += acc[2 * q].x; h.y += acc[2 * q].y; h.z += acc[2 * q + 1].x; h.w += acc[2 * q + 1].y; op[q] = h; }
    }
}
template <int SIDE> __device__ __forceinline__ void peer_side(Frame& F, const Args& AR, int rep = 0) {
    gu32* cnt = F.ctl + CW_PEER + (SIDE + 2 * rep) * 16 * 64;
    LAS int* sh = (LAS int*)F.lds;
    const unsigned xcc = xb_xcc_id() & 7u;
#pragma unroll 1
    for (int k = 0; k < NSL; ++k) {
        const int s = (int)((xcc + (unsigned)k) & (unsigned)(NSL - 1));
#pragma unroll 1
        for (;;) {
            __syncthreads();
            if (F.tid == 0) sh[0] = (int)__hip_atomic_fetch_add(cnt + 64 * s, 1u, RLX_AGENT);
            __syncthreads();
            const int blk = sh[0];
            if (blk >= MTOK / 128) break;
            const size_t t0 = (size_t)blk * 128 + F.wave * 16;
            peer_item8<SIDE>(F, AR, s, t0); peer_item8<SIDE>(F, AR, s, t0 + 8);
        }
    }
}
__device__ __forceinline__ void peer_coef_token(Frame& F, size_t tok, float inv_su, float inv_sv) {
    const int lane = F.lane;
    const unsigned short* pp = ((const unsigned short*)(F.ws + WS_SUBK)) + tok * NSL * 128;
    float a0 = 0.f, a1 = 0.f;
#pragma unroll
    for (int s = 0; s < NSL; ++s) { a0 += __uint_as_float((unsigned)pp[s * 128 + lane] << 16); a1 += __uint_as_float((unsigned)pp[s * 128 + 64 + lane] << 16); }
    float* gp = ((float*)(F.ws + WS_RG)) + tok * 128;
    const float sc = inv_su * row_rs((const float*)(F.ws + WS_SSP), tok);
    gp[lane] = gp[lane] * gelu_erf(a0 * sc) * inv_sv; gp[64 + lane] = gp[64 + lane] * gelu_erf(a1 * sc) * inv_sv;
}

__global__ void __launch_bounds__(NWAVES * 64, 2) mk_fwd(Args args) {
    extern __shared__ __attribute__((aligned(16))) unsigned char lds[];
    Frame F;
    F.lds = (LAS unsigned char*)lds;
    F.MISC = (volatile LAS unsigned*)(F.lds + MISC_OFF);
    F.tid = threadIdx.x; F.lane = F.tid & 63; F.wave = __builtin_amdgcn_readfirstlane(F.tid >> 6);
    F.G = gridDim.x; { const int bx = blockIdx.x; F.vcu = (F.G % 8 == 0) ? (bx % 8) * (F.G / 8) + bx / 8 : bx; }
    F.ws = args.ws;
    F.ctl = (gu32*)(F.ws + WS_CTL);
    const Args& AR = args;
    for (int u = F.tid; u < (LDS_BYTES - LDSCTL_OFF) / 4; u += NWAVES * 64) ((LAS unsigned*)(F.lds + LDSCTL_OFF))[u] = 0u;
    __syncthreads();
    XcdBarrier bar; bar.bar = (unsigned*)(F.ctl + CW_BAR); bar.x = 0; bar.st = nullptr;
#if !MK_PER_PHASE
    bar = xcd_barrier_post((unsigned*)(F.ctl + CW_BAR), F.MISC + 8);
#endif
    unsigned long long tacc_ = 0ull; unsigned tcnt_ = 0u;
    const unsigned long long tk0c_ = (PROBE_SEC == 10) ? __builtin_amdgcn_s_memtime() : 0ull, tk0r_ = (PROBE_SEC == 10) ? __builtin_amdgcn_s_memrealtime() : 0ull;
    const int lo = args.ph_lo, hi = args.ph_hi;
#if defined(ONLY_PHASE)
#define IN(k) ((k) == ONLY_PHASE && lo <= (k) && (k) < hi)
#elif defined(PHASE_MASK)
#define IN(k) (((PHASE_MASK >> (k)) & 1) && lo <= (k) && (k) < hi)
#else
#define IN(k) (lo <= (k) && (k) < hi)
#endif
#if MK_PER_PHASE
#define SEAM(k) do { } while (0)
#else
#define SEAM(k) do { if (IN(k) && IN((k) + 1)) xcd_barrier(bar); } while (0)
#endif
#define FRESH() Frame P = F; { int t_ = threadIdx.x; asm volatile("" : "+v"(t_)); P.tid = t_; P.lane = t_ & 63; P.wave = __builtin_amdgcn_readfirstlane(t_ >> 6); } const int gw = P.vcu * NWAVES + P.wave, NGW = P.G * NWAVES; (void)gw; (void)NGW

    for (int rep_ = 0; rep_ < (((REPEAT_MASK >> 0) & 1) ? 2 : 1); ++rep_) if (IN(0)) { FRESH(); p0_prologue(P, args); } SEAM(0);
    for (int rep_ = 0; rep_ < (((REPEAT_MASK >> 1) & 1) ? 2 : 1); ++rep_) if (IN(1)) { pg8::Gemm g{((bf16*)(F.ws + WS_ACT)), ((bf16*)(F.ws + WS_WIN)), MTOK, LDP, 1024, 1024, 1024}; pg8::StaticOrder S; S.init(MTOK, LDP, F.G, (int)blockIdx.x);
        pg8::EpiStoreBf16 E{((bf16*)(F.ws + WS_PROJ)), LDP};
        pg8::gemm_phase<pg8::EpiStoreBf16, pg8::StaticOrder, true, true>(F.lds, g, S, E); } SEAM(1);
    if (IN(2)) { FRESH(); for (int m = gw; m < MTOK; m += NGW) fixup_token(P, args, m);
        for (int r0 = gw * 32; r0 < MTOK; r0 += NGW * 32) pool_run(P, r0, 32);
        const float su = fp8_scale(__hip_atomic_load(P.ctl + CW_AMAX, RLX_AGENT)), sv = fp8_scale(__hip_atomic_load(P.ctl + CW_AMAX + 1, RLX_AGENT));
#pragma unroll 4
        for (int r = gw; r < 2 * 16384; r += NGW) { const int rr = r & 16383;
            if (r < 16384) row_to_fp8(args.in[13] + (size_t)rr * 1024, (unsigned char*)(P.ws + WS_U16) + (size_t)rr * 1024, su, P.lane);
            else row_to_fp8(args.in[14] + (size_t)rr * 1024, (unsigned char*)(P.ws + WS_V16) + (size_t)rr * 1024, sv, P.lane); } } SEAM(2);
    for (int rep_ = 0; rep_ < (((REPEAT_MASK >> 3) & 1) ? 2 : 1); ++rep_) if (IN(3)) { FRESH(); for (int i = P.vcu; i < 256; i += P.G) { const int b = i >> 4, s = i & 15;
#pragma unroll 1
            for (int k = 0; k < 4; ++k) idx_unit(P, args, b, (k == 0) ? s : (k == 1) ? 31 - s : (k == 2) ? 32 + s : 63 - s, PROBE_NOSEL ? (rep_ == 1) : true); } } SEAM(3);
    const unsigned long long tp4_ = (PROBE_SEC == 5 || PROBE_SEC == 6 || PROBE_SEC == 7) ? ((PROBE_SEC != 6) ? __builtin_amdgcn_s_memtime() : __builtin_amdgcn_s_memrealtime()) : 0ull;
    for (int rep_ = 0; rep_ < (((REPEAT_MASK >> 4) & 1) ? 2 : 1); ++rep_) if (IN(4)) { FRESH(); for (int i = P.vcu; i < 256; i += P.G) { const int bh = i >> 1, s = i & 1, b = bh >> 3, h = bh & 7;
#pragma unroll 1
            for (int k = 0; k < 8; ++k) attn_unit(P, args, b, h, (k & 1) ? 15 - (k >> 1) * 2 - s : (k >> 1) * 2 + s, tacc_, tcnt_); }
        if (PROBE_SEC == 7) { tacc_ = (__builtin_amdgcn_s_memtime() - tp4_) / 1000ull; tcnt_ = 1u; } } SEAM(4);
    if (PROBE_SEC == 5) { tacc_ = (__builtin_amdgcn_s_memtime() - tp4_) / 1000ull; tcnt_ = 1u; }
    if (PROBE_SEC == 6) { tacc_ = (__builtin_amdgcn_s_memrealtime() - tp4_) / 10ull; tcnt_ = 1u; }
    for (int rep_ = 0; rep_ < (((REPEAT_MASK >> 5) & 1) ? 2 : 1); ++rep_) if (IN(5)) { pg8::Gemm g{((bf16*)(F.ws + WS_AO)), ((bf16*)(F.ws + WS_WA)), MTOK, 1024, 512, 512, 512}; pg8::StaticOrder S; S.init(MTOK, 1024, F.G, (int)blockIdx.x);
        pg8::EpiGate<false> E{((bf16*)(F.ws + WS_ACT)), 1024, ((bf16*)(F.ws + WS_PROJ)) + GA_OFF, LDP};
        pg8::gemm_phase<pg8::EpiGate<false>, pg8::StaticOrder, true, true>(F.lds, g, S, E); }
    if (IN(6)) { pg8::Gemm g{((bf16*)(F.ws + WS_POOLED)), ((bf16*)(F.ws + WS_WPP)), MTOK, 1024, 512, 512, 512}; pg8::StaticOrder S; S.init(MTOK, 1024, F.G, (int)blockIdx.x);
                pg8::EpiGate<true> E{((bf16*)(F.ws + WS_ACT)), 1024, ((bf16*)(F.ws + WS_PROJ)) + GP_OFF, LDP};
        pg8::gemm_phase<pg8::EpiGate<true>, pg8::StaticOrder, true, true>(F.lds, g, S, E); } SEAM(6);
    for (int rep_ = 0; rep_ < (((REPEAT_MASK >> 7) & 1) ? 2 : 1); ++rep_) if (IN(7)) { pg8::Gemm g{((bf16*)(F.ws + WS_ACT)), ((bf16*)(F.ws + WS_WO)), MTOK, 1024, 1024, 1024, 1024}; pg8::StaticOrder S; S.init(MTOK, 1024, F.G, (int)blockIdx.x);
        pg8::EpiResHG E{(AR.in[0]), (AR.out), ((bf16*)(F.ws + WS_HG)), (AR.in[10]), ((float*)(F.ws + WS_SSP)), 1024};
        pg8::gemm_phase<pg8::EpiResHG, pg8::StaticOrder, true, true>(F.lds, g, S, E); } SEAM(7);

    for (int rep_ = 0; rep_ < (((REPEAT_MASK >> 9) & 1) ? 2 : 1); ++rep_) if (IN(9)) { pg8::Gemm g{((bf16*)(F.ws + WS_HG)), ((bf16*)(F.ws + WS_W2)), MTOK, 1024, 1024, 1024, 1024}; pg8::StaticOrder S; S.init(MTOK, 1024, F.G, (int)blockIdx.x);
        pg8::EpiStoreBf16 E{((bf16*)(F.ws + WS_SUBK)), 1024};
        pg8::gemm_phase<pg8::EpiStoreBf16, pg8::StaticOrder, true, true>(F.lds, g, S, E); } SEAM(9);
    for (int rep_ = 0; rep_ < (((REPEAT_MASK >> 10) & 1) ? 2 : 1); ++rep_) if (IN(10)) { FRESH(); for (int tt = P.vcu; tt < MTOK / 32; tt += P.G) route_task(P, args, tt, P.wave); } SEAM(10);
        for (int rep_ = 0; rep_ < (((REPEAT_MASK >> 11) & 1) ? 2 : 1); ++rep_) if (IN(11)) { FRESH(); peer_side<0>(P, args, rep_); } SEAM(11);
    if (IN(12)) { FRESH(); const float iu = fp8_inv_scale(__hip_atomic_load(P.ctl + CW_AMAX, RLX_AGENT)), iv = fp8_inv_scale(__hip_atomic_load(P.ctl + CW_AMAX + 1, RLX_AGENT));
        for (int m = gw; m < MTOK; m += NGW) peer_coef_token(P, (size_t)m, iu, iv); } SEAM(12);
    if (IN(13)) { FRESH(); peer_side<1>(P, args); }
#if PROBE_SEC == 10
    { const unsigned long long dc = __builtin_amdgcn_s_memtime() - tk0c_, dr = __builtin_amdgcn_s_memrealtime() - tk0r_; tacc_ = dc * 100ull / (dr ? dr : 1ull); tcnt_ = 1u; }
#endif
#if PROBE_SEC
    if (blockIdx.x == 0 && F.wave == 7) { const unsigned long long avg = tacc_ / (unsigned long long)(tcnt_ ? tcnt_ : 1u); const unsigned long long t_end = __builtin_amdgcn_s_memrealtime() + avg * 10ull;
        while (__builtin_amdgcn_s_memrealtime() < t_end) __builtin_amdgcn_s_sleep(8); }
#endif

#undef IN
#undef SEAM
}

extern "C" void kernel_launch(void* const* d_in, const int* in_sizes, int n_in, void* d_out, int out_size, void* d_ws, size_t ws_size, hipStream_t stream) {
    static int grid = 0;
    if (grid == 0) {
        if (n_in != 15 || in_sizes[0] != MTOK * DM || out_size != MTOK * DM || ws_size < WS_END) { fprintf(stderr, "kernel_launch: unexpected shapes (n_in %d, in0 %d, out %d, ws %zu < %zu)\n", n_in, n_in > 0 ? in_sizes[0] : -1, out_size, ws_size, (size_t)WS_END); grid = -1; return; }
        int dev = 0, cus = 0, per_cu = 0;
        if (hipGetDevice(&dev) != hipSuccess || hipDeviceGetAttribute(&cus, hipDeviceAttributeMultiprocessorCount, dev) != hipSuccess) { grid = -1; return; }
        if (hipFuncSetAttribute((const void*)mk_fwd, hipFuncAttributeMaxDynamicSharedMemorySize, LDS_BYTES) != hipSuccess) { fprintf(stderr, "kernel_launch: hipFuncSetAttribute failed\n"); grid = -1; return; }
        if (hipOccupancyMaxActiveBlocksPerMultiprocessor(&per_cu, (const void*)mk_fwd, NWAVES * 64, LDS_BYTES) != hipSuccess || per_cu < 1) { fprintf(stderr, "kernel_launch: occupancy query says %d blocks per CU\n", per_cu); (void)hipGetLastError(); grid = -1; return; }
        grid = cus;
    }
    if (grid < 0) return;
    if (hipMemsetAsync((char*)d_ws + WS_CTL, 0, CTL_ZERO_BYTES, stream) != hipSuccess) return;
    Args a{};
    for (int i = 0; i < 15; ++i) a.in[i] = (const float*)d_in[i];
    a.out = (float*)d_out; a.ws = (unsigned char*)d_ws;
#if MK_PER_PHASE
    for (int p = 0; p < NPHASE; ++p) { a.ph_lo = p; a.ph_hi = p + 1; hipLaunchKernelGGL(mk_fwd, dim3(grid), dim3(NWAVES * 64), LDS_BYTES, stream, a); }
#else
    a.ph_lo = 0; a.ph_hi = NPHASE;
    hipLaunchKernelGGL(mk_fwd, dim3(grid), dim3(NWAVES * 64), LDS_BYTES, stream, a);
#endif
}
```

```cpp
#include <hip/hip_runtime.h>
#include <cstdio>
#include <cstdint>
namespace pg8 {
#define PG8_LAS __attribute__((address_space(3)))
typedef unsigned short bf16_t;
typedef short bf16x8 __attribute__((ext_vector_type(8)));
typedef float f32x4 __attribute__((ext_vector_type(4)));
typedef unsigned u32x4 __attribute__((ext_vector_type(4)));
constexpr int BM = 256, BK = 64, HALF = 128, HTB = HALF * BK * 2  , STAGE_BYTES = 8 * HTB, NXCD = 8, WGM = 8;

__host__ __device__ __forceinline__ int lds_byte(int r, int c) { const int st = (r >> 4) * 2 + (c >> 5), rr = r & 15, cc = c & 31, ob = rr * 64 + cc * 2; return st * 1024 + (ob ^ (((ob >> 9) & 1) << 5)); }
__host__ __device__ __forceinline__ void stage_rc(int b, int& R, int& C) { const int st = b / 1024, sb = b % 1024, swz = sb ^ (((sb >> 9) & 1) << 5); R = (st >> 1) * 16 + swz / 64; C = (st & 1) * 32 + (swz % 64) / 2; }
__host__ __device__ __forceinline__ int perm32(int rho) { const int n = rho >> 4, i = rho & 15; return 8 * (i >> 2) + 4 * n + (i & 3); }

struct Unit { int pm, pn; };
struct Gemm { const bf16_t* A; const bf16_t* Bt; int M, N, K, lda, ldb; };

struct StaticOrder {
    int nM, nN, nwg, G, c;
    __host__ __device__ void init(int M, int N, int G_, int c_) { nM = M / BM; nN = N / BM; nwg = nM * nN; G = G_; c = c_; }
    __host__ __device__ bool next(int i, Unit& u) const {
        const long L = (long)i * G + c; if (L >= nwg) return false;
        int wgid = (int)L; { const int q = nwg / NXCD, r = nwg % NXCD, xcd = wgid % NXCD, off = wgid / NXCD; wgid = (xcd < r ? xcd * (q + 1) : r * (q + 1) + (xcd - r) * q) + off; }
        const int nig = WGM * nN, gid = wgid / nig, fm = gid * WGM, gsz = (nM - fm) < WGM ? (nM - fm) : WGM;
        u.pm = fm + ((wgid % nig) % gsz); u.pn = (wgid % nig) / gsz; return true;
    }
    __device__ __forceinline__ void a_ready(const Unit&) const {}
    __device__ __forceinline__ void done(const Unit&) const {}
};
struct PanelOrder {
    int nN, pm;
    __host__ __device__ bool next(int i, Unit& u) const { if (i >= nN) return false; u.pm = pm; u.pn = i; return true; }
    __device__ __forceinline__ void a_ready(const Unit&) const {}
    __device__ __forceinline__ void done(const Unit&) const {}
};
typedef float f32x2c_t __attribute__((ext_vector_type(2))); typedef __bf16 bf16x2c_t __attribute__((ext_vector_type(2)));
__device__ __forceinline__ unsigned cvt_pk_bf16(float lo, float hi) { f32x2c_t v = {lo, hi}; bf16x2c_t b = __builtin_convertvector(v, bf16x2c_t); return __builtin_bit_cast(unsigned, b); }
typedef float f32x2 __attribute__((ext_vector_type(2)));
__device__ __forceinline__ f32x2 gelu_pk(f32x2 v) {
    const f32x2 av = __builtin_elementwise_abs(v), d = av * 0.2316418882f + 1.0f;
    f32x2 t; t.x = __builtin_amdgcn_rcpf(d.x); t.y = __builtin_amdgcn_rcpf(d.y);
    f32x2 q = t * 0.5307027145f + (-0.7265760135f); q = q * t + 0.7107068705f; q = q * t + (-0.142248368f); q = q * t + 0.127414796f; q = q * t;
    const f32x2 s = (v * v) * (-0.72134752044f);
    f32x2 e; e.x = __builtin_amdgcn_exp2f(s.x); e.y = __builtin_amdgcn_exp2f(s.y);
    const f32x2 m = v * (q * e), r = v - m;
    f32x2 o; o.x = v.x < 0.f ? m.x : r.x; o.y = v.y < 0.f ? m.y : r.y; return o;
}
typedef unsigned u32x2e __attribute__((ext_vector_type(2)));
__device__ __forceinline__ float bf_lo(unsigned w) { return __uint_as_float(w << 16); }
__device__ __forceinline__ float bf_hi(unsigned w) { return __uint_as_float(w & 0xffff0000u); }
__device__ __forceinline__ float sigmoidf_fast(float g) { return __builtin_amdgcn_rcpf(1.0f + __builtin_amdgcn_exp2f(-1.4426950408889634f * g)); }
__device__ __forceinline__ unsigned ord_key(float f) { const unsigned b = __float_as_uint(f); return b ^ ((unsigned)((int)b >> 31) | 0x80000000u); }
__device__ __forceinline__ float unord_key(unsigned k) { return __uint_as_float((k & 0x80000000u) ? (k ^ 0x80000000u) : ~k); }

struct EpiStoreBf16 {
    static constexpr bool PERM = true, AFTER_DRAIN = false;
    bf16_t* O; int ldc;
    __device__ __forceinline__ void operator()(const f32x4 (&acc)[2][2][4][2], const Unit& u, int wr, int wc, int fr, int fq) const {
        const int row0 = u.pm * BM + wr * 64 + fr, col0 = u.pn * BM + wc * 32 + 8 * fq;
#pragma unroll
        for (int ai = 0; ai < 2; ++ai)
#pragma unroll
            for (int m = 0; m < 4; ++m) { bf16_t* rowp = O + (size_t)(row0 + ai * HALF + m * 16) * ldc + col0;
#pragma unroll
                for (int bj = 0; bj < 2; ++bj) { const f32x4 v0 = acc[ai][bj][m][0], v1 = acc[ai][bj][m][1];
                    u32x4 w; w.x = cvt_pk_bf16(v0[0], v0[1]); w.y = cvt_pk_bf16(v0[2], v0[3]); w.z = cvt_pk_bf16(v1[0], v1[1]); w.w = cvt_pk_bf16(v1[2], v1[3]);
                    *(u32x4*)(rowp + bj * HALF) = w; } }
    }
};
template <bool ADD> struct EpiGate {
    static constexpr bool PERM = true, AFTER_DRAIN = false;
    bf16_t* O; int ldc; const bf16_t* G; int ldg;
    __device__ __forceinline__ void operator()(const f32x4 (&acc)[2][2][4][2], const Unit& u, int wr, int wc, int fr, int fq) const {
        const int row0 = u.pm * BM + wr * 64 + fr, col0 = u.pn * BM + wc * 32 + 8 * fq;
#pragma unroll
        for (int ai = 0; ai < 2; ++ai)
#pragma unroll
            for (int m = 0; m < 4; ++m) { const size_t row = (size_t)(row0 + ai * HALF + m * 16);
#pragma unroll
                for (int bj = 0; bj < 2; ++bj) { const int col = col0 + bj * HALF;
                    const u32x4 gr = *(const u32x4*)(G + row * ldg + col);
                    f32x4 v0 = acc[ai][bj][m][0], v1 = acc[ai][bj][m][1];
                    v0[0] *= sigmoidf_fast(bf_lo(gr.x)); v0[1] *= sigmoidf_fast(bf_hi(gr.x)); v0[2] *= sigmoidf_fast(bf_lo(gr.y)); v0[3] *= sigmoidf_fast(bf_hi(gr.y));
                    v1[0] *= sigmoidf_fast(bf_lo(gr.z)); v1[1] *= sigmoidf_fast(bf_hi(gr.z)); v1[2] *= sigmoidf_fast(bf_lo(gr.w)); v1[3] *= sigmoidf_fast(bf_hi(gr.w));
                    bf16_t* op = O + row * ldc + col;
                    if (ADD) { const u32x4 pr = *(const u32x4*)op;
                        v0[0] += bf_lo(pr.x); v0[1] += bf_hi(pr.x); v0[2] += bf_lo(pr.y); v0[3] += bf_hi(pr.y);
                        v1[0] += bf_lo(pr.z); v1[1] += bf_hi(pr.z); v1[2] += bf_lo(pr.w); v1[3] += bf_hi(pr.w); }
                    u32x4 w; w.x = cvt_pk_bf16(v0[0], v0[1]); w.y = cvt_pk_bf16(v0[2], v0[3]); w.z = cvt_pk_bf16(v1[0], v1[1]); w.w = cvt_pk_bf16(v1[2], v1[3]);
                    *(u32x4*)op = w; } }
    }
};
struct EpiResF32 {
    static constexpr bool PERM = false, AFTER_DRAIN = false;
    const float* base; float* out; int ldc;
    __device__ __forceinline__ void operator()(const f32x4 (&acc)[2][2][4][2], const Unit& u, int wr, int wc, int fr, int fq) const {
        const int col0 = u.pn * BM + wc * 32 + 4 * fq;
#pragma unroll
        for (int ai = 0; ai < 2; ++ai)
#pragma unroll
            for (int m = 0; m < 4; ++m) { const size_t off = (size_t)(u.pm * BM + ai * HALF + wr * 64 + m * 16 + fr) * ldc + col0;
#pragma unroll
                for (int bj = 0; bj < 2; ++bj)
#pragma unroll
                    for (int n = 0; n < 2; ++n) { const f32x4 bs = *(const f32x4*)(base + off + bj * HALF + n * 16); *(f32x4*)(out + off + bj * HALF + n * 16) = bs + acc[ai][bj][m][n]; } }
    }
};
struct EpiResHG {
    static constexpr bool PERM = false, AFTER_DRAIN = false;
    const float* base; float* out; bf16_t* hg; const float* gain; float* ssp; int ldc;
    __device__ __forceinline__ void operator()(const f32x4 (&acc)[2][2][4][2], const Unit& u, int wr, int wc, int fr, int fq) const {
        const int col0 = u.pn * BM + wc * 32 + 4 * fq;
        f32x4 gv[2][2];
#pragma unroll
        for (int bj = 0; bj < 2; ++bj)
#pragma unroll
            for (int n = 0; n < 2; ++n) gv[bj][n] = *(const f32x4*)(gain + col0 + bj * HALF + n * 16);
#pragma unroll
        for (int ai = 0; ai < 2; ++ai)
#pragma unroll
            for (int m = 0; m < 4; ++m) { const int row = u.pm * BM + ai * HALF + wr * 64 + m * 16 + fr; const size_t off = (size_t)row * ldc + col0; float ss = 0.f;
#pragma unroll
                for (int bj = 0; bj < 2; ++bj)
#pragma unroll
                    for (int n = 0; n < 2; ++n) { const f32x4 h = *(const f32x4*)(base + off + bj * HALF + n * 16) + acc[ai][bj][m][n]; *(f32x4*)(out + off + bj * HALF + n * 16) = h;
                        ss += (h[0] * h[0] + h[1] * h[1]) + (h[2] * h[2] + h[3] * h[3]);
                        const f32x4 hgv = h * gv[bj][n]; u32x2e w; w.x = cvt_pk_bf16(hgv[0], hgv[1]); w.y = cvt_pk_bf16(hgv[2], hgv[3]); *(u32x2e*)(hg + off + bj * HALF + n * 16) = w; }
                ss += __shfl_xor(ss, 16); ss += __shfl_xor(ss, 32);
                if (fq == 0) ssp[(size_t)row * 16 + u.pn * 4 + wc] = ss; }
    }
};
struct EpiKeys {
    static constexpr bool PERM = false, AFTER_DRAIN = false;
    unsigned* O; int ldc;
    __device__ __forceinline__ void operator()(const f32x4 (&acc)[2][2][4][2], const Unit& u, int wr, int wc, int fr, int fq) const {
        const int col0 = u.pn * BM + wc * 32 + 4 * fq;
#pragma unroll
        for (int ai = 0; ai < 2; ++ai)
#pragma unroll
            for (int m = 0; m < 4; ++m) { const size_t off = (size_t)(u.pm * BM + ai * HALF + wr * 64 + m * 16 + fr) * ldc + col0;
#pragma unroll
                for (int bj = 0; bj < 2; ++bj)
#pragma unroll
                    for (int n = 0; n < 2; ++n) { const int nn = (col0 + bj * HALF + n * 16) & 127; const f32x4 a = acc[ai][bj][m][n]; u32x4 w;
                        w.x = (ord_key(a[0]) & ~127u) | (unsigned)(127 - nn); w.y = (ord_key(a[1]) & ~127u) | (unsigned)(126 - nn);
                        w.z = (ord_key(a[2]) & ~127u) | (unsigned)(125 - nn); w.w = (ord_key(a[3]) & ~127u) | (unsigned)(124 - nn);
                        *(u32x4*)(O + off + bj * HALF + n * 16) = w; } }
    }
};

template <class Epi, class Sched, bool ALIGN_EPI = false, bool SP2 = false>
__device__ __forceinline__ void gemm_phase(PG8_LAS unsigned char* lds, const Gemm g, const Sched& S, const Epi& E) {
    int tid_ = threadIdx.x; asm volatile("" : "+v"(tid_));
    const int tid = tid_, wid = __builtin_amdgcn_readfirstlane(tid >> 6), lane = tid & 63, wr = wid >> 2, wc = wid & 3, fr = lane & 15, fq = lane >> 4;
    const int K = g.K, nt = K / BK;
    unsigned voffA[2], voffB[2];
#pragma unroll
    for (int i = 0; i < 2; ++i) { int R, C; stage_rc(tid * 16 + i * 8192, R, C); const int Rb = Epi::PERM ? ((R & ~31) + perm32(R & 31)) : R;
        voffA[i] = (unsigned)(R * g.lda + C) * 2u; voffB[i] = (unsigned)(Rb * g.ldb + C) * 2u; }
    const size_t kstep = (size_t)(BK * 2);
    const size_t hstepA = (size_t)HALF * g.lda * 2, hstepB = (size_t)HALF * g.ldb * 2;
    const size_t tstepA = 2 * hstepA, tstepB = 2 * hstepB;
    const unsigned ldsw = (unsigned)wid * 1024u;
    const int aoff = lds_byte(wr * 64 + fr, fq * 8), boff = lds_byte(wc * 32 + fr, fq * 8);
#define PG8_SA(b, h) (((b) * 2 + (h)) * HTB)
#define PG8_SB(b, h) ((4 + (b) * 2 + (h)) * HTB)
#define PG8_STAGE(bufoff, gbase, voff) do { _Pragma("unroll") for (int _i = 0; _i < 2; ++_i) \
        __builtin_amdgcn_global_load_lds((const unsigned*)((const char*)(gbase) + (voff)[_i]), (PG8_LAS unsigned*)(lds + (bufoff) + ldsw + _i * 8192), 16, 0, 0); } while (0)
#define PG8_LDA(dst, b, h) do { _Pragma("unroll") for (int m = 0; m < 4; ++m) _Pragma("unroll") for (int k = 0; k < 2; ++k) dst[m][k] = *(const PG8_LAS bf16x8*)(lds + PG8_SA(b, h) + aoff + m * 2048 + k * 1024); } while (0)
#define PG8_LDB(dst, b, h) do { _Pragma("unroll") for (int n = 0; n < 2; ++n) _Pragma("unroll") for (int k = 0; k < 2; ++k) dst[n][k] = *(const PG8_LAS bf16x8*)(lds + PG8_SB(b, h) + boff + n * 2048 + k * 1024); } while (0)
#define PG8_MMA(ai, bj, At, Bt) do { __builtin_amdgcn_s_setprio(1); _Pragma("unroll") for (int m = 0; m < 4; ++m) _Pragma("unroll") for (int n = 0; n < 2; ++n) _Pragma("unroll") for (int k = 0; k < 2; ++k) \
        acc[ai][bj][m][n] = __builtin_amdgcn_mfma_f32_16x16x32_bf16(Bt[n][k], At[m][k], acc[ai][bj][m][n], 0, 0, 0); __builtin_amdgcn_s_setprio(0); } while (0)
#define PG8_WAIT_V(n) asm volatile("s_waitcnt vmcnt(" #n ")" ::: "memory")
#define PG8_WAIT_L(n) asm volatile("s_waitcnt lgkmcnt(" #n ")" ::: "memory")
#define PG8_BAR __builtin_amdgcn_s_barrier()
#define PG8_SCHED __builtin_amdgcn_sched_barrier(0)
    Unit cur, nxt; int ui = 0;
    if (!S.next(0, cur)) return;
    f32x4 acc[2][2][4][2];
#pragma unroll
    for (int a = 0; a < 2; ++a)
#pragma unroll
        for (int b = 0; b < 2; ++b)
#pragma unroll
            for (int m = 0; m < 4; ++m)
#pragma unroll
                for (int n = 0; n < 2; ++n) acc[a][b][m][n] = (f32x4){0.f, 0.f, 0.f, 0.f};
    bf16x8 At[4][2], B0[2][2], B1[2][2];
    const char* cA = (const char*)g.A + (size_t)cur.pm * tstepA; const char* cB = (const char*)g.Bt + (size_t)cur.pn * tstepB;
    S.a_ready(cur);
    if constexpr (SP2) {
        PG8_STAGE(PG8_SB(0, 0), cB, voffB); PG8_STAGE(PG8_SB(0, 1), cB + hstepB, voffB); PG8_STAGE(PG8_SA(0, 0), cA, voffA); PG8_STAGE(PG8_SA(0, 1), cA + hstepA, voffA);
        if (wr == 1) PG8_BAR;
        PG8_WAIT_V(2); PG8_BAR;
        PG8_STAGE(PG8_SB(1, 0), cB + kstep, voffB); PG8_STAGE(PG8_SA(1, 0), cA + kstep, voffA); PG8_STAGE(PG8_SB(1, 1), cB + hstepB + kstep, voffB);
        PG8_WAIT_V(6); PG8_BAR;
    } else {
        PG8_STAGE(PG8_SB(0, 0), cB, voffB); PG8_STAGE(PG8_SA(0, 0), cA, voffA); PG8_STAGE(PG8_SB(0, 1), cB + hstepB, voffB); PG8_STAGE(PG8_SA(0, 1), cA + hstepA, voffA);
        if (wr == 1) PG8_BAR;
        PG8_WAIT_V(4); PG8_BAR;
        PG8_STAGE(PG8_SB(1, 0), cB + kstep, voffB); PG8_STAGE(PG8_SA(1, 0), cA + kstep, voffA); PG8_STAGE(PG8_SB(1, 1), cB + hstepB + kstep, voffB);
        PG8_WAIT_V(6); PG8_BAR;
    }
    for (;;) {
        const bool has_next = S.next(ui + 1, nxt);
        const char* nA = has_next ? (const char*)g.A + (size_t)nxt.pm * tstepA : cA; const char* nB = has_next ? (const char*)g.Bt + (size_t)nxt.pn * tstepB : cB;
        for (int t = 0; t < nt; t += 2) {
            const bool last = (t == nt - 2);
            const char* a1 = cA + (size_t)(t + 1) * kstep;
            const char* a2 = last ? nA : cA + (size_t)(t + 2) * kstep; const char* b2 = last ? nB : cB + (size_t)(t + 2) * kstep;
            const char* a3 = a2 + kstep; const char* b3 = b2 + kstep;
            if (last && has_next) S.a_ready(nxt);
            if constexpr (SP2) {
            PG8_LDB(B0, 0, 0); PG8_LDB(B1, 0, 1); PG8_SCHED; PG8_LDA(At, 0, 0); PG8_STAGE(PG8_SA(1, 1), a1 + hstepA, voffA);
            PG8_WAIT_V(8); PG8_WAIT_L(0); PG8_BAR; PG8_MMA(0, 0, At, B0); PG8_MMA(0, 1, At, B1); PG8_BAR; PG8_SCHED;
            PG8_LDA(At, 0, 1); PG8_STAGE(PG8_SB(0, 0), b2, voffB); PG8_STAGE(PG8_SB(0, 1), b2 + hstepB, voffB); PG8_STAGE(PG8_SA(0, 0), a2, voffA);
            PG8_WAIT_V(8); PG8_WAIT_L(0); PG8_BAR; PG8_MMA(1, 0, At, B0); PG8_MMA(1, 1, At, B1); PG8_BAR; PG8_SCHED;
            PG8_LDB(B0, 1, 0); PG8_LDB(B1, 1, 1); PG8_SCHED; PG8_LDA(At, 1, 0); PG8_STAGE(PG8_SA(0, 1), a2 + hstepA, voffA);
            PG8_WAIT_V(8); PG8_WAIT_L(0); PG8_BAR; PG8_MMA(0, 0, At, B0); PG8_MMA(0, 1, At, B1); PG8_BAR; PG8_SCHED;
            PG8_LDA(At, 1, 1); PG8_STAGE(PG8_SB(1, 0), b3, voffB); PG8_STAGE(PG8_SB(1, 1), b3 + hstepB, voffB); PG8_STAGE(PG8_SA(1, 0), a3, voffA);
            PG8_WAIT_V(8); PG8_WAIT_L(0); PG8_BAR; PG8_MMA(1, 0, At, B0); PG8_MMA(1, 1, At, B1); PG8_BAR; PG8_SCHED;
            } else {
            PG8_LDB(B0, 0, 0); PG8_SCHED; PG8_LDA(At, 0, 0); PG8_STAGE(PG8_SA(1, 1), a1 + hstepA, voffA);
            PG8_WAIT_L(8); PG8_BAR; PG8_WAIT_L(0); PG8_MMA(0, 0, At, B0); PG8_BAR; PG8_SCHED;
            PG8_LDB(B1, 0, 1); PG8_STAGE(PG8_SB(0, 0), b2, voffB);
            PG8_BAR; PG8_WAIT_L(0); PG8_MMA(0, 1, At, B1); PG8_BAR;
            PG8_LDA(At, 0, 1); PG8_STAGE(PG8_SA(0, 0), a2, voffA);
            PG8_BAR; PG8_WAIT_L(0); PG8_MMA(1, 0, At, B0); PG8_BAR; PG8_SCHED;
            PG8_STAGE(PG8_SB(0, 1), b2 + hstepB, voffB);
            PG8_WAIT_V(6); PG8_BAR; PG8_MMA(1, 1, At, B1); PG8_BAR;
            PG8_LDB(B0, 1, 0); PG8_SCHED; PG8_LDA(At, 1, 0); PG8_STAGE(PG8_SA(0, 1), a2 + hstepA, voffA);
            PG8_WAIT_L(8); PG8_BAR; PG8_WAIT_L(0); PG8_MMA(0, 0, At, B0); PG8_BAR; PG8_SCHED;
            PG8_LDB(B1, 1, 1); PG8_STAGE(PG8_SB(1, 0), b3, voffB);
            PG8_BAR; PG8_WAIT_L(0); PG8_MMA(0, 1, At, B1); PG8_BAR;
            PG8_LDA(At, 1, 1); PG8_STAGE(PG8_SA(1, 0), a3, voffA);
            PG8_BAR; PG8_WAIT_L(0); PG8_MMA(1, 0, At, B0); PG8_BAR; PG8_SCHED;
            PG8_STAGE(PG8_SB(1, 1), b3 + hstepB, voffB);
            PG8_WAIT_V(6); PG8_BAR; PG8_MMA(1, 1, At, B1); PG8_BAR;
            }
        }
        if constexpr (ALIGN_EPI) { if (wr == 0) PG8_BAR; }
        if constexpr (!Epi::AFTER_DRAIN) { Unit ue = cur; asm volatile("" : "+s"(ue.pm), "+s"(ue.pn));
            E(acc, ue, wr, wc, fr, fq); S.done(cur); }
        if (!has_next) break;
#pragma unroll
        for (int a = 0; a < 2; ++a)
#pragma unroll
            for (int b = 0; b < 2; ++b)
#pragma unroll
                for (int m = 0; m < 4; ++m)
#pragma unroll
                    for (int n = 0; n < 2; ++n) acc[a][b][m][n] = (f32x4){0.f, 0.f, 0.f, 0.f};
        cur = nxt; cA = nA; cB = nB; ++ui;
        if constexpr (ALIGN_EPI) { if (wr == 1) PG8_BAR; }
    }
    PG8_WAIT_V(0);
    if constexpr (!ALIGN_EPI) { if (wr == 0) PG8_BAR; }
    PG8_BAR;
    if constexpr (Epi::AFTER_DRAIN) { E.fused(acc, cur, wr, wc, fr, fq, lds, wid, lane); S.done(cur); }
#undef PG8_SA
#undef PG8_SB
#undef PG8_STAGE
#undef PG8_LDA
#undef PG8_LDB
#undef PG8_MMA
#undef PG8_WAIT_V
#undef PG8_WAIT_L
#undef PG8_BAR
#undef PG8_SCHED
}
}

constexpr int NWAVES = 8;
#ifndef REPEAT_MASK
#define REPEAT_MASK 0
#endif
#ifndef PROBE_SEL2
#define PROBE_SEL2 1
#endif
#ifndef PROBE_SEC
#define PROBE_SEC 0
#endif
#ifndef PROBE_FAKEID
#define PROBE_FAKEID 0
#endif
#ifndef PROBE_NOSEL
#define PROBE_NOSEL 0
#endif
#ifndef MK_PER_PHASE
#define MK_PER_PHASE 0
#endif
constexpr int NPHASE = 14;

constexpr int BATCH = 16, SEQ = 4096, DM = 1024, MTOK = BATCH * SEQ;
constexpr int LDP = 4864;
constexpr int Q_OFF = 0, K_OFF = 512, V_OFF = 1024, QI_OFF = 1536, P_OFF = 2048, GA_OFF = 2560, GP_OFF = 3584, KI_OFF = 4608, WI_OFF = 4672;
constexpr int IN_WIDTH = 4680;
constexpr float EPS = 1e-6f;
constexpr float C2 = 0.125f * 1.4426950408889634f;
constexpr float WI_SCALE = 0.35355339059327373f * 0.125f;

constexpr size_t MiB = 1u << 20;
constexpr size_t WS_CTL = 0, CTL_ZERO_BYTES = 1 * MiB;
constexpr size_t WS_ROPE = 1 * MiB;
constexpr size_t WS_WIN = 2 * MiB;
constexpr size_t WS_WA = 12 * MiB;
constexpr size_t WS_WPP = 13 * MiB;
constexpr size_t WS_WO = 14 * MiB;
constexpr size_t WS_W2 = 16 * MiB;
constexpr size_t WS_SKB = 19 * MiB;
constexpr size_t WS_U16 = 20 * MiB, WS_V16 = 52 * MiB;
constexpr size_t WS_MASK = 84 * MiB;
constexpr size_t WS_POOLED = 116 * MiB;
constexpr size_t WS_ACT = 180 * MiB;
constexpr size_t WS_PROJ = 308 * MiB;
constexpr size_t WS_AO = 916 * MiB;
constexpr size_t WS_REXP = 980 * MiB, WS_RG = 116 * MiB;
constexpr size_t WS_HG = 308 * MiB;
constexpr size_t WS_SUBK = 436 * MiB;
constexpr size_t WS_SSP = 948 * MiB;
constexpr size_t WS_END = 1024 * MiB;
constexpr int CW_TMO = 0, CW_BAR = 4096, CW_AMAX = 12288;

constexpr int RING_BYTES = 131072;
constexpr int LDSCTL_OFF = RING_BYTES, MISC_OFF = LDSCTL_OFF + 320;
constexpr int LDS_BYTES = 147456;

#define GAS __attribute__((address_space(1)))
#define LAS __attribute__((address_space(3)))
typedef unsigned short bf16;
typedef unsigned v4u __attribute__((ext_vector_type(4)));
typedef unsigned v2u __attribute__((ext_vector_type(2)));
typedef float f32x4 __attribute__((ext_vector_type(4)));
typedef float f32x16 __attribute__((ext_vector_type(16)));
typedef short bf16x8 __attribute__((ext_vector_type(8)));
typedef short s16x4 __attribute__((ext_vector_type(4)));
typedef GAS unsigned gu32;
#define RLX_AGENT __ATOMIC_RELAXED, __HIP_MEMORY_SCOPE_AGENT
#define LDS_WAIT() asm volatile("s_waitcnt lgkmcnt(0)" ::: "memory")
#define BAR_LDS() asm volatile("s_waitcnt lgkmcnt(0)\n\ts_barrier" ::: "memory")
#define VM_WAIT() asm volatile("s_waitcnt vmcnt(0)" ::: "memory")
__device__ __forceinline__ unsigned f2bf(float f) { unsigned u = __builtin_bit_cast(unsigned, f); return (u + 0x7fffu + ((u >> 16) & 1u)) >> 16; }
typedef float f32x2k_t __attribute__((ext_vector_type(2))); typedef __bf16 bf16x2k_t __attribute__((ext_vector_type(2)));
__device__ __forceinline__ unsigned pk2(float lo, float hi) { f32x2k_t v = {lo, hi}; bf16x2k_t b = __builtin_convertvector(v, bf16x2k_t); return __builtin_bit_cast(unsigned, b); }
__device__ __forceinline__ float bflo(unsigned w) { return __uint_as_float(w << 16); }
__device__ __forceinline__ float bfhi(unsigned w) { return __uint_as_float(w & 0xffff0000u); }
__device__ __forceinline__ unsigned ordk(float f) { const unsigned b = __float_as_uint(f); return b ^ ((unsigned)((int)b >> 31) | 0x80000000u); }
__device__ __forceinline__ float unordk(unsigned k) { return __uint_as_float((k & 0x80000000u) ? (k ^ 0x80000000u) : ~k); }
__device__ __forceinline__ float relu_i(float x) { const int i = __float_as_int(x); return __int_as_float(i > 0 ? i : 0); }
__device__ __forceinline__ int crow(int r, int hi) { return (r & 3) + 8 * (r >> 2) + 4 * hi; }
typedef __bf16 bf16x2v_t __attribute__((ext_vector_type(2)));
__device__ __forceinline__ float dot2bf(unsigned a, unsigned b, float acc) { return __builtin_amdgcn_fdot2_f32_bf16(__builtin_bit_cast(bf16x2v_t, a), __builtin_bit_cast(bf16x2v_t, b), acc, false); }

#define XB_TMO      128
#define XB_XCNT(j)  (256  + 64 * (j))
#define XB_XSUB(j)  (1280 + 64 * (j))
#define XB_XGEN(j)  (2304 + 64 * (j))
#define XB_TOP      3328
#define XB_TOPGEN   3392
#define XCD_BAR_WORDS 3456
#define XB_SPIN_CAP (1u << 18)

__device__ __forceinline__ unsigned xb_ld(unsigned* p)              { return __hip_atomic_load(p, __ATOMIC_RELAXED, __HIP_MEMORY_SCOPE_AGENT); }
__device__ __forceinline__ unsigned xb_add(unsigned* p, unsigned v) { return __hip_atomic_fetch_add(p, v, __ATOMIC_RELAXED, __HIP_MEMORY_SCOPE_AGENT); }
__device__ __forceinline__ unsigned xb_xcc_id() { return (unsigned)__builtin_amdgcn_s_getreg((3 << 11) | 20) & 0xFu; }
#define XB_SPIN(cond, bar) do { unsigned _sp = 0; while (cond) { __builtin_amdgcn_s_sleep(1); \
    if ((++_sp & 255u) == 0u) { if (xb_ld(&(bar)[XB_TMO])) break; if (_sp > XB_SPIN_CAP) { atomicAdd(&(bar)[XB_TMO], 1u); break; } } } } while (0)

struct XcdBarrier {
    unsigned* bar; unsigned x;
    volatile LAS unsigned* st;
};

__device__ __forceinline__ XcdBarrier xcd_barrier_post(unsigned* bar, volatile LAS unsigned* st) {
    XcdBarrier b; b.bar = bar; b.x = xb_xcc_id(); b.st = st;
    if (threadIdx.x == 0) (void)xb_add(&bar[XB_XCNT(b.x)], 1u);
    return b;
}
__device__ __forceinline__ void xcd_barrier_complete(unsigned* bar, unsigned x, unsigned& nloc, unsigned& nx) {
    const unsigned G = gridDim.x * gridDim.y * gridDim.z;
    unsigned sum, cnt, mine, sp = 0u;
    for (;;) {
        sum = 0u; cnt = 0u; mine = 0u;
#pragma unroll
        for (unsigned j = 0; j < 16; ++j) { const unsigned c = xb_ld(&bar[XB_XCNT(j)]); sum += c; cnt += (c > 0u) ? 1u : 0u; mine = (j == x) ? c : mine; }
        if (sum == G) break;
        __builtin_amdgcn_s_sleep(1);
        if ((++sp & 255u) == 0u) { if (xb_ld(&bar[XB_TMO])) break; if (sp > XB_SPIN_CAP) { atomicAdd(&bar[XB_TMO], 1u); break; } }
    }
    nloc = mine > 0u ? mine : 1u; nx = cnt > 0u ? cnt : 1u;
}

__device__ __forceinline__ void xcd_barrier(const XcdBarrier& b) {
    asm volatile("s_waitcnt vmcnt(0)" ::: "memory");
    __syncthreads();
    if (threadIdx.x == 0) {
        unsigned* bar = b.bar;
        __builtin_amdgcn_s_waitcnt(0);
        unsigned nloc = b.st[0], nx = b.st[1];
        if (nloc == 0u) { xcd_barrier_complete(bar, b.x, nloc, nx); b.st[0] = nloc; b.st[1] = nx; }
        const unsigned old = xb_add(&bar[XB_XSUB(b.x)], 1u);
        const unsigned gen = old / nloc;
        if (old + 1u == (gen + 1u) * nloc) {
            __builtin_amdgcn_fence(__ATOMIC_RELEASE, "agent");
            asm volatile("s_waitcnt vmcnt(0)" ::: "memory");
            const unsigned og = xb_add(&bar[XB_TOP], 1u);
            const unsigned tg = og / nx;
            if (og + 1u == (tg + 1u) * nx) xb_add(&bar[XB_TOPGEN], 1u);
            else XB_SPIN(xb_ld(&bar[XB_TOPGEN]) == tg, bar);
            __builtin_amdgcn_fence(__ATOMIC_ACQUIRE, "agent");
            xb_add(&bar[XB_XGEN(b.x)], 1u);
            asm volatile("s_waitcnt vmcnt(0)" ::: "memory");
        } else {
            XB_SPIN(xb_ld(&bar[XB_XGEN(b.x)]) == gen, bar);
            __builtin_amdgcn_fence(__ATOMIC_ACQUIRE, "agent");
            asm volatile("s_waitcnt vmcnt(0)" ::: "memory");
        }
    }
    __syncthreads();
}


struct Frame {
    LAS unsigned char* lds;
    volatile LAS unsigned* MISC;
    gu32* ctl;
    unsigned char* ws;
    int tid, lane, wave, vcu, G;
};
struct Args { const float* in[15]; float* out; unsigned char* ws; int ph_lo, ph_hi; };

__device__ __forceinline__ float wave_sum(float v) {
#pragma unroll
    for (int o = 1; o < 64; o <<= 1) v += __shfl_xor(v, o);
    return v;
}

template <class ColMap>
__device__ __forceinline__ void p0_transpose_item(const float* W, int K, int N, bf16* WT, int nblk, LAS float* scr, int item, int lane, ColMap cm) {
    const int kb = item / nblk, nb = item % nblk, k0 = 64 * kb, n0 = 32 * nb;
    const int src = cm(n0 + (lane & 31));
#pragma unroll 8
    for (int i = 0; i < 32; ++i) { const int kk = 2 * i + (lane >> 5); scr[kk * 33 + (lane & 31)] = (src >= 0) ? W[(size_t)(k0 + kk) * N + src] : 0.f; }
    LDS_WAIT(); asm volatile("" ::: "memory");
    const int c = lane & 7;
#pragma unroll
    for (int j = 0; j < 4; ++j) { const int n = (lane >> 3) + 8 * j; const LAS float* s = scr + (8 * c) * 33 + n;
        v4u o; o.x = pk2(s[0 * 33], s[1 * 33]); o.y = pk2(s[2 * 33], s[3 * 33]); o.z = pk2(s[4 * 33], s[5 * 33]); o.w = pk2(s[6 * 33], s[7 * 33]);
        *(GAS v4u*)(WT + (size_t)(n0 + n) * K + k0 + 8 * c) = o; }
    LDS_WAIT(); asm volatile("" ::: "memory");
}
struct MapIdent { __device__ __forceinline__ int operator()(int n) const { return n; } };
struct MapWin { __device__ __forceinline__ int operator()(int n) const {
    if (n < 2048) return n;
    if (n < 2560) return 2120 + (n - 2048);
    if (n < 4608) return 2632 + (n - 2560);
    if (n < 4672) return 2048 + (n - 4608);
    if (n < 4680) return 2112 + (n - 4672);
    return -1; } };

template <int NR> __device__ __forceinline__ void rms_rows_to_bf16(const float* x, const float* g, bf16* o, int m0, int stride, int lane) {
    f32x4 v[NR][4]; float s[NR];
#pragma unroll
    for (int r = 0; r < NR; ++r) { const GAS f32x4* xr = (const GAS f32x4*)(x + (size_t)(m0 + r * stride) * DM) + lane;
#pragma unroll
        for (int j = 0; j < 4; ++j) v[r][j] = xr[64 * j]; }
#pragma unroll
    for (int r = 0; r < NR; ++r) { float a = 0.f;
#pragma unroll
        for (int j = 0; j < 4; ++j) a += (v[r][j].x * v[r][j].x + v[r][j].y * v[r][j].y) + (v[r][j].z * v[r][j].z + v[r][j].w * v[r][j].w);
        s[r] = a; }
#pragma unroll
    for (int o2 = 1; o2 < 64; o2 <<= 1) {
#pragma unroll
        for (int r = 0; r < NR; ++r) s[r] += __shfl_xor(s[r], o2);
    }
    const GAS f32x4* gr = (const GAS f32x4*)g + lane;
    f32x4 gg[4];
#pragma unroll
    for (int j = 0; j < 4; ++j) gg[j] = gr[64 * j];
#pragma unroll
    for (int r = 0; r < NR; ++r) { const float rs = 1.0f / sqrtf(s[r] * (1.f / 1024.f) + EPS);
        GAS unsigned long long* o8 = (GAS unsigned long long*)(o + (size_t)(m0 + r * stride) * DM) + lane;
#pragma unroll
        for (int j = 0; j < 4; ++j) o8[64 * j] = (unsigned long long)pk2(v[r][j].x * rs * gg[j].x, v[r][j].y * rs * gg[j].y) | ((unsigned long long)pk2(v[r][j].z * rs * gg[j].z, v[r][j].w * rs * gg[j].w) << 32); }
}

__device__ __forceinline__ void p0_prologue(Frame& F, const Args& AR) {
    LAS float* scr = (LAS float*)(F.lds + F.wave * 16384);
    const int gw = F.vcu * NWAVES + F.wave, NGW = F.G * NWAVES, lane = F.lane;
    constexpr int I_WIN = 16 * 152, I_WA = 8 * 32, I_WO = 16 * 32;
    for (int it = gw; it < I_WIN + I_WA + I_WO; it += NGW) {
        int r = it;
        if (r < I_WIN) { p0_transpose_item((AR.in[2]), 1024, IN_WIDTH, ((bf16*)(F.ws + WS_WIN)), 152, scr, r, lane, MapWin()); continue; } r -= I_WIN;
        if (r < I_WA) { p0_transpose_item((AR.in[7]), 512, 1024, ((bf16*)(F.ws + WS_WA)), 32, scr, r, lane, MapIdent()); continue; } r -= I_WA;
        p0_transpose_item((AR.in[9]), 1024, 1024, ((bf16*)(F.ws + WS_WO)), 32, scr, r, lane, MapIdent());
    }
    for (int it = gw; it < 16 * 64; it += NGW) {
        const int nb = it & 15, kb = it >> 4, n = nb * 64 + lane, k0 = kb * 8, g = k0 >> 7, c0 = k0 & 127;
        float acc[8];
#pragma unroll
        for (int j = 0; j < 8; ++j) acc[j] = 0.f;
        for (int d = 0; d < 128; ++d) {
            const float wv = (AR.in[8])[(size_t)(g * 128 + d) * 1024 + n] * (AR.in[6])[g * 128 + d];
#pragma unroll
            for (int j = 0; j < 8; ++j) acc[j] += (AR.in[5])[(size_t)(g * 128 + c0 + j) * 128 + d] * wv;
        }
        v4u o; o.x = pk2(acc[0], acc[1]); o.y = pk2(acc[2], acc[3]); o.z = pk2(acc[4], acc[5]); o.w = pk2(acc[6], acc[7]);
        *(GAS v4u*)(((bf16*)(F.ws + WS_WPP)) + (size_t)n * 512 + k0) = o;
    }
    for (int it = gw; it < 16 * 32; it += NGW) p0_transpose_item((AR.in[11]), 1024, 1024, ((bf16*)(F.ws + WS_W2)), 32, scr, it, lane, MapIdent());
    for (int it = gw; it < 256; it += NGW) { const size_t e0 = (size_t)it * 512 + lane * 8;
        const f32x4 a = *(const GAS f32x4*)((AR.in[12]) + e0), b = *(const GAS f32x4*)((AR.in[12]) + e0 + 4);
        v4u o; o.x = pk2(a.x, a.y); o.y = pk2(a.z, a.w); o.z = pk2(b.x, b.y); o.w = pk2(b.z, b.w);
        *(GAS v4u*)(((bf16*)(F.ws + WS_SKB)) + e0) = o; }
    {   float mu = 0.f, mv = 0.f;
#pragma unroll 4
        for (int it = gw; it < 2 * 32768; it += NGW) {
            const float* src = (it < 32768) ? (AR.in[13]) : (AR.in[14]); const size_t e0 = (size_t)(it & 32767) * 512 + lane * 8;
            const f32x4 a = *(const GAS f32x4*)(src + e0), b = *(const GAS f32x4*)(src + e0 + 4);
            const float m = fmaxf(fmaxf(fmaxf(fabsf(a.x), fabsf(a.y)), fmaxf(fabsf(a.z), fabsf(a.w))), fmaxf(fmaxf(fabsf(b.x), fabsf(b.y)), fmaxf(fabsf(b.z), fabsf(b.w))));
            if (it < 32768) mu = fmaxf(mu, m); else mv = fmaxf(mv, m);
        }
#pragma unroll
        for (int o = 1; o < 64; o <<= 1) { mu = fmaxf(mu, __shfl_xor(mu, o)); mv = fmaxf(mv, __shfl_xor(mv, o)); }
        if (lane == 0) { __hip_atomic_fetch_max(F.ctl + CW_AMAX, __float_as_uint(mu), RLX_AGENT); __hip_atomic_fetch_max(F.ctl + CW_AMAX + 1, __float_as_uint(mv), RLX_AGENT); }
    }
    for (int it = gw * 64 + lane; it < 4096 * 8; it += NGW * 64) {
        const int pos = it >> 3, i = it & 7;
        const float invf = exp2f(-(float)i * 0.125f * 18.931568569324174f);
        const double ang = (double)((float)pos * invf);
        const double kq = __builtin_rint(ang * 0.6366197723675814);
        const float r = (float)(ang - kq * 1.5707963267948966);
        const int q = (int)((long long)kq & 3);
        const float r2 = r * r;
        const float sn = r + r * r2 * (-1.6666654611e-1f + r2 * (8.3321608736e-3f + r2 * (-1.9515295891e-4f)));
        const float cs = 1.0f - 0.5f * r2 + r2 * r2 * (4.166664568298827e-2f + r2 * (-1.388731625493765e-3f + r2 * 2.443315711809948e-5f));
        const float s = (q == 0) ? sn : (q == 1) ? cs : (q == 2) ? -sn : -cs;
        const float c = (q == 0) ? cs : (q == 1) ? -sn : (q == 2) ? -cs : sn;
        ((float*)(F.ws + WS_ROPE))[pos * 16 + i] = c; ((float*)(F.ws + WS_ROPE))[pos * 16 + 8 + i] = s;
    }
    { int m = gw;
      for (; m + 3 * NGW < MTOK; m += 4 * NGW) rms_rows_to_bf16<4>((AR.in[0]), (AR.in[1]), ((bf16*)(F.ws + WS_ACT)), m, NGW, lane);
      for (; m < MTOK; m += NGW) rms_rows_to_bf16<1>((AR.in[0]), (AR.in[1]), ((bf16*)(F.ws + WS_ACT)), m, NGW, lane); }
}

__device__ __forceinline__ void unpack8(const v4u w, float (&v)[8]) { v[0] = bflo(w.x); v[1] = bfhi(w.x); v[2] = bflo(w.y); v[3] = bfhi(w.y); v[4] = bflo(w.z); v[5] = bfhi(w.z); v[6] = bflo(w.w); v[7] = bfhi(w.w); }
__device__ __forceinline__ v4u pack8(const float (&v)[8]) { v4u o; o.x = pk2(v[0], v[1]); o.y = pk2(v[2], v[3]); o.z = pk2(v[4], v[5]); o.w = pk2(v[6], v[7]); return o; }
__device__ __forceinline__ void rope8(float (&v)[8], int sub, const float (&cs)[8], const float (&sn)[8]) {
    float pv[8];
#pragma unroll
    for (int j = 0; j < 8; ++j) pv[j] = __shfl_xor(v[j], 1);
    if (sub == 0) {
#pragma unroll
        for (int j = 0; j < 8; ++j) v[j] = v[j] * cs[j] - pv[j] * sn[j];
    } else if (sub == 1) {
#pragma unroll
        for (int j = 0; j < 8; ++j) v[j] = v[j] * cs[j] + pv[j] * sn[j];
    }
}
__device__ __forceinline__ float fp8_scale(unsigned amax_bits) { const unsigned be = (amax_bits >> 23) & 0xffu; return (be == 0u || be > 250u) ? 1.0f : __uint_as_float((261u - be) << 23); }
__device__ __forceinline__ float fp8_inv_scale(unsigned amax_bits) { const unsigned be = (amax_bits >> 23) & 0xffu; return (be == 0u || be > 250u) ? 1.0f : __uint_as_float((be - 7u) << 23); }
__device__ __forceinline__ void row_to_fp8(const float* src, unsigned char* dst, float sc, int lane) {
    const GAS f32x4* p = (const GAS f32x4*)src + lane * 4; v4u o;
#pragma unroll
    for (int q = 0; q < 4; ++q) { const f32x4 a = p[q]; int w = 0; w = __builtin_amdgcn_cvt_pk_fp8_f32(a.x * sc, a.y * sc, w, false); w = __builtin_amdgcn_cvt_pk_fp8_f32(a.z * sc, a.w * sc, w, true); o[q] = (unsigned)w; }
    *(GAS v4u*)(dst + lane * 16) = o;
}
__device__ __forceinline__ void row_to_i8(const float* src, unsigned char* dst, float sc, int lane) {
    const GAS f32x4* p = (const GAS f32x4*)src + lane * 4; v4u o;
#pragma unroll
    for (int q = 0; q < 4; ++q) { const f32x4 a = p[q];
        const unsigned b0 = __float_as_uint(a.x * sc + 12582912.0f), b1 = __float_as_uint(a.y * sc + 12582912.0f), b2 = __float_as_uint(a.z * sc + 12582912.0f), b3 = __float_as_uint(a.w * sc + 12582912.0f);
        o[q] = __builtin_amdgcn_perm(b1, b0, 0x0c0c0400u) | __builtin_amdgcn_perm(b3, b2, 0x04000c0cu); }
    *(GAS v4u*)(dst + lane * 16) = o;
}
__device__ __forceinline__ float i8_scale(unsigned amax_bits) { const float a = __uint_as_float(amax_bits); return (a > 1e-30f && a < 1e30f) ? 127.0f / a : 1.0f; }
__device__ __forceinline__ float i8_inv_scale(unsigned amax_bits) { const float a = __uint_as_float(amax_bits); return (a > 1e-30f && a < 1e30f) ? a * (1.0f / 127.0f) : 1.0f; }
__device__ __forceinline__ void fixup_token(Frame& F, const Args& AR, int tok) {
    const int lane = F.lane, sub = lane & 7, pos = tok & (SEQ - 1);
    bf16* row = ((bf16*)(F.ws + WS_PROJ)) + (size_t)tok * LDP;
    float cs[8], sn[8];
    { const GAS f32x4* rt = (const GAS f32x4*)(((float*)(F.ws + WS_ROPE)) + pos * 16); const f32x4 a = rt[0], b = rt[1], c = rt[2], d = rt[3];
      cs[0] = a.x; cs[1] = a.y; cs[2] = a.z; cs[3] = a.w; cs[4] = b.x; cs[5] = b.y; cs[6] = b.z; cs[7] = b.w;
      sn[0] = c.x; sn[1] = c.y; sn[2] = c.z; sn[3] = c.w; sn[4] = d.x; sn[5] = d.y; sn[6] = d.z; sn[7] = d.w; }
#pragma unroll
    for (int which = 0; which < 2; ++which) {
        GAS v4u* p = (GAS v4u*)(row + (which ? K_OFF : Q_OFF) + lane * 8);
        float v[8]; unpack8(*p, v);
        float ss = 0.f;
#pragma unroll
        for (int j = 0; j < 8; ++j) ss += v[j] * v[j];
        ss += __shfl_xor(ss, 1); ss += __shfl_xor(ss, 2); ss += __shfl_xor(ss, 4);
        const float rs = 1.0f / sqrtf(ss * (1.f / 64.f) + EPS);
        const float* g = (which ? (AR.in[4]) : (AR.in[3])) + sub * 8;
#pragma unroll
        for (int j = 0; j < 8; ++j) v[j] = v[j] * rs * g[j];
        rope8(v, sub, cs, sn);
        if (which == 0) {
#pragma unroll
            for (int j = 0; j < 8; ++j) v[j] *= C2;
        }
        *p = pack8(v);
    }
    { GAS v4u* p = (GAS v4u*)(row + QI_OFF + lane * 8); float v[8]; unpack8(*p, v); rope8(v, sub, cs, sn); *p = pack8(v); }
    { GAS v4u* p = (GAS v4u*)(row + KI_OFF + (lane & 7) * 8); float v[8]; unpack8(*p, v); rope8(v, sub, cs, sn); if (lane < 8) *p = pack8(v); }
}
__device__ __forceinline__ void pool_run(Frame& F, int tok0, int ntok) {
    const int lane = F.lane, g = lane >> 4, w = 2 << g;
    const bf16* pcol = ((const bf16*)(F.ws + WS_PROJ)) + P_OFF + lane * 8;
    float S[8];
#pragma unroll
    for (int j = 0; j < 8; ++j) S[j] = 0.f;
    { const int pos0 = tok0 & (SEQ - 1);
#pragma unroll
      for (int back = 1; back < 16; ++back) {
          if (back < w && back <= pos0) { float t[8]; unpack8(*(const GAS v4u*)(pcol + (size_t)(tok0 - back) * LDP), t);
#pragma unroll
              for (int j = 0; j < 8; ++j) S[j] += t[j]; }
      } }
#pragma unroll 1
    for (int i = 0; i < ntok; ++i) {
        const int tok = tok0 + i, pos = tok & (SEQ - 1);
        float cur[8]; unpack8(*(const GAS v4u*)(pcol + (size_t)tok * LDP), cur);
#pragma unroll
        for (int j = 0; j < 8; ++j) S[j] += cur[j];
        const float inv = 1.0f / (float)((pos + 1 < w) ? (pos + 1) : w);
        float o[8];
#pragma unroll
        for (int j = 0; j < 8; ++j) o[j] = S[j] * inv - cur[j];
        *(GAS v4u*)(((bf16*)(F.ws + WS_POOLED)) + (size_t)tok * 512 + lane * 8) = pack8(o);
        if (pos + 1 >= w) { float t[8]; unpack8(*(const GAS v4u*)(pcol + (size_t)(tok + 1 - w) * LDP), t);
#pragma unroll
            for (int j = 0; j < 8; ++j) S[j] -= t[j]; }
    }
}

__device__ __forceinline__ int wave_incl_scan(int v) {
    v += __builtin_amdgcn_update_dpp(0, v, 0x111, 0xf, 0xf, false);
    v += __builtin_amdgcn_update_dpp(0, v, 0x112, 0xf, 0xf, false);
    v += __builtin_amdgcn_update_dpp(0, v, 0x114, 0xf, 0xf, false);
    v += __builtin_amdgcn_update_dpp(0, v, 0x118, 0xf, 0xf, false);
    v += __builtin_amdgcn_update_dpp(0, v, 0x142, 0xa, 0xf, false);
    v += __builtin_amdgcn_update_dpp(0, v, 0x143, 0xc, 0xf, false);
    return v;
}
template <int NB> __device__ __forceinline__ void hist_search(const LAS unsigned* hist, int need, int lane, int& B, int& G, int& E) {
    constexpr int PER = NB / 64;
    int t = 0;
#pragma unroll
    for (int q = 0; q < PER / 4; ++q) { const v4u h = *(const LAS v4u*)(hist + lane * PER + 4 * q); t += (int)(h.x + h.y + h.z + h.w); }
    const int pfx = wave_incl_scan(t);
    const int L = __ffsll((long long)__ballot(pfx >= need)) - 1;
    const int base = __builtin_amdgcn_readlane(pfx, L) - __builtin_amdgcn_readlane(t, L);
    const int hv = (lane < PER) ? (int)hist[L * PER + lane] : 0;
    const int p2 = wave_incl_scan(hv) + base;
    const int i = __ffsll((long long)__ballot(p2 >= need)) - 1;
    B = L * PER + i; E = __builtin_amdgcn_readlane(hv, i); G = __builtin_amdgcn_readlane(p2, i) - E;
}
template <int NB> __device__ __forceinline__ void hist_zero(LAS unsigned* hist, int lane) {
#pragma unroll
    for (int q = 0; q < NB / 256; ++q) *(LAS v4u*)(hist + q * 256 + lane * 4) = (v4u){0u, 0u, 0u, 0u};
}
#define HIST_ADD(p) (void)__hip_atomic_fetch_add((p), 1u, __ATOMIC_RELAXED, __HIP_MEMORY_SCOPE_WORKGROUP)
#define wlane(dst, sval, j) asm volatile("s_nop 3\n\tv_writelane_b32 %0, %1, %2\n\ts_nop 1" : "+v"(dst) : "s"(sval), "i"(j))
__device__ __forceinline__ void select_row(const unsigned short* srow  , LAS unsigned* hist, int nj, int lastw, GAS unsigned long long* mout, int lane, unsigned long long& tacc, unsigned& tcnt) {
    const unsigned long long ts0_ = (PROBE_SEC >= 30 && PROBE_SEC <= 33) ? __builtin_amdgcn_s_memtime() : 0ull;
    unsigned key[64];
#pragma unroll
    for (int g = 0; g < 8; ++g) {
        if (nj > 8 * g) {
#pragma unroll
            for (int jj = 0; jj < 8; ++jj) key[8 * g + jj] = ordk(__uint_as_float((unsigned)((const GAS unsigned short*)srow)[(64 * (8 * g + jj) + lane) * 8] << 16) + 0.0f);
        } else {
#pragma unroll
            for (int jj = 0; jj < 8; ++jj) key[8 * g + jj] = 0u;
        }
    }
    LDS_WAIT(); asm volatile("" ::: "memory");
    if (PROBE_SEC >= 30 && PROBE_SEC <= 33) asm volatile("s_waitcnt vmcnt(0)" ::: "memory");
    const unsigned long long ts1_ = (PROBE_SEC >= 30 && PROBE_SEC <= 33) ? __builtin_amdgcn_s_memtime() : 0ull;
    int need = 256, B, G, E;
    hist_zero<2048>(hist, lane); LDS_WAIT(); asm volatile("" ::: "memory");
#pragma unroll
    for (int g = 0; g < 8; ++g) if (nj > 8 * g) {
#pragma unroll
        for (int jj = 0; jj < 8; ++jj) HIST_ADD(hist + (2047u - (key[8 * g + jj] >> 21)));
    }
    LDS_WAIT(); asm volatile("" ::: "memory");
    hist_search<2048>(hist, need, lane, B, G, E); need -= G;
    const unsigned long long ts2_ = (PROBE_SEC >= 30 && PROBE_SEC <= 33) ? __builtin_amdgcn_s_memtime() : 0ull;
    const unsigned d1 = 2047u - (unsigned)B;
    asm volatile("" ::: "memory"); hist_zero<2048>(hist, lane); LDS_WAIT(); asm volatile("" ::: "memory");
#pragma unroll
    for (int g = 0; g < 8; ++g) if (nj > 8 * g) {
#pragma unroll
        for (int jj = 0; jj < 8; ++jj) { const unsigned k = key[8 * g + jj]; if ((k >> 21) == d1) HIST_ADD(hist + (2047u - ((k >> 10) & 0x7ffu))); }
    }
    LDS_WAIT(); asm volatile("" ::: "memory");
    hist_search<2048>(hist, need, lane, B, G, E); need -= G;
    const unsigned pre2 = (d1 << 11) | (2047u - (unsigned)B);
    const unsigned v = pre2 << 10;
    const unsigned long long ts3_ = (PROBE_SEC >= 30 && PROBE_SEC <= 33) ? __builtin_amdgcn_s_memtime() : 0ull;
    unsigned mlo = 0u, mhi = 0u;
#pragma unroll
    for (int g = 0; g < 8; ++g) {
        asm volatile("v_cmp_ge_u32_e64 s[40:41], %2, %10\n\tv_cmp_ge_u32_e64 s[42:43], %3, %10\n\tv_cmp_ge_u32_e64 s[44:45], %4, %10\n\tv_cmp_ge_u32_e64 s[46:47], %5, %10\n\t"
                     "v_cmp_ge_u32_e64 s[48:49], %6, %10\n\tv_cmp_ge_u32_e64 s[50:51], %7, %10\n\tv_cmp_ge_u32_e64 s[52:53], %8, %10\n\tv_cmp_ge_u32_e64 s[54:55], %9, %10\n\ts_nop 1\n\t"
                     "v_writelane_b32 %0, s40, %11\n\tv_writelane_b32 %1, s41, %11\n\tv_writelane_b32 %0, s42, %12\n\tv_writelane_b32 %1, s43, %12\n\t"
                     "v_writelane_b32 %0, s44, %13\n\tv_writelane_b32 %1, s45, %13\n\tv_writelane_b32 %0, s46, %14\n\tv_writelane_b32 %1, s47, %14\n\t"
                     "v_writelane_b32 %0, s48, %15\n\tv_writelane_b32 %1, s49, %15\n\tv_writelane_b32 %0, s50, %16\n\tv_writelane_b32 %1, s51, %16\n\t"
                     "v_writelane_b32 %0, s52, %17\n\tv_writelane_b32 %1, s53, %17\n\tv_writelane_b32 %0, s54, %18\n\tv_writelane_b32 %1, s55, %18\n\ts_nop 1"
                     : "+v"(mlo), "+v"(mhi)
                     : "v"(key[8 * g]), "v"(key[8 * g + 1]), "v"(key[8 * g + 2]), "v"(key[8 * g + 3]), "v"(key[8 * g + 4]), "v"(key[8 * g + 5]), "v"(key[8 * g + 6]), "v"(key[8 * g + 7]), "v"(v),
                       "i"(8 * g), "i"(8 * g + 1), "i"(8 * g + 2), "i"(8 * g + 3), "i"(8 * g + 4), "i"(8 * g + 5), "i"(8 * g + 6), "i"(8 * g + 7)
                     : "s40", "s41", "s42", "s43", "s44", "s45", "s46", "s47", "s48", "s49", "s50", "s51", "s52", "s53", "s54", "s55");
    }
    int drop = E - need;
#pragma unroll
    for (int j = 63; j >= 0; --j) {
        if (drop > 0) {
            unsigned long long eq = __ballot(key[j] == v);
            if (eq != 0ull) {
                unsigned long long rem = 0ull;
                while (drop > 0 && eq != 0ull) { const unsigned long long hb = 1ull << (63 - __clzll((long long)eq)); rem |= hb; eq ^= hb; --drop; }
                const unsigned long long m = __ballot(key[j] >= v) & ~rem;
                wlane(mlo, (unsigned)m, j); wlane(mhi, (unsigned)(m >> 32), j);
            }
        }
    }
    if (lane <= lastw) mout[lane] = ((unsigned long long)mhi << 32) | (unsigned long long)mlo;
    LDS_WAIT(); asm volatile("" ::: "memory");
    if (PROBE_SEC >= 30 && PROBE_SEC <= 33) { const unsigned long long ts4_ = __builtin_amdgcn_s_memtime(); tacc += (PROBE_SEC == 30) ? (ts1_ - ts0_) : (PROBE_SEC == 31) ? (ts2_ - ts1_) : (PROBE_SEC == 32) ? (ts3_ - ts2_) : (ts4_ - ts3_); ++tcnt; }
}

__device__ __forceinline__ float* wave_scratch(unsigned char* ws, int gwv) {
    if (gwv < 1024) return (float*)(ws + WS_ACT) + (size_t)gwv * 32768;
    gwv -= 1024; if (gwv < 512) return (float*)(ws + WS_AO) + (size_t)gwv * 32768;
    gwv -= 512; if (gwv < 352) return (float*)(ws + 980 * MiB) + (size_t)gwv * 32768;
    gwv -= 352; if (gwv < 128) return (float*)(ws + 36 * MiB) + (size_t)gwv * 32768;
    gwv -= 128; return (float*)(ws + 68 * MiB) + (size_t)(gwv & 127) * 32768;
}
__device__ __forceinline__ void idx_unit(Frame& F, const Args& AR, int b, int c, unsigned long long& tacc, unsigned& tcnt, bool do_select = true) {
    const unsigned long long ti0_ = (PROBE_SEC >= 20 && PROBE_SEC <= 22) ? __builtin_amdgcn_s_memtime() : 0ull;
    const int lane = F.lane, wid = F.wave, l31 = lane & 31, h2 = lane >> 5;
    const size_t rowb = (size_t)b * SEQ, tp0 = rowb + (size_t)c * 64 + wid * 8;
    GAS unsigned long long* mbase = (GAS unsigned long long*)(((unsigned long long*)(F.ws + WS_MASK)) + tp0 * 64);
    if (c < 4) {
        if (lane < 32) { const int q = lane >> 2, j = lane & 3; mbase[q * 64 + j] = (j <= c) ? ~0ull : 0ull; }
        return;
    }
    unsigned short* sc = (unsigned short*)wave_scratch(F.ws, F.vcu * NWAVES + wid);
    LAS unsigned* hist = (LAS unsigned*)(F.lds + wid * 8192);
    const int ntile = 2 * (c + 1), nj = c + 1, lastw = c | 3, ntile_pad = 16 * ((nj + 7) >> 3);
    const int head = (l31 & 3) | (((l31 >> 3) & 1) << 2), qsub = ((l31 >> 2) & 1) | (((l31 >> 4) & 1) << 1);
    bf16x8 a[2][4]; float w[2][16];
#pragma unroll
    for (int rb = 0; rb < 2; ++rb) {
        const bf16* ap = ((bf16*)(F.ws + WS_PROJ)) + (tp0 + 4 * rb + qsub) * LDP + QI_OFF + head * 64 + h2 * 8;
#pragma unroll
        for (int st = 0; st < 4; ++st) a[rb][st] = *(const GAS bf16x8*)(ap + st * 16);
        const v4u wa = *(const GAS v4u*)(((bf16*)(F.ws + WS_PROJ)) + (tp0 + 4 * rb + h2) * LDP + WI_OFF), wb = *(const GAS v4u*)(((bf16*)(F.ws + WS_PROJ)) + (tp0 + 4 * rb + h2 + 2) * LDP + WI_OFF);
        float t[8]; unpack8(wa, t);
#pragma unroll
        for (int j = 0; j < 8; ++j) w[rb][j] = t[j] * WI_SCALE;
        unpack8(wb, t);
#pragma unroll
        for (int j = 0; j < 8; ++j) w[rb][8 + j] = t[j] * WI_SCALE;
    }
    const unsigned long long ti1_ = (PROBE_SEC >= 20 && PROBE_SEC <= 22) ? __builtin_amdgcn_s_memtime() : 0ull;
    {
        LAS unsigned char* kb = F.lds + 65536;
        const int nstage = (ntile + 3) >> 2;
        const int sk0 = F.tid >> 3, sch = F.tid & 7;
        const bf16* kg = ((bf16*)(F.ws + WS_PROJ)) + (rowb + sk0) * LDP + KI_OFF + sch * 8;
        v4u r0 = *(const GAS v4u*)kg, r1 = *(const GAS v4u*)(kg + (size_t)64 * LDP);
#pragma unroll 1
        for (int sg = 0; sg < nstage; ++sg) {
            LAS unsigned char* cur = kb + (sg & 1) * 18432;
            *(LAS v4u*)(cur + sk0 * 144 + sch * 16) = r0; *(LAS v4u*)(cur + (sk0 + 64) * 144 + sch * 16) = r1;
            BAR_LDS();
            { const int sn = (sg + 1 < nstage) ? sg + 1 : sg; r0 = *(const GAS v4u*)(kg + (size_t)sn * 128 * LDP); r1 = *(const GAS v4u*)(kg + (size_t)(sn * 128 + 64) * LDP); }
#pragma unroll
            for (int t4 = 0; t4 < 4; ++t4) {
                const int kt = 4 * sg + t4;
                if (kt < ntile) {
                    bf16x8 bfr[4];
#pragma unroll
                    for (int st = 0; st < 4; ++st) bfr[st] = *(const LAS bf16x8*)(cur + (t4 * 32 + l31) * 144 + st * 32 + h2 * 16);
                    float sq[4];
#pragma unroll
                    for (int rb = 0; rb < 2; ++rb) {
                        f32x16 acc;
#pragma unroll
                        for (int r = 0; r < 16; ++r) acc[r] = 0.f;
#pragma unroll
                        for (int st = 0; st < 4; ++st) acc = __builtin_amdgcn_mfma_f32_32x32x16_bf16(a[rb][st], bfr[st], acc, 0, 0, 0);
                        float s0 = 0.f, s1 = 0.f;
#pragma unroll
                        for (int r = 0; r < 8; ++r) { s0 = fmaf(w[rb][r], relu_i(acc[r]), s0); s1 = fmaf(w[rb][8 + r], relu_i(acc[8 + r]), s1); }
                        sq[2 * rb] = s0; sq[2 * rb + 1] = s1;
                    }
                    *(GAS v2u*)(sc + (size_t)(kt * 32 + l31) * 8 + 4 * h2) = (v2u){pk2(sq[0], sq[1]), pk2(sq[2], sq[3])};
                }
            }
        }
        for (int kt = ntile; kt < ntile_pad; ++kt)
            *(GAS v2u*)(sc + (size_t)(kt * 32 + l31) * 8 + 4 * h2) = (v2u){0xff80ff80u, 0xff80ff80u};
    }
    const unsigned long long ti2_ = (PROBE_SEC >= 20 && PROBE_SEC <= 22) ? __builtin_amdgcn_s_memtime() : 0ull;
    VM_WAIT();
    if (do_select) {
#pragma unroll 1
        for (int q = 0; q < 8 * PROBE_SEL2; ++q) select_row(sc + 4 * (q & 1) + ((q & 7) >> 1), hist, nj, lastw, mbase + (q & 7) * 64, lane, tacc, tcnt);
    }
    if (PROBE_SEC >= 20 && PROBE_SEC <= 22) { const unsigned long long ti3_ = __builtin_amdgcn_s_memtime(); tacc += (PROBE_SEC == 20) ? (ti1_ - ti0_) : (PROBE_SEC == 21) ? (ti2_ - ti1_) : (ti3_ - ti2_); tcnt = 1000u; }
}

__device__ __forceinline__ void attn_unit(Frame& F, const Args& AR, int b, int h, int qb, unsigned long long& tacc, unsigned& tcnt) {
    const int lane = F.lane, wid = F.wave, l31 = lane & 31, h2 = lane >> 5;
    LAS unsigned char* Ks = F.lds;
    LAS float* wsf = (LAS float*)(F.lds + 2 * 17408) + wid * 32;
    const size_t rowb = (size_t)b * SEQ, tok0 = rowb + (size_t)qb * 256 + wid * 32;
    bf16x8 qf[4];
    { const bf16* qp = ((bf16*)(F.ws + WS_PROJ)) + (tok0 + l31) * LDP + Q_OFF + h * 64 + h2 * 8;
#pragma unroll
      for (int st = 0; st < 4; ++st) qf[st] = *(const GAS bf16x8*)(qp + st * 16); }
    const int NT = 4 * (qb + 1), cw = qb * 4 + (wid >> 1);
    f32x16 o0, o1;
#pragma unroll
    for (int r = 0; r < 16; ++r) { o0[r] = 0.f; o1[r] = 0.f; }
    float lsum = 0.f;
    const int skey = F.tid >> 3, sch = F.tid & 7;
    const bf16* kg = ((bf16*)(F.ws + WS_PROJ)) + (rowb + skey) * LDP + K_OFF + h * 64 + sch * 8;
    const bf16* vg = ((bf16*)(F.ws + WS_PROJ)) + (rowb + skey) * LDP + V_OFF + h * 64 + sch * 8;
    const unsigned kst = skey * 144 + sch * 16, vst = skey * 128 + ((sch * 16) ^ (((skey >> 1) & 1) << 6));
    const GAS unsigned long long* mrow = (const GAS unsigned long long*)(((unsigned long long*)(F.ws + WS_MASK)) + (tok0 + l31) * 64);
    const int i16 = lane & 15, qq = i16 >> 2, pp = i16 & 3, blk = (lane >> 4) & 1;
    const unsigned vrd = (unsigned)((4 * h2 + qq) * 128 + ((32 * blk + 8 * pp) ^ (((qq >> 1) & 1) << 6)));
    v4u kr[3], vr[3];
#pragma unroll
    for (int u = 0; u < 3; ++u) { kr[u] = *(const GAS v4u*)(kg + (size_t)u * 64 * LDP); vr[u] = *(const GAS v4u*)(vg + (size_t)u * 64 * LDP); }
    unsigned long long mwn = mrow[0];
#pragma unroll 1
    for (int t = 0; t < NT; t += 3) {
#pragma unroll
        for (int u = 0; u < 3; ++u) {
            const int tt = t + u;
            if (tt < NT) {
                LAS unsigned char* Kc = Ks + (tt & 1) * 17408; LAS unsigned char* Vc = Kc + 9216;
                const unsigned long long t_a = PROBE_SEC ? __builtin_amdgcn_s_memtime() : 0ull;
                *(LAS v4u*)(Kc + kst) = kr[u]; *(LAS v4u*)(Vc + vst) = vr[u];
                BAR_LDS();
                const unsigned long long t_b = PROBE_SEC ? __builtin_amdgcn_s_memtime() : 0ull;
                { const int tn = (tt + 3 < NT) ? tt + 3 : NT - 1;
                  kr[u] = *(const GAS v4u*)(kg + (size_t)tn * 64 * LDP); vr[u] = *(const GAS v4u*)(vg + (size_t)tn * 64 * LDP); }
                const unsigned long long mw = mwn;
                mwn = mrow[(tt + 1 < NT) ? tt + 1 : tt];
                if (tt <= cw) {
                    bf16x8 vfr[2][2][2];
        #pragma unroll
                    for (int kb = 0; kb < 2; ++kb)
        #pragma unroll
                        for (int s = 0; s < 2; ++s)
        #pragma unroll
                            for (int d0 = 0; d0 < 2; ++d0) {
                                const unsigned ad = (vrd + (unsigned)((32 * kb + 16 * s) * 128)) ^ (unsigned)(d0 << 6);
                                const s16x4 lo = __builtin_bit_cast(s16x4, __builtin_amdgcn_ds_read_tr16_b64_v4i16((LAS s16x4*)(Vc + ad)));
                                const s16x4 hi = __builtin_bit_cast(s16x4, __builtin_amdgcn_ds_read_tr16_b64_v4i16((LAS s16x4*)(Vc + ad + 8 * 128)));
                                vfr[kb][s][d0] = (bf16x8){lo[0], lo[1], lo[2], lo[3], hi[0], hi[1], hi[2], hi[3]};
                            }
                    f32x16 p[2];
        #pragma unroll
                    for (int kb = 0; kb < 2; ++kb) {
                        f32x16 acc;
        #pragma unroll
                        for (int r = 0; r < 16; ++r) acc[r] = 0.f;
        #pragma unroll
                        for (int st = 0; st < 4; ++st) { const bf16x8 ka = *(const LAS bf16x8*)(Kc + (32 * kb + l31) * 144 + st * 32 + h2 * 16); acc = __builtin_amdgcn_mfma_f32_32x32x16_bf16(ka, qf[st], acc, 0, 0, 0); }
                        const unsigned wk = (kb ? (unsigned)(mw >> 32) : (unsigned)mw) >> (4 * h2);
        #pragma unroll
                        for (int r = 0; r < 16; ++r) {
                            const float e = __builtin_amdgcn_exp2f(acc[r]);
                            float pe;
                            asm("v_bfe_i32 %0, %2, %3, 1\n\tv_and_b32 %0, %0, %1" : "=&v"(pe) : "v"(e), "v"(wk), "i"((r & 3) + 8 * (r >> 2)));
                            acc[r] = pe;
                        }
                        p[kb] = acc;
                    }
                    const unsigned long long t_c = PROBE_SEC ? __builtin_amdgcn_s_memtime() : 0ull;
        #pragma unroll
                    for (int kb = 0; kb < 2; ++kb)
        #pragma unroll
                        for (int s = 0; s < 2; ++s) {
                            v4u pw; pw.x = pg8::cvt_pk_bf16(p[kb][8 * s + 0], p[kb][8 * s + 1]); pw.y = pg8::cvt_pk_bf16(p[kb][8 * s + 2], p[kb][8 * s + 3]); pw.z = pg8::cvt_pk_bf16(p[kb][8 * s + 4], p[kb][8 * s + 5]); pw.w = pg8::cvt_pk_bf16(p[kb][8 * s + 6], p[kb][8 * s + 7]);
                            lsum = dot2bf(pw.x, 0x3f803f80u, lsum); lsum = dot2bf(pw.y, 0x3f803f80u, lsum); lsum = dot2bf(pw.z, 0x3f803f80u, lsum); lsum = dot2bf(pw.w, 0x3f803f80u, lsum);
                            const bf16x8 pa = __builtin_bit_cast(bf16x8, pw);
        #pragma unroll
                            for (int d0 = 0; d0 < 2; ++d0) {
                                const bf16x8 vb = vfr[kb][s][d0];
                                if (d0 == 0) o0 = __builtin_amdgcn_mfma_f32_32x32x16_bf16(pa, vb, o0, 0, 0, 0); else o1 = __builtin_amdgcn_mfma_f32_32x32x16_bf16(pa, vb, o1, 0, 0, 0);
                            }
                        }
                    if (PROBE_SEC) { const unsigned long long t_d = __builtin_amdgcn_s_memtime(); tacc += (PROBE_SEC == 1) ? (t_b - t_a) : (PROBE_SEC == 2) ? (t_c - t_b) : (PROBE_SEC == 3) ? (t_d - t_c) : (t_d - t_a); ++tcnt; }
                }
            }
        }
    }
    lsum += __shfl_xor(lsum, 32);
    if (h2 == 0) wsf[l31] = lsum;
    LDS_WAIT(); asm volatile("" ::: "memory");
    LAS bf16* stg = (LAS bf16*)(F.lds + 2 * 17408 + 1024) + wid * 2048;
#pragma unroll
    for (int r = 0; r < 16; ++r) { const int q = crow(r, h2); const float rl = 1.0f / wsf[q];
        stg[q * 64 + l31] = (bf16)f2bf(o0[r] * rl); stg[q * 64 + 32 + l31] = (bf16)f2bf(o1[r] * rl); }
    LDS_WAIT(); asm volatile("" ::: "memory");
    bf16* ow = ((bf16*)(F.ws + WS_AO)) + tok0 * 512 + h * 64;
#pragma unroll
    for (int i = 0; i < 4; ++i) { const int row = i * 8 + (lane >> 3), ch = lane & 7; const v4u v = *(const LAS v4u*)(stg + row * 64 + ch * 8); *(GAS v4u*)(ow + (size_t)row * 512 + ch * 8) = v; }
    LDS_WAIT(); asm volatile("" ::: "memory");
}

__device__ __forceinline__ float row_rs(const float* ssp, size_t tok) {
    const GAS f32x4* p = (const GAS f32x4*)(ssp + tok * 16); const f32x4 a = p[0], b = p[1], c = p[2], d = p[3];
    const float ss = ((a.x + a.y) + (a.z + a.w)) + ((b.x + b.y) + (b.z + b.w)) + ((c.x + c.y) + (c.z + c.w)) + ((d.x + d.y) + (d.z + d.w));
    return 1.0f / sqrtf(ss * (1.f / 1024.f) + EPS);
}
__device__ __forceinline__ void sort16_desc(unsigned (&a)[16]) {
#pragma unroll
    for (int k = 2; k <= 16; k <<= 1)
#pragma unroll
        for (int j = k >> 1; j > 0; j >>= 1)
#pragma unroll
            for (int i = 0; i < 16; ++i) { const int l = i ^ j; if (l > i) { const unsigned hi = a[i] > a[l] ? a[i] : a[l], lo = a[i] > a[l] ? a[l] : a[i];
                if ((i & k) == 0) { a[i] = hi; a[l] = lo; } else { a[i] = lo; a[l] = hi; } } }
}
__device__ __forceinline__ void merge16_desc(unsigned (&top)[16], const unsigned (&a)[16]) {
#pragma unroll
    for (int i = 0; i < 16; ++i) top[i] = top[i] > a[15 - i] ? top[i] : a[15 - i];
#pragma unroll
    for (int j = 8; j > 0; j >>= 1)
#pragma unroll
        for (int i = 0; i < 16; ++i) { const int l = i ^ j; if (l > i) { const unsigned hi = top[i] > top[l] ? top[i] : top[l], lo = top[i] > top[l] ? top[l] : top[i]; top[i] = hi; top[l] = lo; } }
}
struct PairTab { int i[64], j[64]; };
constexpr PairTab make_pairs() { PairTab t{}; int n = 0; for (int i = 0; i < 16; ++i) for (int j = 0; j < 16; ++j) if ((i + 1) * (j + 1) <= 16) { t.i[n] = i; t.j[n] = j; ++n; } for (; n < 64; ++n) { t.i[n] = -1; t.j[n] = -1; } return t; }
__device__ __forceinline__ void route_task(Frame& F, const Args& AR, int tt, int h) {
    const int lane = F.lane, l31 = lane & 31, h2 = lane >> 5;
    const size_t tok = (size_t)tt * 32 + l31;
    LAS unsigned* lk = (LAS unsigned*)F.lds;
    unsigned KA[16], KB[16];
#pragma unroll
    for (int i = 0; i < 16; ++i) { KA[i] = 0u; KB[i] = 0u; }
#pragma unroll 1
    for (int p = 0; p < 2; ++p) {
        const int hp = 2 * h + p;
        bf16x8 bq[4];
        { const bf16* qp = ((const bf16*)(F.ws + WS_SUBK)) + tok * 1024 + hp * 64 + h2 * 8;
#pragma unroll
          for (int st = 0; st < 4; ++st) bq[st] = *(const GAS bf16x8*)(qp + st * 16); }
        unsigned top[16];
#pragma unroll
        for (int i = 0; i < 16; ++i) top[i] = 0u;
#pragma unroll 1
        for (int blk = 0; blk < 4; ++blk) {
            const bf16* ap = ((const bf16*)(F.ws + WS_SKB)) + (size_t)(hp * 128 + 32 * blk + l31) * 64 + h2 * 8;
            f32x16 acc;
#pragma unroll
            for (int r = 0; r < 16; ++r) acc[r] = 0.f;
#pragma unroll
            for (int st = 0; st < 4; ++st) { const bf16x8 af = *(const GAS bf16x8*)(ap + st * 16); acc = __builtin_amdgcn_mfma_f32_32x32x16_bf16(af, bq[st], acc, 0, 0, 0); }
            unsigned a16[16];
#pragma unroll
            for (int r = 0; r < 16; ++r) a16[r] = (ordk(acc[r]) & ~127u) | (unsigned)(127 - (32 * blk + (r & 3) + 8 * (r >> 2)) - 4 * h2);
            sort16_desc(a16);
            merge16_desc(top, a16);
        }
        unsigned oth[16];
#pragma unroll
        for (int i = 0; i < 16; ++i) oth[i] = __shfl_xor(top[i], 32);
        merge16_desc(top, oth);
#pragma unroll
        for (int i = 0; i < 16; ++i) { if (p == 0) KA[i] = top[i]; else KB[i] = top[i]; }
    }
    float sa[16], sb[16];
#pragma unroll
    for (int i = 0; i < 16; ++i) { sa[i] = unordk(KA[i] & ~127u); sb[i] = unordk(KB[i] & ~127u); lk[i * 512 + F.tid] = KA[i]; lk[(16 + i) * 512 + F.tid] = KB[i]; }
    unsigned ck[16];
#pragma unroll
    for (int grp = 0; grp < 4; ++grp) {
        unsigned a[16];
#pragma unroll
        for (int q = 0; q < 16; ++q) { constexpr PairTab T = make_pairs(); const int pi = T.i[grp * 16 + q], pj = T.j[grp * 16 + q];
            a[q] = (pi < 0) ? 0u : ((ordk(sa[pi < 0 ? 0 : pi] + sb[pj < 0 ? 0 : pj]) & ~255u) | (unsigned)(255 - (pi * 16 + pj))); }
        sort16_desc(a);
        if (grp == 0) {
#pragma unroll
            for (int i = 0; i < 16; ++i) ck[i] = a[i];
        } else merge16_desc(ck, a);
    }
    LDS_WAIT(); asm volatile("" ::: "memory");
    unsigned ce[16];
#pragma unroll
    for (int t = 0; t < 16; ++t) { const unsigned flat = 255u - (ck[t] & 255u); const unsigned ka = lk[(flat >> 4) * 512 + F.tid], kb = lk[(16u + (flat & 15u)) * 512 + F.tid];
        ce[t] = (127u - (ka & 127u)) * 128u + (127u - (kb & 127u)); }
    LDS_WAIT(); asm volatile("" ::: "memory");
    float ts[16]; float sum = 0.f; const float mx = unordk(ck[0] & ~255u);
    const float rsl = row_rs((const float*)(F.ws + WS_SSP), tok) * 1.4426950408889634f;
#pragma unroll
    for (int t = 0; t < 16; ++t) { ts[t] = __builtin_amdgcn_exp2f((unordk(ck[t] & ~255u) - mx) * rsl); sum += ts[t]; }
    const float inv = 1.0f / sum;
    if (h2 == 0) {
        GAS v4u* eo = (GAS v4u*)(((unsigned short*)(F.ws + WS_REXP)) + tok * 128 + h * 16); GAS f32x4* go = (GAS f32x4*)(((float*)(F.ws + WS_RG)) + tok * 128 + h * 16);
        eo[0] = (v4u){ce[0] | (ce[1] << 16), ce[2] | (ce[3] << 16), ce[4] | (ce[5] << 16), ce[6] | (ce[7] << 16)};
        eo[1] = (v4u){ce[8] | (ce[9] << 16), ce[10] | (ce[11] << 16), ce[12] | (ce[13] << 16), ce[14] | (ce[15] << 16)};
#pragma unroll
        for (int t4 = 0; t4 < 4; ++t4) go[t4] = (f32x4){ts[4 * t4] * inv, ts[4 * t4 + 1] * inv, ts[4 * t4 + 2] * inv, ts[4 * t4 + 3] * inv};
    }
}

__device__ __forceinline__ float gelu_erf(float v) {
    const float av = fabsf(v), t = __builtin_amdgcn_rcpf(av * 0.2316418882f + 1.0f);
    float q = t * 0.5307027145f + (-0.7265760135f); q = q * t + 0.7107068705f; q = q * t + (-0.142248368f); q = q * t + 0.127414796f; q = q * t;
    const float e = __builtin_amdgcn_exp2f((v * v) * (-0.72134752044f));
    const float m = v * (q * e);
    return v < 0.f ? m : v - m;
}
__device__ __forceinline__ float dpp_add(float v, float w_unused) { return v; }
#define DPP_ADD(v, ctrl) ((v) + __builtin_bit_cast(float, __builtin_amdgcn_update_dpp(0, __builtin_bit_cast(int, (v)), (ctrl), 0xf, 0xf, true)))
#define DPP_MAX(v, ctrl) fmaxf((v), __builtin_bit_cast(float, __builtin_amdgcn_update_dpp(0, __builtin_bit_cast(int, (v)), (ctrl), 0xf, 0xf, true)))
#define DPP_ADDI(v, ctrl) ((v) + __builtin_amdgcn_update_dpp(0, (v), (ctrl), 0xf, 0xf, true))
constexpr int NSL = 8;
constexpr int CW_PEER = 8192;
typedef float f32x2v __attribute__((ext_vector_type(2)));
__device__ __forceinline__ unsigned id_of(const v4u a, const v4u b, int m) { const unsigned w = (m < 8) ? a[(m & 7) >> 1] : b[(m & 7) >> 1]; return (m & 1) ? (w >> 16) : (w & 0xffffu); }
__device__ __forceinline__ void load_hn2(const bf16* p, f32x2v (&hn2)[8]) { const v4u a = *(const GAS v4u*)p, b = *(const GAS v4u*)(p + 8);
    hn2[0] = (f32x2v){bflo(a.x), bfhi(a.x)}; hn2[1] = (f32x2v){bflo(a.y), bfhi(a.y)}; hn2[2] = (f32x2v){bflo(a.z), bfhi(a.z)}; hn2[3] = (f32x2v){bflo(a.w), bfhi(a.w)};
    hn2[4] = (f32x2v){bflo(b.x), bfhi(b.x)}; hn2[5] = (f32x2v){bflo(b.y), bfhi(b.y)}; hn2[6] = (f32x2v){bflo(b.z), bfhi(b.z)}; hn2[7] = (f32x2v){bflo(b.w), bfhi(b.w)}; }
template <int SIDE> __device__ __forceinline__ void peer_item8(Frame& F, const Args& AR, int s, size_t t0, unsigned idmask = 0xffffu) {
    const int lane = F.lane, ts = lane >> 3, c = lane & 7;
    const size_t tok = t0 + ts;
    const unsigned char* tbase = ((const unsigned char*)(F.ws + (SIDE == 0 ? WS_U16 : WS_V16))) + 128 * s;
    const unsigned lo = 16u * (unsigned)c;
    const GAS v4u* idq = (const GAS v4u*)(((const unsigned short*)(F.ws + WS_REXP)) + tok * 128);
    v4u ia = idq[0], ib = idq[1];
    if (SIDE == 0) {
        int hq[4]; float dq;
        { const bf16* hp = ((const bf16*)(F.ws + WS_HG)) + tok * 1024 + 128 * s + 16 * c; const v4u a = *(const GAS v4u*)hp, b2 = *(const GAS v4u*)(hp + 8);
          float x[16]; x[0] = bflo(a.x); x[1] = bfhi(a.x); x[2] = bflo(a.y); x[3] = bfhi(a.y); x[4] = bflo(a.z); x[5] = bfhi(a.z); x[6] = bflo(a.w); x[7] = bfhi(a.w);
          x[8] = bflo(b2.x); x[9] = bfhi(b2.x); x[10] = bflo(b2.y); x[11] = bfhi(b2.y); x[12] = bflo(b2.z); x[13] = bfhi(b2.z); x[14] = bflo(b2.w); x[15] = bfhi(b2.w);
          float am = 1e-30f;
#pragma unroll
          for (int i = 0; i < 16; ++i) am = fmaxf(am, fabsf(x[i]));
          am = DPP_MAX(am, 0xB1); am = DPP_MAX(am, 0x4E); am = DPP_MAX(am, 0x141);
          const float qs = 127.0f * __builtin_amdgcn_rcpf(am) * 0.99999f; dq = am * (1.0f / (127.0f * 0.99999f));
#pragma unroll
          for (int q = 0; q < 4; ++q) { unsigned bt[4];
#pragma unroll
              for (int i = 0; i < 4; ++i) bt[i] = __float_as_uint(x[4 * q + i] * qs + 12582912.0f);
              hq[q] = (int)(__builtin_amdgcn_perm(bt[1], bt[0], 0x0c0c0400u) | __builtin_amdgcn_perm(bt[3], bt[2], 0x04000c0cu)); } }
        bf16* po = ((bf16*)(F.ws + WS_SUBK)) + (tok * NSL + s) * 128;
#pragma unroll 1
        for (int b = 0; b < 8; ++b) {
            v4u r[16];
#pragma unroll
            for (int m = 0; m < 16; ++m) r[m] = *(const GAS v4u*)(tbase + (size_t)(((id_of(ia, ib, m) & idmask) << 10) + lo));
            const int bn = (b + 1) & 7; ia = idq[2 * bn]; ib = idq[2 * bn + 1];
            float d[16];
#pragma unroll
            for (int m = 0; m < 16; ++m) { int acc = 0;
#pragma unroll
                for (int q = 0; q < 4; ++q) acc = __builtin_amdgcn_sdot4((int)r[m][q], hq[q], acc, false);
                acc = DPP_ADDI(acc, 0xB1); acc = DPP_ADDI(acc, 0x4E); acc = DPP_ADDI(acc, 0x141); d[m] = (float)acc * dq; }
            if (c == 0) { GAS v4u* pq = (GAS v4u*)(po + 16 * b);
                pq[0] = (v4u){pk2(d[0], d[1]), pk2(d[2], d[3]), pk2(d[4], d[5]), pk2(d[6], d[7])}; pq[1] = (v4u){pk2(d[8], d[9]), pk2(d[10], d[11]), pk2(d[12], d[13]), pk2(d[14], d[15])}; }
        }
    } else {
        const GAS f32x4* cfq = (const GAS f32x4*)(((const float*)(F.ws + WS_RG)) + tok * 128);
        f32x4 cf[4];
#pragma unroll
        for (int q = 0; q < 4; ++q) cf[q] = cfq[q];
        f32x2v acc[8];
#pragma unroll
        for (int j = 0; j < 8; ++j) acc[j] = (f32x2v){0.f, 0.f};
#pragma unroll 1
        for (int b = 0; b < 8; ++b) {
            v4u r[16];
#pragma unroll
            for (int m = 0; m < 16; ++m) r[m] = *(const GAS v4u*)(tbase + (size_t)(((id_of(ia, ib, m) & idmask) << 10) + lo));
            const int bn = (b + 1) & 7; ia = idq[2 * bn]; ib = idq[2 * bn + 1];
            f32x4 cn[4];
#pragma unroll
            for (int q = 0; q < 4; ++q) cn[q] = cfq[4 * bn + q];
#pragma unroll
            for (int m = 0; m < 16; ++m) { const float cm = cf[m >> 2][m & 3]; const f32x2v c2 = {cm, cm};
#pragma unroll
                for (int q = 0; q < 4; ++q) { const int w = (int)r[m][q]; acc[2 * q] = __builtin_amdgcn_cvt_pk_f32_fp8(w, false) * c2 + acc[2 * q]; acc[2 * q + 1] = __builtin_amdgcn_cvt_pk_f32_fp8(w, true) * c2 + acc[2 * q + 1]; } }
#pragma unroll
            for (int q = 0; q < 4; ++q) cf[q] = cn[q];
        }
        GAS f32x4* op = (GAS f32x4*)((AR.out) + tok * 1024 + 128 * s + 16 * c);
#pragma unroll
        for (int q = 0; q < 4; ++q) { f32x4 h = op[q]; h.x += acc[2 * q].x; h.y += acc[2 * q].y; h.z += acc[2 * q + 1].x; h.w += acc[2 * q + 1].y; op[q] = h; }
    }
}
template <int SIDE> __device__ __forceinline__ void peer_side(Frame& F, const Args& AR, int rep = 0) {
    gu32* cnt = F.ctl + CW_PEER + (SIDE + 2 * rep) * 16 * 64;
    LAS int* sh = (LAS int*)F.lds;
    const unsigned xcc = xb_xcc_id() & 7u;
#pragma unroll 1
    for (int k = 0; k < NSL; ++k) {
        const int s = (int)((xcc + (unsigned)k) & (unsigned)(NSL - 1));
#pragma unroll 1
        for (;;) {
            __syncthreads();
            if (F.tid == 0) sh[0] = (int)__hip_atomic_fetch_add(cnt + 64 * s, 1u, RLX_AGENT);
            __syncthreads();
            const int blk = sh[0];
            if (blk >= MTOK / 128) break;
            const size_t t0 = (size_t)blk * 128 + F.wave * 16;
            peer_item8<SIDE>(F, AR, s, t0); peer_item8<SIDE>(F, AR, s, t0 + 8);
        }
    }
}
__device__ __forceinline__ void peer_coef_token(Frame& F, size_t tok, float inv_su, float inv_sv) {
    const int lane = F.lane;
    const unsigned short* pp = ((const unsigned short*)(F.ws + WS_SUBK)) + tok * NSL * 128;
    float a0 = 0.f, a1 = 0.f;
#pragma unroll
    for (int s = 0; s < NSL; ++s) { a0 += __uint_as_float((unsigned)pp[s * 128 + lane] << 16); a1 += __uint_as_float((unsigned)pp[s * 128 + 64 + lane] << 16); }
    float* gp = ((float*)(F.ws + WS_RG)) + tok * 128;
    const float sc = inv_su * row_rs((const float*)(F.ws + WS_SSP), tok);
    gp[lane] = gp[lane] * gelu_erf(a0 * sc) * inv_sv; gp[64 + lane] = gp[64 + lane] * gelu_erf(a1 * sc) * inv_sv;
}

__global__ void __launch_bounds__(NWAVES * 64, 2) mk_fwd(Args args) {
    extern __shared__ __attribute__((aligned(16))) unsigned char lds[];
    Frame F;
    F.lds = (LAS unsigned char*)lds;
    F.MISC = (volatile LAS unsigned*)(F.lds + MISC_OFF);
    F.tid = threadIdx.x; F.lane = F.tid & 63; F.wave = __builtin_amdgcn_readfirstlane(F.tid >> 6);
    F.G = gridDim.x; { const int bx = blockIdx.x; F.vcu = (F.G % 8 == 0) ? (bx % 8) * (F.G / 8) + bx / 8 : bx; }
    F.ws = args.ws;
    F.ctl = (gu32*)(F.ws + WS_CTL);
    const Args& AR = args;
    for (int u = F.tid; u < (LDS_BYTES - LDSCTL_OFF) / 4; u += NWAVES * 64) ((LAS unsigned*)(F.lds + LDSCTL_OFF))[u] = 0u;
    __syncthreads();
    XcdBarrier bar; bar.bar = (unsigned*)(F.ctl + CW_BAR); bar.x = 0; bar.st = nullptr;
#if !MK_PER_PHASE
    bar = xcd_barrier_post((unsigned*)(F.ctl + CW_BAR), F.MISC + 8);
#endif
    unsigned long long tacc_ = 0ull; unsigned tcnt_ = 0u;
    const unsigned long long tk0c_ = (PROBE_SEC == 10) ? __builtin_amdgcn_s_memtime() : 0ull, tk0r_ = (PROBE_SEC == 10) ? __builtin_amdgcn_s_memrealtime() : 0ull;
    const int lo = args.ph_lo, hi = args.ph_hi;
#if defined(ONLY_PHASE)
#define IN(k) ((k) == ONLY_PHASE && lo <= (k) && (k) < hi)
#elif defined(PHASE_MASK)
#define IN(k) (((PHASE_MASK >> (k)) & 1) && lo <= (k) && (k) < hi)
#else
#define IN(k) (lo <= (k) && (k) < hi)
#endif
#if MK_PER_PHASE
#define SEAM(k) do { } while (0)
#else
#define SEAM(k) do { if (IN(k) && IN((k) + 1)) xcd_barrier(bar); } while (0)
#endif
#define FRESH() Frame P = F; { int t_ = threadIdx.x; asm volatile("" : "+v"(t_)); P.tid = t_; P.lane = t_ & 63; P.wave = __builtin_amdgcn_readfirstlane(t_ >> 6); } const int gw = P.vcu * NWAVES + P.wave, NGW = P.G * NWAVES; (void)gw; (void)NGW

    for (int rep_ = 0; rep_ < (((REPEAT_MASK >> 0) & 1) ? 2 : 1); ++rep_) if (IN(0)) { FRESH(); p0_prologue(P, args); } SEAM(0);
    const unsigned long long tq0c_ = (PROBE_SEC == 12) ? __builtin_amdgcn_s_memtime() : 0ull, tq0r_ = (PROBE_SEC == 12) ? __builtin_amdgcn_s_memrealtime() : 0ull;
    for (int rep_ = 0; rep_ < (((REPEAT_MASK >> 1) & 1) ? 2 : 1); ++rep_) if (IN(1)) { pg8::Gemm g{((bf16*)(F.ws + WS_ACT)), ((bf16*)(F.ws + WS_WIN)), MTOK, LDP, 1024, 1024, 1024}; pg8::StaticOrder S; S.init(MTOK, LDP, F.G, (int)blockIdx.x);
        pg8::EpiStoreBf16 E{((bf16*)(F.ws + WS_PROJ)), LDP};
        pg8::gemm_phase<pg8::EpiStoreBf16, pg8::StaticOrder, true, true>(F.lds, g, S, E); } SEAM(1);
    if (PROBE_SEC == 12) { const unsigned long long dc = __builtin_amdgcn_s_memtime() - tq0c_, dr = __builtin_amdgcn_s_memrealtime() - tq0r_; tacc_ = dc * 100ull / (dr ? dr : 1ull); tcnt_ = 1u; }
    if (IN(2)) { FRESH(); for (int m = gw; m < MTOK; m += NGW) fixup_token(P, args, m);
        for (int r0 = gw * 32; r0 < MTOK; r0 += NGW * 32) pool_run(P, r0, 32);
        const float su = i8_scale(__hip_atomic_load(P.ctl + CW_AMAX, RLX_AGENT)), sv = fp8_scale(__hip_atomic_load(P.ctl + CW_AMAX + 1, RLX_AGENT));
#pragma unroll 4
        for (int r = gw; r < 2 * 16384; r += NGW) { const int rr = r & 16383;
            if (r < 16384) row_to_i8(args.in[13] + (size_t)rr * 1024, (unsigned char*)(P.ws + WS_U16) + (size_t)rr * 1024, su, P.lane);
            else row_to_fp8(args.in[14] + (size_t)rr * 1024, (unsigned char*)(P.ws + WS_V16) + (size_t)rr * 1024, sv, P.lane); } } SEAM(2);
    for (int rep_ = 0; rep_ < (((REPEAT_MASK >> 3) & 1) ? 2 : 1); ++rep_) if (IN(3)) { FRESH(); for (int i = P.vcu; i < 256; i += P.G) { const int b = i >> 4, s = i & 15;
#pragma unroll 1
            for (int k = 0; k < 4; ++k) idx_unit(P, args, b, (k == 0) ? s : (k == 1) ? 31 - s : (k == 2) ? 32 + s : 63 - s, tacc_, tcnt_, PROBE_NOSEL ? (rep_ == 1) : true); } } SEAM(3);
    const unsigned long long tp4_ = (PROBE_SEC == 5 || PROBE_SEC == 6 || PROBE_SEC == 7) ? ((PROBE_SEC != 6) ? __builtin_amdgcn_s_memtime() : __builtin_amdgcn_s_memrealtime()) : 0ull;
    for (int rep_ = 0; rep_ < (((REPEAT_MASK >> 4) & 1) ? 2 : 1); ++rep_) if (IN(4)) { FRESH(); for (int i = P.vcu; i < 256; i += P.G) { const int bh = i >> 1, s = i & 1, b = bh >> 3, h = bh & 7;
#pragma unroll 1
            for (int k = 0; k < 8; ++k) attn_unit(P, args, b, h, (k & 1) ? 15 - (k >> 1) * 2 - s : (k >> 1) * 2 + s, tacc_, tcnt_); }
        if (PROBE_SEC == 7) { tacc_ = (__builtin_amdgcn_s_memtime() - tp4_) / 1000ull; tcnt_ = 1u; } } SEAM(4);
    if (PROBE_SEC == 5) { tacc_ = (__builtin_amdgcn_s_memtime() - tp4_) / 1000ull; tcnt_ = 1u; }
    if (PROBE_SEC == 6) { tacc_ = (__builtin_amdgcn_s_memrealtime() - tp4_) / 10ull; tcnt_ = 1u; }
    for (int rep_ = 0; rep_ < (((REPEAT_MASK >> 5) & 1) ? 2 : 1); ++rep_) if (IN(5)) { pg8::Gemm g{((bf16*)(F.ws + WS_AO)), ((bf16*)(F.ws + WS_WA)), MTOK, 1024, 512, 512, 512}; pg8::StaticOrder S; S.init(MTOK, 1024, F.G, (int)blockIdx.x);
        pg8::EpiGate<false> E{((bf16*)(F.ws + WS_ACT)), 1024, ((bf16*)(F.ws + WS_PROJ)) + GA_OFF, LDP};
        pg8::gemm_phase<pg8::EpiGate<false>, pg8::StaticOrder, true, true>(F.lds, g, S, E); }
    if (IN(6)) { pg8::Gemm g{((bf16*)(F.ws + WS_POOLED)), ((bf16*)(F.ws + WS_WPP)), MTOK, 1024, 512, 512, 512}; pg8::StaticOrder S; S.init(MTOK, 1024, F.G, (int)blockIdx.x);
                pg8::EpiGate<true> E{((bf16*)(F.ws + WS_ACT)), 1024, ((bf16*)(F.ws + WS_PROJ)) + GP_OFF, LDP};
        pg8::gemm_phase<pg8::EpiGate<true>, pg8::StaticOrder, true, true>(F.lds, g, S, E); } SEAM(6);
    for (int rep_ = 0; rep_ < (((REPEAT_MASK >> 7) & 1) ? 2 : 1); ++rep_) if (IN(7)) { pg8::Gemm g{((bf16*)(F.ws + WS_ACT)), ((bf16*)(F.ws + WS_WO)), MTOK, 1024, 1024, 1024, 1024}; pg8::StaticOrder S; S.init(MTOK, 1024, F.G, (int)blockIdx.x);
        pg8::EpiResHG E{(AR.in[0]), (AR.out), ((bf16*)(F.ws + WS_HG)), (AR.in[10]), ((float*)(F.ws + WS_SSP)), 1024};
        pg8::gemm_phase<pg8::EpiResHG, pg8::StaticOrder, true, true>(F.lds, g, S, E); } SEAM(7);

    for (int rep_ = 0; rep_ < (((REPEAT_MASK >> 9) & 1) ? 2 : 1); ++rep_) if (IN(9)) { pg8::Gemm g{((bf16*)(F.ws + WS_HG)), ((bf16*)(F.ws + WS_W2)), MTOK, 1024, 1024, 1024, 1024}; pg8::StaticOrder S; S.init(MTOK, 1024, F.G, (int)blockIdx.x);
        pg8::EpiStoreBf16 E{((bf16*)(F.ws + WS_SUBK)), 1024};
        pg8::gemm_phase<pg8::EpiStoreBf16, pg8::StaticOrder, true, true>(F.lds, g, S, E); } SEAM(9);
    for (int rep_ = 0; rep_ < (((REPEAT_MASK >> 10) & 1) ? 2 : 1); ++rep_) if (IN(10)) { FRESH(); for (int tt = P.vcu; tt < MTOK / 32; tt += P.G) route_task(P, args, tt, P.wave); } SEAM(10);
        const unsigned long long tg0c_ = (PROBE_SEC == 11) ? __builtin_amdgcn_s_memtime() : 0ull, tg0r_ = (PROBE_SEC == 11) ? __builtin_amdgcn_s_memrealtime() : 0ull;
    for (int rep_ = 0; rep_ < (((REPEAT_MASK >> 11) & 1) ? 2 : 1); ++rep_) if (IN(11)) { FRESH(); peer_side<0>(P, args, rep_); } SEAM(11);
    if (IN(12)) { FRESH(); const float iu = i8_inv_scale(__hip_atomic_load(P.ctl + CW_AMAX, RLX_AGENT)), iv = fp8_inv_scale(__hip_atomic_load(P.ctl + CW_AMAX + 1, RLX_AGENT));
        for (int m = gw; m < MTOK; m += NGW) peer_coef_token(P, (size_t)m, iu, iv); } SEAM(12);
    if (IN(13)) { FRESH(); peer_side<1>(P, args); }
#if PROBE_SEC == 11
    { const unsigned long long dc = __builtin_amdgcn_s_memtime() - tg0c_, dr = __builtin_amdgcn_s_memrealtime() - tg0r_; tacc_ = dc * 100ull / (dr ? dr : 1ull); tcnt_ = 1u; }
#endif
#if PROBE_SEC == 10
    { const unsigned long long dc = __builtin_amdgcn_s_memtime() - tk0c_, dr = __builtin_amdgcn_s_memrealtime() - tk0r_; tacc_ = dc * 100ull / (dr ? dr : 1ull); tcnt_ = 1u; }
#endif
#if PROBE_SEC
    if (blockIdx.x == 0 && F.wave == 7) { const unsigned long long avg = tacc_ / (unsigned long long)(tcnt_ ? tcnt_ : 1u); const unsigned long long t_end = __builtin_amdgcn_s_memrealtime() + avg * 10ull;
        while (__builtin_amdgcn_s_memrealtime() < t_end) __builtin_amdgcn_s_sleep(8); }
#endif

#undef IN
#undef SEAM
}

extern "C" void kernel_launch(void* const* d_in, const int* in_sizes, int n_in, void* d_out, int out_size, void* d_ws, size_t ws_size, hipStream_t stream) {
    static int grid = 0;
    if (grid == 0) {
        if (n_in != 15 || in_sizes[0] != MTOK * DM || out_size != MTOK * DM || ws_size < WS_END) { fprintf(stderr, "kernel_launch: unexpected shapes (n_in %d, in0 %d, out %d, ws %zu < %zu)\n", n_in, n_in > 0 ? in_sizes[0] : -1, out_size, ws_size, (size_t)WS_END); grid = -1; return; }
        int dev = 0, cus = 0, per_cu = 0;
        if (hipGetDevice(&dev) != hipSuccess || hipDeviceGetAttribute(&cus, hipDeviceAttributeMultiprocessorCount, dev) != hipSuccess) { grid = -1; return; }
        if (hipFuncSetAttribute((const void*)mk_fwd, hipFuncAttributeMaxDynamicSharedMemorySize, LDS_BYTES) != hipSuccess) { fprintf(stderr, "kernel_launch: hipFuncSetAttribute failed\n"); grid = -1; return; }
        if (hipOccupancyMaxActiveBlocksPerMultiprocessor(&per_cu, (const void*)mk_fwd, NWAVES * 64, LDS_BYTES) != hipSuccess || per_cu < 1) { fprintf(stderr, "kernel_launch: occupancy query says %d blocks per CU\n", per_cu); (void)hipGetLastError(); grid = -1; return; }
        grid = cus;
    }
    if (grid < 0) return;
    if (hipMemsetAsync((char*)d_ws + WS_CTL, 0, CTL_ZERO_BYTES, stream) != hipSuccess) return;
    Args a{};
    for (int i = 0; i < 15; ++i) a.in[i] = (const float*)d_in[i];
    a.out = (float*)d_out; a.ws = (unsigned char*)d_ws;
#if MK_PER_PHASE
    for (int p = 0; p < NPHASE; ++p) { a.ph_lo = p; a.ph_hi = p + 1; hipLaunchKernelGGL(mk_fwd, dim3(grid), dim3(NWAVES * 64), LDS_BYTES, stream, a); }
#else
    a.ph_lo = 0; a.ph_hi = NPHASE;
    hipLaunchKernelGGL(mk_fwd, dim3(grid), dim3(NWAVES * 64), LDS_BYTES, stream, a);
#endif
}
```

```cpp
#include <hip/hip_runtime.h>
#include <cstdio>
#include <cstdint>
namespace pg8 {
#define PG8_LAS __attribute__((address_space(3)))
typedef unsigned short bf16_t;
typedef short bf16x8 __attribute__((ext_vector_type(8)));
typedef float f32x4 __attribute__((ext_vector_type(4)));
typedef unsigned u32x4 __attribute__((ext_vector_type(4)));
constexpr int BM = 256, BK = 64, HALF = 128, HTB = HALF * BK * 2  , STAGE_BYTES = 8 * HTB, NXCD = 8, WGM = 8;

__host__ __device__ __forceinline__ int lds_byte(int r, int c) { const int st = (r >> 4) * 2 + (c >> 5), rr = r & 15, cc = c & 31, ob = rr * 64 + cc * 2; return st * 1024 + (ob ^ (((ob >> 9) & 1) << 5)); }
__host__ __device__ __forceinline__ void stage_rc(int b, int& R, int& C) { const int st = b / 1024, sb = b % 1024, swz = sb ^ (((sb >> 9) & 1) << 5); R = (st >> 1) * 16 + swz / 64; C = (st & 1) * 32 + (swz % 64) / 2; }
__host__ __device__ __forceinline__ int perm32(int rho) { const int n = rho >> 4, i = rho & 15; return 8 * (i >> 2) + 4 * n + (i & 3); }

struct Unit { int pm, pn; };
struct Gemm { const bf16_t* A; const bf16_t* Bt; int M, N, K, lda, ldb; };

struct StaticOrder {
    int nM, nN, nwg, G, c;
    __host__ __device__ void init(int M, int N, int G_, int c_) { nM = M / BM; nN = N / BM; nwg = nM * nN; G = G_; c = c_; }
    __host__ __device__ bool next(int i, Unit& u) const {
        const long L = (long)i * G + c; if (L >= nwg) return false;
        int wgid = (int)L; { const int q = nwg / NXCD, r = nwg % NXCD, xcd = wgid % NXCD, off = wgid / NXCD; wgid = (xcd < r ? xcd * (q + 1) : r * (q + 1) + (xcd - r) * q) + off; }
        const int nig = WGM * nN, gid = wgid / nig, fm = gid * WGM, gsz = (nM - fm) < WGM ? (nM - fm) : WGM;
        u.pm = fm + ((wgid % nig) % gsz); u.pn = (wgid % nig) / gsz; return true;
    }
    __device__ __forceinline__ void a_ready(const Unit&) const {}
    __device__ __forceinline__ void done(const Unit&) const {}
};
struct PanelOrder {
    int nN, pm;
    __host__ __device__ bool next(int i, Unit& u) const { if (i >= nN) return false; u.pm = pm; u.pn = i; return true; }
    __device__ __forceinline__ void a_ready(const Unit&) const {}
    __device__ __forceinline__ void done(const Unit&) const {}
};
typedef float f32x2c_t __attribute__((ext_vector_type(2))); typedef __bf16 bf16x2c_t __attribute__((ext_vector_type(2)));
__device__ __forceinline__ unsigned cvt_pk_bf16(float lo, float hi) { f32x2c_t v = {lo, hi}; bf16x2c_t b = __builtin_convertvector(v, bf16x2c_t); return __builtin_bit_cast(unsigned, b); }
typedef float f32x2 __attribute__((ext_vector_type(2)));
__device__ __forceinline__ f32x2 gelu_pk(f32x2 v) {
    const f32x2 av = __builtin_elementwise_abs(v), d = av * 0.2316418882f + 1.0f;
    f32x2 t; t.x = __builtin_amdgcn_rcpf(d.x); t.y = __builtin_amdgcn_rcpf(d.y);
    f32x2 q = t * 0.5307027145f + (-0.7265760135f); q = q * t + 0.7107068705f; q = q * t + (-0.142248368f); q = q * t + 0.127414796f; q = q * t;
    const f32x2 s = (v * v) * (-0.72134752044f);
    f32x2 e; e.x = __builtin_amdgcn_exp2f(s.x); e.y = __builtin_amdgcn_exp2f(s.y);
    const f32x2 m = v * (q * e), r = v - m;
    f32x2 o; o.x = v.x < 0.f ? m.x : r.x; o.y = v.y < 0.f ? m.y : r.y; return o;
}
typedef unsigned u32x2e __attribute__((ext_vector_type(2)));
__device__ __forceinline__ float bf_lo(unsigned w) { return __uint_as_float(w << 16); }
__device__ __forceinline__ float bf_hi(unsigned w) { return __uint_as_float(w & 0xffff0000u); }
__device__ __forceinline__ float sigmoidf_fast(float g) { return __builtin_amdgcn_rcpf(1.0f + __builtin_amdgcn_exp2f(-1.4426950408889634f * g)); }
__device__ __forceinline__ unsigned ord_key(float f) { const unsigned b = __float_as_uint(f); return b ^ ((unsigned)((int)b >> 31) | 0x80000000u); }
__device__ __forceinline__ float unord_key(unsigned k) { return __uint_as_float((k & 0x80000000u) ? (k ^ 0x80000000u) : ~k); }

struct EpiStoreBf16 {
    static constexpr bool PERM = true, AFTER_DRAIN = false;
    bf16_t* O; int ldc;
    __device__ __forceinline__ void operator()(const f32x4 (&acc)[2][2][4][2], const Unit& u, int wr, int wc, int fr, int fq) const {
        const int row0 = u.pm * BM + wr * 64 + fr, col0 = u.pn * BM + wc * 32 + 8 * fq;
#pragma unroll
        for (int ai = 0; ai < 2; ++ai)
#pragma unroll
            for (int m = 0; m < 4; ++m) { bf16_t* rowp = O + (size_t)(row0 + ai * HALF + m * 16) * ldc + col0;
#pragma unroll
                for (int bj = 0; bj < 2; ++bj) { const f32x4 v0 = acc[ai][bj][m][0], v1 = acc[ai][bj][m][1];
                    u32x4 w; w.x = cvt_pk_bf16(v0[0], v0[1]); w.y = cvt_pk_bf16(v0[2], v0[3]); w.z = cvt_pk_bf16(v1[0], v1[1]); w.w = cvt_pk_bf16(v1[2], v1[3]);
                    *(u32x4*)(rowp + bj * HALF) = w; } }
    }
};
template <bool ADD> struct EpiGate {
    static constexpr bool PERM = true, AFTER_DRAIN = false;
    bf16_t* O; int ldc; const bf16_t* G; int ldg;
    __device__ __forceinline__ void operator()(const f32x4 (&acc)[2][2][4][2], const Unit& u, int wr, int wc, int fr, int fq) const {
        const int row0 = u.pm * BM + wr * 64 + fr, col0 = u.pn * BM + wc * 32 + 8 * fq;
#pragma unroll
        for (int ai = 0; ai < 2; ++ai)
#pragma unroll
            for (int m = 0; m < 4; ++m) { const size_t row = (size_t)(row0 + ai * HALF + m * 16);
#pragma unroll
                for (int bj = 0; bj < 2; ++bj) { const int col = col0 + bj * HALF;
                    const u32x4 gr = *(const u32x4*)(G + row * ldg + col);
                    f32x4 v0 = acc[ai][bj][m][0], v1 = acc[ai][bj][m][1];
                    v0[0] *= sigmoidf_fast(bf_lo(gr.x)); v0[1] *= sigmoidf_fast(bf_hi(gr.x)); v0[2] *= sigmoidf_fast(bf_lo(gr.y)); v0[3] *= sigmoidf_fast(bf_hi(gr.y));
                    v1[0] *= sigmoidf_fast(bf_lo(gr.z)); v1[1] *= sigmoidf_fast(bf_hi(gr.z)); v1[2] *= sigmoidf_fast(bf_lo(gr.w)); v1[3] *= sigmoidf_fast(bf_hi(gr.w));
                    bf16_t* op = O + row * ldc + col;
                    if (ADD) { const u32x4 pr = *(const u32x4*)op;
                        v0[0] += bf_lo(pr.x); v0[1] += bf_hi(pr.x); v0[2] += bf_lo(pr.y); v0[3] += bf_hi(pr.y);
                        v1[0] += bf_lo(pr.z); v1[1] += bf_hi(pr.z); v1[2] += bf_lo(pr.w); v1[3] += bf_hi(pr.w); }
                    u32x4 w; w.x = cvt_pk_bf16(v0[0], v0[1]); w.y = cvt_pk_bf16(v0[2], v0[3]); w.z = cvt_pk_bf16(v1[0], v1[1]); w.w = cvt_pk_bf16(v1[2], v1[3]);
                    *(u32x4*)op = w; } }
    }
};
struct EpiResF32 {
    static constexpr bool PERM = false, AFTER_DRAIN = false;
    const float* base; float* out; int ldc;
    __device__ __forceinline__ void operator()(const f32x4 (&acc)[2][2][4][2], const Unit& u, int wr, int wc, int fr, int fq) const {
        const int col0 = u.pn * BM + wc * 32 + 4 * fq;
#pragma unroll
        for (int ai = 0; ai < 2; ++ai)
#pragma unroll
            for (int m = 0; m < 4; ++m) { const size_t off = (size_t)(u.pm * BM + ai * HALF + wr * 64 + m * 16 + fr) * ldc + col0;
#pragma unroll
                for (int bj = 0; bj < 2; ++bj)
#pragma unroll
                    for (int n = 0; n < 2; ++n) { const f32x4 bs = *(const f32x4*)(base + off + bj * HALF + n * 16); *(f32x4*)(out + off + bj * HALF + n * 16) = bs + acc[ai][bj][m][n]; } }
    }
};
struct EpiResHG {
    static constexpr bool PERM = false, AFTER_DRAIN = false;
    const float* base; float* out; bf16_t* hg; const float* gain; float* ssp; int ldc;
    __device__ __forceinline__ void operator()(const f32x4 (&acc)[2][2][4][2], const Unit& u, int wr, int wc, int fr, int fq) const {
        const int col0 = u.pn * BM + wc * 32 + 4 * fq;
        f32x4 gv[2][2];
#pragma unroll
        for (int bj = 0; bj < 2; ++bj)
#pragma unroll
            for (int n = 0; n < 2; ++n) gv[bj][n] = *(const f32x4*)(gain + col0 + bj * HALF + n * 16);
#pragma unroll
        for (int ai = 0; ai < 2; ++ai)
#pragma unroll
            for (int m = 0; m < 4; ++m) { const int row = u.pm * BM + ai * HALF + wr * 64 + m * 16 + fr; const size_t off = (size_t)row * ldc + col0; float ss = 0.f;
#pragma unroll
                for (int bj = 0; bj < 2; ++bj)
#pragma unroll
                    for (int n = 0; n < 2; ++n) { const f32x4 h = *(const f32x4*)(base + off + bj * HALF + n * 16) + acc[ai][bj][m][n]; *(f32x4*)(out + off + bj * HALF + n * 16) = h;
                        ss += (h[0] * h[0] + h[1] * h[1]) + (h[2] * h[2] + h[3] * h[3]);
                        const f32x4 hgv = h * gv[bj][n]; u32x2e w; w.x = cvt_pk_bf16(hgv[0], hgv[1]); w.y = cvt_pk_bf16(hgv[2], hgv[3]); *(u32x2e*)(hg + off + bj * HALF + n * 16) = w; }
                ss += __shfl_xor(ss, 16); ss += __shfl_xor(ss, 32);
                if (fq == 0) ssp[(size_t)row * 16 + u.pn * 4 + wc] = ss; }
    }
};
struct EpiKeys {
    static constexpr bool PERM = false, AFTER_DRAIN = false;
    unsigned* O; int ldc;
    __device__ __forceinline__ void operator()(const f32x4 (&acc)[2][2][4][2], const Unit& u, int wr, int wc, int fr, int fq) const {
        const int col0 = u.pn * BM + wc * 32 + 4 * fq;
#pragma unroll
        for (int ai = 0; ai < 2; ++ai)
#pragma unroll
            for (int m = 0; m < 4; ++m) { const size_t off = (size_t)(u.pm * BM + ai * HALF + wr * 64 + m * 16 + fr) * ldc + col0;
#pragma unroll
                for (int bj = 0; bj < 2; ++bj)
#pragma unroll
                    for (int n = 0; n < 2; ++n) { const int nn = (col0 + bj * HALF + n * 16) & 127; const f32x4 a = acc[ai][bj][m][n]; u32x4 w;
                        w.x = (ord_key(a[0]) & ~127u) | (unsigned)(127 - nn); w.y = (ord_key(a[1]) & ~127u) | (unsigned)(126 - nn);
                        w.z = (ord_key(a[2]) & ~127u) | (unsigned)(125 - nn); w.w = (ord_key(a[3]) & ~127u) | (unsigned)(124 - nn);
                        *(u32x4*)(O + off + bj * HALF + n * 16) = w; } }
    }
};

template <class Epi, class Sched, bool ALIGN_EPI = false, bool SP2 = false>
__device__ __forceinline__ void gemm_phase(PG8_LAS unsigned char* lds, const Gemm g, const Sched& S, const Epi& E) {
    int tid_ = threadIdx.x; asm volatile("" : "+v"(tid_));
    const int tid = tid_, wid = __builtin_amdgcn_readfirstlane(tid >> 6), lane = tid & 63, wr = wid >> 2, wc = wid & 3, fr = lane & 15, fq = lane >> 4;
    const int K = g.K, nt = K / BK;
    unsigned voffA[2], voffB[2];
#pragma unroll
    for (int i = 0; i < 2; ++i) { int R, C; stage_rc(tid * 16 + i * 8192, R, C); const int Rb = Epi::PERM ? ((R & ~31) + perm32(R & 31)) : R;
        voffA[i] = (unsigned)(R * g.lda + C) * 2u; voffB[i] = (unsigned)(Rb * g.ldb + C) * 2u; }
    const size_t kstep = (size_t)(BK * 2);
    const size_t hstepA = (size_t)HALF * g.lda * 2, hstepB = (size_t)HALF * g.ldb * 2;
    const size_t tstepA = 2 * hstepA, tstepB = 2 * hstepB;
    const unsigned ldsw = (unsigned)wid * 1024u;
    const int aoff = lds_byte(wr * 64 + fr, fq * 8), boff = lds_byte(wc * 32 + fr, fq * 8);
#define PG8_SA(b, h) (((b) * 2 + (h)) * HTB)
#define PG8_SB(b, h) ((4 + (b) * 2 + (h)) * HTB)
#define PG8_STAGE(bufoff, gbase, voff) do { _Pragma("unroll") for (int _i = 0; _i < 2; ++_i) \
        __builtin_amdgcn_global_load_lds((const unsigned*)((const char*)(gbase) + (voff)[_i]), (PG8_LAS unsigned*)(lds + (bufoff) + ldsw + _i * 8192), 16, 0, 0); } while (0)
#define PG8_LDA(dst, b, h) do { _Pragma("unroll") for (int m = 0; m < 4; ++m) _Pragma("unroll") for (int k = 0; k < 2; ++k) dst[m][k] = *(const PG8_LAS bf16x8*)(lds + PG8_SA(b, h) + aoff + m * 2048 + k * 1024); } while (0)
#define PG8_LDB(dst, b, h) do { _Pragma("unroll") for (int n = 0; n < 2; ++n) _Pragma("unroll") for (int k = 0; k < 2; ++k) dst[n][k] = *(const PG8_LAS bf16x8*)(lds + PG8_SB(b, h) + boff + n * 2048 + k * 1024); } while (0)
#define PG8_MMA(ai, bj, At, Bt) do { __builtin_amdgcn_s_setprio(1); _Pragma("unroll") for (int m = 0; m < 4; ++m) _Pragma("unroll") for (int n = 0; n < 2; ++n) _Pragma("unroll") for (int k = 0; k < 2; ++k) \
        acc[ai][bj][m][n] = __builtin_amdgcn_mfma_f32_16x16x32_bf16(Bt[n][k], At[m][k], acc[ai][bj][m][n], 0, 0, 0); __builtin_amdgcn_s_setprio(0); } while (0)
#define PG8_WAIT_V(n) asm volatile("s_waitcnt vmcnt(" #n ")" ::: "memory")
#define PG8_WAIT_L(n) asm volatile("s_waitcnt lgkmcnt(" #n ")" ::: "memory")
#define PG8_BAR __builtin_amdgcn_s_barrier()
#define PG8_SCHED __builtin_amdgcn_sched_barrier(0)
    Unit cur, nxt; int ui = 0;
    if (!S.next(0, cur)) return;
    f32x4 acc[2][2][4][2];
#pragma unroll
    for (int a = 0; a < 2; ++a)
#pragma unroll
        for (int b = 0; b < 2; ++b)
#pragma unroll
            for (int m = 0; m < 4; ++m)
#pragma unroll
                for (int n = 0; n < 2; ++n) acc[a][b][m][n] = (f32x4){0.f, 0.f, 0.f, 0.f};
    bf16x8 At[4][2], B0[2][2], B1[2][2];
    const char* cA = (const char*)g.A + (size_t)cur.pm * tstepA; const char* cB = (const char*)g.Bt + (size_t)cur.pn * tstepB;
    S.a_ready(cur);
    if constexpr (SP2) {
        PG8_STAGE(PG8_SB(0, 0), cB, voffB); PG8_STAGE(PG8_SB(0, 1), cB + hstepB, voffB); PG8_STAGE(PG8_SA(0, 0), cA, voffA); PG8_STAGE(PG8_SA(0, 1), cA + hstepA, voffA);
        if (wr == 1) PG8_BAR;
        PG8_WAIT_V(2); PG8_BAR;
        PG8_STAGE(PG8_SB(1, 0), cB + kstep, voffB); PG8_STAGE(PG8_SA(1, 0), cA + kstep, voffA); PG8_STAGE(PG8_SB(1, 1), cB + hstepB + kstep, voffB);
        PG8_WAIT_V(6); PG8_BAR;
    } else {
        PG8_STAGE(PG8_SB(0, 0), cB, voffB); PG8_STAGE(PG8_SA(0, 0), cA, voffA); PG8_STAGE(PG8_SB(0, 1), cB + hstepB, voffB); PG8_STAGE(PG8_SA(0, 1), cA + hstepA, voffA);
        if (wr == 1) PG8_BAR;
        PG8_WAIT_V(4); PG8_BAR;
        PG8_STAGE(PG8_SB(1, 0), cB + kstep, voffB); PG8_STAGE(PG8_SA(1, 0), cA + kstep, voffA); PG8_STAGE(PG8_SB(1, 1), cB + hstepB + kstep, voffB);
        PG8_WAIT_V(6); PG8_BAR;
    }
    for (;;) {
        const bool has_next = S.next(ui + 1, nxt);
        const char* nA = has_next ? (const char*)g.A + (size_t)nxt.pm * tstepA : cA; const char* nB = has_next ? (const char*)g.Bt + (size_t)nxt.pn * tstepB : cB;
        for (int t = 0; t < nt; t += 2) {
            const bool last = (t == nt - 2);
            const char* a1 = cA + (size_t)(t + 1) * kstep;
            const char* a2 = last ? nA : cA + (size_t)(t + 2) * kstep; const char* b2 = last ? nB : cB + (size_t)(t + 2) * kstep;
            const char* a3 = a2 + kstep; const char* b3 = b2 + kstep;
            if (last && has_next) S.a_ready(nxt);
            if constexpr (SP2) {
            PG8_LDB(B0, 0, 0); PG8_LDB(B1, 0, 1); PG8_SCHED; PG8_LDA(At, 0, 0); PG8_STAGE(PG8_SA(1, 1), a1 + hstepA, voffA);
            PG8_WAIT_V(8); PG8_WAIT_L(0); PG8_BAR; PG8_MMA(0, 0, At, B0); PG8_MMA(0, 1, At, B1); PG8_BAR; PG8_SCHED;
            PG8_LDA(At, 0, 1); PG8_STAGE(PG8_SB(0, 0), b2, voffB); PG8_STAGE(PG8_SB(0, 1), b2 + hstepB, voffB); PG8_STAGE(PG8_SA(0, 0), a2, voffA);
            PG8_WAIT_V(8); PG8_WAIT_L(0); PG8_BAR; PG8_MMA(1, 0, At, B0); PG8_MMA(1, 1, At, B1); PG8_BAR; PG8_SCHED;
            PG8_LDB(B0, 1, 0); PG8_LDB(B1, 1, 1); PG8_SCHED; PG8_LDA(At, 1, 0); PG8_STAGE(PG8_SA(0, 1), a2 + hstepA, voffA);
            PG8_WAIT_V(8); PG8_WAIT_L(0); PG8_BAR; PG8_MMA(0, 0, At, B0); PG8_MMA(0, 1, At, B1); PG8_BAR; PG8_SCHED;
            PG8_LDA(At, 1, 1); PG8_STAGE(PG8_SB(1, 0), b3, voffB); PG8_STAGE(PG8_SB(1, 1), b3 + hstepB, voffB); PG8_STAGE(PG8_SA(1, 0), a3, voffA);
            PG8_WAIT_V(8); PG8_WAIT_L(0); PG8_BAR; PG8_MMA(1, 0, At, B0); PG8_MMA(1, 1, At, B1); PG8_BAR; PG8_SCHED;
            } else {
            PG8_LDB(B0, 0, 0); PG8_SCHED; PG8_LDA(At, 0, 0); PG8_STAGE(PG8_SA(1, 1), a1 + hstepA, voffA);
            PG8_WAIT_L(8); PG8_BAR; PG8_WAIT_L(0); PG8_MMA(0, 0, At, B0); PG8_BAR; PG8_SCHED;
            PG8_LDB(B1, 0, 1); PG8_STAGE(PG8_SB(0, 0), b2, voffB);
            PG8_BAR; PG8_WAIT_L(0); PG8_MMA(0, 1, At, B1); PG8_BAR;
            PG8_LDA(At, 0, 1); PG8_STAGE(PG8_SA(0, 0), a2, voffA);
            PG8_BAR; PG8_WAIT_L(0); PG8_MMA(1, 0, At, B0); PG8_BAR; PG8_SCHED;
            PG8_STAGE(PG8_SB(0, 1), b2 + hstepB, voffB);
            PG8_WAIT_V(6); PG8_BAR; PG8_MMA(1, 1, At, B1); PG8_BAR;
            PG8_LDB(B0, 1, 0); PG8_SCHED; PG8_LDA(At, 1, 0); PG8_STAGE(PG8_SA(0, 1), a2 + hstepA, voffA);
            PG8_WAIT_L(8); PG8_BAR; PG8_WAIT_L(0); PG8_MMA(0, 0, At, B0); PG8_BAR; PG8_SCHED;
            PG8_LDB(B1, 1, 1); PG8_STAGE(PG8_SB(1, 0), b3, voffB);
            PG8_BAR; PG8_WAIT_L(0); PG8_MMA(0, 1, At, B1); PG8_BAR;
            PG8_LDA(At, 1, 1); PG8_STAGE(PG8_SA(1, 0), a3, voffA);
            PG8_BAR; PG8_WAIT_L(0); PG8_MMA(1, 0, At, B0); PG8_BAR; PG8_SCHED;
            PG8_STAGE(PG8_SB(1, 1), b3 + hstepB, voffB);
            PG8_WAIT_V(6); PG8_BAR; PG8_MMA(1, 1, At, B1); PG8_BAR;
            }
        }
        if constexpr (ALIGN_EPI) { if (wr == 0) PG8_BAR; }
        if constexpr (!Epi::AFTER_DRAIN) { Unit ue = cur; asm volatile("" : "+s"(ue.pm), "+s"(ue.pn));
            E(acc, ue, wr, wc, fr, fq); S.done(cur); }
        if (!has_next) break;
#pragma unroll
        for (int a = 0; a < 2; ++a)
#pragma unroll
            for (int b = 0; b < 2; ++b)
#pragma unroll
                for (int m = 0; m < 4; ++m)
#pragma unroll
                    for (int n = 0; n < 2; ++n) acc[a][b][m][n] = (f32x4){0.f, 0.f, 0.f, 0.f};
        cur = nxt; cA = nA; cB = nB; ++ui;
        if constexpr (ALIGN_EPI) { if (wr == 1) PG8_BAR; }
    }
    PG8_WAIT_V(0);
    if constexpr (!ALIGN_EPI) { if (wr == 0) PG8_BAR; }
    PG8_BAR;
    if constexpr (Epi::AFTER_DRAIN) { E.fused(acc, cur, wr, wc, fr, fq, lds, wid, lane); S.done(cur); }
#undef PG8_SA
#undef PG8_SB
#undef PG8_STAGE
#undef PG8_LDA
#undef PG8_LDB
#undef PG8_MMA
#undef PG8_WAIT_V
#undef PG8_WAIT_L
#undef PG8_BAR
#undef PG8_SCHED
}
}

constexpr int NWAVES = 8;
#ifndef REPEAT_MASK
#define REPEAT_MASK 0
#endif
#ifndef PROBE_SEL2
#define PROBE_SEL2 1
#endif
#ifndef PROBE_SEC
#define PROBE_SEC 0
#endif
#ifndef PROBE_FAKEID
#define PROBE_FAKEID 0
#endif
#ifndef PROBE_NOSEL
#define PROBE_NOSEL 0
#endif
#ifndef MK_PER_PHASE
#define MK_PER_PHASE 0
#endif
constexpr int NPHASE = 14;

constexpr int BATCH = 16, SEQ = 4096, DM = 1024, MTOK = BATCH * SEQ;
constexpr int LDP = 4864;
constexpr int Q_OFF = 0, K_OFF = 512, V_OFF = 1024, QI_OFF = 1536, P_OFF = 2048, GA_OFF = 2560, GP_OFF = 3584, KI_OFF = 4608, WI_OFF = 4672;
constexpr int IN_WIDTH = 4680;
constexpr float EPS = 1e-6f;
constexpr float C2 = 0.125f * 1.4426950408889634f;
constexpr float WI_SCALE = 0.35355339059327373f * 0.125f;

constexpr size_t MiB = 1u << 20;
constexpr size_t WS_CTL = 0, CTL_ZERO_BYTES = 1 * MiB;
constexpr size_t WS_ROPE = 1 * MiB;
constexpr size_t WS_WIN = 2 * MiB;
constexpr size_t WS_WA = 12 * MiB;
constexpr size_t WS_WPP = 13 * MiB;
constexpr size_t WS_WO = 14 * MiB;
constexpr size_t WS_W2 = 16 * MiB;
constexpr size_t WS_SKB = 19 * MiB;
constexpr size_t WS_U16 = 20 * MiB, WS_V16 = 52 * MiB;
constexpr size_t WS_MASK = 84 * MiB;
constexpr size_t WS_POOLED = 116 * MiB;
constexpr size_t WS_ACT = 180 * MiB;
constexpr size_t WS_PROJ = 308 * MiB;
constexpr size_t WS_AO = 916 * MiB;
constexpr size_t WS_REXP = 980 * MiB, WS_RG = 116 * MiB;
constexpr size_t WS_HG = 308 * MiB;
constexpr size_t WS_SUBK = 436 * MiB;
constexpr size_t WS_SSP = 948 * MiB;
constexpr size_t WS_END = 1024 * MiB;
constexpr int CW_TMO = 0, CW_BAR = 4096, CW_AMAX = 12288;

constexpr int RING_BYTES = 131072;
constexpr int LDSCTL_OFF = RING_BYTES, MISC_OFF = LDSCTL_OFF + 320;
constexpr int LDS_BYTES = 147456;

#define GAS __attribute__((address_space(1)))
#define LAS __attribute__((address_space(3)))
typedef unsigned short bf16;
typedef unsigned v4u __attribute__((ext_vector_type(4)));
typedef unsigned v2u __attribute__((ext_vector_type(2)));
typedef float f32x4 __attribute__((ext_vector_type(4)));
typedef float f32x16 __attribute__((ext_vector_type(16)));
typedef short bf16x8 __attribute__((ext_vector_type(8)));
typedef short s16x4 __attribute__((ext_vector_type(4)));
typedef GAS unsigned gu32;
#define RLX_AGENT __ATOMIC_RELAXED, __HIP_MEMORY_SCOPE_AGENT
#define LDS_WAIT() asm volatile("s_waitcnt lgkmcnt(0)" ::: "memory")
#define BAR_LDS() asm volatile("s_waitcnt lgkmcnt(0)\n\ts_barrier" ::: "memory")
#define VM_WAIT() asm volatile("s_waitcnt vmcnt(0)" ::: "memory")
__device__ __forceinline__ unsigned f2bf(float f) { unsigned u = __builtin_bit_cast(unsigned, f); return (u + 0x7fffu + ((u >> 16) & 1u)) >> 16; }
typedef float f32x2k_t __attribute__((ext_vector_type(2))); typedef __bf16 bf16x2k_t __attribute__((ext_vector_type(2)));
__device__ __forceinline__ unsigned pk2(float lo, float hi) { f32x2k_t v = {lo, hi}; bf16x2k_t b = __builtin_convertvector(v, bf16x2k_t); return __builtin_bit_cast(unsigned, b); }
__device__ __forceinline__ float bflo(unsigned w) { return __uint_as_float(w << 16); }
__device__ __forceinline__ float bfhi(unsigned w) { return __uint_as_float(w & 0xffff0000u); }
__device__ __forceinline__ unsigned ordk(float f) { const unsigned b = __float_as_uint(f); return b ^ ((unsigned)((int)b >> 31) | 0x80000000u); }
__device__ __forceinline__ float unordk(unsigned k) { return __uint_as_float((k & 0x80000000u) ? (k ^ 0x80000000u) : ~k); }
__device__ __forceinline__ float relu_i(float x) { const int i = __float_as_int(x); return __int_as_float(i > 0 ? i : 0); }
__device__ __forceinline__ int crow(int r, int hi) { return (r & 3) + 8 * (r >> 2) + 4 * hi; }
typedef __bf16 bf16x2v_t __attribute__((ext_vector_type(2)));
__device__ __forceinline__ float dot2bf(unsigned a, unsigned b, float acc) { return __builtin_amdgcn_fdot2_f32_bf16(__builtin_bit_cast(bf16x2v_t, a), __builtin_bit_cast(bf16x2v_t, b), acc, false); }

#define XB_TMO      128
#define XB_XCNT(j)  (256  + 64 * (j))
#define XB_XSUB(j)  (1280 + 64 * (j))
#define XB_XGEN(j)  (2304 + 64 * (j))
#define XB_TOP      3328
#define XB_TOPGEN   3392
#define XCD_BAR_WORDS 3456
#define XB_SPIN_CAP (1u << 18)

__device__ __forceinline__ unsigned xb_ld(unsigned* p)              { return __hip_atomic_load(p, __ATOMIC_RELAXED, __HIP_MEMORY_SCOPE_AGENT); }
__device__ __forceinline__ unsigned xb_add(unsigned* p, unsigned v) { return __hip_atomic_fetch_add(p, v, __ATOMIC_RELAXED, __HIP_MEMORY_SCOPE_AGENT); }
__device__ __forceinline__ unsigned xb_xcc_id() { return (unsigned)__builtin_amdgcn_s_getreg((3 << 11) | 20) & 0xFu; }
#define XB_SPIN(cond, bar) do { unsigned _sp = 0; while (cond) { __builtin_amdgcn_s_sleep(1); \
    if ((++_sp & 255u) == 0u) { if (xb_ld(&(bar)[XB_TMO])) break; if (_sp > XB_SPIN_CAP) { atomicAdd(&(bar)[XB_TMO], 1u); break; } } } } while (0)

struct XcdBarrier {
    unsigned* bar; unsigned x;
    volatile LAS unsigned* st;
};

__device__ __forceinline__ XcdBarrier xcd_barrier_post(unsigned* bar, volatile LAS unsigned* st) {
    XcdBarrier b; b.bar = bar; b.x = xb_xcc_id(); b.st = st;
    if (threadIdx.x == 0) (void)xb_add(&bar[XB_XCNT(b.x)], 1u);
    return b;
}
__device__ __forceinline__ void xcd_barrier_complete(unsigned* bar, unsigned x, unsigned& nloc, unsigned& nx) {
    const unsigned G = gridDim.x * gridDim.y * gridDim.z;
    unsigned sum, cnt, mine, sp = 0u;
    for (;;) {
        sum = 0u; cnt = 0u; mine = 0u;
#pragma unroll
        for (unsigned j = 0; j < 16; ++j) { const unsigned c = xb_ld(&bar[XB_XCNT(j)]); sum += c; cnt += (c > 0u) ? 1u : 0u; mine = (j == x) ? c : mine; }
        if (sum == G) break;
        __builtin_amdgcn_s_sleep(1);
        if ((++sp & 255u) == 0u) { if (xb_ld(&bar[XB_TMO])) break; if (sp > XB_SPIN_CAP) { atomicAdd(&bar[XB_TMO], 1u); break; } }
    }
    nloc = mine > 0u ? mine : 1u; nx = cnt > 0u ? cnt : 1u;
}

__device__ __forceinline__ void xcd_barrier(const XcdBarrier& b) {
    asm volatile("s_waitcnt vmcnt(0)" ::: "memory");
    __syncthreads();
    if (threadIdx.x == 0) {
        unsigned* bar = b.bar;
        __builtin_amdgcn_s_waitcnt(0);
        unsigned nloc = b.st[0], nx = b.st[1];
        if (nloc == 0u) { xcd_barrier_complete(bar, b.x, nloc, nx); b.st[0] = nloc; b.st[1] = nx; }
        const unsigned old = xb_add(&bar[XB_XSUB(b.x)], 1u);
        const unsigned gen = old / nloc;
        if (old + 1u == (gen + 1u) * nloc) {
            __builtin_amdgcn_fence(__ATOMIC_RELEASE, "agent");
            asm volatile("s_waitcnt vmcnt(0)" ::: "memory");
            const unsigned og = xb_add(&bar[XB_TOP], 1u);
            const unsigned tg = og / nx;
            if (og + 1u == (tg + 1u) * nx) xb_add(&bar[XB_TOPGEN], 1u);
            else XB_SPIN(xb_ld(&bar[XB_TOPGEN]) == tg, bar);
            __builtin_amdgcn_fence(__ATOMIC_ACQUIRE, "agent");
            xb_add(&bar[XB_XGEN(b.x)], 1u);
            asm volatile("s_waitcnt vmcnt(0)" ::: "memory");
        } else {
            XB_SPIN(xb_ld(&bar[XB_XGEN(b.x)]) == gen, bar);
            __builtin_amdgcn_fence(__ATOMIC_ACQUIRE, "agent");
            asm volatile("s_waitcnt vmcnt(0)" ::: "memory");
        }
    }
    __syncthreads();
}


struct Frame {
    LAS unsigned char* lds;
    volatile LAS unsigned* MISC;
    gu32* ctl;
    unsigned char* ws;
    int tid, lane, wave, vcu, G;
};
struct Args { const float* in[15]; float* out; unsigned char* ws; int ph_lo, ph_hi; };

__device__ __forceinline__ float wave_sum(float v) {
#pragma unroll
    for (int o = 1; o < 64; o <<= 1) v += __shfl_xor(v, o);
    return v;
}

template <class ColMap>
__device__ __forceinline__ void p0_transpose_item(const float* W, int K, int N, bf16* WT, int nblk, LAS float* scr, int item, int lane, ColMap cm) {
    const int kb = item / nblk, nb = item % nblk, k0 = 64 * kb, n0 = 32 * nb;
    const int src = cm(n0 + (lane & 31));
#pragma unroll 8
    for (int i = 0; i < 32; ++i) { const int kk = 2 * i + (lane >> 5); scr[kk * 33 + (lane & 31)] = (src >= 0) ? W[(size_t)(k0 + kk) * N + src] : 0.f; }
    LDS_WAIT(); asm volatile("" ::: "memory");
    const int c = lane & 7;
#pragma unroll
    for (int j = 0; j < 4; ++j) { const int n = (lane >> 3) + 8 * j; const LAS float* s = scr + (8 * c) * 33 + n;
        v4u o; o.x = pk2(s[0 * 33], s[1 * 33]); o.y = pk2(s[2 * 33], s[3 * 33]); o.z = pk2(s[4 * 33], s[5 * 33]); o.w = pk2(s[6 * 33], s[7 * 33]);
        *(GAS v4u*)(WT + (size_t)(n0 + n) * K + k0 + 8 * c) = o; }
    LDS_WAIT(); asm volatile("" ::: "memory");
}
struct MapIdent { __device__ __forceinline__ int operator()(int n) const { return n; } };
struct MapWin { __device__ __forceinline__ int operator()(int n) const {
    if (n < 2048) return n;
    if (n < 2560) return 2120 + (n - 2048);
    if (n < 4608) return 2632 + (n - 2560);
    if (n < 4672) return 2048 + (n - 4608);
    if (n < 4680) return 2112 + (n - 4672);
    return -1; } };

template <int NR> __device__ __forceinline__ void rms_rows_to_bf16(const float* x, const float* g, bf16* o, int m0, int stride, int lane) {
    f32x4 v[NR][4]; float s[NR];
#pragma unroll
    for (int r = 0; r < NR; ++r) { const GAS f32x4* xr = (const GAS f32x4*)(x + (size_t)(m0 + r * stride) * DM) + lane;
#pragma unroll
        for (int j = 0; j < 4; ++j) v[r][j] = xr[64 * j]; }
#pragma unroll
    for (int r = 0; r < NR; ++r) { float a = 0.f;
#pragma unroll
        for (int j = 0; j < 4; ++j) a += (v[r][j].x * v[r][j].x + v[r][j].y * v[r][j].y) + (v[r][j].z * v[r][j].z + v[r][j].w * v[r][j].w);
        s[r] = a; }
#pragma unroll
    for (int o2 = 1; o2 < 64; o2 <<= 1) {
#pragma unroll
        for (int r = 0; r < NR; ++r) s[r] += __shfl_xor(s[r], o2);
    }
    const GAS f32x4* gr = (const GAS f32x4*)g + lane;
    f32x4 gg[4];
#pragma unroll
    for (int j = 0; j < 4; ++j) gg[j] = gr[64 * j];
#pragma unroll
    for (int r = 0; r < NR; ++r) { const float rs = 1.0f / sqrtf(s[r] * (1.f / 1024.f) + EPS);
        GAS unsigned long long* o8 = (GAS unsigned long long*)(o + (size_t)(m0 + r * stride) * DM) + lane;
#pragma unroll
        for (int j = 0; j < 4; ++j) o8[64 * j] = (unsigned long long)pk2(v[r][j].x * rs * gg[j].x, v[r][j].y * rs * gg[j].y) | ((unsigned long long)pk2(v[r][j].z * rs * gg[j].z, v[r][j].w * rs * gg[j].w) << 32); }
}

__device__ __forceinline__ void p0_prologue(Frame& F, const Args& AR) {
    LAS float* scr = (LAS float*)(F.lds + F.wave * 16384);
    const int gw = F.vcu * NWAVES + F.wave, NGW = F.G * NWAVES, lane = F.lane;
    constexpr int I_WIN = 16 * 152, I_WA = 8 * 32, I_WO = 16 * 32;
    for (int it = gw; it < I_WIN + I_WA + I_WO; it += NGW) {
        int r = it;
        if (r < I_WIN) { p0_transpose_item((AR.in[2]), 1024, IN_WIDTH, ((bf16*)(F.ws + WS_WIN)), 152, scr, r, lane, MapWin()); continue; } r -= I_WIN;
        if (r < I_WA) { p0_transpose_item((AR.in[7]), 512, 1024, ((bf16*)(F.ws + WS_WA)), 32, scr, r, lane, MapIdent()); continue; } r -= I_WA;
        p0_transpose_item((AR.in[9]), 1024, 1024, ((bf16*)(F.ws + WS_WO)), 32, scr, r, lane, MapIdent());
    }
    for (int it = gw; it < 16 * 64; it += NGW) {
        const int nb = it & 15, kb = it >> 4, n = nb * 64 + lane, k0 = kb * 8, g = k0 >> 7, c0 = k0 & 127;
        float acc[8];
#pragma unroll
        for (int j = 0; j < 8; ++j) acc[j] = 0.f;
        for (int d = 0; d < 128; ++d) {
            const float wv = (AR.in[8])[(size_t)(g * 128 + d) * 1024 + n] * (AR.in[6])[g * 128 + d];
#pragma unroll
            for (int j = 0; j < 8; ++j) acc[j] += (AR.in[5])[(size_t)(g * 128 + c0 + j) * 128 + d] * wv;
        }
        v4u o; o.x = pk2(acc[0], acc[1]); o.y = pk2(acc[2], acc[3]); o.z = pk2(acc[4], acc[5]); o.w = pk2(acc[6], acc[7]);
        *(GAS v4u*)(((bf16*)(F.ws + WS_WPP)) + (size_t)n * 512 + k0) = o;
    }
    for (int it = gw; it < 16 * 32; it += NGW) p0_transpose_item((AR.in[11]), 1024, 1024, ((bf16*)(F.ws + WS_W2)), 32, scr, it, lane, MapIdent());
    for (int it = gw; it < 256; it += NGW) { const size_t e0 = (size_t)it * 512 + lane * 8;
        const f32x4 a = *(const GAS f32x4*)((AR.in[12]) + e0), b = *(const GAS f32x4*)((AR.in[12]) + e0 + 4);
        v4u o; o.x = pk2(a.x, a.y); o.y = pk2(a.z, a.w); o.z = pk2(b.x, b.y); o.w = pk2(b.z, b.w);
        *(GAS v4u*)(((bf16*)(F.ws + WS_SKB)) + e0) = o; }
    {   float mu = 0.f, mv = 0.f;
#pragma unroll 4
        for (int it = gw; it < 2 * 32768; it += NGW) {
            const float* src = (it < 32768) ? (AR.in[13]) : (AR.in[14]); const size_t e0 = (size_t)(it & 32767) * 512 + lane * 8;
            const f32x4 a = *(const GAS f32x4*)(src + e0), b = *(const GAS f32x4*)(src + e0 + 4);
            const float m = fmaxf(fmaxf(fmaxf(fabsf(a.x), fabsf(a.y)), fmaxf(fabsf(a.z), fabsf(a.w))), fmaxf(fmaxf(fabsf(b.x), fabsf(b.y)), fmaxf(fabsf(b.z), fabsf(b.w))));
            if (it < 32768) mu = fmaxf(mu, m); else mv = fmaxf(mv, m);
        }
#pragma unroll
        for (int o = 1; o < 64; o <<= 1) { mu = fmaxf(mu, __shfl_xor(mu, o)); mv = fmaxf(mv, __shfl_xor(mv, o)); }
        if (lane == 0) { __hip_atomic_fetch_max(F.ctl + CW_AMAX, __float_as_uint(mu), RLX_AGENT); __hip_atomic_fetch_max(F.ctl + CW_AMAX + 1, __float_as_uint(mv), RLX_AGENT); }
    }
    for (int it = gw * 64 + lane; it < 4096 * 8; it += NGW * 64) {
        const int pos = it >> 3, i = it & 7;
        const float invf = exp2f(-(float)i * 0.125f * 18.931568569324174f);
        const double ang = (double)((float)pos * invf);
        const double kq = __builtin_rint(ang * 0.6366197723675814);
        const float r = (float)(ang - kq * 1.5707963267948966);
        const int q = (int)((long long)kq & 3);
        const float r2 = r * r;
        const float sn = r + r * r2 * (-1.6666654611e-1f + r2 * (8.3321608736e-3f + r2 * (-1.9515295891e-4f)));
        const float cs = 1.0f - 0.5f * r2 + r2 * r2 * (4.166664568298827e-2f + r2 * (-1.388731625493765e-3f + r2 * 2.443315711809948e-5f));
        const float s = (q == 0) ? sn : (q == 1) ? cs : (q == 2) ? -sn : -cs;
        const float c = (q == 0) ? cs : (q == 1) ? -sn : (q == 2) ? -cs : sn;
        ((float*)(F.ws + WS_ROPE))[pos * 16 + i] = c; ((float*)(F.ws + WS_ROPE))[pos * 16 + 8 + i] = s;
    }
    { int m = gw;
      for (; m + 3 * NGW < MTOK; m += 4 * NGW) rms_rows_to_bf16<4>((AR.in[0]), (AR.in[1]), ((bf16*)(F.ws + WS_ACT)), m, NGW, lane);
      for (; m < MTOK; m += NGW) rms_rows_to_bf16<1>((AR.in[0]), (AR.in[1]), ((bf16*)(F.ws + WS_ACT)), m, NGW, lane); }
}

__device__ __forceinline__ void unpack8(const v4u w, float (&v)[8]) { v[0] = bflo(w.x); v[1] = bfhi(w.x); v[2] = bflo(w.y); v[3] = bfhi(w.y); v[4] = bflo(w.z); v[5] = bfhi(w.z); v[6] = bflo(w.w); v[7] = bfhi(w.w); }
__device__ __forceinline__ v4u pack8(const float (&v)[8]) { v4u o; o.x = pk2(v[0], v[1]); o.y = pk2(v[2], v[3]); o.z = pk2(v[4], v[5]); o.w = pk2(v[6], v[7]); return o; }
__device__ __forceinline__ void rope8(float (&v)[8], int sub, const float (&cs)[8], const float (&sn)[8]) {
    float pv[8];
#pragma unroll
    for (int j = 0; j < 8; ++j) pv[j] = __shfl_xor(v[j], 1);
    if (sub == 0) {
#pragma unroll
        for (int j = 0; j < 8; ++j) v[j] = v[j] * cs[j] - pv[j] * sn[j];
    } else if (sub == 1) {
#pragma unroll
        for (int j = 0; j < 8; ++j) v[j] = v[j] * cs[j] + pv[j] * sn[j];
    }
}
__device__ __forceinline__ float fp8_scale(unsigned amax_bits) { const unsigned be = (amax_bits >> 23) & 0xffu; return (be == 0u || be > 250u) ? 1.0f : __uint_as_float((261u - be) << 23); }
__device__ __forceinline__ float fp8_inv_scale(unsigned amax_bits) { const unsigned be = (amax_bits >> 23) & 0xffu; return (be == 0u || be > 250u) ? 1.0f : __uint_as_float((be - 7u) << 23); }
__device__ __forceinline__ void row_to_fp8(const float* src, unsigned char* dst, float sc, int lane) {
    const GAS f32x4* p = (const GAS f32x4*)src + lane * 4; v4u o;
#pragma unroll
    for (int q = 0; q < 4; ++q) { const f32x4 a = p[q]; int w = 0; w = __builtin_amdgcn_cvt_pk_fp8_f32(a.x * sc, a.y * sc, w, false); w = __builtin_amdgcn_cvt_pk_fp8_f32(a.z * sc, a.w * sc, w, true); o[q] = (unsigned)w; }
    *(GAS v4u*)(dst + ((size_t)(lane >> 3) << 21) + (lane & 7) * 16) = o;
}
__device__ __forceinline__ void row_to_i8(const float* src, unsigned char* dst, float sc, int lane) {
    const GAS f32x4* p = (const GAS f32x4*)src + lane * 4; v4u o;
#pragma unroll
    for (int q = 0; q < 4; ++q) { const f32x4 a = p[q];
        const unsigned b0 = __float_as_uint(a.x * sc + 12582912.0f), b1 = __float_as_uint(a.y * sc + 12582912.0f), b2 = __float_as_uint(a.z * sc + 12582912.0f), b3 = __float_as_uint(a.w * sc + 12582912.0f);
        o[q] = __builtin_amdgcn_perm(b1, b0, 0x0c0c0400u) | __builtin_amdgcn_perm(b3, b2, 0x04000c0cu); }
    *(GAS v4u*)(dst + ((size_t)(lane >> 3) << 21) + (lane & 7) * 16) = o;
}
__device__ __forceinline__ float i8_scale(unsigned amax_bits) { const float a = __uint_as_float(amax_bits); return (a > 1e-30f && a < 1e30f) ? 127.0f / a : 1.0f; }
__device__ __forceinline__ float i8_inv_scale(unsigned amax_bits) { const float a = __uint_as_float(amax_bits); return (a > 1e-30f && a < 1e30f) ? a * (1.0f / 127.0f) : 1.0f; }
__device__ __forceinline__ void fixup_token(Frame& F, const Args& AR, int tok) {
    const int lane = F.lane, sub = lane & 7, pos = tok & (SEQ - 1);
    bf16* row = ((bf16*)(F.ws + WS_PROJ)) + (size_t)tok * LDP;
    float cs[8], sn[8];
    { const GAS f32x4* rt = (const GAS f32x4*)(((float*)(F.ws + WS_ROPE)) + pos * 16); const f32x4 a = rt[0], b = rt[1], c = rt[2], d = rt[3];
      cs[0] = a.x; cs[1] = a.y; cs[2] = a.z; cs[3] = a.w; cs[4] = b.x; cs[5] = b.y; cs[6] = b.z; cs[7] = b.w;
      sn[0] = c.x; sn[1] = c.y; sn[2] = c.z; sn[3] = c.w; sn[4] = d.x; sn[5] = d.y; sn[6] = d.z; sn[7] = d.w; }
#pragma unroll
    for (int which = 0; which < 2; ++which) {
        GAS v4u* p = (GAS v4u*)(row + (which ? K_OFF : Q_OFF) + lane * 8);
        float v[8]; unpack8(*p, v);
        float ss = 0.f;
#pragma unroll
        for (int j = 0; j < 8; ++j) ss += v[j] * v[j];
        ss += __shfl_xor(ss, 1); ss += __shfl_xor(ss, 2); ss += __shfl_xor(ss, 4);
        const float rs = 1.0f / sqrtf(ss * (1.f / 64.f) + EPS);
        const float* g = (which ? (AR.in[4]) : (AR.in[3])) + sub * 8;
#pragma unroll
        for (int j = 0; j < 8; ++j) v[j] = v[j] * rs * g[j];
        rope8(v, sub, cs, sn);
        if (which == 0) {
#pragma unroll
            for (int j = 0; j < 8; ++j) v[j] *= C2;
        }
        *p = pack8(v);
    }
    { GAS v4u* p = (GAS v4u*)(row + QI_OFF + lane * 8); float v[8]; unpack8(*p, v); rope8(v, sub, cs, sn); *p = pack8(v); }
    { GAS v4u* p = (GAS v4u*)(row + KI_OFF + (lane & 7) * 8); float v[8]; unpack8(*p, v); rope8(v, sub, cs, sn); if (lane < 8) *p = pack8(v); }
}
__device__ __forceinline__ void pool_run(Frame& F, int tok0, int ntok) {
    const int lane = F.lane, g = lane >> 4, w = 2 << g;
    const bf16* pcol = ((const bf16*)(F.ws + WS_PROJ)) + P_OFF + lane * 8;
    float S[8];
#pragma unroll
    for (int j = 0; j < 8; ++j) S[j] = 0.f;
    { const int pos0 = tok0 & (SEQ - 1);
#pragma unroll
      for (int back = 1; back < 16; ++back) {
          if (back < w && back <= pos0) { float t[8]; unpack8(*(const GAS v4u*)(pcol + (size_t)(tok0 - back) * LDP), t);
#pragma unroll
              for (int j = 0; j < 8; ++j) S[j] += t[j]; }
      } }
#pragma unroll 1
    for (int i = 0; i < ntok; ++i) {
        const int tok = tok0 + i, pos = tok & (SEQ - 1);
        float cur[8]; unpack8(*(const GAS v4u*)(pcol + (size_t)tok * LDP), cur);
#pragma unroll
        for (int j = 0; j < 8; ++j) S[j] += cur[j];
        const float inv = 1.0f / (float)((pos + 1 < w) ? (pos + 1) : w);
        float o[8];
#pragma unroll
        for (int j = 0; j < 8; ++j) o[j] = S[j] * inv - cur[j];
        *(GAS v4u*)(((bf16*)(F.ws + WS_POOLED)) + (size_t)tok * 512 + lane * 8) = pack8(o);
        if (pos + 1 >= w) { float t[8]; unpack8(*(const GAS v4u*)(pcol + (size_t)(tok + 1 - w) * LDP), t);
#pragma unroll
            for (int j = 0; j < 8; ++j) S[j] -= t[j]; }
    }
}

__device__ __forceinline__ int wave_incl_scan(int v) {
    v += __builtin_amdgcn_update_dpp(0, v, 0x111, 0xf, 0xf, false);
    v += __builtin_amdgcn_update_dpp(0, v, 0x112, 0xf, 0xf, false);
    v += __builtin_amdgcn_update_dpp(0, v, 0x114, 0xf, 0xf, false);
    v += __builtin_amdgcn_update_dpp(0, v, 0x118, 0xf, 0xf, false);
    v += __builtin_amdgcn_update_dpp(0, v, 0x142, 0xa, 0xf, false);
    v += __builtin_amdgcn_update_dpp(0, v, 0x143, 0xc, 0xf, false);
    return v;
}
template <int NB> __device__ __forceinline__ void hist_search(const LAS unsigned* hist, int need, int lane, int& B, int& G, int& E) {
    constexpr int PER = NB / 64;
    int t = 0;
#pragma unroll
    for (int q = 0; q < PER / 4; ++q) { const v4u h = *(const LAS v4u*)(hist + lane * PER + 4 * q); t += (int)(h.x + h.y + h.z + h.w); }
    const int pfx = wave_incl_scan(t);
    const int L = __ffsll((long long)__ballot(pfx >= need)) - 1;
    const int base = __builtin_amdgcn_readlane(pfx, L) - __builtin_amdgcn_readlane(t, L);
    const int hv = (lane < PER) ? (int)hist[L * PER + lane] : 0;
    const int p2 = wave_incl_scan(hv) + base;
    const int i = __ffsll((long long)__ballot(p2 >= need)) - 1;
    B = L * PER + i; E = __builtin_amdgcn_readlane(hv, i); G = __builtin_amdgcn_readlane(p2, i) - E;
}
template <int NB> __device__ __forceinline__ void hist_zero(LAS unsigned* hist, int lane) {
#pragma unroll
    for (int q = 0; q < NB / 256; ++q) *(LAS v4u*)(hist + q * 256 + lane * 4) = (v4u){0u, 0u, 0u, 0u};
}
#define HIST_ADD(p) (void)__hip_atomic_fetch_add((p), 1u, __ATOMIC_RELAXED, __HIP_MEMORY_SCOPE_WORKGROUP)
#define wlane(dst, sval, j) asm volatile("s_nop 3\n\tv_writelane_b32 %0, %1, %2\n\ts_nop 1" : "+v"(dst) : "s"(sval), "i"(j))
__device__ __forceinline__ void select_row(const unsigned short* srow  , LAS unsigned* hist, int nj, int lastw, GAS unsigned long long* mout, int lane, unsigned long long& tacc, unsigned& tcnt) {
    const unsigned long long ts0_ = (PROBE_SEC >= 30 && PROBE_SEC <= 33) ? __builtin_amdgcn_s_memtime() : 0ull;
    unsigned key[64];
#pragma unroll
    for (int g = 0; g < 8; ++g) {
        if (nj > 8 * g) {
#pragma unroll
            for (int jj = 0; jj < 8; ++jj) key[8 * g + jj] = ordk(__uint_as_float((unsigned)((const GAS unsigned short*)srow)[(64 * (8 * g + jj) + lane) * 8] << 16) + 0.0f);
        } else {
#pragma unroll
            for (int jj = 0; jj < 8; ++jj) key[8 * g + jj] = 0u;
        }
    }
    LDS_WAIT(); asm volatile("" ::: "memory");
    if (PROBE_SEC >= 30 && PROBE_SEC <= 33) asm volatile("s_waitcnt vmcnt(0)" ::: "memory");
    const unsigned long long ts1_ = (PROBE_SEC >= 30 && PROBE_SEC <= 33) ? __builtin_amdgcn_s_memtime() : 0ull;
    int need = 256, B, G, E;
    hist_zero<2048>(hist, lane); LDS_WAIT(); asm volatile("" ::: "memory");
#pragma unroll
    for (int g = 0; g < 8; ++g) if (nj > 8 * g) {
#pragma unroll
        for (int jj = 0; jj < 8; ++jj) HIST_ADD(hist + (2047u - (key[8 * g + jj] >> 21)));
    }
    LDS_WAIT(); asm volatile("" ::: "memory");
    hist_search<2048>(hist, need, lane, B, G, E); need -= G;
    const unsigned long long ts2_ = (PROBE_SEC >= 30 && PROBE_SEC <= 33) ? __builtin_amdgcn_s_memtime() : 0ull;
    const unsigned d1 = 2047u - (unsigned)B;
    asm volatile("" ::: "memory"); hist_zero<2048>(hist, lane); LDS_WAIT(); asm volatile("" ::: "memory");
#pragma unroll
    for (int g = 0; g < 8; ++g) if (nj > 8 * g) {
#pragma unroll
        for (int jj = 0; jj < 8; ++jj) { const unsigned k = key[8 * g + jj]; if ((k >> 21) == d1) HIST_ADD(hist + (2047u - ((k >> 10) & 0x7ffu))); }
    }
    LDS_WAIT(); asm volatile("" ::: "memory");
    hist_search<2048>(hist, need, lane, B, G, E); need -= G;
    const unsigned pre2 = (d1 << 11) | (2047u - (unsigned)B);
    const unsigned v = pre2 << 10;
    const unsigned long long ts3_ = (PROBE_SEC >= 30 && PROBE_SEC <= 33) ? __builtin_amdgcn_s_memtime() : 0ull;
    unsigned mlo = 0u, mhi = 0u;
#pragma unroll
    for (int g = 0; g < 8; ++g) {
        asm volatile("v_cmp_ge_u32_e64 s[40:41], %2, %10\n\tv_cmp_ge_u32_e64 s[42:43], %3, %10\n\tv_cmp_ge_u32_e64 s[44:45], %4, %10\n\tv_cmp_ge_u32_e64 s[46:47], %5, %10\n\t"
                     "v_cmp_ge_u32_e64 s[48:49], %6, %10\n\tv_cmp_ge_u32_e64 s[50:51], %7, %10\n\tv_cmp_ge_u32_e64 s[52:53], %8, %10\n\tv_cmp_ge_u32_e64 s[54:55], %9, %10\n\ts_nop 1\n\t"
                     "v_writelane_b32 %0, s40, %11\n\tv_writelane_b32 %1, s41, %11\n\tv_writelane_b32 %0, s42, %12\n\tv_writelane_b32 %1, s43, %12\n\t"
                     "v_writelane_b32 %0, s44, %13\n\tv_writelane_b32 %1, s45, %13\n\tv_writelane_b32 %0, s46, %14\n\tv_writelane_b32 %1, s47, %14\n\t"
                     "v_writelane_b32 %0, s48, %15\n\tv_writelane_b32 %1, s49, %15\n\tv_writelane_b32 %0, s50, %16\n\tv_writelane_b32 %1, s51, %16\n\t"
                     "v_writelane_b32 %0, s52, %17\n\tv_writelane_b32 %1, s53, %17\n\tv_writelane_b32 %0, s54, %18\n\tv_writelane_b32 %1, s55, %18\n\ts_nop 1"
                     : "+v"(mlo), "+v"(mhi)
                     : "v"(key[8 * g]), "v"(key[8 * g + 1]), "v"(key[8 * g + 2]), "v"(key[8 * g + 3]), "v"(key[8 * g + 4]), "v"(key[8 * g + 5]), "v"(key[8 * g + 6]), "v"(key[8 * g + 7]), "v"(v),
                       "i"(8 * g), "i"(8 * g + 1), "i"(8 * g + 2), "i"(8 * g + 3), "i"(8 * g + 4), "i"(8 * g + 5), "i"(8 * g + 6), "i"(8 * g + 7)
                     : "s40", "s41", "s42", "s43", "s44", "s45", "s46", "s47", "s48", "s49", "s50", "s51", "s52", "s53", "s54", "s55");
    }
    int drop = E - need;
#pragma unroll
    for (int j = 63; j >= 0; --j) {
        if (drop > 0) {
            unsigned long long eq = __ballot(key[j] == v);
            if (eq != 0ull) {
                unsigned long long rem = 0ull;
                while (drop > 0 && eq != 0ull) { const unsigned long long hb = 1ull << (63 - __clzll((long long)eq)); rem |= hb; eq ^= hb; --drop; }
                const unsigned long long m = __ballot(key[j] >= v) & ~rem;
                wlane(mlo, (unsigned)m, j); wlane(mhi, (unsigned)(m >> 32), j);
            }
        }
    }
    if (lane <= lastw) mout[lane] = ((unsigned long long)mhi << 32) | (unsigned long long)mlo;
    LDS_WAIT(); asm volatile("" ::: "memory");
    if (PROBE_SEC >= 30 && PROBE_SEC <= 33) { const unsigned long long ts4_ = __builtin_amdgcn_s_memtime(); tacc += (PROBE_SEC == 30) ? (ts1_ - ts0_) : (PROBE_SEC == 31) ? (ts2_ - ts1_) : (PROBE_SEC == 32) ? (ts3_ - ts2_) : (ts4_ - ts3_); ++tcnt; }
}

__device__ __forceinline__ float* wave_scratch(unsigned char* ws, int gwv) {
    if (gwv < 1024) return (float*)(ws + WS_ACT) + (size_t)gwv * 32768;
    gwv -= 1024; if (gwv < 512) return (float*)(ws + WS_AO) + (size_t)gwv * 32768;
    gwv -= 512; if (gwv < 352) return (float*)(ws + 980 * MiB) + (size_t)gwv * 32768;
    gwv -= 352; if (gwv < 128) return (float*)(ws + 36 * MiB) + (size_t)gwv * 32768;
    gwv -= 128; return (float*)(ws + 68 * MiB) + (size_t)(gwv & 127) * 32768;
}
__device__ __forceinline__ void idx_unit(Frame& F, const Args& AR, int b, int c, unsigned long long& tacc, unsigned& tcnt, bool do_select = true) {
    const unsigned long long ti0_ = (PROBE_SEC >= 20 && PROBE_SEC <= 22) ? __builtin_amdgcn_s_memtime() : 0ull;
    const int lane = F.lane, wid = F.wave, l31 = lane & 31, h2 = lane >> 5;
    const size_t rowb = (size_t)b * SEQ, tp0 = rowb + (size_t)c * 64 + wid * 8;
    GAS unsigned long long* mbase = (GAS unsigned long long*)(((unsigned long long*)(F.ws + WS_MASK)) + tp0 * 64);
    if (c < 4) {
        if (lane < 32) { const int q = lane >> 2, j = lane & 3; mbase[q * 64 + j] = (j <= c) ? ~0ull : 0ull; }
        return;
    }
    unsigned short* sc = (unsigned short*)wave_scratch(F.ws, F.vcu * NWAVES + wid);
    LAS unsigned* hist = (LAS unsigned*)(F.lds + wid * 8192);
    const int ntile = 2 * (c + 1), nj = c + 1, lastw = c | 3, ntile_pad = 16 * ((nj + 7) >> 3);
    const int head = (l31 & 3) | (((l31 >> 3) & 1) << 2), qsub = ((l31 >> 2) & 1) | (((l31 >> 4) & 1) << 1);
    bf16x8 a[2][4]; float w[2][16];
#pragma unroll
    for (int rb = 0; rb < 2; ++rb) {
        const bf16* ap = ((bf16*)(F.ws + WS_PROJ)) + (tp0 + 4 * rb + qsub) * LDP + QI_OFF + head * 64 + h2 * 8;
#pragma unroll
        for (int st = 0; st < 4; ++st) a[rb][st] = *(const GAS bf16x8*)(ap + st * 16);
        const v4u wa = *(const GAS v4u*)(((bf16*)(F.ws + WS_PROJ)) + (tp0 + 4 * rb + h2) * LDP + WI_OFF), wb = *(const GAS v4u*)(((bf16*)(F.ws + WS_PROJ)) + (tp0 + 4 * rb + h2 + 2) * LDP + WI_OFF);
        float t[8]; unpack8(wa, t);
#pragma unroll
        for (int j = 0; j < 8; ++j) w[rb][j] = t[j] * WI_SCALE;
        unpack8(wb, t);
#pragma unroll
        for (int j = 0; j < 8; ++j) w[rb][8 + j] = t[j] * WI_SCALE;
    }
    const unsigned long long ti1_ = (PROBE_SEC >= 20 && PROBE_SEC <= 22) ? __builtin_amdgcn_s_memtime() : 0ull;
    {
        LAS unsigned char* kb = F.lds + 65536;
        const int nstage = (ntile + 3) >> 2;
        const int sk0 = F.tid >> 3, sch = F.tid & 7;
        const bf16* kg = ((bf16*)(F.ws + WS_PROJ)) + (rowb + sk0) * LDP + KI_OFF + sch * 8;
        v4u r0 = *(const GAS v4u*)kg, r1 = *(const GAS v4u*)(kg + (size_t)64 * LDP);
#pragma unroll 1
        for (int sg = 0; sg < nstage; ++sg) {
            LAS unsigned char* cur = kb + (sg & 1) * 18432;
            *(LAS v4u*)(cur + sk0 * 144 + sch * 16) = r0; *(LAS v4u*)(cur + (sk0 + 64) * 144 + sch * 16) = r1;
            BAR_LDS();
            { const int sn = (sg + 1 < nstage) ? sg + 1 : sg; r0 = *(const GAS v4u*)(kg + (size_t)sn * 128 * LDP); r1 = *(const GAS v4u*)(kg + (size_t)(sn * 128 + 64) * LDP); }
#pragma unroll
            for (int t4 = 0; t4 < 4; ++t4) {
                const int kt = 4 * sg + t4;
                if (kt < ntile) {
                    bf16x8 bfr[4];
#pragma unroll
                    for (int st = 0; st < 4; ++st) bfr[st] = *(const LAS bf16x8*)(cur + (t4 * 32 + l31) * 144 + st * 32 + h2 * 16);
                    float sq[4];
#pragma unroll
                    for (int rb = 0; rb < 2; ++rb) {
                        f32x16 acc;
#pragma unroll
                        for (int r = 0; r < 16; ++r) acc[r] = 0.f;
#pragma unroll
                        for (int st = 0; st < 4; ++st) acc = __builtin_amdgcn_mfma_f32_32x32x16_bf16(a[rb][st], bfr[st], acc, 0, 0, 0);
                        float s0 = 0.f, s1 = 0.f;
#pragma unroll
                        for (int r = 0; r < 8; ++r) { s0 = fmaf(w[rb][r], relu_i(acc[r]), s0); s1 = fmaf(w[rb][8 + r], relu_i(acc[8 + r]), s1); }
                        sq[2 * rb] = s0; sq[2 * rb + 1] = s1;
                    }
                    *(GAS v2u*)(sc + (size_t)(kt * 32 + l31) * 8 + 4 * h2) = (v2u){pk2(sq[0], sq[1]), pk2(sq[2], sq[3])};
                }
            }
        }
        for (int kt = ntile; kt < ntile_pad; ++kt)
            *(GAS v2u*)(sc + (size_t)(kt * 32 + l31) * 8 + 4 * h2) = (v2u){0xff80ff80u, 0xff80ff80u};
    }
    const unsigned long long ti2_ = (PROBE_SEC >= 20 && PROBE_SEC <= 22) ? __builtin_amdgcn_s_memtime() : 0ull;
    VM_WAIT();
    if (do_select) {
#pragma unroll 1
        for (int q = 0; q < 8 * PROBE_SEL2; ++q) select_row(sc + 4 * (q & 1) + ((q & 7) >> 1), hist, nj, lastw, mbase + (q & 7) * 64, lane, tacc, tcnt);
    }
    if (PROBE_SEC >= 20 && PROBE_SEC <= 22) { const unsigned long long ti3_ = __builtin_amdgcn_s_memtime(); tacc += (PROBE_SEC == 20) ? (ti1_ - ti0_) : (PROBE_SEC == 21) ? (ti2_ - ti1_) : (ti3_ - ti2_); tcnt = 1000u; }
}

__device__ __forceinline__ void attn_unit(Frame& F, const Args& AR, int b, int h, int qb, unsigned long long& tacc, unsigned& tcnt) {
    const int lane = F.lane, wid = F.wave, l31 = lane & 31, h2 = lane >> 5;
    LAS unsigned char* Ks = F.lds;
    LAS float* wsf = (LAS float*)(F.lds + 2 * 17408) + wid * 32;
    const size_t rowb = (size_t)b * SEQ, tok0 = rowb + (size_t)qb * 256 + wid * 32;
    bf16x8 qf[4];
    { const bf16* qp = ((bf16*)(F.ws + WS_PROJ)) + (tok0 + l31) * LDP + Q_OFF + h * 64 + h2 * 8;
#pragma unroll
      for (int st = 0; st < 4; ++st) qf[st] = *(const GAS bf16x8*)(qp + st * 16); }
    const int NT = 4 * (qb + 1), cw = qb * 4 + (wid >> 1);
    f32x16 o0, o1;
#pragma unroll
    for (int r = 0; r < 16; ++r) { o0[r] = 0.f; o1[r] = 0.f; }
    float lsum = 0.f;
    const int skey = F.tid >> 3, sch = F.tid & 7;
    const bf16* kg = ((bf16*)(F.ws + WS_PROJ)) + (rowb + skey) * LDP + K_OFF + h * 64 + sch * 8;
    const bf16* vg = ((bf16*)(F.ws + WS_PROJ)) + (rowb + skey) * LDP + V_OFF + h * 64 + sch * 8;
    const unsigned kst = skey * 144 + sch * 16, vst = skey * 128 + ((sch * 16) ^ (((skey >> 1) & 1) << 6));
    const GAS unsigned long long* mrow = (const GAS unsigned long long*)(((unsigned long long*)(F.ws + WS_MASK)) + (tok0 + l31) * 64);
    const int i16 = lane & 15, qq = i16 >> 2, pp = i16 & 3, blk = (lane >> 4) & 1;
    const unsigned vrd = (unsigned)((4 * h2 + qq) * 128 + ((32 * blk + 8 * pp) ^ (((qq >> 1) & 1) << 6)));
    v4u kr[3], vr[3];
#pragma unroll
    for (int u = 0; u < 3; ++u) { kr[u] = *(const GAS v4u*)(kg + (size_t)u * 64 * LDP); vr[u] = *(const GAS v4u*)(vg + (size_t)u * 64 * LDP); }
    unsigned long long mwn = mrow[0];
#pragma unroll 1
    for (int t = 0; t < NT; t += 3) {
#pragma unroll
        for (int u = 0; u < 3; ++u) {
            const int tt = t + u;
            if (tt < NT) {
                LAS unsigned char* Kc = Ks + (tt & 1) * 17408; LAS unsigned char* Vc = Kc + 9216;
                const unsigned long long t_a = PROBE_SEC ? __builtin_amdgcn_s_memtime() : 0ull;
                *(LAS v4u*)(Kc + kst) = kr[u]; *(LAS v4u*)(Vc + vst) = vr[u];
                BAR_LDS();
                const unsigned long long t_b = PROBE_SEC ? __builtin_amdgcn_s_memtime() : 0ull;
                { const int tn = (tt + 3 < NT) ? tt + 3 : NT - 1;
                  kr[u] = *(const GAS v4u*)(kg + (size_t)tn * 64 * LDP); vr[u] = *(const GAS v4u*)(vg + (size_t)tn * 64 * LDP); }
                const unsigned long long mw = mwn;
                mwn = mrow[(tt + 1 < NT) ? tt + 1 : tt];
                if (tt <= cw) {
                    bf16x8 vfr[2][2][2];
        #pragma unroll
                    for (int kb = 0; kb < 2; ++kb)
        #pragma unroll
                        for (int s = 0; s < 2; ++s)
        #pragma unroll
                            for (int d0 = 0; d0 < 2; ++d0) {
                                const unsigned ad = (vrd + (unsigned)((32 * kb + 16 * s) * 128)) ^ (unsigned)(d0 << 6);
                                const s16x4 lo = __builtin_bit_cast(s16x4, __builtin_amdgcn_ds_read_tr16_b64_v4i16((LAS s16x4*)(Vc + ad)));
                                const s16x4 hi = __builtin_bit_cast(s16x4, __builtin_amdgcn_ds_read_tr16_b64_v4i16((LAS s16x4*)(Vc + ad + 8 * 128)));
                                vfr[kb][s][d0] = (bf16x8){lo[0], lo[1], lo[2], lo[3], hi[0], hi[1], hi[2], hi[3]};
                            }
                    f32x16 p[2];
        #pragma unroll
                    for (int kb = 0; kb < 2; ++kb) {
                        f32x16 acc;
        #pragma unroll
                        for (int r = 0; r < 16; ++r) acc[r] = 0.f;
        #pragma unroll
                        for (int st = 0; st < 4; ++st) { const bf16x8 ka = *(const LAS bf16x8*)(Kc + (32 * kb + l31) * 144 + st * 32 + h2 * 16); acc = __builtin_amdgcn_mfma_f32_32x32x16_bf16(ka, qf[st], acc, 0, 0, 0); }
                        const unsigned wk = (kb ? (unsigned)(mw >> 32) : (unsigned)mw) >> (4 * h2);
        #pragma unroll
                        for (int r = 0; r < 16; ++r) {
                            const float e = __builtin_amdgcn_exp2f(acc[r]);
                            float pe;
                            asm("v_bfe_i32 %0, %2, %3, 1\n\tv_and_b32 %0, %0, %1" : "=&v"(pe) : "v"(e), "v"(wk), "i"((r & 3) + 8 * (r >> 2)));
                            acc[r] = pe;
                        }
                        p[kb] = acc;
                    }
                    const unsigned long long t_c = PROBE_SEC ? __builtin_amdgcn_s_memtime() : 0ull;
        #pragma unroll
                    for (int kb = 0; kb < 2; ++kb)
        #pragma unroll
                        for (int s = 0; s < 2; ++s) {
                            v4u pw; pw.x = pg8::cvt_pk_bf16(p[kb][8 * s + 0], p[kb][8 * s + 1]); pw.y = pg8::cvt_pk_bf16(p[kb][8 * s + 2], p[kb][8 * s + 3]); pw.z = pg8::cvt_pk_bf16(p[kb][8 * s + 4], p[kb][8 * s + 5]); pw.w = pg8::cvt_pk_bf16(p[kb][8 * s + 6], p[kb][8 * s + 7]);
                            lsum = dot2bf(pw.x, 0x3f803f80u, lsum); lsum = dot2bf(pw.y, 0x3f803f80u, lsum); lsum = dot2bf(pw.z, 0x3f803f80u, lsum); lsum = dot2bf(pw.w, 0x3f803f80u, lsum);
                            const bf16x8 pa = __builtin_bit_cast(bf16x8, pw);
        #pragma unroll
                            for (int d0 = 0; d0 < 2; ++d0) {
                                const bf16x8 vb = vfr[kb][s][d0];
                                if (d0 == 0) o0 = __builtin_amdgcn_mfma_f32_32x32x16_bf16(pa, vb, o0, 0, 0, 0); else o1 = __builtin_amdgcn_mfma_f32_32x32x16_bf16(pa, vb, o1, 0, 0, 0);
                            }
                        }
                    if (PROBE_SEC) { const unsigned long long t_d = __builtin_amdgcn_s_memtime(); tacc += (PROBE_SEC == 1) ? (t_b - t_a) : (PROBE_SEC == 2) ? (t_c - t_b) : (PROBE_SEC == 3) ? (t_d - t_c) : (t_d - t_a); ++tcnt; }
                }
            }
        }
    }
    lsum += __shfl_xor(lsum, 32);
    if (h2 == 0) wsf[l31] = lsum;
    LDS_WAIT(); asm volatile("" ::: "memory");
    LAS bf16* stg = (LAS bf16*)(F.lds + 2 * 17408 + 1024) + wid * 2048;
#pragma unroll
    for (int r = 0; r < 16; ++r) { const int q = crow(r, h2); const float rl = 1.0f / wsf[q];
        stg[q * 64 + l31] = (bf16)f2bf(o0[r] * rl); stg[q * 64 + 32 + l31] = (bf16)f2bf(o1[r] * rl); }
    LDS_WAIT(); asm volatile("" ::: "memory");
    bf16* ow = ((bf16*)(F.ws + WS_AO)) + tok0 * 512 + h * 64;
#pragma unroll
    for (int i = 0; i < 4; ++i) { const int row = i * 8 + (lane >> 3), ch = lane & 7; const v4u v = *(const LAS v4u*)(stg + row * 64 + ch * 8); *(GAS v4u*)(ow + (size_t)row * 512 + ch * 8) = v; }
    LDS_WAIT(); asm volatile("" ::: "memory");
}

__device__ __forceinline__ float row_rs(const float* ssp, size_t tok) {
    const GAS f32x4* p = (const GAS f32x4*)(ssp + tok * 16); const f32x4 a = p[0], b = p[1], c = p[2], d = p[3];
    const float ss = ((a.x + a.y) + (a.z + a.w)) + ((b.x + b.y) + (b.z + b.w)) + ((c.x + c.y) + (c.z + c.w)) + ((d.x + d.y) + (d.z + d.w));
    return 1.0f / sqrtf(ss * (1.f / 1024.f) + EPS);
}
__device__ __forceinline__ void sort16_desc(unsigned (&a)[16]) {
#pragma unroll
    for (int k = 2; k <= 16; k <<= 1)
#pragma unroll
        for (int j = k >> 1; j > 0; j >>= 1)
#pragma unroll
            for (int i = 0; i < 16; ++i) { const int l = i ^ j; if (l > i) { const unsigned hi = a[i] > a[l] ? a[i] : a[l], lo = a[i] > a[l] ? a[l] : a[i];
                if ((i & k) == 0) { a[i] = hi; a[l] = lo; } else { a[i] = lo; a[l] = hi; } } }
}
__device__ __forceinline__ void merge16_desc(unsigned (&top)[16], const unsigned (&a)[16]) {
#pragma unroll
    for (int i = 0; i < 16; ++i) top[i] = top[i] > a[15 - i] ? top[i] : a[15 - i];
#pragma unroll
    for (int j = 8; j > 0; j >>= 1)
#pragma unroll
        for (int i = 0; i < 16; ++i) { const int l = i ^ j; if (l > i) { const unsigned hi = top[i] > top[l] ? top[i] : top[l], lo = top[i] > top[l] ? top[l] : top[i]; top[i] = hi; top[l] = lo; } }
}
struct PairTab { int i[64], j[64]; };
constexpr PairTab make_pairs() { PairTab t{}; int n = 0; for (int i = 0; i < 16; ++i) for (int j = 0; j < 16; ++j) if ((i + 1) * (j + 1) <= 16) { t.i[n] = i; t.j[n] = j; ++n; } for (; n < 64; ++n) { t.i[n] = -1; t.j[n] = -1; } return t; }
__device__ __forceinline__ void route_task(Frame& F, const Args& AR, int tt, int h) {
    const int lane = F.lane, l31 = lane & 31, h2 = lane >> 5;
    const size_t tok = (size_t)tt * 32 + l31;
    LAS unsigned* lk = (LAS unsigned*)F.lds;
    unsigned KA[16], KB[16];
#pragma unroll
    for (int i = 0; i < 16; ++i) { KA[i] = 0u; KB[i] = 0u; }
#pragma unroll 1
    for (int p = 0; p < 2; ++p) {
        const int hp = 2 * h + p;
        bf16x8 bq[4];
        { const bf16* qp = ((const bf16*)(F.ws + WS_SUBK)) + tok * 1024 + hp * 64 + h2 * 8;
#pragma unroll
          for (int st = 0; st < 4; ++st) bq[st] = *(const GAS bf16x8*)(qp + st * 16); }
        unsigned top[16];
#pragma unroll
        for (int i = 0; i < 16; ++i) top[i] = 0u;
#pragma unroll 1
        for (int blk = 0; blk < 4; ++blk) {
            const bf16* ap = ((const bf16*)(F.ws + WS_SKB)) + (size_t)(hp * 128 + 32 * blk + l31) * 64 + h2 * 8;
            f32x16 acc;
#pragma unroll
            for (int r = 0; r < 16; ++r) acc[r] = 0.f;
#pragma unroll
            for (int st = 0; st < 4; ++st) { const bf16x8 af = *(const GAS bf16x8*)(ap + st * 16); acc = __builtin_amdgcn_mfma_f32_32x32x16_bf16(af, bq[st], acc, 0, 0, 0); }
            unsigned a16[16];
#pragma unroll
            for (int r = 0; r < 16; ++r) a16[r] = (ordk(acc[r]) & ~127u) | (unsigned)(127 - (32 * blk + (r & 3) + 8 * (r >> 2)) - 4 * h2);
            sort16_desc(a16);
            merge16_desc(top, a16);
        }
        unsigned oth[16];
#pragma unroll
        for (int i = 0; i < 16; ++i) oth[i] = __shfl_xor(top[i], 32);
        merge16_desc(top, oth);
#pragma unroll
        for (int i = 0; i < 16; ++i) { if (p == 0) KA[i] = top[i]; else KB[i] = top[i]; }
    }
    float sa[16], sb[16];
#pragma unroll
    for (int i = 0; i < 16; ++i) { sa[i] = unordk(KA[i] & ~127u); sb[i] = unordk(KB[i] & ~127u); lk[i * 512 + F.tid] = KA[i]; lk[(16 + i) * 512 + F.tid] = KB[i]; }
    unsigned ck[16];
#pragma unroll
    for (int grp = 0; grp < 4; ++grp) {
        unsigned a[16];
#pragma unroll
        for (int q = 0; q < 16; ++q) { constexpr PairTab T = make_pairs(); const int pi = T.i[grp * 16 + q], pj = T.j[grp * 16 + q];
            a[q] = (pi < 0) ? 0u : ((ordk(sa[pi < 0 ? 0 : pi] + sb[pj < 0 ? 0 : pj]) & ~255u) | (unsigned)(255 - (pi * 16 + pj))); }
        sort16_desc(a);
        if (grp == 0) {
#pragma unroll
            for (int i = 0; i < 16; ++i) ck[i] = a[i];
        } else merge16_desc(ck, a);
    }
    LDS_WAIT(); asm volatile("" ::: "memory");
    unsigned ce[16];
#pragma unroll
    for (int t = 0; t < 16; ++t) { const unsigned flat = 255u - (ck[t] & 255u); const unsigned ka = lk[(flat >> 4) * 512 + F.tid], kb = lk[(16u + (flat & 15u)) * 512 + F.tid];
        ce[t] = (127u - (ka & 127u)) * 128u + (127u - (kb & 127u)); }
    LDS_WAIT(); asm volatile("" ::: "memory");
    float ts[16]; float sum = 0.f; const float mx = unordk(ck[0] & ~255u);
    const float rsl = row_rs((const float*)(F.ws + WS_SSP), tok) * 1.4426950408889634f;
#pragma unroll
    for (int t = 0; t < 16; ++t) { ts[t] = __builtin_amdgcn_exp2f((unordk(ck[t] & ~255u) - mx) * rsl); sum += ts[t]; }
    const float inv = 1.0f / sum;
    if (h2 == 0) {
        GAS v4u* eo = (GAS v4u*)(((unsigned short*)(F.ws + WS_REXP)) + tok * 128 + h * 16); GAS f32x4* go = (GAS f32x4*)(((float*)(F.ws + WS_RG)) + tok * 128 + h * 16);
        eo[0] = (v4u){ce[0] | (ce[1] << 16), ce[2] | (ce[3] << 16), ce[4] | (ce[5] << 16), ce[6] | (ce[7] << 16)};
        eo[1] = (v4u){ce[8] | (ce[9] << 16), ce[10] | (ce[11] << 16), ce[12] | (ce[13] << 16), ce[14] | (ce[15] << 16)};
#pragma unroll
        for (int t4 = 0; t4 < 4; ++t4) go[t4] = (f32x4){ts[4 * t4] * inv, ts[4 * t4 + 1] * inv, ts[4 * t4 + 2] * inv, ts[4 * t4 + 3] * inv};
    }
}

__device__ __forceinline__ float gelu_erf(float v) {
    const float av = fabsf(v), t = __builtin_amdgcn_rcpf(av * 0.2316418882f + 1.0f);
    float q = t * 0.5307027145f + (-0.7265760135f); q = q * t + 0.7107068705f; q = q * t + (-0.142248368f); q = q * t + 0.127414796f; q = q * t;
    const float e = __builtin_amdgcn_exp2f((v * v) * (-0.72134752044f));
    const float m = v * (q * e);
    return v < 0.f ? m : v - m;
}
__device__ __forceinline__ float dpp_add(float v, float w_unused) { return v; }
#define DPP_ADD(v, ctrl) ((v) + __builtin_bit_cast(float, __builtin_amdgcn_update_dpp(0, __builtin_bit_cast(int, (v)), (ctrl), 0xf, 0xf, true)))
#define DPP_MAX(v, ctrl) fmaxf((v), __builtin_bit_cast(float, __builtin_amdgcn_update_dpp(0, __builtin_bit_cast(int, (v)), (ctrl), 0xf, 0xf, true)))
#define DPP_ADDI(v, ctrl) ((v) + __builtin_amdgcn_update_dpp(0, (v), (ctrl), 0xf, 0xf, true))
constexpr int NSL = 8;
constexpr int CW_PEER = 8192;
typedef float f32x2v __attribute__((ext_vector_type(2)));
__device__ __forceinline__ unsigned id_of(const v4u a, const v4u b, int m) { const unsigned w = (m < 8) ? a[(m & 7) >> 1] : b[(m & 7) >> 1]; return (m & 1) ? (w >> 16) : (w & 0xffffu); }
__device__ __forceinline__ void load_hn2(const bf16* p, f32x2v (&hn2)[8]) { const v4u a = *(const GAS v4u*)p, b = *(const GAS v4u*)(p + 8);
    hn2[0] = (f32x2v){bflo(a.x), bfhi(a.x)}; hn2[1] = (f32x2v){bflo(a.y), bfhi(a.y)}; hn2[2] = (f32x2v){bflo(a.z), bfhi(a.z)}; hn2[3] = (f32x2v){bflo(a.w), bfhi(a.w)};
    hn2[4] = (f32x2v){bflo(b.x), bfhi(b.x)}; hn2[5] = (f32x2v){bflo(b.y), bfhi(b.y)}; hn2[6] = (f32x2v){bflo(b.z), bfhi(b.z)}; hn2[7] = (f32x2v){bflo(b.w), bfhi(b.w)}; }
template <int SIDE> __device__ __forceinline__ void peer_item8(Frame& F, const Args& AR, int s, size_t t0, unsigned idmask = 0xffffu) {
    const int lane = F.lane, ts = lane >> 3, c = lane & 7;
    const size_t tok = t0 + ts;
    const unsigned char* tbase = ((const unsigned char*)(F.ws + (SIDE == 0 ? WS_U16 : WS_V16))) + ((size_t)s << 21);
    const unsigned lo = 16u * (unsigned)c;
    const GAS v4u* idq = (const GAS v4u*)(((const unsigned short*)(F.ws + WS_REXP)) + tok * 128);
    v4u ia = idq[0], ib = idq[1];
    if (SIDE == 0) {
        int hq[4]; float dq;
        { const bf16* hp = ((const bf16*)(F.ws + WS_HG)) + tok * 1024 + 128 * s + 16 * c; const v4u a = *(const GAS v4u*)hp, b2 = *(const GAS v4u*)(hp + 8);
          float x[16]; x[0] = bflo(a.x); x[1] = bfhi(a.x); x[2] = bflo(a.y); x[3] = bfhi(a.y); x[4] = bflo(a.z); x[5] = bfhi(a.z); x[6] = bflo(a.w); x[7] = bfhi(a.w);
          x[8] = bflo(b2.x); x[9] = bfhi(b2.x); x[10] = bflo(b2.y); x[11] = bfhi(b2.y); x[12] = bflo(b2.z); x[13] = bfhi(b2.z); x[14] = bflo(b2.w); x[15] = bfhi(b2.w);
          float am = 1e-30f;
#pragma unroll
          for (int i = 0; i < 16; ++i) am = fmaxf(am, fabsf(x[i]));
          am = DPP_MAX(am, 0xB1); am = DPP_MAX(am, 0x4E); am = DPP_MAX(am, 0x141);
          const float qs = 127.0f * __builtin_amdgcn_rcpf(am) * 0.99999f; dq = am * (1.0f / (127.0f * 0.99999f));
#pragma unroll
          for (int q = 0; q < 4; ++q) { unsigned bt[4];
#pragma unroll
              for (int i = 0; i < 4; ++i) bt[i] = __float_as_uint(x[4 * q + i] * qs + 12582912.0f);
              hq[q] = (int)(__builtin_amdgcn_perm(bt[1], bt[0], 0x0c0c0400u) | __builtin_amdgcn_perm(bt[3], bt[2], 0x04000c0cu)); } }
        bf16* po = ((bf16*)(F.ws + WS_SUBK)) + (tok * NSL + s) * 128;
#pragma unroll 1
        for (int b = 0; b < 8; ++b) {
            v4u r[16];
#pragma unroll
            for (int m = 0; m < 16; ++m) r[m] = *(const GAS v4u*)(tbase + (size_t)(((id_of(ia, ib, m) & idmask) << 7) + lo));
            const int bn = (b + 1) & 7; ia = idq[2 * bn]; ib = idq[2 * bn + 1];
            float d[16];
#pragma unroll
            for (int m = 0; m < 16; ++m) { int acc = 0;
#pragma unroll
                for (int q = 0; q < 4; ++q) acc = __builtin_amdgcn_sdot4((int)r[m][q], hq[q], acc, false);
                acc = DPP_ADDI(acc, 0xB1); acc = DPP_ADDI(acc, 0x4E); acc = DPP_ADDI(acc, 0x141); d[m] = (float)acc * dq; }
            if (c == 0) { GAS v4u* pq = (GAS v4u*)(po + 16 * b);
                pq[0] = (v4u){pk2(d[0], d[1]), pk2(d[2], d[3]), pk2(d[4], d[5]), pk2(d[6], d[7])}; pq[1] = (v4u){pk2(d[8], d[9]), pk2(d[10], d[11]), pk2(d[12], d[13]), pk2(d[14], d[15])}; }
        }
    } else {
        const GAS f32x4* cfq = (const GAS f32x4*)(((const float*)(F.ws + WS_RG)) + tok * 128);
        f32x4 cf[4];
#pragma unroll
        for (int q = 0; q < 4; ++q) cf[q] = cfq[q];
        f32x2v acc[8];
#pragma unroll
        for (int j = 0; j < 8; ++j) acc[j] = (f32x2v){0.f, 0.f};
#pragma unroll 1
        for (int b = 0; b < 8; ++b) {
            v4u r[16];
#pragma unroll
            for (int m = 0; m < 16; ++m) r[m] = *(const GAS v4u*)(tbase + (size_t)(((id_of(ia, ib, m) & idmask) << 7) + lo));
            const int bn = (b + 1) & 7; ia = idq[2 * bn]; ib = idq[2 * bn + 1];
            f32x4 cn[4];
#pragma unroll
            for (int q = 0; q < 4; ++q) cn[q] = cfq[4 * bn + q];
#pragma unroll
            for (int m = 0; m < 16; ++m) { const float cm = cf[m >> 2][m & 3]; const f32x2v c2 = {cm, cm};
#pragma unroll
                for (int q = 0; q < 4; ++q) { const int w = (int)r[m][q]; acc[2 * q] = __builtin_amdgcn_cvt_pk_f32_fp8(w, false) * c2 + acc[2 * q]; acc[2 * q + 1] = __builtin_amdgcn_cvt_pk_f32_fp8(w, true) * c2 + acc[2 * q + 1]; } }
#pragma unroll
            for (int q = 0; q < 4; ++q) cf[q] = cn[q];
        }
        GAS f32x4* op = (GAS f32x4*)((AR.out) + tok * 1024 + 128 * s + 16 * c);
#pragma unroll
        for (int q = 0; q < 4; ++q) { f32x4 h = op[q]; h.x += acc[2 * q].x; h.y += acc[2 * q].y; h.z += acc[2 * q + 1].x; h.w += acc[2 * q + 1].y; op[q] = h; }
    }
}
__device__ __forceinline__ void quant_hn16(const bf16* hp, int (&hq)[4], float& dq) {
    const v4u a = *(const GAS v4u*)hp, b2 = *(const GAS v4u*)(hp + 8);
    float x[16]; x[0] = bflo(a.x); x[1] = bfhi(a.x); x[2] = bflo(a.y); x[3] = bfhi(a.y); x[4] = bflo(a.z); x[5] = bfhi(a.z); x[6] = bflo(a.w); x[7] = bfhi(a.w);
    x[8] = bflo(b2.x); x[9] = bfhi(b2.x); x[10] = bflo(b2.y); x[11] = bfhi(b2.y); x[12] = bflo(b2.z); x[13] = bfhi(b2.z); x[14] = bflo(b2.w); x[15] = bfhi(b2.w);
    float am = 1e-30f;
#pragma unroll
    for (int i = 0; i < 16; ++i) am = fmaxf(am, fabsf(x[i]));
    am = DPP_MAX(am, 0xB1); am = DPP_MAX(am, 0x4E); am = DPP_MAX(am, 0x141);
    const float qs = 127.0f * __builtin_amdgcn_rcpf(am) * 0.99999f; dq = am * (1.0f / (127.0f * 0.99999f));
#pragma unroll
    for (int q = 0; q < 4; ++q) { unsigned bt[4];
#pragma unroll
        for (int i = 0; i < 4; ++i) bt[i] = __float_as_uint(x[4 * q + i] * qs + 12582912.0f);
        hq[q] = (int)(__builtin_amdgcn_perm(bt[1], bt[0], 0x0c0c0400u) | __builtin_amdgcn_perm(bt[3], bt[2], 0x04000c0cu)); }
}
__device__ __forceinline__ void peer_u16(Frame& F, int s, size_t t0) {
    const int lane = F.lane, ts = lane >> 3, c = lane & 7;
    const size_t tok = t0 + ts;
    const unsigned char* tbase = ((const unsigned char*)(F.ws + WS_U16)) + ((size_t)s << 21);
    const unsigned lo = 16u * (unsigned)c;
    const GAS v4u* idq = (const GAS v4u*)(((const unsigned short*)(F.ws + WS_REXP)) + tok * 128);
    int hq0[4], hq1[4]; float dq0, dq1;
    quant_hn16(((const bf16*)(F.ws + WS_HG)) + tok * 1024 + 128 * s + 16 * c, hq0, dq0);
    quant_hn16(((const bf16*)(F.ws + WS_HG)) + (tok + 8) * 1024 + 128 * s + 16 * c, hq1, dq1);
    bf16* po = ((bf16*)(F.ws + WS_SUBK)) + (tok * NSL + s) * 128;
    v4u ia, ib;
    v4u r[16];
    { const v4u i0 = idq[0], i1 = idq[1]; ia = idq[2]; ib = idq[3];
      asm volatile("" :: "v"(ia), "v"(ib));
#pragma unroll
      for (int m = 0; m < 16; ++m) r[m] = *(const GAS v4u*)(tbase + (size_t)((id_of(i0, i1, m) << 7) + lo)); }
#pragma unroll 1
    for (int j = 0; j < 15; ++j) {
        const bool g1 = j >= 8;
        v4u na, nb; { const int jn = (j + 2 < 16) ? j + 2 : 15; const GAS v4u* ip = idq + ((jn >> 3) * 128 + 2 * (jn & 7)); na = ip[0]; nb = ip[1]; }
        int hq[4];
#pragma unroll
        for (int q = 0; q < 4; ++q) hq[q] = g1 ? hq1[q] : hq0[q];
        const float dq = g1 ? dq1 : dq0;
        float d[16];
#pragma unroll
        for (int m = 0; m < 16; ++m) { int acc = 0;
#pragma unroll
            for (int q = 0; q < 4; ++q) acc = __builtin_amdgcn_sdot4((int)r[m][q], hq[q], acc, false);
            r[m] = *(const GAS v4u*)(tbase + (size_t)((id_of(ia, ib, m) << 7) + lo));
            acc = DPP_ADDI(acc, 0xB1); acc = DPP_ADDI(acc, 0x4E); acc = DPP_ADDI(acc, 0x141); d[m] = (float)acc * dq; }
        ia = na; ib = nb;
        if (c == 0) { GAS v4u* pq = (GAS v4u*)(po + (j >> 3) * (8 * NSL * 128) + 16 * (j & 7));
            pq[0] = (v4u){pk2(d[0], d[1]), pk2(d[2], d[3]), pk2(d[4], d[5]), pk2(d[6], d[7])}; pq[1] = (v4u){pk2(d[8], d[9]), pk2(d[10], d[11]), pk2(d[12], d[13]), pk2(d[14], d[15])}; }
    }
    { float d[16];
#pragma unroll
        for (int m = 0; m < 16; ++m) { int acc = 0;
#pragma unroll
            for (int q = 0; q < 4; ++q) acc = __builtin_amdgcn_sdot4((int)r[m][q], hq1[q], acc, false);
            acc = DPP_ADDI(acc, 0xB1); acc = DPP_ADDI(acc, 0x4E); acc = DPP_ADDI(acc, 0x141); d[m] = (float)acc * dq1; }
        if (c == 0) { GAS v4u* pq = (GAS v4u*)(po + (8 * NSL * 128) + 16 * 7);
            pq[0] = (v4u){pk2(d[0], d[1]), pk2(d[2], d[3]), pk2(d[4], d[5]), pk2(d[6], d[7])}; pq[1] = (v4u){pk2(d[8], d[9]), pk2(d[10], d[11]), pk2(d[12], d[13]), pk2(d[14], d[15])}; } }
}
template <int SIDE> __device__ __forceinline__ void peer_side(Frame& F, const Args& AR, int rep = 0) {
    gu32* cnt = F.ctl + CW_PEER + (SIDE + 2 * rep) * 16 * 64;
    LAS int* sh = (LAS int*)F.lds;
    const unsigned xcc = xb_xcc_id() & 7u;
#pragma unroll 1
    for (int k = 0; k < NSL; ++k) {
        const int s = (int)((xcc + (unsigned)k) & (unsigned)(NSL - 1));
#pragma unroll 1
        for (;;) {
            __syncthreads();
            if (F.tid == 0) sh[0] = (int)__hip_atomic_fetch_add(cnt + 64 * s, 1u, RLX_AGENT);
            __syncthreads();
            const int blk = sh[0];
            if (blk >= MTOK / 128) break;
            const size_t t0 = (size_t)blk * 128 + F.wave * 16;
            if (SIDE == 0) peer_u16(F, s, t0); else { peer_item8<1>(F, AR, s, t0); peer_item8<1>(F, AR, s, t0 + 8); }
        }
    }
}
__device__ __forceinline__ void peer_coef_token(Frame& F, size_t tok, float inv_su, float inv_sv) {
    const int lane = F.lane;
    const unsigned short* pp = ((const unsigned short*)(F.ws + WS_SUBK)) + tok * NSL * 128;
    float a0 = 0.f, a1 = 0.f;
#pragma unroll
    for (int s = 0; s < NSL; ++s) { a0 += __uint_as_float((unsigned)pp[s * 128 + lane] << 16); a1 += __uint_as_float((unsigned)pp[s * 128 + 64 + lane] << 16); }
    float* gp = ((float*)(F.ws + WS_RG)) + tok * 128;
    const float sc = inv_su * row_rs((const float*)(F.ws + WS_SSP), tok);
    gp[lane] = gp[lane] * gelu_erf(a0 * sc) * inv_sv; gp[64 + lane] = gp[64 + lane] * gelu_erf(a1 * sc) * inv_sv;
}

__global__ void __launch_bounds__(NWAVES * 64, 2) mk_fwd(Args args) {
    extern __shared__ __attribute__((aligned(16))) unsigned char lds[];
    Frame F;
    F.lds = (LAS unsigned char*)lds;
    F.MISC = (volatile LAS unsigned*)(F.lds + MISC_OFF);
    F.tid = threadIdx.x; F.lane = F.tid & 63; F.wave = __builtin_amdgcn_readfirstlane(F.tid >> 6);
    F.G = gridDim.x; { const int bx = blockIdx.x; F.vcu = (F.G % 8 == 0) ? (bx % 8) * (F.G / 8) + bx / 8 : bx; }
    F.ws = args.ws;
    F.ctl = (gu32*)(F.ws + WS_CTL);
    const Args& AR = args;
    for (int u = F.tid; u < (LDS_BYTES - LDSCTL_OFF) / 4; u += NWAVES * 64) ((LAS unsigned*)(F.lds + LDSCTL_OFF))[u] = 0u;
    __syncthreads();
    XcdBarrier bar; bar.bar = (unsigned*)(F.ctl + CW_BAR); bar.x = 0; bar.st = nullptr;
#if !MK_PER_PHASE
    bar = xcd_barrier_post((unsigned*)(F.ctl + CW_BAR), F.MISC + 8);
#endif
    unsigned long long tacc_ = 0ull; unsigned tcnt_ = 0u;
    const unsigned long long tk0c_ = (PROBE_SEC == 10) ? __builtin_amdgcn_s_memtime() : 0ull, tk0r_ = (PROBE_SEC == 10) ? __builtin_amdgcn_s_memrealtime() : 0ull;
    const int lo = args.ph_lo, hi = args.ph_hi;
#if defined(ONLY_PHASE)
#define IN(k) ((k) == ONLY_PHASE && lo <= (k) && (k) < hi)
#elif defined(PHASE_MASK)
#define IN(k) (((PHASE_MASK >> (k)) & 1) && lo <= (k) && (k) < hi)
#else
#define IN(k) (lo <= (k) && (k) < hi)
#endif
#if MK_PER_PHASE
#define SEAM(k) do { } while (0)
#else
#define SEAM(k) do { if (IN(k) && IN((k) + 1)) xcd_barrier(bar); } while (0)
#endif
#define FRESH() Frame P = F; { int t_ = threadIdx.x; asm volatile("" : "+v"(t_)); P.tid = t_; P.lane = t_ & 63; P.wave = __builtin_amdgcn_readfirstlane(t_ >> 6); } const int gw = P.vcu * NWAVES + P.wave, NGW = P.G * NWAVES; (void)gw; (void)NGW

    for (int rep_ = 0; rep_ < (((REPEAT_MASK >> 0) & 1) ? 2 : 1); ++rep_) if (IN(0)) { FRESH(); p0_prologue(P, args); } SEAM(0);
    const unsigned long long tq0c_ = (PROBE_SEC == 12) ? __builtin_amdgcn_s_memtime() : 0ull, tq0r_ = (PROBE_SEC == 12) ? __builtin_amdgcn_s_memrealtime() : 0ull;
    for (int rep_ = 0; rep_ < (((REPEAT_MASK >> 1) & 1) ? 2 : 1); ++rep_) if (IN(1)) { pg8::Gemm g{((bf16*)(F.ws + WS_ACT)), ((bf16*)(F.ws + WS_WIN)), MTOK, LDP, 1024, 1024, 1024}; pg8::StaticOrder S; S.init(MTOK, LDP, F.G, (int)blockIdx.x);
        pg8::EpiStoreBf16 E{((bf16*)(F.ws + WS_PROJ)), LDP};
        pg8::gemm_phase<pg8::EpiStoreBf16, pg8::StaticOrder, true, true>(F.lds, g, S, E); } SEAM(1);
    if (PROBE_SEC == 12) { const unsigned long long dc = __builtin_amdgcn_s_memtime() - tq0c_, dr = __builtin_amdgcn_s_memrealtime() - tq0r_; tacc_ = dc * 100ull / (dr ? dr : 1ull); tcnt_ = 1u; }
    if (IN(2)) { FRESH(); for (int m = gw; m < MTOK; m += NGW) fixup_token(P, args, m);
        for (int r0 = gw * 32; r0 < MTOK; r0 += NGW * 32) pool_run(P, r0, 32);
        const float su = i8_scale(__hip_atomic_load(P.ctl + CW_AMAX, RLX_AGENT)), sv = fp8_scale(__hip_atomic_load(P.ctl + CW_AMAX + 1, RLX_AGENT));
#pragma unroll 4
        for (int r = gw; r < 2 * 16384; r += NGW) { const int rr = r & 16383;
            if (r < 16384) row_to_i8(args.in[13] + (size_t)rr * 1024, (unsigned char*)(P.ws + WS_U16) + (size_t)rr * 128, su, P.lane);
            else row_to_fp8(args.in[14] + (size_t)rr * 1024, (unsigned char*)(P.ws + WS_V16) + (size_t)rr * 128, sv, P.lane); } } SEAM(2);
    for (int rep_ = 0; rep_ < (((REPEAT_MASK >> 3) & 1) ? 2 : 1); ++rep_) if (IN(3)) { FRESH(); for (int i = P.vcu; i < 256; i += P.G) { const int b = i >> 4, s = i & 15;
#pragma unroll 1
            for (int k = 0; k < 4; ++k) idx_unit(P, args, b, (k == 0) ? s : (k == 1) ? 31 - s : (k == 2) ? 32 + s : 63 - s, tacc_, tcnt_, PROBE_NOSEL ? (rep_ == 1) : true); } } SEAM(3);
    const unsigned long long tp4_ = (PROBE_SEC == 5 || PROBE_SEC == 6 || PROBE_SEC == 7) ? ((PROBE_SEC != 6) ? __builtin_amdgcn_s_memtime() : __builtin_amdgcn_s_memrealtime()) : 0ull;
    for (int rep_ = 0; rep_ < (((REPEAT_MASK >> 4) & 1) ? 2 : 1); ++rep_) if (IN(4)) { FRESH(); for (int i = P.vcu; i < 256; i += P.G) { const int bh = i >> 1, s = i & 1, b = bh >> 3, h = bh & 7;
#pragma unroll 1
            for (int k = 0; k < 8; ++k) attn_unit(P, args, b, h, (k & 1) ? 15 - (k >> 1) * 2 - s : (k >> 1) * 2 + s, tacc_, tcnt_); }
        if (PROBE_SEC == 7) { tacc_ = (__builtin_amdgcn_s_memtime() - tp4_) / 1000ull; tcnt_ = 1u; } } SEAM(4);
    if (PROBE_SEC == 5) { tacc_ = (__builtin_amdgcn_s_memtime() - tp4_) / 1000ull; tcnt_ = 1u; }
    if (PROBE_SEC == 6) { tacc_ = (__builtin_amdgcn_s_memrealtime() - tp4_) / 10ull; tcnt_ = 1u; }
    for (int rep_ = 0; rep_ < (((REPEAT_MASK >> 5) & 1) ? 2 : 1); ++rep_) if (IN(5)) { pg8::Gemm g{((bf16*)(F.ws + WS_AO)), ((bf16*)(F.ws + WS_WA)), MTOK, 1024, 512, 512, 512}; pg8::StaticOrder S; S.init(MTOK, 1024, F.G, (int)blockIdx.x);
        pg8::EpiGate<false> E{((bf16*)(F.ws + WS_ACT)), 1024, ((bf16*)(F.ws + WS_PROJ)) + GA_OFF, LDP};
        pg8::gemm_phase<pg8::EpiGate<false>, pg8::StaticOrder, true, true>(F.lds, g, S, E); }
    if (IN(6)) { pg8::Gemm g{((bf16*)(F.ws + WS_POOLED)), ((bf16*)(F.ws + WS_WPP)), MTOK, 1024, 512, 512, 512}; pg8::StaticOrder S; S.init(MTOK, 1024, F.G, (int)blockIdx.x);
                pg8::EpiGate<true> E{((bf16*)(F.ws + WS_ACT)), 1024, ((bf16*)(F.ws + WS_PROJ)) + GP_OFF, LDP};
        pg8::gemm_phase<pg8::EpiGate<true>, pg8::StaticOrder, true, true>(F.lds, g, S, E); } SEAM(6);
    for (int rep_ = 0; rep_ < (((REPEAT_MASK >> 7) & 1) ? 2 : 1); ++rep_) if (IN(7)) { pg8::Gemm g{((bf16*)(F.ws + WS_ACT)), ((bf16*)(F.ws + WS_WO)), MTOK, 1024, 1024, 1024, 1024}; pg8::StaticOrder S; S.init(MTOK, 1024, F.G, (int)blockIdx.x);
        pg8::EpiResHG E{(AR.in[0]), (AR.out), ((bf16*)(F.ws + WS_HG)), (AR.in[10]), ((float*)(F.ws + WS_SSP)), 1024};
        pg8::gemm_phase<pg8::EpiResHG, pg8::StaticOrder, true, true>(F.lds, g, S, E); } SEAM(7);

    for (int rep_ = 0; rep_ < (((REPEAT_MASK >> 9) & 1) ? 2 : 1); ++rep_) if (IN(9)) { pg8::Gemm g{((bf16*)(F.ws + WS_HG)), ((bf16*)(F.ws + WS_W2)), MTOK, 1024, 1024, 1024, 1024}; pg8::StaticOrder S; S.init(MTOK, 1024, F.G, (int)blockIdx.x);
        pg8::EpiStoreBf16 E{((bf16*)(F.ws + WS_SUBK)), 1024};
        pg8::gemm_phase<pg8::EpiStoreBf16, pg8::StaticOrder, true, true>(F.lds, g, S, E); } SEAM(9);
    for (int rep_ = 0; rep_ < (((REPEAT_MASK >> 10) & 1) ? 2 : 1); ++rep_) if (IN(10)) { FRESH(); for (int tt = P.vcu; tt < MTOK / 32; tt += P.G) route_task(P, args, tt, P.wave); } SEAM(10);
        const unsigned long long tg0c_ = (PROBE_SEC == 11) ? __builtin_amdgcn_s_memtime() : 0ull, tg0r_ = (PROBE_SEC == 11) ? __builtin_amdgcn_s_memrealtime() : 0ull;
    for (int rep_ = 0; rep_ < (((REPEAT_MASK >> 11) & 1) ? 2 : 1); ++rep_) if (IN(11)) { FRESH(); peer_side<0>(P, args, rep_); } SEAM(11);
    if (IN(12)) { FRESH(); const float iu = i8_inv_scale(__hip_atomic_load(P.ctl + CW_AMAX, RLX_AGENT)), iv = fp8_inv_scale(__hip_atomic_load(P.ctl + CW_AMAX + 1, RLX_AGENT));
        for (int m = gw; m < MTOK; m += NGW) peer_coef_token(P, (size_t)m, iu, iv); } SEAM(12);
    if (IN(13)) { FRESH(); peer_side<1>(P, args); }
#if PROBE_SEC == 11
    { const unsigned long long dc = __builtin_amdgcn_s_memtime() - tg0c_, dr = __builtin_amdgcn_s_memrealtime() - tg0r_; tacc_ = dc * 100ull / (dr ? dr : 1ull); tcnt_ = 1u; }
#endif
#if PROBE_SEC == 10
    { const unsigned long long dc = __builtin_amdgcn_s_memtime() - tk0c_, dr = __builtin_amdgcn_s_memrealtime() - tk0r_; tacc_ = dc * 100ull / (dr ? dr : 1ull); tcnt_ = 1u; }
#endif
#if PROBE_SEC
    if (blockIdx.x == 0 && F.wave == 7) { const unsigned long long avg = tacc_ / (unsigned long long)(tcnt_ ? tcnt_ : 1u); const unsigned long long t_end = __builtin_amdgcn_s_memrealtime() + avg * 10ull;
        while (__builtin_amdgcn_s_memrealtime() < t_end) __builtin_amdgcn_s_sleep(8); }
#endif

#undef IN
#undef SEAM
}

extern "C" void kernel_launch(void* const* d_in, const int* in_sizes, int n_in, void* d_out, int out_size, void* d_ws, size_t ws_size, hipStream_t stream) {
    static int grid = 0;
    if (grid == 0) {
        if (n_in != 15 || in_sizes[0] != MTOK * DM || out_size != MTOK * DM || ws_size < WS_END) { fprintf(stderr, "kernel_launch: unexpected shapes (n_in %d, in0 %d, out %d, ws %zu < %zu)\n", n_in, n_in > 0 ? in_sizes[0] : -1, out_size, ws_size, (size_t)WS_END); grid = -1; return; }
        int dev = 0, cus = 0, per_cu = 0;
        if (hipGetDevice(&dev) != hipSuccess || hipDeviceGetAttribute(&cus, hipDeviceAttributeMultiprocessorCount, dev) != hipSuccess) { grid = -1; return; }
        if (hipFuncSetAttribute((const void*)mk_fwd, hipFuncAttributeMaxDynamicSharedMemorySize, LDS_BYTES) != hipSuccess) { fprintf(stderr, "kernel_launch: hipFuncSetAttribute failed\n"); grid = -1; return; }
        if (hipOccupancyMaxActiveBlocksPerMultiprocessor(&per_cu, (const void*)mk_fwd, NWAVES * 64, LDS_BYTES) != hipSuccess || per_cu < 1) { fprintf(stderr, "kernel_launch: occupancy query says %d blocks per CU\n", per_cu); (void)hipGetLastError(); grid = -1; return; }
        grid = cus;
    }
    if (grid < 0) return;
    if (hipMemsetAsync((char*)d_ws + WS_CTL, 0, CTL_ZERO_BYTES, stream) != hipSuccess) return;
    Args a{};
    for (int i = 0; i < 15; ++i) a.in[i] = (const float*)d_in[i];
    a.out = (float*)d_out; a.ws = (unsigned char*)d_ws;
#if MK_PER_PHASE
    for (int p = 0; p < NPHASE; ++p) { a.ph_lo = p; a.ph_hi = p + 1; hipLaunchKernelGGL(mk_fwd, dim3(grid), dim3(NWAVES * 64), LDS_BYTES, stream, a); }
#else
    a.ph_lo = 0; a.ph_hi = NPHASE;
    hipLaunchKernelGGL(mk_fwd, dim3(grid), dim3(NWAVES * 64), LDS_BYTES, stream, a);
#endif
}
```

```cpp
#include <hip/hip_runtime.h>
#include <cstdio>
#include <cstdint>
namespace pg8 {
#define PG8_LAS __attribute__((address_space(3)))
typedef unsigned short bf16_t;
typedef short bf16x8 __attribute__((ext_vector_type(8)));
typedef float f32x4 __attribute__((ext_vector_type(4)));
typedef unsigned u32x4 __attribute__((ext_vector_type(4)));
constexpr int BM = 256, BK = 64, HALF = 128, HTB = HALF * BK * 2  , STAGE_BYTES = 8 * HTB, NXCD = 8, WGM = 8;

__host__ __device__ __forceinline__ int lds_byte(int r, int c) { const int st = (r >> 4) * 2 + (c >> 5), rr = r & 15, cc = c & 31, ob = rr * 64 + cc * 2; return st * 1024 + (ob ^ (((ob >> 9) & 1) << 5)); }
__host__ __device__ __forceinline__ void stage_rc(int b, int& R, int& C) { const int st = b / 1024, sb = b % 1024, swz = sb ^ (((sb >> 9) & 1) << 5); R = (st >> 1) * 16 + swz / 64; C = (st & 1) * 32 + (swz % 64) / 2; }
__host__ __device__ __forceinline__ int perm32(int rho) { const int n = rho >> 4, i = rho & 15; return 8 * (i >> 2) + 4 * n + (i & 3); }

struct Unit { int pm, pn; };
struct Gemm { const bf16_t* A; const bf16_t* Bt; int M, N, K, lda, ldb; };

struct StaticOrder {
    int nM, nN, nwg, G, c;
    __host__ __device__ void init(int M, int N, int G_, int c_) { nM = M / BM; nN = N / BM; nwg = nM * nN; G = G_; c = c_; }
    __host__ __device__ bool next(int i, Unit& u) const {
        const long L = (long)i * G + c; if (L >= nwg) return false;
        int wgid = (int)L; { const int q = nwg / NXCD, r = nwg % NXCD, xcd = wgid % NXCD, off = wgid / NXCD; wgid = (xcd < r ? xcd * (q + 1) : r * (q + 1) + (xcd - r) * q) + off; }
        const int nig = WGM * nN, gid = wgid / nig, fm = gid * WGM, gsz = (nM - fm) < WGM ? (nM - fm) : WGM;
        u.pm = fm + ((wgid % nig) % gsz); u.pn = (wgid % nig) / gsz; return true;
    }
    __device__ __forceinline__ void a_ready(const Unit&) const {}
    __device__ __forceinline__ void done(const Unit&) const {}
};
struct PanelOrder {
    int nN, pm;
    __host__ __device__ bool next(int i, Unit& u) const { if (i >= nN) return false; u.pm = pm; u.pn = i; return true; }
    __device__ __forceinline__ void a_ready(const Unit&) const {}
    __device__ __forceinline__ void done(const Unit&) const {}
};
typedef float f32x2c_t __attribute__((ext_vector_type(2))); typedef __bf16 bf16x2c_t __attribute__((ext_vector_type(2)));
__device__ __forceinline__ unsigned cvt_pk_bf16(float lo, float hi) { f32x2c_t v = {lo, hi}; bf16x2c_t b = __builtin_convertvector(v, bf16x2c_t); return __builtin_bit_cast(unsigned, b); }
typedef float f32x2 __attribute__((ext_vector_type(2)));
__device__ __forceinline__ f32x2 gelu_pk(f32x2 v) {
    const f32x2 av = __builtin_elementwise_abs(v), d = av * 0.2316418882f + 1.0f;
    f32x2 t; t.x = __builtin_amdgcn_rcpf(d.x); t.y = __builtin_amdgcn_rcpf(d.y);
    f32x2 q = t * 0.5307027145f + (-0.7265760135f); q = q * t + 0.7107068705f; q = q * t + (-0.142248368f); q = q * t + 0.127414796f; q = q * t;
    const f32x2 s = (v * v) * (-0.72134752044f);
    f32x2 e; e.x = __builtin_amdgcn_exp2f(s.x); e.y = __builtin_amdgcn_exp2f(s.y);
    const f32x2 m = v * (q * e), r = v - m;
    f32x2 o; o.x = v.x < 0.f ? m.x : r.x; o.y = v.y < 0.f ? m.y : r.y; return o;
}
typedef unsigned u32x2e __attribute__((ext_vector_type(2)));
__device__ __forceinline__ float bf_lo(unsigned w) { return __uint_as_float(w << 16); }
__device__ __forceinline__ float bf_hi(unsigned w) { return __uint_as_float(w & 0xffff0000u); }
__device__ __forceinline__ float sigmoidf_fast(float g) { return __builtin_amdgcn_rcpf(1.0f + __builtin_amdgcn_exp2f(-1.4426950408889634f * g)); }
__device__ __forceinline__ unsigned ord_key(float f) { const unsigned b = __float_as_uint(f); return b ^ ((unsigned)((int)b >> 31) | 0x80000000u); }
__device__ __forceinline__ float unord_key(unsigned k) { return __uint_as_float((k & 0x80000000u) ? (k ^ 0x80000000u) : ~k); }

struct EpiStoreBf16 {
    static constexpr bool PERM = true, AFTER_DRAIN = false;
    bf16_t* O; int ldc;
    __device__ __forceinline__ void operator()(const f32x4 (&acc)[2][2][4][2], const Unit& u, int wr, int wc, int fr, int fq) const {
        const int row0 = u.pm * BM + wr * 64 + fr, col0 = u.pn * BM + wc * 32 + 8 * fq;
#pragma unroll
        for (int ai = 0; ai < 2; ++ai)
#pragma unroll
            for (int m = 0; m < 4; ++m) { bf16_t* rowp = O + (size_t)(row0 + ai * HALF + m * 16) * ldc + col0;
#pragma unroll
                for (int bj = 0; bj < 2; ++bj) { const f32x4 v0 = acc[ai][bj][m][0], v1 = acc[ai][bj][m][1];
                    u32x4 w; w.x = cvt_pk_bf16(v0[0], v0[1]); w.y = cvt_pk_bf16(v0[2], v0[3]); w.z = cvt_pk_bf16(v1[0], v1[1]); w.w = cvt_pk_bf16(v1[2], v1[3]);
                    *(u32x4*)(rowp + bj * HALF) = w; } }
    }
};
template <bool ADD> struct EpiGate {
    static constexpr bool PERM = true, AFTER_DRAIN = false;
    bf16_t* O; int ldc; const bf16_t* G; int ldg;
    __device__ __forceinline__ void operator()(const f32x4 (&acc)[2][2][4][2], const Unit& u, int wr, int wc, int fr, int fq) const {
        const int row0 = u.pm * BM + wr * 64 + fr, col0 = u.pn * BM + wc * 32 + 8 * fq;
#pragma unroll
        for (int ai = 0; ai < 2; ++ai)
#pragma unroll
            for (int m = 0; m < 4; ++m) { const size_t row = (size_t)(row0 + ai * HALF + m * 16);
#pragma unroll
                for (int bj = 0; bj < 2; ++bj) { const int col = col0 + bj * HALF;
                    const u32x4 gr = *(const u32x4*)(G + row * ldg + col);
                    f32x4 v0 = acc[ai][bj][m][0], v1 = acc[ai][bj][m][1];
                    v0[0] *= sigmoidf_fast(bf_lo(gr.x)); v0[1] *= sigmoidf_fast(bf_hi(gr.x)); v0[2] *= sigmoidf_fast(bf_lo(gr.y)); v0[3] *= sigmoidf_fast(bf_hi(gr.y));
                    v1[0] *= sigmoidf_fast(bf_lo(gr.z)); v1[1] *= sigmoidf_fast(bf_hi(gr.z)); v1[2] *= sigmoidf_fast(bf_lo(gr.w)); v1[3] *= sigmoidf_fast(bf_hi(gr.w));
                    bf16_t* op = O + row * ldc + col;
                    if (ADD) { const u32x4 pr = *(const u32x4*)op;
                        v0[0] += bf_lo(pr.x); v0[1] += bf_hi(pr.x); v0[2] += bf_lo(pr.y); v0[3] += bf_hi(pr.y);
                        v1[0] += bf_lo(pr.z); v1[1] += bf_hi(pr.z); v1[2] += bf_lo(pr.w); v1[3] += bf_hi(pr.w); }
                    u32x4 w; w.x = cvt_pk_bf16(v0[0], v0[1]); w.y = cvt_pk_bf16(v0[2], v0[3]); w.z = cvt_pk_bf16(v1[0], v1[1]); w.w = cvt_pk_bf16(v1[2], v1[3]);
                    *(u32x4*)op = w; } }
    }
};
struct EpiResF32 {
    static constexpr bool PERM = false, AFTER_DRAIN = false;
    const float* base; float* out; int ldc;
    __device__ __forceinline__ void operator()(const f32x4 (&acc)[2][2][4][2], const Unit& u, int wr, int wc, int fr, int fq) const {
        const int col0 = u.pn * BM + wc * 32 + 4 * fq;
#pragma unroll
        for (int ai = 0; ai < 2; ++ai)
#pragma unroll
            for (int m = 0; m < 4; ++m) { const size_t off = (size_t)(u.pm * BM + ai * HALF + wr * 64 + m * 16 + fr) * ldc + col0;
#pragma unroll
                for (int bj = 0; bj < 2; ++bj)
#pragma unroll
                    for (int n = 0; n < 2; ++n) { const f32x4 bs = *(const f32x4*)(base + off + bj * HALF + n * 16); *(f32x4*)(out + off + bj * HALF + n * 16) = bs + acc[ai][bj][m][n]; } }
    }
};
struct EpiResHG {
    static constexpr bool PERM = false, AFTER_DRAIN = false;
    const float* base; float* out; bf16_t* hg; const float* gain; float* ssp; int ldc;
    __device__ __forceinline__ void operator()(const f32x4 (&acc)[2][2][4][2], const Unit& u, int wr, int wc, int fr, int fq) const {
        const int col0 = u.pn * BM + wc * 32 + 4 * fq;
        f32x4 gv[2][2];
#pragma unroll
        for (int bj = 0; bj < 2; ++bj)
#pragma unroll
            for (int n = 0; n < 2; ++n) gv[bj][n] = *(const f32x4*)(gain + col0 + bj * HALF + n * 16);
#pragma unroll
        for (int ai = 0; ai < 2; ++ai)
#pragma unroll
            for (int m = 0; m < 4; ++m) { const int row = u.pm * BM + ai * HALF + wr * 64 + m * 16 + fr; const size_t off = (size_t)row * ldc + col0; float ss = 0.f;
#pragma unroll
                for (int bj = 0; bj < 2; ++bj)
#pragma unroll
                    for (int n = 0; n < 2; ++n) { const f32x4 h = *(const f32x4*)(base + off + bj * HALF + n * 16) + acc[ai][bj][m][n]; *(f32x4*)(out + off + bj * HALF + n * 16) = h;
                        ss += (h[0] * h[0] + h[1] * h[1]) + (h[2] * h[2] + h[3] * h[3]);
                        const f32x4 hgv = h * gv[bj][n]; u32x2e w; w.x = cvt_pk_bf16(hgv[0], hgv[1]); w.y = cvt_pk_bf16(hgv[2], hgv[3]); *(u32x2e*)(hg + off + bj * HALF + n * 16) = w; }
                ss += __shfl_xor(ss, 16); ss += __shfl_xor(ss, 32);
                if (fq == 0) ssp[(size_t)row * 16 + u.pn * 4 + wc] = ss; }
    }
};
struct EpiKeys {
    static constexpr bool PERM = false, AFTER_DRAIN = false;
    unsigned* O; int ldc;
    __device__ __forceinline__ void operator()(const f32x4 (&acc)[2][2][4][2], const Unit& u, int wr, int wc, int fr, int fq) const {
        const int col0 = u.pn * BM + wc * 32 + 4 * fq;
#pragma unroll
        for (int ai = 0; ai < 2; ++ai)
#pragma unroll
            for (int m = 0; m < 4; ++m) { const size_t off = (size_t)(u.pm * BM + ai * HALF + wr * 64 + m * 16 + fr) * ldc + col0;
#pragma unroll
                for (int bj = 0; bj < 2; ++bj)
#pragma unroll
                    for (int n = 0; n < 2; ++n) { const int nn = (col0 + bj * HALF + n * 16) & 127; const f32x4 a = acc[ai][bj][m][n]; u32x4 w;
                        w.x = (ord_key(a[0]) & ~127u) | (unsigned)(127 - nn); w.y = (ord_key(a[1]) & ~127u) | (unsigned)(126 - nn);
                        w.z = (ord_key(a[2]) & ~127u) | (unsigned)(125 - nn); w.w = (ord_key(a[3]) & ~127u) | (unsigned)(124 - nn);
                        *(u32x4*)(O + off + bj * HALF + n * 16) = w; } }
    }
};

template <class Epi, class Sched, bool ALIGN_EPI = false, bool SP2 = false>
__device__ __forceinline__ void gemm_phase(PG8_LAS unsigned char* lds, const Gemm g, const Sched& S, const Epi& E) {
    int tid_ = threadIdx.x; asm volatile("" : "+v"(tid_));
    const int tid = tid_, wid = __builtin_amdgcn_readfirstlane(tid >> 6), lane = tid & 63, wr = wid >> 2, wc = wid & 3, fr = lane & 15, fq = lane >> 4;
    const int K = g.K, nt = K / BK;
    unsigned voffA[2], voffB[2];
#pragma unroll
    for (int i = 0; i < 2; ++i) { int R, C; stage_rc(tid * 16 + i * 8192, R, C); const int Rb = Epi::PERM ? ((R & ~31) + perm32(R & 31)) : R;
        voffA[i] = (unsigned)(R * g.lda + C) * 2u; voffB[i] = (unsigned)(Rb * g.ldb + C) * 2u; }
    const size_t kstep = (size_t)(BK * 2);
    const size_t hstepA = (size_t)HALF * g.lda * 2, hstepB = (size_t)HALF * g.ldb * 2;
    const size_t tstepA = 2 * hstepA, tstepB = 2 * hstepB;
    const unsigned ldsw = (unsigned)wid * 1024u;
    const int aoff = lds_byte(wr * 64 + fr, fq * 8), boff = lds_byte(wc * 32 + fr, fq * 8);
#define PG8_SA(b, h) (((b) * 2 + (h)) * HTB)
#define PG8_SB(b, h) ((4 + (b) * 2 + (h)) * HTB)
#define PG8_STAGE(bufoff, gbase, voff) do { _Pragma("unroll") for (int _i = 0; _i < 2; ++_i) \
        __builtin_amdgcn_global_load_lds((const unsigned*)((const char*)(gbase) + (voff)[_i]), (PG8_LAS unsigned*)(lds + (bufoff) + ldsw + _i * 8192), 16, 0, 0); } while (0)
#define PG8_LDA(dst, b, h) do { _Pragma("unroll") for (int m = 0; m < 4; ++m) _Pragma("unroll") for (int k = 0; k < 2; ++k) dst[m][k] = *(const PG8_LAS bf16x8*)(lds + PG8_SA(b, h) + aoff + m * 2048 + k * 1024); } while (0)
#define PG8_LDB(dst, b, h) do { _Pragma("unroll") for (int n = 0; n < 2; ++n) _Pragma("unroll") for (int k = 0; k < 2; ++k) dst[n][k] = *(const PG8_LAS bf16x8*)(lds + PG8_SB(b, h) + boff + n * 2048 + k * 1024); } while (0)
#define PG8_MMA(ai, bj, At, Bt) do { __builtin_amdgcn_s_setprio(1); _Pragma("unroll") for (int m = 0; m < 4; ++m) _Pragma("unroll") for (int n = 0; n < 2; ++n) _Pragma("unroll") for (int k = 0; k < 2; ++k) \
        acc[ai][bj][m][n] = __builtin_amdgcn_mfma_f32_16x16x32_bf16(Bt[n][k], At[m][k], acc[ai][bj][m][n], 0, 0, 0); __builtin_amdgcn_s_setprio(0); } while (0)
#define PG8_WAIT_V(n) asm volatile("s_waitcnt vmcnt(" #n ")" ::: "memory")
#define PG8_WAIT_L(n) asm volatile("s_waitcnt lgkmcnt(" #n ")" ::: "memory")
#define PG8_BAR __builtin_amdgcn_s_barrier()
#define PG8_SCHED __builtin_amdgcn_sched_barrier(0)
    Unit cur, nxt; int ui = 0;
    if (!S.next(0, cur)) return;
    f32x4 acc[2][2][4][2];
#pragma unroll
    for (int a = 0; a < 2; ++a)
#pragma unroll
        for (int b = 0; b < 2; ++b)
#pragma unroll
            for (int m = 0; m < 4; ++m)
#pragma unroll
                for (int n = 0; n < 2; ++n) acc[a][b][m][n] = (f32x4){0.f, 0.f, 0.f, 0.f};
    bf16x8 At[4][2], B0[2][2], B1[2][2];
    const char* cA = (const char*)g.A + (size_t)cur.pm * tstepA; const char* cB = (const char*)g.Bt + (size_t)cur.pn * tstepB;
    S.a_ready(cur);
    if constexpr (SP2) {
        PG8_STAGE(PG8_SB(0, 0), cB, voffB); PG8_STAGE(PG8_SB(0, 1), cB + hstepB, voffB); PG8_STAGE(PG8_SA(0, 0), cA, voffA); PG8_STAGE(PG8_SA(0, 1), cA + hstepA, voffA);
        if (wr == 1) PG8_BAR;
        PG8_WAIT_V(2); PG8_BAR;
        PG8_STAGE(PG8_SB(1, 0), cB + kstep, voffB); PG8_STAGE(PG8_SA(1, 0), cA + kstep, voffA); PG8_STAGE(PG8_SB(1, 1), cB + hstepB + kstep, voffB);
        PG8_WAIT_V(6); PG8_BAR;
    } else {
        PG8_STAGE(PG8_SB(0, 0), cB, voffB); PG8_STAGE(PG8_SA(0, 0), cA, voffA); PG8_STAGE(PG8_SB(0, 1), cB + hstepB, voffB); PG8_STAGE(PG8_SA(0, 1), cA + hstepA, voffA);
        if (wr == 1) PG8_BAR;
        PG8_WAIT_V(4); PG8_BAR;
        PG8_STAGE(PG8_SB(1, 0), cB + kstep, voffB); PG8_STAGE(PG8_SA(1, 0), cA + kstep, voffA); PG8_STAGE(PG8_SB(1, 1), cB + hstepB + kstep, voffB);
        PG8_WAIT_V(6); PG8_BAR;
    }
    for (;;) {
        const bool has_next = S.next(ui + 1, nxt);
        const char* nA = has_next ? (const char*)g.A + (size_t)nxt.pm * tstepA : cA; const char* nB = has_next ? (const char*)g.Bt + (size_t)nxt.pn * tstepB : cB;
        for (int t = 0; t < nt; t += 2) {
            const bool last = (t == nt - 2);
            const char* a1 = cA + (size_t)(t + 1) * kstep;
            const char* a2 = last ? nA : cA + (size_t)(t + 2) * kstep; const char* b2 = last ? nB : cB + (size_t)(t + 2) * kstep;
            const char* a3 = a2 + kstep; const char* b3 = b2 + kstep;
            if (last && has_next) S.a_ready(nxt);
            if constexpr (SP2) {
            PG8_LDB(B0, 0, 0); PG8_LDB(B1, 0, 1); PG8_SCHED; PG8_LDA(At, 0, 0); PG8_STAGE(PG8_SA(1, 1), a1 + hstepA, voffA);
            PG8_WAIT_V(8); PG8_WAIT_L(0); PG8_BAR; PG8_MMA(0, 0, At, B0); PG8_MMA(0, 1, At, B1); PG8_BAR; PG8_SCHED;
            PG8_LDA(At, 0, 1); PG8_STAGE(PG8_SB(0, 0), b2, voffB); PG8_STAGE(PG8_SB(0, 1), b2 + hstepB, voffB); PG8_STAGE(PG8_SA(0, 0), a2, voffA);
            PG8_WAIT_V(8); PG8_WAIT_L(0); PG8_BAR; PG8_MMA(1, 0, At, B0); PG8_MMA(1, 1, At, B1); PG8_BAR; PG8_SCHED;
            PG8_LDB(B0, 1, 0); PG8_LDB(B1, 1, 1); PG8_SCHED; PG8_LDA(At, 1, 0); PG8_STAGE(PG8_SA(0, 1), a2 + hstepA, voffA);
            PG8_WAIT_V(8); PG8_WAIT_L(0); PG8_BAR; PG8_MMA(0, 0, At, B0); PG8_MMA(0, 1, At, B1); PG8_BAR; PG8_SCHED;
            PG8_LDA(At, 1, 1); PG8_STAGE(PG8_SB(1, 0), b3, voffB); PG8_STAGE(PG8_SB(1, 1), b3 + hstepB, voffB); PG8_STAGE(PG8_SA(1, 0), a3, voffA);
            PG8_WAIT_V(8); PG8_WAIT_L(0); PG8_BAR; PG8_MMA(1, 0, At, B0); PG8_MMA(1, 1, At, B1); PG8_BAR; PG8_SCHED;
            } else {
            PG8_LDB(B0, 0, 0); PG8_SCHED; PG8_LDA(At, 0, 0); PG8_STAGE(PG8_SA(1, 1), a1 + hstepA, voffA);
            PG8_WAIT_L(8); PG8_BAR; PG8_WAIT_L(0); PG8_MMA(0, 0, At, B0); PG8_BAR; PG8_SCHED;
            PG8_LDB(B1, 0, 1); PG8_STAGE(PG8_SB(0, 0), b2, voffB);
            PG8_BAR; PG8_WAIT_L(0); PG8_MMA(0, 1, At, B1); PG8_BAR;
            PG8_LDA(At, 0, 1); PG8_STAGE(PG8_SA(0, 0), a2, voffA);
            PG8_BAR; PG8_WAIT_L(0); PG8_MMA(1, 0, At, B0); PG8_BAR; PG8_SCHED;
            PG8_STAGE(PG8_SB(0, 1), b2 + hstepB, voffB);
            PG8_WAIT_V(6); PG8_BAR; PG8_MMA(1, 1, At, B1); PG8_BAR;
            PG8_LDB(B0, 1, 0); PG8_SCHED; PG8_LDA(At, 1, 0); PG8_STAGE(PG8_SA(0, 1), a2 + hstepA, voffA);
            PG8_WAIT_L(8); PG8_BAR; PG8_WAIT_L(0); PG8_MMA(0, 0, At, B0); PG8_BAR; PG8_SCHED;
            PG8_LDB(B1, 1, 1); PG8_STAGE(PG8_SB(1, 0), b3, voffB);
            PG8_BAR; PG8_WAIT_L(0); PG8_MMA(0, 1, At, B1); PG8_BAR;
            PG8_LDA(At, 1, 1); PG8_STAGE(PG8_SA(1, 0), a3, voffA);
            PG8_BAR; PG8_WAIT_L(0); PG8_MMA(1, 0, At, B0); PG8_BAR; PG8_SCHED;
            PG8_STAGE(PG8_SB(1, 1), b3 + hstepB, voffB);
            PG8_WAIT_V(6); PG8_BAR; PG8_MMA(1, 1, At, B1); PG8_BAR;
            }
        }
        if constexpr (ALIGN_EPI) { if (wr == 0) PG8_BAR; }
        if constexpr (!Epi::AFTER_DRAIN) { Unit ue = cur; asm volatile("" : "+s"(ue.pm), "+s"(ue.pn));
            E(acc, ue, wr, wc, fr, fq); S.done(cur); }
        if (!has_next) break;
#pragma unroll
        for (int a = 0; a < 2; ++a)
#pragma unroll
            for (int b = 0; b < 2; ++b)
#pragma unroll
                for (int m = 0; m < 4; ++m)
#pragma unroll
                    for (int n = 0; n < 2; ++n) acc[a][b][m][n] = (f32x4){0.f, 0.f, 0.f, 0.f};
        cur = nxt; cA = nA; cB = nB; ++ui;
        if constexpr (ALIGN_EPI) { if (wr == 1) PG8_BAR; }
    }
    PG8_WAIT_V(0);
    if constexpr (!ALIGN_EPI) { if (wr == 0) PG8_BAR; }
    PG8_BAR;
    if constexpr (Epi::AFTER_DRAIN) { E.fused(acc, cur, wr, wc, fr, fq, lds, wid, lane); S.done(cur); }
#undef PG8_SA
#undef PG8_SB
#undef PG8_STAGE
#undef PG8_LDA
#undef PG8_LDB
#undef PG8_MMA
#undef PG8_WAIT_V
#undef PG8_WAIT_L
#undef PG8_BAR
#undef PG8_SCHED
}
}

constexpr int NWAVES = 8;
#ifndef REPEAT_MASK
#define REPEAT_MASK 0
#endif
#ifndef PROBE_SEL2
#define PROBE_SEL2 1
#endif
#ifndef PROBE_SEC
#define PROBE_SEC 0
#endif
#ifndef PROBE_RATE
#define PROBE_RATE 0
#endif
#ifndef PROBE_FAKEID
#define PROBE_FAKEID 0
#endif
#ifndef PROBE_NOSEL
#define PROBE_NOSEL 0
#endif
#ifndef MK_PER_PHASE
#define MK_PER_PHASE 0
#endif
constexpr int NPHASE = 14;

constexpr int BATCH = 16, SEQ = 4096, DM = 1024, MTOK = BATCH * SEQ;
constexpr int LDP = 4864;
constexpr int Q_OFF = 0, K_OFF = 512, V_OFF = 1024, QI_OFF = 1536, P_OFF = 2048, GA_OFF = 2560, GP_OFF = 3584, KI_OFF = 4608, WI_OFF = 4672;
constexpr int IN_WIDTH = 4680;
constexpr float EPS = 1e-6f;
constexpr float C2 = 0.125f * 1.4426950408889634f;
constexpr float WI_SCALE = 0.35355339059327373f * 0.125f;

constexpr size_t MiB = 1u << 20;
constexpr size_t WS_CTL = 0, CTL_ZERO_BYTES = 1 * MiB;
constexpr size_t WS_ROPE = 1 * MiB;
constexpr size_t WS_WIN = 2 * MiB;
constexpr size_t WS_WA = 12 * MiB;
constexpr size_t WS_WPP = 13 * MiB;
constexpr size_t WS_WO = 14 * MiB;
constexpr size_t WS_W2 = 16 * MiB;
constexpr size_t WS_SKB = 19 * MiB;
constexpr size_t WS_U16 = 20 * MiB, WS_V16 = 52 * MiB;
constexpr size_t WS_MASK = 84 * MiB;
constexpr size_t WS_POOLED = 116 * MiB;
constexpr size_t WS_ACT = 180 * MiB;
constexpr size_t WS_PROJ = 308 * MiB;
constexpr size_t WS_AO = 916 * MiB;
constexpr size_t WS_REXP = 980 * MiB, WS_RG = 116 * MiB;
constexpr size_t WS_HG = 308 * MiB;
constexpr size_t WS_SUBK = 436 * MiB;
constexpr size_t WS_SSP = 948 * MiB;
constexpr size_t WS_END = 1024 * MiB;
constexpr int CW_TMO = 0, CW_BAR = 4096, CW_AMAX = 12288;

constexpr int RING_BYTES = 131072;
constexpr int LDSCTL_OFF = RING_BYTES, MISC_OFF = LDSCTL_OFF + 320;
constexpr int LDS_BYTES = 147456;

#define GAS __attribute__((address_space(1)))
#define LAS __attribute__((address_space(3)))
typedef unsigned short bf16;
typedef unsigned v4u __attribute__((ext_vector_type(4)));
typedef unsigned v2u __attribute__((ext_vector_type(2)));
typedef float f32x4 __attribute__((ext_vector_type(4)));
typedef float f32x16 __attribute__((ext_vector_type(16)));
typedef short bf16x8 __attribute__((ext_vector_type(8)));
typedef short s16x4 __attribute__((ext_vector_type(4)));
typedef GAS unsigned gu32;
#define RLX_AGENT __ATOMIC_RELAXED, __HIP_MEMORY_SCOPE_AGENT
#define LDS_WAIT() asm volatile("s_waitcnt lgkmcnt(0)" ::: "memory")
#define BAR_LDS() asm volatile("s_waitcnt lgkmcnt(0)\n\ts_barrier" ::: "memory")
#define VM_WAIT() asm volatile("s_waitcnt vmcnt(0)" ::: "memory")
__device__ __forceinline__ unsigned f2bf(float f) { unsigned u = __builtin_bit_cast(unsigned, f); return (u + 0x7fffu + ((u >> 16) & 1u)) >> 16; }
typedef float f32x2k_t __attribute__((ext_vector_type(2))); typedef __bf16 bf16x2k_t __attribute__((ext_vector_type(2)));
__device__ __forceinline__ unsigned pk2(float lo, float hi) { f32x2k_t v = {lo, hi}; bf16x2k_t b = __builtin_convertvector(v, bf16x2k_t); return __builtin_bit_cast(unsigned, b); }
__device__ __forceinline__ float bflo(unsigned w) { return __uint_as_float(w << 16); }
__device__ __forceinline__ float bfhi(unsigned w) { return __uint_as_float(w & 0xffff0000u); }
__device__ __forceinline__ unsigned ordk(float f) { const unsigned b = __float_as_uint(f); return b ^ ((unsigned)((int)b >> 31) | 0x80000000u); }
__device__ __forceinline__ float unordk(unsigned k) { return __uint_as_float((k & 0x80000000u) ? (k ^ 0x80000000u) : ~k); }
__device__ __forceinline__ float relu_i(float x) { const int i = __float_as_int(x); return __int_as_float(i > 0 ? i : 0); }
__device__ __forceinline__ int crow(int r, int hi) { return (r & 3) + 8 * (r >> 2) + 4 * hi; }
typedef __bf16 bf16x2v_t __attribute__((ext_vector_type(2)));
__device__ __forceinline__ float dot2bf(unsigned a, unsigned b, float acc) { return __builtin_amdgcn_fdot2_f32_bf16(__builtin_bit_cast(bf16x2v_t, a), __builtin_bit_cast(bf16x2v_t, b), acc, false); }

#define XB_TMO      128
#define XB_XCNT(j)  (256  + 64 * (j))
#define XB_XSUB(j)  (1280 + 64 * (j))
#define XB_XGEN(j)  (2304 + 64 * (j))
#define XB_TOP      3328
#define XB_TOPGEN   3392
#define XCD_BAR_WORDS 3456
#define XB_SPIN_CAP (1u << 18)

__device__ __forceinline__ unsigned xb_ld(unsigned* p)              { return __hip_atomic_load(p, __ATOMIC_RELAXED, __HIP_MEMORY_SCOPE_AGENT); }
__device__ __forceinline__ unsigned xb_add(unsigned* p, unsigned v) { return __hip_atomic_fetch_add(p, v, __ATOMIC_RELAXED, __HIP_MEMORY_SCOPE_AGENT); }
__device__ __forceinline__ unsigned xb_xcc_id() { return (unsigned)__builtin_amdgcn_s_getreg((3 << 11) | 20) & 0xFu; }
#define XB_SPIN(cond, bar) do { unsigned _sp = 0; while (cond) { __builtin_amdgcn_s_sleep(1); \
    if ((++_sp & 255u) == 0u) { if (xb_ld(&(bar)[XB_TMO])) break; if (_sp > XB_SPIN_CAP) { atomicAdd(&(bar)[XB_TMO], 1u); break; } } } } while (0)

struct XcdBarrier {
    unsigned* bar; unsigned x;
    volatile LAS unsigned* st;
};

__device__ __forceinline__ XcdBarrier xcd_barrier_post(unsigned* bar, volatile LAS unsigned* st) {
    XcdBarrier b; b.bar = bar; b.x = xb_xcc_id(); b.st = st;
    if (threadIdx.x == 0) (void)xb_add(&bar[XB_XCNT(b.x)], 1u);
    return b;
}
__device__ __forceinline__ void xcd_barrier_complete(unsigned* bar, unsigned x, unsigned& nloc, unsigned& nx) {
    const unsigned G = gridDim.x * gridDim.y * gridDim.z;
    unsigned sum, cnt, mine, sp = 0u;
    for (;;) {
        sum = 0u; cnt = 0u; mine = 0u;
#pragma unroll
        for (unsigned j = 0; j < 16; ++j) { const unsigned c = xb_ld(&bar[XB_XCNT(j)]); sum += c; cnt += (c > 0u) ? 1u : 0u; mine = (j == x) ? c : mine; }
        if (sum == G) break;
        __builtin_amdgcn_s_sleep(1);
        if ((++sp & 255u) == 0u) { if (xb_ld(&bar[XB_TMO])) break; if (sp > XB_SPIN_CAP) { atomicAdd(&bar[XB_TMO], 1u); break; } }
    }
    nloc = mine > 0u ? mine : 1u; nx = cnt > 0u ? cnt : 1u;
}

__device__ __forceinline__ void xcd_barrier(const XcdBarrier& b) {
    asm volatile("s_waitcnt vmcnt(0)" ::: "memory");
    __syncthreads();
    if (threadIdx.x == 0) {
        unsigned* bar = b.bar;
        __builtin_amdgcn_s_waitcnt(0);
        unsigned nloc = b.st[0], nx = b.st[1];
        if (nloc == 0u) { xcd_barrier_complete(bar, b.x, nloc, nx); b.st[0] = nloc; b.st[1] = nx; }
        const unsigned old = xb_add(&bar[XB_XSUB(b.x)], 1u);
        const unsigned gen = old / nloc;
        if (old + 1u == (gen + 1u) * nloc) {
            __builtin_amdgcn_fence(__ATOMIC_RELEASE, "agent");
            asm volatile("s_waitcnt vmcnt(0)" ::: "memory");
            const unsigned og = xb_add(&bar[XB_TOP], 1u);
            const unsigned tg = og / nx;
            if (og + 1u == (tg + 1u) * nx) xb_add(&bar[XB_TOPGEN], 1u);
            else XB_SPIN(xb_ld(&bar[XB_TOPGEN]) == tg, bar);
            __builtin_amdgcn_fence(__ATOMIC_ACQUIRE, "agent");
            xb_add(&bar[XB_XGEN(b.x)], 1u);
            asm volatile("s_waitcnt vmcnt(0)" ::: "memory");
        } else {
            XB_SPIN(xb_ld(&bar[XB_XGEN(b.x)]) == gen, bar);
            __builtin_amdgcn_fence(__ATOMIC_ACQUIRE, "agent");
            asm volatile("s_waitcnt vmcnt(0)" ::: "memory");
        }
    }
    __syncthreads();
}


struct Frame {
    LAS unsigned char* lds;
    volatile LAS unsigned* MISC;
    gu32* ctl;
    unsigned char* ws;
    int tid, lane, wave, vcu, G;
};
struct Args { const float* in[15]; float* out; unsigned char* ws; int ph_lo, ph_hi; };

__device__ __forceinline__ float wave_sum(float v) {
#pragma unroll
    for (int o = 1; o < 64; o <<= 1) v += __shfl_xor(v, o);
    return v;
}

template <class ColMap>
__device__ __forceinline__ void p0_transpose_item(const float* W, int K, int N, bf16* WT, int nblk, LAS float* scr, int item, int lane, ColMap cm) {
    const int kb = item / nblk, nb = item % nblk, k0 = 64 * kb, n0 = 32 * nb;
    const int src = cm(n0 + (lane & 31));
#pragma unroll 8
    for (int i = 0; i < 32; ++i) { const int kk = 2 * i + (lane >> 5); scr[kk * 33 + (lane & 31)] = (src >= 0) ? W[(size_t)(k0 + kk) * N + src] : 0.f; }
    LDS_WAIT(); asm volatile("" ::: "memory");
    const int c = lane & 7;
#pragma unroll
    for (int j = 0; j < 4; ++j) { const int n = (lane >> 3) + 8 * j; const LAS float* s = scr + (8 * c) * 33 + n;
        v4u o; o.x = pk2(s[0 * 33], s[1 * 33]); o.y = pk2(s[2 * 33], s[3 * 33]); o.z = pk2(s[4 * 33], s[5 * 33]); o.w = pk2(s[6 * 33], s[7 * 33]);
        *(GAS v4u*)(WT + (size_t)(n0 + n) * K + k0 + 8 * c) = o; }
    LDS_WAIT(); asm volatile("" ::: "memory");
}
struct MapIdent { __device__ __forceinline__ int operator()(int n) const { return n; } };
struct MapWin { __device__ __forceinline__ int operator()(int n) const {
    if (n < 2048) return n;
    if (n < 2560) return 2120 + (n - 2048);
    if (n < 4608) return 2632 + (n - 2560);
    if (n < 4672) return 2048 + (n - 4608);
    if (n < 4680) return 2112 + (n - 4672);
    return -1; } };

template <int NR> __device__ __forceinline__ void rms_rows_to_bf16(const float* x, const float* g, bf16* o, int m0, int stride, int lane) {
    f32x4 v[NR][4]; float s[NR];
#pragma unroll
    for (int r = 0; r < NR; ++r) { const GAS f32x4* xr = (const GAS f32x4*)(x + (size_t)(m0 + r * stride) * DM) + lane;
#pragma unroll
        for (int j = 0; j < 4; ++j) v[r][j] = xr[64 * j]; }
#pragma unroll
    for (int r = 0; r < NR; ++r) { float a = 0.f;
#pragma unroll
        for (int j = 0; j < 4; ++j) a += (v[r][j].x * v[r][j].x + v[r][j].y * v[r][j].y) + (v[r][j].z * v[r][j].z + v[r][j].w * v[r][j].w);
        s[r] = a; }
#pragma unroll
    for (int o2 = 1; o2 < 64; o2 <<= 1) {
#pragma unroll
        for (int r = 0; r < NR; ++r) s[r] += __shfl_xor(s[r], o2);
    }
    const GAS f32x4* gr = (const GAS f32x4*)g + lane;
    f32x4 gg[4];
#pragma unroll
    for (int j = 0; j < 4; ++j) gg[j] = gr[64 * j];
#pragma unroll
    for (int r = 0; r < NR; ++r) { const float rs = 1.0f / sqrtf(s[r] * (1.f / 1024.f) + EPS);
        GAS unsigned long long* o8 = (GAS unsigned long long*)(o + (size_t)(m0 + r * stride) * DM) + lane;
#pragma unroll
        for (int j = 0; j < 4; ++j) o8[64 * j] = (unsigned long long)pk2(v[r][j].x * rs * gg[j].x, v[r][j].y * rs * gg[j].y) | ((unsigned long long)pk2(v[r][j].z * rs * gg[j].z, v[r][j].w * rs * gg[j].w) << 32); }
}

__device__ __forceinline__ void p0_prologue(Frame& F, const Args& AR) {
    LAS float* scr = (LAS float*)(F.lds + F.wave * 16384);
    const int gw = F.vcu * NWAVES + F.wave, NGW = F.G * NWAVES, lane = F.lane;
    constexpr int I_WIN = 16 * 152, I_WA = 8 * 32, I_WO = 16 * 32;
    for (int it = gw; it < I_WIN + I_WA + I_WO; it += NGW) {
        int r = it;
        if (r < I_WIN) { p0_transpose_item((AR.in[2]), 1024, IN_WIDTH, ((bf16*)(F.ws + WS_WIN)), 152, scr, r, lane, MapWin()); continue; } r -= I_WIN;
        if (r < I_WA) { p0_transpose_item((AR.in[7]), 512, 1024, ((bf16*)(F.ws + WS_WA)), 32, scr, r, lane, MapIdent()); continue; } r -= I_WA;
        p0_transpose_item((AR.in[9]), 1024, 1024, ((bf16*)(F.ws + WS_WO)), 32, scr, r, lane, MapIdent());
    }
    for (int it = gw; it < 16 * 64; it += NGW) {
        const int nb = it & 15, kb = it >> 4, n = nb * 64 + lane, k0 = kb * 8, g = k0 >> 7, c0 = k0 & 127;
        float acc[8];
#pragma unroll
        for (int j = 0; j < 8; ++j) acc[j] = 0.f;
        for (int d = 0; d < 128; ++d) {
            const float wv = (AR.in[8])[(size_t)(g * 128 + d) * 1024 + n] * (AR.in[6])[g * 128 + d];
#pragma unroll
            for (int j = 0; j < 8; ++j) acc[j] += (AR.in[5])[(size_t)(g * 128 + c0 + j) * 128 + d] * wv;
        }
        v4u o; o.x = pk2(acc[0], acc[1]); o.y = pk2(acc[2], acc[3]); o.z = pk2(acc[4], acc[5]); o.w = pk2(acc[6], acc[7]);
        *(GAS v4u*)(((bf16*)(F.ws + WS_WPP)) + (size_t)n * 512 + k0) = o;
    }
    for (int it = gw; it < 16 * 32; it += NGW) p0_transpose_item((AR.in[11]), 1024, 1024, ((bf16*)(F.ws + WS_W2)), 32, scr, it, lane, MapIdent());
    for (int it = gw; it < 256; it += NGW) { const size_t e0 = (size_t)it * 512 + lane * 8;
        const f32x4 a = *(const GAS f32x4*)((AR.in[12]) + e0), b = *(const GAS f32x4*)((AR.in[12]) + e0 + 4);
        v4u o; o.x = pk2(a.x, a.y); o.y = pk2(a.z, a.w); o.z = pk2(b.x, b.y); o.w = pk2(b.z, b.w);
        *(GAS v4u*)(((bf16*)(F.ws + WS_SKB)) + e0) = o; }
    {   float mu = 0.f, mv = 0.f;
#pragma unroll 4
        for (int it = gw; it < 2 * 32768; it += NGW) {
            const float* src = (it < 32768) ? (AR.in[13]) : (AR.in[14]); const size_t e0 = (size_t)(it & 32767) * 512 + lane * 8;
            const f32x4 a = *(const GAS f32x4*)(src + e0), b = *(const GAS f32x4*)(src + e0 + 4);
            const float m = fmaxf(fmaxf(fmaxf(fabsf(a.x), fabsf(a.y)), fmaxf(fabsf(a.z), fabsf(a.w))), fmaxf(fmaxf(fabsf(b.x), fabsf(b.y)), fmaxf(fabsf(b.z), fabsf(b.w))));
            if (it < 32768) mu = fmaxf(mu, m); else mv = fmaxf(mv, m);
        }
#pragma unroll
        for (int o = 1; o < 64; o <<= 1) { mu = fmaxf(mu, __shfl_xor(mu, o)); mv = fmaxf(mv, __shfl_xor(mv, o)); }
        if (lane == 0) { __hip_atomic_fetch_max(F.ctl + CW_AMAX, __float_as_uint(mu), RLX_AGENT); __hip_atomic_fetch_max(F.ctl + CW_AMAX + 1, __float_as_uint(mv), RLX_AGENT); }
    }
    for (int it = gw * 64 + lane; it < 4096 * 8; it += NGW * 64) {
        const int pos = it >> 3, i = it & 7;
        const float invf = exp2f(-(float)i * 0.125f * 18.931568569324174f);
        const double ang = (double)((float)pos * invf);
        const double kq = __builtin_rint(ang * 0.6366197723675814);
        const float r = (float)(ang - kq * 1.5707963267948966);
        const int q = (int)((long long)kq & 3);
        const float r2 = r * r;
        const float sn = r + r * r2 * (-1.6666654611e-1f + r2 * (8.3321608736e-3f + r2 * (-1.9515295891e-4f)));
        const float cs = 1.0f - 0.5f * r2 + r2 * r2 * (4.166664568298827e-2f + r2 * (-1.388731625493765e-3f + r2 * 2.443315711809948e-5f));
        const float s = (q == 0) ? sn : (q == 1) ? cs : (q == 2) ? -sn : -cs;
        const float c = (q == 0) ? cs : (q == 1) ? -sn : (q == 2) ? -cs : sn;
        ((float*)(F.ws + WS_ROPE))[pos * 16 + i] = c; ((float*)(F.ws + WS_ROPE))[pos * 16 + 8 + i] = s;
    }
    { int m = gw;
      for (; m + 3 * NGW < MTOK; m += 4 * NGW) rms_rows_to_bf16<4>((AR.in[0]), (AR.in[1]), ((bf16*)(F.ws + WS_ACT)), m, NGW, lane);
      for (; m < MTOK; m += NGW) rms_rows_to_bf16<1>((AR.in[0]), (AR.in[1]), ((bf16*)(F.ws + WS_ACT)), m, NGW, lane); }
}

__device__ __forceinline__ void unpack8(const v4u w, float (&v)[8]) { v[0] = bflo(w.x); v[1] = bfhi(w.x); v[2] = bflo(w.y); v[3] = bfhi(w.y); v[4] = bflo(w.z); v[5] = bfhi(w.z); v[6] = bflo(w.w); v[7] = bfhi(w.w); }
__device__ __forceinline__ v4u pack8(const float (&v)[8]) { v4u o; o.x = pk2(v[0], v[1]); o.y = pk2(v[2], v[3]); o.z = pk2(v[4], v[5]); o.w = pk2(v[6], v[7]); return o; }
__device__ __forceinline__ void rope8(float (&v)[8], int sub, const float (&cs)[8], const float (&sn)[8]) {
    float pv[8];
#pragma unroll
    for (int j = 0; j < 8; ++j) pv[j] = __shfl_xor(v[j], 1);
    if (sub == 0) {
#pragma unroll
        for (int j = 0; j < 8; ++j) v[j] = v[j] * cs[j] - pv[j] * sn[j];
    } else if (sub == 1) {
#pragma unroll
        for (int j = 0; j < 8; ++j) v[j] = v[j] * cs[j] + pv[j] * sn[j];
    }
}
__device__ __forceinline__ float fp8_scale(unsigned amax_bits) { const unsigned be = (amax_bits >> 23) & 0xffu; return (be == 0u || be > 250u) ? 1.0f : __uint_as_float((261u - be) << 23); }
__device__ __forceinline__ float fp8_inv_scale(unsigned amax_bits) { const unsigned be = (amax_bits >> 23) & 0xffu; return (be == 0u || be > 250u) ? 1.0f : __uint_as_float((be - 7u) << 23); }
__device__ __forceinline__ void row_to_fp8(const float* src, unsigned char* dst, float sc, int lane) {
    const GAS f32x4* p = (const GAS f32x4*)src + lane * 4; v4u o;
#pragma unroll
    for (int q = 0; q < 4; ++q) { const f32x4 a = p[q]; int w = 0; w = __builtin_amdgcn_cvt_pk_fp8_f32(a.x * sc, a.y * sc, w, false); w = __builtin_amdgcn_cvt_pk_fp8_f32(a.z * sc, a.w * sc, w, true); o[q] = (unsigned)w; }
    *(GAS v4u*)(dst + ((size_t)(lane >> 3) << 21) + (lane & 7) * 16) = o;
}
__device__ __forceinline__ void row_to_i8(const float* src, unsigned char* dst, float sc, int lane) {
    const GAS f32x4* p = (const GAS f32x4*)src + lane * 4; v4u o;
#pragma unroll
    for (int q = 0; q < 4; ++q) { const f32x4 a = p[q];
        const unsigned b0 = __float_as_uint(a.x * sc + 12582912.0f), b1 = __float_as_uint(a.y * sc + 12582912.0f), b2 = __float_as_uint(a.z * sc + 12582912.0f), b3 = __float_as_uint(a.w * sc + 12582912.0f);
        o[q] = __builtin_amdgcn_perm(b1, b0, 0x0c0c0400u) | __builtin_amdgcn_perm(b3, b2, 0x04000c0cu); }
    *(GAS v4u*)(dst + ((size_t)(lane >> 3) << 21) + (lane & 7) * 16) = o;
}
__device__ __forceinline__ float i8_scale(unsigned amax_bits) { const float a = __uint_as_float(amax_bits); return (a > 1e-30f && a < 1e30f) ? 127.0f / a : 1.0f; }
__device__ __forceinline__ float i8_inv_scale(unsigned amax_bits) { const float a = __uint_as_float(amax_bits); return (a > 1e-30f && a < 1e30f) ? a * (1.0f / 127.0f) : 1.0f; }
__device__ __forceinline__ void fixup_token(Frame& F, const Args& AR, int tok) {
    const int lane = F.lane, sub = lane & 7, pos = tok & (SEQ - 1);
    bf16* row = ((bf16*)(F.ws + WS_PROJ)) + (size_t)tok * LDP;
    float cs[8], sn[8];
    { const GAS f32x4* rt = (const GAS f32x4*)(((float*)(F.ws + WS_ROPE)) + pos * 16); const f32x4 a = rt[0], b = rt[1], c = rt[2], d = rt[3];
      cs[0] = a.x; cs[1] = a.y; cs[2] = a.z; cs[3] = a.w; cs[4] = b.x; cs[5] = b.y; cs[6] = b.z; cs[7] = b.w;
      sn[0] = c.x; sn[1] = c.y; sn[2] = c.z; sn[3] = c.w; sn[4] = d.x; sn[5] = d.y; sn[6] = d.z; sn[7] = d.w; }
#pragma unroll
    for (int which = 0; which < 2; ++which) {
        GAS v4u* p = (GAS v4u*)(row + (which ? K_OFF : Q_OFF) + lane * 8);
        float v[8]; unpack8(*p, v);
        float ss = 0.f;
#pragma unroll
        for (int j = 0; j < 8; ++j) ss += v[j] * v[j];
        ss += __shfl_xor(ss, 1); ss += __shfl_xor(ss, 2); ss += __shfl_xor(ss, 4);
        const float rs = 1.0f / sqrtf(ss * (1.f / 64.f) + EPS);
        const float* g = (which ? (AR.in[4]) : (AR.in[3])) + sub * 8;
#pragma unroll
        for (int j = 0; j < 8; ++j) v[j] = v[j] * rs * g[j];
        rope8(v, sub, cs, sn);
        if (which == 0) {
#pragma unroll
            for (int j = 0; j < 8; ++j) v[j] *= C2;
        }
        *p = pack8(v);
    }
    { GAS v4u* p = (GAS v4u*)(row + QI_OFF + lane * 8); float v[8]; unpack8(*p, v); rope8(v, sub, cs, sn); *p = pack8(v); }
    { GAS v4u* p = (GAS v4u*)(row + KI_OFF + (lane & 7) * 8); float v[8]; unpack8(*p, v); rope8(v, sub, cs, sn); if (lane < 8) *p = pack8(v); }
}
__device__ __forceinline__ void pool_run(Frame& F, int tok0, int ntok) {
    const int lane = F.lane, g = lane >> 4, w = 2 << g;
    const bf16* pcol = ((const bf16*)(F.ws + WS_PROJ)) + P_OFF + lane * 8;
    float S[8];
#pragma unroll
    for (int j = 0; j < 8; ++j) S[j] = 0.f;
    { const int pos0 = tok0 & (SEQ - 1);
#pragma unroll
      for (int back = 1; back < 16; ++back) {
          if (back < w && back <= pos0) { float t[8]; unpack8(*(const GAS v4u*)(pcol + (size_t)(tok0 - back) * LDP), t);
#pragma unroll
              for (int j = 0; j < 8; ++j) S[j] += t[j]; }
      } }
#pragma unroll 1
    for (int i = 0; i < ntok; ++i) {
        const int tok = tok0 + i, pos = tok & (SEQ - 1);
        float cur[8]; unpack8(*(const GAS v4u*)(pcol + (size_t)tok * LDP), cur);
#pragma unroll
        for (int j = 0; j < 8; ++j) S[j] += cur[j];
        const float inv = 1.0f / (float)((pos + 1 < w) ? (pos + 1) : w);
        float o[8];
#pragma unroll
        for (int j = 0; j < 8; ++j) o[j] = S[j] * inv - cur[j];
        *(GAS v4u*)(((bf16*)(F.ws + WS_POOLED)) + (size_t)tok * 512 + lane * 8) = pack8(o);
        if (pos + 1 >= w) { float t[8]; unpack8(*(const GAS v4u*)(pcol + (size_t)(tok + 1 - w) * LDP), t);
#pragma unroll
            for (int j = 0; j < 8; ++j) S[j] -= t[j]; }
    }
}

__device__ __forceinline__ int wave_incl_scan(int v) {
    v += __builtin_amdgcn_update_dpp(0, v, 0x111, 0xf, 0xf, false);
    v += __builtin_amdgcn_update_dpp(0, v, 0x112, 0xf, 0xf, false);
    v += __builtin_amdgcn_update_dpp(0, v, 0x114, 0xf, 0xf, false);
    v += __builtin_amdgcn_update_dpp(0, v, 0x118, 0xf, 0xf, false);
    v += __builtin_amdgcn_update_dpp(0, v, 0x142, 0xa, 0xf, false);
    v += __builtin_amdgcn_update_dpp(0, v, 0x143, 0xc, 0xf, false);
    return v;
}
template <int NB> __device__ __forceinline__ void hist_search(const LAS unsigned* hist, int need, int lane, int& B, int& G, int& E) {
    constexpr int PER = NB / 64;
    int t = 0;
#pragma unroll
    for (int q = 0; q < PER / 4; ++q) { const v4u h = *(const LAS v4u*)(hist + lane * PER + 4 * q); t += (int)(h.x + h.y + h.z + h.w); }
    const int pfx = wave_incl_scan(t);
    const int L = __ffsll((long long)__ballot(pfx >= need)) - 1;
    const int base = __builtin_amdgcn_readlane(pfx, L) - __builtin_amdgcn_readlane(t, L);
    const int hv = (lane < PER) ? (int)hist[L * PER + lane] : 0;
    const int p2 = wave_incl_scan(hv) + base;
    const int i = __ffsll((long long)__ballot(p2 >= need)) - 1;
    B = L * PER + i; E = __builtin_amdgcn_readlane(hv, i); G = __builtin_amdgcn_readlane(p2, i) - E;
}
template <int NB> __device__ __forceinline__ void hist_zero(LAS unsigned* hist, int lane) {
#pragma unroll
    for (int q = 0; q < NB / 256; ++q) *(LAS v4u*)(hist + q * 256 + lane * 4) = (v4u){0u, 0u, 0u, 0u};
}
#define HIST_ADD(p) (void)__hip_atomic_fetch_add((p), 1u, __ATOMIC_RELAXED, __HIP_MEMORY_SCOPE_WORKGROUP)
#define wlane(dst, sval, j) asm volatile("s_nop 3\n\tv_writelane_b32 %0, %1, %2\n\ts_nop 1" : "+v"(dst) : "s"(sval), "i"(j))
__device__ __forceinline__ void select_row(const unsigned short* srow  , LAS unsigned* hist, int nj, int lastw, GAS unsigned long long* mout, int lane, unsigned long long& tacc, unsigned& tcnt) {
    const unsigned long long ts0_ = (PROBE_SEC >= 30 && PROBE_SEC <= 33) ? __builtin_amdgcn_s_memtime() : 0ull;
    unsigned key[64];
#pragma unroll
    for (int g = 0; g < 8; ++g) {
        if (nj > 8 * g) {
#pragma unroll
            for (int jj = 0; jj < 8; ++jj) key[8 * g + jj] = ordk(__uint_as_float((unsigned)((const GAS unsigned short*)srow)[(64 * (8 * g + jj) + lane) * 8] << 16) + 0.0f);
        } else {
#pragma unroll
            for (int jj = 0; jj < 8; ++jj) key[8 * g + jj] = 0u;
        }
    }
    LDS_WAIT(); asm volatile("" ::: "memory");
    if (PROBE_SEC >= 30 && PROBE_SEC <= 33) asm volatile("s_waitcnt vmcnt(0)" ::: "memory");
    const unsigned long long ts1_ = (PROBE_SEC >= 30 && PROBE_SEC <= 33) ? __builtin_amdgcn_s_memtime() : 0ull;
    int need = 256, B, G, E;
    hist_zero<2048>(hist, lane); LDS_WAIT(); asm volatile("" ::: "memory");
#pragma unroll
    for (int g = 0; g < 8; ++g) if (nj > 8 * g) {
#pragma unroll
        for (int jj = 0; jj < 8; ++jj) HIST_ADD(hist + (2047u - (key[8 * g + jj] >> 21)));
    }
    LDS_WAIT(); asm volatile("" ::: "memory");
    hist_search<2048>(hist, need, lane, B, G, E); need -= G;
    const unsigned long long ts2_ = (PROBE_SEC >= 30 && PROBE_SEC <= 33) ? __builtin_amdgcn_s_memtime() : 0ull;
    const unsigned d1 = 2047u - (unsigned)B;
    asm volatile("" ::: "memory"); hist_zero<2048>(hist, lane); LDS_WAIT(); asm volatile("" ::: "memory");
#pragma unroll
    for (int g = 0; g < 8; ++g) if (nj > 8 * g) {
#pragma unroll
        for (int jj = 0; jj < 8; ++jj) { const unsigned k = key[8 * g + jj]; if ((k >> 21) == d1) HIST_ADD(hist + (2047u - ((k >> 10) & 0x7ffu))); }
    }
    LDS_WAIT(); asm volatile("" ::: "memory");
    hist_search<2048>(hist, need, lane, B, G, E); need -= G;
    const unsigned pre2 = (d1 << 11) | (2047u - (unsigned)B);
    const unsigned v = pre2 << 10;
    const unsigned long long ts3_ = (PROBE_SEC >= 30 && PROBE_SEC <= 33) ? __builtin_amdgcn_s_memtime() : 0ull;
    unsigned mlo = 0u, mhi = 0u;
#pragma unroll
    for (int g = 0; g < 8; ++g) {
        asm volatile("v_cmp_ge_u32_e64 s[40:41], %2, %10\n\tv_cmp_ge_u32_e64 s[42:43], %3, %10\n\tv_cmp_ge_u32_e64 s[44:45], %4, %10\n\tv_cmp_ge_u32_e64 s[46:47], %5, %10\n\t"
                     "v_cmp_ge_u32_e64 s[48:49], %6, %10\n\tv_cmp_ge_u32_e64 s[50:51], %7, %10\n\tv_cmp_ge_u32_e64 s[52:53], %8, %10\n\tv_cmp_ge_u32_e64 s[54:55], %9, %10\n\ts_nop 1\n\t"
                     "v_writelane_b32 %0, s40, %11\n\tv_writelane_b32 %1, s41, %11\n\tv_writelane_b32 %0, s42, %12\n\tv_writelane_b32 %1, s43, %12\n\t"
                     "v_writelane_b32 %0, s44, %13\n\tv_writelane_b32 %1, s45, %13\n\tv_writelane_b32 %0, s46, %14\n\tv_writelane_b32 %1, s47, %14\n\t"
                     "v_writelane_b32 %0, s48, %15\n\tv_writelane_b32 %1, s49, %15\n\tv_writelane_b32 %0, s50, %16\n\tv_writelane_b32 %1, s51, %16\n\t"
                     "v_writelane_b32 %0, s52, %17\n\tv_writelane_b32 %1, s53, %17\n\tv_writelane_b32 %0, s54, %18\n\tv_writelane_b32 %1, s55, %18\n\ts_nop 1"
                     : "+v"(mlo), "+v"(mhi)
                     : "v"(key[8 * g]), "v"(key[8 * g + 1]), "v"(key[8 * g + 2]), "v"(key[8 * g + 3]), "v"(key[8 * g + 4]), "v"(key[8 * g + 5]), "v"(key[8 * g + 6]), "v"(key[8 * g + 7]), "v"(v),
                       "i"(8 * g), "i"(8 * g + 1), "i"(8 * g + 2), "i"(8 * g + 3), "i"(8 * g + 4), "i"(8 * g + 5), "i"(8 * g + 6), "i"(8 * g + 7)
                     : "s40", "s41", "s42", "s43", "s44", "s45", "s46", "s47", "s48", "s49", "s50", "s51", "s52", "s53", "s54", "s55");
    }
    int drop = E - need;
#pragma unroll
    for (int j = 63; j >= 0; --j) {
        if (drop > 0) {
            unsigned long long eq = __ballot(key[j] == v);
            if (eq != 0ull) {
                unsigned long long rem = 0ull;
                while (drop > 0 && eq != 0ull) { const unsigned long long hb = 1ull << (63 - __clzll((long long)eq)); rem |= hb; eq ^= hb; --drop; }
                const unsigned long long m = __ballot(key[j] >= v) & ~rem;
                wlane(mlo, (unsigned)m, j); wlane(mhi, (unsigned)(m >> 32), j);
            }
        }
    }
    if (lane <= lastw) mout[lane] = ((unsigned long long)mhi << 32) | (unsigned long long)mlo;
    LDS_WAIT(); asm volatile("" ::: "memory");
    if (PROBE_SEC >= 30 && PROBE_SEC <= 33) { const unsigned long long ts4_ = __builtin_amdgcn_s_memtime(); tacc += (PROBE_SEC == 30) ? (ts1_ - ts0_) : (PROBE_SEC == 31) ? (ts2_ - ts1_) : (PROBE_SEC == 32) ? (ts3_ - ts2_) : (ts4_ - ts3_); ++tcnt; }
}

__device__ __forceinline__ float* wave_scratch(unsigned char* ws, int gwv) {
    if (gwv < 1024) return (float*)(ws + WS_ACT) + (size_t)gwv * 32768;
    gwv -= 1024; if (gwv < 512) return (float*)(ws + WS_AO) + (size_t)gwv * 32768;
    gwv -= 512; if (gwv < 352) return (float*)(ws + 980 * MiB) + (size_t)gwv * 32768;
    gwv -= 352; if (gwv < 128) return (float*)(ws + 36 * MiB) + (size_t)gwv * 32768;
    gwv -= 128; return (float*)(ws + 68 * MiB) + (size_t)(gwv & 127) * 32768;
}
__device__ __forceinline__ void idx_unit(Frame& F, const Args& AR, int b, int c, unsigned long long& tacc, unsigned& tcnt, bool do_select = true) {
    const unsigned long long ti0_ = (PROBE_SEC >= 20 && PROBE_SEC <= 22) ? __builtin_amdgcn_s_memtime() : 0ull;
    const int lane = F.lane, wid = F.wave, l31 = lane & 31, h2 = lane >> 5;
    const size_t rowb = (size_t)b * SEQ, tp0 = rowb + (size_t)c * 64 + wid * 8;
    GAS unsigned long long* mbase = (GAS unsigned long long*)(((unsigned long long*)(F.ws + WS_MASK)) + tp0 * 64);
    if (c < 4) {
        if (lane < 32) { const int q = lane >> 2, j = lane & 3; mbase[q * 64 + j] = (j <= c) ? ~0ull : 0ull; }
        return;
    }
    unsigned short* sc = (unsigned short*)wave_scratch(F.ws, F.vcu * NWAVES + wid);
    LAS unsigned* hist = (LAS unsigned*)(F.lds + wid * 8192);
    const int ntile = 2 * (c + 1), nj = c + 1, lastw = c | 3, ntile_pad = 16 * ((nj + 7) >> 3);
    const int head = (l31 & 3) | (((l31 >> 3) & 1) << 2), qsub = ((l31 >> 2) & 1) | (((l31 >> 4) & 1) << 1);
    bf16x8 a[2][4]; float w[2][16];
#pragma unroll
    for (int rb = 0; rb < 2; ++rb) {
        const bf16* ap = ((bf16*)(F.ws + WS_PROJ)) + (tp0 + 4 * rb + qsub) * LDP + QI_OFF + head * 64 + h2 * 8;
#pragma unroll
        for (int st = 0; st < 4; ++st) a[rb][st] = *(const GAS bf16x8*)(ap + st * 16);
        const v4u wa = *(const GAS v4u*)(((bf16*)(F.ws + WS_PROJ)) + (tp0 + 4 * rb + h2) * LDP + WI_OFF), wb = *(const GAS v4u*)(((bf16*)(F.ws + WS_PROJ)) + (tp0 + 4 * rb + h2 + 2) * LDP + WI_OFF);
        float t[8]; unpack8(wa, t);
#pragma unroll
        for (int j = 0; j < 8; ++j) w[rb][j] = t[j] * WI_SCALE;
        unpack8(wb, t);
#pragma unroll
        for (int j = 0; j < 8; ++j) w[rb][8 + j] = t[j] * WI_SCALE;
    }
    const unsigned long long ti1_ = (PROBE_SEC >= 20 && PROBE_SEC <= 22) ? __builtin_amdgcn_s_memtime() : 0ull;
    {
        LAS unsigned char* kb = F.lds + 65536;
        const int nstage = (ntile + 3) >> 2;
        const int sk0 = F.tid >> 3, sch = F.tid & 7;
        const bf16* kg = ((bf16*)(F.ws + WS_PROJ)) + (rowb + sk0) * LDP + KI_OFF + sch * 8;
        v4u r0 = *(const GAS v4u*)kg, r1 = *(const GAS v4u*)(kg + (size_t)64 * LDP);
#pragma unroll 1
        for (int sg = 0; sg < nstage; ++sg) {
            LAS unsigned char* cur = kb + (sg & 1) * 18432;
            *(LAS v4u*)(cur + sk0 * 144 + sch * 16) = r0; *(LAS v4u*)(cur + (sk0 + 64) * 144 + sch * 16) = r1;
            BAR_LDS();
            { const int sn = (sg + 1 < nstage) ? sg + 1 : sg; r0 = *(const GAS v4u*)(kg + (size_t)sn * 128 * LDP); r1 = *(const GAS v4u*)(kg + (size_t)(sn * 128 + 64) * LDP); }
#pragma unroll
            for (int t4 = 0; t4 < 4; ++t4) {
                const int kt = 4 * sg + t4;
                if (kt < ntile) {
                    bf16x8 bfr[4];
#pragma unroll
                    for (int st = 0; st < 4; ++st) bfr[st] = *(const LAS bf16x8*)(cur + (t4 * 32 + l31) * 144 + st * 32 + h2 * 16);
                    float sq[4];
#pragma unroll
                    for (int rb = 0; rb < 2; ++rb) {
                        f32x16 acc;
#pragma unroll
                        for (int r = 0; r < 16; ++r) acc[r] = 0.f;
#pragma unroll
                        for (int st = 0; st < 4; ++st) acc = __builtin_amdgcn_mfma_f32_32x32x16_bf16(a[rb][st], bfr[st], acc, 0, 0, 0);
                        float s0 = 0.f, s1 = 0.f;
#pragma unroll
                        for (int r = 0; r < 8; ++r) { s0 = fmaf(w[rb][r], relu_i(acc[r]), s0); s1 = fmaf(w[rb][8 + r], relu_i(acc[8 + r]), s1); }
                        sq[2 * rb] = s0; sq[2 * rb + 1] = s1;
                    }
                    *(GAS v2u*)(sc + (size_t)(kt * 32 + l31) * 8 + 4 * h2) = (v2u){pk2(sq[0], sq[1]), pk2(sq[2], sq[3])};
                }
            }
        }
        for (int kt = ntile; kt < ntile_pad; ++kt)
            *(GAS v2u*)(sc + (size_t)(kt * 32 + l31) * 8 + 4 * h2) = (v2u){0xff80ff80u, 0xff80ff80u};
    }
    const unsigned long long ti2_ = (PROBE_SEC >= 20 && PROBE_SEC <= 22) ? __builtin_amdgcn_s_memtime() : 0ull;
    VM_WAIT();
    if (do_select) {
#pragma unroll 1
        for (int q = 0; q < 8 * PROBE_SEL2; ++q) select_row(sc + 4 * (q & 1) + ((q & 7) >> 1), hist, nj, lastw, mbase + (q & 7) * 64, lane, tacc, tcnt);
    }
    if (PROBE_SEC >= 20 && PROBE_SEC <= 22) { const unsigned long long ti3_ = __builtin_amdgcn_s_memtime(); tacc += (PROBE_SEC == 20) ? (ti1_ - ti0_) : (PROBE_SEC == 21) ? (ti2_ - ti1_) : (ti3_ - ti2_); tcnt = 1000u; }
}

__device__ __forceinline__ void attn_unit(Frame& F, const Args& AR, int b, int h, int qb, unsigned long long& tacc, unsigned& tcnt) {
    const int lane = F.lane, wid = F.wave, l31 = lane & 31, h2 = lane >> 5;
    LAS unsigned char* Ks = F.lds;
    LAS float* wsf = (LAS float*)(F.lds + 2 * 17408) + wid * 32;
    const size_t rowb = (size_t)b * SEQ, tok0 = rowb + (size_t)qb * 256 + wid * 32;
    bf16x8 qf[4];
    { const bf16* qp = ((bf16*)(F.ws + WS_PROJ)) + (tok0 + l31) * LDP + Q_OFF + h * 64 + h2 * 8;
#pragma unroll
      for (int st = 0; st < 4; ++st) qf[st] = *(const GAS bf16x8*)(qp + st * 16); }
    const int NT = 4 * (qb + 1), cw = qb * 4 + (wid >> 1);
    f32x16 o0, o1;
#pragma unroll
    for (int r = 0; r < 16; ++r) { o0[r] = 0.f; o1[r] = 0.f; }
    float lsum = 0.f;
    const int skey = F.tid >> 3, sch = F.tid & 7;
    const bf16* kg = ((bf16*)(F.ws + WS_PROJ)) + (rowb + skey) * LDP + K_OFF + h * 64 + sch * 8;
    const bf16* vg = ((bf16*)(F.ws + WS_PROJ)) + (rowb + skey) * LDP + V_OFF + h * 64 + sch * 8;
    const unsigned kst = skey * 144 + sch * 16, vst = skey * 128 + ((sch * 16) ^ (((skey >> 1) & 1) << 6));
    const GAS unsigned long long* mrow = (const GAS unsigned long long*)(((unsigned long long*)(F.ws + WS_MASK)) + (tok0 + l31) * 64);
    const int i16 = lane & 15, qq = i16 >> 2, pp = i16 & 3, blk = (lane >> 4) & 1;
    const unsigned vrd = (unsigned)((4 * h2 + qq) * 128 + ((32 * blk + 8 * pp) ^ (((qq >> 1) & 1) << 6)));
    v4u kr[3], vr[3];
#pragma unroll
    for (int u = 0; u < 3; ++u) { kr[u] = *(const GAS v4u*)(kg + (size_t)u * 64 * LDP); vr[u] = *(const GAS v4u*)(vg + (size_t)u * 64 * LDP); }
    unsigned long long mwn = mrow[0];
#pragma unroll 1
    for (int t = 0; t < NT; t += 3) {
#pragma unroll
        for (int u = 0; u < 3; ++u) {
            const int tt = t + u;
            if (tt < NT) {
                LAS unsigned char* Kc = Ks + (tt & 1) * 17408; LAS unsigned char* Vc = Kc + 9216;
                const unsigned long long t_a = PROBE_SEC ? __builtin_amdgcn_s_memtime() : 0ull;
                *(LAS v4u*)(Kc + kst) = kr[u]; *(LAS v4u*)(Vc + vst) = vr[u];
                BAR_LDS();
                const unsigned long long t_b = PROBE_SEC ? __builtin_amdgcn_s_memtime() : 0ull;
                { const int tn = (tt + 3 < NT) ? tt + 3 : NT - 1;
                  kr[u] = *(const GAS v4u*)(kg + (size_t)tn * 64 * LDP); vr[u] = *(const GAS v4u*)(vg + (size_t)tn * 64 * LDP); }
                const unsigned long long mw = mwn;
                mwn = mrow[(tt + 1 < NT) ? tt + 1 : tt];
                if (tt <= cw) {
                    bf16x8 vfr[2][2][2];
        #pragma unroll
                    for (int kb = 0; kb < 2; ++kb)
        #pragma unroll
                        for (int s = 0; s < 2; ++s)
        #pragma unroll
                            for (int d0 = 0; d0 < 2; ++d0) {
                                const unsigned ad = (vrd + (unsigned)((32 * kb + 16 * s) * 128)) ^ (unsigned)(d0 << 6);
                                const s16x4 lo = __builtin_bit_cast(s16x4, __builtin_amdgcn_ds_read_tr16_b64_v4i16((LAS s16x4*)(Vc + ad)));
                                const s16x4 hi = __builtin_bit_cast(s16x4, __builtin_amdgcn_ds_read_tr16_b64_v4i16((LAS s16x4*)(Vc + ad + 8 * 128)));
                                vfr[kb][s][d0] = (bf16x8){lo[0], lo[1], lo[2], lo[3], hi[0], hi[1], hi[2], hi[3]};
                            }
                    f32x16 p[2];
        #pragma unroll
                    for (int kb = 0; kb < 2; ++kb) {
                        f32x16 acc;
        #pragma unroll
                        for (int r = 0; r < 16; ++r) acc[r] = 0.f;
        #pragma unroll
                        for (int st = 0; st < 4; ++st) { const bf16x8 ka = *(const LAS bf16x8*)(Kc + (32 * kb + l31) * 144 + st * 32 + h2 * 16); acc = __builtin_amdgcn_mfma_f32_32x32x16_bf16(ka, qf[st], acc, 0, 0, 0); }
                        const unsigned wk = (kb ? (unsigned)(mw >> 32) : (unsigned)mw) >> (4 * h2);
        #pragma unroll
                        for (int r = 0; r < 16; ++r) {
                            const float e = __builtin_amdgcn_exp2f(acc[r]);
                            float pe;
                            asm("v_bfe_i32 %0, %2, %3, 1\n\tv_and_b32 %0, %0, %1" : "=&v"(pe) : "v"(e), "v"(wk), "i"((r & 3) + 8 * (r >> 2)));
                            acc[r] = pe;
                        }
                        p[kb] = acc;
                    }
                    const unsigned long long t_c = PROBE_SEC ? __builtin_amdgcn_s_memtime() : 0ull;
        #pragma unroll
                    for (int kb = 0; kb < 2; ++kb)
        #pragma unroll
                        for (int s = 0; s < 2; ++s) {
                            v4u pw; pw.x = pg8::cvt_pk_bf16(p[kb][8 * s + 0], p[kb][8 * s + 1]); pw.y = pg8::cvt_pk_bf16(p[kb][8 * s + 2], p[kb][8 * s + 3]); pw.z = pg8::cvt_pk_bf16(p[kb][8 * s + 4], p[kb][8 * s + 5]); pw.w = pg8::cvt_pk_bf16(p[kb][8 * s + 6], p[kb][8 * s + 7]);
                            lsum = dot2bf(pw.x, 0x3f803f80u, lsum); lsum = dot2bf(pw.y, 0x3f803f80u, lsum); lsum = dot2bf(pw.z, 0x3f803f80u, lsum); lsum = dot2bf(pw.w, 0x3f803f80u, lsum);
                            const bf16x8 pa = __builtin_bit_cast(bf16x8, pw);
        #pragma unroll
                            for (int d0 = 0; d0 < 2; ++d0) {
                                const bf16x8 vb = vfr[kb][s][d0];
                                if (d0 == 0) o0 = __builtin_amdgcn_mfma_f32_32x32x16_bf16(pa, vb, o0, 0, 0, 0); else o1 = __builtin_amdgcn_mfma_f32_32x32x16_bf16(pa, vb, o1, 0, 0, 0);
                            }
                        }
                    if (PROBE_SEC) { const unsigned long long t_d = __builtin_amdgcn_s_memtime(); tacc += (PROBE_SEC == 1) ? (t_b - t_a) : (PROBE_SEC == 2) ? (t_c - t_b) : (PROBE_SEC == 3) ? (t_d - t_c) : (t_d - t_a); ++tcnt; }
                }
            }
        }
    }
    lsum += __shfl_xor(lsum, 32);
    if (h2 == 0) wsf[l31] = lsum;
    LDS_WAIT(); asm volatile("" ::: "memory");
    LAS bf16* stg = (LAS bf16*)(F.lds + 2 * 17408 + 1024) + wid * 2048;
#pragma unroll
    for (int r = 0; r < 16; ++r) { const int q = crow(r, h2); const float rl = 1.0f / wsf[q];
        stg[q * 64 + l31] = (bf16)f2bf(o0[r] * rl); stg[q * 64 + 32 + l31] = (bf16)f2bf(o1[r] * rl); }
    LDS_WAIT(); asm volatile("" ::: "memory");
    bf16* ow = ((bf16*)(F.ws + WS_AO)) + tok0 * 512 + h * 64;
#pragma unroll
    for (int i = 0; i < 4; ++i) { const int row = i * 8 + (lane >> 3), ch = lane & 7; const v4u v = *(const LAS v4u*)(stg + row * 64 + ch * 8); *(GAS v4u*)(ow + (size_t)row * 512 + ch * 8) = v; }
    LDS_WAIT(); asm volatile("" ::: "memory");
}

__device__ __forceinline__ float row_rs(const float* ssp, size_t tok) {
    const GAS f32x4* p = (const GAS f32x4*)(ssp + tok * 16); const f32x4 a = p[0], b = p[1], c = p[2], d = p[3];
    const float ss = ((a.x + a.y) + (a.z + a.w)) + ((b.x + b.y) + (b.z + b.w)) + ((c.x + c.y) + (c.z + c.w)) + ((d.x + d.y) + (d.z + d.w));
    return 1.0f / sqrtf(ss * (1.f / 1024.f) + EPS);
}
__device__ __forceinline__ void sort16_desc(unsigned (&a)[16]) {
#pragma unroll
    for (int k = 2; k <= 16; k <<= 1)
#pragma unroll
        for (int j = k >> 1; j > 0; j >>= 1)
#pragma unroll
            for (int i = 0; i < 16; ++i) { const int l = i ^ j; if (l > i) { const unsigned hi = a[i] > a[l] ? a[i] : a[l], lo = a[i] > a[l] ? a[l] : a[i];
                if ((i & k) == 0) { a[i] = hi; a[l] = lo; } else { a[i] = lo; a[l] = hi; } } }
}
__device__ __forceinline__ void merge16_desc(unsigned (&top)[16], const unsigned (&a)[16]) {
#pragma unroll
    for (int i = 0; i < 16; ++i) top[i] = top[i] > a[15 - i] ? top[i] : a[15 - i];
#pragma unroll
    for (int j = 8; j > 0; j >>= 1)
#pragma unroll
        for (int i = 0; i < 16; ++i) { const int l = i ^ j; if (l > i) { const unsigned hi = top[i] > top[l] ? top[i] : top[l], lo = top[i] > top[l] ? top[l] : top[i]; top[i] = hi; top[l] = lo; } }
}
struct PairTab { int i[64], j[64]; };
constexpr PairTab make_pairs() { PairTab t{}; int n = 0; for (int i = 0; i < 16; ++i) for (int j = 0; j < 16; ++j) if ((i + 1) * (j + 1) <= 16) { t.i[n] = i; t.j[n] = j; ++n; } for (; n < 64; ++n) { t.i[n] = -1; t.j[n] = -1; } return t; }
__device__ __forceinline__ void route_task(Frame& F, const Args& AR, int tt, int h) {
    const int lane = F.lane, l31 = lane & 31, h2 = lane >> 5;
    const size_t tok = (size_t)tt * 32 + l31;
    LAS unsigned* lk = (LAS unsigned*)F.lds;
    unsigned KA[16], KB[16];
#pragma unroll
    for (int i = 0; i < 16; ++i) { KA[i] = 0u; KB[i] = 0u; }
#pragma unroll 1
    for (int p = 0; p < 2; ++p) {
        const int hp = 2 * h + p;
        bf16x8 bq[4];
        { const bf16* qp = ((const bf16*)(F.ws + WS_SUBK)) + tok * 1024 + hp * 64 + h2 * 8;
#pragma unroll
          for (int st = 0; st < 4; ++st) bq[st] = *(const GAS bf16x8*)(qp + st * 16); }
        unsigned top[16];
#pragma unroll
        for (int i = 0; i < 16; ++i) top[i] = 0u;
#pragma unroll 1
        for (int blk = 0; blk < 4; ++blk) {
            const bf16* ap = ((const bf16*)(F.ws + WS_SKB)) + (size_t)(hp * 128 + 32 * blk + l31) * 64 + h2 * 8;
            f32x16 acc;
#pragma unroll
            for (int r = 0; r < 16; ++r) acc[r] = 0.f;
#pragma unroll
            for (int st = 0; st < 4; ++st) { const bf16x8 af = *(const GAS bf16x8*)(ap + st * 16); acc = __builtin_amdgcn_mfma_f32_32x32x16_bf16(af, bq[st], acc, 0, 0, 0); }
            unsigned a16[16];
#pragma unroll
            for (int r = 0; r < 16; ++r) a16[r] = (ordk(acc[r]) & ~127u) | (unsigned)(127 - (32 * blk + (r & 3) + 8 * (r >> 2)) - 4 * h2);
            sort16_desc(a16);
            merge16_desc(top, a16);
        }
        unsigned oth[16];
#pragma unroll
        for (int i = 0; i < 16; ++i) oth[i] = __shfl_xor(top[i], 32);
        merge16_desc(top, oth);
#pragma unroll
        for (int i = 0; i < 16; ++i) { if (p == 0) KA[i] = top[i]; else KB[i] = top[i]; }
    }
    float sa[16], sb[16];
#pragma unroll
    for (int i = 0; i < 16; ++i) { sa[i] = unordk(KA[i] & ~127u); sb[i] = unordk(KB[i] & ~127u); lk[i * 512 + F.tid] = KA[i]; lk[(16 + i) * 512 + F.tid] = KB[i]; }
    unsigned ck[16];
#pragma unroll
    for (int grp = 0; grp < 4; ++grp) {
        unsigned a[16];
#pragma unroll
        for (int q = 0; q < 16; ++q) { constexpr PairTab T = make_pairs(); const int pi = T.i[grp * 16 + q], pj = T.j[grp * 16 + q];
            a[q] = (pi < 0) ? 0u : ((ordk(sa[pi < 0 ? 0 : pi] + sb[pj < 0 ? 0 : pj]) & ~255u) | (unsigned)(255 - (pi * 16 + pj))); }
        sort16_desc(a);
        if (grp == 0) {
#pragma unroll
            for (int i = 0; i < 16; ++i) ck[i] = a[i];
        } else merge16_desc(ck, a);
    }
    LDS_WAIT(); asm volatile("" ::: "memory");
    unsigned ce[16];
#pragma unroll
    for (int t = 0; t < 16; ++t) { const unsigned flat = 255u - (ck[t] & 255u); const unsigned ka = lk[(flat >> 4) * 512 + F.tid], kb = lk[(16u + (flat & 15u)) * 512 + F.tid];
        ce[t] = (127u - (ka & 127u)) * 128u + (127u - (kb & 127u)); }
    LDS_WAIT(); asm volatile("" ::: "memory");
    float ts[16]; float sum = 0.f; const float mx = unordk(ck[0] & ~255u);
    const float rsl = row_rs((const float*)(F.ws + WS_SSP), tok) * 1.4426950408889634f;
#pragma unroll
    for (int t = 0; t < 16; ++t) { ts[t] = __builtin_amdgcn_exp2f((unordk(ck[t] & ~255u) - mx) * rsl); sum += ts[t]; }
    const float inv = 1.0f / sum;
    if (h2 == 0) {
        GAS v4u* eo = (GAS v4u*)(((unsigned short*)(F.ws + WS_REXP)) + tok * 128 + h * 16); GAS f32x4* go = (GAS f32x4*)(((float*)(F.ws + WS_RG)) + tok * 128 + h * 16);
        eo[0] = (v4u){ce[0] | (ce[1] << 16), ce[2] | (ce[3] << 16), ce[4] | (ce[5] << 16), ce[6] | (ce[7] << 16)};
        eo[1] = (v4u){ce[8] | (ce[9] << 16), ce[10] | (ce[11] << 16), ce[12] | (ce[13] << 16), ce[14] | (ce[15] << 16)};
#pragma unroll
        for (int t4 = 0; t4 < 4; ++t4) go[t4] = (f32x4){ts[4 * t4] * inv, ts[4 * t4 + 1] * inv, ts[4 * t4 + 2] * inv, ts[4 * t4 + 3] * inv};
    }
}

__device__ __forceinline__ float gelu_erf(float v) {
    const float av = fabsf(v), t = __builtin_amdgcn_rcpf(av * 0.2316418882f + 1.0f);
    float q = t * 0.5307027145f + (-0.7265760135f); q = q * t + 0.7107068705f; q = q * t + (-0.142248368f); q = q * t + 0.127414796f; q = q * t;
    const float e = __builtin_amdgcn_exp2f((v * v) * (-0.72134752044f));
    const float m = v * (q * e);
    return v < 0.f ? m : v - m;
}
__device__ __forceinline__ float dpp_add(float v, float w_unused) { return v; }
#define DPP_ADD(v, ctrl) ((v) + __builtin_bit_cast(float, __builtin_amdgcn_update_dpp(0, __builtin_bit_cast(int, (v)), (ctrl), 0xf, 0xf, true)))
#define DPP_MAX(v, ctrl) fmaxf((v), __builtin_bit_cast(float, __builtin_amdgcn_update_dpp(0, __builtin_bit_cast(int, (v)), (ctrl), 0xf, 0xf, true)))
#define DPP_ADDI(v, ctrl) ((v) + __builtin_amdgcn_update_dpp(0, (v), (ctrl), 0xf, 0xf, true))
constexpr int NSL = 8;
constexpr int CW_PEER = 8192;
typedef float f32x2v __attribute__((ext_vector_type(2)));
__device__ __forceinline__ unsigned id_of(const v4u a, const v4u b, int m) { const unsigned w = (m < 8) ? a[(m & 7) >> 1] : b[(m & 7) >> 1]; return (m & 1) ? (w >> 16) : (w & 0xffffu); }
__device__ __forceinline__ void load_hn2(const bf16* p, f32x2v (&hn2)[8]) { const v4u a = *(const GAS v4u*)p, b = *(const GAS v4u*)(p + 8);
    hn2[0] = (f32x2v){bflo(a.x), bfhi(a.x)}; hn2[1] = (f32x2v){bflo(a.y), bfhi(a.y)}; hn2[2] = (f32x2v){bflo(a.z), bfhi(a.z)}; hn2[3] = (f32x2v){bflo(a.w), bfhi(a.w)};
    hn2[4] = (f32x2v){bflo(b.x), bfhi(b.x)}; hn2[5] = (f32x2v){bflo(b.y), bfhi(b.y)}; hn2[6] = (f32x2v){bflo(b.z), bfhi(b.z)}; hn2[7] = (f32x2v){bflo(b.w), bfhi(b.w)}; }
template <int SIDE> __device__ __forceinline__ void peer_item8(Frame& F, const Args& AR, int s, size_t t0, unsigned idmask = 0xffffu, bool dry = false) {
    const int lane = F.lane, ts = lane >> 3, c = lane & 7;
    const size_t tok = t0 + ts;
    const unsigned char* tbase = ((const unsigned char*)(F.ws + (SIDE == 0 ? WS_U16 : WS_V16))) + ((size_t)s << 21);
    const unsigned lo = 16u * (unsigned)c;
    const GAS v4u* idq = (const GAS v4u*)(((const unsigned short*)(F.ws + WS_REXP)) + tok * 128);
    v4u ia = idq[0], ib = idq[1];
    if (SIDE == 0) {
        int hq[4]; float dq;
        { const bf16* hp = ((const bf16*)(F.ws + WS_HG)) + tok * 1024 + 128 * s + 16 * c; const v4u a = *(const GAS v4u*)hp, b2 = *(const GAS v4u*)(hp + 8);
          float x[16]; x[0] = bflo(a.x); x[1] = bfhi(a.x); x[2] = bflo(a.y); x[3] = bfhi(a.y); x[4] = bflo(a.z); x[5] = bfhi(a.z); x[6] = bflo(a.w); x[7] = bfhi(a.w);
          x[8] = bflo(b2.x); x[9] = bfhi(b2.x); x[10] = bflo(b2.y); x[11] = bfhi(b2.y); x[12] = bflo(b2.z); x[13] = bfhi(b2.z); x[14] = bflo(b2.w); x[15] = bfhi(b2.w);
          float am = 1e-30f;
#pragma unroll
          for (int i = 0; i < 16; ++i) am = fmaxf(am, fabsf(x[i]));
          am = DPP_MAX(am, 0xB1); am = DPP_MAX(am, 0x4E); am = DPP_MAX(am, 0x141);
          const float qs = 127.0f * __builtin_amdgcn_rcpf(am) * 0.99999f; dq = am * (1.0f / (127.0f * 0.99999f));
#pragma unroll
          for (int q = 0; q < 4; ++q) { unsigned bt[4];
#pragma unroll
              for (int i = 0; i < 4; ++i) bt[i] = __float_as_uint(x[4 * q + i] * qs + 12582912.0f);
              hq[q] = (int)(__builtin_amdgcn_perm(bt[1], bt[0], 0x0c0c0400u) | __builtin_amdgcn_perm(bt[3], bt[2], 0x04000c0cu)); } }
        bf16* po = ((bf16*)(F.ws + WS_SUBK)) + (tok * NSL + s) * 128;
#pragma unroll 1
        for (int b = 0; b < 8; ++b) {
            v4u r[16];
#pragma unroll
            for (int m = 0; m < 16; ++m) r[m] = *(const GAS v4u*)(tbase + (size_t)(((id_of(ia, ib, m) & idmask) << 7) + lo));
            const int bn = (b + 1) & 7; ia = idq[2 * bn]; ib = idq[2 * bn + 1];
            float d[16];
#pragma unroll
            for (int m = 0; m < 16; ++m) { int acc = 0;
#pragma unroll
                for (int q = 0; q < 4; ++q) acc = __builtin_amdgcn_sdot4((int)r[m][q], hq[q], acc, false);
                acc = DPP_ADDI(acc, 0xB1); acc = DPP_ADDI(acc, 0x4E); acc = DPP_ADDI(acc, 0x141); d[m] = (float)acc * dq; }
            if (c == 0) { GAS v4u* pq = (GAS v4u*)(po + 16 * b);
                pq[0] = (v4u){pk2(d[0], d[1]), pk2(d[2], d[3]), pk2(d[4], d[5]), pk2(d[6], d[7])}; pq[1] = (v4u){pk2(d[8], d[9]), pk2(d[10], d[11]), pk2(d[12], d[13]), pk2(d[14], d[15])}; }
        }
    } else {
        const GAS f32x4* cfq = (const GAS f32x4*)(((const float*)(F.ws + WS_RG)) + tok * 128);
        f32x4 cf[4];
#pragma unroll
        for (int q = 0; q < 4; ++q) cf[q] = cfq[q];
        f32x2v acc[8];
#pragma unroll
        for (int j = 0; j < 8; ++j) acc[j] = (f32x2v){0.f, 0.f};
#pragma unroll 1
        for (int b = 0; b < 8; ++b) {
            v4u r[16];
#pragma unroll
            for (int m = 0; m < 16; ++m) r[m] = *(const GAS v4u*)(tbase + (size_t)(((id_of(ia, ib, m) & idmask) << 7) + lo));
            const int bn = (b + 1) & 7; ia = idq[2 * bn]; ib = idq[2 * bn + 1];
            f32x4 cn[4];
#pragma unroll
            for (int q = 0; q < 4; ++q) cn[q] = cfq[4 * bn + q];
#pragma unroll
            for (int m = 0; m < 16; ++m) { const float cm = cf[m >> 2][m & 3]; const f32x2v c2 = {cm, cm};
#pragma unroll
                for (int q = 0; q < 4; ++q) { const int w = (int)r[m][q]; acc[2 * q] = __builtin_amdgcn_cvt_pk_f32_fp8(w, false) * c2 + acc[2 * q]; acc[2 * q + 1] = __builtin_amdgcn_cvt_pk_f32_fp8(w, true) * c2 + acc[2 * q + 1]; } }
#pragma unroll
            for (int q = 0; q < 4; ++q) cf[q] = cn[q];
        }
        GAS f32x4* op = (GAS f32x4*)((AR.out) + tok * 1024 + 128 * s + 16 * c);
#pragma unroll
        for (int q = 0; q < 4; ++q) { f32x4 h = op[q]; h.x += acc[2 * q].x; h.y += acc[2 * q].y; h.z += acc[2 * q + 1].x; h.w += acc[2 * q + 1].y; if (!dry || h.x == 1.2345e30f) op[q] = h; }
    }
}
__device__ __forceinline__ void quant_hn16(const bf16* hp, int (&hq)[4], float& dq) {
    const v4u a = *(const GAS v4u*)hp, b2 = *(const GAS v4u*)(hp + 8);
    float x[16]; x[0] = bflo(a.x); x[1] = bfhi(a.x); x[2] = bflo(a.y); x[3] = bfhi(a.y); x[4] = bflo(a.z); x[5] = bfhi(a.z); x[6] = bflo(a.w); x[7] = bfhi(a.w);
    x[8] = bflo(b2.x); x[9] = bfhi(b2.x); x[10] = bflo(b2.y); x[11] = bfhi(b2.y); x[12] = bflo(b2.z); x[13] = bfhi(b2.z); x[14] = bflo(b2.w); x[15] = bfhi(b2.w);
    float am = 1e-30f;
#pragma unroll
    for (int i = 0; i < 16; ++i) am = fmaxf(am, fabsf(x[i]));
    am = DPP_MAX(am, 0xB1); am = DPP_MAX(am, 0x4E); am = DPP_MAX(am, 0x141);
    const float qs = 127.0f * __builtin_amdgcn_rcpf(am) * 0.99999f; dq = am * (1.0f / (127.0f * 0.99999f));
#pragma unroll
    for (int q = 0; q < 4; ++q) { unsigned bt[4];
#pragma unroll
        for (int i = 0; i < 4; ++i) bt[i] = __float_as_uint(x[4 * q + i] * qs + 12582912.0f);
        hq[q] = (int)(__builtin_amdgcn_perm(bt[1], bt[0], 0x0c0c0400u) | __builtin_amdgcn_perm(bt[3], bt[2], 0x04000c0cu)); }
}
__device__ __forceinline__ void peer_u16(Frame& F, int s, size_t t0, unsigned idmask = 0xffffu) {
    const int lane = F.lane, ts = lane >> 3, c = lane & 7;
    const size_t tok = t0 + ts;
    const unsigned char* tbase = ((const unsigned char*)(F.ws + WS_U16)) + ((size_t)s << 21);
    const unsigned lo = 16u * (unsigned)c;
    const GAS v4u* idq = (const GAS v4u*)(((const unsigned short*)(F.ws + WS_REXP)) + tok * 128);
    int hq0[4], hq1[4]; float dq0, dq1;
    quant_hn16(((const bf16*)(F.ws + WS_HG)) + tok * 1024 + 128 * s + 16 * c, hq0, dq0);
    quant_hn16(((const bf16*)(F.ws + WS_HG)) + (tok + 8) * 1024 + 128 * s + 16 * c, hq1, dq1);
    bf16* po = ((bf16*)(F.ws + WS_SUBK)) + (tok * NSL + s) * 128;
    v4u ia, ib;
    v4u r[16];
    { const v4u i0 = idq[0], i1 = idq[1]; ia = idq[2]; ib = idq[3];
      asm volatile("" :: "v"(ia), "v"(ib));
#pragma unroll
      for (int m = 0; m < 16; ++m) r[m] = *(const GAS v4u*)(tbase + (size_t)(((id_of(i0, i1, m) & idmask) << 7) + lo)); }
#pragma unroll 1
    for (int j = 0; j < 15; ++j) {
        const bool g1 = j >= 8;
        v4u na, nb; { const int jn = (j + 2 < 16) ? j + 2 : 15; const GAS v4u* ip = idq + ((jn >> 3) * 128 + 2 * (jn & 7)); na = ip[0]; nb = ip[1]; }
        int hq[4];
#pragma unroll
        for (int q = 0; q < 4; ++q) hq[q] = g1 ? hq1[q] : hq0[q];
        const float dq = g1 ? dq1 : dq0;
        float d[16];
#pragma unroll
        for (int m = 0; m < 16; ++m) { int acc = 0;
#pragma unroll
            for (int q = 0; q < 4; ++q) acc = __builtin_amdgcn_sdot4((int)r[m][q], hq[q], acc, false);
            r[m] = *(const GAS v4u*)(tbase + (size_t)(((id_of(ia, ib, m) & idmask) << 7) + lo));
            acc = DPP_ADDI(acc, 0xB1); acc = DPP_ADDI(acc, 0x4E); acc = DPP_ADDI(acc, 0x141); d[m] = (float)acc * dq; }
        ia = na; ib = nb;
        if (c == 0) { GAS v4u* pq = (GAS v4u*)(po + (j >> 3) * (8 * NSL * 128) + 16 * (j & 7));
            pq[0] = (v4u){pk2(d[0], d[1]), pk2(d[2], d[3]), pk2(d[4], d[5]), pk2(d[6], d[7])}; pq[1] = (v4u){pk2(d[8], d[9]), pk2(d[10], d[11]), pk2(d[12], d[13]), pk2(d[14], d[15])}; }
    }
    { float d[16];
#pragma unroll
        for (int m = 0; m < 16; ++m) { int acc = 0;
#pragma unroll
            for (int q = 0; q < 4; ++q) acc = __builtin_amdgcn_sdot4((int)r[m][q], hq1[q], acc, false);
            acc = DPP_ADDI(acc, 0xB1); acc = DPP_ADDI(acc, 0x4E); acc = DPP_ADDI(acc, 0x141); d[m] = (float)acc * dq1; }
        if (c == 0) { GAS v4u* pq = (GAS v4u*)(po + (8 * NSL * 128) + 16 * 7);
            pq[0] = (v4u){pk2(d[0], d[1]), pk2(d[2], d[3]), pk2(d[4], d[5]), pk2(d[6], d[7])}; pq[1] = (v4u){pk2(d[8], d[9]), pk2(d[10], d[11]), pk2(d[12], d[13]), pk2(d[14], d[15])}; } }
}
constexpr int PV_IDROW = 272, PV_CFROW = 528, PV_CFOFF = 16 * PV_IDROW, PV_WAVE = PV_CFOFF + 16 * PV_CFROW, PV_BASE = 1024;
__device__ __forceinline__ void peer_v16(Frame& F, const Args& AR, int s, size_t t0, unsigned idmask, bool dry) {
    const int lane = F.lane, ts = lane >> 3, c = lane & 7;
    const unsigned char* tbase = ((const unsigned char*)(F.ws + WS_V16)) + ((size_t)s << 21);
    const unsigned lo = 16u * (unsigned)c;
    LAS unsigned char* wl = F.lds + PV_BASE + F.wave * PV_WAVE;
    { const GAS v4u* gi = (const GAS v4u*)(((const unsigned short*)(F.ws + WS_REXP)) + t0 * 128);
      const GAS v4u* gc = (const GAS v4u*)(((const float*)(F.ws + WS_RG)) + t0 * 128);
      v4u si[4], sc[8];
#pragma unroll
      for (int i = 0; i < 4; ++i) si[i] = gi[lane + 64 * i];
#pragma unroll
      for (int i = 0; i < 8; ++i) sc[i] = gc[lane + 64 * i];
#pragma unroll
      for (int i = 0; i < 4; ++i) { const int j = lane + 64 * i; *(LAS v4u*)(wl + (j >> 4) * PV_IDROW + 16 * (j & 15)) = si[i]; }
#pragma unroll
      for (int i = 0; i < 8; ++i) { const int j = lane + 64 * i; *(LAS v4u*)(wl + PV_CFOFF + (j >> 5) * PV_CFROW + 16 * (j & 31)) = sc[i]; } }
#pragma unroll 1
    for (int g = 0; g < 2; ++g) {
        const size_t tok = t0 + 8 * g + ts;
        const LAS v4u* idl = (const LAS v4u*)(wl + (8 * g + ts) * PV_IDROW);
        const LAS f32x4* cfl = (const LAS f32x4*)(wl + PV_CFOFF + (8 * g + ts) * PV_CFROW);
        f32x2v acc[8];
#pragma unroll
        for (int j = 0; j < 8; ++j) acc[j] = (f32x2v){0.f, 0.f};
        v4u ia = idl[0], ib = idl[1];
#pragma unroll 1
        for (int b = 0; b < 8; ++b) {
            v4u r[16];
#pragma unroll
            for (int m = 0; m < 16; ++m) r[m] = *(const GAS v4u*)(tbase + (size_t)(((id_of(ia, ib, m) & idmask) << 7) + lo));
            f32x4 cf[4];
#pragma unroll
            for (int q = 0; q < 4; ++q) cf[q] = cfl[4 * b + q];
            { const int bn = (b + 1) & 7; ia = idl[2 * bn]; ib = idl[2 * bn + 1]; }
#pragma unroll
            for (int m = 0; m < 16; ++m) { const float cm = cf[m >> 2][m & 3]; const f32x2v c2 = {cm, cm};
#pragma unroll
                for (int q = 0; q < 4; ++q) { const int w = (int)r[m][q]; acc[2 * q] = __builtin_amdgcn_cvt_pk_f32_fp8(w, false) * c2 + acc[2 * q]; acc[2 * q + 1] = __builtin_amdgcn_cvt_pk_f32_fp8(w, true) * c2 + acc[2 * q + 1]; } }
        }
        GAS f32x4* op = (GAS f32x4*)((AR.out) + tok * 1024 + 128 * s + 16 * c);
#pragma unroll
        for (int q = 0; q < 4; ++q) { f32x4 h = op[q]; h.x += acc[2 * q].x; h.y += acc[2 * q].y; h.z += acc[2 * q + 1].x; h.w += acc[2 * q + 1].y; if (!dry || h.x == 1.2345e30f) op[q] = h; }
    }
}
template <int SIDE> __device__ __forceinline__ void peer_side(Frame& F, const Args& AR, int rep = 0) {
    gu32* cnt = F.ctl + CW_PEER + (SIDE + 2 * rep) * 16 * 64;
    LAS int* sh = (LAS int*)F.lds;
    const unsigned xcc = xb_xcc_id() & 7u;
#pragma unroll 1
    for (int k = 0; k < NSL; ++k) {
        const int s = (int)((xcc + (unsigned)k) & (unsigned)(NSL - 1));
#pragma unroll 1
        for (;;) {
            __syncthreads();
            if (F.tid == 0) sh[0] = (int)__hip_atomic_fetch_add(cnt + 64 * s, 1u, RLX_AGENT);
            __syncthreads();
            const int blk = sh[0];
            if (blk >= MTOK / 128) break;
            const size_t t0 = (size_t)blk * 128 + F.wave * 16;
            if (SIDE == 0) peer_u16(F, s, t0, (PROBE_FAKEID && ((REPEAT_MASK >> 11) & 1) && rep == 0) ? (unsigned)PROBE_FAKEID : 0xffffu); else { const bool dry = ((REPEAT_MASK >> 13) & 1) && rep == 0; const unsigned im = (dry && PROBE_FAKEID) ? (unsigned)PROBE_FAKEID : 0xffffu; peer_v16(F, AR, s, t0, im, dry); }
        }
    }
}
__device__ __forceinline__ void peer_coef_token(Frame& F, size_t tok, float inv_su, float inv_sv) {
    const int lane = F.lane;
    const unsigned short* pp = ((const unsigned short*)(F.ws + WS_SUBK)) + tok * NSL * 128;
    float a0 = 0.f, a1 = 0.f;
#pragma unroll
    for (int s = 0; s < NSL; ++s) { a0 += __uint_as_float((unsigned)pp[s * 128 + lane] << 16); a1 += __uint_as_float((unsigned)pp[s * 128 + 64 + lane] << 16); }
    float* gp = ((float*)(F.ws + WS_RG)) + tok * 128;
    const float sc = inv_su * row_rs((const float*)(F.ws + WS_SSP), tok);
    gp[lane] = gp[lane] * gelu_erf(a0 * sc) * inv_sv; gp[64 + lane] = gp[64 + lane] * gelu_erf(a1 * sc) * inv_sv;
}

__global__ void __launch_bounds__(NWAVES * 64, 2) mk_fwd(Args args) {
    extern __shared__ __attribute__((aligned(16))) unsigned char lds[];
    Frame F;
    F.lds = (LAS unsigned char*)lds;
    F.MISC = (volatile LAS unsigned*)(F.lds + MISC_OFF);
    F.tid = threadIdx.x; F.lane = F.tid & 63; F.wave = __builtin_amdgcn_readfirstlane(F.tid >> 6);
    F.G = gridDim.x; { const int bx = blockIdx.x; F.vcu = (F.G % 8 == 0) ? (bx % 8) * (F.G / 8) + bx / 8 : bx; }
    F.ws = args.ws;
    F.ctl = (gu32*)(F.ws + WS_CTL);
    const Args& AR = args;
    for (int u = F.tid; u < (LDS_BYTES - LDSCTL_OFF) / 4; u += NWAVES * 64) ((LAS unsigned*)(F.lds + LDSCTL_OFF))[u] = 0u;
    __syncthreads();
    XcdBarrier bar; bar.bar = (unsigned*)(F.ctl + CW_BAR); bar.x = 0; bar.st = nullptr;
#if !MK_PER_PHASE
    bar = xcd_barrier_post((unsigned*)(F.ctl + CW_BAR), F.MISC + 8);
#endif
    unsigned long long tacc_ = 0ull; unsigned tcnt_ = 0u;
    const unsigned long long tk0c_ = (PROBE_SEC == 10) ? __builtin_amdgcn_s_memtime() : 0ull, tk0r_ = (PROBE_SEC == 10) ? __builtin_amdgcn_s_memrealtime() : 0ull;
    const int lo = args.ph_lo, hi = args.ph_hi;
#if defined(ONLY_PHASE)
#define IN(k) ((k) == ONLY_PHASE && lo <= (k) && (k) < hi)
#elif defined(PHASE_MASK)
#define IN(k) (((PHASE_MASK >> (k)) & 1) && lo <= (k) && (k) < hi)
#else
#define IN(k) (lo <= (k) && (k) < hi)
#endif
#if MK_PER_PHASE
#define SEAM(k) do { } while (0)
#else
#define SEAM(k) do { if (IN(k) && IN((k) + 1)) xcd_barrier(bar); } while (0)
#endif
#define FRESH() Frame P = F; { int t_ = threadIdx.x; asm volatile("" : "+v"(t_)); P.tid = t_; P.lane = t_ & 63; P.wave = __builtin_amdgcn_readfirstlane(t_ >> 6); } const int gw = P.vcu * NWAVES + P.wave, NGW = P.G * NWAVES; (void)gw; (void)NGW

    for (int rep_ = 0; rep_ < (((REPEAT_MASK >> 0) & 1) ? 2 : 1); ++rep_) if (IN(0)) { FRESH(); p0_prologue(P, args); } SEAM(0);
    const unsigned long long tq0c_ = (PROBE_SEC == 12) ? __builtin_amdgcn_s_memtime() : 0ull, tq0r_ = (PROBE_SEC == 12) ? __builtin_amdgcn_s_memrealtime() : 0ull;
    for (int rep_ = 0; rep_ < (((REPEAT_MASK >> 1) & 1) ? 2 : 1); ++rep_) if (IN(1)) { pg8::Gemm g{((bf16*)(F.ws + WS_ACT)), ((bf16*)(F.ws + WS_WIN)), MTOK, LDP, 1024, 1024, 1024}; pg8::StaticOrder S; S.init(MTOK, LDP, F.G, (int)blockIdx.x);
        pg8::EpiStoreBf16 E{((bf16*)(F.ws + WS_PROJ)), LDP};
        pg8::gemm_phase<pg8::EpiStoreBf16, pg8::StaticOrder, true, true>(F.lds, g, S, E); } SEAM(1);
    if (PROBE_SEC == 12) { const unsigned long long dc = __builtin_amdgcn_s_memtime() - tq0c_, dr = __builtin_amdgcn_s_memrealtime() - tq0r_; tacc_ = dc * 100ull / (dr ? dr : 1ull); tcnt_ = 1u; }
    if (IN(2)) { FRESH(); for (int m = gw; m < MTOK; m += NGW) fixup_token(P, args, m);
        for (int r0 = gw * 32; r0 < MTOK; r0 += NGW * 32) pool_run(P, r0, 32);
        const float su = i8_scale(__hip_atomic_load(P.ctl + CW_AMAX, RLX_AGENT)), sv = fp8_scale(__hip_atomic_load(P.ctl + CW_AMAX + 1, RLX_AGENT));
#pragma unroll 4
        for (int r = gw; r < 2 * 16384; r += NGW) { const int rr = r & 16383;
            if (r < 16384) row_to_i8(args.in[13] + (size_t)rr * 1024, (unsigned char*)(P.ws + WS_U16) + (size_t)rr * 128, su, P.lane);
            else row_to_fp8(args.in[14] + (size_t)rr * 1024, (unsigned char*)(P.ws + WS_V16) + (size_t)rr * 128, sv, P.lane); } } SEAM(2);
    for (int rep_ = 0; rep_ < (((REPEAT_MASK >> 3) & 1) ? 2 : 1); ++rep_) if (IN(3)) { FRESH(); for (int i = P.vcu; i < 256; i += P.G) { const int b = i >> 4, s = i & 15;
#pragma unroll 1
            for (int k = 0; k < 4; ++k) idx_unit(P, args, b, (k == 0) ? s : (k == 1) ? 31 - s : (k == 2) ? 32 + s : 63 - s, tacc_, tcnt_, PROBE_NOSEL ? (rep_ == 1) : true); } } SEAM(3);
    const unsigned long long tp4_ = (PROBE_SEC == 5 || PROBE_SEC == 6 || PROBE_SEC == 7) ? ((PROBE_SEC != 6) ? __builtin_amdgcn_s_memtime() : __builtin_amdgcn_s_memrealtime()) : 0ull;
    for (int rep_ = 0; rep_ < (((REPEAT_MASK >> 4) & 1) ? 2 : 1); ++rep_) if (IN(4)) { FRESH(); for (int i = P.vcu; i < 256; i += P.G) { const int bh = i >> 1, s = i & 1, b = bh >> 3, h = bh & 7;
#pragma unroll 1
            for (int k = 0; k < 8; ++k) attn_unit(P, args, b, h, (k & 1) ? 15 - (k >> 1) * 2 - s : (k >> 1) * 2 + s, tacc_, tcnt_); }
        if (PROBE_SEC == 7) { tacc_ = (__builtin_amdgcn_s_memtime() - tp4_) / 1000ull; tcnt_ = 1u; } } SEAM(4);
    if (PROBE_SEC == 5) { tacc_ = (__builtin_amdgcn_s_memtime() - tp4_) / 1000ull; tcnt_ = 1u; }
    if (PROBE_SEC == 6) { tacc_ = (__builtin_amdgcn_s_memrealtime() - tp4_) / 10ull; tcnt_ = 1u; }
    for (int rep_ = 0; rep_ < (((REPEAT_MASK >> 5) & 1) ? 2 : 1); ++rep_) if (IN(5)) { pg8::Gemm g{((bf16*)(F.ws + WS_AO)), ((bf16*)(F.ws + WS_WA)), MTOK, 1024, 512, 512, 512}; pg8::StaticOrder S; S.init(MTOK, 1024, F.G, (int)blockIdx.x);
        pg8::EpiGate<false> E{((bf16*)(F.ws + WS_ACT)), 1024, ((bf16*)(F.ws + WS_PROJ)) + GA_OFF, LDP};
        pg8::gemm_phase<pg8::EpiGate<false>, pg8::StaticOrder, true, true>(F.lds, g, S, E); }
    if (IN(6)) { pg8::Gemm g{((bf16*)(F.ws + WS_POOLED)), ((bf16*)(F.ws + WS_WPP)), MTOK, 1024, 512, 512, 512}; pg8::StaticOrder S; S.init(MTOK, 1024, F.G, (int)blockIdx.x);
                pg8::EpiGate<true> E{((bf16*)(F.ws + WS_ACT)), 1024, ((bf16*)(F.ws + WS_PROJ)) + GP_OFF, LDP};
        pg8::gemm_phase<pg8::EpiGate<true>, pg8::StaticOrder, true, true>(F.lds, g, S, E); } SEAM(6);
    for (int rep_ = 0; rep_ < (((REPEAT_MASK >> 7) & 1) ? 2 : 1); ++rep_) if (IN(7)) { pg8::Gemm g{((bf16*)(F.ws + WS_ACT)), ((bf16*)(F.ws + WS_WO)), MTOK, 1024, 1024, 1024, 1024}; pg8::StaticOrder S; S.init(MTOK, 1024, F.G, (int)blockIdx.x);
        pg8::EpiResHG E{(AR.in[0]), (AR.out), ((bf16*)(F.ws + WS_HG)), (AR.in[10]), ((float*)(F.ws + WS_SSP)), 1024};
        pg8::gemm_phase<pg8::EpiResHG, pg8::StaticOrder, true, true>(F.lds, g, S, E); } SEAM(7);

    for (int rep_ = 0; rep_ < (((REPEAT_MASK >> 9) & 1) ? 2 : 1); ++rep_) if (IN(9)) { pg8::Gemm g{((bf16*)(F.ws + WS_HG)), ((bf16*)(F.ws + WS_W2)), MTOK, 1024, 1024, 1024, 1024}; pg8::StaticOrder S; S.init(MTOK, 1024, F.G, (int)blockIdx.x);
        pg8::EpiStoreBf16 E{((bf16*)(F.ws + WS_SUBK)), 1024};
        pg8::gemm_phase<pg8::EpiStoreBf16, pg8::StaticOrder, true, true>(F.lds, g, S, E); } SEAM(9);
    for (int rep_ = 0; rep_ < (((REPEAT_MASK >> 10) & 1) ? 2 : 1); ++rep_) if (IN(10)) { FRESH(); for (int tt = P.vcu; tt < MTOK / 32; tt += P.G) route_task(P, args, tt, P.wave); } SEAM(10);
        const unsigned long long tg0c_ = (PROBE_SEC == 11) ? __builtin_amdgcn_s_memtime() : 0ull, tg0r_ = (PROBE_SEC == 11) ? __builtin_amdgcn_s_memrealtime() : 0ull;
    for (int rep_ = 0; rep_ < (((REPEAT_MASK >> 11) & 1) ? 2 : 1); ++rep_) if (IN(11)) { FRESH(); peer_side<0>(P, args, rep_); } SEAM(11);
    if (IN(12)) { FRESH(); const float iu = i8_inv_scale(__hip_atomic_load(P.ctl + CW_AMAX, RLX_AGENT)), iv = fp8_inv_scale(__hip_atomic_load(P.ctl + CW_AMAX + 1, RLX_AGENT));
        for (int m = gw; m < MTOK; m += NGW) peer_coef_token(P, (size_t)m, iu, iv); } SEAM(12);
    for (int rep_ = 0; rep_ < (((REPEAT_MASK >> 13) & 1) ? 2 : 1); ++rep_) if (IN(13)) { FRESH(); peer_side<1>(P, args, rep_); }
#if PROBE_SEC == 11
    { const unsigned long long dc = __builtin_amdgcn_s_memtime() - tg0c_, dr = __builtin_amdgcn_s_memrealtime() - tg0r_; tacc_ = dc * 100ull / (dr ? dr : 1ull); tcnt_ = 1u; }
#endif
#if PROBE_SEC == 10
    { const unsigned long long dc = __builtin_amdgcn_s_memtime() - tk0c_, dr = __builtin_amdgcn_s_memrealtime() - tk0r_; tacc_ = dc * 100ull / (dr ? dr : 1ull); tcnt_ = 1u; }
#endif
#if PROBE_RATE
    { int lane_ = threadIdx.x; asm volatile("" : "+v"(lane_)); int x = lane_ * 3 + 1, y = lane_ ^ 0x55; int a[8]; f32x2v f[8]; const f32x2v fx = {1.0001f, 0.9999f}, fy = {1e-9f, 2e-9f};
#pragma unroll
      for (int k = 0; k < 8; ++k) { a[k] = lane_ + k; f[k] = (f32x2v){(float)k, 1.f}; }
#pragma unroll 1
      for (int i = 0; i < 640; ++i) {
#pragma unroll
          for (int r = 0; r < 8; ++r)
#pragma unroll
              for (int k = 0; k < 8; ++k) {
                  if (PROBE_RATE == 1) asm volatile("v_dot4c_i32_i8_e32 %0, %1, %2" : "+v"(a[k]) : "v"(x), "v"(y));
                  if (PROBE_RATE == 2) asm volatile("v_pk_fma_f32 %0, %1, %2, %0" : "+v"(f[k]) : "v"(fx), "v"(fy));
                  if (PROBE_RATE == 3) asm volatile("v_cvt_pk_f32_fp8_e32 %0, %1" : "=v"(f[k]) : "v"(x));
                  if (PROBE_RATE == 4) asm volatile("v_add_u32_dpp %0, %0, %0 quad_perm:[1,0,3,2] row_mask:0xf bank_mask:0xf bound_ctrl:1" : "+v"(a[k]));
                  if (PROBE_RATE == 5) asm volatile("v_perm_b32 %0, %0, %1, %2" : "+v"(a[k]) : "v"(x), "v"(y));
                  if (PROBE_RATE == 6) asm volatile("v_fma_f32 %0, %1, %2, %0" : "+v"(f[k].x) : "v"(fx.x), "v"(fy.x));
                  if (PROBE_RATE == 7) asm volatile("v_lshl_or_b32 %0, %0, 10, %1" : "+v"(a[k]) : "v"(x));
                  if (PROBE_RATE == 10) asm volatile("v_dot4c_i32_i8_e32 %0, %1, %2" : "+v"(a[0]) : "v"(x), "v"(y));
                  if (PROBE_RATE == 11) asm volatile("v_pk_fma_f32 %0, %1, %2, %0" : "+v"(f[0]) : "v"(fx), "v"(fy));
              }
      }
      int sum = 0;
#pragma unroll
      for (int k = 0; k < 8; ++k) sum += a[k] + (int)f[k].x + (int)f[k].y;
      if (sum == 0x7fffffff) ((volatile int*)(F.ws + WS_CTL))[2048 + threadIdx.x] = sum; }
#endif
#if PROBE_SEC
    if (blockIdx.x == 0 && F.wave == 7) { const unsigned long long avg = tacc_ / (unsigned long long)(tcnt_ ? tcnt_ : 1u); const unsigned long long t_end = __builtin_amdgcn_s_memrealtime() + avg * 10ull;
        while (__builtin_amdgcn_s_memrealtime() < t_end) __builtin_amdgcn_s_sleep(8); }
#endif

#undef IN
#undef SEAM
}

extern "C" void kernel_launch(void* const* d_in, const int* in_sizes, int n_in, void* d_out, int out_size, void* d_ws, size_t ws_size, hipStream_t stream) {
    static int grid = 0;
    if (grid == 0) {
        if (n_in != 15 || in_sizes[0] != MTOK * DM || out_size != MTOK * DM || ws_size < WS_END) { fprintf(stderr, "kernel_launch: unexpected shapes (n_in %d, in0 %d, out %d, ws %zu < %zu)\n", n_in, n_in > 0 ? in_sizes[0] : -1, out_size, ws_size, (size_t)WS_END); grid = -1; return; }
        int dev = 0, cus = 0, per_cu = 0;
        if (hipGetDevice(&dev) != hipSuccess || hipDeviceGetAttribute(&cus, hipDeviceAttributeMultiprocessorCount, dev) != hipSuccess) { grid = -1; return; }
        if (hipFuncSetAttribute((const void*)mk_fwd, hipFuncAttributeMaxDynamicSharedMemorySize, LDS_BYTES) != hipSuccess) { fprintf(stderr, "kernel_launch: hipFuncSetAttribute failed\n"); grid = -1; return; }
        if (hipOccupancyMaxActiveBlocksPerMultiprocessor(&per_cu, (const void*)mk_fwd, NWAVES * 64, LDS_BYTES) != hipSuccess || per_cu < 1) { fprintf(stderr, "kernel_launch: occupancy query says %d blocks per CU\n", per_cu); (void)hipGetLastError(); grid = -1; return; }
        grid = cus;
    }
    if (grid < 0) return;
    if (hipMemsetAsync((char*)d_ws + WS_CTL, 0, CTL_ZERO_BYTES, stream) != hipSuccess) return;
    Args a{};
    for (int i = 0; i < 15; ++i) a.in[i] = (const float*)d_in[i];
    a.out = (float*)d_out; a.ws = (unsigned char*)d_ws;
#if MK_PER_PHASE
    for (int p = 0; p < NPHASE; ++p) { a.ph_lo = p; a.ph_hi = p + 1; hipLaunchKernelGGL(mk_fwd, dim3(grid), dim3(NWAVES * 64), LDS_BYTES, stream, a); }
#else
    a.ph_lo = 0; a.ph_hi = NPHASE;
    hipLaunchKernelGGL(mk_fwd, dim3(grid), dim3(NWAVES * 64), LDS_BYTES, stream, a);
#endif
}
```

```cpp
#include <hip/hip_runtime.h>
#include <cstdio>
#include <cstdint>
namespace pg8 {
#define PG8_LAS __attribute__((address_space(3)))
typedef unsigned short bf16_t;
typedef short bf16x8 __attribute__((ext_vector_type(8)));
typedef float f32x4 __attribute__((ext_vector_type(4)));
typedef unsigned u32x4 __attribute__((ext_vector_type(4)));
constexpr int BM = 256, BK = 64, HALF = 128, HTB = HALF * BK * 2  , STAGE_BYTES = 8 * HTB, NXCD = 8, WGM = 8;

__host__ __device__ __forceinline__ int lds_byte(int r, int c) { const int st = (r >> 4) * 2 + (c >> 5), rr = r & 15, cc = c & 31, ob = rr * 64 + cc * 2; return st * 1024 + (ob ^ (((ob >> 9) & 1) << 5)); }
__host__ __device__ __forceinline__ void stage_rc(int b, int& R, int& C) { const int st = b / 1024, sb = b % 1024, swz = sb ^ (((sb >> 9) & 1) << 5); R = (st >> 1) * 16 + swz / 64; C = (st & 1) * 32 + (swz % 64) / 2; }
__host__ __device__ __forceinline__ int perm32(int rho) { const int n = rho >> 4, i = rho & 15; return 8 * (i >> 2) + 4 * n + (i & 3); }

struct Unit { int pm, pn; };
struct Gemm { const bf16_t* A; const bf16_t* Bt; int M, N, K, lda, ldb; };

struct StaticOrder {
    int nM, nN, nwg, G, c;
    __host__ __device__ void init(int M, int N, int G_, int c_) { nM = M / BM; nN = N / BM; nwg = nM * nN; G = G_; c = c_; }
    __host__ __device__ bool next(int i, Unit& u) const {
        const long L = (long)i * G + c; if (L >= nwg) return false;
        int wgid = (int)L; { const int q = nwg / NXCD, r = nwg % NXCD, xcd = wgid % NXCD, off = wgid / NXCD; wgid = (xcd < r ? xcd * (q + 1) : r * (q + 1) + (xcd - r) * q) + off; }
        const int nig = WGM * nN, gid = wgid / nig, fm = gid * WGM, gsz = (nM - fm) < WGM ? (nM - fm) : WGM;
        u.pm = fm + ((wgid % nig) % gsz); u.pn = (wgid % nig) / gsz; return true;
    }
    __device__ __forceinline__ void a_ready(const Unit&) const {}
    __device__ __forceinline__ void done(const Unit&) const {}
};
struct PanelOrder {
    int nN, pm;
    __host__ __device__ bool next(int i, Unit& u) const { if (i >= nN) return false; u.pm = pm; u.pn = i; return true; }
    __device__ __forceinline__ void a_ready(const Unit&) const {}
    __device__ __forceinline__ void done(const Unit&) const {}
};
typedef float f32x2c_t __attribute__((ext_vector_type(2))); typedef __bf16 bf16x2c_t __attribute__((ext_vector_type(2)));
__device__ __forceinline__ unsigned cvt_pk_bf16(float lo, float hi) { f32x2c_t v = {lo, hi}; bf16x2c_t b = __builtin_convertvector(v, bf16x2c_t); return __builtin_bit_cast(unsigned, b); }
typedef float f32x2 __attribute__((ext_vector_type(2)));
__device__ __forceinline__ f32x2 gelu_pk(f32x2 v) {
    const f32x2 av = __builtin_elementwise_abs(v), d = av * 0.2316418882f + 1.0f;
    f32x2 t; t.x = __builtin_amdgcn_rcpf(d.x); t.y = __builtin_amdgcn_rcpf(d.y);
    f32x2 q = t * 0.5307027145f + (-0.7265760135f); q = q * t + 0.7107068705f; q = q * t + (-0.142248368f); q = q * t + 0.127414796f; q = q * t;
    const f32x2 s = (v * v) * (-0.72134752044f);
    f32x2 e; e.x = __builtin_amdgcn_exp2f(s.x); e.y = __builtin_amdgcn_exp2f(s.y);
    const f32x2 m = v * (q * e), r = v - m;
    f32x2 o; o.x = v.x < 0.f ? m.x : r.x; o.y = v.y < 0.f ? m.y : r.y; return o;
}
typedef unsigned u32x2e __attribute__((ext_vector_type(2)));
__device__ __forceinline__ float bf_lo(unsigned w) { return __uint_as_float(w << 16); }
__device__ __forceinline__ float bf_hi(unsigned w) { return __uint_as_float(w & 0xffff0000u); }
__device__ __forceinline__ float sigmoidf_fast(float g) { return __builtin_amdgcn_rcpf(1.0f + __builtin_amdgcn_exp2f(-1.4426950408889634f * g)); }
__device__ __forceinline__ unsigned ord_key(float f) { const unsigned b = __float_as_uint(f); return b ^ ((unsigned)((int)b >> 31) | 0x80000000u); }
__device__ __forceinline__ float unord_key(unsigned k) { return __uint_as_float((k & 0x80000000u) ? (k ^ 0x80000000u) : ~k); }

struct EpiStoreBf16 {
    static constexpr bool PERM = true, AFTER_DRAIN = false;
    bf16_t* O; int ldc;
    __device__ __forceinline__ void operator()(const f32x4 (&acc)[2][2][4][2], const Unit& u, int wr, int wc, int fr, int fq) const {
        const int row0 = u.pm * BM + wr * 64 + fr, col0 = u.pn * BM + wc * 32 + 8 * fq;
#pragma unroll
        for (int ai = 0; ai < 2; ++ai)
#pragma unroll
            for (int m = 0; m < 4; ++m) { bf16_t* rowp = O + (size_t)(row0 + ai * HALF + m * 16) * ldc + col0;
#pragma unroll
                for (int bj = 0; bj < 2; ++bj) { const f32x4 v0 = acc[ai][bj][m][0], v1 = acc[ai][bj][m][1];
                    u32x4 w; w.x = cvt_pk_bf16(v0[0], v0[1]); w.y = cvt_pk_bf16(v0[2], v0[3]); w.z = cvt_pk_bf16(v1[0], v1[1]); w.w = cvt_pk_bf16(v1[2], v1[3]);
                    *(u32x4*)(rowp + bj * HALF) = w; } }
    }
};
template <bool ADD> struct EpiGate {
    static constexpr bool PERM = true, AFTER_DRAIN = false;
    bf16_t* O; int ldc; const bf16_t* G; int ldg;
    __device__ __forceinline__ void operator()(const f32x4 (&acc)[2][2][4][2], const Unit& u, int wr, int wc, int fr, int fq) const {
        const int row0 = u.pm * BM + wr * 64 + fr, col0 = u.pn * BM + wc * 32 + 8 * fq;
#pragma unroll
        for (int ai = 0; ai < 2; ++ai)
#pragma unroll
            for (int m = 0; m < 4; ++m) { const size_t row = (size_t)(row0 + ai * HALF + m * 16);
#pragma unroll
                for (int bj = 0; bj < 2; ++bj) { const int col = col0 + bj * HALF;
                    const u32x4 gr = *(const u32x4*)(G + row * ldg + col);
                    f32x4 v0 = acc[ai][bj][m][0], v1 = acc[ai][bj][m][1];
                    v0[0] *= sigmoidf_fast(bf_lo(gr.x)); v0[1] *= sigmoidf_fast(bf_hi(gr.x)); v0[2] *= sigmoidf_fast(bf_lo(gr.y)); v0[3] *= sigmoidf_fast(bf_hi(gr.y));
                    v1[0] *= sigmoidf_fast(bf_lo(gr.z)); v1[1] *= sigmoidf_fast(bf_hi(gr.z)); v1[2] *= sigmoidf_fast(bf_lo(gr.w)); v1[3] *= sigmoidf_fast(bf_hi(gr.w));
                    bf16_t* op = O + row * ldc + col;
                    if (ADD) { const u32x4 pr = *(const u32x4*)op;
                        v0[0] += bf_lo(pr.x); v0[1] += bf_hi(pr.x); v0[2] += bf_lo(pr.y); v0[3] += bf_hi(pr.y);
                        v1[0] += bf_lo(pr.z); v1[1] += bf_hi(pr.z); v1[2] += bf_lo(pr.w); v1[3] += bf_hi(pr.w); }
                    u32x4 w; w.x = cvt_pk_bf16(v0[0], v0[1]); w.y = cvt_pk_bf16(v0[2], v0[3]); w.z = cvt_pk_bf16(v1[0], v1[1]); w.w = cvt_pk_bf16(v1[2], v1[3]);
                    *(u32x4*)op = w; } }
    }
};
struct EpiResF32 {
    static constexpr bool PERM = false, AFTER_DRAIN = false;
    const float* base; float* out; int ldc;
    __device__ __forceinline__ void operator()(const f32x4 (&acc)[2][2][4][2], const Unit& u, int wr, int wc, int fr, int fq) const {
        const int col0 = u.pn * BM + wc * 32 + 4 * fq;
#pragma unroll
        for (int ai = 0; ai < 2; ++ai)
#pragma unroll
            for (int m = 0; m < 4; ++m) { const size_t off = (size_t)(u.pm * BM + ai * HALF + wr * 64 + m * 16 + fr) * ldc + col0;
#pragma unroll
                for (int bj = 0; bj < 2; ++bj)
#pragma unroll
                    for (int n = 0; n < 2; ++n) { const f32x4 bs = *(const f32x4*)(base + off + bj * HALF + n * 16); *(f32x4*)(out + off + bj * HALF + n * 16) = bs + acc[ai][bj][m][n]; } }
    }
};
struct EpiResHG {
    static constexpr bool PERM = false, AFTER_DRAIN = false;
    const float* base; float* out; bf16_t* hg; const float* gain; float* ssp; int ldc;
    __device__ __forceinline__ void operator()(const f32x4 (&acc)[2][2][4][2], const Unit& u, int wr, int wc, int fr, int fq) const {
        const int col0 = u.pn * BM + wc * 32 + 4 * fq;
        f32x4 gv[2][2];
#pragma unroll
        for (int bj = 0; bj < 2; ++bj)
#pragma unroll
            for (int n = 0; n < 2; ++n) gv[bj][n] = *(const f32x4*)(gain + col0 + bj * HALF + n * 16);
#pragma unroll
        for (int ai = 0; ai < 2; ++ai)
#pragma unroll
            for (int m = 0; m < 4; ++m) { const int row = u.pm * BM + ai * HALF + wr * 64 + m * 16 + fr; const size_t off = (size_t)row * ldc + col0; float ss = 0.f;
#pragma unroll
                for (int bj = 0; bj < 2; ++bj)
#pragma unroll
                    for (int n = 0; n < 2; ++n) { const f32x4 h = *(const f32x4*)(base + off + bj * HALF + n * 16) + acc[ai][bj][m][n]; *(f32x4*)(out + off + bj * HALF + n * 16) = h;
                        ss += (h[0] * h[0] + h[1] * h[1]) + (h[2] * h[2] + h[3] * h[3]);
                        const f32x4 hgv = h * gv[bj][n]; u32x2e w; w.x = cvt_pk_bf16(hgv[0], hgv[1]); w.y = cvt_pk_bf16(hgv[2], hgv[3]); *(u32x2e*)(hg + off + bj * HALF + n * 16) = w; }
                ss += __shfl_xor(ss, 16); ss += __shfl_xor(ss, 32);
                if (fq == 0) ssp[(size_t)row * 16 + u.pn * 4 + wc] = ss; }
    }
};
struct EpiKeys {
    static constexpr bool PERM = false, AFTER_DRAIN = false;
    unsigned* O; int ldc;
    __device__ __forceinline__ void operator()(const f32x4 (&acc)[2][2][4][2], const Unit& u, int wr, int wc, int fr, int fq) const {
        const int col0 = u.pn * BM + wc * 32 + 4 * fq;
#pragma unroll
        for (int ai = 0; ai < 2; ++ai)
#pragma unroll
            for (int m = 0; m < 4; ++m) { const size_t off = (size_t)(u.pm * BM + ai * HALF + wr * 64 + m * 16 + fr) * ldc + col0;
#pragma unroll
                for (int bj = 0; bj < 2; ++bj)
#pragma unroll
                    for (int n = 0; n < 2; ++n) { const int nn = (col0 + bj * HALF + n * 16) & 127; const f32x4 a = acc[ai][bj][m][n]; u32x4 w;
                        w.x = (ord_key(a[0]) & ~127u) | (unsigned)(127 - nn); w.y = (ord_key(a[1]) & ~127u) | (unsigned)(126 - nn);
                        w.z = (ord_key(a[2]) & ~127u) | (unsigned)(125 - nn); w.w = (ord_key(a[3]) & ~127u) | (unsigned)(124 - nn);
                        *(u32x4*)(O + off + bj * HALF + n * 16) = w; } }
    }
};

template <class Epi, class Sched, bool ALIGN_EPI = false, bool SP2 = false>
__device__ __forceinline__ void gemm_phase(PG8_LAS unsigned char* lds, const Gemm g, const Sched& S, const Epi& E) {
    int tid_ = threadIdx.x; asm volatile("" : "+v"(tid_));
    const int tid = tid_, wid = __builtin_amdgcn_readfirstlane(tid >> 6), lane = tid & 63, wr = wid >> 2, wc = wid & 3, fr = lane & 15, fq = lane >> 4;
    const int K = g.K, nt = K / BK;
    unsigned voffA[2], voffB[2];
#pragma unroll
    for (int i = 0; i < 2; ++i) { int R, C; stage_rc(tid * 16 + i * 8192, R, C); const int Rb = Epi::PERM ? ((R & ~31) + perm32(R & 31)) : R;
        voffA[i] = (unsigned)(R * g.lda + C) * 2u; voffB[i] = (unsigned)(Rb * g.ldb + C) * 2u; }
    const size_t kstep = (size_t)(BK * 2);
    const size_t hstepA = (size_t)HALF * g.lda * 2, hstepB = (size_t)HALF * g.ldb * 2;
    const size_t tstepA = 2 * hstepA, tstepB = 2 * hstepB;
    const unsigned ldsw = (unsigned)wid * 1024u;
    const int aoff = lds_byte(wr * 64 + fr, fq * 8), boff = lds_byte(wc * 32 + fr, fq * 8);
#define PG8_SA(b, h) (((b) * 2 + (h)) * HTB)
#define PG8_SB(b, h) ((4 + (b) * 2 + (h)) * HTB)
#define PG8_STAGE(bufoff, gbase, voff) do { _Pragma("unroll") for (int _i = 0; _i < 2; ++_i) \
        __builtin_amdgcn_global_load_lds((const unsigned*)((const char*)(gbase) + (voff)[_i]), (PG8_LAS unsigned*)(lds + (bufoff) + ldsw + _i * 8192), 16, 0, 0); } while (0)
#define PG8_LDA(dst, b, h) do { _Pragma("unroll") for (int m = 0; m < 4; ++m) _Pragma("unroll") for (int k = 0; k < 2; ++k) dst[m][k] = *(const PG8_LAS bf16x8*)(lds + PG8_SA(b, h) + aoff + m * 2048 + k * 1024); } while (0)
#define PG8_LDB(dst, b, h) do { _Pragma("unroll") for (int n = 0; n < 2; ++n) _Pragma("unroll") for (int k = 0; k < 2; ++k) dst[n][k] = *(const PG8_LAS bf16x8*)(lds + PG8_SB(b, h) + boff + n * 2048 + k * 1024); } while (0)
#define PG8_MMA(ai, bj, At, Bt) do { __builtin_amdgcn_s_setprio(1); _Pragma("unroll") for (int m = 0; m < 4; ++m) _Pragma("unroll") for (int n = 0; n < 2; ++n) _Pragma("unroll") for (int k = 0; k < 2; ++k) \
        acc[ai][bj][m][n] = __builtin_amdgcn_mfma_f32_16x16x32_bf16(Bt[n][k], At[m][k], acc[ai][bj][m][n], 0, 0, 0); __builtin_amdgcn_s_setprio(0); } while (0)
#define PG8_WAIT_V(n) asm volatile("s_waitcnt vmcnt(" #n ")" ::: "memory")
#define PG8_WAIT_L(n) asm volatile("s_waitcnt lgkmcnt(" #n ")" ::: "memory")
#define PG8_BAR __builtin_amdgcn_s_barrier()
#define PG8_SCHED __builtin_amdgcn_sched_barrier(0)
    Unit cur, nxt; int ui = 0;
    if (!S.next(0, cur)) return;
    f32x4 acc[2][2][4][2];
#pragma unroll
    for (int a = 0; a < 2; ++a)
#pragma unroll
        for (int b = 0; b < 2; ++b)
#pragma unroll
            for (int m = 0; m < 4; ++m)
#pragma unroll
                for (int n = 0; n < 2; ++n) acc[a][b][m][n] = (f32x4){0.f, 0.f, 0.f, 0.f};
    bf16x8 At[4][2], B0[2][2], B1[2][2];
    const char* cA = (const char*)g.A + (size_t)cur.pm * tstepA; const char* cB = (const char*)g.Bt + (size_t)cur.pn * tstepB;
    S.a_ready(cur);
    if constexpr (SP2) {
        PG8_STAGE(PG8_SB(0, 0), cB, voffB); PG8_STAGE(PG8_SB(0, 1), cB + hstepB, voffB); PG8_STAGE(PG8_SA(0, 0), cA, voffA); PG8_STAGE(PG8_SA(0, 1), cA + hstepA, voffA);
        if (wr == 1) PG8_BAR;
        PG8_WAIT_V(2); PG8_BAR;
        PG8_STAGE(PG8_SB(1, 0), cB + kstep, voffB); PG8_STAGE(PG8_SA(1, 0), cA + kstep, voffA); PG8_STAGE(PG8_SB(1, 1), cB + hstepB + kstep, voffB);
        PG8_WAIT_V(6); PG8_BAR;
    } else {
        PG8_STAGE(PG8_SB(0, 0), cB, voffB); PG8_STAGE(PG8_SA(0, 0), cA, voffA); PG8_STAGE(PG8_SB(0, 1), cB + hstepB, voffB); PG8_STAGE(PG8_SA(0, 1), cA + hstepA, voffA);
        if (wr == 1) PG8_BAR;
        PG8_WAIT_V(4); PG8_BAR;
        PG8_STAGE(PG8_SB(1, 0), cB + kstep, voffB); PG8_STAGE(PG8_SA(1, 0), cA + kstep, voffA); PG8_STAGE(PG8_SB(1, 1), cB + hstepB + kstep, voffB);
        PG8_WAIT_V(6); PG8_BAR;
    }
    for (;;) {
        const bool has_next = S.next(ui + 1, nxt);
        const char* nA = has_next ? (const char*)g.A + (size_t)nxt.pm * tstepA : cA; const char* nB = has_next ? (const char*)g.Bt + (size_t)nxt.pn * tstepB : cB;
        for (int t = 0; t < nt; t += 2) {
            const bool last = (t == nt - 2);
            const char* a1 = cA + (size_t)(t + 1) * kstep;
            const char* a2 = last ? nA : cA + (size_t)(t + 2) * kstep; const char* b2 = last ? nB : cB + (size_t)(t + 2) * kstep;
            const char* a3 = a2 + kstep; const char* b3 = b2 + kstep;
            if (last && has_next) S.a_ready(nxt);
            if constexpr (SP2) {
            PG8_LDB(B0, 0, 0); PG8_LDB(B1, 0, 1); PG8_SCHED; PG8_LDA(At, 0, 0); PG8_STAGE(PG8_SA(1, 1), a1 + hstepA, voffA);
            PG8_WAIT_V(8); PG8_WAIT_L(0); PG8_BAR; PG8_MMA(0, 0, At, B0); PG8_MMA(0, 1, At, B1); PG8_BAR; PG8_SCHED;
            PG8_LDA(At, 0, 1); PG8_STAGE(PG8_SB(0, 0), b2, voffB); PG8_STAGE(PG8_SB(0, 1), b2 + hstepB, voffB); PG8_STAGE(PG8_SA(0, 0), a2, voffA);
            PG8_WAIT_V(8); PG8_WAIT_L(0); PG8_BAR; PG8_MMA(1, 0, At, B0); PG8_MMA(1, 1, At, B1); PG8_BAR; PG8_SCHED;
            PG8_LDB(B0, 1, 0); PG8_LDB(B1, 1, 1); PG8_SCHED; PG8_LDA(At, 1, 0); PG8_STAGE(PG8_SA(0, 1), a2 + hstepA, voffA);
            PG8_WAIT_V(8); PG8_WAIT_L(0); PG8_BAR; PG8_MMA(0, 0, At, B0); PG8_MMA(0, 1, At, B1); PG8_BAR; PG8_SCHED;
            PG8_LDA(At, 1, 1); PG8_STAGE(PG8_SB(1, 0), b3, voffB); PG8_STAGE(PG8_SB(1, 1), b3 + hstepB, voffB); PG8_STAGE(PG8_SA(1, 0), a3, voffA);
            PG8_WAIT_V(8); PG8_WAIT_L(0); PG8_BAR; PG8_MMA(1, 0, At, B0); PG8_MMA(1, 1, At, B1); PG8_BAR; PG8_SCHED;
            } else {
            PG8_LDB(B0, 0, 0); PG8_SCHED; PG8_LDA(At, 0, 0); PG8_STAGE(PG8_SA(1, 1), a1 + hstepA, voffA);
            PG8_WAIT_L(8); PG8_BAR; PG8_WAIT_L(0); PG8_MMA(0, 0, At, B0); PG8_BAR; PG8_SCHED;
            PG8_LDB(B1, 0, 1); PG8_STAGE(PG8_SB(0, 0), b2, voffB);
            PG8_BAR; PG8_WAIT_L(0); PG8_MMA(0, 1, At, B1); PG8_BAR;
            PG8_LDA(At, 0, 1); PG8_STAGE(PG8_SA(0, 0), a2, voffA);
            PG8_BAR; PG8_WAIT_L(0); PG8_MMA(1, 0, At, B0); PG8_BAR; PG8_SCHED;
            PG8_STAGE(PG8_SB(0, 1), b2 + hstepB, voffB);
            PG8_WAIT_V(6); PG8_BAR; PG8_MMA(1, 1, At, B1); PG8_BAR;
            PG8_LDB(B0, 1, 0); PG8_SCHED; PG8_LDA(At, 1, 0); PG8_STAGE(PG8_SA(0, 1), a2 + hstepA, voffA);
            PG8_WAIT_L(8); PG8_BAR; PG8_WAIT_L(0); PG8_MMA(0, 0, At, B0); PG8_BAR; PG8_SCHED;
            PG8_LDB(B1, 1, 1); PG8_STAGE(PG8_SB(1, 0), b3, voffB);
            PG8_BAR; PG8_WAIT_L(0); PG8_MMA(0, 1, At, B1); PG8_BAR;
            PG8_LDA(At, 1, 1); PG8_STAGE(PG8_SA(1, 0), a3, voffA);
            PG8_BAR; PG8_WAIT_L(0); PG8_MMA(1, 0, At, B0); PG8_BAR; PG8_SCHED;
            PG8_STAGE(PG8_SB(1, 1), b3 + hstepB, voffB);
            PG8_WAIT_V(6); PG8_BAR; PG8_MMA(1, 1, At, B1); PG8_BAR;
            }
        }
        if constexpr (ALIGN_EPI) { if (wr == 0) PG8_BAR; }
        if constexpr (!Epi::AFTER_DRAIN) { Unit ue = cur; asm volatile("" : "+s"(ue.pm), "+s"(ue.pn));
            E(acc, ue, wr, wc, fr, fq); S.done(cur); }
        if (!has_next) break;
#pragma unroll
        for (int a = 0; a < 2; ++a)
#pragma unroll
            for (int b = 0; b < 2; ++b)
#pragma unroll
                for (int m = 0; m < 4; ++m)
#pragma unroll
                    for (int n = 0; n < 2; ++n) acc[a][b][m][n] = (f32x4){0.f, 0.f, 0.f, 0.f};
        cur = nxt; cA = nA; cB = nB; ++ui;
        if constexpr (ALIGN_EPI) { if (wr == 1) PG8_BAR; }
    }
    PG8_WAIT_V(0);
    if constexpr (!ALIGN_EPI) { if (wr == 0) PG8_BAR; }
    PG8_BAR;
    if constexpr (Epi::AFTER_DRAIN) { E.fused(acc, cur, wr, wc, fr, fq, lds, wid, lane); S.done(cur); }
#undef PG8_SA
#undef PG8_SB
#undef PG8_STAGE
#undef PG8_LDA
#undef PG8_LDB
#undef PG8_MMA
#undef PG8_WAIT_V
#undef PG8_WAIT_L
#undef PG8_BAR
#undef PG8_SCHED
}
}

constexpr int NWAVES = 8;
#ifndef REPEAT_MASK
#define REPEAT_MASK 0
#endif
#ifndef PROBE_SEL2
#define PROBE_SEL2 1
#endif
#ifndef PROBE_SEC
#define PROBE_SEC 0
#endif
#ifndef PROBE_RATE
#define PROBE_RATE 0
#endif
#ifndef PROBE_FAKEID
#define PROBE_FAKEID 0
#endif
#ifndef PROBE_NOSEL
#define PROBE_NOSEL 0
#endif
#ifndef MK_PER_PHASE
#define MK_PER_PHASE 0
#endif
constexpr int NPHASE = 14;

constexpr int BATCH = 16, SEQ = 4096, DM = 1024, MTOK = BATCH * SEQ;
constexpr int LDP = 4864;
constexpr int Q_OFF = 0, K_OFF = 512, V_OFF = 1024, QI_OFF = 1536, P_OFF = 2048, GA_OFF = 2560, GP_OFF = 3584, KI_OFF = 4608, WI_OFF = 4672;
constexpr int IN_WIDTH = 4680;
constexpr float EPS = 1e-6f;
constexpr float C2 = 0.125f * 1.4426950408889634f;
constexpr float WI_SCALE = 0.35355339059327373f * 0.125f;

constexpr size_t MiB = 1u << 20;
constexpr size_t WS_CTL = 0, CTL_ZERO_BYTES = 1 * MiB;
constexpr size_t WS_ROPE = 1 * MiB;
constexpr size_t WS_WIN = 2 * MiB;
constexpr size_t WS_WA = 12 * MiB;
constexpr size_t WS_WPP = 13 * MiB;
constexpr size_t WS_WO = 14 * MiB;
constexpr size_t WS_W2 = 16 * MiB;
constexpr size_t WS_SKB = 19 * MiB;
constexpr size_t WS_U16 = 20 * MiB, WS_V16 = 52 * MiB;
constexpr size_t WS_MASK = 84 * MiB;
constexpr size_t WS_POOLED = 116 * MiB;
constexpr size_t WS_ACT = 180 * MiB;
constexpr size_t WS_PROJ = 308 * MiB;
constexpr size_t WS_AO = 916 * MiB;
constexpr size_t WS_REXP = 980 * MiB, WS_RG = 116 * MiB;
constexpr size_t WS_HG = 308 * MiB;
constexpr size_t WS_SUBK = 436 * MiB;
constexpr size_t WS_SSP = 948 * MiB;
constexpr size_t WS_END = 1024 * MiB;
constexpr int CW_TMO = 0, CW_BAR = 4096, CW_AMAX = 12288;

constexpr int RING_BYTES = 131072;
constexpr int LDSCTL_OFF = RING_BYTES, MISC_OFF = LDSCTL_OFF + 320;
constexpr int LDS_BYTES = 147456;

#define GAS __attribute__((address_space(1)))
#define LAS __attribute__((address_space(3)))
typedef unsigned short bf16;
typedef unsigned v4u __attribute__((ext_vector_type(4)));
typedef unsigned v2u __attribute__((ext_vector_type(2)));
typedef float f32x4 __attribute__((ext_vector_type(4)));
typedef float f32x16 __attribute__((ext_vector_type(16)));
typedef short bf16x8 __attribute__((ext_vector_type(8)));
typedef short s16x4 __attribute__((ext_vector_type(4)));
typedef GAS unsigned gu32;
#define RLX_AGENT __ATOMIC_RELAXED, __HIP_MEMORY_SCOPE_AGENT
#define LDS_WAIT() asm volatile("s_waitcnt lgkmcnt(0)" ::: "memory")
#define BAR_LDS() asm volatile("s_waitcnt lgkmcnt(0)\n\ts_barrier" ::: "memory")
#define VM_WAIT() asm volatile("s_waitcnt vmcnt(0)" ::: "memory")
__device__ __forceinline__ unsigned f2bf(float f) { unsigned u = __builtin_bit_cast(unsigned, f); return (u + 0x7fffu + ((u >> 16) & 1u)) >> 16; }
typedef float f32x2k_t __attribute__((ext_vector_type(2))); typedef __bf16 bf16x2k_t __attribute__((ext_vector_type(2)));
__device__ __forceinline__ unsigned pk2(float lo, float hi) { f32x2k_t v = {lo, hi}; bf16x2k_t b = __builtin_convertvector(v, bf16x2k_t); return __builtin_bit_cast(unsigned, b); }
__device__ __forceinline__ float bflo(unsigned w) { return __uint_as_float(w << 16); }
__device__ __forceinline__ float bfhi(unsigned w) { return __uint_as_float(w & 0xffff0000u); }
__device__ __forceinline__ unsigned ordk(float f) { const unsigned b = __float_as_uint(f); return b ^ ((unsigned)((int)b >> 31) | 0x80000000u); }
__device__ __forceinline__ float unordk(unsigned k) { return __uint_as_float((k & 0x80000000u) ? (k ^ 0x80000000u) : ~k); }
__device__ __forceinline__ float relu_i(float x) { const int i = __float_as_int(x); return __int_as_float(i > 0 ? i : 0); }
__device__ __forceinline__ int crow(int r, int hi) { return (r & 3) + 8 * (r >> 2) + 4 * hi; }
typedef __bf16 bf16x2v_t __attribute__((ext_vector_type(2)));
__device__ __forceinline__ float dot2bf(unsigned a, unsigned b, float acc) { return __builtin_amdgcn_fdot2_f32_bf16(__builtin_bit_cast(bf16x2v_t, a), __builtin_bit_cast(bf16x2v_t, b), acc, false); }

#define XB_TMO      128
#define XB_XCNT(j)  (256  + 64 * (j))
#define XB_XSUB(j)  (1280 + 64 * (j))
#define XB_XGEN(j)  (2304 + 64 * (j))
#define XB_TOP      3328
#define XB_TOPGEN   3392
#define XCD_BAR_WORDS 3456
#define XB_SPIN_CAP (1u << 18)

__device__ __forceinline__ unsigned xb_ld(unsigned* p)              { return __hip_atomic_load(p, __ATOMIC_RELAXED, __HIP_MEMORY_SCOPE_AGENT); }
__device__ __forceinline__ unsigned xb_add(unsigned* p, unsigned v) { return __hip_atomic_fetch_add(p, v, __ATOMIC_RELAXED, __HIP_MEMORY_SCOPE_AGENT); }
__device__ __forceinline__ unsigned xb_xcc_id() { return (unsigned)__builtin_amdgcn_s_getreg((3 << 11) | 20) & 0xFu; }
#define XB_SPIN(cond, bar) do { unsigned _sp = 0; while (cond) { __builtin_amdgcn_s_sleep(1); \
    if ((++_sp & 255u) == 0u) { if (xb_ld(&(bar)[XB_TMO])) break; if (_sp > XB_SPIN_CAP) { atomicAdd(&(bar)[XB_TMO], 1u); break; } } } } while (0)

struct XcdBarrier {
    unsigned* bar; unsigned x;
    volatile LAS unsigned* st;
};

__device__ __forceinline__ XcdBarrier xcd_barrier_post(unsigned* bar, volatile LAS unsigned* st) {
    XcdBarrier b; b.bar = bar; b.x = xb_xcc_id(); b.st = st;
    if (threadIdx.x == 0) (void)xb_add(&bar[XB_XCNT(b.x)], 1u);
    return b;
}
__device__ __forceinline__ void xcd_barrier_complete(unsigned* bar, unsigned x, unsigned& nloc, unsigned& nx) {
    const unsigned G = gridDim.x * gridDim.y * gridDim.z;
    unsigned sum, cnt, mine, sp = 0u;
    for (;;) {
        sum = 0u; cnt = 0u; mine = 0u;
#pragma unroll
        for (unsigned j = 0; j < 16; ++j) { const unsigned c = xb_ld(&bar[XB_XCNT(j)]); sum += c; cnt += (c > 0u) ? 1u : 0u; mine = (j == x) ? c : mine; }
        if (sum == G) break;
        __builtin_amdgcn_s_sleep(1);
        if ((++sp & 255u) == 0u) { if (xb_ld(&bar[XB_TMO])) break; if (sp > XB_SPIN_CAP) { atomicAdd(&bar[XB_TMO], 1u); break; } }
    }
    nloc = mine > 0u ? mine : 1u; nx = cnt > 0u ? cnt : 1u;
}

__device__ __forceinline__ void xcd_barrier(const XcdBarrier& b) {
    asm volatile("s_waitcnt vmcnt(0)" ::: "memory");
    __syncthreads();
    if (threadIdx.x == 0) {
        unsigned* bar = b.bar;
        __builtin_amdgcn_s_waitcnt(0);
        unsigned nloc = b.st[0], nx = b.st[1];
        if (nloc == 0u) { xcd_barrier_complete(bar, b.x, nloc, nx); b.st[0] = nloc; b.st[1] = nx; }
        const unsigned old = xb_add(&bar[XB_XSUB(b.x)], 1u);
        const unsigned gen = old / nloc;
        if (old + 1u == (gen + 1u) * nloc) {
            __builtin_amdgcn_fence(__ATOMIC_RELEASE, "agent");
            asm volatile("s_waitcnt vmcnt(0)" ::: "memory");
            const unsigned og = xb_add(&bar[XB_TOP], 1u);
            const unsigned tg = og / nx;
            if (og + 1u == (tg + 1u) * nx) xb_add(&bar[XB_TOPGEN], 1u);
            else XB_SPIN(xb_ld(&bar[XB_TOPGEN]) == tg, bar);
            __builtin_amdgcn_fence(__ATOMIC_ACQUIRE, "agent");
            xb_add(&bar[XB_XGEN(b.x)], 1u);
            asm volatile("s_waitcnt vmcnt(0)" ::: "memory");
        } else {
            XB_SPIN(xb_ld(&bar[XB_XGEN(b.x)]) == gen, bar);
            __builtin_amdgcn_fence(__ATOMIC_ACQUIRE, "agent");
            asm volatile("s_waitcnt vmcnt(0)" ::: "memory");
        }
    }
    __syncthreads();
}


struct Frame {
    LAS unsigned char* lds;
    volatile LAS unsigned* MISC;
    gu32* ctl;
    unsigned char* ws;
    int tid, lane, wave, vcu, G;
};
struct Args { const float* in[15]; float* out; unsigned char* ws; int ph_lo, ph_hi; };

__device__ __forceinline__ float wave_sum(float v) {
#pragma unroll
    for (int o = 1; o < 64; o <<= 1) v += __shfl_xor(v, o);
    return v;
}

template <class ColMap>
__device__ __forceinline__ void p0_transpose_item(const float* W, int K, int N, bf16* WT, int nblk, LAS float* scr, int item, int lane, ColMap cm) {
    const int kb = item / nblk, nb = item % nblk, k0 = 64 * kb, n0 = 32 * nb;
    const int src = cm(n0 + (lane & 31));
#pragma unroll 8
    for (int i = 0; i < 32; ++i) { const int kk = 2 * i + (lane >> 5); scr[kk * 33 + (lane & 31)] = (src >= 0) ? W[(size_t)(k0 + kk) * N + src] : 0.f; }
    LDS_WAIT(); asm volatile("" ::: "memory");
    const int c = lane & 7;
#pragma unroll
    for (int j = 0; j < 4; ++j) { const int n = (lane >> 3) + 8 * j; const LAS float* s = scr + (8 * c) * 33 + n;
        v4u o; o.x = pk2(s[0 * 33], s[1 * 33]); o.y = pk2(s[2 * 33], s[3 * 33]); o.z = pk2(s[4 * 33], s[5 * 33]); o.w = pk2(s[6 * 33], s[7 * 33]);
        *(GAS v4u*)(WT + (size_t)(n0 + n) * K + k0 + 8 * c) = o; }
    LDS_WAIT(); asm volatile("" ::: "memory");
}
struct MapIdent { __device__ __forceinline__ int operator()(int n) const { return n; } };
struct MapWin { __device__ __forceinline__ int operator()(int n) const {
    if (n < 2048) return n;
    if (n < 2560) return 2120 + (n - 2048);
    if (n < 4608) return 2632 + (n - 2560);
    if (n < 4672) return 2048 + (n - 4608);
    if (n < 4680) return 2112 + (n - 4672);
    return -1; } };

template <int NR> __device__ __forceinline__ void rms_rows_to_bf16(const float* x, const float* g, bf16* o, int m0, int stride, int lane) {
    f32x4 v[NR][4]; float s[NR];
#pragma unroll
    for (int r = 0; r < NR; ++r) { const GAS f32x4* xr = (const GAS f32x4*)(x + (size_t)(m0 + r * stride) * DM) + lane;
#pragma unroll
        for (int j = 0; j < 4; ++j) v[r][j] = xr[64 * j]; }
#pragma unroll
    for (int r = 0; r < NR; ++r) { float a = 0.f;
#pragma unroll
        for (int j = 0; j < 4; ++j) a += (v[r][j].x * v[r][j].x + v[r][j].y * v[r][j].y) + (v[r][j].z * v[r][j].z + v[r][j].w * v[r][j].w);
        s[r] = a; }
#pragma unroll
    for (int o2 = 1; o2 < 64; o2 <<= 1) {
#pragma unroll
        for (int r = 0; r < NR; ++r) s[r] += __shfl_xor(s[r], o2);
    }
    const GAS f32x4* gr = (const GAS f32x4*)g + lane;
    f32x4 gg[4];
#pragma unroll
    for (int j = 0; j < 4; ++j) gg[j] = gr[64 * j];
#pragma unroll
    for (int r = 0; r < NR; ++r) { const float rs = 1.0f / sqrtf(s[r] * (1.f / 1024.f) + EPS);
        GAS unsigned long long* o8 = (GAS unsigned long long*)(o + (size_t)(m0 + r * stride) * DM) + lane;
#pragma unroll
        for (int j = 0; j < 4; ++j) o8[64 * j] = (unsigned long long)pk2(v[r][j].x * rs * gg[j].x, v[r][j].y * rs * gg[j].y) | ((unsigned long long)pk2(v[r][j].z * rs * gg[j].z, v[r][j].w * rs * gg[j].w) << 32); }
}

__device__ __forceinline__ void p0_prologue(Frame& F, const Args& AR) {
    LAS float* scr = (LAS float*)(F.lds + F.wave * 16384);
    const int gw = F.vcu * NWAVES + F.wave, NGW = F.G * NWAVES, lane = F.lane;
    constexpr int I_WIN = 16 * 152, I_WA = 8 * 32, I_WO = 16 * 32;
    for (int it = gw; it < I_WIN + I_WA + I_WO; it += NGW) {
        int r = it;
        if (r < I_WIN) { p0_transpose_item((AR.in[2]), 1024, IN_WIDTH, ((bf16*)(F.ws + WS_WIN)), 152, scr, r, lane, MapWin()); continue; } r -= I_WIN;
        if (r < I_WA) { p0_transpose_item((AR.in[7]), 512, 1024, ((bf16*)(F.ws + WS_WA)), 32, scr, r, lane, MapIdent()); continue; } r -= I_WA;
        p0_transpose_item((AR.in[9]), 1024, 1024, ((bf16*)(F.ws + WS_WO)), 32, scr, r, lane, MapIdent());
    }
    for (int it = gw; it < 16 * 64; it += NGW) {
        const int nb = it & 15, kb = it >> 4, n = nb * 64 + lane, k0 = kb * 8, g = k0 >> 7, c0 = k0 & 127;
        float acc[8];
#pragma unroll
        for (int j = 0; j < 8; ++j) acc[j] = 0.f;
        for (int d = 0; d < 128; ++d) {
            const float wv = (AR.in[8])[(size_t)(g * 128 + d) * 1024 + n] * (AR.in[6])[g * 128 + d];
#pragma unroll
            for (int j = 0; j < 8; ++j) acc[j] += (AR.in[5])[(size_t)(g * 128 + c0 + j) * 128 + d] * wv;
        }
        v4u o; o.x = pk2(acc[0], acc[1]); o.y = pk2(acc[2], acc[3]); o.z = pk2(acc[4], acc[5]); o.w = pk2(acc[6], acc[7]);
        *(GAS v4u*)(((bf16*)(F.ws + WS_WPP)) + (size_t)n * 512 + k0) = o;
    }
    for (int it = gw; it < 16 * 32; it += NGW) p0_transpose_item((AR.in[11]), 1024, 1024, ((bf16*)(F.ws + WS_W2)), 32, scr, it, lane, MapIdent());
    for (int it = gw; it < 256; it += NGW) { const size_t e0 = (size_t)it * 512 + lane * 8;
        const f32x4 a = *(const GAS f32x4*)((AR.in[12]) + e0), b = *(const GAS f32x4*)((AR.in[12]) + e0 + 4);
        v4u o; o.x = pk2(a.x, a.y); o.y = pk2(a.z, a.w); o.z = pk2(b.x, b.y); o.w = pk2(b.z, b.w);
        *(GAS v4u*)(((bf16*)(F.ws + WS_SKB)) + e0) = o; }
    {   float mu = 0.f, mv = 0.f;
#pragma unroll 4
        for (int it = gw; it < 2 * 32768; it += NGW) {
            const float* src = (it < 32768) ? (AR.in[13]) : (AR.in[14]); const size_t e0 = (size_t)(it & 32767) * 512 + lane * 8;
            const f32x4 a = *(const GAS f32x4*)(src + e0), b = *(const GAS f32x4*)(src + e0 + 4);
            const float m = fmaxf(fmaxf(fmaxf(fabsf(a.x), fabsf(a.y)), fmaxf(fabsf(a.z), fabsf(a.w))), fmaxf(fmaxf(fabsf(b.x), fabsf(b.y)), fmaxf(fabsf(b.z), fabsf(b.w))));
            if (it < 32768) mu = fmaxf(mu, m); else mv = fmaxf(mv, m);
        }
#pragma unroll
        for (int o = 1; o < 64; o <<= 1) { mu = fmaxf(mu, __shfl_xor(mu, o)); mv = fmaxf(mv, __shfl_xor(mv, o)); }
        if (lane == 0) { __hip_atomic_fetch_max(F.ctl + CW_AMAX, __float_as_uint(mu), RLX_AGENT); __hip_atomic_fetch_max(F.ctl + CW_AMAX + 1, __float_as_uint(mv), RLX_AGENT); }
    }
    for (int it = gw * 64 + lane; it < 4096 * 8; it += NGW * 64) {
        const int pos = it >> 3, i = it & 7;
        const float invf = exp2f(-(float)i * 0.125f * 18.931568569324174f);
        const double ang = (double)((float)pos * invf);
        const double kq = __builtin_rint(ang * 0.6366197723675814);
        const float r = (float)(ang - kq * 1.5707963267948966);
        const int q = (int)((long long)kq & 3);
        const float r2 = r * r;
        const float sn = r + r * r2 * (-1.6666654611e-1f + r2 * (8.3321608736e-3f + r2 * (-1.9515295891e-4f)));
        const float cs = 1.0f - 0.5f * r2 + r2 * r2 * (4.166664568298827e-2f + r2 * (-1.388731625493765e-3f + r2 * 2.443315711809948e-5f));
        const float s = (q == 0) ? sn : (q == 1) ? cs : (q == 2) ? -sn : -cs;
        const float c = (q == 0) ? cs : (q == 1) ? -sn : (q == 2) ? -cs : sn;
        ((float*)(F.ws + WS_ROPE))[pos * 16 + i] = c; ((float*)(F.ws + WS_ROPE))[pos * 16 + 8 + i] = s;
    }
    { int m = gw;
      for (; m + 3 * NGW < MTOK; m += 4 * NGW) rms_rows_to_bf16<4>((AR.in[0]), (AR.in[1]), ((bf16*)(F.ws + WS_ACT)), m, NGW, lane);
      for (; m < MTOK; m += NGW) rms_rows_to_bf16<1>((AR.in[0]), (AR.in[1]), ((bf16*)(F.ws + WS_ACT)), m, NGW, lane); }
}

__device__ __forceinline__ void unpack8(const v4u w, float (&v)[8]) { v[0] = bflo(w.x); v[1] = bfhi(w.x); v[2] = bflo(w.y); v[3] = bfhi(w.y); v[4] = bflo(w.z); v[5] = bfhi(w.z); v[6] = bflo(w.w); v[7] = bfhi(w.w); }
__device__ __forceinline__ v4u pack8(const float (&v)[8]) { v4u o; o.x = pk2(v[0], v[1]); o.y = pk2(v[2], v[3]); o.z = pk2(v[4], v[5]); o.w = pk2(v[6], v[7]); return o; }
__device__ __forceinline__ void rope8(float (&v)[8], int sub, const float (&cs)[8], const float (&sn)[8]) {
    float pv[8];
#pragma unroll
    for (int j = 0; j < 8; ++j) pv[j] = __shfl_xor(v[j], 1);
    if (sub == 0) {
#pragma unroll
        for (int j = 0; j < 8; ++j) v[j] = v[j] * cs[j] - pv[j] * sn[j];
    } else if (sub == 1) {
#pragma unroll
        for (int j = 0; j < 8; ++j) v[j] = v[j] * cs[j] + pv[j] * sn[j];
    }
}
__device__ __forceinline__ float fp8_scale(unsigned amax_bits) { const unsigned be = (amax_bits >> 23) & 0xffu; return (be == 0u || be > 250u) ? 1.0f : __uint_as_float((261u - be) << 23); }
__device__ __forceinline__ float fp8_inv_scale(unsigned amax_bits) { const unsigned be = (amax_bits >> 23) & 0xffu; return (be == 0u || be > 250u) ? 1.0f : __uint_as_float((be - 7u) << 23); }
__device__ __forceinline__ void row_to_fp8(const float* src, unsigned char* dst, float sc, int lane) {
    const GAS f32x4* p = (const GAS f32x4*)src + lane * 4; v4u o;
#pragma unroll
    for (int q = 0; q < 4; ++q) { const f32x4 a = p[q]; int w = 0; w = __builtin_amdgcn_cvt_pk_fp8_f32(a.x * sc, a.y * sc, w, false); w = __builtin_amdgcn_cvt_pk_fp8_f32(a.z * sc, a.w * sc, w, true); o[q] = (unsigned)w; }
    *(GAS v4u*)(dst + ((size_t)(lane >> 3) << 21) + (lane & 7) * 16) = o;
}
__device__ __forceinline__ void row_to_i8(const float* src, unsigned char* dst, float sc, int lane) {
    const GAS f32x4* p = (const GAS f32x4*)src + lane * 4; v4u o;
#pragma unroll
    for (int q = 0; q < 4; ++q) { const f32x4 a = p[q];
        const unsigned b0 = __float_as_uint(a.x * sc + 12582912.0f), b1 = __float_as_uint(a.y * sc + 12582912.0f), b2 = __float_as_uint(a.z * sc + 12582912.0f), b3 = __float_as_uint(a.w * sc + 12582912.0f);
        o[q] = __builtin_amdgcn_perm(b1, b0, 0x0c0c0400u) | __builtin_amdgcn_perm(b3, b2, 0x04000c0cu); }
    *(GAS v4u*)(dst + ((size_t)(lane >> 3) << 21) + (lane & 7) * 16) = o;
}
__device__ __forceinline__ float i8_scale(unsigned amax_bits) { const float a = __uint_as_float(amax_bits); return (a > 1e-30f && a < 1e30f) ? 127.0f / a : 1.0f; }
__device__ __forceinline__ float i8_inv_scale(unsigned amax_bits) { const float a = __uint_as_float(amax_bits); return (a > 1e-30f && a < 1e30f) ? a * (1.0f / 127.0f) : 1.0f; }
__device__ __forceinline__ void fixup_token(Frame& F, const Args& AR, int tok) {
    const int lane = F.lane, sub = lane & 7, pos = tok & (SEQ - 1);
    bf16* row = ((bf16*)(F.ws + WS_PROJ)) + (size_t)tok * LDP;
    float cs[8], sn[8];
    { const GAS f32x4* rt = (const GAS f32x4*)(((float*)(F.ws + WS_ROPE)) + pos * 16); const f32x4 a = rt[0], b = rt[1], c = rt[2], d = rt[3];
      cs[0] = a.x; cs[1] = a.y; cs[2] = a.z; cs[3] = a.w; cs[4] = b.x; cs[5] = b.y; cs[6] = b.z; cs[7] = b.w;
      sn[0] = c.x; sn[1] = c.y; sn[2] = c.z; sn[3] = c.w; sn[4] = d.x; sn[5] = d.y; sn[6] = d.z; sn[7] = d.w; }
#pragma unroll
    for (int which = 0; which < 2; ++which) {
        GAS v4u* p = (GAS v4u*)(row + (which ? K_OFF : Q_OFF) + lane * 8);
        float v[8]; unpack8(*p, v);
        float ss = 0.f;
#pragma unroll
        for (int j = 0; j < 8; ++j) ss += v[j] * v[j];
        ss += __shfl_xor(ss, 1); ss += __shfl_xor(ss, 2); ss += __shfl_xor(ss, 4);
        const float rs = 1.0f / sqrtf(ss * (1.f / 64.f) + EPS);
        const float* g = (which ? (AR.in[4]) : (AR.in[3])) + sub * 8;
#pragma unroll
        for (int j = 0; j < 8; ++j) v[j] = v[j] * rs * g[j];
        rope8(v, sub, cs, sn);
        if (which == 0) {
#pragma unroll
            for (int j = 0; j < 8; ++j) v[j] *= C2;
        }
        *p = pack8(v);
    }
    { GAS v4u* p = (GAS v4u*)(row + QI_OFF + lane * 8); float v[8]; unpack8(*p, v); rope8(v, sub, cs, sn); *p = pack8(v); }
    { GAS v4u* p = (GAS v4u*)(row + KI_OFF + (lane & 7) * 8); float v[8]; unpack8(*p, v); rope8(v, sub, cs, sn); if (lane < 8) *p = pack8(v); }
}
__device__ __forceinline__ void pool_run(Frame& F, int tok0, int ntok) {
    const int lane = F.lane, g = lane >> 4, w = 2 << g;
    const bf16* pcol = ((const bf16*)(F.ws + WS_PROJ)) + P_OFF + lane * 8;
    float S[8];
#pragma unroll
    for (int j = 0; j < 8; ++j) S[j] = 0.f;
    { const int pos0 = tok0 & (SEQ - 1);
#pragma unroll
      for (int back = 1; back < 16; ++back) {
          if (back < w && back <= pos0) { float t[8]; unpack8(*(const GAS v4u*)(pcol + (size_t)(tok0 - back) * LDP), t);
#pragma unroll
              for (int j = 0; j < 8; ++j) S[j] += t[j]; }
      } }
#pragma unroll 1
    for (int i = 0; i < ntok; ++i) {
        const int tok = tok0 + i, pos = tok & (SEQ - 1);
        float cur[8]; unpack8(*(const GAS v4u*)(pcol + (size_t)tok * LDP), cur);
#pragma unroll
        for (int j = 0; j < 8; ++j) S[j] += cur[j];
        const float inv = 1.0f / (float)((pos + 1 < w) ? (pos + 1) : w);
        float o[8];
#pragma unroll
        for (int j = 0; j < 8; ++j) o[j] = S[j] * inv - cur[j];
        *(GAS v4u*)(((bf16*)(F.ws + WS_POOLED)) + (size_t)tok * 512 + lane * 8) = pack8(o);
        if (pos + 1 >= w) { float t[8]; unpack8(*(const GAS v4u*)(pcol + (size_t)(tok + 1 - w) * LDP), t);
#pragma unroll
            for (int j = 0; j < 8; ++j) S[j] -= t[j]; }
    }
}

__device__ __forceinline__ int wave_incl_scan(int v) {
    v += __builtin_amdgcn_update_dpp(0, v, 0x111, 0xf, 0xf, false);
    v += __builtin_amdgcn_update_dpp(0, v, 0x112, 0xf, 0xf, false);
    v += __builtin_amdgcn_update_dpp(0, v, 0x114, 0xf, 0xf, false);
    v += __builtin_amdgcn_update_dpp(0, v, 0x118, 0xf, 0xf, false);
    v += __builtin_amdgcn_update_dpp(0, v, 0x142, 0xa, 0xf, false);
    v += __builtin_amdgcn_update_dpp(0, v, 0x143, 0xc, 0xf, false);
    return v;
}
template <int NB> __device__ __forceinline__ void hist_search(const LAS unsigned* hist, int need, int lane, int& B, int& G, int& E) {
    constexpr int PER = NB / 64;
    int t = 0;
#pragma unroll
    for (int q = 0; q < PER / 4; ++q) { const v4u h = *(const LAS v4u*)(hist + lane * PER + 4 * q); t += (int)(h.x + h.y + h.z + h.w); }
    const int pfx = wave_incl_scan(t);
    const int L = __ffsll((long long)__ballot(pfx >= need)) - 1;
    const int base = __builtin_amdgcn_readlane(pfx, L) - __builtin_amdgcn_readlane(t, L);
    const int hv = (lane < PER) ? (int)hist[L * PER + lane] : 0;
    const int p2 = wave_incl_scan(hv) + base;
    const int i = __ffsll((long long)__ballot(p2 >= need)) - 1;
    B = L * PER + i; E = __builtin_amdgcn_readlane(hv, i); G = __builtin_amdgcn_readlane(p2, i) - E;
}
template <int NB> __device__ __forceinline__ void hist_zero(LAS unsigned* hist, int lane) {
#pragma unroll
    for (int q = 0; q < NB / 256; ++q) *(LAS v4u*)(hist + q * 256 + lane * 4) = (v4u){0u, 0u, 0u, 0u};
}
#define HIST_ADD(p) (void)__hip_atomic_fetch_add((p), 1u, __ATOMIC_RELAXED, __HIP_MEMORY_SCOPE_WORKGROUP)
#define wlane(dst, sval, j) asm volatile("s_nop 3\n\tv_writelane_b32 %0, %1, %2\n\ts_nop 1" : "+v"(dst) : "s"(sval), "i"(j))
__device__ __forceinline__ void select_row(const unsigned short* srow  , LAS unsigned* hist, int nj, int lastw, GAS unsigned long long* mout, int lane, unsigned long long& tacc, unsigned& tcnt) {
    const unsigned long long ts0_ = (PROBE_SEC >= 30 && PROBE_SEC <= 33) ? __builtin_amdgcn_s_memtime() : 0ull;
    unsigned key[64];
#pragma unroll
    for (int g = 0; g < 8; ++g) {
        if (nj > 8 * g) {
#pragma unroll
            for (int jj = 0; jj < 8; ++jj) key[8 * g + jj] = ordk(__uint_as_float((unsigned)((const GAS unsigned short*)srow)[(64 * (8 * g + jj) + lane) * 8] << 16) + 0.0f);
        } else {
#pragma unroll
            for (int jj = 0; jj < 8; ++jj) key[8 * g + jj] = 0u;
        }
    }
    LDS_WAIT(); asm volatile("" ::: "memory");
    if (PROBE_SEC >= 30 && PROBE_SEC <= 33) asm volatile("s_waitcnt vmcnt(0)" ::: "memory");
    const unsigned long long ts1_ = (PROBE_SEC >= 30 && PROBE_SEC <= 33) ? __builtin_amdgcn_s_memtime() : 0ull;
    int need = 256, B, G, E;
    hist_zero<2048>(hist, lane); LDS_WAIT(); asm volatile("" ::: "memory");
#pragma unroll
    for (int g = 0; g < 8; ++g) if (nj > 8 * g) {
#pragma unroll
        for (int jj = 0; jj < 8; ++jj) HIST_ADD(hist + (2047u - (key[8 * g + jj] >> 21)));
    }
    LDS_WAIT(); asm volatile("" ::: "memory");
    hist_search<2048>(hist, need, lane, B, G, E); need -= G;
    const unsigned long long ts2_ = (PROBE_SEC >= 30 && PROBE_SEC <= 33) ? __builtin_amdgcn_s_memtime() : 0ull;
    const unsigned d1 = 2047u - (unsigned)B;
    asm volatile("" ::: "memory"); hist_zero<2048>(hist, lane); LDS_WAIT(); asm volatile("" ::: "memory");
#pragma unroll
    for (int g = 0; g < 8; ++g) if (nj > 8 * g) {
#pragma unroll
        for (int jj = 0; jj < 8; ++jj) { const unsigned k = key[8 * g + jj]; if ((k >> 21) == d1) HIST_ADD(hist + (2047u - ((k >> 10) & 0x7ffu))); }
    }
    LDS_WAIT(); asm volatile("" ::: "memory");
    hist_search<2048>(hist, need, lane, B, G, E); need -= G;
    const unsigned pre2 = (d1 << 11) | (2047u - (unsigned)B);
    const unsigned v = pre2 << 10;
    const unsigned long long ts3_ = (PROBE_SEC >= 30 && PROBE_SEC <= 33) ? __builtin_amdgcn_s_memtime() : 0ull;
    unsigned mlo = 0u, mhi = 0u;
#pragma unroll
    for (int g = 0; g < 8; ++g) {
        asm volatile("v_cmp_ge_u32_e64 s[40:41], %2, %10\n\tv_cmp_ge_u32_e64 s[42:43], %3, %10\n\tv_cmp_ge_u32_e64 s[44:45], %4, %10\n\tv_cmp_ge_u32_e64 s[46:47], %5, %10\n\t"
                     "v_cmp_ge_u32_e64 s[48:49], %6, %10\n\tv_cmp_ge_u32_e64 s[50:51], %7, %10\n\tv_cmp_ge_u32_e64 s[52:53], %8, %10\n\tv_cmp_ge_u32_e64 s[54:55], %9, %10\n\ts_nop 1\n\t"
                     "v_writelane_b32 %0, s40, %11\n\tv_writelane_b32 %1, s41, %11\n\tv_writelane_b32 %0, s42, %12\n\tv_writelane_b32 %1, s43, %12\n\t"
                     "v_writelane_b32 %0, s44, %13\n\tv_writelane_b32 %1, s45, %13\n\tv_writelane_b32 %0, s46, %14\n\tv_writelane_b32 %1, s47, %14\n\t"
                     "v_writelane_b32 %0, s48, %15\n\tv_writelane_b32 %1, s49, %15\n\tv_writelane_b32 %0, s50, %16\n\tv_writelane_b32 %1, s51, %16\n\t"
                     "v_writelane_b32 %0, s52, %17\n\tv_writelane_b32 %1, s53, %17\n\tv_writelane_b32 %0, s54, %18\n\tv_writelane_b32 %1, s55, %18\n\ts_nop 1"
                     : "+v"(mlo), "+v"(mhi)
                     : "v"(key[8 * g]), "v"(key[8 * g + 1]), "v"(key[8 * g + 2]), "v"(key[8 * g + 3]), "v"(key[8 * g + 4]), "v"(key[8 * g + 5]), "v"(key[8 * g + 6]), "v"(key[8 * g + 7]), "v"(v),
                       "i"(8 * g), "i"(8 * g + 1), "i"(8 * g + 2), "i"(8 * g + 3), "i"(8 * g + 4), "i"(8 * g + 5), "i"(8 * g + 6), "i"(8 * g + 7)
                     : "s40", "s41", "s42", "s43", "s44", "s45", "s46", "s47", "s48", "s49", "s50", "s51", "s52", "s53", "s54", "s55");
    }
    int drop = E - need;
#pragma unroll
    for (int j = 63; j >= 0; --j) {
        if (drop > 0) {
            unsigned long long eq = __ballot(key[j] == v);
            if (eq != 0ull) {
                unsigned long long rem = 0ull;
                while (drop > 0 && eq != 0ull) { const unsigned long long hb = 1ull << (63 - __clzll((long long)eq)); rem |= hb; eq ^= hb; --drop; }
                const unsigned long long m = __ballot(key[j] >= v) & ~rem;
                wlane(mlo, (unsigned)m, j); wlane(mhi, (unsigned)(m >> 32), j);
            }
        }
    }
    if (lane <= lastw) mout[lane] = ((unsigned long long)mhi << 32) | (unsigned long long)mlo;
    LDS_WAIT(); asm volatile("" ::: "memory");
    if (PROBE_SEC >= 30 && PROBE_SEC <= 33) { const unsigned long long ts4_ = __builtin_amdgcn_s_memtime(); tacc += (PROBE_SEC == 30) ? (ts1_ - ts0_) : (PROBE_SEC == 31) ? (ts2_ - ts1_) : (PROBE_SEC == 32) ? (ts3_ - ts2_) : (ts4_ - ts3_); ++tcnt; }
}

__device__ __forceinline__ float* wave_scratch(unsigned char* ws, int gwv) {
    if (gwv < 1024) return (float*)(ws + WS_ACT) + (size_t)gwv * 32768;
    gwv -= 1024; if (gwv < 512) return (float*)(ws + WS_AO) + (size_t)gwv * 32768;
    gwv -= 512; if (gwv < 352) return (float*)(ws + 980 * MiB) + (size_t)gwv * 32768;
    gwv -= 352; if (gwv < 128) return (float*)(ws + 36 * MiB) + (size_t)gwv * 32768;
    gwv -= 128; return (float*)(ws + 68 * MiB) + (size_t)(gwv & 127) * 32768;
}
__device__ __forceinline__ void idx_unit(Frame& F, const Args& AR, int b, int c, unsigned long long& tacc, unsigned& tcnt, bool do_select = true) {
    const unsigned long long ti0_ = (PROBE_SEC >= 20 && PROBE_SEC <= 22) ? __builtin_amdgcn_s_memtime() : 0ull;
    const int lane = F.lane, wid = F.wave, l31 = lane & 31, h2 = lane >> 5;
    const size_t rowb = (size_t)b * SEQ, tp0 = rowb + (size_t)c * 64 + wid * 8;
    GAS unsigned long long* mbase = (GAS unsigned long long*)(((unsigned long long*)(F.ws + WS_MASK)) + tp0 * 64);
    if (c < 4) {
        if (lane < 32) { const int q = lane >> 2, j = lane & 3; mbase[q * 64 + j] = (j <= c) ? ~0ull : 0ull; }
        return;
    }
    unsigned short* sc = (unsigned short*)wave_scratch(F.ws, F.vcu * NWAVES + wid);
    LAS unsigned* hist = (LAS unsigned*)(F.lds + wid * 8192);
    const int ntile = 2 * (c + 1), nj = c + 1, lastw = c | 3, ntile_pad = 16 * ((nj + 7) >> 3);
    const int head = (l31 & 3) | (((l31 >> 3) & 1) << 2), qsub = ((l31 >> 2) & 1) | (((l31 >> 4) & 1) << 1);
    bf16x8 a[2][4]; float w[2][16];
#pragma unroll
    for (int rb = 0; rb < 2; ++rb) {
        const bf16* ap = ((bf16*)(F.ws + WS_PROJ)) + (tp0 + 4 * rb + qsub) * LDP + QI_OFF + head * 64 + h2 * 8;
#pragma unroll
        for (int st = 0; st < 4; ++st) a[rb][st] = *(const GAS bf16x8*)(ap + st * 16);
        const v4u wa = *(const GAS v4u*)(((bf16*)(F.ws + WS_PROJ)) + (tp0 + 4 * rb + h2) * LDP + WI_OFF), wb = *(const GAS v4u*)(((bf16*)(F.ws + WS_PROJ)) + (tp0 + 4 * rb + h2 + 2) * LDP + WI_OFF);
        float t[8]; unpack8(wa, t);
#pragma unroll
        for (int j = 0; j < 8; ++j) w[rb][j] = t[j] * WI_SCALE;
        unpack8(wb, t);
#pragma unroll
        for (int j = 0; j < 8; ++j) w[rb][8 + j] = t[j] * WI_SCALE;
    }
    const unsigned long long ti1_ = (PROBE_SEC >= 20 && PROBE_SEC <= 22) ? __builtin_amdgcn_s_memtime() : 0ull;
    {
        LAS unsigned char* kb = F.lds + 65536;
        const int nstage = (ntile + 3) >> 2;
        const int sk0 = F.tid >> 3, sch = F.tid & 7;
        const bf16* kg = ((bf16*)(F.ws + WS_PROJ)) + (rowb + sk0) * LDP + KI_OFF + sch * 8;
        v4u r0 = *(const GAS v4u*)kg, r1 = *(const GAS v4u*)(kg + (size_t)64 * LDP);
#pragma unroll 1
        for (int sg = 0; sg < nstage; ++sg) {
            LAS unsigned char* cur = kb + (sg & 1) * 18432;
            *(LAS v4u*)(cur + sk0 * 144 + sch * 16) = r0; *(LAS v4u*)(cur + (sk0 + 64) * 144 + sch * 16) = r1;
            BAR_LDS();
            { const int sn = (sg + 1 < nstage) ? sg + 1 : sg; r0 = *(const GAS v4u*)(kg + (size_t)sn * 128 * LDP); r1 = *(const GAS v4u*)(kg + (size_t)(sn * 128 + 64) * LDP); }
#pragma unroll
            for (int t4 = 0; t4 < 4; ++t4) {
                const int kt = 4 * sg + t4;
                if (kt < ntile) {
                    bf16x8 bfr[4];
#pragma unroll
                    for (int st = 0; st < 4; ++st) bfr[st] = *(const LAS bf16x8*)(cur + (t4 * 32 + l31) * 144 + st * 32 + h2 * 16);
                    float sq[4];
#pragma unroll
                    for (int rb = 0; rb < 2; ++rb) {
                        f32x16 acc;
#pragma unroll
                        for (int r = 0; r < 16; ++r) acc[r] = 0.f;
#pragma unroll
                        for (int st = 0; st < 4; ++st) acc = __builtin_amdgcn_mfma_f32_32x32x16_bf16(a[rb][st], bfr[st], acc, 0, 0, 0);
                        float s0 = 0.f, s1 = 0.f;
#pragma unroll
                        for (int r = 0; r < 8; ++r) { s0 = fmaf(w[rb][r], relu_i(acc[r]), s0); s1 = fmaf(w[rb][8 + r], relu_i(acc[8 + r]), s1); }
                        sq[2 * rb] = s0; sq[2 * rb + 1] = s1;
                    }
                    *(GAS v2u*)(sc + (size_t)(kt * 32 + l31) * 8 + 4 * h2) = (v2u){pk2(sq[0], sq[1]), pk2(sq[2], sq[3])};
                }
            }
        }
        for (int kt = ntile; kt < ntile_pad; ++kt)
            *(GAS v2u*)(sc + (size_t)(kt * 32 + l31) * 8 + 4 * h2) = (v2u){0xff80ff80u, 0xff80ff80u};
    }
    const unsigned long long ti2_ = (PROBE_SEC >= 20 && PROBE_SEC <= 22) ? __builtin_amdgcn_s_memtime() : 0ull;
    VM_WAIT();
    if (do_select) {
#pragma unroll 1
        for (int q = 0; q < 8 * PROBE_SEL2; ++q) select_row(sc + 4 * (q & 1) + ((q & 7) >> 1), hist, nj, lastw, mbase + (q & 7) * 64, lane, tacc, tcnt);
    }
    if (PROBE_SEC >= 20 && PROBE_SEC <= 22) { const unsigned long long ti3_ = __builtin_amdgcn_s_memtime(); tacc += (PROBE_SEC == 20) ? (ti1_ - ti0_) : (PROBE_SEC == 21) ? (ti2_ - ti1_) : (ti3_ - ti2_); tcnt = 1000u; }
}

__device__ __forceinline__ void attn_unit(Frame& F, const Args& AR, int b, int h, int qb, unsigned long long& tacc, unsigned& tcnt) {
    const int lane = F.lane, wid = F.wave, l31 = lane & 31, h2 = lane >> 5;
    LAS unsigned char* Ks = F.lds;
    LAS float* wsf = (LAS float*)(F.lds + 2 * 17408) + wid * 32;
    const size_t rowb = (size_t)b * SEQ, tok0 = rowb + (size_t)qb * 256 + wid * 32;
    bf16x8 qf[4];
    { const bf16* qp = ((bf16*)(F.ws + WS_PROJ)) + (tok0 + l31) * LDP + Q_OFF + h * 64 + h2 * 8;
#pragma unroll
      for (int st = 0; st < 4; ++st) qf[st] = *(const GAS bf16x8*)(qp + st * 16); }
    const int NT = 4 * (qb + 1), cw = qb * 4 + (wid >> 1);
    f32x16 o0, o1;
#pragma unroll
    for (int r = 0; r < 16; ++r) { o0[r] = 0.f; o1[r] = 0.f; }
    float lsum = 0.f;
    const int skey = F.tid >> 3, sch = F.tid & 7;
    const bf16* kg = ((bf16*)(F.ws + WS_PROJ)) + (rowb + skey) * LDP + K_OFF + h * 64 + sch * 8;
    const bf16* vg = ((bf16*)(F.ws + WS_PROJ)) + (rowb + skey) * LDP + V_OFF + h * 64 + sch * 8;
    const unsigned kst = skey * 144 + sch * 16, vst = skey * 128 + ((sch * 16) ^ (((skey >> 1) & 1) << 6));
    const GAS unsigned long long* mrow = (const GAS unsigned long long*)(((unsigned long long*)(F.ws + WS_MASK)) + (tok0 + l31) * 64);
    const int i16 = lane & 15, qq = i16 >> 2, pp = i16 & 3, blk = (lane >> 4) & 1;
    const unsigned vrd = (unsigned)((4 * h2 + qq) * 128 + ((32 * blk + 8 * pp) ^ (((qq >> 1) & 1) << 6)));
    v4u kr[3], vr[3];
#pragma unroll
    for (int u = 0; u < 3; ++u) { kr[u] = *(const GAS v4u*)(kg + (size_t)u * 64 * LDP); vr[u] = *(const GAS v4u*)(vg + (size_t)u * 64 * LDP); }
    unsigned long long mwn = mrow[0];
#pragma unroll 1
    for (int t = 0; t < NT; t += 3) {
#pragma unroll
        for (int u = 0; u < 3; ++u) {
            const int tt = t + u;
            if (tt < NT) {
                LAS unsigned char* Kc = Ks + (tt & 1) * 17408; LAS unsigned char* Vc = Kc + 9216;
                const unsigned long long t_a = PROBE_SEC ? __builtin_amdgcn_s_memtime() : 0ull;
                *(LAS v4u*)(Kc + kst) = kr[u]; *(LAS v4u*)(Vc + vst) = vr[u];
                BAR_LDS();
                const unsigned long long t_b = PROBE_SEC ? __builtin_amdgcn_s_memtime() : 0ull;
                { const int tn = (tt + 3 < NT) ? tt + 3 : NT - 1;
                  kr[u] = *(const GAS v4u*)(kg + (size_t)tn * 64 * LDP); vr[u] = *(const GAS v4u*)(vg + (size_t)tn * 64 * LDP); }
                const unsigned long long mw = mwn;
                mwn = mrow[(tt + 1 < NT) ? tt + 1 : tt];
                if (tt <= cw) {
                    bf16x8 vfr[2][2][2];
        #pragma unroll
                    for (int kb = 0; kb < 2; ++kb)
        #pragma unroll
                        for (int s = 0; s < 2; ++s)
        #pragma unroll
                            for (int d0 = 0; d0 < 2; ++d0) {
                                const unsigned ad = (vrd + (unsigned)((32 * kb + 16 * s) * 128)) ^ (unsigned)(d0 << 6);
                                const s16x4 lo = __builtin_bit_cast(s16x4, __builtin_amdgcn_ds_read_tr16_b64_v4i16((LAS s16x4*)(Vc + ad)));
                                const s16x4 hi = __builtin_bit_cast(s16x4, __builtin_amdgcn_ds_read_tr16_b64_v4i16((LAS s16x4*)(Vc + ad + 8 * 128)));
                                vfr[kb][s][d0] = (bf16x8){lo[0], lo[1], lo[2], lo[3], hi[0], hi[1], hi[2], hi[3]};
                            }
                    f32x16 p[2];
        #pragma unroll
                    for (int kb = 0; kb < 2; ++kb) {
                        f32x16 acc;
        #pragma unroll
                        for (int r = 0; r < 16; ++r) acc[r] = 0.f;
        #pragma unroll
                        for (int st = 0; st < 4; ++st) { const bf16x8 ka = *(const LAS bf16x8*)(Kc + (32 * kb + l31) * 144 + st * 32 + h2 * 16); acc = __builtin_amdgcn_mfma_f32_32x32x16_bf16(ka, qf[st], acc, 0, 0, 0); }
                        const unsigned wk = (kb ? (unsigned)(mw >> 32) : (unsigned)mw) >> (4 * h2);
        #pragma unroll
                        for (int r = 0; r < 16; ++r) {
                            const float e = __builtin_amdgcn_exp2f(acc[r]);
                            float pe;
                            asm("v_bfe_i32 %0, %2, %3, 1\n\tv_and_b32 %0, %0, %1" : "=&v"(pe) : "v"(e), "v"(wk), "i"((r & 3) + 8 * (r >> 2)));
                            acc[r] = pe;
                        }
                        p[kb] = acc;
                    }
                    const unsigned long long t_c = PROBE_SEC ? __builtin_amdgcn_s_memtime() : 0ull;
        #pragma unroll
                    for (int kb = 0; kb < 2; ++kb)
        #pragma unroll
                        for (int s = 0; s < 2; ++s) {
                            v4u pw; pw.x = pg8::cvt_pk_bf16(p[kb][8 * s + 0], p[kb][8 * s + 1]); pw.y = pg8::cvt_pk_bf16(p[kb][8 * s + 2], p[kb][8 * s + 3]); pw.z = pg8::cvt_pk_bf16(p[kb][8 * s + 4], p[kb][8 * s + 5]); pw.w = pg8::cvt_pk_bf16(p[kb][8 * s + 6], p[kb][8 * s + 7]);
                            lsum = dot2bf(pw.x, 0x3f803f80u, lsum); lsum = dot2bf(pw.y, 0x3f803f80u, lsum); lsum = dot2bf(pw.z, 0x3f803f80u, lsum); lsum = dot2bf(pw.w, 0x3f803f80u, lsum);
                            const bf16x8 pa = __builtin_bit_cast(bf16x8, pw);
        #pragma unroll
                            for (int d0 = 0; d0 < 2; ++d0) {
                                const bf16x8 vb = vfr[kb][s][d0];
                                if (d0 == 0) o0 = __builtin_amdgcn_mfma_f32_32x32x16_bf16(pa, vb, o0, 0, 0, 0); else o1 = __builtin_amdgcn_mfma_f32_32x32x16_bf16(pa, vb, o1, 0, 0, 0);
                            }
                        }
                    if (PROBE_SEC) { const unsigned long long t_d = __builtin_amdgcn_s_memtime(); tacc += (PROBE_SEC == 1) ? (t_b - t_a) : (PROBE_SEC == 2) ? (t_c - t_b) : (PROBE_SEC == 3) ? (t_d - t_c) : (t_d - t_a); ++tcnt; }
                }
            }
        }
    }
    lsum += __shfl_xor(lsum, 32);
    if (h2 == 0) wsf[l31] = lsum;
    LDS_WAIT(); asm volatile("" ::: "memory");
    LAS bf16* stg = (LAS bf16*)(F.lds + 2 * 17408 + 1024) + wid * 2048;
#pragma unroll
    for (int r = 0; r < 16; ++r) { const int q = crow(r, h2); const float rl = 1.0f / wsf[q];
        stg[q * 64 + l31] = (bf16)f2bf(o0[r] * rl); stg[q * 64 + 32 + l31] = (bf16)f2bf(o1[r] * rl); }
    LDS_WAIT(); asm volatile("" ::: "memory");
    bf16* ow = ((bf16*)(F.ws + WS_AO)) + tok0 * 512 + h * 64;
#pragma unroll
    for (int i = 0; i < 4; ++i) { const int row = i * 8 + (lane >> 3), ch = lane & 7; const v4u v = *(const LAS v4u*)(stg + row * 64 + ch * 8); *(GAS v4u*)(ow + (size_t)row * 512 + ch * 8) = v; }
    LDS_WAIT(); asm volatile("" ::: "memory");
}

__device__ __forceinline__ float row_rs(const float* ssp, size_t tok) {
    const GAS f32x4* p = (const GAS f32x4*)(ssp + tok * 16); const f32x4 a = p[0], b = p[1], c = p[2], d = p[3];
    const float ss = ((a.x + a.y) + (a.z + a.w)) + ((b.x + b.y) + (b.z + b.w)) + ((c.x + c.y) + (c.z + c.w)) + ((d.x + d.y) + (d.z + d.w));
    return 1.0f / sqrtf(ss * (1.f / 1024.f) + EPS);
}
__device__ __forceinline__ void sort16_desc(unsigned (&a)[16]) {
#pragma unroll
    for (int k = 2; k <= 16; k <<= 1)
#pragma unroll
        for (int j = k >> 1; j > 0; j >>= 1)
#pragma unroll
            for (int i = 0; i < 16; ++i) { const int l = i ^ j; if (l > i) { const unsigned hi = a[i] > a[l] ? a[i] : a[l], lo = a[i] > a[l] ? a[l] : a[i];
                if ((i & k) == 0) { a[i] = hi; a[l] = lo; } else { a[i] = lo; a[l] = hi; } } }
}
__device__ __forceinline__ void merge16_desc(unsigned (&top)[16], const unsigned (&a)[16]) {
#pragma unroll
    for (int i = 0; i < 16; ++i) top[i] = top[i] > a[15 - i] ? top[i] : a[15 - i];
#pragma unroll
    for (int j = 8; j > 0; j >>= 1)
#pragma unroll
        for (int i = 0; i < 16; ++i) { const int l = i ^ j; if (l > i) { const unsigned hi = top[i] > top[l] ? top[i] : top[l], lo = top[i] > top[l] ? top[l] : top[i]; top[i] = hi; top[l] = lo; } }
}
struct PairTab { int i[64], j[64]; };
constexpr PairTab make_pairs() { PairTab t{}; int n = 0; for (int i = 0; i < 16; ++i) for (int j = 0; j < 16; ++j) if ((i + 1) * (j + 1) <= 16) { t.i[n] = i; t.j[n] = j; ++n; } for (; n < 64; ++n) { t.i[n] = -1; t.j[n] = -1; } return t; }
__device__ __forceinline__ void route_task(Frame& F, const Args& AR, int tt, int h) {
    const int lane = F.lane, l31 = lane & 31, h2 = lane >> 5;
    const size_t tok = (size_t)tt * 32 + l31;
    LAS unsigned* lk = (LAS unsigned*)F.lds;
    unsigned KA[16], KB[16];
#pragma unroll
    for (int i = 0; i < 16; ++i) { KA[i] = 0u; KB[i] = 0u; }
#pragma unroll 1
    for (int p = 0; p < 2; ++p) {
        const int hp = 2 * h + p;
        bf16x8 bq[4];
        { const bf16* qp = ((const bf16*)(F.ws + WS_SUBK)) + tok * 1024 + hp * 64 + h2 * 8;
#pragma unroll
          for (int st = 0; st < 4; ++st) bq[st] = *(const GAS bf16x8*)(qp + st * 16); }
        unsigned top[16];
#pragma unroll
        for (int i = 0; i < 16; ++i) top[i] = 0u;
#pragma unroll 1
        for (int blk = 0; blk < 4; ++blk) {
            const bf16* ap = ((const bf16*)(F.ws + WS_SKB)) + (size_t)(hp * 128 + 32 * blk + l31) * 64 + h2 * 8;
            f32x16 acc;
#pragma unroll
            for (int r = 0; r < 16; ++r) acc[r] = 0.f;
#pragma unroll
            for (int st = 0; st < 4; ++st) { const bf16x8 af = *(const GAS bf16x8*)(ap + st * 16); acc = __builtin_amdgcn_mfma_f32_32x32x16_bf16(af, bq[st], acc, 0, 0, 0); }
            unsigned a16[16];
#pragma unroll
            for (int r = 0; r < 16; ++r) a16[r] = (ordk(acc[r]) & ~127u) | (unsigned)(127 - (32 * blk + (r & 3) + 8 * (r >> 2)) - 4 * h2);
            sort16_desc(a16);
            merge16_desc(top, a16);
        }
        unsigned oth[16];
#pragma unroll
        for (int i = 0; i < 16; ++i) oth[i] = __shfl_xor(top[i], 32);
        merge16_desc(top, oth);
#pragma unroll
        for (int i = 0; i < 16; ++i) { if (p == 0) KA[i] = top[i]; else KB[i] = top[i]; }
    }
    float sa[16], sb[16];
#pragma unroll
    for (int i = 0; i < 16; ++i) { sa[i] = unordk(KA[i] & ~127u); sb[i] = unordk(KB[i] & ~127u); lk[i * 512 + F.tid] = KA[i]; lk[(16 + i) * 512 + F.tid] = KB[i]; }
    unsigned ck[16];
#pragma unroll
    for (int grp = 0; grp < 4; ++grp) {
        unsigned a[16];
#pragma unroll
        for (int q = 0; q < 16; ++q) { constexpr PairTab T = make_pairs(); const int pi = T.i[grp * 16 + q], pj = T.j[grp * 16 + q];
            a[q] = (pi < 0) ? 0u : ((ordk(sa[pi < 0 ? 0 : pi] + sb[pj < 0 ? 0 : pj]) & ~255u) | (unsigned)(255 - (pi * 16 + pj))); }
        sort16_desc(a);
        if (grp == 0) {
#pragma unroll
            for (int i = 0; i < 16; ++i) ck[i] = a[i];
        } else merge16_desc(ck, a);
    }
    LDS_WAIT(); asm volatile("" ::: "memory");
    unsigned ce[16];
#pragma unroll
    for (int t = 0; t < 16; ++t) { const unsigned flat = 255u - (ck[t] & 255u); const unsigned ka = lk[(flat >> 4) * 512 + F.tid], kb = lk[(16u + (flat & 15u)) * 512 + F.tid];
        ce[t] = (127u - (ka & 127u)) * 128u + (127u - (kb & 127u)); }
    LDS_WAIT(); asm volatile("" ::: "memory");
    float ts[16]; float sum = 0.f; const float mx = unordk(ck[0] & ~255u);
    const float rsl = row_rs((const float*)(F.ws + WS_SSP), tok) * 1.4426950408889634f;
#pragma unroll
    for (int t = 0; t < 16; ++t) { ts[t] = __builtin_amdgcn_exp2f((unordk(ck[t] & ~255u) - mx) * rsl); sum += ts[t]; }
    const float inv = 1.0f / sum;
    if (h2 == 0) {
        GAS v4u* eo = (GAS v4u*)(((unsigned short*)(F.ws + WS_REXP)) + tok * 128 + h * 16); GAS f32x4* go = (GAS f32x4*)(((float*)(F.ws + WS_RG)) + tok * 128 + h * 16);
        eo[0] = (v4u){ce[0] | (ce[1] << 16), ce[2] | (ce[3] << 16), ce[4] | (ce[5] << 16), ce[6] | (ce[7] << 16)};
        eo[1] = (v4u){ce[8] | (ce[9] << 16), ce[10] | (ce[11] << 16), ce[12] | (ce[13] << 16), ce[14] | (ce[15] << 16)};
#pragma unroll
        for (int t4 = 0; t4 < 4; ++t4) go[t4] = (f32x4){ts[4 * t4] * inv, ts[4 * t4 + 1] * inv, ts[4 * t4 + 2] * inv, ts[4 * t4 + 3] * inv};
    }
}

__device__ __forceinline__ float gelu_erf(float v) {
    const float av = fabsf(v), t = __builtin_amdgcn_rcpf(av * 0.2316418882f + 1.0f);
    float q = t * 0.5307027145f + (-0.7265760135f); q = q * t + 0.7107068705f; q = q * t + (-0.142248368f); q = q * t + 0.127414796f; q = q * t;
    const float e = __builtin_amdgcn_exp2f((v * v) * (-0.72134752044f));
    const float m = v * (q * e);
    return v < 0.f ? m : v - m;
}
__device__ __forceinline__ float dpp_add(float v, float w_unused) { return v; }
#define DPP_ADD(v, ctrl) ((v) + __builtin_bit_cast(float, __builtin_amdgcn_update_dpp(0, __builtin_bit_cast(int, (v)), (ctrl), 0xf, 0xf, true)))
#define DPP_MAX(v, ctrl) fmaxf((v), __builtin_bit_cast(float, __builtin_amdgcn_update_dpp(0, __builtin_bit_cast(int, (v)), (ctrl), 0xf, 0xf, true)))
#define DPP_ADDI(v, ctrl) ((v) + __builtin_amdgcn_update_dpp(0, (v), (ctrl), 0xf, 0xf, true))
constexpr int NSL = 8;
constexpr int CW_PEER = 8192;
typedef float f32x2v __attribute__((ext_vector_type(2)));
__device__ __forceinline__ unsigned id_of(const v4u a, const v4u b, int m) { const unsigned w = (m < 8) ? a[(m & 7) >> 1] : b[(m & 7) >> 1]; return (m & 1) ? (w >> 16) : (w & 0xffffu); }
__device__ __forceinline__ void load_hn2(const bf16* p, f32x2v (&hn2)[8]) { const v4u a = *(const GAS v4u*)p, b = *(const GAS v4u*)(p + 8);
    hn2[0] = (f32x2v){bflo(a.x), bfhi(a.x)}; hn2[1] = (f32x2v){bflo(a.y), bfhi(a.y)}; hn2[2] = (f32x2v){bflo(a.z), bfhi(a.z)}; hn2[3] = (f32x2v){bflo(a.w), bfhi(a.w)};
    hn2[4] = (f32x2v){bflo(b.x), bfhi(b.x)}; hn2[5] = (f32x2v){bflo(b.y), bfhi(b.y)}; hn2[6] = (f32x2v){bflo(b.z), bfhi(b.z)}; hn2[7] = (f32x2v){bflo(b.w), bfhi(b.w)}; }
template <int SIDE> __device__ __forceinline__ void peer_item8(Frame& F, const Args& AR, int s, size_t t0, unsigned idmask = 0xffffu, bool dry = false) {
    const int lane = F.lane, ts = lane >> 3, c = lane & 7;
    const size_t tok = t0 + ts;
    const unsigned char* tbase = ((const unsigned char*)(F.ws + (SIDE == 0 ? WS_U16 : WS_V16))) + ((size_t)s << 21);
    const unsigned lo = 16u * (unsigned)c;
    const GAS v4u* idq = (const GAS v4u*)(((const unsigned short*)(F.ws + WS_REXP)) + tok * 128);
    v4u ia = idq[0], ib = idq[1];
    if (SIDE == 0) {
        int hq[4]; float dq;
        { const bf16* hp = ((const bf16*)(F.ws + WS_HG)) + tok * 1024 + 128 * s + 16 * c; const v4u a = *(const GAS v4u*)hp, b2 = *(const GAS v4u*)(hp + 8);
          float x[16]; x[0] = bflo(a.x); x[1] = bfhi(a.x); x[2] = bflo(a.y); x[3] = bfhi(a.y); x[4] = bflo(a.z); x[5] = bfhi(a.z); x[6] = bflo(a.w); x[7] = bfhi(a.w);
          x[8] = bflo(b2.x); x[9] = bfhi(b2.x); x[10] = bflo(b2.y); x[11] = bfhi(b2.y); x[12] = bflo(b2.z); x[13] = bfhi(b2.z); x[14] = bflo(b2.w); x[15] = bfhi(b2.w);
          float am = 1e-30f;
#pragma unroll
          for (int i = 0; i < 16; ++i) am = fmaxf(am, fabsf(x[i]));
          am = DPP_MAX(am, 0xB1); am = DPP_MAX(am, 0x4E); am = DPP_MAX(am, 0x141);
          const float qs = 127.0f * __builtin_amdgcn_rcpf(am) * 0.99999f; dq = am * (1.0f / (127.0f * 0.99999f));
#pragma unroll
          for (int q = 0; q < 4; ++q) { unsigned bt[4];
#pragma unroll
              for (int i = 0; i < 4; ++i) bt[i] = __float_as_uint(x[4 * q + i] * qs + 12582912.0f);
              hq[q] = (int)(__builtin_amdgcn_perm(bt[1], bt[0], 0x0c0c0400u) | __builtin_amdgcn_perm(bt[3], bt[2], 0x04000c0cu)); } }
        bf16* po = ((bf16*)(F.ws + WS_SUBK)) + (tok * NSL + s) * 128;
#pragma unroll 1
        for (int b = 0; b < 8; ++b) {
            v4u r[16];
#pragma unroll
            for (int m = 0; m < 16; ++m) r[m] = *(const GAS v4u*)(tbase + (size_t)(((id_of(ia, ib, m) & idmask) << 7) + lo));
            const int bn = (b + 1) & 7; ia = idq[2 * bn]; ib = idq[2 * bn + 1];
            float d[16];
#pragma unroll
            for (int m = 0; m < 16; ++m) { int acc = 0;
#pragma unroll
                for (int q = 0; q < 4; ++q) acc = __builtin_amdgcn_sdot4((int)r[m][q], hq[q], acc, false);
                acc = DPP_ADDI(acc, 0xB1); acc = DPP_ADDI(acc, 0x4E); acc = DPP_ADDI(acc, 0x141); d[m] = (float)acc * dq; }
            if (c == 0) { GAS v4u* pq = (GAS v4u*)(po + 16 * b);
                pq[0] = (v4u){pk2(d[0], d[1]), pk2(d[2], d[3]), pk2(d[4], d[5]), pk2(d[6], d[7])}; pq[1] = (v4u){pk2(d[8], d[9]), pk2(d[10], d[11]), pk2(d[12], d[13]), pk2(d[14], d[15])}; }
        }
    } else {
        const GAS f32x4* cfq = (const GAS f32x4*)(((const float*)(F.ws + WS_RG)) + tok * 128);
        f32x4 cf[4];
#pragma unroll
        for (int q = 0; q < 4; ++q) cf[q] = cfq[q];
        f32x2v acc[8];
#pragma unroll
        for (int j = 0; j < 8; ++j) acc[j] = (f32x2v){0.f, 0.f};
#pragma unroll 1
        for (int b = 0; b < 8; ++b) {
            v4u r[16];
#pragma unroll
            for (int m = 0; m < 16; ++m) r[m] = *(const GAS v4u*)(tbase + (size_t)(((id_of(ia, ib, m) & idmask) << 7) + lo));
            const int bn = (b + 1) & 7; ia = idq[2 * bn]; ib = idq[2 * bn + 1];
            f32x4 cn[4];
#pragma unroll
            for (int q = 0; q < 4; ++q) cn[q] = cfq[4 * bn + q];
#pragma unroll
            for (int m = 0; m < 16; ++m) { const float cm = cf[m >> 2][m & 3]; const f32x2v c2 = {cm, cm};
#pragma unroll
                for (int q = 0; q < 4; ++q) { const int w = (int)r[m][q]; acc[2 * q] = __builtin_amdgcn_cvt_pk_f32_fp8(w, false) * c2 + acc[2 * q]; acc[2 * q + 1] = __builtin_amdgcn_cvt_pk_f32_fp8(w, true) * c2 + acc[2 * q + 1]; } }
#pragma unroll
            for (int q = 0; q < 4; ++q) cf[q] = cn[q];
        }
        GAS f32x4* op = (GAS f32x4*)((AR.out) + tok * 1024 + 128 * s + 16 * c);
#pragma unroll
        for (int q = 0; q < 4; ++q) { f32x4 h = op[q]; h.x += acc[2 * q].x; h.y += acc[2 * q].y; h.z += acc[2 * q + 1].x; h.w += acc[2 * q + 1].y; if (!dry || h.x == 1.2345e30f) op[q] = h; }
    }
}
__device__ __forceinline__ void quant_hn16(const bf16* hp, int (&hq)[4], float& dq) {
    const v4u a = *(const GAS v4u*)hp, b2 = *(const GAS v4u*)(hp + 8);
    float x[16]; x[0] = bflo(a.x); x[1] = bfhi(a.x); x[2] = bflo(a.y); x[3] = bfhi(a.y); x[4] = bflo(a.z); x[5] = bfhi(a.z); x[6] = bflo(a.w); x[7] = bfhi(a.w);
    x[8] = bflo(b2.x); x[9] = bfhi(b2.x); x[10] = bflo(b2.y); x[11] = bfhi(b2.y); x[12] = bflo(b2.z); x[13] = bfhi(b2.z); x[14] = bflo(b2.w); x[15] = bfhi(b2.w);
    float am = 1e-30f;
#pragma unroll
    for (int i = 0; i < 16; ++i) am = fmaxf(am, fabsf(x[i]));
    am = DPP_MAX(am, 0xB1); am = DPP_MAX(am, 0x4E); am = DPP_MAX(am, 0x141);
    const float qs = 127.0f * __builtin_amdgcn_rcpf(am) * 0.99999f; dq = am * (1.0f / (127.0f * 0.99999f));
#pragma unroll
    for (int q = 0; q < 4; ++q) { unsigned bt[4];
#pragma unroll
        for (int i = 0; i < 4; ++i) bt[i] = __float_as_uint(x[4 * q + i] * qs + 12582912.0f);
        hq[q] = (int)(__builtin_amdgcn_perm(bt[1], bt[0], 0x0c0c0400u) | __builtin_amdgcn_perm(bt[3], bt[2], 0x04000c0cu)); }
}
__device__ __forceinline__ void peer_u16(Frame& F, int s, size_t t0, unsigned idmask = 0xffffu) {
    const int lane = F.lane, ts = lane >> 3, c = lane & 7;
    const size_t tok = t0 + ts;
    const unsigned char* tbase = ((const unsigned char*)(F.ws + WS_U16)) + ((size_t)s << 21);
    const unsigned lo = 16u * (unsigned)c;
    const GAS v4u* idq = (const GAS v4u*)(((const unsigned short*)(F.ws + WS_REXP)) + tok * 128);
    int hq0[4], hq1[4]; float dq0, dq1;
    quant_hn16(((const bf16*)(F.ws + WS_HG)) + tok * 1024 + 128 * s + 16 * c, hq0, dq0);
    quant_hn16(((const bf16*)(F.ws + WS_HG)) + (tok + 8) * 1024 + 128 * s + 16 * c, hq1, dq1);
    bf16* po = ((bf16*)(F.ws + WS_SUBK)) + (tok * NSL + s) * 128;
    v4u ia, ib;
    v4u r[16];
    { const v4u i0 = idq[0], i1 = idq[1]; ia = idq[2]; ib = idq[3];
      asm volatile("" :: "v"(ia), "v"(ib));
#pragma unroll
      for (int m = 0; m < 16; ++m) r[m] = *(const GAS v4u*)(tbase + (size_t)(((id_of(i0, i1, m) & idmask) << 7) + lo)); }
#pragma unroll 1
    for (int j = 0; j < 15; ++j) {
        const bool g1 = j >= 8;
        v4u na, nb; { const int jn = (j + 2 < 16) ? j + 2 : 15; const GAS v4u* ip = idq + ((jn >> 3) * 128 + 2 * (jn & 7)); na = ip[0]; nb = ip[1]; }
        int hq[4];
#pragma unroll
        for (int q = 0; q < 4; ++q) hq[q] = g1 ? hq1[q] : hq0[q];
        const float dq = g1 ? dq1 : dq0;
        float d[16];
#pragma unroll
        for (int m = 0; m < 16; ++m) { int acc = 0;
#pragma unroll
            for (int q = 0; q < 4; ++q) acc = __builtin_amdgcn_sdot4((int)r[m][q], hq[q], acc, false);
            r[m] = *(const GAS v4u*)(tbase + (size_t)(((id_of(ia, ib, m) & idmask) << 7) + lo));
            acc = DPP_ADDI(acc, 0xB1); acc = DPP_ADDI(acc, 0x4E); acc = DPP_ADDI(acc, 0x141); d[m] = (float)acc * dq; }
        ia = na; ib = nb;
        if (c == 0) { GAS v4u* pq = (GAS v4u*)(po + (j >> 3) * (8 * NSL * 128) + 16 * (j & 7));
            pq[0] = (v4u){pk2(d[0], d[1]), pk2(d[2], d[3]), pk2(d[4], d[5]), pk2(d[6], d[7])}; pq[1] = (v4u){pk2(d[8], d[9]), pk2(d[10], d[11]), pk2(d[12], d[13]), pk2(d[14], d[15])}; }
    }
    { float d[16];
#pragma unroll
        for (int m = 0; m < 16; ++m) { int acc = 0;
#pragma unroll
            for (int q = 0; q < 4; ++q) acc = __builtin_amdgcn_sdot4((int)r[m][q], hq1[q], acc, false);
            acc = DPP_ADDI(acc, 0xB1); acc = DPP_ADDI(acc, 0x4E); acc = DPP_ADDI(acc, 0x141); d[m] = (float)acc * dq1; }
        if (c == 0) { GAS v4u* pq = (GAS v4u*)(po + (8 * NSL * 128) + 16 * 7);
            pq[0] = (v4u){pk2(d[0], d[1]), pk2(d[2], d[3]), pk2(d[4], d[5]), pk2(d[6], d[7])}; pq[1] = (v4u){pk2(d[8], d[9]), pk2(d[10], d[11]), pk2(d[12], d[13]), pk2(d[14], d[15])}; } }
}
constexpr int PV_IDROW = 272, PV_CFROW = 528, PV_CFOFF = 16 * PV_IDROW, PV_WAVE = PV_CFOFF + 16 * PV_CFROW, PV_BASE = 1024;
__device__ __forceinline__ void peer_v16(Frame& F, const Args& AR, int s, size_t t0, unsigned idmask, bool dry) {
    const int lane = F.lane, ts = lane >> 3, c = lane & 7;
    const unsigned char* tbase = ((const unsigned char*)(F.ws + WS_V16)) + ((size_t)s << 21);
    const unsigned lo = 16u * (unsigned)c;
    LAS unsigned char* wl = F.lds + PV_BASE + F.wave * PV_WAVE;
    { const GAS v4u* gi = (const GAS v4u*)(((const unsigned short*)(F.ws + WS_REXP)) + t0 * 128);
      const GAS v4u* gc = (const GAS v4u*)(((const float*)(F.ws + WS_RG)) + t0 * 128);
      v4u si[4], sc[8];
#pragma unroll
      for (int i = 0; i < 4; ++i) si[i] = gi[lane + 64 * i];
#pragma unroll
      for (int i = 0; i < 8; ++i) sc[i] = gc[lane + 64 * i];
#pragma unroll
      for (int i = 0; i < 4; ++i) { const int j = lane + 64 * i; *(LAS v4u*)(wl + (j >> 4) * PV_IDROW + 16 * (j & 15)) = si[i]; }
#pragma unroll
      for (int i = 0; i < 8; ++i) { const int j = lane + 64 * i; *(LAS v4u*)(wl + PV_CFOFF + (j >> 5) * PV_CFROW + 16 * (j & 31)) = sc[i]; } }
    const LAS v4u* idl = (const LAS v4u*)(wl + ts * PV_IDROW);
    const LAS f32x4* cfl = (const LAS f32x4*)(wl + PV_CFOFF + ts * PV_CFROW);
    f32x2v acc[8];
#pragma unroll
    for (int j = 0; j < 8; ++j) acc[j] = (f32x2v){0.f, 0.f};
    v4u r[16];
    { const v4u i0 = idl[0], i1 = idl[1];
#pragma unroll
      for (int m = 0; m < 16; ++m) r[m] = *(const GAS v4u*)(tbase + (size_t)(((id_of(i0, i1, m) & idmask) << 7) + lo)); }
#pragma unroll 1
    for (int j = 0; j < 15; ++j) {
        const int g = j >> 3, b = j & 7, jn = j + 1;
        const LAS v4u* ip = idl + ((jn >> 3) * (8 * PV_IDROW / 16) + 2 * (jn & 7)); const v4u ia = ip[0], ib = ip[1];
        const LAS f32x4* cp = cfl + (g * (8 * PV_CFROW / 16) + 4 * b);
        f32x4 cf[4];
#pragma unroll
        for (int q = 0; q < 4; ++q) cf[q] = cp[q];
#pragma unroll
        for (int m = 0; m < 16; ++m) { const float cm = cf[m >> 2][m & 3]; const f32x2v c2 = {cm, cm};
#pragma unroll
            for (int q = 0; q < 4; ++q) { const int w = (int)r[m][q]; acc[2 * q] = __builtin_amdgcn_cvt_pk_f32_fp8(w, false) * c2 + acc[2 * q]; acc[2 * q + 1] = __builtin_amdgcn_cvt_pk_f32_fp8(w, true) * c2 + acc[2 * q + 1]; }
            r[m] = *(const GAS v4u*)(tbase + (size_t)(((id_of(ia, ib, m) & idmask) << 7) + lo));
            __builtin_amdgcn_sched_barrier(0); }
        if (b == 7) {
            GAS f32x4* op = (GAS f32x4*)((AR.out) + (t0 + ts) * 1024 + 128 * s + 16 * c);
#pragma unroll
            for (int q = 0; q < 4; ++q) { f32x4 h = op[q]; h.x += acc[2 * q].x; h.y += acc[2 * q].y; h.z += acc[2 * q + 1].x; h.w += acc[2 * q + 1].y; if (!dry || h.x == 1.2345e30f) op[q] = h; }
#pragma unroll
            for (int q = 0; q < 8; ++q) acc[q] = (f32x2v){0.f, 0.f};
        }
    }
    { const LAS f32x4* cp = cfl + ((8 * PV_CFROW / 16) + 4 * 7);
      f32x4 cf[4];
#pragma unroll
      for (int q = 0; q < 4; ++q) cf[q] = cp[q];
#pragma unroll
      for (int m = 0; m < 16; ++m) { const float cm = cf[m >> 2][m & 3]; const f32x2v c2 = {cm, cm};
#pragma unroll
          for (int q = 0; q < 4; ++q) { const int w = (int)r[m][q]; acc[2 * q] = __builtin_amdgcn_cvt_pk_f32_fp8(w, false) * c2 + acc[2 * q]; acc[2 * q + 1] = __builtin_amdgcn_cvt_pk_f32_fp8(w, true) * c2 + acc[2 * q + 1]; } }
      GAS f32x4* op = (GAS f32x4*)((AR.out) + (t0 + 8 + ts) * 1024 + 128 * s + 16 * c);
#pragma unroll
      for (int q = 0; q < 4; ++q) { f32x4 h = op[q]; h.x += acc[2 * q].x; h.y += acc[2 * q].y; h.z += acc[2 * q + 1].x; h.w += acc[2 * q + 1].y; if (!dry || h.x == 1.2345e30f) op[q] = h; } }
}
template <int SIDE> __device__ __forceinline__ void peer_side(Frame& F, const Args& AR, int rep = 0) {
    gu32* cnt = F.ctl + CW_PEER + (SIDE + 2 * rep) * 16 * 64;
    LAS int* sh = (LAS int*)F.lds;
    const unsigned xcc = xb_xcc_id() & 7u;
#pragma unroll 1
    for (int k = 0; k < NSL; ++k) {
        const int s = (int)((xcc + (unsigned)k) & (unsigned)(NSL - 1));
#pragma unroll 1
        for (;;) {
            __syncthreads();
            if (F.tid == 0) sh[0] = (int)__hip_atomic_fetch_add(cnt + 64 * s, 1u, RLX_AGENT);
            __syncthreads();
            const int blk = sh[0];
            if (blk >= MTOK / 128) break;
            const size_t t0 = (size_t)blk * 128 + F.wave * 16;
            if (SIDE == 0) peer_u16(F, s, t0, (PROBE_FAKEID && ((REPEAT_MASK >> 11) & 1) && rep == 0) ? (unsigned)PROBE_FAKEID : 0xffffu); else { const bool dry = ((REPEAT_MASK >> 13) & 1) && rep == 0; const unsigned im = (dry && PROBE_FAKEID) ? (unsigned)PROBE_FAKEID : 0xffffu; peer_v16(F, AR, s, t0, im, dry); }
        }
    }
}
__device__ __forceinline__ void peer_coef_token(Frame& F, size_t tok, float inv_su, float inv_sv) {
    const int lane = F.lane;
    const unsigned short* pp = ((const unsigned short*)(F.ws + WS_SUBK)) + tok * NSL * 128;
    float a0 = 0.f, a1 = 0.f;
#pragma unroll
    for (int s = 0; s < NSL; ++s) { a0 += __uint_as_float((unsigned)pp[s * 128 + lane] << 16); a1 += __uint_as_float((unsigned)pp[s * 128 + 64 + lane] << 16); }
    float* gp = ((float*)(F.ws + WS_RG)) + tok * 128;
    const float sc = inv_su * row_rs((const float*)(F.ws + WS_SSP), tok);
    gp[lane] = gp[lane] * gelu_erf(a0 * sc) * inv_sv; gp[64 + lane] = gp[64 + lane] * gelu_erf(a1 * sc) * inv_sv;
}

__global__ void __launch_bounds__(NWAVES * 64, 2) mk_fwd(Args args) {
    extern __shared__ __attribute__((aligned(16))) unsigned char lds[];
    Frame F;
    F.lds = (LAS unsigned char*)lds;
    F.MISC = (volatile LAS unsigned*)(F.lds + MISC_OFF);
    F.tid = threadIdx.x; F.lane = F.tid & 63; F.wave = __builtin_amdgcn_readfirstlane(F.tid >> 6);
    F.G = gridDim.x; { const int bx = blockIdx.x; F.vcu = (F.G % 8 == 0) ? (bx % 8) * (F.G / 8) + bx / 8 : bx; }
    F.ws = args.ws;
    F.ctl = (gu32*)(F.ws + WS_CTL);
    const Args& AR = args;
    for (int u = F.tid; u < (LDS_BYTES - LDSCTL_OFF) / 4; u += NWAVES * 64) ((LAS unsigned*)(F.lds + LDSCTL_OFF))[u] = 0u;
    __syncthreads();
    XcdBarrier bar; bar.bar = (unsigned*)(F.ctl + CW_BAR); bar.x = 0; bar.st = nullptr;
#if !MK_PER_PHASE
    bar = xcd_barrier_post((unsigned*)(F.ctl + CW_BAR), F.MISC + 8);
#endif
    unsigned long long tacc_ = 0ull; unsigned tcnt_ = 0u;
    const unsigned long long tk0c_ = (PROBE_SEC == 10) ? __builtin_amdgcn_s_memtime() : 0ull, tk0r_ = (PROBE_SEC == 10) ? __builtin_amdgcn_s_memrealtime() : 0ull;
    const int lo = args.ph_lo, hi = args.ph_hi;
#if defined(ONLY_PHASE)
#define IN(k) ((k) == ONLY_PHASE && lo <= (k) && (k) < hi)
#elif defined(PHASE_MASK)
#define IN(k) (((PHASE_MASK >> (k)) & 1) && lo <= (k) && (k) < hi)
#else
#define IN(k) (lo <= (k) && (k) < hi)
#endif
#if MK_PER_PHASE
#define SEAM(k) do { } while (0)
#else
#define SEAM(k) do { if (IN(k) && IN((k) + 1)) xcd_barrier(bar); } while (0)
#endif
#define FRESH() Frame P = F; { int t_ = threadIdx.x; asm volatile("" : "+v"(t_)); P.tid = t_; P.lane = t_ & 63; P.wave = __builtin_amdgcn_readfirstlane(t_ >> 6); } const int gw = P.vcu * NWAVES + P.wave, NGW = P.G * NWAVES; (void)gw; (void)NGW

    for (int rep_ = 0; rep_ < (((REPEAT_MASK >> 0) & 1) ? 2 : 1); ++rep_) if (IN(0)) { FRESH(); p0_prologue(P, args); } SEAM(0);
    const unsigned long long tq0c_ = (PROBE_SEC == 12) ? __builtin_amdgcn_s_memtime() : 0ull, tq0r_ = (PROBE_SEC == 12) ? __builtin_amdgcn_s_memrealtime() : 0ull;
    for (int rep_ = 0; rep_ < (((REPEAT_MASK >> 1) & 1) ? 2 : 1); ++rep_) if (IN(1)) { pg8::Gemm g{((bf16*)(F.ws + WS_ACT)), ((bf16*)(F.ws + WS_WIN)), MTOK, LDP, 1024, 1024, 1024}; pg8::StaticOrder S; S.init(MTOK, LDP, F.G, (int)blockIdx.x);
        pg8::EpiStoreBf16 E{((bf16*)(F.ws + WS_PROJ)), LDP};
        pg8::gemm_phase<pg8::EpiStoreBf16, pg8::StaticOrder, true, true>(F.lds, g, S, E); } SEAM(1);
    if (PROBE_SEC == 12) { const unsigned long long dc = __builtin_amdgcn_s_memtime() - tq0c_, dr = __builtin_amdgcn_s_memrealtime() - tq0r_; tacc_ = dc * 100ull / (dr ? dr : 1ull); tcnt_ = 1u; }
    if (IN(2)) { FRESH(); for (int m = gw; m < MTOK; m += NGW) fixup_token(P, args, m);
        for (int r0 = gw * 32; r0 < MTOK; r0 += NGW * 32) pool_run(P, r0, 32);
        const float su = i8_scale(__hip_atomic_load(P.ctl + CW_AMAX, RLX_AGENT)), sv = fp8_scale(__hip_atomic_load(P.ctl + CW_AMAX + 1, RLX_AGENT));
#pragma unroll 4
        for (int r = gw; r < 2 * 16384; r += NGW) { const int rr = r & 16383;
            if (r < 16384) row_to_i8(args.in[13] + (size_t)rr * 1024, (unsigned char*)(P.ws + WS_U16) + (size_t)rr * 128, su, P.lane);
            else row_to_fp8(args.in[14] + (size_t)rr * 1024, (unsigned char*)(P.ws + WS_V16) + (size_t)rr * 128, sv, P.lane); } } SEAM(2);
    for (int rep_ = 0; rep_ < (((REPEAT_MASK >> 3) & 1) ? 2 : 1); ++rep_) if (IN(3)) { FRESH(); for (int i = P.vcu; i < 256; i += P.G) { const int b = i >> 4, s = i & 15;
#pragma unroll 1
            for (int k = 0; k < 4; ++k) idx_unit(P, args, b, (k == 0) ? s : (k == 1) ? 31 - s : (k == 2) ? 32 + s : 63 - s, tacc_, tcnt_, PROBE_NOSEL ? (rep_ == 1) : true); } } SEAM(3);
    const unsigned long long tp4_ = (PROBE_SEC == 5 || PROBE_SEC == 6 || PROBE_SEC == 7) ? ((PROBE_SEC != 6) ? __builtin_amdgcn_s_memtime() : __builtin_amdgcn_s_memrealtime()) : 0ull;
    for (int rep_ = 0; rep_ < (((REPEAT_MASK >> 4) & 1) ? 2 : 1); ++rep_) if (IN(4)) { FRESH(); for (int i = P.vcu; i < 256; i += P.G) { const int bh = i >> 1, s = i & 1, b = bh >> 3, h = bh & 7;
#pragma unroll 1
            for (int k = 0; k < 8; ++k) attn_unit(P, args, b, h, (k & 1) ? 15 - (k >> 1) * 2 - s : (k >> 1) * 2 + s, tacc_, tcnt_); }
        if (PROBE_SEC == 7) { tacc_ = (__builtin_amdgcn_s_memtime() - tp4_) / 1000ull; tcnt_ = 1u; } } SEAM(4);
    if (PROBE_SEC == 5) { tacc_ = (__builtin_amdgcn_s_memtime() - tp4_) / 1000ull; tcnt_ = 1u; }
    if (PROBE_SEC == 6) { tacc_ = (__builtin_amdgcn_s_memrealtime() - tp4_) / 10ull; tcnt_ = 1u; }
    for (int rep_ = 0; rep_ < (((REPEAT_MASK >> 5) & 1) ? 2 : 1); ++rep_) if (IN(5)) { pg8::Gemm g{((bf16*)(F.ws + WS_AO)), ((bf16*)(F.ws + WS_WA)), MTOK, 1024, 512, 512, 512}; pg8::StaticOrder S; S.init(MTOK, 1024, F.G, (int)blockIdx.x);
        pg8::EpiGate<false> E{((bf16*)(F.ws + WS_ACT)), 1024, ((bf16*)(F.ws + WS_PROJ)) + GA_OFF, LDP};
        pg8::gemm_phase<pg8::EpiGate<false>, pg8::StaticOrder, true, true>(F.lds, g, S, E); }
    if (IN(6)) { pg8::Gemm g{((bf16*)(F.ws + WS_POOLED)), ((bf16*)(F.ws + WS_WPP)), MTOK, 1024, 512, 512, 512}; pg8::StaticOrder S; S.init(MTOK, 1024, F.G, (int)blockIdx.x);
                pg8::EpiGate<true> E{((bf16*)(F.ws + WS_ACT)), 1024, ((bf16*)(F.ws + WS_PROJ)) + GP_OFF, LDP};
        pg8::gemm_phase<pg8::EpiGate<true>, pg8::StaticOrder, true, true>(F.lds, g, S, E); } SEAM(6);
    for (int rep_ = 0; rep_ < (((REPEAT_MASK >> 7) & 1) ? 2 : 1); ++rep_) if (IN(7)) { pg8::Gemm g{((bf16*)(F.ws + WS_ACT)), ((bf16*)(F.ws + WS_WO)), MTOK, 1024, 1024, 1024, 1024}; pg8::StaticOrder S; S.init(MTOK, 1024, F.G, (int)blockIdx.x);
        pg8::EpiResHG E{(AR.in[0]), (AR.out), ((bf16*)(F.ws + WS_HG)), (AR.in[10]), ((float*)(F.ws + WS_SSP)), 1024};
        pg8::gemm_phase<pg8::EpiResHG, pg8::StaticOrder, true, true>(F.lds, g, S, E); } SEAM(7);

    for (int rep_ = 0; rep_ < (((REPEAT_MASK >> 9) & 1) ? 2 : 1); ++rep_) if (IN(9)) { pg8::Gemm g{((bf16*)(F.ws + WS_HG)), ((bf16*)(F.ws + WS_W2)), MTOK, 1024, 1024, 1024, 1024}; pg8::StaticOrder S; S.init(MTOK, 1024, F.G, (int)blockIdx.x);
        pg8::EpiStoreBf16 E{((bf16*)(F.ws + WS_SUBK)), 1024};
        pg8::gemm_phase<pg8::EpiStoreBf16, pg8::StaticOrder, true, true>(F.lds, g, S, E); } SEAM(9);
    for (int rep_ = 0; rep_ < (((REPEAT_MASK >> 10) & 1) ? 2 : 1); ++rep_) if (IN(10)) { FRESH(); for (int tt = P.vcu; tt < MTOK / 32; tt += P.G) route_task(P, args, tt, P.wave); } SEAM(10);
        const unsigned long long tg0c_ = (PROBE_SEC == 11) ? __builtin_amdgcn_s_memtime() : 0ull, tg0r_ = (PROBE_SEC == 11) ? __builtin_amdgcn_s_memrealtime() : 0ull;
    for (int rep_ = 0; rep_ < (((REPEAT_MASK >> 11) & 1) ? 2 : 1); ++rep_) if (IN(11)) { FRESH(); peer_side<0>(P, args, rep_); } SEAM(11);
    if (IN(12)) { FRESH(); const float iu = i8_inv_scale(__hip_atomic_load(P.ctl + CW_AMAX, RLX_AGENT)), iv = fp8_inv_scale(__hip_atomic_load(P.ctl + CW_AMAX + 1, RLX_AGENT));
        for (int m = gw; m < MTOK; m += NGW) peer_coef_token(P, (size_t)m, iu, iv); } SEAM(12);
    for (int rep_ = 0; rep_ < (((REPEAT_MASK >> 13) & 1) ? 2 : 1); ++rep_) if (IN(13)) { FRESH(); peer_side<1>(P, args, rep_); }
#if PROBE_SEC == 11
    { const unsigned long long dc = __builtin_amdgcn_s_memtime() - tg0c_, dr = __builtin_amdgcn_s_memrealtime() - tg0r_; tacc_ = dc * 100ull / (dr ? dr : 1ull); tcnt_ = 1u; }
#endif
#if PROBE_SEC == 10
    { const unsigned long long dc = __builtin_amdgcn_s_memtime() - tk0c_, dr = __builtin_amdgcn_s_memrealtime() - tk0r_; tacc_ = dc * 100ull / (dr ? dr : 1ull); tcnt_ = 1u; }
#endif
#if PROBE_RATE
    { int lane_ = threadIdx.x; asm volatile("" : "+v"(lane_)); int x = lane_ * 3 + 1, y = lane_ ^ 0x55; int a[8]; f32x2v f[8]; const f32x2v fx = {1.0001f, 0.9999f}, fy = {1e-9f, 2e-9f};
#pragma unroll
      for (int k = 0; k < 8; ++k) { a[k] = lane_ + k; f[k] = (f32x2v){(float)k, 1.f}; }
#pragma unroll 1
      for (int i = 0; i < 640; ++i) {
#pragma unroll
          for (int r = 0; r < 8; ++r)
#pragma unroll
              for (int k = 0; k < 8; ++k) {
                  if (PROBE_RATE == 1) asm volatile("v_dot4c_i32_i8_e32 %0, %1, %2" : "+v"(a[k]) : "v"(x), "v"(y));
                  if (PROBE_RATE == 2) asm volatile("v_pk_fma_f32 %0, %1, %2, %0" : "+v"(f[k]) : "v"(fx), "v"(fy));
                  if (PROBE_RATE == 3) asm volatile("v_cvt_pk_f32_fp8_e32 %0, %1" : "=v"(f[k]) : "v"(x));
                  if (PROBE_RATE == 4) asm volatile("v_add_u32_dpp %0, %0, %0 quad_perm:[1,0,3,2] row_mask:0xf bank_mask:0xf bound_ctrl:1" : "+v"(a[k]));
                  if (PROBE_RATE == 5) asm volatile("v_perm_b32 %0, %0, %1, %2" : "+v"(a[k]) : "v"(x), "v"(y));
                  if (PROBE_RATE == 6) asm volatile("v_fma_f32 %0, %1, %2, %0" : "+v"(f[k].x) : "v"(fx.x), "v"(fy.x));
                  if (PROBE_RATE == 7) asm volatile("v_lshl_or_b32 %0, %0, 10, %1" : "+v"(a[k]) : "v"(x));
                  if (PROBE_RATE == 10) asm volatile("v_dot4c_i32_i8_e32 %0, %1, %2" : "+v"(a[0]) : "v"(x), "v"(y));
                  if (PROBE_RATE == 11) asm volatile("v_pk_fma_f32 %0, %1, %2, %0" : "+v"(f[0]) : "v"(fx), "v"(fy));
              }
      }
      int sum = 0;
#pragma unroll
      for (int k = 0; k < 8; ++k) sum += a[k] + (int)f[k].x + (int)f[k].y;
      if (sum == 0x7fffffff) ((volatile int*)(F.ws + WS_CTL))[2048 + threadIdx.x] = sum; }
#endif
#if PROBE_SEC
    if (blockIdx.x == 0 && F.wave == 7) { const unsigned long long avg = tacc_ / (unsigned long long)(tcnt_ ? tcnt_ : 1u); const unsigned long long t_end = __builtin_amdgcn_s_memrealtime() + avg * 10ull;
        while (__builtin_amdgcn_s_memrealtime() < t_end) __builtin_amdgcn_s_sleep(8); }
#endif

#undef IN
#undef SEAM
}

extern "C" void kernel_launch(void* const* d_in, const int* in_sizes, int n_in, void* d_out, int out_size, void* d_ws, size_t ws_size, hipStream_t stream) {
    static int grid = 0;
    if (grid == 0) {
        if (n_in != 15 || in_sizes[0] != MTOK * DM || out_size != MTOK * DM || ws_size < WS_END) { fprintf(stderr, "kernel_launch: unexpected shapes (n_in %d, in0 %d, out %d, ws %zu < %zu)\n", n_in, n_in > 0 ? in_sizes[0] : -1, out_size, ws_size, (size_t)WS_END); grid = -1; return; }
        int dev = 0, cus = 0, per_cu = 0;
        if (hipGetDevice(&dev) != hipSuccess || hipDeviceGetAttribute(&cus, hipDeviceAttributeMultiprocessorCount, dev) != hipSuccess) { grid = -1; return; }
        if (hipFuncSetAttribute((const void*)mk_fwd, hipFuncAttributeMaxDynamicSharedMemorySize, LDS_BYTES) != hipSuccess) { fprintf(stderr, "kernel_launch: hipFuncSetAttribute failed\n"); grid = -1; return; }
        if (hipOccupancyMaxActiveBlocksPerMultiprocessor(&per_cu, (const void*)mk_fwd, NWAVES * 64, LDS_BYTES) != hipSuccess || per_cu < 1) { fprintf(stderr, "kernel_launch: occupancy query says %d blocks per CU\n", per_cu); (void)hipGetLastError(); grid = -1; return; }
        grid = cus;
    }
    if (grid < 0) return;
    if (hipMemsetAsync((char*)d_ws + WS_CTL, 0, CTL_ZERO_BYTES, stream) != hipSuccess) return;
    Args a{};
    for (int i = 0; i < 15; ++i) a.in[i] = (const float*)d_in[i];
    a.out = (float*)d_out; a.ws = (unsigned char*)d_ws;
#if MK_PER_PHASE
    for (int p = 0; p < NPHASE; ++p) { a.ph_lo = p; a.ph_hi = p + 1; hipLaunchKernelGGL(mk_fwd, dim3(grid), dim3(NWAVES * 64), LDS_BYTES, stream, a); }
#else
    a.ph_lo = 0; a.ph_hi = NPHASE;
    hipLaunchKernelGGL(mk_fwd, dim3(grid), dim3(NWAVES * 64), LDS_BYTES, stream, a);
#endif
}
```

```cpp
#include <hip/hip_runtime.h>
#include <cstdio>
#include <cstdint>
namespace pg8 {
#define PG8_LAS __attribute__((address_space(3)))
typedef unsigned short bf16_t;
typedef short bf16x8 __attribute__((ext_vector_type(8)));
typedef float f32x4 __attribute__((ext_vector_type(4)));
typedef unsigned u32x4 __attribute__((ext_vector_type(4)));
constexpr int BM = 256, BK = 64, HALF = 128, HTB = HALF * BK * 2  , STAGE_BYTES = 8 * HTB, NXCD = 8, WGM = 8;

__host__ __device__ __forceinline__ int lds_byte(int r, int c) { const int st = (r >> 4) * 2 + (c >> 5), rr = r & 15, cc = c & 31, ob = rr * 64 + cc * 2; return st * 1024 + (ob ^ (((ob >> 9) & 1) << 5)); }
__host__ __device__ __forceinline__ void stage_rc(int b, int& R, int& C) { const int st = b / 1024, sb = b % 1024, swz = sb ^ (((sb >> 9) & 1) << 5); R = (st >> 1) * 16 + swz / 64; C = (st & 1) * 32 + (swz % 64) / 2; }
__host__ __device__ __forceinline__ int perm32(int rho) { const int n = rho >> 4, i = rho & 15; return 8 * (i >> 2) + 4 * n + (i & 3); }

struct Unit { int pm, pn; };
struct Gemm { const bf16_t* A; const bf16_t* Bt; int M, N, K, lda, ldb; };

struct StaticOrder {
    int nM, nN, nwg, G, c;
    __host__ __device__ void init(int M, int N, int G_, int c_) { nM = M / BM; nN = N / BM; nwg = nM * nN; G = G_; c = c_; }
    __host__ __device__ bool next(int i, Unit& u) const {
        const long L = (long)i * G + c; if (L >= nwg) return false;
        int wgid = (int)L; { const int q = nwg / NXCD, r = nwg % NXCD, xcd = wgid % NXCD, off = wgid / NXCD; wgid = (xcd < r ? xcd * (q + 1) : r * (q + 1) + (xcd - r) * q) + off; }
        const int nig = WGM * nN, gid = wgid / nig, fm = gid * WGM, gsz = (nM - fm) < WGM ? (nM - fm) : WGM;
        u.pm = fm + ((wgid % nig) % gsz); u.pn = (wgid % nig) / gsz; return true;
    }
    __device__ __forceinline__ void a_ready(const Unit&) const {}
    __device__ __forceinline__ void done(const Unit&) const {}
};
struct PanelOrder {
    int nN, pm;
    __host__ __device__ bool next(int i, Unit& u) const { if (i >= nN) return false; u.pm = pm; u.pn = i; return true; }
    __device__ __forceinline__ void a_ready(const Unit&) const {}
    __device__ __forceinline__ void done(const Unit&) const {}
};
typedef float f32x2c_t __attribute__((ext_vector_type(2))); typedef __bf16 bf16x2c_t __attribute__((ext_vector_type(2)));
__device__ __forceinline__ unsigned cvt_pk_bf16(float lo, float hi) { f32x2c_t v = {lo, hi}; bf16x2c_t b = __builtin_convertvector(v, bf16x2c_t); return __builtin_bit_cast(unsigned, b); }
typedef float f32x2 __attribute__((ext_vector_type(2)));
__device__ __forceinline__ f32x2 gelu_pk(f32x2 v) {
    const f32x2 av = __builtin_elementwise_abs(v), d = av * 0.2316418882f + 1.0f;
    f32x2 t; t.x = __builtin_amdgcn_rcpf(d.x); t.y = __builtin_amdgcn_rcpf(d.y);
    f32x2 q = t * 0.5307027145f + (-0.7265760135f); q = q * t + 0.7107068705f; q = q * t + (-0.142248368f); q = q * t + 0.127414796f; q = q * t;
    const f32x2 s = (v * v) * (-0.72134752044f);
    f32x2 e; e.x = __builtin_amdgcn_exp2f(s.x); e.y = __builtin_amdgcn_exp2f(s.y);
    const f32x2 m = v * (q * e), r = v - m;
    f32x2 o; o.x = v.x < 0.f ? m.x : r.x; o.y = v.y < 0.f ? m.y : r.y; return o;
}
typedef unsigned u32x2e __attribute__((ext_vector_type(2)));
__device__ __forceinline__ float bf_lo(unsigned w) { return __uint_as_float(w << 16); }
__device__ __forceinline__ float bf_hi(unsigned w) { return __uint_as_float(w & 0xffff0000u); }
__device__ __forceinline__ float sigmoidf_fast(float g) { return __builtin_amdgcn_rcpf(1.0f + __builtin_amdgcn_exp2f(-1.4426950408889634f * g)); }
__device__ __forceinline__ unsigned ord_key(float f) { const unsigned b = __float_as_uint(f); return b ^ ((unsigned)((int)b >> 31) | 0x80000000u); }
__device__ __forceinline__ float unord_key(unsigned k) { return __uint_as_float((k & 0x80000000u) ? (k ^ 0x80000000u) : ~k); }

struct EpiStoreBf16 {
    static constexpr bool PERM = true, AFTER_DRAIN = false;
    bf16_t* O; int ldc;
    __device__ __forceinline__ void operator()(const f32x4 (&acc)[2][2][4][2], const Unit& u, int wr, int wc, int fr, int fq) const {
        const int row0 = u.pm * BM + wr * 64 + fr, col0 = u.pn * BM + wc * 32 + 8 * fq;
#pragma unroll
        for (int ai = 0; ai < 2; ++ai)
#pragma unroll
            for (int m = 0; m < 4; ++m) { bf16_t* rowp = O + (size_t)(row0 + ai * HALF + m * 16) * ldc + col0;
#pragma unroll
                for (int bj = 0; bj < 2; ++bj) { const f32x4 v0 = acc[ai][bj][m][0], v1 = acc[ai][bj][m][1];
                    u32x4 w; w.x = cvt_pk_bf16(v0[0], v0[1]); w.y = cvt_pk_bf16(v0[2], v0[3]); w.z = cvt_pk_bf16(v1[0], v1[1]); w.w = cvt_pk_bf16(v1[2], v1[3]);
                    *(u32x4*)(rowp + bj * HALF) = w; } }
    }
};
template <bool ADD> struct EpiGate {
    static constexpr bool PERM = true, AFTER_DRAIN = false;
    bf16_t* O; int ldc; const bf16_t* G; int ldg;
    __device__ __forceinline__ void operator()(const f32x4 (&acc)[2][2][4][2], const Unit& u, int wr, int wc, int fr, int fq) const {
        const int row0 = u.pm * BM + wr * 64 + fr, col0 = u.pn * BM + wc * 32 + 8 * fq;
#pragma unroll
        for (int ai = 0; ai < 2; ++ai)
#pragma unroll
            for (int m = 0; m < 4; ++m) { const size_t row = (size_t)(row0 + ai * HALF + m * 16);
#pragma unroll
                for (int bj = 0; bj < 2; ++bj) { const int col = col0 + bj * HALF;
                    const u32x4 gr = *(const u32x4*)(G + row * ldg + col);
                    f32x4 v0 = acc[ai][bj][m][0], v1 = acc[ai][bj][m][1];
                    v0[0] *= sigmoidf_fast(bf_lo(gr.x)); v0[1] *= sigmoidf_fast(bf_hi(gr.x)); v0[2] *= sigmoidf_fast(bf_lo(gr.y)); v0[3] *= sigmoidf_fast(bf_hi(gr.y));
                    v1[0] *= sigmoidf_fast(bf_lo(gr.z)); v1[1] *= sigmoidf_fast(bf_hi(gr.z)); v1[2] *= sigmoidf_fast(bf_lo(gr.w)); v1[3] *= sigmoidf_fast(bf_hi(gr.w));
                    bf16_t* op = O + row * ldc + col;
                    if (ADD) { const u32x4 pr = *(const u32x4*)op;
                        v0[0] += bf_lo(pr.x); v0[1] += bf_hi(pr.x); v0[2] += bf_lo(pr.y); v0[3] += bf_hi(pr.y);
                        v1[0] += bf_lo(pr.z); v1[1] += bf_hi(pr.z); v1[2] += bf_lo(pr.w); v1[3] += bf_hi(pr.w); }
                    u32x4 w; w.x = cvt_pk_bf16(v0[0], v0[1]); w.y = cvt_pk_bf16(v0[2], v0[3]); w.z = cvt_pk_bf16(v1[0], v1[1]); w.w = cvt_pk_bf16(v1[2], v1[3]);
                    *(u32x4*)op = w; } }
    }
};
struct EpiResF32 {
    static constexpr bool PERM = false, AFTER_DRAIN = false;
    const float* base; float* out; int ldc;
    __device__ __forceinline__ void operator()(const f32x4 (&acc)[2][2][4][2], const Unit& u, int wr, int wc, int fr, int fq) const {
        const int col0 = u.pn * BM + wc * 32 + 4 * fq;
#pragma unroll
        for (int ai = 0; ai < 2; ++ai)
#pragma unroll
            for (int m = 0; m < 4; ++m) { const size_t off = (size_t)(u.pm * BM + ai * HALF + wr * 64 + m * 16 + fr) * ldc + col0;
#pragma unroll
                for (int bj = 0; bj < 2; ++bj)
#pragma unroll
                    for (int n = 0; n < 2; ++n) { const f32x4 bs = *(const f32x4*)(base + off + bj * HALF + n * 16); *(f32x4*)(out + off + bj * HALF + n * 16) = bs + acc[ai][bj][m][n]; } }
    }
};
struct EpiResHG {
    static constexpr bool PERM = false, AFTER_DRAIN = false;
    const float* base; float* out; bf16_t* hg; const float* gain; float* ssp; int ldc;
    __device__ __forceinline__ void operator()(const f32x4 (&acc)[2][2][4][2], const Unit& u, int wr, int wc, int fr, int fq) const {
        const int col0 = u.pn * BM + wc * 32 + 4 * fq;
        f32x4 gv[2][2];
#pragma unroll
        for (int bj = 0; bj < 2; ++bj)
#pragma unroll
            for (int n = 0; n < 2; ++n) gv[bj][n] = *(const f32x4*)(gain + col0 + bj * HALF + n * 16);
#pragma unroll
        for (int ai = 0; ai < 2; ++ai)
#pragma unroll
            for (int m = 0; m < 4; ++m) { const int row = u.pm * BM + ai * HALF + wr * 64 + m * 16 + fr; const size_t off = (size_t)row * ldc + col0; float ss = 0.f;
#pragma unroll
                for (int bj = 0; bj < 2; ++bj)
#pragma unroll
                    for (int n = 0; n < 2; ++n) { const f32x4 h = *(const f32x4*)(base + off + bj * HALF + n * 16) + acc[ai][bj][m][n]; *(f32x4*)(out + off + bj * HALF + n * 16) = h;
                        ss += (h[0] * h[0] + h[1] * h[1]) + (h[2] * h[2] + h[3] * h[3]);
                        const f32x4 hgv = h * gv[bj][n]; u32x2e w; w.x = cvt_pk_bf16(hgv[0], hgv[1]); w.y = cvt_pk_bf16(hgv[2], hgv[3]); *(u32x2e*)(hg + off + bj * HALF + n * 16) = w; }
                ss += __shfl_xor(ss, 16); ss += __shfl_xor(ss, 32);
                if (fq == 0) ssp[(size_t)row * 16 + u.pn * 4 + wc] = ss; }
    }
};
struct EpiKeys {
    static constexpr bool PERM = false, AFTER_DRAIN = false;
    unsigned* O; int ldc;
    __device__ __forceinline__ void operator()(const f32x4 (&acc)[2][2][4][2], const Unit& u, int wr, int wc, int fr, int fq) const {
        const int col0 = u.pn * BM + wc * 32 + 4 * fq;
#pragma unroll
        for (int ai = 0; ai < 2; ++ai)
#pragma unroll
            for (int m = 0; m < 4; ++m) { const size_t off = (size_t)(u.pm * BM + ai * HALF + wr * 64 + m * 16 + fr) * ldc + col0;
#pragma unroll
                for (int bj = 0; bj < 2; ++bj)
#pragma unroll
                    for (int n = 0; n < 2; ++n) { const int nn = (col0 + bj * HALF + n * 16) & 127; const f32x4 a = acc[ai][bj][m][n]; u32x4 w;
                        w.x = (ord_key(a[0]) & ~127u) | (unsigned)(127 - nn); w.y = (ord_key(a[1]) & ~127u) | (unsigned)(126 - nn);
                        w.z = (ord_key(a[2]) & ~127u) | (unsigned)(125 - nn); w.w = (ord_key(a[3]) & ~127u) | (unsigned)(124 - nn);
                        *(u32x4*)(O + off + bj * HALF + n * 16) = w; } }
    }
};

template <class Epi, class Sched, bool ALIGN_EPI = false, bool SP2 = false>
__device__ __forceinline__ void gemm_phase(PG8_LAS unsigned char* lds, const Gemm g, const Sched& S, const Epi& E) {
    int tid_ = threadIdx.x; asm volatile("" : "+v"(tid_));
    const int tid = tid_, wid = __builtin_amdgcn_readfirstlane(tid >> 6), lane = tid & 63, wr = wid >> 2, wc = wid & 3, fr = lane & 15, fq = lane >> 4;
    const int K = g.K, nt = K / BK;
    unsigned voffA[2], voffB[2];
#pragma unroll
    for (int i = 0; i < 2; ++i) { int R, C; stage_rc(tid * 16 + i * 8192, R, C); const int Rb = Epi::PERM ? ((R & ~31) + perm32(R & 31)) : R;
        voffA[i] = (unsigned)(R * g.lda + C) * 2u; voffB[i] = (unsigned)(Rb * g.ldb + C) * 2u; }
    const size_t kstep = (size_t)(BK * 2);
    const size_t hstepA = (size_t)HALF * g.lda * 2, hstepB = (size_t)HALF * g.ldb * 2;
    const size_t tstepA = 2 * hstepA, tstepB = 2 * hstepB;
    const unsigned ldsw = (unsigned)wid * 1024u;
    const int aoff = lds_byte(wr * 64 + fr, fq * 8), boff = lds_byte(wc * 32 + fr, fq * 8);
#define PG8_SA(b, h) (((b) * 2 + (h)) * HTB)
#define PG8_SB(b, h) ((4 + (b) * 2 + (h)) * HTB)
#define PG8_STAGE(bufoff, gbase, voff) do { _Pragma("unroll") for (int _i = 0; _i < 2; ++_i) \
        __builtin_amdgcn_global_load_lds((const unsigned*)((const char*)(gbase) + (voff)[_i]), (PG8_LAS unsigned*)(lds + (bufoff) + ldsw + _i * 8192), 16, 0, 0); } while (0)
#define PG8_LDA(dst, b, h) do { _Pragma("unroll") for (int m = 0; m < 4; ++m) _Pragma("unroll") for (int k = 0; k < 2; ++k) dst[m][k] = *(const PG8_LAS bf16x8*)(lds + PG8_SA(b, h) + aoff + m * 2048 + k * 1024); } while (0)
#define PG8_LDB(dst, b, h) do { _Pragma("unroll") for (int n = 0; n < 2; ++n) _Pragma("unroll") for (int k = 0; k < 2; ++k) dst[n][k] = *(const PG8_LAS bf16x8*)(lds + PG8_SB(b, h) + boff + n * 2048 + k * 1024); } while (0)
#define PG8_MMA(ai, bj, At, Bt) do { __builtin_amdgcn_s_setprio(1); _Pragma("unroll") for (int m = 0; m < 4; ++m) _Pragma("unroll") for (int n = 0; n < 2; ++n) _Pragma("unroll") for (int k = 0; k < 2; ++k) \
        acc[ai][bj][m][n] = __builtin_amdgcn_mfma_f32_16x16x32_bf16(Bt[n][k], At[m][k], acc[ai][bj][m][n], 0, 0, 0); __builtin_amdgcn_s_setprio(0); } while (0)
#define PG8_WAIT_V(n) asm volatile("s_waitcnt vmcnt(" #n ")" ::: "memory")
#define PG8_WAIT_L(n) asm volatile("s_waitcnt lgkmcnt(" #n ")" ::: "memory")
#define PG8_BAR __builtin_amdgcn_s_barrier()
#define PG8_SCHED __builtin_amdgcn_sched_barrier(0)
    Unit cur, nxt; int ui = 0;
    if (!S.next(0, cur)) return;
    f32x4 acc[2][2][4][2];
#pragma unroll
    for (int a = 0; a < 2; ++a)
#pragma unroll
        for (int b = 0; b < 2; ++b)
#pragma unroll
            for (int m = 0; m < 4; ++m)
#pragma unroll
                for (int n = 0; n < 2; ++n) acc[a][b][m][n] = (f32x4){0.f, 0.f, 0.f, 0.f};
    bf16x8 At[4][2], B0[2][2], B1[2][2];
    const char* cA = (const char*)g.A + (size_t)cur.pm * tstepA; const char* cB = (const char*)g.Bt + (size_t)cur.pn * tstepB;
    S.a_ready(cur);
    if constexpr (SP2) {
        PG8_STAGE(PG8_SB(0, 0), cB, voffB); PG8_STAGE(PG8_SB(0, 1), cB + hstepB, voffB); PG8_STAGE(PG8_SA(0, 0), cA, voffA); PG8_STAGE(PG8_SA(0, 1), cA + hstepA, voffA);
        if (wr == 1) PG8_BAR;
        PG8_WAIT_V(2); PG8_BAR;
        PG8_STAGE(PG8_SB(1, 0), cB + kstep, voffB); PG8_STAGE(PG8_SA(1, 0), cA + kstep, voffA); PG8_STAGE(PG8_SB(1, 1), cB + hstepB + kstep, voffB);
        PG8_WAIT_V(6); PG8_BAR;
    } else {
        PG8_STAGE(PG8_SB(0, 0), cB, voffB); PG8_STAGE(PG8_SA(0, 0), cA, voffA); PG8_STAGE(PG8_SB(0, 1), cB + hstepB, voffB); PG8_STAGE(PG8_SA(0, 1), cA + hstepA, voffA);
        if (wr == 1) PG8_BAR;
        PG8_WAIT_V(4); PG8_BAR;
        PG8_STAGE(PG8_SB(1, 0), cB + kstep, voffB); PG8_STAGE(PG8_SA(1, 0), cA + kstep, voffA); PG8_STAGE(PG8_SB(1, 1), cB + hstepB + kstep, voffB);
        PG8_WAIT_V(6); PG8_BAR;
    }
    for (;;) {
        const bool has_next = S.next(ui + 1, nxt);
        const char* nA = has_next ? (const char*)g.A + (size_t)nxt.pm * tstepA : cA; const char* nB = has_next ? (const char*)g.Bt + (size_t)nxt.pn * tstepB : cB;
        for (int t = 0; t < nt; t += 2) {
            const bool last = (t == nt - 2);
            const char* a1 = cA + (size_t)(t + 1) * kstep;
            const char* a2 = last ? nA : cA + (size_t)(t + 2) * kstep; const char* b2 = last ? nB : cB + (size_t)(t + 2) * kstep;
            const char* a3 = a2 + kstep; const char* b3 = b2 + kstep;
            if (last && has_next) S.a_ready(nxt);
            if constexpr (SP2) {
            PG8_LDB(B0, 0, 0); PG8_LDB(B1, 0, 1); PG8_SCHED; PG8_LDA(At, 0, 0); PG8_STAGE(PG8_SA(1, 1), a1 + hstepA, voffA);
            PG8_WAIT_V(8); PG8_WAIT_L(0); PG8_BAR; PG8_MMA(0, 0, At, B0); PG8_MMA(0, 1, At, B1); PG8_BAR; PG8_SCHED;
            PG8_LDA(At, 0, 1); PG8_STAGE(PG8_SB(0, 0), b2, voffB); PG8_STAGE(PG8_SB(0, 1), b2 + hstepB, voffB); PG8_STAGE(PG8_SA(0, 0), a2, voffA);
            PG8_WAIT_V(8); PG8_WAIT_L(0); PG8_BAR; PG8_MMA(1, 0, At, B0); PG8_MMA(1, 1, At, B1); PG8_BAR; PG8_SCHED;
            PG8_LDB(B0, 1, 0); PG8_LDB(B1, 1, 1); PG8_SCHED; PG8_LDA(At, 1, 0); PG8_STAGE(PG8_SA(0, 1), a2 + hstepA, voffA);
            PG8_WAIT_V(8); PG8_WAIT_L(0); PG8_BAR; PG8_MMA(0, 0, At, B0); PG8_MMA(0, 1, At, B1); PG8_BAR; PG8_SCHED;
            PG8_LDA(At, 1, 1); PG8_STAGE(PG8_SB(1, 0), b3, voffB); PG8_STAGE(PG8_SB(1, 1), b3 + hstepB, voffB); PG8_STAGE(PG8_SA(1, 0), a3, voffA);
            PG8_WAIT_V(8); PG8_WAIT_L(0); PG8_BAR; PG8_MMA(1, 0, At, B0); PG8_MMA(1, 1, At, B1); PG8_BAR; PG8_SCHED;
            } else {
            PG8_LDB(B0, 0, 0); PG8_SCHED; PG8_LDA(At, 0, 0); PG8_STAGE(PG8_SA(1, 1), a1 + hstepA, voffA);
            PG8_WAIT_L(8); PG8_BAR; PG8_WAIT_L(0); PG8_MMA(0, 0, At, B0); PG8_BAR; PG8_SCHED;
            PG8_LDB(B1, 0, 1); PG8_STAGE(PG8_SB(0, 0), b2, voffB);
            PG8_BAR; PG8_WAIT_L(0); PG8_MMA(0, 1, At, B1); PG8_BAR;
            PG8_LDA(At, 0, 1); PG8_STAGE(PG8_SA(0, 0), a2, voffA);
            PG8_BAR; PG8_WAIT_L(0); PG8_MMA(1, 0, At, B0); PG8_BAR; PG8_SCHED;
            PG8_STAGE(PG8_SB(0, 1), b2 + hstepB, voffB);
            PG8_WAIT_V(6); PG8_BAR; PG8_MMA(1, 1, At, B1); PG8_BAR;
            PG8_LDB(B0, 1, 0); PG8_SCHED; PG8_LDA(At, 1, 0); PG8_STAGE(PG8_SA(0, 1), a2 + hstepA, voffA);
            PG8_WAIT_L(8); PG8_BAR; PG8_WAIT_L(0); PG8_MMA(0, 0, At, B0); PG8_BAR; PG8_SCHED;
            PG8_LDB(B1, 1, 1); PG8_STAGE(PG8_SB(1, 0), b3, voffB);
            PG8_BAR; PG8_WAIT_L(0); PG8_MMA(0, 1, At, B1); PG8_BAR;
            PG8_LDA(At, 1, 1); PG8_STAGE(PG8_SA(1, 0), a3, voffA);
            PG8_BAR; PG8_WAIT_L(0); PG8_MMA(1, 0, At, B0); PG8_BAR; PG8_SCHED;
            PG8_STAGE(PG8_SB(1, 1), b3 + hstepB, voffB);
            PG8_WAIT_V(6); PG8_BAR; PG8_MMA(1, 1, At, B1); PG8_BAR;
            }
        }
        if constexpr (ALIGN_EPI) { if (wr == 0) PG8_BAR; }
        if constexpr (!Epi::AFTER_DRAIN) { Unit ue = cur; asm volatile("" : "+s"(ue.pm), "+s"(ue.pn));
            E(acc, ue, wr, wc, fr, fq); S.done(cur); }
        if (!has_next) break;
#pragma unroll
        for (int a = 0; a < 2; ++a)
#pragma unroll
            for (int b = 0; b < 2; ++b)
#pragma unroll
                for (int m = 0; m < 4; ++m)
#pragma unroll
                    for (int n = 0; n < 2; ++n) acc[a][b][m][n] = (f32x4){0.f, 0.f, 0.f, 0.f};
        cur = nxt; cA = nA; cB = nB; ++ui;
        if constexpr (ALIGN_EPI) { if (wr == 1) PG8_BAR; }
    }
    PG8_WAIT_V(0);
    if constexpr (!ALIGN_EPI) { if (wr == 0) PG8_BAR; }
    PG8_BAR;
    if constexpr (Epi::AFTER_DRAIN) { E.fused(acc, cur, wr, wc, fr, fq, lds, wid, lane); S.done(cur); }
#undef PG8_SA
#undef PG8_SB
#undef PG8_STAGE
#undef PG8_LDA
#undef PG8_LDB
#undef PG8_MMA
#undef PG8_WAIT_V
#undef PG8_WAIT_L
#undef PG8_BAR
#undef PG8_SCHED
}
}

constexpr int NWAVES = 8;
#ifndef REPEAT_MASK
#define REPEAT_MASK 0
#endif
#ifndef PROBE_SEL2
#define PROBE_SEL2 1
#endif
#ifndef PROBE_SEC
#define PROBE_SEC 0
#endif
#ifndef PROBE_RATE
#define PROBE_RATE 0
#endif
#ifndef PROBE_FAKEID
#define PROBE_FAKEID 0
#endif
#ifndef PROBE_NOSEL
#define PROBE_NOSEL 0
#endif
#ifndef MK_PER_PHASE
#define MK_PER_PHASE 0
#endif
constexpr int NPHASE = 14;

constexpr int BATCH = 16, SEQ = 4096, DM = 1024, MTOK = BATCH * SEQ;
constexpr int LDP = 4864;
constexpr int Q_OFF = 0, K_OFF = 512, V_OFF = 1024, QI_OFF = 1536, P_OFF = 2048, GA_OFF = 2560, GP_OFF = 3584, KI_OFF = 4608, WI_OFF = 4672;
constexpr int IN_WIDTH = 4680;
constexpr float EPS = 1e-6f;
constexpr float C2 = 0.125f * 1.4426950408889634f;
constexpr float WI_SCALE = 0.35355339059327373f * 0.125f;

constexpr size_t MiB = 1u << 20;
constexpr size_t WS_CTL = 0, CTL_ZERO_BYTES = 1 * MiB;
constexpr size_t WS_ROPE = 1 * MiB;
constexpr size_t WS_WIN = 2 * MiB;
constexpr size_t WS_WA = 12 * MiB;
constexpr size_t WS_WPP = 13 * MiB;
constexpr size_t WS_WO = 14 * MiB;
constexpr size_t WS_W2 = 16 * MiB;
constexpr size_t WS_SKB = 19 * MiB;
constexpr size_t WS_U16 = 20 * MiB, WS_V16 = 52 * MiB;
constexpr size_t WS_MASK = 84 * MiB;
constexpr size_t WS_POOLED = 116 * MiB;
constexpr size_t WS_ACT = 180 * MiB;
constexpr size_t WS_PROJ = 308 * MiB;
constexpr size_t WS_AO = 916 * MiB;
constexpr size_t WS_REXP = 980 * MiB, WS_RG = 116 * MiB;
constexpr size_t WS_HG = 308 * MiB;
constexpr size_t WS_SUBK = 436 * MiB;
constexpr size_t WS_SSP = 948 * MiB;
constexpr size_t WS_END = 1024 * MiB;
constexpr int CW_TMO = 0, CW_BAR = 4096, CW_AMAX = 12288;

constexpr int RING_BYTES = 131072;
constexpr int LDSCTL_OFF = RING_BYTES, MISC_OFF = LDSCTL_OFF + 320;
constexpr int LDS_BYTES = 147456;

#define GAS __attribute__((address_space(1)))
#define LAS __attribute__((address_space(3)))
typedef unsigned short bf16;
typedef unsigned v4u __attribute__((ext_vector_type(4)));
typedef unsigned v2u __attribute__((ext_vector_type(2)));
typedef float f32x4 __attribute__((ext_vector_type(4)));
typedef float f32x16 __attribute__((ext_vector_type(16)));
typedef short bf16x8 __attribute__((ext_vector_type(8)));
typedef short s16x4 __attribute__((ext_vector_type(4)));
typedef GAS unsigned gu32;
#define RLX_AGENT __ATOMIC_RELAXED, __HIP_MEMORY_SCOPE_AGENT
#define LDS_WAIT() asm volatile("s_waitcnt lgkmcnt(0)" ::: "memory")
#define BAR_LDS() asm volatile("s_waitcnt lgkmcnt(0)\n\ts_barrier" ::: "memory")
#define VM_WAIT() asm volatile("s_waitcnt vmcnt(0)" ::: "memory")
__device__ __forceinline__ unsigned f2bf(float f) { unsigned u = __builtin_bit_cast(unsigned, f); return (u + 0x7fffu + ((u >> 16) & 1u)) >> 16; }
typedef float f32x2k_t __attribute__((ext_vector_type(2))); typedef __bf16 bf16x2k_t __attribute__((ext_vector_type(2)));
__device__ __forceinline__ unsigned pk2(float lo, float hi) { f32x2k_t v = {lo, hi}; bf16x2k_t b = __builtin_convertvector(v, bf16x2k_t); return __builtin_bit_cast(unsigned, b); }
__device__ __forceinline__ float bflo(unsigned w) { return __uint_as_float(w << 16); }
__device__ __forceinline__ float bfhi(unsigned w) { return __uint_as_float(w & 0xffff0000u); }
__device__ __forceinline__ unsigned ordk(float f) { const unsigned b = __float_as_uint(f); return b ^ ((unsigned)((int)b >> 31) | 0x80000000u); }
__device__ __forceinline__ float unordk(unsigned k) { return __uint_as_float((k & 0x80000000u) ? (k ^ 0x80000000u) : ~k); }
__device__ __forceinline__ float relu_i(float x) { const int i = __float_as_int(x); return __int_as_float(i > 0 ? i : 0); }
__device__ __forceinline__ int crow(int r, int hi) { return (r & 3) + 8 * (r >> 2) + 4 * hi; }
typedef __bf16 bf16x2v_t __attribute__((ext_vector_type(2)));
__device__ __forceinline__ float dot2bf(unsigned a, unsigned b, float acc) { return __builtin_amdgcn_fdot2_f32_bf16(__builtin_bit_cast(bf16x2v_t, a), __builtin_bit_cast(bf16x2v_t, b), acc, false); }

#define XB_TMO      128
#define XB_XCNT(j)  (256  + 64 * (j))
#define XB_XSUB(j)  (1280 + 64 * (j))
#define XB_XGEN(j)  (2304 + 64 * (j))
#define XB_TOP      3328
#define XB_TOPGEN   3392
#define XCD_BAR_WORDS 3456
#define XB_SPIN_CAP (1u << 18)

__device__ __forceinline__ unsigned xb_ld(unsigned* p)              { return __hip_atomic_load(p, __ATOMIC_RELAXED, __HIP_MEMORY_SCOPE_AGENT); }
__device__ __forceinline__ unsigned xb_add(unsigned* p, unsigned v) { return __hip_atomic_fetch_add(p, v, __ATOMIC_RELAXED, __HIP_MEMORY_SCOPE_AGENT); }
__device__ __forceinline__ unsigned xb_xcc_id() { return (unsigned)__builtin_amdgcn_s_getreg((3 << 11) | 20) & 0xFu; }
#define XB_SPIN(cond, bar) do { unsigned _sp = 0; while (cond) { __builtin_amdgcn_s_sleep(1); \
    if ((++_sp & 255u) == 0u) { if (xb_ld(&(bar)[XB_TMO])) break; if (_sp > XB_SPIN_CAP) { atomicAdd(&(bar)[XB_TMO], 1u); break; } } } } while (0)

struct XcdBarrier {
    unsigned* bar; unsigned x;
    volatile LAS unsigned* st;
};

__device__ __forceinline__ XcdBarrier xcd_barrier_post(unsigned* bar, volatile LAS unsigned* st) {
    XcdBarrier b; b.bar = bar; b.x = xb_xcc_id(); b.st = st;
    if (threadIdx.x == 0) (void)xb_add(&bar[XB_XCNT(b.x)], 1u);
    return b;
}
__device__ __forceinline__ void xcd_barrier_complete(unsigned* bar, unsigned x, unsigned& nloc, unsigned& nx) {
    const unsigned G = gridDim.x * gridDim.y * gridDim.z;
    unsigned sum, cnt, mine, sp = 0u;
    for (;;) {
        sum = 0u; cnt = 0u; mine = 0u;
#pragma unroll
        for (unsigned j = 0; j < 16; ++j) { const unsigned c = xb_ld(&bar[XB_XCNT(j)]); sum += c; cnt += (c > 0u) ? 1u : 0u; mine = (j == x) ? c : mine; }
        if (sum == G) break;
        __builtin_amdgcn_s_sleep(1);
        if ((++sp & 255u) == 0u) { if (xb_ld(&bar[XB_TMO])) break; if (sp > XB_SPIN_CAP) { atomicAdd(&bar[XB_TMO], 1u); break; } }
    }
    nloc = mine > 0u ? mine : 1u; nx = cnt > 0u ? cnt : 1u;
}

__device__ __forceinline__ void xcd_barrier(const XcdBarrier& b) {
    asm volatile("s_waitcnt vmcnt(0)" ::: "memory");
    __syncthreads();
    if (threadIdx.x == 0) {
        unsigned* bar = b.bar;
        __builtin_amdgcn_s_waitcnt(0);
        unsigned nloc = b.st[0], nx = b.st[1];
        if (nloc == 0u) { xcd_barrier_complete(bar, b.x, nloc, nx); b.st[0] = nloc; b.st[1] = nx; }
        const unsigned old = xb_add(&bar[XB_XSUB(b.x)], 1u);
        const unsigned gen = old / nloc;
        if (old + 1u == (gen + 1u) * nloc) {
            __builtin_amdgcn_fence(__ATOMIC_RELEASE, "agent");
            asm volatile("s_waitcnt vmcnt(0)" ::: "memory");
            const unsigned og = xb_add(&bar[XB_TOP], 1u);
            const unsigned tg = og / nx;
            if (og + 1u == (tg + 1u) * nx) xb_add(&bar[XB_TOPGEN], 1u);
            else XB_SPIN(xb_ld(&bar[XB_TOPGEN]) == tg, bar);
            __builtin_amdgcn_fence(__ATOMIC_ACQUIRE, "agent");
            xb_add(&bar[XB_XGEN(b.x)], 1u);
            asm volatile("s_waitcnt vmcnt(0)" ::: "memory");
        } else {
            XB_SPIN(xb_ld(&bar[XB_XGEN(b.x)]) == gen, bar);
            __builtin_amdgcn_fence(__ATOMIC_ACQUIRE, "agent");
            asm volatile("s_waitcnt vmcnt(0)" ::: "memory");
        }
    }
    __syncthreads();
}


struct Frame {
    LAS unsigned char* lds;
    volatile LAS unsigned* MISC;
    gu32* ctl;
    unsigned char* ws;
    int tid, lane, wave, vcu, G;
};
struct Args { const float* in[15]; float* out; unsigned char* ws; int ph_lo, ph_hi; };

__device__ __forceinline__ float wave_sum(float v) {
#pragma unroll
    for (int o = 1; o < 64; o <<= 1) v += __shfl_xor(v, o);
    return v;
}

template <class ColMap>
__device__ __forceinline__ void p0_transpose_item(const float* W, int K, int N, bf16* WT, int nblk, LAS float* scr, int item, int lane, ColMap cm) {
    const int kb = item / nblk, nb = item % nblk, k0 = 64 * kb, n0 = 32 * nb;
    const int src = cm(n0 + (lane & 31));
#pragma unroll 8
    for (int i = 0; i < 32; ++i) { const int kk = 2 * i + (lane >> 5); scr[kk * 33 + (lane & 31)] = (src >= 0) ? W[(size_t)(k0 + kk) * N + src] : 0.f; }
    LDS_WAIT(); asm volatile("" ::: "memory");
    const int c = lane & 7;
#pragma unroll
    for (int j = 0; j < 4; ++j) { const int n = (lane >> 3) + 8 * j; const LAS float* s = scr + (8 * c) * 33 + n;
        v4u o; o.x = pk2(s[0 * 33], s[1 * 33]); o.y = pk2(s[2 * 33], s[3 * 33]); o.z = pk2(s[4 * 33], s[5 * 33]); o.w = pk2(s[6 * 33], s[7 * 33]);
        *(GAS v4u*)(WT + (size_t)(n0 + n) * K + k0 + 8 * c) = o; }
    LDS_WAIT(); asm volatile("" ::: "memory");
}
struct MapIdent { __device__ __forceinline__ int operator()(int n) const { return n; } };
struct MapWin { __device__ __forceinline__ int operator()(int n) const {
    if (n < 2048) return n;
    if (n < 2560) return 2120 + (n - 2048);
    if (n < 4608) return 2632 + (n - 2560);
    if (n < 4672) return 2048 + (n - 4608);
    if (n < 4680) return 2112 + (n - 4672);
    return -1; } };

template <int NR> __device__ __forceinline__ void rms_rows_to_bf16(const float* x, const float* g, bf16* o, int m0, int stride, int lane) {
    f32x4 v[NR][4]; float s[NR];
#pragma unroll
    for (int r = 0; r < NR; ++r) { const GAS f32x4* xr = (const GAS f32x4*)(x + (size_t)(m0 + r * stride) * DM) + lane;
#pragma unroll
        for (int j = 0; j < 4; ++j) v[r][j] = xr[64 * j]; }
#pragma unroll
    for (int r = 0; r < NR; ++r) { float a = 0.f;
#pragma unroll
        for (int j = 0; j < 4; ++j) a += (v[r][j].x * v[r][j].x + v[r][j].y * v[r][j].y) + (v[r][j].z * v[r][j].z + v[r][j].w * v[r][j].w);
        s[r] = a; }
#pragma unroll
    for (int o2 = 1; o2 < 64; o2 <<= 1) {
#pragma unroll
        for (int r = 0; r < NR; ++r) s[r] += __shfl_xor(s[r], o2);
    }
    const GAS f32x4* gr = (const GAS f32x4*)g + lane;
    f32x4 gg[4];
#pragma unroll
    for (int j = 0; j < 4; ++j) gg[j] = gr[64 * j];
#pragma unroll
    for (int r = 0; r < NR; ++r) { const float rs = 1.0f / sqrtf(s[r] * (1.f / 1024.f) + EPS);
        GAS unsigned long long* o8 = (GAS unsigned long long*)(o + (size_t)(m0 + r * stride) * DM) + lane;
#pragma unroll
        for (int j = 0; j < 4; ++j) o8[64 * j] = (unsigned long long)pk2(v[r][j].x * rs * gg[j].x, v[r][j].y * rs * gg[j].y) | ((unsigned long long)pk2(v[r][j].z * rs * gg[j].z, v[r][j].w * rs * gg[j].w) << 32); }
}

__device__ __forceinline__ void p0_prologue(Frame& F, const Args& AR) {
    LAS float* scr = (LAS float*)(F.lds + F.wave * 16384);
    const int gw = F.vcu * NWAVES + F.wave, NGW = F.G * NWAVES, lane = F.lane;
    constexpr int I_WIN = 16 * 152, I_WA = 8 * 32, I_WO = 16 * 32;
    for (int it = gw; it < I_WIN + I_WA + I_WO; it += NGW) {
        int r = it;
        if (r < I_WIN) { p0_transpose_item((AR.in[2]), 1024, IN_WIDTH, ((bf16*)(F.ws + WS_WIN)), 152, scr, r, lane, MapWin()); continue; } r -= I_WIN;
        if (r < I_WA) { p0_transpose_item((AR.in[7]), 512, 1024, ((bf16*)(F.ws + WS_WA)), 32, scr, r, lane, MapIdent()); continue; } r -= I_WA;
        p0_transpose_item((AR.in[9]), 1024, 1024, ((bf16*)(F.ws + WS_WO)), 32, scr, r, lane, MapIdent());
    }
    for (int it = gw; it < 16 * 64; it += NGW) {
        const int nb = it & 15, kb = it >> 4, n = nb * 64 + lane, k0 = kb * 8, g = k0 >> 7, c0 = k0 & 127;
        float acc[8];
#pragma unroll
        for (int j = 0; j < 8; ++j) acc[j] = 0.f;
        for (int d = 0; d < 128; ++d) {
            const float wv = (AR.in[8])[(size_t)(g * 128 + d) * 1024 + n] * (AR.in[6])[g * 128 + d];
#pragma unroll
            for (int j = 0; j < 8; ++j) acc[j] += (AR.in[5])[(size_t)(g * 128 + c0 + j) * 128 + d] * wv;
        }
        v4u o; o.x = pk2(acc[0], acc[1]); o.y = pk2(acc[2], acc[3]); o.z = pk2(acc[4], acc[5]); o.w = pk2(acc[6], acc[7]);
        *(GAS v4u*)(((bf16*)(F.ws + WS_WPP)) + (size_t)n * 512 + k0) = o;
    }
    for (int it = gw; it < 16 * 32; it += NGW) p0_transpose_item((AR.in[11]), 1024, 1024, ((bf16*)(F.ws + WS_W2)), 32, scr, it, lane, MapIdent());
    for (int it = gw; it < 256; it += NGW) { const size_t e0 = (size_t)it * 512 + lane * 8;
        const f32x4 a = *(const GAS f32x4*)((AR.in[12]) + e0), b = *(const GAS f32x4*)((AR.in[12]) + e0 + 4);
        v4u o; o.x = pk2(a.x, a.y); o.y = pk2(a.z, a.w); o.z = pk2(b.x, b.y); o.w = pk2(b.z, b.w);
        *(GAS v4u*)(((bf16*)(F.ws + WS_SKB)) + e0) = o; }
    {   float mu = 0.f, mv = 0.f;
#pragma unroll 4
        for (int it = gw; it < 2 * 32768; it += NGW) {
            const float* src = (it < 32768) ? (AR.in[13]) : (AR.in[14]); const size_t e0 = (size_t)(it & 32767) * 512 + lane * 8;
            const f32x4 a = *(const GAS f32x4*)(src + e0), b = *(const GAS f32x4*)(src + e0 + 4);
            const float m = fmaxf(fmaxf(fmaxf(fabsf(a.x), fabsf(a.y)), fmaxf(fabsf(a.z), fabsf(a.w))), fmaxf(fmaxf(fabsf(b.x), fabsf(b.y)), fmaxf(fabsf(b.z), fabsf(b.w))));
            if (it < 32768) mu = fmaxf(mu, m); else mv = fmaxf(mv, m);
        }
#pragma unroll
        for (int o = 1; o < 64; o <<= 1) { mu = fmaxf(mu, __shfl_xor(mu, o)); mv = fmaxf(mv, __shfl_xor(mv, o)); }
        if (lane == 0) { __hip_atomic_fetch_max(F.ctl + CW_AMAX, __float_as_uint(mu), RLX_AGENT); __hip_atomic_fetch_max(F.ctl + CW_AMAX + 1, __float_as_uint(mv), RLX_AGENT); }
    }
    for (int it = gw * 64 + lane; it < 4096 * 8; it += NGW * 64) {
        const int pos = it >> 3, i = it & 7;
        const float invf = exp2f(-(float)i * 0.125f * 18.931568569324174f);
        const double ang = (double)((float)pos * invf);
        const double kq = __builtin_rint(ang * 0.6366197723675814);
        const float r = (float)(ang - kq * 1.5707963267948966);
        const int q = (int)((long long)kq & 3);
        const float r2 = r * r;
        const float sn = r + r * r2 * (-1.6666654611e-1f + r2 * (8.3321608736e-3f + r2 * (-1.9515295891e-4f)));
        const float cs = 1.0f - 0.5f * r2 + r2 * r2 * (4.166664568298827e-2f + r2 * (-1.388731625493765e-3f + r2 * 2.443315711809948e-5f));
        const float s = (q == 0) ? sn : (q == 1) ? cs : (q == 2) ? -sn : -cs;
        const float c = (q == 0) ? cs : (q == 1) ? -sn : (q == 2) ? -cs : sn;
        ((float*)(F.ws + WS_ROPE))[pos * 16 + i] = c; ((float*)(F.ws + WS_ROPE))[pos * 16 + 8 + i] = s;
    }
    { int m = gw;
      for (; m + 3 * NGW < MTOK; m += 4 * NGW) rms_rows_to_bf16<4>((AR.in[0]), (AR.in[1]), ((bf16*)(F.ws + WS_ACT)), m, NGW, lane);
      for (; m < MTOK; m += NGW) rms_rows_to_bf16<1>((AR.in[0]), (AR.in[1]), ((bf16*)(F.ws + WS_ACT)), m, NGW, lane); }
}

__device__ __forceinline__ void unpack8(const v4u w, float (&v)[8]) { v[0] = bflo(w.x); v[1] = bfhi(w.x); v[2] = bflo(w.y); v[3] = bfhi(w.y); v[4] = bflo(w.z); v[5] = bfhi(w.z); v[6] = bflo(w.w); v[7] = bfhi(w.w); }
__device__ __forceinline__ v4u pack8(const float (&v)[8]) { v4u o; o.x = pk2(v[0], v[1]); o.y = pk2(v[2], v[3]); o.z = pk2(v[4], v[5]); o.w = pk2(v[6], v[7]); return o; }
__device__ __forceinline__ void rope8(float (&v)[8], int sub, const float (&cs)[8], const float (&sn)[8]) {
    float pv[8];
#pragma unroll
    for (int j = 0; j < 8; ++j) pv[j] = __shfl_xor(v[j], 1);
    if (sub == 0) {
#pragma unroll
        for (int j = 0; j < 8; ++j) v[j] = v[j] * cs[j] - pv[j] * sn[j];
    } else if (sub == 1) {
#pragma unroll
        for (int j = 0; j < 8; ++j) v[j] = v[j] * cs[j] + pv[j] * sn[j];
    }
}
__device__ __forceinline__ float fp8_scale(unsigned amax_bits) { const unsigned be = (amax_bits >> 23) & 0xffu; return (be == 0u || be > 250u) ? 1.0f : __uint_as_float((261u - be) << 23); }
__device__ __forceinline__ float fp8_inv_scale(unsigned amax_bits) { const unsigned be = (amax_bits >> 23) & 0xffu; return (be == 0u || be > 250u) ? 1.0f : __uint_as_float((be - 7u) << 23); }
__device__ __forceinline__ void row_to_fp8(const float* src, unsigned char* dst, float sc, int lane) {
    const GAS f32x4* p = (const GAS f32x4*)src + lane * 4; v4u o;
#pragma unroll
    for (int q = 0; q < 4; ++q) { const f32x4 a = p[q]; int w = 0; w = __builtin_amdgcn_cvt_pk_fp8_f32(a.x * sc, a.y * sc, w, false); w = __builtin_amdgcn_cvt_pk_fp8_f32(a.z * sc, a.w * sc, w, true); o[q] = (unsigned)w; }
    *(GAS v4u*)(dst + ((size_t)(lane >> 3) << 21) + (lane & 7) * 16) = o;
}
__device__ __forceinline__ void row_to_i8(const float* src, unsigned char* dst, float sc, int lane) {
    const GAS f32x4* p = (const GAS f32x4*)src + lane * 4; v4u o;
#pragma unroll
    for (int q = 0; q < 4; ++q) { const f32x4 a = p[q];
        const unsigned b0 = __float_as_uint(a.x * sc + 12582912.0f), b1 = __float_as_uint(a.y * sc + 12582912.0f), b2 = __float_as_uint(a.z * sc + 12582912.0f), b3 = __float_as_uint(a.w * sc + 12582912.0f);
        o[q] = __builtin_amdgcn_perm(b1, b0, 0x0c0c0400u) | __builtin_amdgcn_perm(b3, b2, 0x04000c0cu); }
    *(GAS v4u*)(dst + ((size_t)(lane >> 3) << 21) + (lane & 7) * 16) = o;
}
__device__ __forceinline__ float i8_scale(unsigned amax_bits) { const float a = __uint_as_float(amax_bits); return (a > 1e-30f && a < 1e30f) ? 127.0f / a : 1.0f; }
__device__ __forceinline__ float i8_inv_scale(unsigned amax_bits) { const float a = __uint_as_float(amax_bits); return (a > 1e-30f && a < 1e30f) ? a * (1.0f / 127.0f) : 1.0f; }
__device__ __forceinline__ void fixup_token(Frame& F, const Args& AR, int tok) {
    const int lane = F.lane, sub = lane & 7, pos = tok & (SEQ - 1);
    bf16* row = ((bf16*)(F.ws + WS_PROJ)) + (size_t)tok * LDP;
    float cs[8], sn[8];
    { const GAS f32x4* rt = (const GAS f32x4*)(((float*)(F.ws + WS_ROPE)) + pos * 16); const f32x4 a = rt[0], b = rt[1], c = rt[2], d = rt[3];
      cs[0] = a.x; cs[1] = a.y; cs[2] = a.z; cs[3] = a.w; cs[4] = b.x; cs[5] = b.y; cs[6] = b.z; cs[7] = b.w;
      sn[0] = c.x; sn[1] = c.y; sn[2] = c.z; sn[3] = c.w; sn[4] = d.x; sn[5] = d.y; sn[6] = d.z; sn[7] = d.w; }
#pragma unroll
    for (int which = 0; which < 2; ++which) {
        GAS v4u* p = (GAS v4u*)(row + (which ? K_OFF : Q_OFF) + lane * 8);
        float v[8]; unpack8(*p, v);
        float ss = 0.f;
#pragma unroll
        for (int j = 0; j < 8; ++j) ss += v[j] * v[j];
        ss += __shfl_xor(ss, 1); ss += __shfl_xor(ss, 2); ss += __shfl_xor(ss, 4);
        const float rs = 1.0f / sqrtf(ss * (1.f / 64.f) + EPS);
        const float* g = (which ? (AR.in[4]) : (AR.in[3])) + sub * 8;
#pragma unroll
        for (int j = 0; j < 8; ++j) v[j] = v[j] * rs * g[j];
        rope8(v, sub, cs, sn);
        if (which == 0) {
#pragma unroll
            for (int j = 0; j < 8; ++j) v[j] *= C2;
        }
        *p = pack8(v);
    }
    { GAS v4u* p = (GAS v4u*)(row + QI_OFF + lane * 8); float v[8]; unpack8(*p, v); rope8(v, sub, cs, sn); *p = pack8(v); }
    { GAS v4u* p = (GAS v4u*)(row + KI_OFF + (lane & 7) * 8); float v[8]; unpack8(*p, v); rope8(v, sub, cs, sn); if (lane < 8) *p = pack8(v); }
}
__device__ __forceinline__ void pool_run(Frame& F, int tok0, int ntok) {
    const int lane = F.lane, g = lane >> 4, w = 2 << g;
    const bf16* pcol = ((const bf16*)(F.ws + WS_PROJ)) + P_OFF + lane * 8;
    float S[8];
#pragma unroll
    for (int j = 0; j < 8; ++j) S[j] = 0.f;
    { const int pos0 = tok0 & (SEQ - 1);
#pragma unroll
      for (int back = 1; back < 16; ++back) {
          if (back < w && back <= pos0) { float t[8]; unpack8(*(const GAS v4u*)(pcol + (size_t)(tok0 - back) * LDP), t);
#pragma unroll
              for (int j = 0; j < 8; ++j) S[j] += t[j]; }
      } }
#pragma unroll 1
    for (int i = 0; i < ntok; ++i) {
        const int tok = tok0 + i, pos = tok & (SEQ - 1);
        float cur[8]; unpack8(*(const GAS v4u*)(pcol + (size_t)tok * LDP), cur);
#pragma unroll
        for (int j = 0; j < 8; ++j) S[j] += cur[j];
        const float inv = 1.0f / (float)((pos + 1 < w) ? (pos + 1) : w);
        float o[8];
#pragma unroll
        for (int j = 0; j < 8; ++j) o[j] = S[j] * inv - cur[j];
        *(GAS v4u*)(((bf16*)(F.ws + WS_POOLED)) + (size_t)tok * 512 + lane * 8) = pack8(o);
        if (pos + 1 >= w) { float t[8]; unpack8(*(const GAS v4u*)(pcol + (size_t)(tok + 1 - w) * LDP), t);
#pragma unroll
            for (int j = 0; j < 8; ++j) S[j] -= t[j]; }
    }
}

__device__ __forceinline__ int wave_incl_scan(int v) {
    v += __builtin_amdgcn_update_dpp(0, v, 0x111, 0xf, 0xf, false);
    v += __builtin_amdgcn_update_dpp(0, v, 0x112, 0xf, 0xf, false);
    v += __builtin_amdgcn_update_dpp(0, v, 0x114, 0xf, 0xf, false);
    v += __builtin_amdgcn_update_dpp(0, v, 0x118, 0xf, 0xf, false);
    v += __builtin_amdgcn_update_dpp(0, v, 0x142, 0xa, 0xf, false);
    v += __builtin_amdgcn_update_dpp(0, v, 0x143, 0xc, 0xf, false);
    return v;
}
template <int NB> __device__ __forceinline__ void hist_search(const LAS unsigned* hist, int need, int lane, int& B, int& G, int& E) {
    constexpr int PER = NB / 64;
    int t = 0;
#pragma unroll
    for (int q = 0; q < PER / 4; ++q) { const v4u h = *(const LAS v4u*)(hist + lane * PER + 4 * q); t += (int)(h.x + h.y + h.z + h.w); }
    const int pfx = wave_incl_scan(t);
    const int L = __ffsll((long long)__ballot(pfx >= need)) - 1;
    const int base = __builtin_amdgcn_readlane(pfx, L) - __builtin_amdgcn_readlane(t, L);
    const int hv = (lane < PER) ? (int)hist[L * PER + lane] : 0;
    const int p2 = wave_incl_scan(hv) + base;
    const int i = __ffsll((long long)__ballot(p2 >= need)) - 1;
    B = L * PER + i; E = __builtin_amdgcn_readlane(hv, i); G = __builtin_amdgcn_readlane(p2, i) - E;
}
template <int NB> __device__ __forceinline__ void hist_zero(LAS unsigned* hist, int lane) {
#pragma unroll
    for (int q = 0; q < NB / 256; ++q) *(LAS v4u*)(hist + q * 256 + lane * 4) = (v4u){0u, 0u, 0u, 0u};
}
#define HIST_ADD(p) (void)__hip_atomic_fetch_add((p), 1u, __ATOMIC_RELAXED, __HIP_MEMORY_SCOPE_WORKGROUP)
#define wlane(dst, sval, j) asm volatile("s_nop 3\n\tv_writelane_b32 %0, %1, %2\n\ts_nop 1" : "+v"(dst) : "s"(sval), "i"(j))
__device__ __forceinline__ void load_pair(const unsigned short* srow  , int nj, int lane, unsigned (&raw)[64]) {
    asm volatile("" : "+v"(lane));
#pragma unroll
    for (int g = 0; g < 8; ++g) {
        if (nj > 8 * g) {
#pragma unroll
            for (int jj = 0; jj < 8; ++jj) raw[8 * g + jj] = *(const GAS unsigned*)(srow + (size_t)(64 * (8 * g + jj) + lane) * 8);
        } else {
#pragma unroll
            for (int jj = 0; jj < 8; ++jj) raw[8 * g + jj] = 0xff80ff80u;
        }
    }
}
template <int HALF_> __device__ __forceinline__ void select_row(const unsigned (&raw)[64]  , LAS unsigned* hist, int nj, int lastw, GAS unsigned long long* mout, int lane, unsigned long long& tacc, unsigned& tcnt) {
    const unsigned long long ts0_ = (PROBE_SEC >= 30 && PROBE_SEC <= 33) ? __builtin_amdgcn_s_memtime() : 0ull;
    unsigned key[64];
#pragma unroll
    for (int g = 0; g < 8; ++g) {
        if (nj > 8 * g) {
#pragma unroll
            for (int jj = 0; jj < 8; ++jj) key[8 * g + jj] = ordk(__uint_as_float(HALF_ ? (raw[8 * g + jj] & 0xffff0000u) : (raw[8 * g + jj] << 16)) + 0.0f);
        } else {
#pragma unroll
            for (int jj = 0; jj < 8; ++jj) key[8 * g + jj] = 0u;
        }
    }
    LDS_WAIT(); asm volatile("" ::: "memory");
    if (PROBE_SEC >= 30 && PROBE_SEC <= 33) asm volatile("s_waitcnt vmcnt(0)" ::: "memory");
    const unsigned long long ts1_ = (PROBE_SEC >= 30 && PROBE_SEC <= 33) ? __builtin_amdgcn_s_memtime() : 0ull;
    int need = 256, B, G, E;
    hist_zero<2048>(hist, lane); LDS_WAIT(); asm volatile("" ::: "memory");
#pragma unroll
    for (int g = 0; g < 8; ++g) if (nj > 8 * g) {
#pragma unroll
        for (int jj = 0; jj < 8; ++jj) HIST_ADD(hist + (2047u - (key[8 * g + jj] >> 21)));
    }
    LDS_WAIT(); asm volatile("" ::: "memory");
    hist_search<2048>(hist, need, lane, B, G, E); need -= G;
    const unsigned long long ts2_ = (PROBE_SEC >= 30 && PROBE_SEC <= 33) ? __builtin_amdgcn_s_memtime() : 0ull;
    const unsigned d1 = 2047u - (unsigned)B;
    asm volatile("" ::: "memory"); hist_zero<2048>(hist, lane); LDS_WAIT(); asm volatile("" ::: "memory");
#pragma unroll
    for (int g = 0; g < 8; ++g) if (nj > 8 * g) {
#pragma unroll
        for (int jj = 0; jj < 8; ++jj) { const unsigned k = key[8 * g + jj]; if ((k >> 21) == d1) HIST_ADD(hist + (2047u - ((k >> 10) & 0x7ffu))); }
    }
    LDS_WAIT(); asm volatile("" ::: "memory");
    hist_search<2048>(hist, need, lane, B, G, E); need -= G;
    const unsigned pre2 = (d1 << 11) | (2047u - (unsigned)B);
    const unsigned v = pre2 << 10;
    const unsigned long long ts3_ = (PROBE_SEC >= 30 && PROBE_SEC <= 33) ? __builtin_amdgcn_s_memtime() : 0ull;
    unsigned mlo = 0u, mhi = 0u;
#pragma unroll
    for (int g = 0; g < 8; ++g) {
        asm volatile("v_cmp_ge_u32_e64 s[40:41], %2, %10\n\tv_cmp_ge_u32_e64 s[42:43], %3, %10\n\tv_cmp_ge_u32_e64 s[44:45], %4, %10\n\tv_cmp_ge_u32_e64 s[46:47], %5, %10\n\t"
                     "v_cmp_ge_u32_e64 s[48:49], %6, %10\n\tv_cmp_ge_u32_e64 s[50:51], %7, %10\n\tv_cmp_ge_u32_e64 s[52:53], %8, %10\n\tv_cmp_ge_u32_e64 s[54:55], %9, %10\n\ts_nop 1\n\t"
                     "v_writelane_b32 %0, s40, %11\n\tv_writelane_b32 %1, s41, %11\n\tv_writelane_b32 %0, s42, %12\n\tv_writelane_b32 %1, s43, %12\n\t"
                     "v_writelane_b32 %0, s44, %13\n\tv_writelane_b32 %1, s45, %13\n\tv_writelane_b32 %0, s46, %14\n\tv_writelane_b32 %1, s47, %14\n\t"
                     "v_writelane_b32 %0, s48, %15\n\tv_writelane_b32 %1, s49, %15\n\tv_writelane_b32 %0, s50, %16\n\tv_writelane_b32 %1, s51, %16\n\t"
                     "v_writelane_b32 %0, s52, %17\n\tv_writelane_b32 %1, s53, %17\n\tv_writelane_b32 %0, s54, %18\n\tv_writelane_b32 %1, s55, %18\n\ts_nop 1"
                     : "+v"(mlo), "+v"(mhi)
                     : "v"(key[8 * g]), "v"(key[8 * g + 1]), "v"(key[8 * g + 2]), "v"(key[8 * g + 3]), "v"(key[8 * g + 4]), "v"(key[8 * g + 5]), "v"(key[8 * g + 6]), "v"(key[8 * g + 7]), "v"(v),
                       "i"(8 * g), "i"(8 * g + 1), "i"(8 * g + 2), "i"(8 * g + 3), "i"(8 * g + 4), "i"(8 * g + 5), "i"(8 * g + 6), "i"(8 * g + 7)
                     : "s40", "s41", "s42", "s43", "s44", "s45", "s46", "s47", "s48", "s49", "s50", "s51", "s52", "s53", "s54", "s55");
    }
    int drop = E - need;
#pragma unroll
    for (int j = 63; j >= 0; --j) {
        if (drop > 0) {
            unsigned long long eq = __ballot(key[j] == v);
            if (eq != 0ull) {
                unsigned long long rem = 0ull;
                while (drop > 0 && eq != 0ull) { const unsigned long long hb = 1ull << (63 - __clzll((long long)eq)); rem |= hb; eq ^= hb; --drop; }
                const unsigned long long m = __ballot(key[j] >= v) & ~rem;
                wlane(mlo, (unsigned)m, j); wlane(mhi, (unsigned)(m >> 32), j);
            }
        }
    }
    if (lane <= lastw) mout[lane] = ((unsigned long long)mhi << 32) | (unsigned long long)mlo;
    LDS_WAIT(); asm volatile("" ::: "memory");
    if (PROBE_SEC >= 30 && PROBE_SEC <= 33) { const unsigned long long ts4_ = __builtin_amdgcn_s_memtime(); tacc += (PROBE_SEC == 30) ? (ts1_ - ts0_) : (PROBE_SEC == 31) ? (ts2_ - ts1_) : (PROBE_SEC == 32) ? (ts3_ - ts2_) : (ts4_ - ts3_); ++tcnt; }
}

__device__ __forceinline__ float* wave_scratch(unsigned char* ws, int gwv) {
    if (gwv < 1024) return (float*)(ws + WS_ACT) + (size_t)gwv * 32768;
    gwv -= 1024; if (gwv < 512) return (float*)(ws + WS_AO) + (size_t)gwv * 32768;
    gwv -= 512; if (gwv < 352) return (float*)(ws + 980 * MiB) + (size_t)gwv * 32768;
    gwv -= 352; if (gwv < 128) return (float*)(ws + 36 * MiB) + (size_t)gwv * 32768;
    gwv -= 128; return (float*)(ws + 68 * MiB) + (size_t)(gwv & 127) * 32768;
}
__device__ __forceinline__ void idx_unit(Frame& F, const Args& AR, int b, int c, unsigned long long& tacc, unsigned& tcnt, bool do_select = true) {
    const unsigned long long ti0_ = (PROBE_SEC >= 20 && PROBE_SEC <= 22) ? __builtin_amdgcn_s_memtime() : 0ull;
    const int lane = F.lane, wid = F.wave, l31 = lane & 31, h2 = lane >> 5;
    const size_t rowb = (size_t)b * SEQ, tp0 = rowb + (size_t)c * 64 + wid * 8;
    GAS unsigned long long* mbase = (GAS unsigned long long*)(((unsigned long long*)(F.ws + WS_MASK)) + tp0 * 64);
    if (c < 4) {
        if (lane < 32) { const int q = lane >> 2, j = lane & 3; mbase[q * 64 + j] = (j <= c) ? ~0ull : 0ull; }
        return;
    }
    unsigned short* sc = (unsigned short*)wave_scratch(F.ws, F.vcu * NWAVES + wid);
    LAS unsigned* hist = (LAS unsigned*)(F.lds + wid * 8192);
    const int ntile = 2 * (c + 1), nj = c + 1, lastw = c | 3, ntile_pad = 16 * ((nj + 7) >> 3);
    const int head = (l31 & 3) | (((l31 >> 3) & 1) << 2), qsub = ((l31 >> 2) & 1) | (((l31 >> 4) & 1) << 1);
    bf16x8 a[2][4]; float w[2][16];
#pragma unroll
    for (int rb = 0; rb < 2; ++rb) {
        const bf16* ap = ((bf16*)(F.ws + WS_PROJ)) + (tp0 + 4 * rb + qsub) * LDP + QI_OFF + head * 64 + h2 * 8;
#pragma unroll
        for (int st = 0; st < 4; ++st) a[rb][st] = *(const GAS bf16x8*)(ap + st * 16);
        const v4u wa = *(const GAS v4u*)(((bf16*)(F.ws + WS_PROJ)) + (tp0 + 4 * rb + h2) * LDP + WI_OFF), wb = *(const GAS v4u*)(((bf16*)(F.ws + WS_PROJ)) + (tp0 + 4 * rb + h2 + 2) * LDP + WI_OFF);
        float t[8]; unpack8(wa, t);
#pragma unroll
        for (int j = 0; j < 8; ++j) w[rb][j] = t[j] * WI_SCALE;
        unpack8(wb, t);
#pragma unroll
        for (int j = 0; j < 8; ++j) w[rb][8 + j] = t[j] * WI_SCALE;
    }
    const unsigned long long ti1_ = (PROBE_SEC >= 20 && PROBE_SEC <= 22) ? __builtin_amdgcn_s_memtime() : 0ull;
    {
        LAS unsigned char* kb = F.lds + 65536;
        const int nstage = (ntile + 3) >> 2;
        const int sk0 = F.tid >> 3, sch = F.tid & 7;
        const bf16* kg = ((bf16*)(F.ws + WS_PROJ)) + (rowb + sk0) * LDP + KI_OFF + sch * 8;
        v4u r0 = *(const GAS v4u*)kg, r1 = *(const GAS v4u*)(kg + (size_t)64 * LDP);
#pragma unroll 1
        for (int sg = 0; sg < nstage; ++sg) {
            LAS unsigned char* cur = kb + (sg & 1) * 18432;
            *(LAS v4u*)(cur + sk0 * 144 + sch * 16) = r0; *(LAS v4u*)(cur + (sk0 + 64) * 144 + sch * 16) = r1;
            BAR_LDS();
            { const int sn = (sg + 1 < nstage) ? sg + 1 : sg; r0 = *(const GAS v4u*)(kg + (size_t)sn * 128 * LDP); r1 = *(const GAS v4u*)(kg + (size_t)(sn * 128 + 64) * LDP); }
#pragma unroll
            for (int t4 = 0; t4 < 4; ++t4) {
                const int kt = 4 * sg + t4;
                if (kt < ntile) {
                    bf16x8 bfr[4];
#pragma unroll
                    for (int st = 0; st < 4; ++st) bfr[st] = *(const LAS bf16x8*)(cur + (t4 * 32 + l31) * 144 + st * 32 + h2 * 16);
                    float sq[4];
#pragma unroll
                    for (int rb = 0; rb < 2; ++rb) {
                        f32x16 acc;
#pragma unroll
                        for (int r = 0; r < 16; ++r) acc[r] = 0.f;
#pragma unroll
                        for (int st = 0; st < 4; ++st) acc = __builtin_amdgcn_mfma_f32_32x32x16_bf16(a[rb][st], bfr[st], acc, 0, 0, 0);
                        float s0 = 0.f, s1 = 0.f;
#pragma unroll
                        for (int r = 0; r < 8; ++r) { s0 = fmaf(w[rb][r], relu_i(acc[r]), s0); s1 = fmaf(w[rb][8 + r], relu_i(acc[8 + r]), s1); }
                        sq[2 * rb] = s0; sq[2 * rb + 1] = s1;
                    }
                    *(GAS v2u*)(sc + (size_t)(kt * 32 + l31) * 8 + 4 * h2) = (v2u){pk2(sq[0], sq[1]), pk2(sq[2], sq[3])};
                }
            }
        }
        for (int kt = ntile; kt < ntile_pad; ++kt)
            *(GAS v2u*)(sc + (size_t)(kt * 32 + l31) * 8 + 4 * h2) = (v2u){0xff80ff80u, 0xff80ff80u};
    }
    const unsigned long long ti2_ = (PROBE_SEC >= 20 && PROBE_SEC <= 22) ? __builtin_amdgcn_s_memtime() : 0ull;
    VM_WAIT();
    if (do_select) {
#pragma unroll 1
        for (int pr = 0; pr < 4 * PROBE_SEL2; ++pr) {
            const int p = pr & 3, q0 = (p & 1) * 4 + (p >> 1), slot = 4 * (q0 & 1) + (q0 >> 1);
            unsigned raw[64];
            load_pair(sc + slot, nj, lane, raw);
            select_row<0>(raw, hist, nj, lastw, mbase + q0 * 64, lane, tacc, tcnt);
            select_row<1>(raw, hist, nj, lastw, mbase + (q0 + 2) * 64, lane, tacc, tcnt);
        }
    }
    if (PROBE_SEC >= 20 && PROBE_SEC <= 22) { const unsigned long long ti3_ = __builtin_amdgcn_s_memtime(); tacc += (PROBE_SEC == 20) ? (ti1_ - ti0_) : (PROBE_SEC == 21) ? (ti2_ - ti1_) : (ti3_ - ti2_); tcnt = 1000u; }
}

__device__ __forceinline__ void attn_unit(Frame& F, const Args& AR, int b, int h, int qb, unsigned long long& tacc, unsigned& tcnt) {
    const int lane = F.lane, wid = F.wave, l31 = lane & 31, h2 = lane >> 5;
    LAS unsigned char* Ks = F.lds;
    LAS float* wsf = (LAS float*)(F.lds + 2 * 17408) + wid * 32;
    const size_t rowb = (size_t)b * SEQ, tok0 = rowb + (size_t)qb * 256 + wid * 32;
    bf16x8 qf[4];
    { const bf16* qp = ((bf16*)(F.ws + WS_PROJ)) + (tok0 + l31) * LDP + Q_OFF + h * 64 + h2 * 8;
#pragma unroll
      for (int st = 0; st < 4; ++st) qf[st] = *(const GAS bf16x8*)(qp + st * 16); }
    const int NT = 4 * (qb + 1), cw = qb * 4 + (wid >> 1);
    f32x16 o0, o1;
#pragma unroll
    for (int r = 0; r < 16; ++r) { o0[r] = 0.f; o1[r] = 0.f; }
    float lsum = 0.f;
    const int skey = F.tid >> 3, sch = F.tid & 7;
    const bf16* kg = ((bf16*)(F.ws + WS_PROJ)) + (rowb + skey) * LDP + K_OFF + h * 64 + sch * 8;
    const bf16* vg = ((bf16*)(F.ws + WS_PROJ)) + (rowb + skey) * LDP + V_OFF + h * 64 + sch * 8;
    const unsigned kst = skey * 144 + sch * 16, vst = skey * 128 + ((sch * 16) ^ (((skey >> 1) & 1) << 6));
    const GAS unsigned long long* mrow = (const GAS unsigned long long*)(((unsigned long long*)(F.ws + WS_MASK)) + (tok0 + l31) * 64);
    const int i16 = lane & 15, qq = i16 >> 2, pp = i16 & 3, blk = (lane >> 4) & 1;
    const unsigned vrd = (unsigned)((4 * h2 + qq) * 128 + ((32 * blk + 8 * pp) ^ (((qq >> 1) & 1) << 6)));
    v4u kr[3], vr[3];
#pragma unroll
    for (int u = 0; u < 3; ++u) { kr[u] = *(const GAS v4u*)(kg + (size_t)u * 64 * LDP); vr[u] = *(const GAS v4u*)(vg + (size_t)u * 64 * LDP); }
    unsigned long long mwn = mrow[0];
#pragma unroll 1
    for (int t = 0; t < NT; t += 3) {
#pragma unroll
        for (int u = 0; u < 3; ++u) {
            const int tt = t + u;
            if (tt < NT) {
                LAS unsigned char* Kc = Ks + (tt & 1) * 17408; LAS unsigned char* Vc = Kc + 9216;
                const unsigned long long t_a = PROBE_SEC ? __builtin_amdgcn_s_memtime() : 0ull;
                *(LAS v4u*)(Kc + kst) = kr[u]; *(LAS v4u*)(Vc + vst) = vr[u];
                BAR_LDS();
                const unsigned long long t_b = PROBE_SEC ? __builtin_amdgcn_s_memtime() : 0ull;
                { const int tn = (tt + 3 < NT) ? tt + 3 : NT - 1;
                  kr[u] = *(const GAS v4u*)(kg + (size_t)tn * 64 * LDP); vr[u] = *(const GAS v4u*)(vg + (size_t)tn * 64 * LDP); }
                const unsigned long long mw = mwn;
                mwn = mrow[(tt + 1 < NT) ? tt + 1 : tt];
                if (tt <= cw) {
                    bf16x8 vfr[2][2][2];
        #pragma unroll
                    for (int kb = 0; kb < 2; ++kb)
        #pragma unroll
                        for (int s = 0; s < 2; ++s)
        #pragma unroll
                            for (int d0 = 0; d0 < 2; ++d0) {
                                const unsigned ad = (vrd + (unsigned)((32 * kb + 16 * s) * 128)) ^ (unsigned)(d0 << 6);
                                const s16x4 lo = __builtin_bit_cast(s16x4, __builtin_amdgcn_ds_read_tr16_b64_v4i16((LAS s16x4*)(Vc + ad)));
                                const s16x4 hi = __builtin_bit_cast(s16x4, __builtin_amdgcn_ds_read_tr16_b64_v4i16((LAS s16x4*)(Vc + ad + 8 * 128)));
                                vfr[kb][s][d0] = (bf16x8){lo[0], lo[1], lo[2], lo[3], hi[0], hi[1], hi[2], hi[3]};
                            }
                    f32x16 p[2];
        #pragma unroll
                    for (int kb = 0; kb < 2; ++kb) {
                        f32x16 acc;
        #pragma unroll
                        for (int r = 0; r < 16; ++r) acc[r] = 0.f;
        #pragma unroll
                        for (int st = 0; st < 4; ++st) { const bf16x8 ka = *(const LAS bf16x8*)(Kc + (32 * kb + l31) * 144 + st * 32 + h2 * 16); acc = __builtin_amdgcn_mfma_f32_32x32x16_bf16(ka, qf[st], acc, 0, 0, 0); }
                        const unsigned wk = (kb ? (unsigned)(mw >> 32) : (unsigned)mw) >> (4 * h2);
        #pragma unroll
                        for (int r = 0; r < 16; ++r) {
                            const float e = __builtin_amdgcn_exp2f(acc[r]);
                            float pe;
                            asm("v_bfe_i32 %0, %2, %3, 1\n\tv_and_b32 %0, %0, %1" : "=&v"(pe) : "v"(e), "v"(wk), "i"((r & 3) + 8 * (r >> 2)));
                            acc[r] = pe;
                        }
                        p[kb] = acc;
                    }
                    const unsigned long long t_c = PROBE_SEC ? __builtin_amdgcn_s_memtime() : 0ull;
        #pragma unroll
                    for (int kb = 0; kb < 2; ++kb)
        #pragma unroll
                        for (int s = 0; s < 2; ++s) {
                            v4u pw; pw.x = pg8::cvt_pk_bf16(p[kb][8 * s + 0], p[kb][8 * s + 1]); pw.y = pg8::cvt_pk_bf16(p[kb][8 * s + 2], p[kb][8 * s + 3]); pw.z = pg8::cvt_pk_bf16(p[kb][8 * s + 4], p[kb][8 * s + 5]); pw.w = pg8::cvt_pk_bf16(p[kb][8 * s + 6], p[kb][8 * s + 7]);
                            lsum = dot2bf(pw.x, 0x3f803f80u, lsum); lsum = dot2bf(pw.y, 0x3f803f80u, lsum); lsum = dot2bf(pw.z, 0x3f803f80u, lsum); lsum = dot2bf(pw.w, 0x3f803f80u, lsum);
                            const bf16x8 pa = __builtin_bit_cast(bf16x8, pw);
        #pragma unroll
                            for (int d0 = 0; d0 < 2; ++d0) {
                                const bf16x8 vb = vfr[kb][s][d0];
                                if (d0 == 0) o0 = __builtin_amdgcn_mfma_f32_32x32x16_bf16(pa, vb, o0, 0, 0, 0); else o1 = __builtin_amdgcn_mfma_f32_32x32x16_bf16(pa, vb, o1, 0, 0, 0);
                            }
                        }
                    if (PROBE_SEC) { const unsigned long long t_d = __builtin_amdgcn_s_memtime(); tacc += (PROBE_SEC == 1) ? (t_b - t_a) : (PROBE_SEC == 2) ? (t_c - t_b) : (PROBE_SEC == 3) ? (t_d - t_c) : (t_d - t_a); ++tcnt; }
                }
            }
        }
    }
    lsum += __shfl_xor(lsum, 32);
    if (h2 == 0) wsf[l31] = lsum;
    LDS_WAIT(); asm volatile("" ::: "memory");
    LAS bf16* stg = (LAS bf16*)(F.lds + 2 * 17408 + 1024) + wid * 2048;
#pragma unroll
    for (int r = 0; r < 16; ++r) { const int q = crow(r, h2); const float rl = 1.0f / wsf[q];
        stg[q * 64 + l31] = (bf16)f2bf(o0[r] * rl); stg[q * 64 + 32 + l31] = (bf16)f2bf(o1[r] * rl); }
    LDS_WAIT(); asm volatile("" ::: "memory");
    bf16* ow = ((bf16*)(F.ws + WS_AO)) + tok0 * 512 + h * 64;
#pragma unroll
    for (int i = 0; i < 4; ++i) { const int row = i * 8 + (lane >> 3), ch = lane & 7; const v4u v = *(const LAS v4u*)(stg + row * 64 + ch * 8); *(GAS v4u*)(ow + (size_t)row * 512 + ch * 8) = v; }
    LDS_WAIT(); asm volatile("" ::: "memory");
}

__device__ __forceinline__ float row_rs(const float* ssp, size_t tok) {
    const GAS f32x4* p = (const GAS f32x4*)(ssp + tok * 16); const f32x4 a = p[0], b = p[1], c = p[2], d = p[3];
    const float ss = ((a.x + a.y) + (a.z + a.w)) + ((b.x + b.y) + (b.z + b.w)) + ((c.x + c.y) + (c.z + c.w)) + ((d.x + d.y) + (d.z + d.w));
    return 1.0f / sqrtf(ss * (1.f / 1024.f) + EPS);
}
__device__ __forceinline__ void sort16_desc(unsigned (&a)[16]) {
#pragma unroll
    for (int k = 2; k <= 16; k <<= 1)
#pragma unroll
        for (int j = k >> 1; j > 0; j >>= 1)
#pragma unroll
            for (int i = 0; i < 16; ++i) { const int l = i ^ j; if (l > i) { const unsigned hi = a[i] > a[l] ? a[i] : a[l], lo = a[i] > a[l] ? a[l] : a[i];
                if ((i & k) == 0) { a[i] = hi; a[l] = lo; } else { a[i] = lo; a[l] = hi; } } }
}
__device__ __forceinline__ void merge16_desc(unsigned (&top)[16], const unsigned (&a)[16]) {
#pragma unroll
    for (int i = 0; i < 16; ++i) top[i] = top[i] > a[15 - i] ? top[i] : a[15 - i];
#pragma unroll
    for (int j = 8; j > 0; j >>= 1)
#pragma unroll
        for (int i = 0; i < 16; ++i) { const int l = i ^ j; if (l > i) { const unsigned hi = top[i] > top[l] ? top[i] : top[l], lo = top[i] > top[l] ? top[l] : top[i]; top[i] = hi; top[l] = lo; } }
}
struct PairTab { int i[64], j[64]; };
constexpr PairTab make_pairs() { PairTab t{}; int n = 0; for (int i = 0; i < 16; ++i) for (int j = 0; j < 16; ++j) if ((i + 1) * (j + 1) <= 16) { t.i[n] = i; t.j[n] = j; ++n; } for (; n < 64; ++n) { t.i[n] = -1; t.j[n] = -1; } return t; }
__device__ __forceinline__ void route_task(Frame& F, const Args& AR, int tt, int h) {
    const int lane = F.lane, l31 = lane & 31, h2 = lane >> 5;
    const size_t tok = (size_t)tt * 32 + l31;
    LAS unsigned* lk = (LAS unsigned*)F.lds;
    unsigned KA[16], KB[16];
#pragma unroll
    for (int i = 0; i < 16; ++i) { KA[i] = 0u; KB[i] = 0u; }
#pragma unroll 1
    for (int p = 0; p < 2; ++p) {
        const int hp = 2 * h + p;
        bf16x8 bq[4];
        { const bf16* qp = ((const bf16*)(F.ws + WS_SUBK)) + tok * 1024 + hp * 64 + h2 * 8;
#pragma unroll
          for (int st = 0; st < 4; ++st) bq[st] = *(const GAS bf16x8*)(qp + st * 16); }
        unsigned top[16];
#pragma unroll
        for (int i = 0; i < 16; ++i) top[i] = 0u;
#pragma unroll 1
        for (int blk = 0; blk < 4; ++blk) {
            const bf16* ap = ((const bf16*)(F.ws + WS_SKB)) + (size_t)(hp * 128 + 32 * blk + l31) * 64 + h2 * 8;
            f32x16 acc;
#pragma unroll
            for (int r = 0; r < 16; ++r) acc[r] = 0.f;
#pragma unroll
            for (int st = 0; st < 4; ++st) { const bf16x8 af = *(const GAS bf16x8*)(ap + st * 16); acc = __builtin_amdgcn_mfma_f32_32x32x16_bf16(af, bq[st], acc, 0, 0, 0); }
            unsigned a16[16];
#pragma unroll
            for (int r = 0; r < 16; ++r) a16[r] = (ordk(acc[r]) & ~127u) | (unsigned)(127 - (32 * blk + (r & 3) + 8 * (r >> 2)) - 4 * h2);
            sort16_desc(a16);
            merge16_desc(top, a16);
        }
        unsigned oth[16];
#pragma unroll
        for (int i = 0; i < 16; ++i) oth[i] = __shfl_xor(top[i], 32);
        merge16_desc(top, oth);
#pragma unroll
        for (int i = 0; i < 16; ++i) { if (p == 0) KA[i] = top[i]; else KB[i] = top[i]; }
    }
    float sa[16], sb[16];
#pragma unroll
    for (int i = 0; i < 16; ++i) { sa[i] = unordk(KA[i] & ~127u); sb[i] = unordk(KB[i] & ~127u); lk[i * 512 + F.tid] = KA[i]; lk[(16 + i) * 512 + F.tid] = KB[i]; }
    unsigned ck[16];
#pragma unroll
    for (int grp = 0; grp < 4; ++grp) {
        unsigned a[16];
#pragma unroll
        for (int q = 0; q < 16; ++q) { constexpr PairTab T = make_pairs(); const int pi = T.i[grp * 16 + q], pj = T.j[grp * 16 + q];
            a[q] = (pi < 0) ? 0u : ((ordk(sa[pi < 0 ? 0 : pi] + sb[pj < 0 ? 0 : pj]) & ~255u) | (unsigned)(255 - (pi * 16 + pj))); }
        sort16_desc(a);
        if (grp == 0) {
#pragma unroll
            for (int i = 0; i < 16; ++i) ck[i] = a[i];
        } else merge16_desc(ck, a);
    }
    LDS_WAIT(); asm volatile("" ::: "memory");
    unsigned ce[16];
#pragma unroll
    for (int t = 0; t < 16; ++t) { const unsigned flat = 255u - (ck[t] & 255u); const unsigned ka = lk[(flat >> 4) * 512 + F.tid], kb = lk[(16u + (flat & 15u)) * 512 + F.tid];
        ce[t] = (127u - (ka & 127u)) * 128u + (127u - (kb & 127u)); }
    LDS_WAIT(); asm volatile("" ::: "memory");
    float ts[16]; float sum = 0.f; const float mx = unordk(ck[0] & ~255u);
    const float rsl = row_rs((const float*)(F.ws + WS_SSP), tok) * 1.4426950408889634f;
#pragma unroll
    for (int t = 0; t < 16; ++t) { ts[t] = __builtin_amdgcn_exp2f((unordk(ck[t] & ~255u) - mx) * rsl); sum += ts[t]; }
    const float inv = 1.0f / sum;
    if (h2 == 0) {
        GAS v4u* eo = (GAS v4u*)(((unsigned short*)(F.ws + WS_REXP)) + tok * 128 + h * 16); GAS f32x4* go = (GAS f32x4*)(((float*)(F.ws + WS_RG)) + tok * 128 + h * 16);
        eo[0] = (v4u){ce[0] | (ce[1] << 16), ce[2] | (ce[3] << 16), ce[4] | (ce[5] << 16), ce[6] | (ce[7] << 16)};
        eo[1] = (v4u){ce[8] | (ce[9] << 16), ce[10] | (ce[11] << 16), ce[12] | (ce[13] << 16), ce[14] | (ce[15] << 16)};
#pragma unroll
        for (int t4 = 0; t4 < 4; ++t4) go[t4] = (f32x4){ts[4 * t4] * inv, ts[4 * t4 + 1] * inv, ts[4 * t4 + 2] * inv, ts[4 * t4 + 3] * inv};
    }
}

__device__ __forceinline__ float gelu_erf(float v) {
    const float av = fabsf(v), t = __builtin_amdgcn_rcpf(av * 0.2316418882f + 1.0f);
    float q = t * 0.5307027145f + (-0.7265760135f); q = q * t + 0.7107068705f; q = q * t + (-0.142248368f); q = q * t + 0.127414796f; q = q * t;
    const float e = __builtin_amdgcn_exp2f((v * v) * (-0.72134752044f));
    const float m = v * (q * e);
    return v < 0.f ? m : v - m;
}
__device__ __forceinline__ float dpp_add(float v, float w_unused) { return v; }
#define DPP_ADD(v, ctrl) ((v) + __builtin_bit_cast(float, __builtin_amdgcn_update_dpp(0, __builtin_bit_cast(int, (v)), (ctrl), 0xf, 0xf, true)))
#define DPP_MAX(v, ctrl) fmaxf((v), __builtin_bit_cast(float, __builtin_amdgcn_update_dpp(0, __builtin_bit_cast(int, (v)), (ctrl), 0xf, 0xf, true)))
#define DPP_ADDI(v, ctrl) ((v) + __builtin_amdgcn_update_dpp(0, (v), (ctrl), 0xf, 0xf, true))
constexpr int NSL = 8;
constexpr int CW_PEER = 8192;
typedef float f32x2v __attribute__((ext_vector_type(2)));
__device__ __forceinline__ unsigned id_of(const v4u a, const v4u b, int m) { const unsigned w = (m < 8) ? a[(m & 7) >> 1] : b[(m & 7) >> 1]; return (m & 1) ? (w >> 16) : (w & 0xffffu); }
__device__ __forceinline__ void load_hn2(const bf16* p, f32x2v (&hn2)[8]) { const v4u a = *(const GAS v4u*)p, b = *(const GAS v4u*)(p + 8);
    hn2[0] = (f32x2v){bflo(a.x), bfhi(a.x)}; hn2[1] = (f32x2v){bflo(a.y), bfhi(a.y)}; hn2[2] = (f32x2v){bflo(a.z), bfhi(a.z)}; hn2[3] = (f32x2v){bflo(a.w), bfhi(a.w)};
    hn2[4] = (f32x2v){bflo(b.x), bfhi(b.x)}; hn2[5] = (f32x2v){bflo(b.y), bfhi(b.y)}; hn2[6] = (f32x2v){bflo(b.z), bfhi(b.z)}; hn2[7] = (f32x2v){bflo(b.w), bfhi(b.w)}; }
template <int SIDE> __device__ __forceinline__ void peer_item8(Frame& F, const Args& AR, int s, size_t t0, unsigned idmask = 0xffffu, bool dry = false) {
    const int lane = F.lane, ts = lane >> 3, c = lane & 7;
    const size_t tok = t0 + ts;
    const unsigned char* tbase = ((const unsigned char*)(F.ws + (SIDE == 0 ? WS_U16 : WS_V16))) + ((size_t)s << 21);
    const unsigned lo = 16u * (unsigned)c;
    const GAS v4u* idq = (const GAS v4u*)(((const unsigned short*)(F.ws + WS_REXP)) + tok * 128);
    v4u ia = idq[0], ib = idq[1];
    if (SIDE == 0) {
        int hq[4]; float dq;
        { const bf16* hp = ((const bf16*)(F.ws + WS_HG)) + tok * 1024 + 128 * s + 16 * c; const v4u a = *(const GAS v4u*)hp, b2 = *(const GAS v4u*)(hp + 8);
          float x[16]; x[0] = bflo(a.x); x[1] = bfhi(a.x); x[2] = bflo(a.y); x[3] = bfhi(a.y); x[4] = bflo(a.z); x[5] = bfhi(a.z); x[6] = bflo(a.w); x[7] = bfhi(a.w);
          x[8] = bflo(b2.x); x[9] = bfhi(b2.x); x[10] = bflo(b2.y); x[11] = bfhi(b2.y); x[12] = bflo(b2.z); x[13] = bfhi(b2.z); x[14] = bflo(b2.w); x[15] = bfhi(b2.w);
          float am = 1e-30f;
#pragma unroll
          for (int i = 0; i < 16; ++i) am = fmaxf(am, fabsf(x[i]));
          am = DPP_MAX(am, 0xB1); am = DPP_MAX(am, 0x4E); am = DPP_MAX(am, 0x141);
          const float qs = 127.0f * __builtin_amdgcn_rcpf(am) * 0.99999f; dq = am * (1.0f / (127.0f * 0.99999f));
#pragma unroll
          for (int q = 0; q < 4; ++q) { unsigned bt[4];
#pragma unroll
              for (int i = 0; i < 4; ++i) bt[i] = __float_as_uint(x[4 * q + i] * qs + 12582912.0f);
              hq[q] = (int)(__builtin_amdgcn_perm(bt[1], bt[0], 0x0c0c0400u) | __builtin_amdgcn_perm(bt[3], bt[2], 0x04000c0cu)); } }
        bf16* po = ((bf16*)(F.ws + WS_SUBK)) + (tok * NSL + s) * 128;
#pragma unroll 1
        for (int b = 0; b < 8; ++b) {
            v4u r[16];
#pragma unroll
            for (int m = 0; m < 16; ++m) r[m] = *(const GAS v4u*)(tbase + (size_t)(((id_of(ia, ib, m) & idmask) << 7) + lo));
            const int bn = (b + 1) & 7; ia = idq[2 * bn]; ib = idq[2 * bn + 1];
            float d[16];
#pragma unroll
            for (int m = 0; m < 16; ++m) { int acc = 0;
#pragma unroll
                for (int q = 0; q < 4; ++q) acc = __builtin_amdgcn_sdot4((int)r[m][q], hq[q], acc, false);
                acc = DPP_ADDI(acc, 0xB1); acc = DPP_ADDI(acc, 0x4E); acc = DPP_ADDI(acc, 0x141); d[m] = (float)acc * dq; }
            if (c == 0) { GAS v4u* pq = (GAS v4u*)(po + 16 * b);
                pq[0] = (v4u){pk2(d[0], d[1]), pk2(d[2], d[3]), pk2(d[4], d[5]), pk2(d[6], d[7])}; pq[1] = (v4u){pk2(d[8], d[9]), pk2(d[10], d[11]), pk2(d[12], d[13]), pk2(d[14], d[15])}; }
        }
    } else {
        const GAS f32x4* cfq = (const GAS f32x4*)(((const float*)(F.ws + WS_RG)) + tok * 128);
        f32x4 cf[4];
#pragma unroll
        for (int q = 0; q < 4; ++q) cf[q] = cfq[q];
        f32x2v acc[8];
#pragma unroll
        for (int j = 0; j < 8; ++j) acc[j] = (f32x2v){0.f, 0.f};
#pragma unroll 1
        for (int b = 0; b < 8; ++b) {
            v4u r[16];
#pragma unroll
            for (int m = 0; m < 16; ++m) r[m] = *(const GAS v4u*)(tbase + (size_t)(((id_of(ia, ib, m) & idmask) << 7) + lo));
            const int bn = (b + 1) & 7; ia = idq[2 * bn]; ib = idq[2 * bn + 1];
            f32x4 cn[4];
#pragma unroll
            for (int q = 0; q < 4; ++q) cn[q] = cfq[4 * bn + q];
#pragma unroll
            for (int m = 0; m < 16; ++m) { const float cm = cf[m >> 2][m & 3]; const f32x2v c2 = {cm, cm};
#pragma unroll
                for (int q = 0; q < 4; ++q) { const int w = (int)r[m][q]; acc[2 * q] = __builtin_amdgcn_cvt_pk_f32_fp8(w, false) * c2 + acc[2 * q]; acc[2 * q + 1] = __builtin_amdgcn_cvt_pk_f32_fp8(w, true) * c2 + acc[2 * q + 1]; } }
#pragma unroll
            for (int q = 0; q < 4; ++q) cf[q] = cn[q];
        }
        GAS f32x4* op = (GAS f32x4*)((AR.out) + tok * 1024 + 128 * s + 16 * c);
#pragma unroll
        for (int q = 0; q < 4; ++q) { f32x4 h = op[q]; h.x += acc[2 * q].x; h.y += acc[2 * q].y; h.z += acc[2 * q + 1].x; h.w += acc[2 * q + 1].y; if (!dry || h.x == 1.2345e30f) op[q] = h; }
    }
}
__device__ __forceinline__ void quant_hn16(const bf16* hp, int (&hq)[4], float& dq) {
    const v4u a = *(const GAS v4u*)hp, b2 = *(const GAS v4u*)(hp + 8);
    float x[16]; x[0] = bflo(a.x); x[1] = bfhi(a.x); x[2] = bflo(a.y); x[3] = bfhi(a.y); x[4] = bflo(a.z); x[5] = bfhi(a.z); x[6] = bflo(a.w); x[7] = bfhi(a.w);
    x[8] = bflo(b2.x); x[9] = bfhi(b2.x); x[10] = bflo(b2.y); x[11] = bfhi(b2.y); x[12] = bflo(b2.z); x[13] = bfhi(b2.z); x[14] = bflo(b2.w); x[15] = bfhi(b2.w);
    float am = 1e-30f;
#pragma unroll
    for (int i = 0; i < 16; ++i) am = fmaxf(am, fabsf(x[i]));
    am = DPP_MAX(am, 0xB1); am = DPP_MAX(am, 0x4E); am = DPP_MAX(am, 0x141);
    const float qs = 127.0f * __builtin_amdgcn_rcpf(am) * 0.99999f; dq = am * (1.0f / (127.0f * 0.99999f));
#pragma unroll
    for (int q = 0; q < 4; ++q) { unsigned bt[4];
#pragma unroll
        for (int i = 0; i < 4; ++i) bt[i] = __float_as_uint(x[4 * q + i] * qs + 12582912.0f);
        hq[q] = (int)(__builtin_amdgcn_perm(bt[1], bt[0], 0x0c0c0400u) | __builtin_amdgcn_perm(bt[3], bt[2], 0x04000c0cu)); }
}
__device__ __forceinline__ void peer_u16(Frame& F, int s, size_t t0, unsigned idmask = 0xffffu) {
    const int lane = F.lane, ts = lane >> 3, c = lane & 7;
    const size_t tok = t0 + ts;
    const unsigned char* tbase = ((const unsigned char*)(F.ws + WS_U16)) + ((size_t)s << 21);
    const unsigned lo = 16u * (unsigned)c;
    const GAS v4u* idq = (const GAS v4u*)(((const unsigned short*)(F.ws + WS_REXP)) + tok * 128);
    int hq0[4], hq1[4]; float dq0, dq1;
    quant_hn16(((const bf16*)(F.ws + WS_HG)) + tok * 1024 + 128 * s + 16 * c, hq0, dq0);
    quant_hn16(((const bf16*)(F.ws + WS_HG)) + (tok + 8) * 1024 + 128 * s + 16 * c, hq1, dq1);
    bf16* po = ((bf16*)(F.ws + WS_SUBK)) + (tok * NSL + s) * 128;
    v4u ia, ib;
    v4u r[16];
    { const v4u i0 = idq[0], i1 = idq[1]; ia = idq[2]; ib = idq[3];
      asm volatile("" :: "v"(ia), "v"(ib));
#pragma unroll
      for (int m = 0; m < 16; ++m) r[m] = *(const GAS v4u*)(tbase + (size_t)(((id_of(i0, i1, m) & idmask) << 7) + lo)); }
#pragma unroll 1
    for (int j = 0; j < 15; ++j) {
        const bool g1 = j >= 8;
        v4u na, nb; { const int jn = (j + 2 < 16) ? j + 2 : 15; const GAS v4u* ip = idq + ((jn >> 3) * 128 + 2 * (jn & 7)); na = ip[0]; nb = ip[1]; }
        int hq[4];
#pragma unroll
        for (int q = 0; q < 4; ++q) hq[q] = g1 ? hq1[q] : hq0[q];
        const float dq = g1 ? dq1 : dq0;
        float d[16];
#pragma unroll
        for (int m = 0; m < 16; ++m) { int acc = 0;
#pragma unroll
            for (int q = 0; q < 4; ++q) acc = __builtin_amdgcn_sdot4((int)r[m][q], hq[q], acc, false);
            r[m] = *(const GAS v4u*)(tbase + (size_t)(((id_of(ia, ib, m) & idmask) << 7) + lo));
            acc = DPP_ADDI(acc, 0xB1); acc = DPP_ADDI(acc, 0x4E); acc = DPP_ADDI(acc, 0x141); d[m] = (float)acc * dq; }
        ia = na; ib = nb;
        if (c == 0) { GAS v4u* pq = (GAS v4u*)(po + (j >> 3) * (8 * NSL * 128) + 16 * (j & 7));
            pq[0] = (v4u){pk2(d[0], d[1]), pk2(d[2], d[3]), pk2(d[4], d[5]), pk2(d[6], d[7])}; pq[1] = (v4u){pk2(d[8], d[9]), pk2(d[10], d[11]), pk2(d[12], d[13]), pk2(d[14], d[15])}; }
    }
    { float d[16];
#pragma unroll
        for (int m = 0; m < 16; ++m) { int acc = 0;
#pragma unroll
            for (int q = 0; q < 4; ++q) acc = __builtin_amdgcn_sdot4((int)r[m][q], hq1[q], acc, false);
            acc = DPP_ADDI(acc, 0xB1); acc = DPP_ADDI(acc, 0x4E); acc = DPP_ADDI(acc, 0x141); d[m] = (float)acc * dq1; }
        if (c == 0) { GAS v4u* pq = (GAS v4u*)(po + (8 * NSL * 128) + 16 * 7);
            pq[0] = (v4u){pk2(d[0], d[1]), pk2(d[2], d[3]), pk2(d[4], d[5]), pk2(d[6], d[7])}; pq[1] = (v4u){pk2(d[8], d[9]), pk2(d[10], d[11]), pk2(d[12], d[13]), pk2(d[14], d[15])}; } }
}
constexpr int PV_IDROW = 272, PV_CFROW = 528, PV_CFOFF = 16 * PV_IDROW, PV_WAVE = PV_CFOFF + 16 * PV_CFROW, PV_BASE = 1024;
__device__ __forceinline__ void peer_v16(Frame& F, const Args& AR, int s, size_t t0, unsigned idmask, bool dry) {
    const int lane = F.lane, ts = lane >> 3, c = lane & 7;
    const unsigned char* tbase = ((const unsigned char*)(F.ws + WS_V16)) + ((size_t)s << 21);
    const unsigned lo = 16u * (unsigned)c;
    LAS unsigned char* wl = F.lds + PV_BASE + F.wave * PV_WAVE;
    { const GAS v4u* gi = (const GAS v4u*)(((const unsigned short*)(F.ws + WS_REXP)) + t0 * 128);
      const GAS v4u* gc = (const GAS v4u*)(((const float*)(F.ws + WS_RG)) + t0 * 128);
      v4u si[4], sc[8];
#pragma unroll
      for (int i = 0; i < 4; ++i) si[i] = gi[lane + 64 * i];
#pragma unroll
      for (int i = 0; i < 8; ++i) sc[i] = gc[lane + 64 * i];
#pragma unroll
      for (int i = 0; i < 4; ++i) { const int j = lane + 64 * i; *(LAS v4u*)(wl + (j >> 4) * PV_IDROW + 16 * (j & 15)) = si[i]; }
#pragma unroll
      for (int i = 0; i < 8; ++i) { const int j = lane + 64 * i; *(LAS v4u*)(wl + PV_CFOFF + (j >> 5) * PV_CFROW + 16 * (j & 31)) = sc[i]; } }
    const LAS v4u* idl = (const LAS v4u*)(wl + ts * PV_IDROW);
    const LAS f32x4* cfl = (const LAS f32x4*)(wl + PV_CFOFF + ts * PV_CFROW);
    f32x2v acc[8];
#pragma unroll
    for (int j = 0; j < 8; ++j) acc[j] = (f32x2v){0.f, 0.f};
    v4u r[16];
    { const v4u i0 = idl[0], i1 = idl[1];
#pragma unroll
      for (int m = 0; m < 16; ++m) r[m] = *(const GAS v4u*)(tbase + (size_t)(((id_of(i0, i1, m) & idmask) << 7) + lo)); }
#pragma unroll 1
    for (int j = 0; j < 15; ++j) {
        const int g = j >> 3, b = j & 7, jn = j + 1;
        const LAS v4u* ip = idl + ((jn >> 3) * (8 * PV_IDROW / 16) + 2 * (jn & 7)); const v4u ia = ip[0], ib = ip[1];
        const LAS f32x4* cp = cfl + (g * (8 * PV_CFROW / 16) + 4 * b);
        f32x4 cf[4];
#pragma unroll
        for (int q = 0; q < 4; ++q) cf[q] = cp[q];
#pragma unroll
        for (int m = 0; m < 16; ++m) { const float cm = cf[m >> 2][m & 3]; const f32x2v c2 = {cm, cm};
#pragma unroll
            for (int q = 0; q < 4; ++q) { const int w = (int)r[m][q]; acc[2 * q] = __builtin_amdgcn_cvt_pk_f32_fp8(w, false) * c2 + acc[2 * q]; acc[2 * q + 1] = __builtin_amdgcn_cvt_pk_f32_fp8(w, true) * c2 + acc[2 * q + 1]; }
            r[m] = *(const GAS v4u*)(tbase + (size_t)(((id_of(ia, ib, m) & idmask) << 7) + lo));
            __builtin_amdgcn_sched_barrier(0); }
        if (b == 7) {
            GAS f32x4* op = (GAS f32x4*)((AR.out) + (t0 + ts) * 1024 + 128 * s + 16 * c);
#pragma unroll
            for (int q = 0; q < 4; ++q) { f32x4 h = op[q]; h.x += acc[2 * q].x; h.y += acc[2 * q].y; h.z += acc[2 * q + 1].x; h.w += acc[2 * q + 1].y; if (!dry || h.x == 1.2345e30f) op[q] = h; }
#pragma unroll
            for (int q = 0; q < 8; ++q) acc[q] = (f32x2v){0.f, 0.f};
        }
    }
    { const LAS f32x4* cp = cfl + ((8 * PV_CFROW / 16) + 4 * 7);
      f32x4 cf[4];
#pragma unroll
      for (int q = 0; q < 4; ++q) cf[q] = cp[q];
#pragma unroll
      for (int m = 0; m < 16; ++m) { const float cm = cf[m >> 2][m & 3]; const f32x2v c2 = {cm, cm};
#pragma unroll
          for (int q = 0; q < 4; ++q) { const int w = (int)r[m][q]; acc[2 * q] = __builtin_amdgcn_cvt_pk_f32_fp8(w, false) * c2 + acc[2 * q]; acc[2 * q + 1] = __builtin_amdgcn_cvt_pk_f32_fp8(w, true) * c2 + acc[2 * q + 1]; } }
      GAS f32x4* op = (GAS f32x4*)((AR.out) + (t0 + 8 + ts) * 1024 + 128 * s + 16 * c);
#pragma unroll
      for (int q = 0; q < 4; ++q) { f32x4 h = op[q]; h.x += acc[2 * q].x; h.y += acc[2 * q].y; h.z += acc[2 * q + 1].x; h.w += acc[2 * q + 1].y; if (!dry || h.x == 1.2345e30f) op[q] = h; } }
}
template <int SIDE> __device__ __forceinline__ void peer_side(Frame& F, const Args& AR, int rep = 0) {
    gu32* cnt = F.ctl + CW_PEER + (SIDE + 2 * rep) * 16 * 64;
    LAS int* sh = (LAS int*)F.lds;
    const unsigned xcc = xb_xcc_id() & 7u;
#pragma unroll 1
    for (int k = 0; k < NSL; ++k) {
        const int s = (int)((xcc + (unsigned)k) & (unsigned)(NSL - 1));
#pragma unroll 1
        for (;;) {
            __syncthreads();
            if (F.tid == 0) sh[0] = (int)__hip_atomic_fetch_add(cnt + 64 * s, 1u, RLX_AGENT);
            __syncthreads();
            const int blk = sh[0];
            if (blk >= MTOK / 128) break;
            const size_t t0 = (size_t)blk * 128 + F.wave * 16;
            if (SIDE == 0) peer_u16(F, s, t0, (PROBE_FAKEID && ((REPEAT_MASK >> 11) & 1) && rep == 0) ? (unsigned)PROBE_FAKEID : 0xffffu); else { const bool dry = ((REPEAT_MASK >> 13) & 1) && rep == 0; const unsigned im = (dry && PROBE_FAKEID) ? (unsigned)PROBE_FAKEID : 0xffffu; peer_v16(F, AR, s, t0, im, dry); }
        }
    }
}
__device__ __forceinline__ void peer_coef_token(Frame& F, size_t tok, float inv_su, float inv_sv) {
    const int lane = F.lane;
    const unsigned short* pp = ((const unsigned short*)(F.ws + WS_SUBK)) + tok * NSL * 128;
    float a0 = 0.f, a1 = 0.f;
#pragma unroll
    for (int s = 0; s < NSL; ++s) { a0 += __uint_as_float((unsigned)pp[s * 128 + lane] << 16); a1 += __uint_as_float((unsigned)pp[s * 128 + 64 + lane] << 16); }
    float* gp = ((float*)(F.ws + WS_RG)) + tok * 128;
    const float sc = inv_su * row_rs((const float*)(F.ws + WS_SSP), tok);
    gp[lane] = gp[lane] * gelu_erf(a0 * sc) * inv_sv; gp[64 + lane] = gp[64 + lane] * gelu_erf(a1 * sc) * inv_sv;
}

__global__ void __launch_bounds__(NWAVES * 64, 2) mk_fwd(Args args) {
    extern __shared__ __attribute__((aligned(16))) unsigned char lds[];
    Frame F;
    F.lds = (LAS unsigned char*)lds;
    F.MISC = (volatile LAS unsigned*)(F.lds + MISC_OFF);
    F.tid = threadIdx.x; F.lane = F.tid & 63; F.wave = __builtin_amdgcn_readfirstlane(F.tid >> 6);
    F.G = gridDim.x; { const int bx = blockIdx.x; F.vcu = (F.G % 8 == 0) ? (bx % 8) * (F.G / 8) + bx / 8 : bx; }
    F.ws = args.ws;
    F.ctl = (gu32*)(F.ws + WS_CTL);
    const Args& AR = args;
    for (int u = F.tid; u < (LDS_BYTES - LDSCTL_OFF) / 4; u += NWAVES * 64) ((LAS unsigned*)(F.lds + LDSCTL_OFF))[u] = 0u;
    __syncthreads();
    XcdBarrier bar; bar.bar = (unsigned*)(F.ctl + CW_BAR); bar.x = 0; bar.st = nullptr;
#if !MK_PER_PHASE
    bar = xcd_barrier_post((unsigned*)(F.ctl + CW_BAR), F.MISC + 8);
#endif
    unsigned long long tacc_ = 0ull; unsigned tcnt_ = 0u;
    const unsigned long long tk0c_ = (PROBE_SEC == 10) ? __builtin_amdgcn_s_memtime() : 0ull, tk0r_ = (PROBE_SEC == 10) ? __builtin_amdgcn_s_memrealtime() : 0ull;
    const int lo = args.ph_lo, hi = args.ph_hi;
#if defined(ONLY_PHASE)
#define IN(k) ((k) == ONLY_PHASE && lo <= (k) && (k) < hi)
#elif defined(PHASE_MASK)
#define IN(k) (((PHASE_MASK >> (k)) & 1) && lo <= (k) && (k) < hi)
#else
#define IN(k) (lo <= (k) && (k) < hi)
#endif
#if MK_PER_PHASE
#define SEAM(k) do { } while (0)
#else
#define SEAM(k) do { if (IN(k) && IN((k) + 1)) xcd_barrier(bar); } while (0)
#endif
#define FRESH() Frame P = F; { int t_ = threadIdx.x; asm volatile("" : "+v"(t_)); P.tid = t_; P.lane = t_ & 63; P.wave = __builtin_amdgcn_readfirstlane(t_ >> 6); } const int gw = P.vcu * NWAVES + P.wave, NGW = P.G * NWAVES; (void)gw; (void)NGW

    for (int rep_ = 0; rep_ < (((REPEAT_MASK >> 0) & 1) ? 2 : 1); ++rep_) if (IN(0)) { FRESH(); p0_prologue(P, args); } SEAM(0);
    const unsigned long long tq0c_ = (PROBE_SEC == 12) ? __builtin_amdgcn_s_memtime() : 0ull, tq0r_ = (PROBE_SEC == 12) ? __builtin_amdgcn_s_memrealtime() : 0ull;
    for (int rep_ = 0; rep_ < (((REPEAT_MASK >> 1) & 1) ? 2 : 1); ++rep_) if (IN(1)) { pg8::Gemm g{((bf16*)(F.ws + WS_ACT)), ((bf16*)(F.ws + WS_WIN)), MTOK, LDP, 1024, 1024, 1024}; pg8::StaticOrder S; S.init(MTOK, LDP, F.G, (int)blockIdx.x);
        pg8::EpiStoreBf16 E{((bf16*)(F.ws + WS_PROJ)), LDP};
        pg8::gemm_phase<pg8::EpiStoreBf16, pg8::StaticOrder, true, true>(F.lds, g, S, E); } SEAM(1);
    if (PROBE_SEC == 12) { const unsigned long long dc = __builtin_amdgcn_s_memtime() - tq0c_, dr = __builtin_amdgcn_s_memrealtime() - tq0r_; tacc_ = dc * 100ull / (dr ? dr : 1ull); tcnt_ = 1u; }
    if (IN(2)) { FRESH(); for (int m = gw; m < MTOK; m += NGW) fixup_token(P, args, m);
        for (int r0 = gw * 32; r0 < MTOK; r0 += NGW * 32) pool_run(P, r0, 32);
        const float su = i8_scale(__hip_atomic_load(P.ctl + CW_AMAX, RLX_AGENT)), sv = fp8_scale(__hip_atomic_load(P.ctl + CW_AMAX + 1, RLX_AGENT));
#pragma unroll 4
        for (int r = gw; r < 2 * 16384; r += NGW) { const int rr = r & 16383;
            if (r < 16384) row_to_i8(args.in[13] + (size_t)rr * 1024, (unsigned char*)(P.ws + WS_U16) + (size_t)rr * 128, su, P.lane);
            else row_to_fp8(args.in[14] + (size_t)rr * 1024, (unsigned char*)(P.ws + WS_V16) + (size_t)rr * 128, sv, P.lane); } } SEAM(2);
    for (int rep_ = 0; rep_ < (((REPEAT_MASK >> 3) & 1) ? 2 : 1); ++rep_) if (IN(3)) { FRESH(); for (int i = P.vcu; i < 256; i += P.G) { const int b = i >> 4, s = i & 15;
#pragma unroll 1
            for (int k = 0; k < 4; ++k) idx_unit(P, args, b, (k == 0) ? s : (k == 1) ? 31 - s : (k == 2) ? 32 + s : 63 - s, tacc_, tcnt_, PROBE_NOSEL ? (rep_ == 1) : true); } } SEAM(3);
    const unsigned long long tp4_ = (PROBE_SEC == 5 || PROBE_SEC == 6 || PROBE_SEC == 7) ? ((PROBE_SEC != 6) ? __builtin_amdgcn_s_memtime() : __builtin_amdgcn_s_memrealtime()) : 0ull;
    for (int rep_ = 0; rep_ < (((REPEAT_MASK >> 4) & 1) ? 2 : 1); ++rep_) if (IN(4)) { FRESH(); for (int i = P.vcu; i < 256; i += P.G) { const int bh = i >> 1, s = i & 1, b = bh >> 3, h = bh & 7;
#pragma unroll 1
            for (int k = 0; k < 8; ++k) attn_unit(P, args, b, h, (k & 1) ? 15 - (k >> 1) * 2 - s : (k >> 1) * 2 + s, tacc_, tcnt_); }
        if (PROBE_SEC == 7) { tacc_ = (__builtin_amdgcn_s_memtime() - tp4_) / 1000ull; tcnt_ = 1u; } } SEAM(4);
    if (PROBE_SEC == 5) { tacc_ = (__builtin_amdgcn_s_memtime() - tp4_) / 1000ull; tcnt_ = 1u; }
    if (PROBE_SEC == 6) { tacc_ = (__builtin_amdgcn_s_memrealtime() - tp4_) / 10ull; tcnt_ = 1u; }
    for (int rep_ = 0; rep_ < (((REPEAT_MASK >> 5) & 1) ? 2 : 1); ++rep_) if (IN(5)) { pg8::Gemm g{((bf16*)(F.ws + WS_AO)), ((bf16*)(F.ws + WS_WA)), MTOK, 1024, 512, 512, 512}; pg8::StaticOrder S; S.init(MTOK, 1024, F.G, (int)blockIdx.x);
        pg8::EpiGate<false> E{((bf16*)(F.ws + WS_ACT)), 1024, ((bf16*)(F.ws + WS_PROJ)) + GA_OFF, LDP};
        pg8::gemm_phase<pg8::EpiGate<false>, pg8::StaticOrder, true, true>(F.lds, g, S, E); }
    if (IN(6)) { pg8::Gemm g{((bf16*)(F.ws + WS_POOLED)), ((bf16*)(F.ws + WS_WPP)), MTOK, 1024, 512, 512, 512}; pg8::StaticOrder S; S.init(MTOK, 1024, F.G, (int)blockIdx.x);
                pg8::EpiGate<true> E{((bf16*)(F.ws + WS_ACT)), 1024, ((bf16*)(F.ws + WS_PROJ)) + GP_OFF, LDP};
        pg8::gemm_phase<pg8::EpiGate<true>, pg8::StaticOrder, true, true>(F.lds, g, S, E); } SEAM(6);
    for (int rep_ = 0; rep_ < (((REPEAT_MASK >> 7) & 1) ? 2 : 1); ++rep_) if (IN(7)) { pg8::Gemm g{((bf16*)(F.ws + WS_ACT)), ((bf16*)(F.ws + WS_WO)), MTOK, 1024, 1024, 1024, 1024}; pg8::StaticOrder S; S.init(MTOK, 1024, F.G, (int)blockIdx.x);
        pg8::EpiResHG E{(AR.in[0]), (AR.out), ((bf16*)(F.ws + WS_HG)), (AR.in[10]), ((float*)(F.ws + WS_SSP)), 1024};
        pg8::gemm_phase<pg8::EpiResHG, pg8::StaticOrder, true, true>(F.lds, g, S, E); } SEAM(7);

    for (int rep_ = 0; rep_ < (((REPEAT_MASK >> 9) & 1) ? 2 : 1); ++rep_) if (IN(9)) { pg8::Gemm g{((bf16*)(F.ws + WS_HG)), ((bf16*)(F.ws + WS_W2)), MTOK, 1024, 1024, 1024, 1024}; pg8::StaticOrder S; S.init(MTOK, 1024, F.G, (int)blockIdx.x);
        pg8::EpiStoreBf16 E{((bf16*)(F.ws + WS_SUBK)), 1024};
        pg8::gemm_phase<pg8::EpiStoreBf16, pg8::StaticOrder, true, true>(F.lds, g, S, E); } SEAM(9);
    for (int rep_ = 0; rep_ < (((REPEAT_MASK >> 10) & 1) ? 2 : 1); ++rep_) if (IN(10)) { FRESH(); for (int tt = P.vcu; tt < MTOK / 32; tt += P.G) route_task(P, args, tt, P.wave); } SEAM(10);
        const unsigned long long tg0c_ = (PROBE_SEC == 11) ? __builtin_amdgcn_s_memtime() : 0ull, tg0r_ = (PROBE_SEC == 11) ? __builtin_amdgcn_s_memrealtime() : 0ull;
    for (int rep_ = 0; rep_ < (((REPEAT_MASK >> 11) & 1) ? 2 : 1); ++rep_) if (IN(11)) { FRESH(); peer_side<0>(P, args, rep_); } SEAM(11);
    if (IN(12)) { FRESH(); const float iu = i8_inv_scale(__hip_atomic_load(P.ctl + CW_AMAX, RLX_AGENT)), iv = fp8_inv_scale(__hip_atomic_load(P.ctl + CW_AMAX + 1, RLX_AGENT));
        for (int m = gw; m < MTOK; m += NGW) peer_coef_token(P, (size_t)m, iu, iv); } SEAM(12);
    for (int rep_ = 0; rep_ < (((REPEAT_MASK >> 13) & 1) ? 2 : 1); ++rep_) if (IN(13)) { FRESH(); peer_side<1>(P, args, rep_); }
#if PROBE_SEC == 11
    { const unsigned long long dc = __builtin_amdgcn_s_memtime() - tg0c_, dr = __builtin_amdgcn_s_memrealtime() - tg0r_; tacc_ = dc * 100ull / (dr ? dr : 1ull); tcnt_ = 1u; }
#endif
#if PROBE_SEC == 10
    { const unsigned long long dc = __builtin_amdgcn_s_memtime() - tk0c_, dr = __builtin_amdgcn_s_memrealtime() - tk0r_; tacc_ = dc * 100ull / (dr ? dr : 1ull); tcnt_ = 1u; }
#endif
#if PROBE_RATE
    { int lane_ = threadIdx.x; asm volatile("" : "+v"(lane_)); int x = lane_ * 3 + 1, y = lane_ ^ 0x55; int a[8]; f32x2v f[8]; const f32x2v fx = {1.0001f, 0.9999f}, fy = {1e-9f, 2e-9f};
#pragma unroll
      for (int k = 0; k < 8; ++k) { a[k] = lane_ + k; f[k] = (f32x2v){(float)k, 1.f}; }
#pragma unroll 1
      for (int i = 0; i < 640; ++i) {
#pragma unroll
          for (int r = 0; r < 8; ++r)
#pragma unroll
              for (int k = 0; k < 8; ++k) {
                  if (PROBE_RATE == 1) asm volatile("v_dot4c_i32_i8_e32 %0, %1, %2" : "+v"(a[k]) : "v"(x), "v"(y));
                  if (PROBE_RATE == 2) asm volatile("v_pk_fma_f32 %0, %1, %2, %0" : "+v"(f[k]) : "v"(fx), "v"(fy));
                  if (PROBE_RATE == 3) asm volatile("v_cvt_pk_f32_fp8_e32 %0, %1" : "=v"(f[k]) : "v"(x));
                  if (PROBE_RATE == 4) asm volatile("v_add_u32_dpp %0, %0, %0 quad_perm:[1,0,3,2] row_mask:0xf bank_mask:0xf bound_ctrl:1" : "+v"(a[k]));
                  if (PROBE_RATE == 5) asm volatile("v_perm_b32 %0, %0, %1, %2" : "+v"(a[k]) : "v"(x), "v"(y));
                  if (PROBE_RATE == 6) asm volatile("v_fma_f32 %0, %1, %2, %0" : "+v"(f[k].x) : "v"(fx.x), "v"(fy.x));
                  if (PROBE_RATE == 7) asm volatile("v_lshl_or_b32 %0, %0, 10, %1" : "+v"(a[k]) : "v"(x));
                  if (PROBE_RATE == 10) asm volatile("v_dot4c_i32_i8_e32 %0, %1, %2" : "+v"(a[0]) : "v"(x), "v"(y));
                  if (PROBE_RATE == 11) asm volatile("v_pk_fma_f32 %0, %1, %2, %0" : "+v"(f[0]) : "v"(fx), "v"(fy));
              }
      }
      int sum = 0;
#pragma unroll
      for (int k = 0; k < 8; ++k) sum += a[k] + (int)f[k].x + (int)f[k].y;
      if (sum == 0x7fffffff) ((volatile int*)(F.ws + WS_CTL))[2048 + threadIdx.x] = sum; }
#endif
#if PROBE_SEC
    if (blockIdx.x == 0 && F.wave == 7) { const unsigned long long avg = tacc_ / (unsigned long long)(tcnt_ ? tcnt_ : 1u); const unsigned long long t_end = __builtin_amdgcn_s_memrealtime() + avg * 10ull;
        while (__builtin_amdgcn_s_memrealtime() < t_end) __builtin_amdgcn_s_sleep(8); }
#endif

#undef IN
#undef SEAM
}

extern "C" void kernel_launch(void* const* d_in, const int* in_sizes, int n_in, void* d_out, int out_size, void* d_ws, size_t ws_size, hipStream_t stream) {
    static int grid = 0;
    if (grid == 0) {
        if (n_in != 15 || in_sizes[0] != MTOK * DM || out_size != MTOK * DM || ws_size < WS_END) { fprintf(stderr, "kernel_launch: unexpected shapes (n_in %d, in0 %d, out %d, ws %zu < %zu)\n", n_in, n_in > 0 ? in_sizes[0] : -1, out_size, ws_size, (size_t)WS_END); grid = -1; return; }
        int dev = 0, cus = 0, per_cu = 0;
        if (hipGetDevice(&dev) != hipSuccess || hipDeviceGetAttribute(&cus, hipDeviceAttributeMultiprocessorCount, dev) != hipSuccess) { grid = -1; return; }
        if (hipFuncSetAttribute((const void*)mk_fwd, hipFuncAttributeMaxDynamicSharedMemorySize, LDS_BYTES) != hipSuccess) { fprintf(stderr, "kernel_launch: hipFuncSetAttribute failed\n"); grid = -1; return; }
        if (hipOccupancyMaxActiveBlocksPerMultiprocessor(&per_cu, (const void*)mk_fwd, NWAVES * 64, LDS_BYTES) != hipSuccess || per_cu < 1) { fprintf(stderr, "kernel_launch: occupancy query says %d blocks per CU\n", per_cu); (void)hipGetLastError(); grid = -1; return; }
        grid = cus;
    }
    if (grid < 0) return;
    if (hipMemsetAsync((char*)d_ws + WS_CTL, 0, CTL_ZERO_BYTES, stream) != hipSuccess) return;
    Args a{};
    for (int i = 0; i < 15; ++i) a.in[i] = (const float*)d_in[i];
    a.out = (float*)d_out; a.ws = (unsigned char*)d_ws;
#if MK_PER_PHASE
    for (int p = 0; p < NPHASE; ++p) { a.ph_lo = p; a.ph_hi = p + 1; hipLaunchKernelGGL(mk_fwd, dim3(grid), dim3(NWAVES * 64), LDS_BYTES, stream, a); }
#else
    a.ph_lo = 0; a.ph_hi = NPHASE;
    hipLaunchKernelGGL(mk_fwd, dim3(grid), dim3(NWAVES * 64), LDS_BYTES, stream, a);
#endif
}
```
